# Optimizing an MI355X kernel written in HIP

```python
import jax, jax.numpy as jnp
from jax import lax
import numpy as np

D_MODEL = 1024
BATCH = 32
SEQ = 2048
DEPTH = 4

HEAD_DIM = 64
MIX_WIDTH = D_MODEL
N_HEADS_A = (MIX_WIDTH // 4) // HEAD_DIM
N_HEADS_B = (MIX_WIDTH // 2) // HEAD_DIM
N_KV_GROUPS_B = 2
N_POOL_GROUPS = 4
POOL_GROUP_DIM = (MIX_WIDTH // 4) // N_POOL_GROUPS
POOL_WINDOWS = (2, 4, 8, 16)
KV_RANK_A = 2 * HEAD_DIM
N_IDX_HEADS = 4
IDX_DIM = 32
TOPK_MAX = 256
CMP_BLOCK = 32
CMP_STRIDE = 16
SLC_BLOCK = 64
N_SLC = 16
WINDOW = 512
ROPE_THETA = 500000.0
ROT_DIM_HEAD = HEAD_DIM // 4
ROT_DIM_IDX = IDX_DIM // 4
D_FF = 4 * D_MODEL
Q_BLOCK = 32
EPS = 1e-6
NEG = -1e30

SPLIT_WIDTHS = (
    N_HEADS_A * HEAD_DIM,
    KV_RANK_A,
    N_IDX_HEADS * IDX_DIM,
    IDX_DIM,
    N_IDX_HEADS,
    N_HEADS_B * HEAD_DIM,
    N_KV_GROUPS_B * HEAD_DIM,
    N_KV_GROUPS_B * HEAD_DIM,
    N_KV_GROUPS_B * HEAD_DIM,
    N_KV_GROUPS_B * HEAD_DIM,
    N_KV_GROUPS_B * HEAD_DIM,
    N_KV_GROUPS_B * HEAD_DIM,
    N_HEADS_B * 3,
    N_POOL_GROUPS * POOL_GROUP_DIM,
)
D_IN = sum(SPLIT_WIDTHS)
SPLIT_OFFSETS = tuple(sum(SPLIT_WIDTHS[:i + 1]) for i in range(len(SPLIT_WIDTHS) - 1))

kernel_name = "hymba_dsa_nsa_pool_hybrid"

f32 = jnp.float32


def rms_norm(x, gain=None):
    xf = x.astype(f32)
    y = xf * lax.rsqrt(jnp.mean(xf * xf, axis=-1, keepdims=True) + EPS)
    if gain is not None:
        y = y * gain.astype(f32)
    return y.astype(x.dtype)


def rope_tables(positions, rot_dim):
    inv_freq = ROPE_THETA ** (-jnp.arange(0, rot_dim, 2, dtype=f32) / rot_dim)
    ang = positions.astype(f32)[..., None] * inv_freq
    return jnp.cos(ang), jnp.sin(ang)


def apply_partial_rope(x, cos, sin):
    half = cos.shape[-1]
    bshape = cos.shape[:2] + (1,) * (x.ndim - 3) + (half,)
    c, s = cos.reshape(bshape), sin.reshape(bshape)
    xf = x.astype(f32)
    x1, x2, rest = xf[..., :half], xf[..., half:2 * half], xf[..., 2 * half:]
    return jnp.concatenate([x1 * c - x2 * s, x1 * s + x2 * c, rest], axis=-1).astype(x.dtype)


def sweep_query_blocks(block_fn, seq_len):
    starts = jnp.arange(seq_len // Q_BLOCK, dtype=jnp.int32) * Q_BLOCK
    out = lax.map(block_fn, starts)
    out = jnp.swapaxes(out, 0, 1)
    return out.reshape((out.shape[0], seq_len) + out.shape[3:])


def take_rows(src, idx):
    return jax.vmap(lambda s, i: s[i])(src, idx)


def dsa_attention(q, k, v, q_idx, k_idx, w_idx):
    S = q.shape[1]
    n_keep = min(TOPK_MAX, S // 4)
    scale = HEAD_DIM ** -0.5
    key_pos = jnp.arange(S)

    def block(q0):
        t = q0 + jnp.arange(Q_BLOCK)
        qi = lax.dynamic_slice_in_dim(q_idx, q0, Q_BLOCK, 1)
        wi = lax.dynamic_slice_in_dim(w_idx, q0, Q_BLOCK, 1)
        qb = lax.dynamic_slice_in_dim(q, q0, Q_BLOCK, 1)
        rel = jax.nn.relu(jnp.einsum('bqhd,bsd->bqhs', qi, k_idx).astype(f32))
        score = jnp.einsum('bqhs,bqh->bqs', rel, wi.astype(f32))
        causal = key_pos[None, :] <= t[:, None]
        score = jnp.where(causal[None], score, -jnp.inf)
        _, idx = lax.top_k(score, n_keep)
        ks = take_rows(k, idx)
        vs = take_rows(v, idx)
        logits = jnp.einsum('bqhd,bqkd->bqhk', qb, ks).astype(f32) * scale
        valid = (idx <= t[None, :, None])[:, :, None, :]
        p = jax.nn.softmax(jnp.where(valid, logits, NEG), axis=-1)
        return jnp.einsum('bqhk,bqkd->bqhd', p.astype(vs.dtype), vs)

    return sweep_query_blocks(block, S)


def nsa_compress(kv, pe, w_phi):
    B, S, G, dh = kv.shape
    chunks = kv.reshape(B, S // CMP_STRIDE, CMP_STRIDE, G, dh)
    blocks = jnp.concatenate([chunks[:, :-1], chunks[:, 1:]], axis=2)
    blocks = blocks + pe[None, None, :, None, :]
    return jnp.einsum('bclgd,lde->bcge', blocks, w_phi)


def nsa_attention(q_nope, q_rope, k_cmp, v_cmp, k_slc, v_slc, k_win, v_win, gates):
    B, S, H, dh = q_nope.shape
    G = k_slc.shape[2]
    R = H // G
    NC = k_cmp.shape[1]
    NS = S // SLC_BLOCK
    n_sel = min(N_SLC, NS)
    scale = dh ** -0.5
    cmp_start = jnp.arange(NC) * CMP_STRIDE
    cmp_end = cmp_start + CMP_BLOCK - 1
    slc_start = jnp.arange(NS) * SLC_BLOCK
    overlap = ((cmp_start[:, None] <= slc_start[None, :] + SLC_BLOCK - 1)
               & (cmp_end[:, None] >= slc_start[None, :])).astype(f32)
    kblk = k_slc.reshape(B, NS, SLC_BLOCK, G, dh).transpose(0, 3, 1, 2, 4)
    vblk = v_slc.reshape(B, NS, SLC_BLOCK, G, dh).transpose(0, 3, 1, 2, 4)
    k_pad = jnp.pad(k_win, ((0, 0), (WINDOW, 0), (0, 0), (0, 0)))
    v_pad = jnp.pad(v_win, ((0, 0), (WINDOW, 0), (0, 0), (0, 0)))
    blk_ids = jnp.arange(NS)
    gather_blocks = jax.vmap(jax.vmap(lambda blocks, i: blocks[i]))

    def block(q0):
        t = q0 + jnp.arange(Q_BLOCK)
        qn = lax.dynamic_slice_in_dim(q_nope, q0, Q_BLOCK, 1).reshape(B, Q_BLOCK, G, R, dh)
        qr = lax.dynamic_slice_in_dim(q_rope, q0, Q_BLOCK, 1).reshape(B, Q_BLOCK, G, R, dh)
        g = jax.nn.sigmoid(lax.dynamic_slice_in_dim(gates, q0, Q_BLOCK, 1).astype(f32))
        g = g.reshape(B, Q_BLOCK, G, R, 3)
        lc = jnp.einsum('bqgrd,bcgd->bqgrc', qn, k_cmp).astype(f32) * scale
        cmask = (cmp_end[None, :] <= t[:, None])[None, :, None, None, :]
        p_cmp = jax.nn.softmax(jnp.where(cmask, lc, NEG), axis=-1) * cmask
        o_cmp = jnp.einsum('bqgrc,bcgd->bqgrd', p_cmp.astype(v_cmp.dtype), v_cmp)
        s_slc = jnp.einsum('bqgrc,cj->bqgj', p_cmp, overlap)
        cur = t // SLC_BLOCK
        forced = ((blk_ids[None, :] == 0) | (blk_ids[None, :] == cur[:, None])
                  | (blk_ids[None, :] == cur[:, None] - 1))
        admissible = slc_start[None, :] <= t[:, None]
        s_slc = jnp.where(forced[None, :, None, :], jnp.inf,
                          jnp.where(admissible[None, :, None, :], s_slc, -jnp.inf))
        _, sel = lax.top_k(s_slc, n_sel)
        sel_t = sel.transpose(0, 2, 1, 3)
        ks = gather_blocks(kblk, sel_t)
        vs = gather_blocks(vblk, sel_t)
        ls = jnp.einsum('bqgrd,bgqnld->bqgrnl', qr, ks).astype(f32) * scale
        tok = sel_t[..., None] * SLC_BLOCK + jnp.arange(SLC_BLOCK)
        smask = (tok <= t[None, None, :, None, None]).transpose(0, 2, 1, 3, 4)[:, :, :, None]
        ls = jnp.where(smask, ls, NEG).reshape(B, Q_BLOCK, G, R, n_sel * SLC_BLOCK)
        p_s = jax.nn.softmax(ls, axis=-1).reshape(B, Q_BLOCK, G, R, n_sel, SLC_BLOCK)
        o_slc = jnp.einsum('bqgrnl,bgqnld->bqgrd', p_s.astype(vs.dtype), vs)
        kw = lax.dynamic_slice_in_dim(k_pad, q0, WINDOW + Q_BLOCK, 1)
        vw = lax.dynamic_slice_in_dim(v_pad, q0, WINDOW + Q_BLOCK, 1)
        kpos = q0 - WINDOW + jnp.arange(WINDOW + Q_BLOCK)
        wmask = ((kpos[None, :] >= 0) & (kpos[None, :] <= t[:, None])
                 & (kpos[None, :] > t[:, None] - WINDOW))
        lw = jnp.einsum('bqgrd,bkgd->bqgrk', qr, kw).astype(f32) * scale
        p_w = jax.nn.softmax(jnp.where(wmask[None, :, None, None, :], lw, NEG), axis=-1)
        o_win = jnp.einsum('bqgrk,bkgd->bqgrd', p_w.astype(vw.dtype), vw)
        o = (g[..., 0:1] * o_cmp.astype(f32) + g[..., 1:2] * o_slc.astype(f32)
             + g[..., 2:3] * o_win.astype(f32))
        return o.astype(q_nope.dtype).reshape(B, Q_BLOCK, H, dh)

    return sweep_query_blocks(block, S)


def multiscale_pool(u, w_pool):
    S = u.shape[1]
    uf = u.astype(f32)
    csum = jnp.cumsum(uf, axis=1)
    count = jnp.arange(1, S + 1, dtype=f32)
    outs = []
    for gi, w in enumerate(POOL_WINDOWS):
        cs = csum[:, :, gi]
        prev = jnp.pad(cs[:, :S - w], ((0, 0), (w, 0), (0, 0)))
        mean = (cs - prev) / jnp.minimum(count, w)[None, :, None]
        outs.append(mean - uf[:, :, gi])
    pooled = jnp.stack(outs, axis=2).astype(u.dtype)
    return jnp.einsum('bsgc,gcd->bsgd', pooled, w_pool)


def hybrid_layer(x, cos_h, sin_h, cos_i, sin_i, w_in, g_kv_a, w_kv_up_a, w_cmp_k, w_cmp_v,
                 pe_cmp_k, pe_cmp_v, w_pool, pool_scale, g_out_a, g_out_b, w_out,
                 g_pre_mix, g_post_mix, g_pre_mlp, g_post_mlp, w_up, w_down):
    B, S, _ = x.shape
    G = N_KV_GROUPS_B
    h = rms_norm(x, g_pre_mix)
    proj = h @ w_in
    (q_a, ckv_a, q_idx, k_idx, w_idx, q_b, k_cmp, v_cmp, k_slc, v_slc,
     k_win, v_win, gate_b, u_c) = jnp.split(proj, SPLIT_OFFSETS, axis=-1)
    q_a = apply_partial_rope(q_a.reshape(B, S, N_HEADS_A, HEAD_DIM), cos_h, sin_h)
    kv_a = rms_norm(ckv_a, g_kv_a) @ w_kv_up_a
    k_a = apply_partial_rope(kv_a[..., :HEAD_DIM], cos_h, sin_h)
    v_a = kv_a[..., HEAD_DIM:]
    q_idx = apply_partial_rope(q_idx.reshape(B, S, N_IDX_HEADS, IDX_DIM), cos_i, sin_i)
    k_idx = apply_partial_rope(k_idx, cos_i, sin_i)
    o_a = dsa_attention(q_a, k_a, v_a, q_idx, k_idx, w_idx).reshape(B, S, -1)
    q_b = q_b.reshape(B, S, N_HEADS_B, HEAD_DIM)
    kc = nsa_compress(k_cmp.reshape(B, S, G, HEAD_DIM), pe_cmp_k, w_cmp_k)
    vc = nsa_compress(v_cmp.reshape(B, S, G, HEAD_DIM), pe_cmp_v, w_cmp_v)
    o_b = nsa_attention(q_b, apply_partial_rope(q_b, cos_h, sin_h), kc, vc,
                        apply_partial_rope(k_slc.reshape(B, S, G, HEAD_DIM), cos_h, sin_h),
                        v_slc.reshape(B, S, G, HEAD_DIM),
                        apply_partial_rope(k_win.reshape(B, S, G, HEAD_DIM), cos_h, sin_h),
                        v_win.reshape(B, S, G, HEAD_DIM),
                        gate_b.reshape(B, S, N_HEADS_B, 3)).reshape(B, S, -1)
    o_c = multiscale_pool(u_c.reshape(B, S, N_POOL_GROUPS, POOL_GROUP_DIM), w_pool).reshape(B, S, -1)
    mixed = jnp.concatenate([rms_norm(o_a, g_out_a), rms_norm(o_b, g_out_b),
                             rms_norm(o_c) * pool_scale.reshape(-1)], axis=-1)
    x = x + rms_norm(mixed @ w_out, g_post_mix)
    h = rms_norm(x, g_pre_mlp)
    f = jnp.square(jax.nn.relu(h @ w_up)) @ w_down
    return x + rms_norm(f, g_post_mlp)


def setup_inputs(seed: int = 0) -> dict:
    key = jax.random.key(seed)
    ks = jax.random.split(key, 24)
    G = N_KV_GROUPS_B

    def nrm(k, shape, fan_in):
        return jax.random.normal(k, shape, f32) * (fan_in ** -0.5)

    def gain(k, shape):
        return 1.0 + 0.1 * jax.random.normal(k, shape, f32)

    x = jax.random.normal(ks[0], (BATCH, SEQ, D_MODEL), f32)
    offset = jax.random.randint(ks[1], (BATCH, 1), 0, 1024, dtype=jnp.int32)
    positions = jnp.arange(SEQ, dtype=jnp.int32)[None, :] + offset
    return {
        "x": x,
        "positions": positions,
        "w_in": nrm(ks[2], (DEPTH, D_MODEL, D_IN), D_MODEL),
        "g_kv_a": gain(ks[3], (DEPTH, KV_RANK_A)),
        "w_kv_up_a": nrm(ks[4], (DEPTH, KV_RANK_A, 2 * HEAD_DIM), KV_RANK_A),
        "w_cmp_k": nrm(ks[5], (DEPTH, CMP_BLOCK, HEAD_DIM, HEAD_DIM), CMP_BLOCK * HEAD_DIM),
        "w_cmp_v": nrm(ks[6], (DEPTH, CMP_BLOCK, HEAD_DIM, HEAD_DIM), CMP_BLOCK * HEAD_DIM),
        "pe_cmp_k": 0.02 * jax.random.normal(ks[7], (DEPTH, CMP_BLOCK, HEAD_DIM), f32),
        "pe_cmp_v": 0.02 * jax.random.normal(ks[8], (DEPTH, CMP_BLOCK, HEAD_DIM), f32),
        "w_pool": nrm(ks[9], (DEPTH, N_POOL_GROUPS, POOL_GROUP_DIM, POOL_GROUP_DIM), POOL_GROUP_DIM),
        "pool_scale": gain(ks[10], (DEPTH, N_POOL_GROUPS, POOL_GROUP_DIM)),
        "g_out_a": gain(ks[11], (DEPTH, N_HEADS_A * HEAD_DIM)),
        "g_out_b": gain(ks[12], (DEPTH, N_HEADS_B * HEAD_DIM)),
        "w_out": nrm(ks[13], (DEPTH, MIX_WIDTH, D_MODEL), MIX_WIDTH),
        "g_pre_mix": gain(ks[14], (DEPTH, D_MODEL)),
        "g_post_mix": gain(ks[15], (DEPTH, D_MODEL)),
        "g_pre_mlp": gain(ks[16], (DEPTH, D_MODEL)),
        "g_post_mlp": gain(ks[17], (DEPTH, D_MODEL)),
        "w_up": nrm(ks[18], (DEPTH, D_MODEL, D_FF), D_MODEL),
        "w_down": nrm(ks[19], (DEPTH, D_FF, D_MODEL), D_FF),
    }


def reference(x, positions, w_in, g_kv_a, w_kv_up_a, w_cmp_k, w_cmp_v, pe_cmp_k, pe_cmp_v,
              w_pool, pool_scale, g_out_a, g_out_b, w_out, g_pre_mix, g_post_mix,
              g_pre_mlp, g_post_mlp, w_up, w_down):
    cos_h, sin_h = rope_tables(positions, ROT_DIM_HEAD)
    cos_i, sin_i = rope_tables(positions, ROT_DIM_IDX)
    for l in range(DEPTH):
        x = hybrid_layer(x, cos_h, sin_h, cos_i, sin_i, w_in[l], g_kv_a[l], w_kv_up_a[l],
                         w_cmp_k[l], w_cmp_v[l], pe_cmp_k[l], pe_cmp_v[l], w_pool[l],
                         pool_scale[l], g_out_a[l], g_out_b[l], w_out[l], g_pre_mix[l],
                         g_post_mix[l], g_pre_mlp[l], g_post_mlp[l], w_up[l], w_down[l])
    return x
```

```cpp
#include <hip/hip_runtime.h>
#include <cstdio>
#include <cstdint>

#ifndef SKIPM
#define SKIPM 0
#endif
#ifndef MK_MULTI
#define MK_MULTI 1
#endif

namespace pg8 {
#define PG8_LAS __attribute__((address_space(3)))
typedef unsigned short bf16_t;
typedef short bf16x8 __attribute__((ext_vector_type(8)));
typedef float f32x4 __attribute__((ext_vector_type(4)));
typedef unsigned u32x4 __attribute__((ext_vector_type(4)));
constexpr int BM = 256, BK = 64, HALF = 128, HTB = HALF * BK * 2, STAGE_BYTES = 8 * HTB, NXCD = 8, WGM = 8;

__host__ __device__ __forceinline__ int lds_byte(int r, int c) { const int st = (r >> 4) * 2 + (c >> 5), rr = r & 15, cc = c & 31, ob = rr * 64 + cc * 2; return st * 1024 + (ob ^ (((ob >> 9) & 1) << 5)); }
__host__ __device__ __forceinline__ void stage_rc(int b, int& R, int& C) { const int st = b / 1024, sb = b % 1024, swz = sb ^ (((sb >> 9) & 1) << 5); R = (st >> 1) * 16 + swz / 64; C = (st & 1) * 32 + (swz % 64) / 2; }
__host__ __device__ __forceinline__ int perm32(int rho) { const int n = rho >> 4, i = rho & 15; return 8 * (i >> 2) + 4 * n + (i & 3); }

struct Unit { int pm, pn; };
struct Gemm { const bf16_t* A; const bf16_t* Bt; int M, N, K; };

struct StaticOrder {
    int nM, nN, nwg, G, c;
    __host__ __device__ void init(int M, int N, int G_, int c_) { nM = M / BM; nN = N / BM; nwg = nM * nN; G = G_; c = c_; }
    __host__ __device__ bool next(int i, Unit& u) const {
        const long L = (long)i * G + c; if (L >= nwg) return false;
        int wgid = (int)L; { const int q = nwg / NXCD, r = nwg % NXCD, xcd = wgid % NXCD, off = wgid / NXCD; wgid = (xcd < r ? xcd * (q + 1) : r * (q + 1) + (xcd - r) * q) + off; }
        const int nig = WGM * nN, gid = wgid / nig, fm = gid * WGM, gsz = (nM - fm) < WGM ? (nM - fm) : WGM;
        u.pm = fm + ((wgid % nig) % gsz); u.pn = (wgid % nig) / gsz; return true;
    }
    __device__ __forceinline__ void a_ready(const Unit&) const {}
    __device__ __forceinline__ void done(const Unit&) const {}
};

__device__ __forceinline__ unsigned cvt_pk_bf16(float lo, float hi) { unsigned r; asm volatile("v_cvt_pk_bf16_f32 %0, %1, %2" : "=v"(r) : "v"(lo), "v"(hi)); return r; }

template <int ACT  > struct EpiStore {
    static constexpr bool PERM = true, AFTER_DRAIN = false;
    bf16_t* O; int ldc;
    __device__ __forceinline__ void operator()(const f32x4 (&acc)[2][2][4][2], const Unit& u, int wr, int wc, int fr, int fq) const {
        const int row0 = u.pm * BM + wr * 64 + fr;
        const int col0 = u.pn * BM + wc * 32 + 8 * fq;
#pragma unroll
        for (int ai = 0; ai < 2; ++ai)
#pragma unroll
            for (int m = 0; m < 4; ++m) { bf16_t* rowp = O + (size_t)(row0 + ai * HALF + m * 16) * ldc + col0;
#pragma unroll
                for (int bj = 0; bj < 2; ++bj) { f32x4 v0 = acc[ai][bj][m][0], v1 = acc[ai][bj][m][1];
                    if (ACT == 2) {
#pragma unroll
                        for (int e = 0; e < 4; ++e) { const float a = fmaxf(v0[e], 0.f), b = fmaxf(v1[e], 0.f); v0[e] = a * a; v1[e] = b * b; } }
                    u32x4 w; w.x = cvt_pk_bf16(v0[0], v0[1]); w.y = cvt_pk_bf16(v0[2], v0[3]); w.z = cvt_pk_bf16(v1[0], v1[1]); w.w = cvt_pk_bf16(v1[2], v1[3]);
                    *(u32x4*)(rowp + bj * HALF) = w; } }
    }
};

template <class Epi, class Sched, bool ALIGN_EPI = false, bool SP2 = false>
__device__ __forceinline__ void gemm_phase(PG8_LAS unsigned char* lds, const Gemm g, const Sched& S, const Epi& E) {
    int tid_ = threadIdx.x; asm volatile("" : "+v"(tid_));
    const int tid = tid_, wid = __builtin_amdgcn_readfirstlane(tid >> 6), lane = tid & 63, wr = wid >> 2, wc = wid & 3, fr = lane & 15, fq = lane >> 4;
    const int K = g.K, nt = K / BK;
    unsigned voffA[2], voffB[2];
#pragma unroll
    for (int i = 0; i < 2; ++i) { int R, C; stage_rc(tid * 16 + i * 8192, R, C); const int Rb = Epi::PERM ? ((R & ~31) + perm32(R & 31)) : R;
        voffA[i] = (unsigned)(R * K + C) * 2u; voffB[i] = (unsigned)(Rb * K + C) * 2u; }
    const size_t kstep = (size_t)(BK * 2);
    const size_t hstep = (size_t)HALF * K * 2;
    const size_t tstep = 2 * hstep;
    const unsigned ldsw = (unsigned)wid * 1024u;
    const int aoff = lds_byte(wr * 64 + fr, fq * 8), boff = lds_byte(wc * 32 + fr, fq * 8);
#define PG8_SA(b, h) (((b) * 2 + (h)) * HTB)
#define PG8_SB(b, h) ((4 + (b) * 2 + (h)) * HTB)
#define PG8_STAGE(bufoff, gbase, voff) do { _Pragma("unroll") for (int _i = 0; _i < 2; ++_i) \
        __builtin_amdgcn_global_load_lds((const unsigned*)((const char*)(gbase) + (voff)[_i]), (PG8_LAS unsigned*)(lds + (bufoff) + ldsw + _i * 8192), 16, 0, 0); } while (0)
#define PG8_LDA(dst, b, h) do { _Pragma("unroll") for (int m = 0; m < 4; ++m) _Pragma("unroll") for (int k = 0; k < 2; ++k) dst[m][k] = *(const PG8_LAS bf16x8*)(lds + PG8_SA(b, h) + aoff + m * 2048 + k * 1024); } while (0)
#define PG8_LDB(dst, b, h) do { _Pragma("unroll") for (int n = 0; n < 2; ++n) _Pragma("unroll") for (int k = 0; k < 2; ++k) dst[n][k] = *(const PG8_LAS bf16x8*)(lds + PG8_SB(b, h) + boff + n * 2048 + k * 1024); } while (0)
#define PG8_MMA(ai, bj, At, Bt) do { __builtin_amdgcn_s_setprio(1); _Pragma("unroll") for (int m = 0; m < 4; ++m) _Pragma("unroll") for (int n = 0; n < 2; ++n) _Pragma("unroll") for (int k = 0; k < 2; ++k) \
        acc[ai][bj][m][n] = __builtin_amdgcn_mfma_f32_16x16x32_bf16(Bt[n][k], At[m][k], acc[ai][bj][m][n], 0, 0, 0); __builtin_amdgcn_s_setprio(0); } while (0)
#define PG8_WAIT_V(n) asm volatile("s_waitcnt vmcnt(" #n ")" ::: "memory")
#define PG8_WAIT_L(n) asm volatile("s_waitcnt lgkmcnt(" #n ")" ::: "memory")
#define PG8_BAR __builtin_amdgcn_s_barrier()
#define PG8_SCHED __builtin_amdgcn_sched_barrier(0)
    Unit cur, nxt; int ui = 0;
    if (!S.next(0, cur)) return;
    f32x4 acc[2][2][4][2];
#pragma unroll
    for (int a = 0; a < 2; ++a)
#pragma unroll
        for (int b = 0; b < 2; ++b)
#pragma unroll
            for (int m = 0; m < 4; ++m)
#pragma unroll
                for (int n = 0; n < 2; ++n) acc[a][b][m][n] = (f32x4){0.f, 0.f, 0.f, 0.f};
    bf16x8 At[4][2], B0[2][2], B1[2][2];
    const char* cA = (const char*)g.A + (size_t)cur.pm * tstep; const char* cB = (const char*)g.Bt + (size_t)cur.pn * tstep;
    S.a_ready(cur);
    if constexpr (SP2) {
        PG8_STAGE(PG8_SB(0, 0), cB, voffB); PG8_STAGE(PG8_SB(0, 1), cB + hstep, voffB); PG8_STAGE(PG8_SA(0, 0), cA, voffA); PG8_STAGE(PG8_SA(0, 1), cA + hstep, voffA);
        if (wr == 1) PG8_BAR;
        PG8_WAIT_V(2); PG8_BAR;
        PG8_STAGE(PG8_SB(1, 0), cB + kstep, voffB); PG8_STAGE(PG8_SA(1, 0), cA + kstep, voffA); PG8_STAGE(PG8_SB(1, 1), cB + hstep + kstep, voffB);
        PG8_WAIT_V(6); PG8_BAR;
    } else {
        PG8_STAGE(PG8_SB(0, 0), cB, voffB); PG8_STAGE(PG8_SA(0, 0), cA, voffA); PG8_STAGE(PG8_SB(0, 1), cB + hstep, voffB); PG8_STAGE(PG8_SA(0, 1), cA + hstep, voffA);
        if (wr == 1) PG8_BAR;
        PG8_WAIT_V(4); PG8_BAR;
        PG8_STAGE(PG8_SB(1, 0), cB + kstep, voffB); PG8_STAGE(PG8_SA(1, 0), cA + kstep, voffA); PG8_STAGE(PG8_SB(1, 1), cB + hstep + kstep, voffB);
        PG8_WAIT_V(6); PG8_BAR;
    }
    for (;;) {
        const bool has_next = S.next(ui + 1, nxt);
        const char* nA = has_next ? (const char*)g.A + (size_t)nxt.pm * tstep : cA; const char* nB = has_next ? (const char*)g.Bt + (size_t)nxt.pn * tstep : cB;
        for (int t = 0; t < nt; t += 2) {
            const bool last = (t == nt - 2);
            const char* a1 = cA + (size_t)(t + 1) * kstep;
            const char* a2 = last ? nA : cA + (size_t)(t + 2) * kstep; const char* b2 = last ? nB : cB + (size_t)(t + 2) * kstep;
            const char* a3 = a2 + kstep; const char* b3 = b2 + kstep;
            if (last && has_next) S.a_ready(nxt);
            if constexpr (SP2) {
            PG8_LDB(B0, 0, 0); PG8_LDB(B1, 0, 1); PG8_SCHED; PG8_LDA(At, 0, 0); PG8_STAGE(PG8_SA(1, 1), a1 + hstep, voffA);
            PG8_WAIT_V(8); PG8_WAIT_L(0); PG8_BAR; PG8_MMA(0, 0, At, B0); PG8_MMA(0, 1, At, B1); PG8_BAR; PG8_SCHED;
            PG8_LDA(At, 0, 1); PG8_STAGE(PG8_SB(0, 0), b2, voffB); PG8_STAGE(PG8_SB(0, 1), b2 + hstep, voffB); PG8_STAGE(PG8_SA(0, 0), a2, voffA);
            PG8_WAIT_V(8); PG8_WAIT_L(0); PG8_BAR; PG8_MMA(1, 0, At, B0); PG8_MMA(1, 1, At, B1); PG8_BAR; PG8_SCHED;
            PG8_LDB(B0, 1, 0); PG8_LDB(B1, 1, 1); PG8_SCHED; PG8_LDA(At, 1, 0); PG8_STAGE(PG8_SA(0, 1), a2 + hstep, voffA);
            PG8_WAIT_V(8); PG8_WAIT_L(0); PG8_BAR; PG8_MMA(0, 0, At, B0); PG8_MMA(0, 1, At, B1); PG8_BAR; PG8_SCHED;
            PG8_LDA(At, 1, 1); PG8_STAGE(PG8_SB(1, 0), b3, voffB); PG8_STAGE(PG8_SB(1, 1), b3 + hstep, voffB); PG8_STAGE(PG8_SA(1, 0), a3, voffA);
            PG8_WAIT_V(8); PG8_WAIT_L(0); PG8_BAR; PG8_MMA(1, 0, At, B0); PG8_MMA(1, 1, At, B1); PG8_BAR; PG8_SCHED;
            } else {
            PG8_LDB(B0, 0, 0); PG8_SCHED; PG8_LDA(At, 0, 0); PG8_STAGE(PG8_SA(1, 1), a1 + hstep, voffA);
            PG8_WAIT_L(8); PG8_BAR; PG8_WAIT_L(0); PG8_MMA(0, 0, At, B0); PG8_BAR; PG8_SCHED;
            PG8_LDB(B1, 0, 1); PG8_STAGE(PG8_SB(0, 0), b2, voffB);
            PG8_BAR; PG8_WAIT_L(0); PG8_MMA(0, 1, At, B1); PG8_BAR;
            PG8_LDA(At, 0, 1); PG8_STAGE(PG8_SA(0, 0), a2, voffA);
            PG8_BAR; PG8_WAIT_L(0); PG8_MMA(1, 0, At, B0); PG8_BAR; PG8_SCHED;
            PG8_STAGE(PG8_SB(0, 1), b2 + hstep, voffB);
            PG8_WAIT_V(6); PG8_BAR; PG8_MMA(1, 1, At, B1); PG8_BAR;
            PG8_LDB(B0, 1, 0); PG8_SCHED; PG8_LDA(At, 1, 0); PG8_STAGE(PG8_SA(0, 1), a2 + hstep, voffA);
            PG8_WAIT_L(8); PG8_BAR; PG8_WAIT_L(0); PG8_MMA(0, 0, At, B0); PG8_BAR; PG8_SCHED;
            PG8_LDB(B1, 1, 1); PG8_STAGE(PG8_SB(1, 0), b3, voffB);
            PG8_BAR; PG8_WAIT_L(0); PG8_MMA(0, 1, At, B1); PG8_BAR;
            PG8_LDA(At, 1, 1); PG8_STAGE(PG8_SA(1, 0), a3, voffA);
            PG8_BAR; PG8_WAIT_L(0); PG8_MMA(1, 0, At, B0); PG8_BAR; PG8_SCHED;
            PG8_STAGE(PG8_SB(1, 1), b3 + hstep, voffB);
            PG8_WAIT_V(6); PG8_BAR; PG8_MMA(1, 1, At, B1); PG8_BAR;
            }
        }
        if constexpr (ALIGN_EPI) { if (wr == 0) PG8_BAR; }
        if constexpr (!Epi::AFTER_DRAIN) { E(acc, cur, wr, wc, fr, fq); S.done(cur); }
        if (!has_next) break;
#pragma unroll
        for (int a = 0; a < 2; ++a)
#pragma unroll
            for (int b = 0; b < 2; ++b)
#pragma unroll
                for (int m = 0; m < 4; ++m)
#pragma unroll
                    for (int n = 0; n < 2; ++n) acc[a][b][m][n] = (f32x4){0.f, 0.f, 0.f, 0.f};
        cur = nxt; cA = nA; cB = nB; ++ui;
        if constexpr (ALIGN_EPI) { if (wr == 1) PG8_BAR; }
    }
    PG8_WAIT_V(0);
    if constexpr (!ALIGN_EPI) { if (wr == 0) PG8_BAR; }
    PG8_BAR;
#undef PG8_SA
#undef PG8_SB
#undef PG8_STAGE
#undef PG8_LDA
#undef PG8_LDB
#undef PG8_MMA
#undef PG8_WAIT_V
#undef PG8_WAIT_L
#undef PG8_BAR
#undef PG8_SCHED
}
}

constexpr int NWAVES = 8;
constexpr int BATCH = 32, S = 2048, D = 1024, DEPTH = 4, FF = 4096;
constexpr int M = BATCH * S;
constexpr int NP = 2304;
constexpr int DIN = 2108;
constexpr int C_QA = 0, C_CKV = 256, C_QIDX = 384, C_QB = 512, C_KCMP = 1024, C_VCMP = 1152, C_KSLC = 1280, C_VSLC = 1408, C_KWIN = 1536, C_VWIN = 1664,
              C_UC = 1792, C_KIDX = 2048, C_WIDX = 2080, C_GATE = 2084;
constexpr int NC = 127;
constexpr float EPS = 1e-6f;
constexpr float NEGF = -1e30f;

__host__ __device__ __forceinline__ int win_src(int n) {
    if (n < 512) return n;
    if (n < 1024) return 548 + (n - 512);
    if (n < 1792) return 1060 + (n - 1024);
    if (n < 2048) return 1852 + (n - 1792);
    if (n < 2080) return 512 + (n - 2048);
    if (n < 2084) return 544 + (n - 2080);
    if (n < 2108) return 1828 + (n - 2084);
    return -1;
}

constexpr size_t MiB = 1u << 20;
constexpr size_t WS_CTL = 0, CTL_ZERO_BYTES = 1 * MiB;
constexpr size_t WS_W = 2 * MiB;
constexpr size_t W_IN_B = (size_t)NP * D * 2, W_OUT_B = (size_t)D * D * 2, W_UP_B = (size_t)FF * D * 2, W_DN_B = (size_t)D * FF * 2;
constexpr size_t W_LAYER_B = W_IN_B + W_OUT_B + W_UP_B + W_DN_B;
constexpr size_t WS_ROPE = 96 * MiB;
constexpr size_t WS_KC = 102 * MiB, WS_VC = 105 * MiB;
constexpr size_t WS_KA = 108 * MiB;
constexpr size_t WS_H = 128 * MiB;
constexpr size_t WS_F = 256 * MiB;
constexpr size_t WS_PROJ = 384 * MiB;
constexpr size_t WS_MIX = 672 * MiB;
constexpr size_t WS_HID = 384 * MiB;
constexpr size_t WS_END = 896 * MiB;
static_assert(WS_W + DEPTH * W_LAYER_B <= WS_ROPE, "weights");
static_assert(WS_ROPE + (size_t)M * 24 * 4 <= WS_KC && WS_KC + (size_t)BATCH * NC * 128 * 4 <= WS_VC && WS_VC + (size_t)BATCH * NC * 128 * 4 <= WS_KA && WS_KA + (size_t)M * 128 * 2 <= WS_H, "map");
static_assert(WS_PROJ + (size_t)M * NP * 2 <= WS_MIX && WS_MIX + (size_t)M * D * 2 <= WS_END && WS_HID + (size_t)M * FF * 2 <= WS_END, "map2");

constexpr int CW_BAR = 4096;
constexpr int RING_BYTES = 131072;
constexpr int LDSCTL_OFF = RING_BYTES, MISC_OFF = LDSCTL_OFF + 320;
constexpr int LDS_BYTES = 147456;
constexpr int WSCR = 16384;

#define GAS __attribute__((address_space(1)))
#define LAS __attribute__((address_space(3)))
typedef unsigned short bf16;
typedef unsigned v4u __attribute__((ext_vector_type(4)));
typedef float f32x4 __attribute__((ext_vector_type(4)));
typedef GAS unsigned gu32;
#define LDS_FENCE() asm volatile("s_waitcnt lgkmcnt(0)" ::: "memory")
__device__ __forceinline__ unsigned f2bf(float f) { unsigned u = __builtin_bit_cast(unsigned, f); return (u + 0x7fffu + ((u >> 16) & 1u)) >> 16; }
__device__ __forceinline__ unsigned pk2(float lo, float hi) { return f2bf(lo) | (f2bf(hi) << 16); }
__device__ __forceinline__ float bf2f(bf16 u) { return __builtin_bit_cast(float, (unsigned)u << 16); }
__device__ __forceinline__ float bflo(unsigned u) { return __builtin_bit_cast(float, u << 16); }
__device__ __forceinline__ float bfhi(unsigned u) { return __builtin_bit_cast(float, u & 0xffff0000u); }

#define XB_TMO      128
#define XB_XCNT(j)  (256  + 64 * (j))
#define XB_XSUB(j)  (1280 + 64 * (j))
#define XB_XGEN(j)  (2304 + 64 * (j))
#define XB_TOP      3328
#define XB_TOPGEN   3392
#define XCD_BAR_WORDS 3456
#define XB_SPIN_CAP (1u << 22)

__device__ __forceinline__ unsigned xb_ld(unsigned* p)              { return __hip_atomic_load(p, __ATOMIC_RELAXED, __HIP_MEMORY_SCOPE_AGENT); }
__device__ __forceinline__ unsigned xb_add(unsigned* p, unsigned v) { return __hip_atomic_fetch_add(p, v, __ATOMIC_RELAXED, __HIP_MEMORY_SCOPE_AGENT); }
__device__ __forceinline__ unsigned xb_xcc_id() { return (unsigned)__builtin_amdgcn_s_getreg((3 << 11) | 20) & 0xFu; }
#define XB_SPIN(cond, bar) do { unsigned _sp = 0; while (cond) { __builtin_amdgcn_s_sleep(1); \
    if ((++_sp & 255u) == 0u) { if (xb_ld(&(bar)[XB_TMO])) break; if (_sp > XB_SPIN_CAP) { atomicAdd(&(bar)[XB_TMO], 1u); break; } } } } while (0)

struct XcdBarrier { unsigned* bar; unsigned x; volatile LAS unsigned* st; };

__device__ __forceinline__ XcdBarrier xcd_barrier_post(unsigned* bar, volatile LAS unsigned* st) {
    XcdBarrier b; b.bar = bar; b.x = xb_xcc_id(); b.st = st;
    if (threadIdx.x == 0) (void)xb_add(&bar[XB_XCNT(b.x)], 1u);
    return b;
}
__device__ __forceinline__ void xcd_barrier_complete(unsigned* bar, unsigned x, unsigned& nloc, unsigned& nx) {
    const unsigned G = gridDim.x * gridDim.y * gridDim.z;
    unsigned sum, cnt, mine, sp = 0u;
    for (;;) {
        sum = 0u; cnt = 0u; mine = 0u;
#pragma unroll
        for (unsigned j = 0; j < 16; ++j) { const unsigned c = xb_ld(&bar[XB_XCNT(j)]); sum += c; cnt += (c > 0u) ? 1u : 0u; mine = (j == x) ? c : mine; }
        if (sum == G) break;
        __builtin_amdgcn_s_sleep(1);
        if ((++sp & 255u) == 0u) { if (xb_ld(&bar[XB_TMO])) break; if (sp > XB_SPIN_CAP) { atomicAdd(&bar[XB_TMO], 1u); break; } }
    }
    nloc = mine > 0u ? mine : 1u; nx = cnt > 0u ? cnt : 1u;
}
__device__ __forceinline__ void xcd_barrier(const XcdBarrier& b) {
    asm volatile("s_waitcnt vmcnt(0)" ::: "memory");
    __syncthreads();
    if (threadIdx.x == 0) {
        unsigned* bar = b.bar; asm volatile("" : "+s"(bar));
        __builtin_amdgcn_s_waitcnt(0);
        unsigned nloc = b.st[0], nx = b.st[1];
        if (nloc == 0u) { xcd_barrier_complete(bar, b.x, nloc, nx); b.st[0] = nloc; b.st[1] = nx; }
        const unsigned old = xb_add(&bar[XB_XSUB(b.x)], 1u);
        const unsigned gen = old / nloc;
        if (old + 1u == (gen + 1u) * nloc) {
            __builtin_amdgcn_fence(__ATOMIC_RELEASE, "agent");
            asm volatile("s_waitcnt vmcnt(0)" ::: "memory");
            const unsigned og = xb_add(&bar[XB_TOP], 1u);
            const unsigned tg = og / nx;
            if (og + 1u == (tg + 1u) * nx) xb_add(&bar[XB_TOPGEN], 1u);
            else XB_SPIN(xb_ld(&bar[XB_TOPGEN]) == tg, bar);
            __builtin_amdgcn_fence(__ATOMIC_ACQUIRE, "agent");
            xb_add(&bar[XB_XGEN(b.x)], 1u);
            asm volatile("s_waitcnt vmcnt(0)" ::: "memory");
        } else {
            XB_SPIN(xb_ld(&bar[XB_XGEN(b.x)]) == gen, bar);
            __builtin_amdgcn_fence(__ATOMIC_ACQUIRE, "agent");
            asm volatile("s_waitcnt vmcnt(0)" ::: "memory");
        }
    }
    __syncthreads();
}

struct Frame {
    LAS unsigned char* lds;
    volatile LAS unsigned* MISC;
    gu32* ctl;
    int tid, lane, wave, vcu, G;
    float* out; unsigned char* ws;
};
struct Args { const void* in[20]; float* out; unsigned char* ws; int ph_lo, ph_hi, use_bar, pad; };
#define IN_F(k) ((const float*)args.in[k])
#define P_X_IN IN_F(0)
#define P_POS ((const int*)args.in[1])
#define P_W_IN IN_F(2)
#define P_G_KV_A IN_F(3)
#define P_W_KV_UP IN_F(4)
#define P_W_CMP_K IN_F(5)
#define P_W_CMP_V IN_F(6)
#define P_PE_K IN_F(7)
#define P_PE_V IN_F(8)
#define P_W_POOL IN_F(9)
#define P_POOL_SCALE IN_F(10)
#define P_G_OUT_A IN_F(11)
#define P_G_OUT_B IN_F(12)
#define P_W_OUT IN_F(13)
#define P_G_PRE_MIX IN_F(14)
#define P_G_POST_MIX IN_F(15)
#define P_G_PRE_MLP IN_F(16)
#define P_G_POST_MLP IN_F(17)
#define P_W_UP IN_F(18)
#define P_W_DOWN IN_F(19)
#define B_ROPE ((float*)(ws_ + WS_ROPE))
#define B_KC ((float*)(ws_ + WS_KC))
#define B_VC ((float*)(ws_ + WS_VC))
#define B_KA ((bf16*)(ws_ + WS_KA))
#define B_H ((bf16*)(ws_ + WS_H))
#define B_F ((bf16*)(ws_ + WS_F))
#define B_PROJ ((bf16*)(ws_ + WS_PROJ))
#define B_MIX ((bf16*)(ws_ + WS_MIX))
#define B_HID ((bf16*)(ws_ + WS_HID))

__device__ __forceinline__ float wave_sum(float v) {
#pragma unroll
    for (int o = 1; o < 64; o <<= 1) v += __shfl_xor(v, o);
    return v;
}
__device__ __forceinline__ float wave_max(float v) {
#pragma unroll
    for (int o = 1; o < 64; o <<= 1) v = fmaxf(v, __shfl_xor(v, o));
    return v;
}
__device__ __forceinline__ int wave_sum_i(int v) {
#pragma unroll
    for (int o = 1; o < 64; o <<= 1) v += __shfl_xor(v, o);
    return v;
}

__constant__ double c_rope_inv[12] = {1.0, 0.19392274474868576, 0.03760603093086393, 0.007292664737217109, 0.001414213562373095, 0.0002742481756762073, 5.318295896944988e-05, 1.031338537721246e-05,
                                       1.0, 0.03760603093086393, 0.001414213562373095, 5.318295896944988e-05};
template <int MODE>
__device__ __forceinline__ void transpose_item(const float* W, int K, int Nsrc, int nblk, bf16* WT, LAS float* scr, int item, int lane) {
    const int kb = item / nblk, nb = item % nblk, k0 = 64 * kb, n0 = 32 * nb;
    const int np = n0 + (lane & 31);
    const int src = MODE ? win_src(np) : np;
#pragma unroll 8
    for (int i = 0; i < 32; ++i) { const int kk = 2 * i + (lane >> 5); scr[kk * 33 + (lane & 31)] = (src >= 0) ? W[(size_t)(k0 + kk) * Nsrc + src] : 0.f; }
    LDS_FENCE();
    const int c = lane & 7;
#pragma unroll
    for (int j = 0; j < 4; ++j) { const int n = (lane >> 3) + 8 * j; const LAS float* s = scr + (8 * c) * 33 + n;
        v4u o; o.x = pk2(s[0 * 33], s[1 * 33]); o.y = pk2(s[2 * 33], s[3 * 33]); o.z = pk2(s[4 * 33], s[5 * 33]); o.w = pk2(s[6 * 33], s[7 * 33]);
        *(v4u*)(WT + (size_t)(n0 + n) * K + k0 + 8 * c) = o; }
    LDS_FENCE();
}

__device__ __forceinline__ bf16* w_in_t(unsigned char* ws_, int l)  { return (bf16*)(ws_ + WS_W + (size_t)l * W_LAYER_B); }
__device__ __forceinline__ bf16* w_out_t(unsigned char* ws_, int l) { return (bf16*)(ws_ + WS_W + (size_t)l * W_LAYER_B + W_IN_B); }
__device__ __forceinline__ bf16* w_up_t(unsigned char* ws_, int l)  { return (bf16*)(ws_ + WS_W + (size_t)l * W_LAYER_B + W_IN_B + W_OUT_B); }
__device__ __forceinline__ bf16* w_dn_t(unsigned char* ws_, int l)  { return (bf16*)(ws_ + WS_W + (size_t)l * W_LAYER_B + W_IN_B + W_OUT_B + W_UP_B); }

__device__ __forceinline__ void norm_row_to_bf16(const float* xrow, const float* gain, bf16* orow, int lane) {
    const f32x4* xr = (const f32x4*)xrow + lane;
    f32x4 v[4]; float s = 0.f;
#pragma unroll
    for (int j = 0; j < 4; ++j) { v[j] = xr[64 * j]; s += (v[j].x * v[j].x + v[j].y * v[j].y) + (v[j].z * v[j].z + v[j].w * v[j].w); }
    const float rs = rsqrtf(wave_sum(s) * (1.f / D) + EPS);
    unsigned long long* o8 = (unsigned long long*)orow + lane;
#pragma unroll
    for (int j = 0; j < 4; ++j) { const f32x4 g = ((const f32x4*)gain)[lane + 64 * j];
        o8[64 * j] = (unsigned long long)pk2(v[j].x * rs * g.x, v[j].y * rs * g.y) | ((unsigned long long)pk2(v[j].z * rs * g.z, v[j].w * rs * g.w) << 32); }
}

__device__ __forceinline__ void phase_prologue(Frame& F, const Args& args) {
    unsigned char* ws_ = F.ws; asm volatile("" : "+s"(ws_)); int lane_ = F.lane; asm volatile("" : "+v"(lane_)); (void)ws_;
    LAS float* scr = (LAS float*)(F.lds + F.wave * WSCR);
    const int gw = F.vcu * NWAVES + F.wave, NGW = F.G * NWAVES;
    constexpr int I_IN = (D / 64) * (NP / 32), I_OUT = (D / 64) * (D / 32), I_UP = (D / 64) * (FF / 32), I_DN = (FF / 64) * (D / 32);
    for (int it = gw; it < DEPTH * I_IN; it += NGW) { const int l = it / I_IN, r = it % I_IN; transpose_item<1>(P_W_IN + (size_t)l * D * DIN, D, DIN, NP / 32, w_in_t(ws_, l), scr, r, lane_); }
    for (int it = gw; it < DEPTH * I_OUT; it += NGW) { const int l = it / I_OUT, r = it % I_OUT; transpose_item<0>(P_W_OUT + (size_t)l * D * D, D, D, D / 32, w_out_t(ws_, l), scr, r, lane_); }
    for (int it = gw; it < DEPTH * I_UP; it += NGW) { const int l = it / I_UP, r = it % I_UP; transpose_item<0>(P_W_UP + (size_t)l * D * FF, D, FF, FF / 32, w_up_t(ws_, l), scr, r, lane_); }
    for (int it = gw; it < DEPTH * I_DN; it += NGW) { const int l = it / I_DN, r = it % I_DN; transpose_item<0>(P_W_DOWN + (size_t)l * FF * D, FF, D, D / 32, w_dn_t(ws_, l), scr, r, lane_); }
    for (int e = gw * 64 + lane_; e < M * 12; e += NGW * 64) {
        const int row = e / 12, i = e % 12;
        const double inv = c_rope_inv[i];
        const double a = (double)P_POS[row] * inv;
        const double k = __builtin_rint(a * 0.15915494309189535);
        const float r = (float)(a - k * 6.283185307179586);
        const float c = __builtin_cosf(r), s = __builtin_sinf(r);
        float* t = B_ROPE + (size_t)row * 24;
        if (i < 8) { t[i] = c; t[8 + i] = s; } else { t[16 + (i - 8)] = c; t[20 + (i - 8)] = s; }
    }
    for (int m = gw; m < M; m += NGW) norm_row_to_bf16(P_X_IN + (size_t)m * D, P_G_PRE_MIX, B_H + (size_t)m * D, lane_);
}

__device__ __forceinline__ void phase_prep(Frame& F, const Args& args, int l) {
    unsigned char* ws_ = F.ws; asm volatile("" : "+s"(ws_)); int lane_ = F.lane; asm volatile("" : "+v"(lane_)); (void)ws_;
    LAS float* xs = (LAS float*)(F.lds + F.wave * WSCR);
    const int gw = F.vcu * NWAVES + F.wave, NGW = F.G * NWAVES, lane = lane_;
    const float* gkv = P_G_KV_A + l * 128; const float* Wkv = P_W_KV_UP + (size_t)l * 128 * 128;
    for (int row = gw; row < M; row += NGW) {
        bf16* prow = B_PROJ + (size_t)row * NP;
        const float* tab = B_ROPE + (size_t)row * 24;
        const unsigned u = *(const unsigned*)(prow + C_CKV + 2 * lane);
        const float x0 = bflo(u), x1 = bfhi(u);
        const float rs = rsqrtf(wave_sum(x0 * x0 + x1 * x1) * (1.f / 128.f) + EPS);
        xs[2 * lane] = x0 * rs * gkv[2 * lane]; xs[2 * lane + 1] = x1 * rs * gkv[2 * lane + 1];
        LDS_FENCE();
        float a0 = 0.f, a1 = 0.f;
#pragma unroll 8
        for (int k = 0; k < 128; ++k) { const float xv = xs[k]; a0 += xv * Wkv[k * 128 + lane]; a1 += xv * Wkv[k * 128 + 64 + lane]; }
        LDS_FENCE();
        {
            const float partner = __shfl_xor(a0, 8);
            const int i = lane & 7; const float c = tab[i], s = tab[8 + i];
            float kr = a0;
            if (lane < 8) kr = a0 * c - partner * s; else if (lane < 16) kr = partner * s + a0 * c;
            B_KA[(size_t)row * 128 + lane] = (bf16)f2bf(kr); B_KA[(size_t)row * 128 + 64 + lane] = (bf16)f2bf(a1);
        }
        if (lane < 4) { const int i = lane; const float c = tab[16 + i], s = tab[20 + i];
            const float x1v = bf2f(prow[C_KIDX + i]), x2v = bf2f(prow[C_KIDX + 4 + i]);
            prow[C_KIDX + i] = (bf16)f2bf(x1v * c - x2v * s); prow[C_KIDX + 4 + i] = (bf16)f2bf(x1v * s + x2v * c);
        } else if (lane < 36) { const int idx = lane - 4, which = idx >> 3, i = idx & 7; const int base = ((which < 2) ? C_KSLC : C_KWIN) + (which & 1) * 64;
            const float c = tab[i], s = tab[8 + i];
            const float x1v = bf2f(prow[base + i]), x2v = bf2f(prow[base + 8 + i]);
            prow[base + i] = (bf16)f2bf(x1v * c - x2v * s); prow[base + 8 + i] = (bf16)f2bf(x1v * s + x2v * c);
        }
    }
    for (int it = gw; it < BATCH * NC * 2; it += NGW) {
        const int kv = it & 1, bc = it >> 1, b = bc / NC, c = bc % NC;
        const float* W = (kv ? P_W_CMP_V : P_W_CMP_K) + (size_t)l * 32 * 64 * 64;
        const float* pe = (kv ? P_PE_V : P_PE_K) + l * 32 * 64;
        float acc0 = 0.f, acc1 = 0.f;
        for (int li = 0; li < 32; ++li) {
            const bf16* prow = B_PROJ + (size_t)(b * S + 16 * c + li) * NP + (kv ? C_VCMP : C_KCMP);
            const float pev = pe[li * 64 + lane];
            const float xv0 = bf2f(prow[lane]) + pev, xv1 = bf2f(prow[64 + lane]) + pev;
            const float* Wl = W + (size_t)li * 64 * 64 + lane;
#pragma unroll 16
            for (int d = 0; d < 64; ++d) { const float w = Wl[d * 64]; acc0 += __shfl(xv0, d) * w; acc1 += __shfl(xv1, d) * w; }
        }
        float* o = (kv ? B_VC : B_KC) + ((size_t)(b * NC + c) * 2) * 64;
        o[lane] = acc0; o[64 + lane] = acc1;
    }
}

__device__ __forceinline__ void dsa_token(unsigned char* ws_, int lane_, int b, int t, LAS unsigned char* scr) {
    const int lane = lane_;
    const size_t row = (size_t)b * S + t;
    const bf16* prow = B_PROJ + row * NP;
    LAS float* sc = (LAS float*)scr;
    LAS unsigned* ku = (LAS unsigned*)scr;
    LAS float* qi = (LAS float*)(scr + 8192);
    LAS float* qa = (LAS float*)(scr + 8192 + 512);
    LAS int* list = (LAS int*)(scr + 8192 + 512 + 1024);
    LAS float* pp = (LAS float*)(scr + 8192 + 512 + 1024 + 1024);
    const float* tab = B_ROPE + row * 24;
    { const unsigned u = *(const unsigned*)(prow + C_QIDX + 2 * lane); qi[2 * lane] = bflo(u); qi[2 * lane + 1] = bfhi(u); }
#pragma unroll
    for (int j = 0; j < 2; ++j) { const unsigned u = *(const unsigned*)(prow + C_QA + 2 * lane + 128 * j); qa[2 * lane + 128 * j] = bflo(u); qa[2 * lane + 128 * j + 1] = bfhi(u); }
    LDS_FENCE();
    if (lane < 16) { const int h = lane >> 2, i = lane & 3; const float c = tab[16 + i], s = tab[20 + i]; const float x1 = qi[h * 32 + i], x2 = qi[h * 32 + 4 + i];
        qi[h * 32 + i] = x1 * c - x2 * s; qi[h * 32 + 4 + i] = x1 * s + x2 * c; }
    if (lane >= 32) { const int h = (lane - 32) >> 3, i = lane & 7; const float c = tab[i], s = tab[8 + i]; const float x1 = qa[h * 64 + i], x2 = qa[h * 64 + 8 + i];
        qa[h * 64 + i] = x1 * c - x2 * s; qa[h * 64 + 8 + i] = x1 * s + x2 * c; }
    LDS_FENCE();
    float w[4];
#pragma unroll
    for (int h = 0; h < 4; ++h) w[h] = bf2f(prow[C_WIDX + h]);
    const int nk = t + 1;
    const bf16* kbase = B_PROJ + (size_t)b * S * NP + C_KIDX;
    for (int s0 = 0; s0 < nk; s0 += 64) {
        const int s = s0 + lane;
        if (s < nk) {
            const v4u* kp = (const v4u*)(kbase + (size_t)s * NP);
            float kf[32];
#pragma unroll
            for (int q = 0; q < 4; ++q) { const v4u kk = kp[q];
                kf[8 * q + 0] = bflo(kk.x); kf[8 * q + 1] = bfhi(kk.x); kf[8 * q + 2] = bflo(kk.y); kf[8 * q + 3] = bfhi(kk.y);
                kf[8 * q + 4] = bflo(kk.z); kf[8 * q + 5] = bfhi(kk.z); kf[8 * q + 6] = bflo(kk.w); kf[8 * q + 7] = bfhi(kk.w); }
            float score = 0.f;
#pragma unroll
            for (int h = 0; h < 4; ++h) { float d = 0.f;
#pragma unroll
                for (int dd = 0; dd < 32; ++dd) d += qi[h * 32 + dd] * kf[dd];
                score += w[h] * fmaxf(d, 0.f); }
            unsigned bits = __builtin_bit_cast(unsigned, score);
            if (bits == 0x80000000u) bits = 0u;
            ku[s] = (bits & 0x80000000u) ? ~bits : (bits | 0x80000000u);
        }
    }
    LDS_FENCE();
    int nsel;
    if (nk <= 256) { nsel = nk; for (int e = lane; e < nk; e += 64) list[e] = e; }
    else {
        unsigned prefix = 0u;
        for (int bit = 31; bit >= 0; --bit) {
            const unsigned cand = prefix | (1u << bit);
            int cnt = 0;
            for (int s = lane; s < nk; s += 64) cnt += (ku[s] >= cand) ? 1 : 0;
            cnt = wave_sum_i(cnt);
            if (cnt >= 256) prefix = cand;
        }
        const unsigned thr = prefix;
        int cgt = 0;
        for (int s = lane; s < nk; s += 64) cgt += (ku[s] > thr) ? 1 : 0;
        cgt = wave_sum_i(cgt);
        const int r = 256 - cgt;
        int pos = 0, eqseen = 0;
        const unsigned long long lt = (1ull << lane) - 1ull;
        for (int s0 = 0; s0 < nk; s0 += 64) {
            const int s = s0 + lane; const bool in = s < nk; const unsigned k = in ? ku[s] : 0u;
            const bool gt = in && (k > thr), eq = in && (k == thr);
            const unsigned long long beq = __ballot(eq);
            const int eqrank = eqseen + __popcll(beq & lt);
            const bool sel = gt || (eq && eqrank < r);
            const unsigned long long bsel = __ballot(sel);
            if (sel) list[pos + __popcll(bsel & lt)] = s;
            pos += __popcll(bsel); eqseen += __popcll(beq);
        }
        nsel = 256;
    }
    LDS_FENCE();
    const bf16* kab = B_KA + (size_t)b * S * 128;
    float lg[4][4];
#pragma unroll
    for (int i = 0; i < 4; ++i) {
        const int e = lane + 64 * i;
#pragma unroll
        for (int h = 0; h < 4; ++h) lg[i][h] = NEGF;
        if (e < nsel) {
            const int s = list[e];
            const v4u* kp = (const v4u*)(kab + (size_t)s * 128);
            float acc[4] = {0.f, 0.f, 0.f, 0.f};
#pragma unroll
            for (int q = 0; q < 8; ++q) { const v4u kk = kp[q]; float kf[8];
                kf[0] = bflo(kk.x); kf[1] = bfhi(kk.x); kf[2] = bflo(kk.y); kf[3] = bfhi(kk.y); kf[4] = bflo(kk.z); kf[5] = bfhi(kk.z); kf[6] = bflo(kk.w); kf[7] = bfhi(kk.w);
#pragma unroll
                for (int h = 0; h < 4; ++h)
#pragma unroll
                    for (int dd = 0; dd < 8; ++dd) acc[h] += qa[h * 64 + 8 * q + dd] * kf[dd]; }
#pragma unroll
            for (int h = 0; h < 4; ++h) lg[i][h] = acc[h] * 0.125f;
        }
    }
#pragma unroll
    for (int h = 0; h < 4; ++h) {
        float m = fmaxf(fmaxf(lg[0][h], lg[1][h]), fmaxf(lg[2][h], lg[3][h])); m = wave_max(m);
        float p[4], sum = 0.f;
#pragma unroll
        for (int i = 0; i < 4; ++i) { p[i] = (lane + 64 * i < nsel) ? __expf(lg[i][h] - m) : 0.f; sum += p[i]; }
        sum = wave_sum(sum); const float inv = 1.f / sum;
#pragma unroll
        for (int i = 0; i < 4; ++i) pp[(lane + 64 * i) * 4 + h] = p[i] * inv;
    }
    LDS_FENCE();
    float o[4] = {0.f, 0.f, 0.f, 0.f};
    for (int e = 0; e < nsel; ++e) {
        const int s = list[e];
        const float v = bf2f(kab[(size_t)s * 128 + 64 + lane]);
        const f32x4 p4 = *(const LAS f32x4*)(pp + e * 4);
        o[0] += p4.x * v; o[1] += p4.y * v; o[2] += p4.z * v; o[3] += p4.w * v;
    }
    bf16* orow = B_MIX + row * D;
#pragma unroll
    for (int h = 0; h < 4; ++h) orow[h * 64 + lane] = (bf16)f2bf(o[h]);
    LDS_FENCE();
}

__device__ __forceinline__ void nsa_tile(const bf16* kbase, const bf16* vbase, int s0, bool valid, const LAS float* q, LAS float* pt, float (&m)[4], float (&l)[4], float (&o)[4], int lane) {
    float lg[4] = {NEGF, NEGF, NEGF, NEGF};
    if (valid) {
        const v4u* kp = (const v4u*)(kbase + (size_t)(s0 + lane) * NP);
        float acc[4] = {0.f, 0.f, 0.f, 0.f};
#pragma unroll
        for (int qq = 0; qq < 8; ++qq) { const v4u kk = kp[qq]; float kf[8];
            kf[0] = bflo(kk.x); kf[1] = bfhi(kk.x); kf[2] = bflo(kk.y); kf[3] = bfhi(kk.y); kf[4] = bflo(kk.z); kf[5] = bfhi(kk.z); kf[6] = bflo(kk.w); kf[7] = bfhi(kk.w);
#pragma unroll
            for (int h = 0; h < 4; ++h)
#pragma unroll
                for (int dd = 0; dd < 8; ++dd) acc[h] += q[h * 64 + 8 * qq + dd] * kf[dd]; }
#pragma unroll
        for (int h = 0; h < 4; ++h) lg[h] = acc[h] * 0.125f;
    }
    float p[4];
#pragma unroll
    for (int h = 0; h < 4; ++h) {
        const float tm = wave_max(lg[h]); const float mn = fmaxf(m[h], tm);
        const float alpha = __expf(m[h] - mn);
        p[h] = valid ? __expf(lg[h] - mn) : 0.f;
        l[h] = l[h] * alpha + wave_sum(p[h]); o[h] *= alpha; m[h] = mn;
    }
    *(LAS f32x4*)(pt + lane * 4) = (f32x4){p[0], p[1], p[2], p[3]};
    LDS_FENCE();
#pragma unroll 8
    for (int k = 0; k < 64; ++k) {
        const float v = bf2f(vbase[(size_t)(s0 + k) * NP + lane]);
        const f32x4 p4 = *(const LAS f32x4*)(pt + k * 4);
        o[0] += p4.x * v; o[1] += p4.y * v; o[2] += p4.z * v; o[3] += p4.w * v;
    }
    LDS_FENCE();
}

__device__ __forceinline__ void nsa_token(unsigned char* ws_, int lane_, int b, int t, int g, LAS unsigned char* scr) {
    const int lane = lane_;
    const size_t row = (size_t)b * S + t;
    const bf16* prow = B_PROJ + row * NP;
    LAS float* qn = (LAS float*)scr;
    LAS float* qr = (LAS float*)(scr + 1024);
    LAS float* pc = (LAS float*)(scr + 2048);
    LAS float* ps = (LAS float*)(scr + 4096);
    LAS float* pt = (LAS float*)(scr + 4608);
    const float* tab = B_ROPE + row * 24;
#pragma unroll
    for (int j = 0; j < 2; ++j) { const unsigned u = *(const unsigned*)(prow + C_QB + g * 256 + 2 * lane + 128 * j);
        const float a = bflo(u), c = bfhi(u); qn[2 * lane + 128 * j] = a; qn[2 * lane + 128 * j + 1] = c; qr[2 * lane + 128 * j] = a; qr[2 * lane + 128 * j + 1] = c; }
    LDS_FENCE();
    if (lane < 32) { const int h = lane >> 3, i = lane & 7; const float c = tab[i], s = tab[8 + i]; const float x1 = qn[h * 64 + i], x2 = qn[h * 64 + 8 + i];
        qr[h * 64 + i] = x1 * c - x2 * s; qr[h * 64 + 8 + i] = x1 * s + x2 * c; }
    LDS_FENCE();
    const int ncv = (t >= 31) ? (((t - 31) >> 4) + 1) : 0;
    float ocmp[4] = {0.f, 0.f, 0.f, 0.f};
    {
        float lg[2][4];
#pragma unroll
        for (int ci = 0; ci < 2; ++ci) {
            const int c = lane + 64 * ci;
#pragma unroll
            for (int h = 0; h < 4; ++h) lg[ci][h] = NEGF;
            if (c < ncv) {
                const f32x4* kp = (const f32x4*)(B_KC + ((size_t)(b * NC + c) * 2 + g) * 64);
                float acc[4] = {0.f, 0.f, 0.f, 0.f};
#pragma unroll
                for (int qq = 0; qq < 16; ++qq) { const f32x4 kk = kp[qq];
#pragma unroll
                    for (int h = 0; h < 4; ++h) acc[h] += qn[h * 64 + 4 * qq] * kk.x + qn[h * 64 + 4 * qq + 1] * kk.y + qn[h * 64 + 4 * qq + 2] * kk.z + qn[h * 64 + 4 * qq + 3] * kk.w; }
#pragma unroll
                for (int h = 0; h < 4; ++h) lg[ci][h] = acc[h] * 0.125f;
            }
        }
        float p[2][4];
#pragma unroll
        for (int h = 0; h < 4; ++h) {
            const float mm = wave_max(fmaxf(lg[0][h], lg[1][h]));
            p[0][h] = (lane < ncv) ? __expf(lg[0][h] - mm) : 0.f; p[1][h] = (lane + 64 < ncv) ? __expf(lg[1][h] - mm) : 0.f;
            const float sum = wave_sum(p[0][h] + p[1][h]);
            const float inv = (ncv > 0) ? 1.f / sum : 0.f;
            p[0][h] *= inv; p[1][h] *= inv;
        }
#pragma unroll
        for (int ci = 0; ci < 2; ++ci) { const int c = lane + 64 * ci;
            *(LAS f32x4*)(pc + c * 4) = (f32x4){p[ci][0], p[ci][1], p[ci][2], p[ci][3]};
            ps[c] = (p[ci][0] + p[ci][1]) + (p[ci][2] + p[ci][3]); }
        LDS_FENCE();
        for (int c = 0; c < ncv; ++c) {
            const float v = B_VC[((size_t)(b * NC + c) * 2 + g) * 64 + lane];
            const f32x4 p4 = *(const LAS f32x4*)(pc + c * 4);
            ocmp[0] += p4.x * v; ocmp[1] += p4.y * v; ocmp[2] += p4.z * v; ocmp[3] += p4.w * v;
        }
    }
    const int cur = t >> 6;
    unsigned selmask;
    if (cur < 16) selmask = (2u << cur) - 1u;
    else {
        float sj = -__builtin_inff();
        if (lane < 32 && lane <= cur) {
            const int j = lane;
            if (j == 0 || j == cur || j == cur - 1) sj = __builtin_inff();
            else { const int c0 = 4 * j - 1, c1 = (4 * j + 3 < NC - 1) ? 4 * j + 3 : NC - 1; float a = 0.f; for (int c = c0; c <= c1; ++c) a += ps[c]; sj = a; }
        }
        int rank = 0;
#pragma unroll
        for (int i = 0; i < 32; ++i) { const float si = __shfl(sj, i); rank += ((si > sj) || (si == sj && i < lane)) ? 1 : 0; }
        const bool sel = (lane < 32) && (rank < 16);
        selmask = (unsigned)(__ballot(sel) & 0xffffffffull);
    }
    float ms[4] = {NEGF, NEGF, NEGF, NEGF}, ls[4] = {0.f, 0.f, 0.f, 0.f}, os[4] = {0.f, 0.f, 0.f, 0.f};
    {
        const bf16* kb = B_PROJ + (size_t)b * S * NP + C_KSLC + g * 64;
        const bf16* vb = B_PROJ + (size_t)b * S * NP + C_VSLC + g * 64;
        for (int j = 0; j <= cur; ++j) {
            if (!((selmask >> j) & 1u)) continue;
            nsa_tile(kb, vb, 64 * j, (64 * j + lane) <= t, qr, pt, ms, ls, os, lane);
        }
    }
    float mw[4] = {NEGF, NEGF, NEGF, NEGF}, lw[4] = {0.f, 0.f, 0.f, 0.f}, ow[4] = {0.f, 0.f, 0.f, 0.f};
    {
        const bf16* kb = B_PROJ + (size_t)b * S * NP + C_KWIN + g * 64;
        const bf16* vb = B_PROJ + (size_t)b * S * NP + C_VWIN + g * 64;
        const int lo = (t - 511 > 0) ? t - 511 : 0;
        for (int j = lo >> 6; j <= cur; ++j) {
            const int s = 64 * j + lane;
            nsa_tile(kb, vb, 64 * j, (s >= lo) && (s <= t), qr, pt, mw, lw, ow, lane);
        }
    }
    bf16* orow = B_MIX + row * D + 256 + g * 256;
#pragma unroll
    for (int h = 0; h < 4; ++h) {
        const bf16* gp = prow + C_GATE + (g * 4 + h) * 3;
        const float g0 = 1.f / (1.f + __expf(-bf2f(gp[0]))), g1 = 1.f / (1.f + __expf(-bf2f(gp[1]))), g2 = 1.f / (1.f + __expf(-bf2f(gp[2])));
        const float o = g0 * ocmp[h] + g1 * (os[h] / ls[h]) + g2 * (ow[h] / lw[h]);
        orow[h * 64 + lane] = (bf16)f2bf(o);
    }
    LDS_FENCE();
}

__device__ __forceinline__ void phase_attn(Frame& F, int l) {
    (void)l;
    unsigned char* ws_ = F.ws; asm volatile("" : "+s"(ws_)); int lane_ = F.lane; asm volatile("" : "+v"(lane_)); (void)ws_;
    LAS unsigned char* scr = F.lds + F.wave * WSCR;
    const int gw = F.vcu * NWAVES + F.wave, NGW = F.G * NWAVES;
    for (int it = gw; it < M; it += NGW) {
        const int b = it / S, t = ((it % S) + 64 * b) % S;
        dsa_token(ws_, lane_, b, t, scr);
    }
    for (int it = gw; it < 2 * M; it += NGW) {
        const int g = it & 1, tk = it >> 1; const int b = tk / S, t = ((tk % S) + 64 * b) % S;
        nsa_token(ws_, lane_, b, t, g, scr);
    }
}

__device__ __forceinline__ void phase_merge(Frame& F, const Args& args, int l) {
    unsigned char* ws_ = F.ws; asm volatile("" : "+s"(ws_)); int lane_ = F.lane; asm volatile("" : "+v"(lane_)); (void)ws_;
    LAS float* pl = (LAS float*)(F.lds + F.wave * WSCR);
    const int gw = F.vcu * NWAVES + F.wave, NGW = F.G * NWAVES, lane = lane_;
    const float* wp = P_W_POOL + (size_t)l * 4 * 64 * 64;
    const float* psc = P_POOL_SCALE + l * 256;
    const float* goa = P_G_OUT_A + l * 256; const float* gob = P_G_OUT_B + l * 512;
    for (int row = gw; row < M; row += NGW) {
        const int t = row % S;
        bf16* mrow = B_MIX + (size_t)row * D;
        { const unsigned long long u = *((const unsigned long long*)mrow + lane);
          const float a0 = bflo((unsigned)u), a1 = bfhi((unsigned)u), a2 = bflo((unsigned)(u >> 32)), a3 = bfhi((unsigned)(u >> 32));
          const float rs = rsqrtf(wave_sum((a0 * a0 + a1 * a1) + (a2 * a2 + a3 * a3)) * (1.f / 256.f) + EPS);
          const f32x4 gg = ((const f32x4*)goa)[lane];
          *((unsigned long long*)mrow + lane) = (unsigned long long)pk2(a0 * rs * gg.x, a1 * rs * gg.y) | ((unsigned long long)pk2(a2 * rs * gg.z, a3 * rs * gg.w) << 32); }
        { const v4u u = *((const v4u*)(mrow + 256) + lane);
          float a[8] = {bflo(u.x), bfhi(u.x), bflo(u.y), bfhi(u.y), bflo(u.z), bfhi(u.z), bflo(u.w), bfhi(u.w)};
          float ss = 0.f;
#pragma unroll
          for (int i = 0; i < 8; ++i) ss += a[i] * a[i];
          const float rs = rsqrtf(wave_sum(ss) * (1.f / 512.f) + EPS);
          const f32x4 g0 = ((const f32x4*)gob)[2 * lane], g1 = ((const f32x4*)gob)[2 * lane + 1];
          v4u o; o.x = pk2(a[0] * rs * g0.x, a[1] * rs * g0.y); o.y = pk2(a[2] * rs * g0.z, a[3] * rs * g0.w); o.z = pk2(a[4] * rs * g1.x, a[5] * rs * g1.y); o.w = pk2(a[6] * rs * g1.z, a[7] * rs * g1.w);
          *((v4u*)(mrow + 256) + lane) = o; }
        const bf16* up = B_PROJ + (size_t)row * NP + C_UC;
#pragma unroll
        for (int gi = 0; gi < 4; ++gi) {
            const int w = 2 << gi;
            const float u0 = bf2f(up[gi * 64 + lane]);
            float sum = u0;
            for (int i = 1; i < w; ++i) if (t - i >= 0) sum += bf2f(up[gi * 64 + lane - (size_t)i * NP]);
            const float cntf = (float)((t + 1 < w) ? t + 1 : w);
            pl[gi * 64 + lane] = sum / cntf - u0;
        }
        LDS_FENCE();
        float oc[4]; float ss = 0.f;
#pragma unroll
        for (int gi = 0; gi < 4; ++gi) {
            float a = 0.f; const float* wg = wp + (size_t)gi * 64 * 64 + lane;
#pragma unroll 16
            for (int c = 0; c < 64; ++c) a += pl[gi * 64 + c] * wg[c * 64];
            oc[gi] = a; ss += a * a;
        }
        const float rs = rsqrtf(wave_sum(ss) * (1.f / 256.f) + EPS);
#pragma unroll
        for (int gi = 0; gi < 4; ++gi) mrow[768 + gi * 64 + lane] = (bf16)f2bf(oc[gi] * rs * psc[gi * 64 + lane]);
        LDS_FENCE();
    }
}

__device__ __forceinline__ void phase_finish(Frame& F, const float* xsrc, const float* gpost, const float* gnext  ) {
    unsigned char* ws_ = F.ws; asm volatile("" : "+s"(ws_)); int lane_ = F.lane; asm volatile("" : "+v"(lane_)); (void)ws_;
    const int gw = F.vcu * NWAVES + F.wave, NGW = F.G * NWAVES, lane = lane_;
    for (int row = gw; row < M; row += NGW) {
        const unsigned long long* fr = (const unsigned long long*)(B_F + (size_t)row * D) + lane;
        const f32x4* xr = (const f32x4*)(xsrc + (size_t)row * D) + lane;
        f32x4 f[4], x[4]; float ss = 0.f;
#pragma unroll
        for (int j = 0; j < 4; ++j) { const unsigned long long u = fr[64 * j]; x[j] = xr[64 * j];
            f[j] = (f32x4){bflo((unsigned)u), bfhi((unsigned)u), bflo((unsigned)(u >> 32)), bfhi((unsigned)(u >> 32))};
            ss += (f[j].x * f[j].x + f[j].y * f[j].y) + (f[j].z * f[j].z + f[j].w * f[j].w); }
        const float rs = rsqrtf(wave_sum(ss) * (1.f / D) + EPS);
        float s2 = 0.f;
        f32x4* orow = (f32x4*)(F.out + (size_t)row * D) + lane;
#pragma unroll
        for (int j = 0; j < 4; ++j) { const f32x4 g = ((const f32x4*)gpost)[lane + 64 * j];
            x[j].x += f[j].x * rs * g.x; x[j].y += f[j].y * rs * g.y; x[j].z += f[j].z * rs * g.z; x[j].w += f[j].w * rs * g.w;
            orow[64 * j] = x[j];
            s2 += (x[j].x * x[j].x + x[j].y * x[j].y) + (x[j].z * x[j].z + x[j].w * x[j].w); }
        if (gnext) {
            const float r2 = rsqrtf(wave_sum(s2) * (1.f / D) + EPS);
            unsigned long long* o8 = (unsigned long long*)(B_H + (size_t)row * D) + lane;
#pragma unroll
            for (int j = 0; j < 4; ++j) { const f32x4 g = ((const f32x4*)gnext)[lane + 64 * j];
                o8[64 * j] = (unsigned long long)pk2(x[j].x * r2 * g.x, x[j].y * r2 * g.y) | ((unsigned long long)pk2(x[j].z * r2 * g.z, x[j].w * r2 * g.w) << 32); }
        }
    }
}

template <int ACT>
__device__ __forceinline__ void phase_gemm(Frame& F, const bf16* A, const bf16* Bt, bf16* O, int N, int K) {
    asm volatile("" : "+s"(A), "+s"(Bt), "+s"(O));
    pg8::Gemm g{A, Bt, M, N, K}; pg8::StaticOrder So; So.init(M, N, F.G, (int)blockIdx.x);
    pg8::EpiStore<ACT> E{O, N};
    pg8::gemm_phase<pg8::EpiStore<ACT>, pg8::StaticOrder, true, true>(F.lds, g, So, E);
}

constexpr int PH_PER_LAYER = 9, NPHASES = 1 + DEPTH * PH_PER_LAYER;
__global__ void __launch_bounds__(NWAVES * 64, 2) mk_fwd(Args args) {
    extern __shared__ __attribute__((aligned(16))) unsigned char lds[];
    Frame F;
    F.lds = (LAS unsigned char*)lds;
    F.MISC = (volatile LAS unsigned*)(F.lds + MISC_OFF);
    F.tid = threadIdx.x; F.lane = F.tid & 63; F.wave = __builtin_amdgcn_readfirstlane(F.tid >> 6);
    F.G = gridDim.x; { const int bx = blockIdx.x; F.vcu = (F.G % 8 == 0) ? (bx % 8) * (F.G / 8) + bx / 8 : bx; }
    unsigned char* ws = args.ws; F.ws = ws;
    F.ctl = (gu32*)(ws + WS_CTL);
    F.out = args.out;
    for (int u = F.tid; u < (LDS_BYTES - LDSCTL_OFF) / 4; u += NWAVES * 64) ((LAS unsigned*)(F.lds + LDSCTL_OFF))[u] = 0u;
    __syncthreads();
    XcdBarrier bar; bar.bar = (unsigned*)(F.ctl + CW_BAR); bar.x = 0; bar.st = F.MISC + 8;
    if (args.use_bar) bar = xcd_barrier_post((unsigned*)(F.ctl + CW_BAR), F.MISC + 8);
    const int lo = args.ph_lo, hi = args.ph_hi;
    int pid = 0;
    unsigned char* ws_ = F.ws;
#define PH_ON (pid >= lo && pid < hi)
#define PH_END do { if (PH_ON && pid + 1 < hi) xcd_barrier(bar); ++pid; } while (0)

    if (PH_ON && !(SKIPM & 1)) phase_prologue(F, args);
    PH_END;
    for (int l = 0; l < DEPTH; ++l) {
        if (PH_ON && !(SKIPM & 2)) phase_gemm<0>(F, B_H, w_in_t(ws_, l), B_PROJ, NP, D);
        PH_END;
        if (PH_ON && !(SKIPM & 4)) phase_prep(F, args, l);
        PH_END;
        if (PH_ON && !(SKIPM & 8)) phase_attn(F, l);
        PH_END;
        if (PH_ON && !(SKIPM & 16)) phase_merge(F, args, l);
        PH_END;
        if (PH_ON && !(SKIPM & 32)) phase_gemm<0>(F, B_MIX, w_out_t(ws_, l), B_F, D, D);
        PH_END;
        if (PH_ON && !(SKIPM & 64)) phase_finish(F, l == 0 ? P_X_IN : F.out, P_G_POST_MIX + l * D, P_G_PRE_MLP + l * D);
        PH_END;
        if (PH_ON && !(SKIPM & 128)) phase_gemm<2>(F, B_H, w_up_t(ws_, l), B_HID, FF, D);
        PH_END;
        if (PH_ON && !(SKIPM & 256)) phase_gemm<0>(F, B_HID, w_dn_t(ws_, l), B_F, D, FF);
        PH_END;
        if (PH_ON && !(SKIPM & 512)) phase_finish(F, F.out, P_G_POST_MLP + l * D, (l + 1 < DEPTH) ? P_G_PRE_MIX + (l + 1) * D : nullptr);
        PH_END;
    }
#undef PH_ON
#undef PH_END
}

extern "C" void kernel_launch(void* const* d_in, const int* in_sizes, int n_in, void* d_out, int out_size, void* d_ws, size_t ws_size, hipStream_t stream) {
    static int grid = 0;
    if (grid == 0) {
        if (n_in != 20 || in_sizes[0] != M * D || out_size != M * D || ws_size < WS_END) {
            fprintf(stderr, "kernel_launch: unexpected shapes / workspace (n_in %d, in0 %d, out %d, ws %zu < %zu); nothing launched\n", n_in, n_in > 0 ? in_sizes[0] : -1, out_size, ws_size, (size_t)WS_END);
            grid = -1; return; }
        int dev = 0, cus = 0, per_cu = 0;
        if (hipGetDevice(&dev) != hipSuccess || hipDeviceGetAttribute(&cus, hipDeviceAttributeMultiprocessorCount, dev) != hipSuccess) { grid = -1; return; }
        if (hipFuncSetAttribute((const void*)mk_fwd, hipFuncAttributeMaxDynamicSharedMemorySize, LDS_BYTES) != hipSuccess) { fprintf(stderr, "kernel_launch: hipFuncSetAttribute failed\n"); grid = -1; return; }
        if (hipOccupancyMaxActiveBlocksPerMultiprocessor(&per_cu, (const void*)mk_fwd, NWAVES * 64, LDS_BYTES) != hipSuccess || per_cu < 1)
            fprintf(stderr, "kernel_launch: note: occupancy query reports %d workgroups per CU\n", per_cu);
        (void)hipGetLastError();
        grid = cus;
    }
    if (grid < 0) return;
    if (hipMemsetAsync((char*)d_ws + WS_CTL, 0, CTL_ZERO_BYTES, stream) != hipSuccess) return;
    Args a{};
    for (int i = 0; i < 20; ++i) a.in[i] = d_in[i];
    a.out = (float*)d_out; a.ws = (unsigned char*)d_ws; a.pad = 0;
#if MK_MULTI
    for (int p = 0; p < NPHASES; ++p) {
        a.ph_lo = p; a.ph_hi = p + 1; a.use_bar = 0;
        hipLaunchKernelGGL(mk_fwd, dim3(grid), dim3(NWAVES * 64), LDS_BYTES, stream, a);
    }
#else
    a.ph_lo = 0; a.ph_hi = NPHASES; a.use_bar = 1;
    hipLaunchKernelGGL(mk_fwd, dim3(grid), dim3(NWAVES * 64), LDS_BYTES, stream, a);
#endif
}
```

```cpp
#include <hip/hip_runtime.h>
#include <cstdio>
#include <cstdint>

#ifndef SKIPM
#define SKIPM 0
#endif
#ifndef MK_MULTI
#define MK_MULTI 0
#endif

namespace pg8 {
#define PG8_LAS __attribute__((address_space(3)))
typedef unsigned short bf16_t;
typedef short bf16x8 __attribute__((ext_vector_type(8)));
typedef float f32x4 __attribute__((ext_vector_type(4)));
typedef unsigned u32x4 __attribute__((ext_vector_type(4)));
constexpr int BM = 256, BK = 64, HALF = 128, HTB = HALF * BK * 2, STAGE_BYTES = 8 * HTB, NXCD = 8, WGM = 8;

__host__ __device__ __forceinline__ int lds_byte(int r, int c) { const int st = (r >> 4) * 2 + (c >> 5), rr = r & 15, cc = c & 31, ob = rr * 64 + cc * 2; return st * 1024 + (ob ^ (((ob >> 9) & 1) << 5)); }
__host__ __device__ __forceinline__ void stage_rc(int b, int& R, int& C) { const int st = b / 1024, sb = b % 1024, swz = sb ^ (((sb >> 9) & 1) << 5); R = (st >> 1) * 16 + swz / 64; C = (st & 1) * 32 + (swz % 64) / 2; }
__host__ __device__ __forceinline__ int perm32(int rho) { const int n = rho >> 4, i = rho & 15; return 8 * (i >> 2) + 4 * n + (i & 3); }

struct Unit { int pm, pn; };
struct Gemm { const bf16_t* A; const bf16_t* Bt; int M, N, K; };

struct StaticOrder {
    int nM, nN, nwg, G, c;
    __host__ __device__ void init(int M, int N, int G_, int c_) { nM = M / BM; nN = N / BM; nwg = nM * nN; G = G_; c = c_; }
    __host__ __device__ bool next(int i, Unit& u) const {
        const long L = (long)i * G + c; if (L >= nwg) return false;
        int wgid = (int)L; { const int q = nwg / NXCD, r = nwg % NXCD, xcd = wgid % NXCD, off = wgid / NXCD; wgid = (xcd < r ? xcd * (q + 1) : r * (q + 1) + (xcd - r) * q) + off; }
        const int nig = WGM * nN, gid = wgid / nig, fm = gid * WGM, gsz = (nM - fm) < WGM ? (nM - fm) : WGM;
        u.pm = fm + ((wgid % nig) % gsz); u.pn = (wgid % nig) / gsz; return true;
    }
    __device__ __forceinline__ void a_ready(const Unit&) const {}
    __device__ __forceinline__ void done(const Unit&) const {}
};

__device__ __forceinline__ unsigned cvt_pk_bf16(float lo, float hi) { unsigned r; asm volatile("v_cvt_pk_bf16_f32 %0, %1, %2" : "=v"(r) : "v"(lo), "v"(hi)); return r; }

template <int ACT  > struct EpiStore {
    static constexpr bool PERM = true, AFTER_DRAIN = false;
    bf16_t* O; int ldc;
    __device__ __forceinline__ void operator()(const f32x4 (&acc)[2][2][4][2], const Unit& u, int wr, int wc, int fr, int fq) const {
        const int row0 = u.pm * BM + wr * 64 + fr;
        const int col0 = u.pn * BM + wc * 32 + 8 * fq;
#pragma unroll
        for (int ai = 0; ai < 2; ++ai)
#pragma unroll
            for (int m = 0; m < 4; ++m) { bf16_t* rowp = O + (size_t)(row0 + ai * HALF + m * 16) * ldc + col0;
#pragma unroll
                for (int bj = 0; bj < 2; ++bj) { f32x4 v0 = acc[ai][bj][m][0], v1 = acc[ai][bj][m][1];
                    if (ACT == 2) {
#pragma unroll
                        for (int e = 0; e < 4; ++e) { const float a = fmaxf(v0[e], 0.f), b = fmaxf(v1[e], 0.f); v0[e] = a * a; v1[e] = b * b; } }
                    u32x4 w; w.x = cvt_pk_bf16(v0[0], v0[1]); w.y = cvt_pk_bf16(v0[2], v0[3]); w.z = cvt_pk_bf16(v1[0], v1[1]); w.w = cvt_pk_bf16(v1[2], v1[3]);
                    *(u32x4*)(rowp + bj * HALF) = w; } }
    }
};

template <class Epi, class Sched, bool ALIGN_EPI = false, bool SP2 = false>
__device__ __forceinline__ void gemm_phase(PG8_LAS unsigned char* lds, const Gemm g, const Sched& S, const Epi& E) {
    int tid_ = threadIdx.x; asm volatile("" : "+v"(tid_));
    const int tid = tid_, wid = __builtin_amdgcn_readfirstlane(tid >> 6), lane = tid & 63, wr = wid >> 2, wc = wid & 3, fr = lane & 15, fq = lane >> 4;
    const int K = g.K, nt = K / BK;
    unsigned voffA[2], voffB[2];
#pragma unroll
    for (int i = 0; i < 2; ++i) { int R, C; stage_rc(tid * 16 + i * 8192, R, C); const int Rb = Epi::PERM ? ((R & ~31) + perm32(R & 31)) : R;
        voffA[i] = (unsigned)(R * K + C) * 2u; voffB[i] = (unsigned)(Rb * K + C) * 2u; }
    const size_t kstep = (size_t)(BK * 2);
    const size_t hstep = (size_t)HALF * K * 2;
    const size_t tstep = 2 * hstep;
    const unsigned ldsw = (unsigned)wid * 1024u;
    const int aoff = lds_byte(wr * 64 + fr, fq * 8), boff = lds_byte(wc * 32 + fr, fq * 8);
#define PG8_SA(b, h) (((b) * 2 + (h)) * HTB)
#define PG8_SB(b, h) ((4 + (b) * 2 + (h)) * HTB)
#define PG8_STAGE(bufoff, gbase, voff) do { _Pragma("unroll") for (int _i = 0; _i < 2; ++_i) \
        __builtin_amdgcn_global_load_lds((const unsigned*)((const char*)(gbase) + (voff)[_i]), (PG8_LAS unsigned*)(lds + (bufoff) + ldsw + _i * 8192), 16, 0, 0); } while (0)
#define PG8_LDA(dst, b, h) do { _Pragma("unroll") for (int m = 0; m < 4; ++m) _Pragma("unroll") for (int k = 0; k < 2; ++k) dst[m][k] = *(const PG8_LAS bf16x8*)(lds + PG8_SA(b, h) + aoff + m * 2048 + k * 1024); } while (0)
#define PG8_LDB(dst, b, h) do { _Pragma("unroll") for (int n = 0; n < 2; ++n) _Pragma("unroll") for (int k = 0; k < 2; ++k) dst[n][k] = *(const PG8_LAS bf16x8*)(lds + PG8_SB(b, h) + boff + n * 2048 + k * 1024); } while (0)
#define PG8_MMA(ai, bj, At, Bt) do { __builtin_amdgcn_s_setprio(1); _Pragma("unroll") for (int m = 0; m < 4; ++m) _Pragma("unroll") for (int n = 0; n < 2; ++n) _Pragma("unroll") for (int k = 0; k < 2; ++k) \
        acc[ai][bj][m][n] = __builtin_amdgcn_mfma_f32_16x16x32_bf16(Bt[n][k], At[m][k], acc[ai][bj][m][n], 0, 0, 0); __builtin_amdgcn_s_setprio(0); } while (0)
#define PG8_WAIT_V(n) asm volatile("s_waitcnt vmcnt(" #n ")" ::: "memory")
#define PG8_WAIT_L(n) asm volatile("s_waitcnt lgkmcnt(" #n ")" ::: "memory")
#define PG8_BAR __builtin_amdgcn_s_barrier()
#define PG8_SCHED __builtin_amdgcn_sched_barrier(0)
    Unit cur, nxt; int ui = 0;
    if (!S.next(0, cur)) return;
    f32x4 acc[2][2][4][2];
#pragma unroll
    for (int a = 0; a < 2; ++a)
#pragma unroll
        for (int b = 0; b < 2; ++b)
#pragma unroll
            for (int m = 0; m < 4; ++m)
#pragma unroll
                for (int n = 0; n < 2; ++n) acc[a][b][m][n] = (f32x4){0.f, 0.f, 0.f, 0.f};
    bf16x8 At[4][2], B0[2][2], B1[2][2];
    const char* cA = (const char*)g.A + (size_t)cur.pm * tstep; const char* cB = (const char*)g.Bt + (size_t)cur.pn * tstep;
    S.a_ready(cur);
    if constexpr (SP2) {
        PG8_STAGE(PG8_SB(0, 0), cB, voffB); PG8_STAGE(PG8_SB(0, 1), cB + hstep, voffB); PG8_STAGE(PG8_SA(0, 0), cA, voffA); PG8_STAGE(PG8_SA(0, 1), cA + hstep, voffA);
        if (wr == 1) PG8_BAR;
        PG8_WAIT_V(2); PG8_BAR;
        PG8_STAGE(PG8_SB(1, 0), cB + kstep, voffB); PG8_STAGE(PG8_SA(1, 0), cA + kstep, voffA); PG8_STAGE(PG8_SB(1, 1), cB + hstep + kstep, voffB);
        PG8_WAIT_V(6); PG8_BAR;
    } else {
        PG8_STAGE(PG8_SB(0, 0), cB, voffB); PG8_STAGE(PG8_SA(0, 0), cA, voffA); PG8_STAGE(PG8_SB(0, 1), cB + hstep, voffB); PG8_STAGE(PG8_SA(0, 1), cA + hstep, voffA);
        if (wr == 1) PG8_BAR;
        PG8_WAIT_V(4); PG8_BAR;
        PG8_STAGE(PG8_SB(1, 0), cB + kstep, voffB); PG8_STAGE(PG8_SA(1, 0), cA + kstep, voffA); PG8_STAGE(PG8_SB(1, 1), cB + hstep + kstep, voffB);
        PG8_WAIT_V(6); PG8_BAR;
    }
    for (;;) {
        const bool has_next = S.next(ui + 1, nxt);
        const char* nA = has_next ? (const char*)g.A + (size_t)nxt.pm * tstep : cA; const char* nB = has_next ? (const char*)g.Bt + (size_t)nxt.pn * tstep : cB;
        for (int t = 0; t < nt; t += 2) {
            const bool last = (t == nt - 2);
            const char* a1 = cA + (size_t)(t + 1) * kstep;
            const char* a2 = last ? nA : cA + (size_t)(t + 2) * kstep; const char* b2 = last ? nB : cB + (size_t)(t + 2) * kstep;
            const char* a3 = a2 + kstep; const char* b3 = b2 + kstep;
            if (last && has_next) S.a_ready(nxt);
            if constexpr (SP2) {
            PG8_LDB(B0, 0, 0); PG8_LDB(B1, 0, 1); PG8_SCHED; PG8_LDA(At, 0, 0); PG8_STAGE(PG8_SA(1, 1), a1 + hstep, voffA);
            PG8_WAIT_V(8); PG8_WAIT_L(0); PG8_BAR; PG8_MMA(0, 0, At, B0); PG8_MMA(0, 1, At, B1); PG8_BAR; PG8_SCHED;
            PG8_LDA(At, 0, 1); PG8_STAGE(PG8_SB(0, 0), b2, voffB); PG8_STAGE(PG8_SB(0, 1), b2 + hstep, voffB); PG8_STAGE(PG8_SA(0, 0), a2, voffA);
            PG8_WAIT_V(8); PG8_WAIT_L(0); PG8_BAR; PG8_MMA(1, 0, At, B0); PG8_MMA(1, 1, At, B1); PG8_BAR; PG8_SCHED;
            PG8_LDB(B0, 1, 0); PG8_LDB(B1, 1, 1); PG8_SCHED; PG8_LDA(At, 1, 0); PG8_STAGE(PG8_SA(0, 1), a2 + hstep, voffA);
            PG8_WAIT_V(8); PG8_WAIT_L(0); PG8_BAR; PG8_MMA(0, 0, At, B0); PG8_MMA(0, 1, At, B1); PG8_BAR; PG8_SCHED;
            PG8_LDA(At, 1, 1); PG8_STAGE(PG8_SB(1, 0), b3, voffB); PG8_STAGE(PG8_SB(1, 1), b3 + hstep, voffB); PG8_STAGE(PG8_SA(1, 0), a3, voffA);
            PG8_WAIT_V(8); PG8_WAIT_L(0); PG8_BAR; PG8_MMA(1, 0, At, B0); PG8_MMA(1, 1, At, B1); PG8_BAR; PG8_SCHED;
            } else {
            PG8_LDB(B0, 0, 0); PG8_SCHED; PG8_LDA(At, 0, 0); PG8_STAGE(PG8_SA(1, 1), a1 + hstep, voffA);
            PG8_WAIT_L(8); PG8_BAR; PG8_WAIT_L(0); PG8_MMA(0, 0, At, B0); PG8_BAR; PG8_SCHED;
            PG8_LDB(B1, 0, 1); PG8_STAGE(PG8_SB(0, 0), b2, voffB);
            PG8_BAR; PG8_WAIT_L(0); PG8_MMA(0, 1, At, B1); PG8_BAR;
            PG8_LDA(At, 0, 1); PG8_STAGE(PG8_SA(0, 0), a2, voffA);
            PG8_BAR; PG8_WAIT_L(0); PG8_MMA(1, 0, At, B0); PG8_BAR; PG8_SCHED;
            PG8_STAGE(PG8_SB(0, 1), b2 + hstep, voffB);
            PG8_WAIT_V(6); PG8_BAR; PG8_MMA(1, 1, At, B1); PG8_BAR;
            PG8_LDB(B0, 1, 0); PG8_SCHED; PG8_LDA(At, 1, 0); PG8_STAGE(PG8_SA(0, 1), a2 + hstep, voffA);
            PG8_WAIT_L(8); PG8_BAR; PG8_WAIT_L(0); PG8_MMA(0, 0, At, B0); PG8_BAR; PG8_SCHED;
            PG8_LDB(B1, 1, 1); PG8_STAGE(PG8_SB(1, 0), b3, voffB);
            PG8_BAR; PG8_WAIT_L(0); PG8_MMA(0, 1, At, B1); PG8_BAR;
            PG8_LDA(At, 1, 1); PG8_STAGE(PG8_SA(1, 0), a3, voffA);
            PG8_BAR; PG8_WAIT_L(0); PG8_MMA(1, 0, At, B0); PG8_BAR; PG8_SCHED;
            PG8_STAGE(PG8_SB(1, 1), b3 + hstep, voffB);
            PG8_WAIT_V(6); PG8_BAR; PG8_MMA(1, 1, At, B1); PG8_BAR;
            }
        }
        if constexpr (ALIGN_EPI) { if (wr == 0) PG8_BAR; }
        if constexpr (!Epi::AFTER_DRAIN) { E(acc, cur, wr, wc, fr, fq); S.done(cur); }
        if (!has_next) break;
#pragma unroll
        for (int a = 0; a < 2; ++a)
#pragma unroll
            for (int b = 0; b < 2; ++b)
#pragma unroll
                for (int m = 0; m < 4; ++m)
#pragma unroll
                    for (int n = 0; n < 2; ++n) acc[a][b][m][n] = (f32x4){0.f, 0.f, 0.f, 0.f};
        cur = nxt; cA = nA; cB = nB; ++ui;
        if constexpr (ALIGN_EPI) { if (wr == 1) PG8_BAR; }
    }
    PG8_WAIT_V(0);
    if constexpr (!ALIGN_EPI) { if (wr == 0) PG8_BAR; }
    PG8_BAR;
#undef PG8_SA
#undef PG8_SB
#undef PG8_STAGE
#undef PG8_LDA
#undef PG8_LDB
#undef PG8_MMA
#undef PG8_WAIT_V
#undef PG8_WAIT_L
#undef PG8_BAR
#undef PG8_SCHED
}
}

constexpr int NWAVES = 8;
constexpr int BATCH = 32, S = 2048, D = 1024, DEPTH = 4, FF = 4096;
constexpr int M = BATCH * S;
constexpr int NP = 2304;
constexpr int DIN = 2108;
constexpr int C_QA = 0, C_CKV = 256, C_QIDX = 384, C_QB = 512, C_KCMP = 1024, C_VCMP = 1152, C_KSLC = 1280, C_VSLC = 1408, C_KWIN = 1536, C_VWIN = 1664,
              C_UC = 1792, C_KIDX = 2048, C_WIDX = 2080, C_GATE = 2084;
constexpr int NC = 127;
constexpr float EPS = 1e-6f;
constexpr float NEGF = -1e30f;

__host__ __device__ __forceinline__ int win_src(int n) {
    if (n < 512) return n;
    if (n < 1024) return 548 + (n - 512);
    if (n < 1792) return 1060 + (n - 1024);
    if (n < 2048) return 1852 + (n - 1792);
    if (n < 2080) return 512 + (n - 2048);
    if (n < 2084) return 544 + (n - 2080);
    if (n < 2108) return 1828 + (n - 2084);
    return -1;
}

constexpr size_t MiB = 1u << 20;
constexpr size_t WS_CTL = 0, CTL_ZERO_BYTES = 1 * MiB;
constexpr size_t WS_W = 2 * MiB;
constexpr size_t W_IN_B = (size_t)NP * D * 2, W_OUT_B = (size_t)D * D * 2, W_UP_B = (size_t)FF * D * 2, W_DN_B = (size_t)D * FF * 2;
constexpr size_t W_LAYER_B = W_IN_B + W_OUT_B + W_UP_B + W_DN_B;
constexpr size_t WS_ROPE = 96 * MiB;
constexpr size_t WS_KC = 102 * MiB, WS_VC = 105 * MiB;
constexpr size_t WS_KA = 108 * MiB;
constexpr size_t WS_H = 128 * MiB;
constexpr size_t WS_F = 256 * MiB;
constexpr size_t WS_PROJ = 384 * MiB;
constexpr size_t WS_MIX = 672 * MiB;
constexpr size_t WS_HID = 384 * MiB;
constexpr size_t WS_END = 896 * MiB;
static_assert(WS_W + DEPTH * W_LAYER_B <= WS_ROPE, "weights");
static_assert(WS_ROPE + (size_t)M * 24 * 4 <= WS_KC && WS_KC + (size_t)BATCH * NC * 128 * 4 <= WS_VC && WS_VC + (size_t)BATCH * NC * 128 * 4 <= WS_KA && WS_KA + (size_t)M * 128 * 2 <= WS_H, "map");
static_assert(WS_PROJ + (size_t)M * NP * 2 <= WS_MIX && WS_MIX + (size_t)M * D * 2 <= WS_END && WS_HID + (size_t)M * FF * 2 <= WS_END, "map2");

constexpr int CW_BAR = 4096;
constexpr int RING_BYTES = 131072;
constexpr int LDSCTL_OFF = RING_BYTES, MISC_OFF = LDSCTL_OFF + 320;
constexpr int LDS_BYTES = 147456;
constexpr int WSCR = 16384;

#define GAS __attribute__((address_space(1)))
#define LAS __attribute__((address_space(3)))
typedef unsigned short bf16;
typedef unsigned v4u __attribute__((ext_vector_type(4)));
typedef float f32x4 __attribute__((ext_vector_type(4)));
typedef GAS unsigned gu32;
#define LDS_FENCE() asm volatile("s_waitcnt lgkmcnt(0)" ::: "memory")
__device__ __forceinline__ unsigned f2bf(float f) { unsigned u = __builtin_bit_cast(unsigned, f); return (u + 0x7fffu + ((u >> 16) & 1u)) >> 16; }
__device__ __forceinline__ unsigned pk2(float lo, float hi) { return f2bf(lo) | (f2bf(hi) << 16); }
__device__ __forceinline__ float bf2f(bf16 u) { return __builtin_bit_cast(float, (unsigned)u << 16); }
__device__ __forceinline__ float bflo(unsigned u) { return __builtin_bit_cast(float, u << 16); }
__device__ __forceinline__ float bfhi(unsigned u) { return __builtin_bit_cast(float, u & 0xffff0000u); }

#define XB_TMO      128
#define XB_XCNT(j)  (256  + 64 * (j))
#define XB_XSUB(j)  (1280 + 64 * (j))
#define XB_XGEN(j)  (2304 + 64 * (j))
#define XB_TOP      3328
#define XB_TOPGEN   3392
#define XCD_BAR_WORDS 3456
#define XB_SPIN_CAP (1u << 22)

__device__ __forceinline__ unsigned xb_ld(unsigned* p)              { return __hip_atomic_load(p, __ATOMIC_RELAXED, __HIP_MEMORY_SCOPE_AGENT); }
__device__ __forceinline__ unsigned xb_add(unsigned* p, unsigned v) { return __hip_atomic_fetch_add(p, v, __ATOMIC_RELAXED, __HIP_MEMORY_SCOPE_AGENT); }
__device__ __forceinline__ unsigned xb_xcc_id() { return (unsigned)__builtin_amdgcn_s_getreg((3 << 11) | 20) & 0xFu; }
#define XB_SPIN(cond, bar) do { unsigned _sp = 0; while (cond) { __builtin_amdgcn_s_sleep(1); \
    if ((++_sp & 255u) == 0u) { if (xb_ld(&(bar)[XB_TMO])) break; if (_sp > XB_SPIN_CAP) { atomicAdd(&(bar)[XB_TMO], 1u); break; } } } } while (0)

struct XcdBarrier { unsigned* bar; unsigned x; volatile LAS unsigned* st; };

__device__ __forceinline__ XcdBarrier xcd_barrier_post(unsigned* bar, volatile LAS unsigned* st) {
    XcdBarrier b; b.bar = bar; b.x = xb_xcc_id(); b.st = st;
    if (threadIdx.x == 0) (void)xb_add(&bar[XB_XCNT(b.x)], 1u);
    return b;
}
__device__ __forceinline__ void xcd_barrier_complete(unsigned* bar, unsigned x, unsigned& nloc, unsigned& nx) {
    const unsigned G = gridDim.x * gridDim.y * gridDim.z;
    unsigned sum, cnt, mine, sp = 0u;
    for (;;) {
        sum = 0u; cnt = 0u; mine = 0u;
#pragma unroll
        for (unsigned j = 0; j < 16; ++j) { const unsigned c = xb_ld(&bar[XB_XCNT(j)]); sum += c; cnt += (c > 0u) ? 1u : 0u; mine = (j == x) ? c : mine; }
        if (sum == G) break;
        __builtin_amdgcn_s_sleep(1);
        if ((++sp & 255u) == 0u) { if (xb_ld(&bar[XB_TMO])) break; if (sp > XB_SPIN_CAP) { atomicAdd(&bar[XB_TMO], 1u); break; } }
    }
    nloc = mine > 0u ? mine : 1u; nx = cnt > 0u ? cnt : 1u;
}
__device__ __forceinline__ void xcd_barrier(const XcdBarrier& b) {
    asm volatile("s_waitcnt vmcnt(0)" ::: "memory");
    __syncthreads();
    if (threadIdx.x == 0) {
        unsigned* bar = b.bar; asm volatile("" : "+s"(bar));
        __builtin_amdgcn_s_waitcnt(0);
        unsigned nloc = b.st[0], nx = b.st[1];
        if (nloc == 0u) { xcd_barrier_complete(bar, b.x, nloc, nx); b.st[0] = nloc; b.st[1] = nx; }
        const unsigned old = xb_add(&bar[XB_XSUB(b.x)], 1u);
        const unsigned gen = old / nloc;
        if (old + 1u == (gen + 1u) * nloc) {
            __builtin_amdgcn_fence(__ATOMIC_RELEASE, "agent");
            asm volatile("s_waitcnt vmcnt(0)" ::: "memory");
            const unsigned og = xb_add(&bar[XB_TOP], 1u);
            const unsigned tg = og / nx;
            if (og + 1u == (tg + 1u) * nx) xb_add(&bar[XB_TOPGEN], 1u);
            else XB_SPIN(xb_ld(&bar[XB_TOPGEN]) == tg, bar);
            __builtin_amdgcn_fence(__ATOMIC_ACQUIRE, "agent");
            xb_add(&bar[XB_XGEN(b.x)], 1u);
            asm volatile("s_waitcnt vmcnt(0)" ::: "memory");
        } else {
            XB_SPIN(xb_ld(&bar[XB_XGEN(b.x)]) == gen, bar);
            __builtin_amdgcn_fence(__ATOMIC_ACQUIRE, "agent");
            asm volatile("s_waitcnt vmcnt(0)" ::: "memory");
        }
    }
    __syncthreads();
}

struct Frame {
    LAS unsigned char* lds;
    volatile LAS unsigned* MISC;
    gu32* ctl;
    int tid, lane, wave, vcu, G;
    float* out; unsigned char* ws;
};
struct Args { const void* in[20]; float* out; unsigned char* ws; int ph_lo, ph_hi, use_bar, pad; };
#define IN_F(k) ((const float*)args.in[k])
#define P_X_IN IN_F(0)
#define P_POS ((const int*)args.in[1])
#define P_W_IN IN_F(2)
#define P_G_KV_A IN_F(3)
#define P_W_KV_UP IN_F(4)
#define P_W_CMP_K IN_F(5)
#define P_W_CMP_V IN_F(6)
#define P_PE_K IN_F(7)
#define P_PE_V IN_F(8)
#define P_W_POOL IN_F(9)
#define P_POOL_SCALE IN_F(10)
#define P_G_OUT_A IN_F(11)
#define P_G_OUT_B IN_F(12)
#define P_W_OUT IN_F(13)
#define P_G_PRE_MIX IN_F(14)
#define P_G_POST_MIX IN_F(15)
#define P_G_PRE_MLP IN_F(16)
#define P_G_POST_MLP IN_F(17)
#define P_W_UP IN_F(18)
#define P_W_DOWN IN_F(19)
#define B_ROPE ((float*)(ws_ + WS_ROPE))
#define B_KC ((float*)(ws_ + WS_KC))
#define B_VC ((float*)(ws_ + WS_VC))
#define B_KA ((bf16*)(ws_ + WS_KA))
#define B_H ((bf16*)(ws_ + WS_H))
#define B_F ((bf16*)(ws_ + WS_F))
#define B_PROJ ((bf16*)(ws_ + WS_PROJ))
#define B_MIX ((bf16*)(ws_ + WS_MIX))
#define B_HID ((bf16*)(ws_ + WS_HID))

__device__ __forceinline__ float wave_sum(float v) {
#pragma unroll
    for (int o = 1; o < 64; o <<= 1) v += __shfl_xor(v, o);
    return v;
}
__device__ __forceinline__ float wave_max(float v) {
#pragma unroll
    for (int o = 1; o < 64; o <<= 1) v = fmaxf(v, __shfl_xor(v, o));
    return v;
}
__device__ __forceinline__ int wave_sum_i(int v) {
#pragma unroll
    for (int o = 1; o < 64; o <<= 1) v += __shfl_xor(v, o);
    return v;
}

__constant__ double c_rope_inv[12] = {1.0, 0.19392274474868576, 0.03760603093086393, 0.007292664737217109, 0.001414213562373095, 0.0002742481756762073, 5.318295896944988e-05, 1.031338537721246e-05,
                                       1.0, 0.03760603093086393, 0.001414213562373095, 5.318295896944988e-05};
template <int MODE>
__device__ __forceinline__ void transpose_item(const float* W, int K, int Nsrc, int nblk, bf16* WT, LAS float* scr, int item, int lane) {
    const int kb = item / nblk, nb = item % nblk, k0 = 64 * kb, n0 = 32 * nb;
    const int np = n0 + (lane & 31);
    const int src = MODE ? win_src(np) : np;
#pragma unroll 8
    for (int i = 0; i < 32; ++i) { const int kk = 2 * i + (lane >> 5); scr[kk * 33 + (lane & 31)] = (src >= 0) ? W[(size_t)(k0 + kk) * Nsrc + src] : 0.f; }
    LDS_FENCE();
    const int c = lane & 7;
#pragma unroll
    for (int j = 0; j < 4; ++j) { const int n = (lane >> 3) + 8 * j; const LAS float* s = scr + (8 * c) * 33 + n;
        v4u o; o.x = pk2(s[0 * 33], s[1 * 33]); o.y = pk2(s[2 * 33], s[3 * 33]); o.z = pk2(s[4 * 33], s[5 * 33]); o.w = pk2(s[6 * 33], s[7 * 33]);
        *(v4u*)(WT + (size_t)(n0 + n) * K + k0 + 8 * c) = o; }
    LDS_FENCE();
}

__device__ __forceinline__ bf16* w_in_t(unsigned char* ws_, int l)  { return (bf16*)(ws_ + WS_W + (size_t)l * W_LAYER_B); }
__device__ __forceinline__ bf16* w_out_t(unsigned char* ws_, int l) { return (bf16*)(ws_ + WS_W + (size_t)l * W_LAYER_B + W_IN_B); }
__device__ __forceinline__ bf16* w_up_t(unsigned char* ws_, int l)  { return (bf16*)(ws_ + WS_W + (size_t)l * W_LAYER_B + W_IN_B + W_OUT_B); }
__device__ __forceinline__ bf16* w_dn_t(unsigned char* ws_, int l)  { return (bf16*)(ws_ + WS_W + (size_t)l * W_LAYER_B + W_IN_B + W_OUT_B + W_UP_B); }

__device__ __forceinline__ void norm_row_to_bf16(const float* xrow, const float* gain, bf16* orow, int lane) {
    const f32x4* xr = (const f32x4*)xrow + lane;
    f32x4 v[4]; float s = 0.f;
#pragma unroll
    for (int j = 0; j < 4; ++j) { v[j] = xr[64 * j]; s += (v[j].x * v[j].x + v[j].y * v[j].y) + (v[j].z * v[j].z + v[j].w * v[j].w); }
    const float rs = rsqrtf(wave_sum(s) * (1.f / D) + EPS);
    unsigned long long* o8 = (unsigned long long*)orow + lane;
#pragma unroll
    for (int j = 0; j < 4; ++j) { const f32x4 g = ((const f32x4*)gain)[lane + 64 * j];
        o8[64 * j] = (unsigned long long)pk2(v[j].x * rs * g.x, v[j].y * rs * g.y) | ((unsigned long long)pk2(v[j].z * rs * g.z, v[j].w * rs * g.w) << 32); }
}

__device__ __forceinline__ void phase_prologue(Frame& F, const Args& args) {
    unsigned char* ws_ = F.ws; asm volatile("" : "+s"(ws_)); int lane_ = F.lane; asm volatile("" : "+v"(lane_)); (void)ws_;
    LAS float* scr = (LAS float*)(F.lds + F.wave * WSCR);
    const int gw = F.vcu * NWAVES + F.wave, NGW = F.G * NWAVES;
    constexpr int I_IN = (D / 64) * (NP / 32), I_OUT = (D / 64) * (D / 32), I_UP = (D / 64) * (FF / 32), I_DN = (FF / 64) * (D / 32);
    for (int it = gw; it < DEPTH * I_IN; it += NGW) { const int l = it / I_IN, r = it % I_IN; transpose_item<1>(P_W_IN + (size_t)l * D * DIN, D, DIN, NP / 32, w_in_t(ws_, l), scr, r, lane_); }
    for (int it = gw; it < DEPTH * I_OUT; it += NGW) { const int l = it / I_OUT, r = it % I_OUT; transpose_item<0>(P_W_OUT + (size_t)l * D * D, D, D, D / 32, w_out_t(ws_, l), scr, r, lane_); }
    for (int it = gw; it < DEPTH * I_UP; it += NGW) { const int l = it / I_UP, r = it % I_UP; transpose_item<0>(P_W_UP + (size_t)l * D * FF, D, FF, FF / 32, w_up_t(ws_, l), scr, r, lane_); }
    for (int it = gw; it < DEPTH * I_DN; it += NGW) { const int l = it / I_DN, r = it % I_DN; transpose_item<0>(P_W_DOWN + (size_t)l * FF * D, FF, D, D / 32, w_dn_t(ws_, l), scr, r, lane_); }
    for (int e = gw * 64 + lane_; e < M * 12; e += NGW * 64) {
        const int row = e / 12, i = e % 12;
        const double inv = c_rope_inv[i];
        const double a = (double)P_POS[row] * inv;
        const double k = __builtin_rint(a * 0.15915494309189535);
        const float r = (float)(a - k * 6.283185307179586);
        const float c = __builtin_cosf(r), s = __builtin_sinf(r);
        float* t = B_ROPE + (size_t)row * 24;
        if (i < 8) { t[i] = c; t[8 + i] = s; } else { t[16 + (i - 8)] = c; t[20 + (i - 8)] = s; }
    }
    for (int m = gw; m < M; m += NGW) norm_row_to_bf16(P_X_IN + (size_t)m * D, P_G_PRE_MIX, B_H + (size_t)m * D, lane_);
}

__device__ __forceinline__ void phase_prep(Frame& F, const Args& args, int l) {
    unsigned char* ws_ = F.ws; asm volatile("" : "+s"(ws_)); int lane_ = F.lane; asm volatile("" : "+v"(lane_)); (void)ws_;
    LAS float* xs = (LAS float*)(F.lds + F.wave * WSCR);
    const int gw = F.vcu * NWAVES + F.wave, NGW = F.G * NWAVES, lane = lane_;
    const float* gkv = P_G_KV_A + l * 128; const float* Wkv = P_W_KV_UP + (size_t)l * 128 * 128;
    for (int row = gw; row < M; row += NGW) {
        bf16* prow = B_PROJ + (size_t)row * NP;
        const float* tab = B_ROPE + (size_t)row * 24;
        const unsigned u = *(const unsigned*)(prow + C_CKV + 2 * lane);
        const float x0 = bflo(u), x1 = bfhi(u);
        const float rs = rsqrtf(wave_sum(x0 * x0 + x1 * x1) * (1.f / 128.f) + EPS);
        xs[2 * lane] = x0 * rs * gkv[2 * lane]; xs[2 * lane + 1] = x1 * rs * gkv[2 * lane + 1];
        LDS_FENCE();
        float a0 = 0.f, a1 = 0.f;
#pragma unroll 8
        for (int k = 0; k < 128; ++k) { const float xv = xs[k]; a0 += xv * Wkv[k * 128 + lane]; a1 += xv * Wkv[k * 128 + 64 + lane]; }
        LDS_FENCE();
        {
            const float partner = __shfl_xor(a0, 8);
            const int i = lane & 7; const float c = tab[i], s = tab[8 + i];
            float kr = a0;
            if (lane < 8) kr = a0 * c - partner * s; else if (lane < 16) kr = partner * s + a0 * c;
            B_KA[(size_t)row * 128 + lane] = (bf16)f2bf(kr); B_KA[(size_t)row * 128 + 64 + lane] = (bf16)f2bf(a1);
        }
        if (lane < 4) { const int i = lane; const float c = tab[16 + i], s = tab[20 + i];
            const float x1v = bf2f(prow[C_KIDX + i]), x2v = bf2f(prow[C_KIDX + 4 + i]);
            prow[C_KIDX + i] = (bf16)f2bf(x1v * c - x2v * s); prow[C_KIDX + 4 + i] = (bf16)f2bf(x1v * s + x2v * c);
        } else if (lane < 36) { const int idx = lane - 4, which = idx >> 3, i = idx & 7; const int base = ((which < 2) ? C_KSLC : C_KWIN) + (which & 1) * 64;
            const float c = tab[i], s = tab[8 + i];
            const float x1v = bf2f(prow[base + i]), x2v = bf2f(prow[base + 8 + i]);
            prow[base + i] = (bf16)f2bf(x1v * c - x2v * s); prow[base + 8 + i] = (bf16)f2bf(x1v * s + x2v * c);
        }
    }
    for (int it = gw; it < BATCH * NC * 2; it += NGW) {
        const int kv = it & 1, bc = it >> 1, b = bc / NC, c = bc % NC;
        const float* W = (kv ? P_W_CMP_V : P_W_CMP_K) + (size_t)l * 32 * 64 * 64;
        const float* pe = (kv ? P_PE_V : P_PE_K) + l * 32 * 64;
        float acc0 = 0.f, acc1 = 0.f;
        for (int li = 0; li < 32; ++li) {
            const bf16* prow = B_PROJ + (size_t)(b * S + 16 * c + li) * NP + (kv ? C_VCMP : C_KCMP);
            const float pev = pe[li * 64 + lane];
            const float xv0 = bf2f(prow[lane]) + pev, xv1 = bf2f(prow[64 + lane]) + pev;
            const float* Wl = W + (size_t)li * 64 * 64 + lane;
#pragma unroll 16
            for (int d = 0; d < 64; ++d) { const float w = Wl[d * 64]; acc0 += __shfl(xv0, d) * w; acc1 += __shfl(xv1, d) * w; }
        }
        float* o = (kv ? B_VC : B_KC) + ((size_t)(b * NC + c) * 2) * 64;
        o[lane] = acc0; o[64 + lane] = acc1;
    }
}

__device__ __forceinline__ void dsa_token(unsigned char* ws_, int lane_, int b, int t, LAS unsigned char* scr) {
    const int lane = lane_;
    const size_t row = (size_t)b * S + t;
    const bf16* prow = B_PROJ + row * NP;
    LAS float* sc = (LAS float*)scr;
    LAS unsigned* ku = (LAS unsigned*)scr;
    LAS float* qi = (LAS float*)(scr + 8192);
    LAS float* qa = (LAS float*)(scr + 8192 + 512);
    LAS int* list = (LAS int*)(scr + 8192 + 512 + 1024);
    LAS float* pp = (LAS float*)(scr + 8192 + 512 + 1024 + 1024);
    const float* tab = B_ROPE + row * 24;
    { const unsigned u = *(const unsigned*)(prow + C_QIDX + 2 * lane); qi[2 * lane] = bflo(u); qi[2 * lane + 1] = bfhi(u); }
#pragma unroll
    for (int j = 0; j < 2; ++j) { const unsigned u = *(const unsigned*)(prow + C_QA + 2 * lane + 128 * j); qa[2 * lane + 128 * j] = bflo(u); qa[2 * lane + 128 * j + 1] = bfhi(u); }
    LDS_FENCE();
    if (lane < 16) { const int h = lane >> 2, i = lane & 3; const float c = tab[16 + i], s = tab[20 + i]; const float x1 = qi[h * 32 + i], x2 = qi[h * 32 + 4 + i];
        qi[h * 32 + i] = x1 * c - x2 * s; qi[h * 32 + 4 + i] = x1 * s + x2 * c; }
    if (lane >= 32) { const int h = (lane - 32) >> 3, i = lane & 7; const float c = tab[i], s = tab[8 + i]; const float x1 = qa[h * 64 + i], x2 = qa[h * 64 + 8 + i];
        qa[h * 64 + i] = x1 * c - x2 * s; qa[h * 64 + 8 + i] = x1 * s + x2 * c; }
    LDS_FENCE();
    float w[4];
#pragma unroll
    for (int h = 0; h < 4; ++h) w[h] = bf2f(prow[C_WIDX + h]);
    const int nk = t + 1;
    const bf16* kbase = B_PROJ + (size_t)b * S * NP + C_KIDX;
    for (int s0 = 0; s0 < nk; s0 += 64) {
        const int s = s0 + lane;
        if (s < nk) {
            const v4u* kp = (const v4u*)(kbase + (size_t)s * NP);
            float kf[32];
#pragma unroll
            for (int q = 0; q < 4; ++q) { const v4u kk = kp[q];
                kf[8 * q + 0] = bflo(kk.x); kf[8 * q + 1] = bfhi(kk.x); kf[8 * q + 2] = bflo(kk.y); kf[8 * q + 3] = bfhi(kk.y);
                kf[8 * q + 4] = bflo(kk.z); kf[8 * q + 5] = bfhi(kk.z); kf[8 * q + 6] = bflo(kk.w); kf[8 * q + 7] = bfhi(kk.w); }
            float score = 0.f;
#pragma unroll
            for (int h = 0; h < 4; ++h) { float d = 0.f;
#pragma unroll
                for (int dd = 0; dd < 32; ++dd) d += qi[h * 32 + dd] * kf[dd];
                score += w[h] * fmaxf(d, 0.f); }
            unsigned bits = __builtin_bit_cast(unsigned, score);
            if (bits == 0x80000000u) bits = 0u;
            ku[s] = (bits & 0x80000000u) ? ~bits : (bits | 0x80000000u);
        }
    }
    LDS_FENCE();
    int nsel;
    if (nk <= 256) { nsel = nk; for (int e = lane; e < nk; e += 64) list[e] = e; }
    else {
        unsigned prefix = 0u;
        for (int bit = 31; bit >= 0; --bit) {
            const unsigned cand = prefix | (1u << bit);
            int cnt = 0;
            for (int s = lane; s < nk; s += 64) cnt += (ku[s] >= cand) ? 1 : 0;
            cnt = wave_sum_i(cnt);
            if (cnt >= 256) prefix = cand;
        }
        const unsigned thr = prefix;
        int cgt = 0;
        for (int s = lane; s < nk; s += 64) cgt += (ku[s] > thr) ? 1 : 0;
        cgt = wave_sum_i(cgt);
        const int r = 256 - cgt;
        int pos = 0, eqseen = 0;
        const unsigned long long lt = (1ull << lane) - 1ull;
        for (int s0 = 0; s0 < nk; s0 += 64) {
            const int s = s0 + lane; const bool in = s < nk; const unsigned k = in ? ku[s] : 0u;
            const bool gt = in && (k > thr), eq = in && (k == thr);
            const unsigned long long beq = __ballot(eq);
            const int eqrank = eqseen + __popcll(beq & lt);
            const bool sel = gt || (eq && eqrank < r);
            const unsigned long long bsel = __ballot(sel);
            if (sel) list[pos + __popcll(bsel & lt)] = s;
            pos += __popcll(bsel); eqseen += __popcll(beq);
        }
        nsel = 256;
    }
    LDS_FENCE();
    const bf16* kab = B_KA + (size_t)b * S * 128;
    float lg[4][4];
#pragma unroll
    for (int i = 0; i < 4; ++i) {
        const int e = lane + 64 * i;
#pragma unroll
        for (int h = 0; h < 4; ++h) lg[i][h] = NEGF;
        if (e < nsel) {
            const int s = list[e];
            const v4u* kp = (const v4u*)(kab + (size_t)s * 128);
            float acc[4] = {0.f, 0.f, 0.f, 0.f};
#pragma unroll
            for (int q = 0; q < 8; ++q) { const v4u kk = kp[q]; float kf[8];
                kf[0] = bflo(kk.x); kf[1] = bfhi(kk.x); kf[2] = bflo(kk.y); kf[3] = bfhi(kk.y); kf[4] = bflo(kk.z); kf[5] = bfhi(kk.z); kf[6] = bflo(kk.w); kf[7] = bfhi(kk.w);
#pragma unroll
                for (int h = 0; h < 4; ++h)
#pragma unroll
                    for (int dd = 0; dd < 8; ++dd) acc[h] += qa[h * 64 + 8 * q + dd] * kf[dd]; }
#pragma unroll
            for (int h = 0; h < 4; ++h) lg[i][h] = acc[h] * 0.125f;
        }
    }
#pragma unroll
    for (int h = 0; h < 4; ++h) {
        float m = fmaxf(fmaxf(lg[0][h], lg[1][h]), fmaxf(lg[2][h], lg[3][h])); m = wave_max(m);
        float p[4], sum = 0.f;
#pragma unroll
        for (int i = 0; i < 4; ++i) { p[i] = (lane + 64 * i < nsel) ? __expf(lg[i][h] - m) : 0.f; sum += p[i]; }
        sum = wave_sum(sum); const float inv = 1.f / sum;
#pragma unroll
        for (int i = 0; i < 4; ++i) pp[(lane + 64 * i) * 4 + h] = p[i] * inv;
    }
    LDS_FENCE();
    float o[4] = {0.f, 0.f, 0.f, 0.f};
    for (int e = 0; e < nsel; ++e) {
        const int s = list[e];
        const float v = bf2f(kab[(size_t)s * 128 + 64 + lane]);
        const f32x4 p4 = *(const LAS f32x4*)(pp + e * 4);
        o[0] += p4.x * v; o[1] += p4.y * v; o[2] += p4.z * v; o[3] += p4.w * v;
    }
    bf16* orow = B_MIX + row * D;
#pragma unroll
    for (int h = 0; h < 4; ++h) orow[h * 64 + lane] = (bf16)f2bf(o[h]);
    LDS_FENCE();
}

__device__ __forceinline__ void nsa_tile(const bf16* kbase, const bf16* vbase, int s0, bool valid, const LAS float* q, LAS float* pt, float (&m)[4], float (&l)[4], float (&o)[4], int lane) {
    float lg[4] = {NEGF, NEGF, NEGF, NEGF};
    if (valid) {
        const v4u* kp = (const v4u*)(kbase + (size_t)(s0 + lane) * NP);
        float acc[4] = {0.f, 0.f, 0.f, 0.f};
#pragma unroll
        for (int qq = 0; qq < 8; ++qq) { const v4u kk = kp[qq]; float kf[8];
            kf[0] = bflo(kk.x); kf[1] = bfhi(kk.x); kf[2] = bflo(kk.y); kf[3] = bfhi(kk.y); kf[4] = bflo(kk.z); kf[5] = bfhi(kk.z); kf[6] = bflo(kk.w); kf[7] = bfhi(kk.w);
#pragma unroll
            for (int h = 0; h < 4; ++h)
#pragma unroll
                for (int dd = 0; dd < 8; ++dd) acc[h] += q[h * 64 + 8 * qq + dd] * kf[dd]; }
#pragma unroll
        for (int h = 0; h < 4; ++h) lg[h] = acc[h] * 0.125f;
    }
    float p[4];
#pragma unroll
    for (int h = 0; h < 4; ++h) {
        const float tm = wave_max(lg[h]); const float mn = fmaxf(m[h], tm);
        const float alpha = __expf(m[h] - mn);
        p[h] = valid ? __expf(lg[h] - mn) : 0.f;
        l[h] = l[h] * alpha + wave_sum(p[h]); o[h] *= alpha; m[h] = mn;
    }
    *(LAS f32x4*)(pt + lane * 4) = (f32x4){p[0], p[1], p[2], p[3]};
    LDS_FENCE();
#pragma unroll 8
    for (int k = 0; k < 64; ++k) {
        const float v = bf2f(vbase[(size_t)(s0 + k) * NP + lane]);
        const f32x4 p4 = *(const LAS f32x4*)(pt + k * 4);
        o[0] += p4.x * v; o[1] += p4.y * v; o[2] += p4.z * v; o[3] += p4.w * v;
    }
    LDS_FENCE();
}

__device__ __forceinline__ void nsa_token(unsigned char* ws_, int lane_, int b, int t, int g, LAS unsigned char* scr) {
    const int lane = lane_;
    const size_t row = (size_t)b * S + t;
    const bf16* prow = B_PROJ + row * NP;
    LAS float* qn = (LAS float*)scr;
    LAS float* qr = (LAS float*)(scr + 1024);
    LAS float* pc = (LAS float*)(scr + 2048);
    LAS float* ps = (LAS float*)(scr + 4096);
    LAS float* pt = (LAS float*)(scr + 4608);
    const float* tab = B_ROPE + row * 24;
#pragma unroll
    for (int j = 0; j < 2; ++j) { const unsigned u = *(const unsigned*)(prow + C_QB + g * 256 + 2 * lane + 128 * j);
        const float a = bflo(u), c = bfhi(u); qn[2 * lane + 128 * j] = a; qn[2 * lane + 128 * j + 1] = c; qr[2 * lane + 128 * j] = a; qr[2 * lane + 128 * j + 1] = c; }
    LDS_FENCE();
    if (lane < 32) { const int h = lane >> 3, i = lane & 7; const float c = tab[i], s = tab[8 + i]; const float x1 = qn[h * 64 + i], x2 = qn[h * 64 + 8 + i];
        qr[h * 64 + i] = x1 * c - x2 * s; qr[h * 64 + 8 + i] = x1 * s + x2 * c; }
    LDS_FENCE();
    const int ncv = (t >= 31) ? (((t - 31) >> 4) + 1) : 0;
    float ocmp[4] = {0.f, 0.f, 0.f, 0.f};
    {
        float lg[2][4];
#pragma unroll
        for (int ci = 0; ci < 2; ++ci) {
            const int c = lane + 64 * ci;
#pragma unroll
            for (int h = 0; h < 4; ++h) lg[ci][h] = NEGF;
            if (c < ncv) {
                const f32x4* kp = (const f32x4*)(B_KC + ((size_t)(b * NC + c) * 2 + g) * 64);
                float acc[4] = {0.f, 0.f, 0.f, 0.f};
#pragma unroll
                for (int qq = 0; qq < 16; ++qq) { const f32x4 kk = kp[qq];
#pragma unroll
                    for (int h = 0; h < 4; ++h) acc[h] += qn[h * 64 + 4 * qq] * kk.x + qn[h * 64 + 4 * qq + 1] * kk.y + qn[h * 64 + 4 * qq + 2] * kk.z + qn[h * 64 + 4 * qq + 3] * kk.w; }
#pragma unroll
                for (int h = 0; h < 4; ++h) lg[ci][h] = acc[h] * 0.125f;
            }
        }
        float p[2][4];
#pragma unroll
        for (int h = 0; h < 4; ++h) {
            const float mm = wave_max(fmaxf(lg[0][h], lg[1][h]));
            p[0][h] = (lane < ncv) ? __expf(lg[0][h] - mm) : 0.f; p[1][h] = (lane + 64 < ncv) ? __expf(lg[1][h] - mm) : 0.f;
            const float sum = wave_sum(p[0][h] + p[1][h]);
            const float inv = (ncv > 0) ? 1.f / sum : 0.f;
            p[0][h] *= inv; p[1][h] *= inv;
        }
#pragma unroll
        for (int ci = 0; ci < 2; ++ci) { const int c = lane + 64 * ci;
            *(LAS f32x4*)(pc + c * 4) = (f32x4){p[ci][0], p[ci][1], p[ci][2], p[ci][3]};
            ps[c] = (p[ci][0] + p[ci][1]) + (p[ci][2] + p[ci][3]); }
        LDS_FENCE();
        for (int c = 0; c < ncv; ++c) {
            const float v = B_VC[((size_t)(b * NC + c) * 2 + g) * 64 + lane];
            const f32x4 p4 = *(const LAS f32x4*)(pc + c * 4);
            ocmp[0] += p4.x * v; ocmp[1] += p4.y * v; ocmp[2] += p4.z * v; ocmp[3] += p4.w * v;
        }
    }
    const int cur = t >> 6;
    unsigned selmask;
    if (cur < 16) selmask = (2u << cur) - 1u;
    else {
        float sj = -__builtin_inff();
        if (lane < 32 && lane <= cur) {
            const int j = lane;
            if (j == 0 || j == cur || j == cur - 1) sj = __builtin_inff();
            else { const int c0 = 4 * j - 1, c1 = (4 * j + 3 < NC - 1) ? 4 * j + 3 : NC - 1; float a = 0.f; for (int c = c0; c <= c1; ++c) a += ps[c]; sj = a; }
        }
        int rank = 0;
#pragma unroll
        for (int i = 0; i < 32; ++i) { const float si = __shfl(sj, i); rank += ((si > sj) || (si == sj && i < lane)) ? 1 : 0; }
        const bool sel = (lane < 32) && (rank < 16);
        selmask = (unsigned)(__ballot(sel) & 0xffffffffull);
    }
    float ms[4] = {NEGF, NEGF, NEGF, NEGF}, ls[4] = {0.f, 0.f, 0.f, 0.f}, os[4] = {0.f, 0.f, 0.f, 0.f};
    {
        const bf16* kb = B_PROJ + (size_t)b * S * NP + C_KSLC + g * 64;
        const bf16* vb = B_PROJ + (size_t)b * S * NP + C_VSLC + g * 64;
        for (int j = 0; j <= cur; ++j) {
            if (!((selmask >> j) & 1u)) continue;
            nsa_tile(kb, vb, 64 * j, (64 * j + lane) <= t, qr, pt, ms, ls, os, lane);
        }
    }
    float mw[4] = {NEGF, NEGF, NEGF, NEGF}, lw[4] = {0.f, 0.f, 0.f, 0.f}, ow[4] = {0.f, 0.f, 0.f, 0.f};
    {
        const bf16* kb = B_PROJ + (size_t)b * S * NP + C_KWIN + g * 64;
        const bf16* vb = B_PROJ + (size_t)b * S * NP + C_VWIN + g * 64;
        const int lo = (t - 511 > 0) ? t - 511 : 0;
        for (int j = lo >> 6; j <= cur; ++j) {
            const int s = 64 * j + lane;
            nsa_tile(kb, vb, 64 * j, (s >= lo) && (s <= t), qr, pt, mw, lw, ow, lane);
        }
    }
    bf16* orow = B_MIX + row * D + 256 + g * 256;
#pragma unroll
    for (int h = 0; h < 4; ++h) {
        const bf16* gp = prow + C_GATE + (g * 4 + h) * 3;
        const float g0 = 1.f / (1.f + __expf(-bf2f(gp[0]))), g1 = 1.f / (1.f + __expf(-bf2f(gp[1]))), g2 = 1.f / (1.f + __expf(-bf2f(gp[2])));
        const float o = g0 * ocmp[h] + g1 * (os[h] / ls[h]) + g2 * (ow[h] / lw[h]);
        orow[h * 64 + lane] = (bf16)f2bf(o);
    }
    LDS_FENCE();
}

__device__ __forceinline__ void phase_attn(Frame& F, int l) {
    (void)l;
    unsigned char* ws_ = F.ws; asm volatile("" : "+s"(ws_)); int lane_ = F.lane; asm volatile("" : "+v"(lane_)); (void)ws_;
    LAS unsigned char* scr = F.lds + F.wave * WSCR;
    const int gw = F.vcu * NWAVES + F.wave, NGW = F.G * NWAVES;
    for (int it = gw; it < M; it += NGW) {
        const int b = it / S, t = ((it % S) + 64 * b) % S;
        dsa_token(ws_, lane_, b, t, scr);
    }
    for (int it = gw; it < 2 * M; it += NGW) {
        const int g = it & 1, tk = it >> 1; const int b = tk / S, t = ((tk % S) + 64 * b) % S;
        nsa_token(ws_, lane_, b, t, g, scr);
    }
}

__device__ __forceinline__ void phase_merge(Frame& F, const Args& args, int l) {
    unsigned char* ws_ = F.ws; asm volatile("" : "+s"(ws_)); int lane_ = F.lane; asm volatile("" : "+v"(lane_)); (void)ws_;
    LAS float* pl = (LAS float*)(F.lds + F.wave * WSCR);
    const int gw = F.vcu * NWAVES + F.wave, NGW = F.G * NWAVES, lane = lane_;
    const float* wp = P_W_POOL + (size_t)l * 4 * 64 * 64;
    const float* psc = P_POOL_SCALE + l * 256;
    const float* goa = P_G_OUT_A + l * 256; const float* gob = P_G_OUT_B + l * 512;
    for (int row = gw; row < M; row += NGW) {
        const int t = row % S;
        bf16* mrow = B_MIX + (size_t)row * D;
        { const unsigned long long u = *((const unsigned long long*)mrow + lane);
          const float a0 = bflo((unsigned)u), a1 = bfhi((unsigned)u), a2 = bflo((unsigned)(u >> 32)), a3 = bfhi((unsigned)(u >> 32));
          const float rs = rsqrtf(wave_sum((a0 * a0 + a1 * a1) + (a2 * a2 + a3 * a3)) * (1.f / 256.f) + EPS);
          const f32x4 gg = ((const f32x4*)goa)[lane];
          *((unsigned long long*)mrow + lane) = (unsigned long long)pk2(a0 * rs * gg.x, a1 * rs * gg.y) | ((unsigned long long)pk2(a2 * rs * gg.z, a3 * rs * gg.w) << 32); }
        { const v4u u = *((const v4u*)(mrow + 256) + lane);
          float a[8] = {bflo(u.x), bfhi(u.x), bflo(u.y), bfhi(u.y), bflo(u.z), bfhi(u.z), bflo(u.w), bfhi(u.w)};
          float ss = 0.f;
#pragma unroll
          for (int i = 0; i < 8; ++i) ss += a[i] * a[i];
          const float rs = rsqrtf(wave_sum(ss) * (1.f / 512.f) + EPS);
          const f32x4 g0 = ((const f32x4*)gob)[2 * lane], g1 = ((const f32x4*)gob)[2 * lane + 1];
          v4u o; o.x = pk2(a[0] * rs * g0.x, a[1] * rs * g0.y); o.y = pk2(a[2] * rs * g0.z, a[3] * rs * g0.w); o.z = pk2(a[4] * rs * g1.x, a[5] * rs * g1.y); o.w = pk2(a[6] * rs * g1.z, a[7] * rs * g1.w);
          *((v4u*)(mrow + 256) + lane) = o; }
        const bf16* up = B_PROJ + (size_t)row * NP + C_UC;
#pragma unroll
        for (int gi = 0; gi < 4; ++gi) {
            const int w = 2 << gi;
            const float u0 = bf2f(up[gi * 64 + lane]);
            float sum = u0;
            for (int i = 1; i < w; ++i) if (t - i >= 0) sum += bf2f(up[gi * 64 + lane - (size_t)i * NP]);
            const float cntf = (float)((t + 1 < w) ? t + 1 : w);
            pl[gi * 64 + lane] = sum / cntf - u0;
        }
        LDS_FENCE();
        float oc[4]; float ss = 0.f;
#pragma unroll
        for (int gi = 0; gi < 4; ++gi) {
            float a = 0.f; const float* wg = wp + (size_t)gi * 64 * 64 + lane;
#pragma unroll 16
            for (int c = 0; c < 64; ++c) a += pl[gi * 64 + c] * wg[c * 64];
            oc[gi] = a; ss += a * a;
        }
        const float rs = rsqrtf(wave_sum(ss) * (1.f / 256.f) + EPS);
#pragma unroll
        for (int gi = 0; gi < 4; ++gi) mrow[768 + gi * 64 + lane] = (bf16)f2bf(oc[gi] * rs * psc[gi * 64 + lane]);
        LDS_FENCE();
    }
}

__device__ __forceinline__ void phase_finish(Frame& F, const float* xsrc, const float* gpost, const float* gnext  ) {
    unsigned char* ws_ = F.ws; asm volatile("" : "+s"(ws_)); int lane_ = F.lane; asm volatile("" : "+v"(lane_)); (void)ws_;
    const int gw = F.vcu * NWAVES + F.wave, NGW = F.G * NWAVES, lane = lane_;
    for (int row = gw; row < M; row += NGW) {
        const unsigned long long* fr = (const unsigned long long*)(B_F + (size_t)row * D) + lane;
        const f32x4* xr = (const f32x4*)(xsrc + (size_t)row * D) + lane;
        f32x4 f[4], x[4]; float ss = 0.f;
#pragma unroll
        for (int j = 0; j < 4; ++j) { const unsigned long long u = fr[64 * j]; x[j] = xr[64 * j];
            f[j] = (f32x4){bflo((unsigned)u), bfhi((unsigned)u), bflo((unsigned)(u >> 32)), bfhi((unsigned)(u >> 32))};
            ss += (f[j].x * f[j].x + f[j].y * f[j].y) + (f[j].z * f[j].z + f[j].w * f[j].w); }
        const float rs = rsqrtf(wave_sum(ss) * (1.f / D) + EPS);
        float s2 = 0.f;
        f32x4* orow = (f32x4*)(F.out + (size_t)row * D) + lane;
#pragma unroll
        for (int j = 0; j < 4; ++j) { const f32x4 g = ((const f32x4*)gpost)[lane + 64 * j];
            x[j].x += f[j].x * rs * g.x; x[j].y += f[j].y * rs * g.y; x[j].z += f[j].z * rs * g.z; x[j].w += f[j].w * rs * g.w;
            orow[64 * j] = x[j];
            s2 += (x[j].x * x[j].x + x[j].y * x[j].y) + (x[j].z * x[j].z + x[j].w * x[j].w); }
        if (gnext) {
            const float r2 = rsqrtf(wave_sum(s2) * (1.f / D) + EPS);
            unsigned long long* o8 = (unsigned long long*)(B_H + (size_t)row * D) + lane;
#pragma unroll
            for (int j = 0; j < 4; ++j) { const f32x4 g = ((const f32x4*)gnext)[lane + 64 * j];
                o8[64 * j] = (unsigned long long)pk2(x[j].x * r2 * g.x, x[j].y * r2 * g.y) | ((unsigned long long)pk2(x[j].z * r2 * g.z, x[j].w * r2 * g.w) << 32); }
        }
    }
}

template <int ACT>
__device__ __forceinline__ void phase_gemm(Frame& F, const bf16* A, const bf16* Bt, bf16* O, int N, int K) {
    asm volatile("" : "+s"(A), "+s"(Bt), "+s"(O));
    pg8::Gemm g{A, Bt, M, N, K}; pg8::StaticOrder So; So.init(M, N, F.G, (int)blockIdx.x);
    pg8::EpiStore<ACT> E{O, N};
    pg8::gemm_phase<pg8::EpiStore<ACT>, pg8::StaticOrder, true, true>(F.lds, g, So, E);
}

constexpr int PH_PER_LAYER = 9, NPHASES = 1 + DEPTH * PH_PER_LAYER;
__global__ void __launch_bounds__(NWAVES * 64, 2) mk_fwd(Args args) {
    extern __shared__ __attribute__((aligned(16))) unsigned char lds[];
    Frame F;
    F.lds = (LAS unsigned char*)lds;
    F.MISC = (volatile LAS unsigned*)(F.lds + MISC_OFF);
    F.tid = threadIdx.x; F.lane = F.tid & 63; F.wave = __builtin_amdgcn_readfirstlane(F.tid >> 6);
    F.G = gridDim.x; { const int bx = blockIdx.x; F.vcu = (F.G % 8 == 0) ? (bx % 8) * (F.G / 8) + bx / 8 : bx; }
    unsigned char* ws = args.ws; F.ws = ws;
    F.ctl = (gu32*)(ws + WS_CTL);
    F.out = args.out;
    for (int u = F.tid; u < (LDS_BYTES - LDSCTL_OFF) / 4; u += NWAVES * 64) ((LAS unsigned*)(F.lds + LDSCTL_OFF))[u] = 0u;
    __syncthreads();
    XcdBarrier bar; bar.bar = (unsigned*)(F.ctl + CW_BAR); bar.x = 0; bar.st = F.MISC + 8;
    if (args.use_bar) bar = xcd_barrier_post((unsigned*)(F.ctl + CW_BAR), F.MISC + 8);
    const int lo = args.ph_lo, hi = args.ph_hi;
    int pid = 0;
    unsigned char* ws_ = F.ws;
#define PH_ON (pid >= lo && pid < hi)
#define PH_END do { if (PH_ON && pid + 1 < hi) xcd_barrier(bar); ++pid; } while (0)

    if (PH_ON && !(SKIPM & 1)) phase_prologue(F, args);
    PH_END;
    for (int l = 0; l < DEPTH; ++l) {
        if (PH_ON && !(SKIPM & 2)) phase_gemm<0>(F, B_H, w_in_t(ws_, l), B_PROJ, NP, D);
        PH_END;
        if (PH_ON && !(SKIPM & 4)) phase_prep(F, args, l);
        PH_END;
        if (PH_ON && !(SKIPM & 8)) phase_attn(F, l);
        PH_END;
        if (PH_ON && !(SKIPM & 16)) phase_merge(F, args, l);
        PH_END;
        if (PH_ON && !(SKIPM & 32)) phase_gemm<0>(F, B_MIX, w_out_t(ws_, l), B_F, D, D);
        PH_END;
        if (PH_ON && !(SKIPM & 64)) phase_finish(F, l == 0 ? P_X_IN : F.out, P_G_POST_MIX + l * D, P_G_PRE_MLP + l * D);
        PH_END;
        if (PH_ON && !(SKIPM & 128)) phase_gemm<2>(F, B_H, w_up_t(ws_, l), B_HID, FF, D);
        PH_END;
        if (PH_ON && !(SKIPM & 256)) phase_gemm<0>(F, B_HID, w_dn_t(ws_, l), B_F, D, FF);
        PH_END;
        if (PH_ON && !(SKIPM & 512)) phase_finish(F, F.out, P_G_POST_MLP + l * D, (l + 1 < DEPTH) ? P_G_PRE_MIX + (l + 1) * D : nullptr);
        PH_END;
    }
#undef PH_ON
#undef PH_END
}

extern "C" void kernel_launch(void* const* d_in, const int* in_sizes, int n_in, void* d_out, int out_size, void* d_ws, size_t ws_size, hipStream_t stream) {
    static int grid = 0;
    if (grid == 0) {
        if (n_in != 20 || in_sizes[0] != M * D || out_size != M * D || ws_size < WS_END) {
            fprintf(stderr, "kernel_launch: unexpected shapes / workspace (n_in %d, in0 %d, out %d, ws %zu < %zu); nothing launched\n", n_in, n_in > 0 ? in_sizes[0] : -1, out_size, ws_size, (size_t)WS_END);
            grid = -1; return; }
        int dev = 0, cus = 0, per_cu = 0;
        if (hipGetDevice(&dev) != hipSuccess || hipDeviceGetAttribute(&cus, hipDeviceAttributeMultiprocessorCount, dev) != hipSuccess) { grid = -1; return; }
        if (hipFuncSetAttribute((const void*)mk_fwd, hipFuncAttributeMaxDynamicSharedMemorySize, LDS_BYTES) != hipSuccess) { fprintf(stderr, "kernel_launch: hipFuncSetAttribute failed\n"); grid = -1; return; }
        if (hipOccupancyMaxActiveBlocksPerMultiprocessor(&per_cu, (const void*)mk_fwd, NWAVES * 64, LDS_BYTES) != hipSuccess || per_cu < 1)
            fprintf(stderr, "kernel_launch: note: occupancy query reports %d workgroups per CU\n", per_cu);
        (void)hipGetLastError();
        grid = cus;
    }
    if (grid < 0) return;
    if (hipMemsetAsync((char*)d_ws + WS_CTL, 0, CTL_ZERO_BYTES, stream) != hipSuccess) return;
    Args a{};
    for (int i = 0; i < 20; ++i) a.in[i] = d_in[i];
    a.out = (float*)d_out; a.ws = (unsigned char*)d_ws; a.pad = 0;
#if MK_MULTI
    for (int p = 0; p < NPHASES; ++p) {
        a.ph_lo = p; a.ph_hi = p + 1; a.use_bar = 0;
        hipLaunchKernelGGL(mk_fwd, dim3(grid), dim3(NWAVES * 64), LDS_BYTES, stream, a);
    }
#else
    a.ph_lo = 0; a.ph_hi = NPHASES; a.use_bar = 1;
    hipLaunchKernelGGL(mk_fwd, dim3(grid), dim3(NWAVES * 64), LDS_BYTES, stream, a);
#endif
}
```

```cpp
#include <hip/hip_runtime.h>
#include <cstdio>
#include <cstdint>

#ifndef DIAG_NAIVE_ATTN
#define DIAG_NAIVE_ATTN 0
#endif
#ifndef SKIPM
#define SKIPM 0
#endif
#ifndef MK_MULTI
#define MK_MULTI 0
#endif

namespace pg8 {
#define PG8_LAS __attribute__((address_space(3)))
typedef unsigned short bf16_t;
typedef short bf16x8 __attribute__((ext_vector_type(8)));
typedef float f32x4 __attribute__((ext_vector_type(4)));
typedef unsigned u32x4 __attribute__((ext_vector_type(4)));
constexpr int BM = 256, BK = 64, HALF = 128, HTB = HALF * BK * 2, STAGE_BYTES = 8 * HTB, NXCD = 8, WGM = 8;

__host__ __device__ __forceinline__ int lds_byte(int r, int c) { const int st = (r >> 4) * 2 + (c >> 5), rr = r & 15, cc = c & 31, ob = rr * 64 + cc * 2; return st * 1024 + (ob ^ (((ob >> 9) & 1) << 5)); }
__host__ __device__ __forceinline__ void stage_rc(int b, int& R, int& C) { const int st = b / 1024, sb = b % 1024, swz = sb ^ (((sb >> 9) & 1) << 5); R = (st >> 1) * 16 + swz / 64; C = (st & 1) * 32 + (swz % 64) / 2; }
__host__ __device__ __forceinline__ int perm32(int rho) { const int n = rho >> 4, i = rho & 15; return 8 * (i >> 2) + 4 * n + (i & 3); }

struct Unit { int pm, pn; };
struct Gemm { const bf16_t* A; const bf16_t* Bt; int M, N, K; };

struct StaticOrder {
    int nM, nN, nwg, G, c;
    __host__ __device__ void init(int M, int N, int G_, int c_) { nM = M / BM; nN = N / BM; nwg = nM * nN; G = G_; c = c_; }
    __host__ __device__ bool next(int i, Unit& u) const {
        const long L = (long)i * G + c; if (L >= nwg) return false;
        int wgid = (int)L; { const int q = nwg / NXCD, r = nwg % NXCD, xcd = wgid % NXCD, off = wgid / NXCD; wgid = (xcd < r ? xcd * (q + 1) : r * (q + 1) + (xcd - r) * q) + off; }
        const int nig = WGM * nN, gid = wgid / nig, fm = gid * WGM, gsz = (nM - fm) < WGM ? (nM - fm) : WGM;
        u.pm = fm + ((wgid % nig) % gsz); u.pn = (wgid % nig) / gsz; return true;
    }
    __device__ __forceinline__ void a_ready(const Unit&) const {}
    __device__ __forceinline__ void done(const Unit&) const {}
};

__device__ __forceinline__ unsigned cvt_pk_bf16(float lo, float hi) { unsigned r; asm volatile("v_cvt_pk_bf16_f32 %0, %1, %2" : "=v"(r) : "v"(lo), "v"(hi)); return r; }

template <int ACT  > struct EpiStore {
    static constexpr bool PERM = true, AFTER_DRAIN = false;
    bf16_t* O; int ldc;
    __device__ __forceinline__ void operator()(const f32x4 (&acc)[2][2][4][2], const Unit& u, int wr, int wc, int fr, int fq) const {
        const int row0 = u.pm * BM + wr * 64 + fr;
        const int col0 = u.pn * BM + wc * 32 + 8 * fq;
#pragma unroll
        for (int ai = 0; ai < 2; ++ai)
#pragma unroll
            for (int m = 0; m < 4; ++m) { bf16_t* rowp = O + (size_t)(row0 + ai * HALF + m * 16) * ldc + col0;
#pragma unroll
                for (int bj = 0; bj < 2; ++bj) { f32x4 v0 = acc[ai][bj][m][0], v1 = acc[ai][bj][m][1];
                    if (ACT == 2) {
#pragma unroll
                        for (int e = 0; e < 4; ++e) { const float a = fmaxf(v0[e], 0.f), b = fmaxf(v1[e], 0.f); v0[e] = a * a; v1[e] = b * b; } }
                    u32x4 w; w.x = cvt_pk_bf16(v0[0], v0[1]); w.y = cvt_pk_bf16(v0[2], v0[3]); w.z = cvt_pk_bf16(v1[0], v1[1]); w.w = cvt_pk_bf16(v1[2], v1[3]);
                    *(u32x4*)(rowp + bj * HALF) = w; } }
    }
};

template <class Epi, class Sched, bool ALIGN_EPI = false, bool SP2 = false>
__device__ __forceinline__ void gemm_phase(PG8_LAS unsigned char* lds, const Gemm g, const Sched& S, const Epi& E) {
    int tid_ = threadIdx.x; asm volatile("" : "+v"(tid_));
    const int tid = tid_, wid = __builtin_amdgcn_readfirstlane(tid >> 6), lane = tid & 63, wr = wid >> 2, wc = wid & 3, fr = lane & 15, fq = lane >> 4;
    const int K = g.K, nt = K / BK;
    unsigned voffA[2], voffB[2];
#pragma unroll
    for (int i = 0; i < 2; ++i) { int R, C; stage_rc(tid * 16 + i * 8192, R, C); const int Rb = Epi::PERM ? ((R & ~31) + perm32(R & 31)) : R;
        voffA[i] = (unsigned)(R * K + C) * 2u; voffB[i] = (unsigned)(Rb * K + C) * 2u; }
    const size_t kstep = (size_t)(BK * 2);
    const size_t hstep = (size_t)HALF * K * 2;
    const size_t tstep = 2 * hstep;
    const unsigned ldsw = (unsigned)wid * 1024u;
    const int aoff = lds_byte(wr * 64 + fr, fq * 8), boff = lds_byte(wc * 32 + fr, fq * 8);
#define PG8_SA(b, h) (((b) * 2 + (h)) * HTB)
#define PG8_SB(b, h) ((4 + (b) * 2 + (h)) * HTB)
#define PG8_STAGE(bufoff, gbase, voff) do { _Pragma("unroll") for (int _i = 0; _i < 2; ++_i) \
        __builtin_amdgcn_global_load_lds((const unsigned*)((const char*)(gbase) + (voff)[_i]), (PG8_LAS unsigned*)(lds + (bufoff) + ldsw + _i * 8192), 16, 0, 0); } while (0)
#define PG8_LDA(dst, b, h) do { _Pragma("unroll") for (int m = 0; m < 4; ++m) _Pragma("unroll") for (int k = 0; k < 2; ++k) dst[m][k] = *(const PG8_LAS bf16x8*)(lds + PG8_SA(b, h) + aoff + m * 2048 + k * 1024); } while (0)
#define PG8_LDB(dst, b, h) do { _Pragma("unroll") for (int n = 0; n < 2; ++n) _Pragma("unroll") for (int k = 0; k < 2; ++k) dst[n][k] = *(const PG8_LAS bf16x8*)(lds + PG8_SB(b, h) + boff + n * 2048 + k * 1024); } while (0)
#define PG8_MMA(ai, bj, At, Bt) do { __builtin_amdgcn_s_setprio(1); _Pragma("unroll") for (int m = 0; m < 4; ++m) _Pragma("unroll") for (int n = 0; n < 2; ++n) _Pragma("unroll") for (int k = 0; k < 2; ++k) \
        acc[ai][bj][m][n] = __builtin_amdgcn_mfma_f32_16x16x32_bf16(Bt[n][k], At[m][k], acc[ai][bj][m][n], 0, 0, 0); __builtin_amdgcn_s_setprio(0); } while (0)
#define PG8_WAIT_V(n) asm volatile("s_waitcnt vmcnt(" #n ")" ::: "memory")
#define PG8_WAIT_L(n) asm volatile("s_waitcnt lgkmcnt(" #n ")" ::: "memory")
#define PG8_BAR __builtin_amdgcn_s_barrier()
#define PG8_SCHED __builtin_amdgcn_sched_barrier(0)
    Unit cur, nxt; int ui = 0;
    if (!S.next(0, cur)) return;
    f32x4 acc[2][2][4][2];
#pragma unroll
    for (int a = 0; a < 2; ++a)
#pragma unroll
        for (int b = 0; b < 2; ++b)
#pragma unroll
            for (int m = 0; m < 4; ++m)
#pragma unroll
                for (int n = 0; n < 2; ++n) acc[a][b][m][n] = (f32x4){0.f, 0.f, 0.f, 0.f};
    bf16x8 At[4][2], B0[2][2], B1[2][2];
    const char* cA = (const char*)g.A + (size_t)cur.pm * tstep; const char* cB = (const char*)g.Bt + (size_t)cur.pn * tstep;
    S.a_ready(cur);
    if constexpr (SP2) {
        PG8_STAGE(PG8_SB(0, 0), cB, voffB); PG8_STAGE(PG8_SB(0, 1), cB + hstep, voffB); PG8_STAGE(PG8_SA(0, 0), cA, voffA); PG8_STAGE(PG8_SA(0, 1), cA + hstep, voffA);
        if (wr == 1) PG8_BAR;
        PG8_WAIT_V(2); PG8_BAR;
        PG8_STAGE(PG8_SB(1, 0), cB + kstep, voffB); PG8_STAGE(PG8_SA(1, 0), cA + kstep, voffA); PG8_STAGE(PG8_SB(1, 1), cB + hstep + kstep, voffB);
        PG8_WAIT_V(6); PG8_BAR;
    } else {
        PG8_STAGE(PG8_SB(0, 0), cB, voffB); PG8_STAGE(PG8_SA(0, 0), cA, voffA); PG8_STAGE(PG8_SB(0, 1), cB + hstep, voffB); PG8_STAGE(PG8_SA(0, 1), cA + hstep, voffA);
        if (wr == 1) PG8_BAR;
        PG8_WAIT_V(4); PG8_BAR;
        PG8_STAGE(PG8_SB(1, 0), cB + kstep, voffB); PG8_STAGE(PG8_SA(1, 0), cA + kstep, voffA); PG8_STAGE(PG8_SB(1, 1), cB + hstep + kstep, voffB);
        PG8_WAIT_V(6); PG8_BAR;
    }
    for (;;) {
        const bool has_next = S.next(ui + 1, nxt);
        const char* nA = has_next ? (const char*)g.A + (size_t)nxt.pm * tstep : cA; const char* nB = has_next ? (const char*)g.Bt + (size_t)nxt.pn * tstep : cB;
        for (int t = 0; t < nt; t += 2) {
            const bool last = (t == nt - 2);
            const char* a1 = cA + (size_t)(t + 1) * kstep;
            const char* a2 = last ? nA : cA + (size_t)(t + 2) * kstep; const char* b2 = last ? nB : cB + (size_t)(t + 2) * kstep;
            const char* a3 = a2 + kstep; const char* b3 = b2 + kstep;
            if (last && has_next) S.a_ready(nxt);
            if constexpr (SP2) {
            PG8_LDB(B0, 0, 0); PG8_LDB(B1, 0, 1); PG8_SCHED; PG8_LDA(At, 0, 0); PG8_STAGE(PG8_SA(1, 1), a1 + hstep, voffA);
            PG8_WAIT_V(8); PG8_WAIT_L(0); PG8_BAR; PG8_MMA(0, 0, At, B0); PG8_MMA(0, 1, At, B1); PG8_BAR; PG8_SCHED;
            PG8_LDA(At, 0, 1); PG8_STAGE(PG8_SB(0, 0), b2, voffB); PG8_STAGE(PG8_SB(0, 1), b2 + hstep, voffB); PG8_STAGE(PG8_SA(0, 0), a2, voffA);
            PG8_WAIT_V(8); PG8_WAIT_L(0); PG8_BAR; PG8_MMA(1, 0, At, B0); PG8_MMA(1, 1, At, B1); PG8_BAR; PG8_SCHED;
            PG8_LDB(B0, 1, 0); PG8_LDB(B1, 1, 1); PG8_SCHED; PG8_LDA(At, 1, 0); PG8_STAGE(PG8_SA(0, 1), a2 + hstep, voffA);
            PG8_WAIT_V(8); PG8_WAIT_L(0); PG8_BAR; PG8_MMA(0, 0, At, B0); PG8_MMA(0, 1, At, B1); PG8_BAR; PG8_SCHED;
            PG8_LDA(At, 1, 1); PG8_STAGE(PG8_SB(1, 0), b3, voffB); PG8_STAGE(PG8_SB(1, 1), b3 + hstep, voffB); PG8_STAGE(PG8_SA(1, 0), a3, voffA);
            PG8_WAIT_V(8); PG8_WAIT_L(0); PG8_BAR; PG8_MMA(1, 0, At, B0); PG8_MMA(1, 1, At, B1); PG8_BAR; PG8_SCHED;
            } else {
            PG8_LDB(B0, 0, 0); PG8_SCHED; PG8_LDA(At, 0, 0); PG8_STAGE(PG8_SA(1, 1), a1 + hstep, voffA);
            PG8_WAIT_L(8); PG8_BAR; PG8_WAIT_L(0); PG8_MMA(0, 0, At, B0); PG8_BAR; PG8_SCHED;
            PG8_LDB(B1, 0, 1); PG8_STAGE(PG8_SB(0, 0), b2, voffB);
            PG8_BAR; PG8_WAIT_L(0); PG8_MMA(0, 1, At, B1); PG8_BAR;
            PG8_LDA(At, 0, 1); PG8_STAGE(PG8_SA(0, 0), a2, voffA);
            PG8_BAR; PG8_WAIT_L(0); PG8_MMA(1, 0, At, B0); PG8_BAR; PG8_SCHED;
            PG8_STAGE(PG8_SB(0, 1), b2 + hstep, voffB);
            PG8_WAIT_V(6); PG8_BAR; PG8_MMA(1, 1, At, B1); PG8_BAR;
            PG8_LDB(B0, 1, 0); PG8_SCHED; PG8_LDA(At, 1, 0); PG8_STAGE(PG8_SA(0, 1), a2 + hstep, voffA);
            PG8_WAIT_L(8); PG8_BAR; PG8_WAIT_L(0); PG8_MMA(0, 0, At, B0); PG8_BAR; PG8_SCHED;
            PG8_LDB(B1, 1, 1); PG8_STAGE(PG8_SB(1, 0), b3, voffB);
            PG8_BAR; PG8_WAIT_L(0); PG8_MMA(0, 1, At, B1); PG8_BAR;
            PG8_LDA(At, 1, 1); PG8_STAGE(PG8_SA(1, 0), a3, voffA);
            PG8_BAR; PG8_WAIT_L(0); PG8_MMA(1, 0, At, B0); PG8_BAR; PG8_SCHED;
            PG8_STAGE(PG8_SB(1, 1), b3 + hstep, voffB);
            PG8_WAIT_V(6); PG8_BAR; PG8_MMA(1, 1, At, B1); PG8_BAR;
            }
        }
        if constexpr (ALIGN_EPI) { if (wr == 0) PG8_BAR; }
        if constexpr (!Epi::AFTER_DRAIN) { E(acc, cur, wr, wc, fr, fq); S.done(cur); }
        if (!has_next) break;
#pragma unroll
        for (int a = 0; a < 2; ++a)
#pragma unroll
            for (int b = 0; b < 2; ++b)
#pragma unroll
                for (int m = 0; m < 4; ++m)
#pragma unroll
                    for (int n = 0; n < 2; ++n) acc[a][b][m][n] = (f32x4){0.f, 0.f, 0.f, 0.f};
        cur = nxt; cA = nA; cB = nB; ++ui;
        if constexpr (ALIGN_EPI) { if (wr == 1) PG8_BAR; }
    }
    PG8_WAIT_V(0);
    if constexpr (!ALIGN_EPI) { if (wr == 0) PG8_BAR; }
    PG8_BAR;
#undef PG8_SA
#undef PG8_SB
#undef PG8_STAGE
#undef PG8_LDA
#undef PG8_LDB
#undef PG8_MMA
#undef PG8_WAIT_V
#undef PG8_WAIT_L
#undef PG8_BAR
#undef PG8_SCHED
}
}

constexpr int NWAVES = 8;
constexpr int BATCH = 32, S = 2048, D = 1024, DEPTH = 4, FF = 4096;
constexpr int M = BATCH * S;
constexpr int NP = 2304;
constexpr int DIN = 2108;
constexpr int C_QA = 0, C_CKV = 256, C_QIDX = 384, C_QB = 512, C_KCMP = 1024, C_VCMP = 1152, C_KSLC = 1280, C_VSLC = 1408, C_KWIN = 1536, C_VWIN = 1664,
              C_UC = 1792, C_KIDX = 2048, C_WIDX = 2080, C_GATE = 2084;
constexpr int NC = 127;
constexpr float EPS = 1e-6f;
constexpr float NEGF = -1e30f;

__host__ __device__ __forceinline__ int win_src(int n) {
    if (n < 512) return n;
    if (n < 1024) return 548 + (n - 512);
    if (n < 1792) return 1060 + (n - 1024);
    if (n < 2048) return 1852 + (n - 1792);
    if (n < 2080) return 512 + (n - 2048);
    if (n < 2084) return 544 + (n - 2080);
    if (n < 2108) return 1828 + (n - 2084);
    return -1;
}

constexpr size_t MiB = 1u << 20;
constexpr size_t WS_CTL = 0, CTL_ZERO_BYTES = 1 * MiB;
constexpr size_t WS_W = 2 * MiB;
constexpr size_t W_IN_B = (size_t)NP * D * 2, W_OUT_B = (size_t)D * D * 2, W_UP_B = (size_t)FF * D * 2, W_DN_B = (size_t)D * FF * 2;
constexpr size_t W_LAYER_B = W_IN_B + W_OUT_B + W_UP_B + W_DN_B;
constexpr size_t WS_ROPE = 96 * MiB;
constexpr size_t WS_KC = 102 * MiB, WS_VC = 105 * MiB;
constexpr size_t WS_KA = 108 * MiB;
constexpr size_t WS_H = 128 * MiB;
constexpr size_t WS_F = 256 * MiB;
constexpr size_t WS_PROJ = 384 * MiB;
constexpr size_t WS_MIX = 672 * MiB;
constexpr size_t WS_MASK = 800 * MiB;
constexpr size_t WS_HID = 384 * MiB;
constexpr size_t WS_END = 896 * MiB;
static_assert(WS_W + DEPTH * W_LAYER_B <= WS_ROPE, "weights");
static_assert(WS_ROPE + (size_t)M * 24 * 4 <= WS_KC && WS_KC + (size_t)BATCH * NC * 128 * 4 <= WS_VC && WS_VC + (size_t)BATCH * NC * 128 * 4 <= WS_KA && WS_KA + (size_t)M * 128 * 2 <= WS_H, "map");
static_assert(WS_PROJ + (size_t)M * NP * 2 <= WS_MIX && WS_MIX + (size_t)M * D * 2 <= WS_END && WS_HID + (size_t)M * FF * 2 <= WS_END, "map2");

constexpr int CW_BAR = 4096;
constexpr int RING_BYTES = 131072;
constexpr int LDSCTL_OFF = RING_BYTES, MISC_OFF = LDSCTL_OFF + 320;
constexpr int LDS_BYTES = 147456;
constexpr int WSCR = 16384;

#define GAS __attribute__((address_space(1)))
#define LAS __attribute__((address_space(3)))
typedef unsigned short bf16;
typedef unsigned v4u __attribute__((ext_vector_type(4)));
typedef float f32x4 __attribute__((ext_vector_type(4)));
typedef GAS unsigned gu32;
#define LDS_FENCE() asm volatile("s_waitcnt lgkmcnt(0)" ::: "memory")
__device__ __forceinline__ unsigned f2bf(float f) { unsigned u = __builtin_bit_cast(unsigned, f); return (u + 0x7fffu + ((u >> 16) & 1u)) >> 16; }
__device__ __forceinline__ unsigned pk2(float lo, float hi) { return f2bf(lo) | (f2bf(hi) << 16); }
__device__ __forceinline__ float bf2f(bf16 u) { return __builtin_bit_cast(float, (unsigned)u << 16); }
__device__ __forceinline__ float bflo(unsigned u) { return __builtin_bit_cast(float, u << 16); }
__device__ __forceinline__ float bfhi(unsigned u) { return __builtin_bit_cast(float, u & 0xffff0000u); }

#define XB_TMO      128
#define XB_XCNT(j)  (256  + 64 * (j))
#define XB_XSUB(j)  (1280 + 64 * (j))
#define XB_XGEN(j)  (2304 + 64 * (j))
#define XB_TOP      3328
#define XB_TOPGEN   3392
#define XCD_BAR_WORDS 3456
#define XB_SPIN_CAP (1u << 22)

__device__ __forceinline__ unsigned xb_ld(unsigned* p)              { return __hip_atomic_load(p, __ATOMIC_RELAXED, __HIP_MEMORY_SCOPE_AGENT); }
__device__ __forceinline__ unsigned xb_add(unsigned* p, unsigned v) { return __hip_atomic_fetch_add(p, v, __ATOMIC_RELAXED, __HIP_MEMORY_SCOPE_AGENT); }
__device__ __forceinline__ unsigned xb_xcc_id() { return (unsigned)__builtin_amdgcn_s_getreg((3 << 11) | 20) & 0xFu; }
#define XB_SPIN(cond, bar) do { unsigned _sp = 0; while (cond) { __builtin_amdgcn_s_sleep(1); \
    if ((++_sp & 255u) == 0u) { if (xb_ld(&(bar)[XB_TMO])) break; if (_sp > XB_SPIN_CAP) { atomicAdd(&(bar)[XB_TMO], 1u); break; } } } } while (0)

struct XcdBarrier { unsigned* bar; unsigned x; volatile LAS unsigned* st; };

__device__ __forceinline__ XcdBarrier xcd_barrier_post(unsigned* bar, volatile LAS unsigned* st) {
    XcdBarrier b; b.bar = bar; b.x = xb_xcc_id(); b.st = st;
    if (threadIdx.x == 0) (void)xb_add(&bar[XB_XCNT(b.x)], 1u);
    return b;
}
__device__ __forceinline__ void xcd_barrier_complete(unsigned* bar, unsigned x, unsigned& nloc, unsigned& nx) {
    const unsigned G = gridDim.x * gridDim.y * gridDim.z;
    unsigned sum, cnt, mine, sp = 0u;
    for (;;) {
        sum = 0u; cnt = 0u; mine = 0u;
#pragma unroll
        for (unsigned j = 0; j < 16; ++j) { const unsigned c = xb_ld(&bar[XB_XCNT(j)]); sum += c; cnt += (c > 0u) ? 1u : 0u; mine = (j == x) ? c : mine; }
        if (sum == G) break;
        __builtin_amdgcn_s_sleep(1);
        if ((++sp & 255u) == 0u) { if (xb_ld(&bar[XB_TMO])) break; if (sp > XB_SPIN_CAP) { atomicAdd(&bar[XB_TMO], 1u); break; } }
    }
    nloc = mine > 0u ? mine : 1u; nx = cnt > 0u ? cnt : 1u;
}
__device__ __forceinline__ void xcd_barrier(const XcdBarrier& b) {
    asm volatile("s_waitcnt vmcnt(0)" ::: "memory");
    __syncthreads();
    if (threadIdx.x == 0) {
        unsigned* bar = b.bar; asm volatile("" : "+s"(bar));
        __builtin_amdgcn_s_waitcnt(0);
        unsigned nloc = b.st[0], nx = b.st[1];
        if (nloc == 0u) { xcd_barrier_complete(bar, b.x, nloc, nx); b.st[0] = nloc; b.st[1] = nx; }
        const unsigned old = xb_add(&bar[XB_XSUB(b.x)], 1u);
        const unsigned gen = old / nloc;
        if (old + 1u == (gen + 1u) * nloc) {
            __builtin_amdgcn_fence(__ATOMIC_RELEASE, "agent");
            asm volatile("s_waitcnt vmcnt(0)" ::: "memory");
            const unsigned og = xb_add(&bar[XB_TOP], 1u);
            const unsigned tg = og / nx;
            if (og + 1u == (tg + 1u) * nx) xb_add(&bar[XB_TOPGEN], 1u);
            else XB_SPIN(xb_ld(&bar[XB_TOPGEN]) == tg, bar);
            __builtin_amdgcn_fence(__ATOMIC_ACQUIRE, "agent");
            xb_add(&bar[XB_XGEN(b.x)], 1u);
            asm volatile("s_waitcnt vmcnt(0)" ::: "memory");
        } else {
            XB_SPIN(xb_ld(&bar[XB_XGEN(b.x)]) == gen, bar);
            __builtin_amdgcn_fence(__ATOMIC_ACQUIRE, "agent");
            asm volatile("s_waitcnt vmcnt(0)" ::: "memory");
        }
    }
    __syncthreads();
}

struct Frame {
    LAS unsigned char* lds;
    volatile LAS unsigned* MISC;
    gu32* ctl;
    int tid, lane, wave, vcu, G;
    float* out; unsigned char* ws;
};
struct Args { const void* in[20]; float* out; unsigned char* ws; int ph_lo, ph_hi, use_bar, pad; };
#define IN_F(k) ((const float*)args.in[k])
#define P_X_IN IN_F(0)
#define P_POS ((const int*)args.in[1])
#define P_W_IN IN_F(2)
#define P_G_KV_A IN_F(3)
#define P_W_KV_UP IN_F(4)
#define P_W_CMP_K IN_F(5)
#define P_W_CMP_V IN_F(6)
#define P_PE_K IN_F(7)
#define P_PE_V IN_F(8)
#define P_W_POOL IN_F(9)
#define P_POOL_SCALE IN_F(10)
#define P_G_OUT_A IN_F(11)
#define P_G_OUT_B IN_F(12)
#define P_W_OUT IN_F(13)
#define P_G_PRE_MIX IN_F(14)
#define P_G_POST_MIX IN_F(15)
#define P_G_PRE_MLP IN_F(16)
#define P_G_POST_MLP IN_F(17)
#define P_W_UP IN_F(18)
#define P_W_DOWN IN_F(19)
#define B_ROPE ((float*)(ws_ + WS_ROPE))
#define B_KC ((float*)(ws_ + WS_KC))
#define B_VC ((float*)(ws_ + WS_VC))
#define B_KA ((bf16*)(ws_ + WS_KA))
#define B_H ((bf16*)(ws_ + WS_H))
#define B_F ((bf16*)(ws_ + WS_F))
#define B_PROJ ((bf16*)(ws_ + WS_PROJ))
#define B_MIX ((bf16*)(ws_ + WS_MIX))
#define B_HID ((bf16*)(ws_ + WS_HID))

__device__ __forceinline__ float wave_sum(float v) {
#pragma unroll
    for (int o = 1; o < 64; o <<= 1) v += __shfl_xor(v, o);
    return v;
}
__device__ __forceinline__ float wave_max(float v) {
#pragma unroll
    for (int o = 1; o < 64; o <<= 1) v = fmaxf(v, __shfl_xor(v, o));
    return v;
}
__device__ __forceinline__ int wave_sum_i(int v) {
#pragma unroll
    for (int o = 1; o < 64; o <<= 1) v += __shfl_xor(v, o);
    return v;
}

__constant__ double c_rope_inv[12] = {1.0, 0.19392274474868576, 0.03760603093086393, 0.007292664737217109, 0.001414213562373095, 0.0002742481756762073, 5.318295896944988e-05, 1.031338537721246e-05,
                                       1.0, 0.03760603093086393, 0.001414213562373095, 5.318295896944988e-05};
template <int MODE>
__device__ __forceinline__ void transpose_item(const float* W, int K, int Nsrc, int nblk, bf16* WT, LAS float* scr, int item, int lane) {
    const int kb = item / nblk, nb = item % nblk, k0 = 64 * kb, n0 = 32 * nb;
    const int np = n0 + (lane & 31);
    const int src = MODE ? win_src(np) : np;
#pragma unroll 8
    for (int i = 0; i < 32; ++i) { const int kk = 2 * i + (lane >> 5); scr[kk * 33 + (lane & 31)] = (src >= 0) ? W[(size_t)(k0 + kk) * Nsrc + src] : 0.f; }
    LDS_FENCE();
    const int c = lane & 7;
#pragma unroll
    for (int j = 0; j < 4; ++j) { const int n = (lane >> 3) + 8 * j; const LAS float* s = scr + (8 * c) * 33 + n;
        v4u o; o.x = pk2(s[0 * 33], s[1 * 33]); o.y = pk2(s[2 * 33], s[3 * 33]); o.z = pk2(s[4 * 33], s[5 * 33]); o.w = pk2(s[6 * 33], s[7 * 33]);
        *(v4u*)(WT + (size_t)(n0 + n) * K + k0 + 8 * c) = o; }
    LDS_FENCE();
}

__device__ __forceinline__ bf16* w_in_t(unsigned char* ws_, int l)  { return (bf16*)(ws_ + WS_W + (size_t)l * W_LAYER_B); }
__device__ __forceinline__ bf16* w_out_t(unsigned char* ws_, int l) { return (bf16*)(ws_ + WS_W + (size_t)l * W_LAYER_B + W_IN_B); }
__device__ __forceinline__ bf16* w_up_t(unsigned char* ws_, int l)  { return (bf16*)(ws_ + WS_W + (size_t)l * W_LAYER_B + W_IN_B + W_OUT_B); }
__device__ __forceinline__ bf16* w_dn_t(unsigned char* ws_, int l)  { return (bf16*)(ws_ + WS_W + (size_t)l * W_LAYER_B + W_IN_B + W_OUT_B + W_UP_B); }

__device__ __forceinline__ void norm_row_to_bf16(const float* xrow, const float* gain, bf16* orow, int lane) {
    const f32x4* xr = (const f32x4*)xrow + lane;
    f32x4 v[4]; float s = 0.f;
#pragma unroll
    for (int j = 0; j < 4; ++j) { v[j] = xr[64 * j]; s += (v[j].x * v[j].x + v[j].y * v[j].y) + (v[j].z * v[j].z + v[j].w * v[j].w); }
    const float rs = rsqrtf(wave_sum(s) * (1.f / D) + EPS);
    unsigned long long* o8 = (unsigned long long*)orow + lane;
#pragma unroll
    for (int j = 0; j < 4; ++j) { const f32x4 g = ((const f32x4*)gain)[lane + 64 * j];
        o8[64 * j] = (unsigned long long)pk2(v[j].x * rs * g.x, v[j].y * rs * g.y) | ((unsigned long long)pk2(v[j].z * rs * g.z, v[j].w * rs * g.w) << 32); }
}

__device__ __forceinline__ void phase_prologue(Frame& F, const Args& args) {
    unsigned char* ws_ = F.ws; asm volatile("" : "+s"(ws_)); int lane_ = F.lane; asm volatile("" : "+v"(lane_)); (void)ws_;
    LAS float* scr = (LAS float*)(F.lds + F.wave * WSCR);
    const int gw = F.vcu * NWAVES + F.wave, NGW = F.G * NWAVES;
    constexpr int I_IN = (D / 64) * (NP / 32), I_OUT = (D / 64) * (D / 32), I_UP = (D / 64) * (FF / 32), I_DN = (FF / 64) * (D / 32);
    for (int it = gw; it < DEPTH * I_IN; it += NGW) { const int l = it / I_IN, r = it % I_IN; transpose_item<1>(P_W_IN + (size_t)l * D * DIN, D, DIN, NP / 32, w_in_t(ws_, l), scr, r, lane_); }
    for (int it = gw; it < DEPTH * I_OUT; it += NGW) { const int l = it / I_OUT, r = it % I_OUT; transpose_item<0>(P_W_OUT + (size_t)l * D * D, D, D, D / 32, w_out_t(ws_, l), scr, r, lane_); }
    for (int it = gw; it < DEPTH * I_UP; it += NGW) { const int l = it / I_UP, r = it % I_UP; transpose_item<0>(P_W_UP + (size_t)l * D * FF, D, FF, FF / 32, w_up_t(ws_, l), scr, r, lane_); }
    for (int it = gw; it < DEPTH * I_DN; it += NGW) { const int l = it / I_DN, r = it % I_DN; transpose_item<0>(P_W_DOWN + (size_t)l * FF * D, FF, D, D / 32, w_dn_t(ws_, l), scr, r, lane_); }
    for (int e = gw * 64 + lane_; e < M * 12; e += NGW * 64) {
        const int row = e / 12, i = e % 12;
        const double inv = c_rope_inv[i];
        const double a = (double)P_POS[row] * inv;
        const double k = __builtin_rint(a * 0.15915494309189535);
        const float r = (float)(a - k * 6.283185307179586);
        const float c = __builtin_cosf(r), s = __builtin_sinf(r);
        float* t = B_ROPE + (size_t)row * 24;
        if (i < 8) { t[i] = c; t[8 + i] = s; } else { t[16 + (i - 8)] = c; t[20 + (i - 8)] = s; }
    }
    for (int m = gw; m < M; m += NGW) norm_row_to_bf16(P_X_IN + (size_t)m * D, P_G_PRE_MIX, B_H + (size_t)m * D, lane_);
}

__device__ __forceinline__ void phase_prep(Frame& F, const Args& args, int l) {
    unsigned char* ws_ = F.ws; asm volatile("" : "+s"(ws_)); int lane_ = F.lane; asm volatile("" : "+v"(lane_)); (void)ws_;
    LAS float* xs = (LAS float*)(F.lds + F.wave * WSCR);
    const int gw = F.vcu * NWAVES + F.wave, NGW = F.G * NWAVES, lane = lane_;
    const float* gkv = P_G_KV_A + l * 128; const float* Wkv = P_W_KV_UP + (size_t)l * 128 * 128;
    for (int row = gw; row < M; row += NGW) {
        bf16* prow = B_PROJ + (size_t)row * NP;
        const float* tab = B_ROPE + (size_t)row * 24;
        const unsigned u = *(const unsigned*)(prow + C_CKV + 2 * lane);
        const float x0 = bflo(u), x1 = bfhi(u);
        const float rs = rsqrtf(wave_sum(x0 * x0 + x1 * x1) * (1.f / 128.f) + EPS);
        xs[2 * lane] = x0 * rs * gkv[2 * lane]; xs[2 * lane + 1] = x1 * rs * gkv[2 * lane + 1];
        LDS_FENCE();
        float a0 = 0.f, a1 = 0.f;
#pragma unroll 8
        for (int k = 0; k < 128; ++k) { const float xv = xs[k]; a0 += xv * Wkv[k * 128 + lane]; a1 += xv * Wkv[k * 128 + 64 + lane]; }
        LDS_FENCE();
        {
            const float partner = __shfl_xor(a0, 8);
            const int i = lane & 7; const float c = tab[i], s = tab[8 + i];
            float kr = a0;
            if (lane < 8) kr = a0 * c - partner * s; else if (lane < 16) kr = partner * s + a0 * c;
            B_KA[(size_t)row * 128 + lane] = (bf16)f2bf(kr); B_KA[(size_t)row * 128 + 64 + lane] = (bf16)f2bf(a1);
        }
        if (lane < 4) { const int i = lane; const float c = tab[16 + i], s = tab[20 + i];
            const float x1v = bf2f(prow[C_KIDX + i]), x2v = bf2f(prow[C_KIDX + 4 + i]);
            prow[C_KIDX + i] = (bf16)f2bf(x1v * c - x2v * s); prow[C_KIDX + 4 + i] = (bf16)f2bf(x1v * s + x2v * c);
        } else if (lane < 36) { const int idx = lane - 4, which = idx >> 3, i = idx & 7; const int base = ((which < 2) ? C_KSLC : C_KWIN) + (which & 1) * 64;
            const float c = tab[i], s = tab[8 + i];
            const float x1v = bf2f(prow[base + i]), x2v = bf2f(prow[base + 8 + i]);
            prow[base + i] = (bf16)f2bf(x1v * c - x2v * s); prow[base + 8 + i] = (bf16)f2bf(x1v * s + x2v * c);
        }
    }
    for (int it = gw; it < BATCH * NC * 2; it += NGW) {
        const int kv = it & 1, bc = it >> 1, b = bc / NC, c = bc % NC;
        const float* W = (kv ? P_W_CMP_V : P_W_CMP_K) + (size_t)l * 32 * 64 * 64;
        const float* pe = (kv ? P_PE_V : P_PE_K) + l * 32 * 64;
        float acc0 = 0.f, acc1 = 0.f;
        for (int li = 0; li < 32; ++li) {
            const bf16* prow = B_PROJ + (size_t)(b * S + 16 * c + li) * NP + (kv ? C_VCMP : C_KCMP);
            const float pev = pe[li * 64 + lane];
            const float xv0 = bf2f(prow[lane]) + pev, xv1 = bf2f(prow[64 + lane]) + pev;
            const float* Wl = W + (size_t)li * 64 * 64 + lane;
#pragma unroll 16
            for (int d = 0; d < 64; ++d) { const float w = Wl[d * 64]; acc0 += __shfl(xv0, d) * w; acc1 += __shfl(xv1, d) * w; }
        }
        float* o = (kv ? B_VC : B_KC) + ((size_t)(b * NC + c) * 2) * 64;
        o[lane] = acc0; o[64 + lane] = acc1;
    }
}

__device__ __forceinline__ void dsa_token(unsigned char* ws_, int lane_, int b, int t, LAS unsigned char* scr) {
    const int lane = lane_;
    const size_t row = (size_t)b * S + t;
    const bf16* prow = B_PROJ + row * NP;
    LAS float* sc = (LAS float*)scr;
    LAS unsigned* ku = (LAS unsigned*)scr;
    LAS float* qi = (LAS float*)(scr + 8192);
    LAS float* qa = (LAS float*)(scr + 8192 + 512);
    LAS int* list = (LAS int*)(scr + 8192 + 512 + 1024);
    LAS float* pp = (LAS float*)(scr + 8192 + 512 + 1024 + 1024);
    const float* tab = B_ROPE + row * 24;
    { const unsigned u = *(const unsigned*)(prow + C_QIDX + 2 * lane); qi[2 * lane] = bflo(u); qi[2 * lane + 1] = bfhi(u); }
#pragma unroll
    for (int j = 0; j < 2; ++j) { const unsigned u = *(const unsigned*)(prow + C_QA + 2 * lane + 128 * j); qa[2 * lane + 128 * j] = bflo(u); qa[2 * lane + 128 * j + 1] = bfhi(u); }
    LDS_FENCE();
    if (lane < 16) { const int h = lane >> 2, i = lane & 3; const float c = tab[16 + i], s = tab[20 + i]; const float x1 = qi[h * 32 + i], x2 = qi[h * 32 + 4 + i];
        qi[h * 32 + i] = x1 * c - x2 * s; qi[h * 32 + 4 + i] = x1 * s + x2 * c; }
    if (lane >= 32) { const int h = (lane - 32) >> 3, i = lane & 7; const float c = tab[i], s = tab[8 + i]; const float x1 = qa[h * 64 + i], x2 = qa[h * 64 + 8 + i];
        qa[h * 64 + i] = x1 * c - x2 * s; qa[h * 64 + 8 + i] = x1 * s + x2 * c; }
    LDS_FENCE();
    const int nk = t + 1;
    int nsel;
    {
        const unsigned* mr = (const unsigned*)(ws_ + WS_MASK) + row * 64;
        int pos = 0;
        const unsigned long long lt = (1ull << lane) - 1ull;
        for (int s0 = 0; s0 < nk; s0 += 64) {
            const int s = s0 + lane; const bool in = s < nk;
            const bool sel = in && ((mr[s >> 5] >> (s & 31)) & 1u);
            const unsigned long long bsel = __ballot(sel);
            const int pp_ = pos + __popcll(bsel & lt);
            if (sel && pp_ < 256) list[pp_] = s;
            pos += __popcll(bsel);
        }
        nsel = pos < 256 ? pos : 256;
    }
    LDS_FENCE();
    const bf16* kab = B_KA + (size_t)b * S * 128;
    float lg[4][4];
#pragma unroll
    for (int i = 0; i < 4; ++i) {
        const int e = lane + 64 * i;
#pragma unroll
        for (int h = 0; h < 4; ++h) lg[i][h] = NEGF;
        if (e < nsel) {
            const int s = list[e];
            const v4u* kp = (const v4u*)(kab + (size_t)s * 128);
            float acc[4] = {0.f, 0.f, 0.f, 0.f};
#pragma unroll
            for (int q = 0; q < 8; ++q) { const v4u kk = kp[q]; float kf[8];
                kf[0] = bflo(kk.x); kf[1] = bfhi(kk.x); kf[2] = bflo(kk.y); kf[3] = bfhi(kk.y); kf[4] = bflo(kk.z); kf[5] = bfhi(kk.z); kf[6] = bflo(kk.w); kf[7] = bfhi(kk.w);
#pragma unroll
                for (int h = 0; h < 4; ++h)
#pragma unroll
                    for (int dd = 0; dd < 8; ++dd) acc[h] += qa[h * 64 + 8 * q + dd] * kf[dd]; }
#pragma unroll
            for (int h = 0; h < 4; ++h) lg[i][h] = acc[h] * 0.125f;
        }
    }
#pragma unroll
    for (int h = 0; h < 4; ++h) {
        float m = fmaxf(fmaxf(lg[0][h], lg[1][h]), fmaxf(lg[2][h], lg[3][h])); m = wave_max(m);
        float p[4], sum = 0.f;
#pragma unroll
        for (int i = 0; i < 4; ++i) { p[i] = (lane + 64 * i < nsel) ? __expf(lg[i][h] - m) : 0.f; sum += p[i]; }
        sum = wave_sum(sum); const float inv = 1.f / sum;
#pragma unroll
        for (int i = 0; i < 4; ++i) pp[(lane + 64 * i) * 4 + h] = p[i] * inv;
    }
    LDS_FENCE();
    float o[4] = {0.f, 0.f, 0.f, 0.f};
    for (int e = 0; e < nsel; ++e) {
        const int s = list[e];
        const float v = bf2f(kab[(size_t)s * 128 + 64 + lane]);
        const f32x4 p4 = *(const LAS f32x4*)(pp + e * 4);
        o[0] += p4.x * v; o[1] += p4.y * v; o[2] += p4.z * v; o[3] += p4.w * v;
    }
    bf16* orow = B_MIX + row * D;
#pragma unroll
    for (int h = 0; h < 4; ++h) orow[h * 64 + lane] = (bf16)f2bf(o[h]);
    LDS_FENCE();
}


typedef short bf16x8 __attribute__((ext_vector_type(8)));
typedef short s16x4 __attribute__((ext_vector_type(4)));
typedef float f32x16 __attribute__((ext_vector_type(16)));
#define MFMA32(a, b, c) __builtin_amdgcn_mfma_f32_32x32x16_bf16((a), (b), (c), 0, 0, 0)
__device__ __forceinline__ int crow(int r, int hi) { return (r & 3) + 8 * (r >> 2) + 4 * hi; }
__device__ __forceinline__ void wg_barrier() { asm volatile("s_waitcnt lgkmcnt(0)\n\ts_barrier" ::: "memory"); }
__device__ __forceinline__ unsigned cvtpk(float lo, float hi) { unsigned r; asm("v_cvt_pk_bf16_f32 %0, %1, %2" : "=v"(r) : "v"(lo), "v"(hi)); return r; }
constexpr float C2 = 0.125f * 1.4426950408889634f;

__device__ __forceinline__ unsigned idxmask(int x, int hi) {
    unsigned m = 0u;
#pragma unroll
    for (int g = 0; g < 4; ++g) { int n = x - (8 * g + 4 * hi); n = n < 0 ? 0 : (n > 4 ? 4 : n); m |= ((1u << n) - 1u) << (4 * g); }
    return m;
}

constexpr int SEL_QF = 0, SEL_PART = 16384;
__device__ __forceinline__ void dsa_select_unit(unsigned char* ws_, int tid_, int b, int qt32, LAS unsigned char* lds) {
    const int lane = tid_ & 63, wid = __builtin_amdgcn_readfirstlane(tid_ >> 6), r32 = lane & 31, hi = lane >> 5;
    unsigned* maskbuf = (unsigned*)(ws_ + WS_MASK);
    if (qt32 < 8) {
        for (int i = tid_; i < 2048; i += 512) { const int qq = i >> 6, blk = i & 63; const int t = 32 * qt32 + qq; const int d = t - 32 * blk;
            const unsigned w = d < 0 ? 0u : (d >= 31 ? 0xffffffffu : ((2u << d) - 1u));
            maskbuf[((size_t)b * S + t) * 64 + blk] = w; }
        return;
    }
    const size_t qrow = (size_t)b * S + 32 * qt32 + r32;
    const bf16* prow = B_PROJ + qrow * NP;
    {
        const int h = wid >> 1, sk = wid & 1;
        const v4u raw = *(const v4u*)(prow + C_QIDX + h * 32 + 16 * sk + 8 * hi);
        float x[8] = {bflo(raw.x), bfhi(raw.x), bflo(raw.y), bfhi(raw.y), bflo(raw.z), bfhi(raw.z), bflo(raw.w), bfhi(raw.w)};
        if (sk == 0 && hi == 0) { const float* tab = B_ROPE + qrow * 24;
#pragma unroll
            for (int i = 0; i < 4; ++i) { const float c = tab[16 + i], sn = tab[20 + i]; const float x1 = x[i], x2 = x[4 + i]; x[i] = x1 * c - x2 * sn; x[4 + i] = x1 * sn + x2 * c; } }
        v4u hp, lp;
        { unsigned hh[4], ll[4];
#pragma unroll
          for (int k = 0; k < 4; ++k) { const float a = x[2 * k], bb = x[2 * k + 1]; const unsigned ha = f2bf(a), hb = f2bf(bb); hh[k] = ha | (hb << 16);
              ll[k] = pk2(a - bf2f((bf16)ha), bb - bf2f((bf16)hb)); }
          hp = (v4u){hh[0], hh[1], hh[2], hh[3]}; lp = (v4u){ll[0], ll[1], ll[2], ll[3]}; }
        LAS v4u* qf = (LAS v4u*)(lds + SEL_QF);
        qf[((h * 2 + sk) * 2 + 0) * 64 + lane] = hp; qf[((h * 2 + sk) * 2 + 1) * 64 + lane] = lp;
    }
    float w[4];
#pragma unroll
    for (int h = 0; h < 4; ++h) w[h] = bf2f(prow[C_WIDX + h]);
    __syncthreads();
    const int nblk = qt32 + 1;
    const bf16* kbase = B_PROJ + (size_t)b * S * NP + C_KIDX;
    unsigned key[8][16];
#pragma unroll
    for (int i = 0; i < 8; ++i) {
        const int blk = wid + 8 * i;
        if (blk < nblk) {
            const bf16* kp = kbase + (size_t)(32 * blk + r32) * NP + 8 * hi;
            const bf16x8 kf0 = *(const bf16x8*)kp, kf1 = *(const bf16x8*)(kp + 16);
            float sc[16];
            const LAS bf16x8* qf = (const LAS bf16x8*)(lds + SEL_QF);
#pragma unroll
            for (int h = 0; h < 4; ++h) {
                f32x16 acc = {};
                acc = MFMA32(kf0, qf[((h * 2 + 0) * 2 + 0) * 64 + lane], acc);
                acc = MFMA32(kf1, qf[((h * 2 + 1) * 2 + 0) * 64 + lane], acc);
                acc = MFMA32(kf0, qf[((h * 2 + 0) * 2 + 1) * 64 + lane], acc);
                acc = MFMA32(kf1, qf[((h * 2 + 1) * 2 + 1) * 64 + lane], acc);
#pragma unroll
                for (int r = 0; r < 16; ++r) sc[r] = (h == 0) ? w[0] * fmaxf(acc[r], 0.f) : fmaf(w[h], fmaxf(acc[r], 0.f), sc[r]);
            }
#pragma unroll
            for (int r = 0; r < 16; ++r) {
                unsigned bits = __builtin_bit_cast(unsigned, sc[r]);
                if (bits == 0x80000000u) bits = 0u;
                unsigned k = (bits & 0x80000000u) ? ~bits : (bits | 0x80000000u);
                if (blk == qt32 && crow(r, hi) > r32) k = 0u;
                key[i][r] = k;
            }
        } else {
#pragma unroll
            for (int r = 0; r < 16; ++r) key[i][r] = 0u;
        }
    }
    LAS unsigned* part = (LAS unsigned*)(lds + SEL_PART);
    int pbi = 0;
#define SEL_REDUCE(cnt_, tot_) do { LAS unsigned* pb_ = part + (pbi & 1) * 512; ++pbi; pb_[wid * 64 + lane] = (cnt_); wg_barrier(); unsigned t_ = 0u; \
        _Pragma("unroll") for (int w8 = 0; w8 < 8; ++w8) t_ += pb_[w8 * 64 + r32] + pb_[w8 * 64 + 32 + r32]; (tot_) = t_; } while (0)
    unsigned prefix = 0u;
    for (int bit = 31; bit >= 0; --bit) {
        const unsigned cand = prefix | (1u << bit);
        unsigned cnt = 0u;
#pragma unroll
        for (int i = 0; i < 8; ++i) if (wid + 8 * i < nblk) {
#pragma unroll
            for (int r = 0; r < 16; ++r) cnt += (key[i][r] >= cand) ? 1u : 0u; }
        unsigned tot; SEL_REDUCE(cnt, tot);
        if (tot >= 256u) prefix = cand;
    }
    const unsigned thr = prefix;
    unsigned gtm[8], eqm[8]; unsigned cg = 0u;
#pragma unroll
    for (int i = 0; i < 8; ++i) { unsigned g = 0u, e = 0u;
        if (wid + 8 * i < nblk) {
#pragma unroll
            for (int r = 0; r < 16; ++r) { g |= (key[i][r] > thr) ? (1u << r) : 0u; e |= (key[i][r] == thr) ? (1u << r) : 0u; } }
        gtm[i] = g; eqm[i] = e; cg += __builtin_popcount(g); }
    unsigned cgt; SEL_REDUCE(cg, cgt);
    const unsigned rneed = 256u - cgt;
    unsigned Y = 0u;
    for (int bit = 10; bit >= 0; --bit) {
        const unsigned c = Y | (1u << bit);
        unsigned cnt = 0u;
#pragma unroll
        for (int i = 0; i < 8; ++i) cnt += __builtin_popcount(eqm[i] & idxmask((int)c - 32 * (wid + 8 * i), hi));
        unsigned tot; SEL_REDUCE(cnt, tot);
        if (tot < rneed) Y = c;
    }
#undef SEL_REDUCE
#pragma unroll
    for (int i = 0; i < 8; ++i) {
        const int blk = wid + 8 * i;
        const unsigned selm = gtm[i] | (eqm[i] & idxmask((int)Y + 1 - 32 * blk, hi));
        unsigned word = ((selm & 0xFu) | ((selm & 0xF0u) << 4) | ((selm & 0xF00u) << 8) | ((selm & 0xF000u) << 12)) << (4 * hi);
        word |= (unsigned)__shfl_xor((int)word, 32);
        if (hi == 0) maskbuf[qrow * 64 + blk] = word;
    }
    __syncthreads();
}

constexpr int AT_K = 0, AT_V = 16384, AT_WS = 32768;
__device__ __forceinline__ void qkt(f32x16& p0, f32x16& p1, const LAS unsigned char* Kslot, const bf16x8* qr, const f32x16& negm, int r32, int hi) {
    const LAS unsigned char* kb = Kslot + hi * 1024 + r32 * 16;
#pragma unroll
    for (int d0 = 0; d0 < 4; ++d0) {
        const bf16x8 b0 = *(const LAS bf16x8*)(kb + d0 * 2048);
        const bf16x8 b1 = *(const LAS bf16x8*)(kb + d0 * 2048 + 512);
        if (d0 == 0) { p0 = MFMA32(b0, qr[0], negm); p1 = MFMA32(b1, qr[0], negm); }
        else { p0 = MFMA32(b0, qr[d0], p0); p1 = MFMA32(b1, qr[d0], p1); }
    }
}
__device__ __forceinline__ void pv(f32x16* o, unsigned vb, bf16x8 pa0, bf16x8 pa1, bf16x8 pa2, bf16x8 pa3) {
#pragma unroll
    for (int d0 = 0; d0 < 2; ++d0) { s16x4 lo0, lo1, lo2, lo3, hi0, hi1, hi2, hi3;
        asm volatile("ds_read_b64_tr_b16 %0,%8 offset:%c9\n\tds_read_b64_tr_b16 %1,%8 offset:%c10\n\tds_read_b64_tr_b16 %2,%8 offset:%c11\n\tds_read_b64_tr_b16 %3,%8 offset:%c12\n\t"
                     "ds_read_b64_tr_b16 %4,%8 offset:%c13\n\tds_read_b64_tr_b16 %5,%8 offset:%c14\n\tds_read_b64_tr_b16 %6,%8 offset:%c15\n\tds_read_b64_tr_b16 %7,%8 offset:%c16\n\t"
                     "s_waitcnt lgkmcnt(0)"
                     : "=&v"(lo0), "=&v"(hi0), "=&v"(lo1), "=&v"(hi1), "=&v"(lo2), "=&v"(hi2), "=&v"(lo3), "=&v"(hi3)
                     : "v"(vb), "i"(d0 * 4096 + 0), "i"(d0 * 4096 + 512), "i"(d0 * 4096 + 1024), "i"(d0 * 4096 + 1536), "i"(d0 * 4096 + 2048), "i"(d0 * 4096 + 2560), "i"(d0 * 4096 + 3072), "i"(d0 * 4096 + 3584)
                     : "memory");
#define PKV(l_, h_) (bf16x8){l_[0], l_[1], l_[2], l_[3], h_[0], h_[1], h_[2], h_[3]}
        o[d0] = MFMA32(pa0, PKV(lo0, hi0), o[d0]);
        o[d0] = MFMA32(pa1, PKV(lo1, hi1), o[d0]);
        o[d0] = MFMA32(pa2, PKV(lo2, hi2), o[d0]);
        o[d0] = MFMA32(pa3, PKV(lo3, hi3), o[d0]);
#undef PKV
    }
}
struct SmState { float mhat, l; f32x16 o[2]; f32x16 negm; };
__device__ __forceinline__ float rowmax32(const f32x16& p0, const f32x16& p1) {
    float a = fmaxf(p0[0], p1[0]);
#pragma unroll
    for (int r = 1; r < 16; ++r) a = fmaxf(a, fmaxf(p0[r], p1[r]));
    return fmaxf(a, __shfl_xor(a, 32));
}
__device__ __forceinline__ void sm_rescale(SmState& st, f32x16& p0, f32x16& p1, bool first, LAS float* wsf, int r32, int hi) {
    const float rm = rowmax32(p0, p1);
    if (first || __any(rm > 8.f)) {
        const float dl = first ? rm : fmaxf(rm, 0.f);
        st.mhat += dl;
#pragma unroll
        for (int r = 0; r < 16; ++r) { p0[r] -= dl; p1[r] -= dl; st.negm[r] = -st.mhat; }
        if (!first) {
            const float f = __builtin_amdgcn_exp2f(-dl); st.l *= f; if (hi == 0) wsf[r32] = f;
            asm volatile("s_waitcnt lgkmcnt(0)" ::: "memory");
#pragma unroll
            for (int d_ = 0; d_ < 2; ++d_)
#pragma unroll
                for (int r = 0; r < 16; ++r) st.o[d_][r] *= wsf[crow(r, hi)];
            asm volatile("s_waitcnt lgkmcnt(0)" ::: "memory");
        }
    }
}

__device__ __forceinline__ void dsa_attn_unit(unsigned char* ws_, int tid_, int b, int qt, LAS unsigned char* lds) {
    const int lane = tid_ & 63, wid = __builtin_amdgcn_readfirstlane(tid_ >> 6), r32 = lane & 31, hi = lane >> 5;
    const int h = wid >> 1, qh = wid & 1;
    const size_t qrow = (size_t)b * S + 64 * qt + 32 * qh + r32;
    LAS float* wsf = (LAS float*)(lds + AT_WS) + wid * 64;
    bf16x8 qr[4];
    {
        const bf16* qp = B_PROJ + qrow * NP + C_QA + h * 64 + 8 * hi;
        const float* tab = B_ROPE + qrow * 24;
#pragma unroll
        for (int d0 = 0; d0 < 4; ++d0) {
            const v4u raw = *(const v4u*)(qp + 16 * d0);
            float x[8] = {bflo(raw.x), bfhi(raw.x), bflo(raw.y), bfhi(raw.y), bflo(raw.z), bfhi(raw.z), bflo(raw.w), bfhi(raw.w)};
            if (d0 == 0) {
#pragma unroll
                for (int j = 0; j < 8; ++j) { const float other = __shfl_xor(x[j], 32); const float c = tab[j], sn = tab[8 + j];
                    x[j] = (hi == 0) ? (x[j] * c - other * sn) : (other * sn + x[j] * c); }
            }
            v4u pk; pk.x = cvtpk(x[0] * C2, x[1] * C2); pk.y = cvtpk(x[2] * C2, x[3] * C2); pk.z = cvtpk(x[4] * C2, x[5] * C2); pk.w = cvtpk(x[6] * C2, x[7] * C2);
            qr[d0] = __builtin_bit_cast(bf16x8, pk);
        }
    }
    const bf16* KAb = B_KA + (size_t)b * S * 128;
    const bf16* ksrc = KAb + (size_t)lane * 128 + wid * 8;
    const bf16* vsrc = KAb + (size_t)(16 * (wid & 3) + (lane >> 2)) * 128 + 64 + (wid >> 2) * 32 + (lane & 3) * 8;
#define AT_DMA(t, slot) do { \
        __builtin_amdgcn_global_load_lds((const unsigned*)(ksrc + (size_t)(t) * 64 * 128), (LAS unsigned*)(lds + AT_K + (slot) * 8192 + wid * 1024), 16, 0, 0); \
        __builtin_amdgcn_global_load_lds((const unsigned*)(vsrc + (size_t)(t) * 64 * 128), (LAS unsigned*)(lds + AT_V + (slot) * 8192 + wid * 1024), 16, 0, 0); } while (0)
    const unsigned vb0 = (unsigned)(uintptr_t)(lds + AT_V) + ((lane >> 4) & 1) * 32 + (lane & 3) * 8 + (4 * hi + ((lane & 15) >> 2)) * 64;
    const int NT = qt + 1;
    SmState st; st.mhat = 0.f; st.l = 0.f; st.o[0] = f32x16{}; st.o[1] = f32x16{}; st.negm = f32x16{};
    const unsigned long long* mrow = (const unsigned long long*)((const unsigned*)(ws_ + WS_MASK) + qrow * 64);
    AT_DMA(0, 0);
    unsigned long long mnext = mrow[0];
    for (int t = 0; t < NT; ++t) {
        asm volatile("s_waitcnt vmcnt(0)" ::: "memory");
        wg_barrier();
        const unsigned long long mcur = mnext;
        if (t + 1 < NT) { AT_DMA(t + 1, (t + 1) & 1); mnext = mrow[t + 1]; }
        f32x16 p0, p1;
        qkt(p0, p1, lds + AT_K + (t & 1) * 8192, qr, st.negm, r32, hi);
        sm_rescale(st, p0, p1, t == 0, wsf, r32, hi);
        const unsigned wx = (unsigned)mcur >> (4 * hi), wy = (unsigned)(mcur >> 32) >> (4 * hi);
        float sacc = 0.f;
#pragma unroll
        for (int r = 0; r < 16; ++r) {
            const int c = (r & 3) + 8 * (r >> 2);
            const unsigned k0 = (unsigned)__builtin_amdgcn_sbfe((int)wx, c, 1), k1 = (unsigned)__builtin_amdgcn_sbfe((int)wy, c, 1);
            const float e0 = __builtin_bit_cast(float, __builtin_bit_cast(unsigned, __builtin_amdgcn_exp2f(p0[r])) & k0);
            const float e1 = __builtin_bit_cast(float, __builtin_bit_cast(unsigned, __builtin_amdgcn_exp2f(p1[r])) & k1);
            p0[r] = e0; p1[r] = e1; sacc += e0 + e1;
        }
        st.l += sacc;
        v4u pw0 = {cvtpk(p0[0], p0[1]), cvtpk(p0[2], p0[3]), cvtpk(p0[4], p0[5]), cvtpk(p0[6], p0[7])};
        v4u pw1 = {cvtpk(p0[8], p0[9]), cvtpk(p0[10], p0[11]), cvtpk(p0[12], p0[13]), cvtpk(p0[14], p0[15])};
        v4u pw2 = {cvtpk(p1[0], p1[1]), cvtpk(p1[2], p1[3]), cvtpk(p1[4], p1[5]), cvtpk(p1[6], p1[7])};
        v4u pw3 = {cvtpk(p1[8], p1[9]), cvtpk(p1[10], p1[11]), cvtpk(p1[12], p1[13]), cvtpk(p1[14], p1[15])};
        pv(st.o, vb0 + (t & 1) * 8192, __builtin_bit_cast(bf16x8, pw0), __builtin_bit_cast(bf16x8, pw1), __builtin_bit_cast(bf16x8, pw2), __builtin_bit_cast(bf16x8, pw3));
    }
#undef AT_DMA
    {
        const float lt = st.l + __shfl_xor(st.l, 32);
        if (hi == 0) wsf[r32] = 1.f / lt;
        asm volatile("s_waitcnt lgkmcnt(0)" ::: "memory");
        bf16* ob = B_MIX + ((size_t)b * S + 64 * qt + 32 * qh) * D + h * 64 + r32;
#pragma unroll
        for (int r = 0; r < 16; ++r) { const int rq = crow(r, hi); const float f = wsf[rq];
            ob[(size_t)rq * D] = (bf16)f2bf(st.o[0][r] * f); ob[(size_t)rq * D + 32] = (bf16)f2bf(st.o[1][r] * f); }
    }
    __syncthreads();
}

__device__ __forceinline__ void nsa_tile(const bf16* kbase, const bf16* vbase, int s0, bool valid, const LAS float* q, LAS float* pt, float (&m)[4], float (&l)[4], float (&o)[4], int lane) {
    float lg[4] = {NEGF, NEGF, NEGF, NEGF};
    if (valid) {
        const v4u* kp = (const v4u*)(kbase + (size_t)(s0 + lane) * NP);
        float acc[4] = {0.f, 0.f, 0.f, 0.f};
#pragma unroll
        for (int qq = 0; qq < 8; ++qq) { const v4u kk = kp[qq]; float kf[8];
            kf[0] = bflo(kk.x); kf[1] = bfhi(kk.x); kf[2] = bflo(kk.y); kf[3] = bfhi(kk.y); kf[4] = bflo(kk.z); kf[5] = bfhi(kk.z); kf[6] = bflo(kk.w); kf[7] = bfhi(kk.w);
#pragma unroll
            for (int h = 0; h < 4; ++h)
#pragma unroll
                for (int dd = 0; dd < 8; ++dd) acc[h] += q[h * 64 + 8 * qq + dd] * kf[dd]; }
#pragma unroll
        for (int h = 0; h < 4; ++h) lg[h] = acc[h] * 0.125f;
    }
    float p[4];
#pragma unroll
    for (int h = 0; h < 4; ++h) {
        const float tm = wave_max(lg[h]); const float mn = fmaxf(m[h], tm);
        const float alpha = __expf(m[h] - mn);
        p[h] = valid ? __expf(lg[h] - mn) : 0.f;
        l[h] = l[h] * alpha + wave_sum(p[h]); o[h] *= alpha; m[h] = mn;
    }
    *(LAS f32x4*)(pt + lane * 4) = (f32x4){p[0], p[1], p[2], p[3]};
    LDS_FENCE();
#pragma unroll 8
    for (int k = 0; k < 64; ++k) {
        const float v = bf2f(vbase[(size_t)(s0 + k) * NP + lane]);
        const f32x4 p4 = *(const LAS f32x4*)(pt + k * 4);
        o[0] += p4.x * v; o[1] += p4.y * v; o[2] += p4.z * v; o[3] += p4.w * v;
    }
    LDS_FENCE();
}

__device__ __forceinline__ void nsa_token(unsigned char* ws_, int lane_, int b, int t, int g, LAS unsigned char* scr) {
    const int lane = lane_;
    const size_t row = (size_t)b * S + t;
    const bf16* prow = B_PROJ + row * NP;
    LAS float* qn = (LAS float*)scr;
    LAS float* qr = (LAS float*)(scr + 1024);
    LAS float* pc = (LAS float*)(scr + 2048);
    LAS float* ps = (LAS float*)(scr + 4096);
    LAS float* pt = (LAS float*)(scr + 4608);
    const float* tab = B_ROPE + row * 24;
#pragma unroll
    for (int j = 0; j < 2; ++j) { const unsigned u = *(const unsigned*)(prow + C_QB + g * 256 + 2 * lane + 128 * j);
        const float a = bflo(u), c = bfhi(u); qn[2 * lane + 128 * j] = a; qn[2 * lane + 128 * j + 1] = c; qr[2 * lane + 128 * j] = a; qr[2 * lane + 128 * j + 1] = c; }
    LDS_FENCE();
    if (lane < 32) { const int h = lane >> 3, i = lane & 7; const float c = tab[i], s = tab[8 + i]; const float x1 = qn[h * 64 + i], x2 = qn[h * 64 + 8 + i];
        qr[h * 64 + i] = x1 * c - x2 * s; qr[h * 64 + 8 + i] = x1 * s + x2 * c; }
    LDS_FENCE();
    const int ncv = (t >= 31) ? (((t - 31) >> 4) + 1) : 0;
    float ocmp[4] = {0.f, 0.f, 0.f, 0.f};
    {
        float lg[2][4];
#pragma unroll
        for (int ci = 0; ci < 2; ++ci) {
            const int c = lane + 64 * ci;
#pragma unroll
            for (int h = 0; h < 4; ++h) lg[ci][h] = NEGF;
            if (c < ncv) {
                const f32x4* kp = (const f32x4*)(B_KC + ((size_t)(b * NC + c) * 2 + g) * 64);
                float acc[4] = {0.f, 0.f, 0.f, 0.f};
#pragma unroll
                for (int qq = 0; qq < 16; ++qq) { const f32x4 kk = kp[qq];
#pragma unroll
                    for (int h = 0; h < 4; ++h) acc[h] += qn[h * 64 + 4 * qq] * kk.x + qn[h * 64 + 4 * qq + 1] * kk.y + qn[h * 64 + 4 * qq + 2] * kk.z + qn[h * 64 + 4 * qq + 3] * kk.w; }
#pragma unroll
                for (int h = 0; h < 4; ++h) lg[ci][h] = acc[h] * 0.125f;
            }
        }
        float p[2][4];
#pragma unroll
        for (int h = 0; h < 4; ++h) {
            const float mm = wave_max(fmaxf(lg[0][h], lg[1][h]));
            p[0][h] = (lane < ncv) ? __expf(lg[0][h] - mm) : 0.f; p[1][h] = (lane + 64 < ncv) ? __expf(lg[1][h] - mm) : 0.f;
            const float sum = wave_sum(p[0][h] + p[1][h]);
            const float inv = (ncv > 0) ? 1.f / sum : 0.f;
            p[0][h] *= inv; p[1][h] *= inv;
        }
#pragma unroll
        for (int ci = 0; ci < 2; ++ci) { const int c = lane + 64 * ci;
            *(LAS f32x4*)(pc + c * 4) = (f32x4){p[ci][0], p[ci][1], p[ci][2], p[ci][3]};
            ps[c] = (p[ci][0] + p[ci][1]) + (p[ci][2] + p[ci][3]); }
        LDS_FENCE();
        for (int c = 0; c < ncv; ++c) {
            const float v = B_VC[((size_t)(b * NC + c) * 2 + g) * 64 + lane];
            const f32x4 p4 = *(const LAS f32x4*)(pc + c * 4);
            ocmp[0] += p4.x * v; ocmp[1] += p4.y * v; ocmp[2] += p4.z * v; ocmp[3] += p4.w * v;
        }
    }
    const int cur = t >> 6;
    unsigned selmask;
    if (cur < 16) selmask = (2u << cur) - 1u;
    else {
        float sj = -__builtin_inff();
        if (lane < 32 && lane <= cur) {
            const int j = lane;
            if (j == 0 || j == cur || j == cur - 1) sj = __builtin_inff();
            else { const int c0 = 4 * j - 1, c1 = (4 * j + 3 < NC - 1) ? 4 * j + 3 : NC - 1; float a = 0.f; for (int c = c0; c <= c1; ++c) a += ps[c]; sj = a; }
        }
        int rank = 0;
#pragma unroll
        for (int i = 0; i < 32; ++i) { const float si = __shfl(sj, i); rank += ((si > sj) || (si == sj && i < lane)) ? 1 : 0; }
        const bool sel = (lane < 32) && (rank < 16);
        selmask = (unsigned)(__ballot(sel) & 0xffffffffull);
    }
    float ms[4] = {NEGF, NEGF, NEGF, NEGF}, ls[4] = {0.f, 0.f, 0.f, 0.f}, os[4] = {0.f, 0.f, 0.f, 0.f};
    {
        const bf16* kb = B_PROJ + (size_t)b * S * NP + C_KSLC + g * 64;
        const bf16* vb = B_PROJ + (size_t)b * S * NP + C_VSLC + g * 64;
        for (int j = 0; j <= cur; ++j) {
            if (!((selmask >> j) & 1u)) continue;
            nsa_tile(kb, vb, 64 * j, (64 * j + lane) <= t, qr, pt, ms, ls, os, lane);
        }
    }
    float mw[4] = {NEGF, NEGF, NEGF, NEGF}, lw[4] = {0.f, 0.f, 0.f, 0.f}, ow[4] = {0.f, 0.f, 0.f, 0.f};
    {
        const bf16* kb = B_PROJ + (size_t)b * S * NP + C_KWIN + g * 64;
        const bf16* vb = B_PROJ + (size_t)b * S * NP + C_VWIN + g * 64;
        const int lo = (t - 511 > 0) ? t - 511 : 0;
        for (int j = lo >> 6; j <= cur; ++j) {
            const int s = 64 * j + lane;
            nsa_tile(kb, vb, 64 * j, (s >= lo) && (s <= t), qr, pt, mw, lw, ow, lane);
        }
    }
    bf16* orow = B_MIX + row * D + 256 + g * 256;
#pragma unroll
    for (int h = 0; h < 4; ++h) {
        const bf16* gp = prow + C_GATE + (g * 4 + h) * 3;
        const float g0 = 1.f / (1.f + __expf(-bf2f(gp[0]))), g1 = 1.f / (1.f + __expf(-bf2f(gp[1]))), g2 = 1.f / (1.f + __expf(-bf2f(gp[2])));
        const float o = g0 * ocmp[h] + g1 * (os[h] / ls[h]) + g2 * (ow[h] / lw[h]);
        orow[h * 64 + lane] = (bf16)f2bf(o);
    }
    LDS_FENCE();
}

__device__ __forceinline__ void phase_attn(Frame& F, int l) {
    (void)l;
    unsigned char* ws_ = F.ws; asm volatile("" : "+s"(ws_)); int lane_ = F.lane; asm volatile("" : "+v"(lane_)); (void)ws_;
    int tid_ = F.tid; asm volatile("" : "+v"(tid_));
    if (F.G == 256) {
        const int b = F.vcu >> 3, sft = F.vcu & 7;
        for (int i = 0; i < 8; ++i) { const int base = 16 * (i >> 1); const int qt32 = (i & 1) ? base + 15 - sft : base + sft; dsa_select_unit(ws_, tid_, b, qt32, F.lds); }
    } else {
        for (int u = F.vcu; u < BATCH * 64; u += F.G) dsa_select_unit(ws_, tid_, u >> 6, u & 63, F.lds);
    }
    __syncthreads();
    LAS unsigned char* scr = F.lds + F.wave * WSCR;
    const int gw = F.vcu * NWAVES + F.wave, NGW = F.G * NWAVES;
    for (int it = gw; it < 2 * M; it += NGW) {
        const int g = it & 1, tk = it >> 1; const int b = tk / S, t = ((tk % S) + 64 * b) % S;
        nsa_token(ws_, lane_, b, t, g, scr);
    }
}
__device__ __forceinline__ void phase_dsa_attn(Frame& F) {
    unsigned char* ws_ = F.ws; asm volatile("" : "+s"(ws_));
    int tid_ = F.tid; asm volatile("" : "+v"(tid_));
#if DIAG_NAIVE_ATTN
    { int lane_ = tid_ & 63; LAS unsigned char* scr = F.lds + F.wave * WSCR; const int gw = F.vcu * NWAVES + F.wave, NGW = F.G * NWAVES;
      for (int it = gw; it < M; it += NGW) { const int b = it / S, t = ((it % S) + 64 * b) % S; dsa_token(ws_, lane_, b, t, scr); } }
#else
    if (F.G == 256) {
        const int b = F.vcu >> 3, sft = F.vcu & 7;
        for (int i = 0; i < 4; ++i) { const int base = 16 * (i >> 1); const int qt = (i & 1) ? base + 15 - sft : base + sft; dsa_attn_unit(ws_, tid_, b, qt, F.lds); }
    } else {
        for (int u = F.vcu; u < BATCH * 32; u += F.G) dsa_attn_unit(ws_, tid_, u >> 5, u & 31, F.lds);
    }
#endif
}

__device__ __forceinline__ void phase_merge(Frame& F, const Args& args, int l) {
    unsigned char* ws_ = F.ws; asm volatile("" : "+s"(ws_)); int lane_ = F.lane; asm volatile("" : "+v"(lane_)); (void)ws_;
    LAS float* pl = (LAS float*)(F.lds + F.wave * WSCR);
    const int gw = F.vcu * NWAVES + F.wave, NGW = F.G * NWAVES, lane = lane_;
    const float* wp = P_W_POOL + (size_t)l * 4 * 64 * 64;
    const float* psc = P_POOL_SCALE + l * 256;
    const float* goa = P_G_OUT_A + l * 256; const float* gob = P_G_OUT_B + l * 512;
    for (int row = gw; row < M; row += NGW) {
        const int t = row % S;
        bf16* mrow = B_MIX + (size_t)row * D;
        { const unsigned long long u = *((const unsigned long long*)mrow + lane);
          const float a0 = bflo((unsigned)u), a1 = bfhi((unsigned)u), a2 = bflo((unsigned)(u >> 32)), a3 = bfhi((unsigned)(u >> 32));
          const float rs = rsqrtf(wave_sum((a0 * a0 + a1 * a1) + (a2 * a2 + a3 * a3)) * (1.f / 256.f) + EPS);
          const f32x4 gg = ((const f32x4*)goa)[lane];
          *((unsigned long long*)mrow + lane) = (unsigned long long)pk2(a0 * rs * gg.x, a1 * rs * gg.y) | ((unsigned long long)pk2(a2 * rs * gg.z, a3 * rs * gg.w) << 32); }
        { const v4u u = *((const v4u*)(mrow + 256) + lane);
          float a[8] = {bflo(u.x), bfhi(u.x), bflo(u.y), bfhi(u.y), bflo(u.z), bfhi(u.z), bflo(u.w), bfhi(u.w)};
          float ss = 0.f;
#pragma unroll
          for (int i = 0; i < 8; ++i) ss += a[i] * a[i];
          const float rs = rsqrtf(wave_sum(ss) * (1.f / 512.f) + EPS);
          const f32x4 g0 = ((const f32x4*)gob)[2 * lane], g1 = ((const f32x4*)gob)[2 * lane + 1];
          v4u o; o.x = pk2(a[0] * rs * g0.x, a[1] * rs * g0.y); o.y = pk2(a[2] * rs * g0.z, a[3] * rs * g0.w); o.z = pk2(a[4] * rs * g1.x, a[5] * rs * g1.y); o.w = pk2(a[6] * rs * g1.z, a[7] * rs * g1.w);
          *((v4u*)(mrow + 256) + lane) = o; }
        const bf16* up = B_PROJ + (size_t)row * NP + C_UC;
#pragma unroll
        for (int gi = 0; gi < 4; ++gi) {
            const int w = 2 << gi;
            const float u0 = bf2f(up[gi * 64 + lane]);
            float sum = u0;
            for (int i = 1; i < w; ++i) if (t - i >= 0) sum += bf2f(up[gi * 64 + lane - (size_t)i * NP]);
            const float cntf = (float)((t + 1 < w) ? t + 1 : w);
            pl[gi * 64 + lane] = sum / cntf - u0;
        }
        LDS_FENCE();
        float oc[4]; float ss = 0.f;
#pragma unroll
        for (int gi = 0; gi < 4; ++gi) {
            float a = 0.f; const float* wg = wp + (size_t)gi * 64 * 64 + lane;
#pragma unroll 16
            for (int c = 0; c < 64; ++c) a += pl[gi * 64 + c] * wg[c * 64];
            oc[gi] = a; ss += a * a;
        }
        const float rs = rsqrtf(wave_sum(ss) * (1.f / 256.f) + EPS);
#pragma unroll
        for (int gi = 0; gi < 4; ++gi) mrow[768 + gi * 64 + lane] = (bf16)f2bf(oc[gi] * rs * psc[gi * 64 + lane]);
        LDS_FENCE();
    }
}

__device__ __forceinline__ void phase_finish(Frame& F, const float* xsrc, const float* gpost, const float* gnext  ) {
    unsigned char* ws_ = F.ws; asm volatile("" : "+s"(ws_)); int lane_ = F.lane; asm volatile("" : "+v"(lane_)); (void)ws_;
    const int gw = F.vcu * NWAVES + F.wave, NGW = F.G * NWAVES, lane = lane_;
    for (int row = gw; row < M; row += NGW) {
        const unsigned long long* fr = (const unsigned long long*)(B_F + (size_t)row * D) + lane;
        const f32x4* xr = (const f32x4*)(xsrc + (size_t)row * D) + lane;
        f32x4 f[4], x[4]; float ss = 0.f;
#pragma unroll
        for (int j = 0; j < 4; ++j) { const unsigned long long u = fr[64 * j]; x[j] = xr[64 * j];
            f[j] = (f32x4){bflo((unsigned)u), bfhi((unsigned)u), bflo((unsigned)(u >> 32)), bfhi((unsigned)(u >> 32))};
            ss += (f[j].x * f[j].x + f[j].y * f[j].y) + (f[j].z * f[j].z + f[j].w * f[j].w); }
        const float rs = rsqrtf(wave_sum(ss) * (1.f / D) + EPS);
        float s2 = 0.f;
        f32x4* orow = (f32x4*)(F.out + (size_t)row * D) + lane;
#pragma unroll
        for (int j = 0; j < 4; ++j) { const f32x4 g = ((const f32x4*)gpost)[lane + 64 * j];
            x[j].x += f[j].x * rs * g.x; x[j].y += f[j].y * rs * g.y; x[j].z += f[j].z * rs * g.z; x[j].w += f[j].w * rs * g.w;
            orow[64 * j] = x[j];
            s2 += (x[j].x * x[j].x + x[j].y * x[j].y) + (x[j].z * x[j].z + x[j].w * x[j].w); }
        if (gnext) {
            const float r2 = rsqrtf(wave_sum(s2) * (1.f / D) + EPS);
            unsigned long long* o8 = (unsigned long long*)(B_H + (size_t)row * D) + lane;
#pragma unroll
            for (int j = 0; j < 4; ++j) { const f32x4 g = ((const f32x4*)gnext)[lane + 64 * j];
                o8[64 * j] = (unsigned long long)pk2(x[j].x * r2 * g.x, x[j].y * r2 * g.y) | ((unsigned long long)pk2(x[j].z * r2 * g.z, x[j].w * r2 * g.w) << 32); }
        }
    }
}

template <int ACT>
__device__ __forceinline__ void phase_gemm(Frame& F, const bf16* A, const bf16* Bt, bf16* O, int N, int K) {
    asm volatile("" : "+s"(A), "+s"(Bt), "+s"(O));
    pg8::Gemm g{A, Bt, M, N, K}; pg8::StaticOrder So; So.init(M, N, F.G, (int)blockIdx.x);
    pg8::EpiStore<ACT> E{O, N};
    pg8::gemm_phase<pg8::EpiStore<ACT>, pg8::StaticOrder, true, true>(F.lds, g, So, E);
}

constexpr int PH_PER_LAYER = 10, NPHASES = 1 + DEPTH * PH_PER_LAYER;
__global__ void __launch_bounds__(NWAVES * 64, 2) mk_fwd(Args args) {
    extern __shared__ __attribute__((aligned(16))) unsigned char lds[];
    Frame F;
    F.lds = (LAS unsigned char*)lds;
    F.MISC = (volatile LAS unsigned*)(F.lds + MISC_OFF);
    F.tid = threadIdx.x; F.lane = F.tid & 63; F.wave = __builtin_amdgcn_readfirstlane(F.tid >> 6);
    F.G = gridDim.x; { const int bx = blockIdx.x; F.vcu = (F.G % 8 == 0) ? (bx % 8) * (F.G / 8) + bx / 8 : bx; }
    unsigned char* ws = args.ws; F.ws = ws;
    F.ctl = (gu32*)(ws + WS_CTL);
    F.out = args.out;
    for (int u = F.tid; u < (LDS_BYTES - LDSCTL_OFF) / 4; u += NWAVES * 64) ((LAS unsigned*)(F.lds + LDSCTL_OFF))[u] = 0u;
    __syncthreads();
    XcdBarrier bar; bar.bar = (unsigned*)(F.ctl + CW_BAR); bar.x = 0; bar.st = F.MISC + 8;
    if (args.use_bar) bar = xcd_barrier_post((unsigned*)(F.ctl + CW_BAR), F.MISC + 8);
    const int lo = args.ph_lo, hi = args.ph_hi;
    int pid = 0;
    unsigned char* ws_ = F.ws;
#define PH_ON (pid >= lo && pid < hi)
#define PH_END do { if (PH_ON && pid + 1 < hi) xcd_barrier(bar); ++pid; } while (0)

    if (PH_ON && !(SKIPM & 1)) phase_prologue(F, args);
    PH_END;
    for (int l = 0; l < DEPTH; ++l) {
        if (PH_ON && !(SKIPM & 2)) phase_gemm<0>(F, B_H, w_in_t(ws_, l), B_PROJ, NP, D);
        PH_END;
        if (PH_ON && !(SKIPM & 4)) phase_prep(F, args, l);
        PH_END;
        if (PH_ON && !(SKIPM & 8)) phase_attn(F, l);
        PH_END;
        if (PH_ON && !(SKIPM & 8)) phase_dsa_attn(F);
        PH_END;
        if (PH_ON && !(SKIPM & 16)) phase_merge(F, args, l);
        PH_END;
        if (PH_ON && !(SKIPM & 32)) phase_gemm<0>(F, B_MIX, w_out_t(ws_, l), B_F, D, D);
        PH_END;
        if (PH_ON && !(SKIPM & 64)) phase_finish(F, l == 0 ? P_X_IN : F.out, P_G_POST_MIX + l * D, P_G_PRE_MLP + l * D);
        PH_END;
        if (PH_ON && !(SKIPM & 128)) phase_gemm<2>(F, B_H, w_up_t(ws_, l), B_HID, FF, D);
        PH_END;
        if (PH_ON && !(SKIPM & 256)) phase_gemm<0>(F, B_HID, w_dn_t(ws_, l), B_F, D, FF);
        PH_END;
        if (PH_ON && !(SKIPM & 512)) phase_finish(F, F.out, P_G_POST_MLP + l * D, (l + 1 < DEPTH) ? P_G_PRE_MIX + (l + 1) * D : nullptr);
        PH_END;
    }
#undef PH_ON
#undef PH_END
}

extern "C" void kernel_launch(void* const* d_in, const int* in_sizes, int n_in, void* d_out, int out_size, void* d_ws, size_t ws_size, hipStream_t stream) {
    static int grid = 0;
    if (grid == 0) {
        if (n_in != 20 || in_sizes[0] != M * D || out_size != M * D || ws_size < WS_END) {
            fprintf(stderr, "kernel_launch: unexpected shapes / workspace (n_in %d, in0 %d, out %d, ws %zu < %zu); nothing launched\n", n_in, n_in > 0 ? in_sizes[0] : -1, out_size, ws_size, (size_t)WS_END);
            grid = -1; return; }
        int dev = 0, cus = 0, per_cu = 0;
        if (hipGetDevice(&dev) != hipSuccess || hipDeviceGetAttribute(&cus, hipDeviceAttributeMultiprocessorCount, dev) != hipSuccess) { grid = -1; return; }
        if (hipFuncSetAttribute((const void*)mk_fwd, hipFuncAttributeMaxDynamicSharedMemorySize, LDS_BYTES) != hipSuccess) { fprintf(stderr, "kernel_launch: hipFuncSetAttribute failed\n"); grid = -1; return; }
        if (hipOccupancyMaxActiveBlocksPerMultiprocessor(&per_cu, (const void*)mk_fwd, NWAVES * 64, LDS_BYTES) != hipSuccess || per_cu < 1)
            fprintf(stderr, "kernel_launch: note: occupancy query reports %d workgroups per CU\n", per_cu);
        (void)hipGetLastError();
        grid = cus;
    }
    if (grid < 0) return;
    if (hipMemsetAsync((char*)d_ws + WS_CTL, 0, CTL_ZERO_BYTES, stream) != hipSuccess) return;
    Args a{};
    for (int i = 0; i < 20; ++i) a.in[i] = d_in[i];
    a.out = (float*)d_out; a.ws = (unsigned char*)d_ws; a.pad = 0;
#if MK_MULTI
    for (int p = 0; p < NPHASES; ++p) {
        a.ph_lo = p; a.ph_hi = p + 1; a.use_bar = 0;
        hipLaunchKernelGGL(mk_fwd, dim3(grid), dim3(NWAVES * 64), LDS_BYTES, stream, a);
    }
#else
    a.ph_lo = 0; a.ph_hi = NPHASES; a.use_bar = 1;
    hipLaunchKernelGGL(mk_fwd, dim3(grid), dim3(NWAVES * 64), LDS_BYTES, stream, a);
#endif
}
```

```cpp
#include <hip/hip_runtime.h>
#include <cstdio>
#include <cstdint>

#ifndef DIAG_NAIVE_NSA
#define DIAG_NAIVE_NSA 0
#endif
#ifndef DIAG_NAIVE_ATTN
#define DIAG_NAIVE_ATTN 0
#endif
#ifndef SKIPM
#define SKIPM 0
#endif
#ifndef MK_MULTI
#define MK_MULTI 0
#endif

namespace pg8 {
#define PG8_LAS __attribute__((address_space(3)))
typedef unsigned short bf16_t;
typedef short bf16x8 __attribute__((ext_vector_type(8)));
typedef float f32x4 __attribute__((ext_vector_type(4)));
typedef unsigned u32x4 __attribute__((ext_vector_type(4)));
constexpr int BM = 256, BK = 64, HALF = 128, HTB = HALF * BK * 2, STAGE_BYTES = 8 * HTB, NXCD = 8, WGM = 8;

__host__ __device__ __forceinline__ int lds_byte(int r, int c) { const int st = (r >> 4) * 2 + (c >> 5), rr = r & 15, cc = c & 31, ob = rr * 64 + cc * 2; return st * 1024 + (ob ^ (((ob >> 9) & 1) << 5)); }
__host__ __device__ __forceinline__ void stage_rc(int b, int& R, int& C) { const int st = b / 1024, sb = b % 1024, swz = sb ^ (((sb >> 9) & 1) << 5); R = (st >> 1) * 16 + swz / 64; C = (st & 1) * 32 + (swz % 64) / 2; }
__host__ __device__ __forceinline__ int perm32(int rho) { const int n = rho >> 4, i = rho & 15; return 8 * (i >> 2) + 4 * n + (i & 3); }

struct Unit { int pm, pn; };
struct Gemm { const bf16_t* A; const bf16_t* Bt; int M, N, K; };

struct StaticOrder {
    int nM, nN, nwg, G, c;
    __host__ __device__ void init(int M, int N, int G_, int c_) { nM = M / BM; nN = N / BM; nwg = nM * nN; G = G_; c = c_; }
    __host__ __device__ bool next(int i, Unit& u) const {
        const long L = (long)i * G + c; if (L >= nwg) return false;
        int wgid = (int)L; { const int q = nwg / NXCD, r = nwg % NXCD, xcd = wgid % NXCD, off = wgid / NXCD; wgid = (xcd < r ? xcd * (q + 1) : r * (q + 1) + (xcd - r) * q) + off; }
        const int nig = WGM * nN, gid = wgid / nig, fm = gid * WGM, gsz = (nM - fm) < WGM ? (nM - fm) : WGM;
        u.pm = fm + ((wgid % nig) % gsz); u.pn = (wgid % nig) / gsz; return true;
    }
    __device__ __forceinline__ void a_ready(const Unit&) const {}
    __device__ __forceinline__ void done(const Unit&) const {}
};

__device__ __forceinline__ unsigned cvt_pk_bf16(float lo, float hi) { unsigned r; asm volatile("v_cvt_pk_bf16_f32 %0, %1, %2" : "=v"(r) : "v"(lo), "v"(hi)); return r; }

template <int ACT  > struct EpiStore {
    static constexpr bool PERM = true, AFTER_DRAIN = false;
    bf16_t* O; int ldc;
    __device__ __forceinline__ void operator()(const f32x4 (&acc)[2][2][4][2], const Unit& u, int wr, int wc, int fr, int fq) const {
        const int row0 = u.pm * BM + wr * 64 + fr;
        const int col0 = u.pn * BM + wc * 32 + 8 * fq;
#pragma unroll
        for (int ai = 0; ai < 2; ++ai)
#pragma unroll
            for (int m = 0; m < 4; ++m) { bf16_t* rowp = O + (size_t)(row0 + ai * HALF + m * 16) * ldc + col0;
#pragma unroll
                for (int bj = 0; bj < 2; ++bj) { f32x4 v0 = acc[ai][bj][m][0], v1 = acc[ai][bj][m][1];
                    if (ACT == 2) {
#pragma unroll
                        for (int e = 0; e < 4; ++e) { const float a = fmaxf(v0[e], 0.f), b = fmaxf(v1[e], 0.f); v0[e] = a * a; v1[e] = b * b; } }
                    u32x4 w; w.x = cvt_pk_bf16(v0[0], v0[1]); w.y = cvt_pk_bf16(v0[2], v0[3]); w.z = cvt_pk_bf16(v1[0], v1[1]); w.w = cvt_pk_bf16(v1[2], v1[3]);
                    *(u32x4*)(rowp + bj * HALF) = w; } }
    }
};

template <class Epi, class Sched, bool ALIGN_EPI = false, bool SP2 = false>
__device__ __forceinline__ void gemm_phase(PG8_LAS unsigned char* lds, const Gemm g, const Sched& S, const Epi& E) {
    int tid_ = threadIdx.x; asm volatile("" : "+v"(tid_));
    const int tid = tid_, wid = __builtin_amdgcn_readfirstlane(tid >> 6), lane = tid & 63, wr = wid >> 2, wc = wid & 3, fr = lane & 15, fq = lane >> 4;
    const int K = g.K, nt = K / BK;
    unsigned voffA[2], voffB[2];
#pragma unroll
    for (int i = 0; i < 2; ++i) { int R, C; stage_rc(tid * 16 + i * 8192, R, C); const int Rb = Epi::PERM ? ((R & ~31) + perm32(R & 31)) : R;
        voffA[i] = (unsigned)(R * K + C) * 2u; voffB[i] = (unsigned)(Rb * K + C) * 2u; }
    const size_t kstep = (size_t)(BK * 2);
    const size_t hstep = (size_t)HALF * K * 2;
    const size_t tstep = 2 * hstep;
    const unsigned ldsw = (unsigned)wid * 1024u;
    const int aoff = lds_byte(wr * 64 + fr, fq * 8), boff = lds_byte(wc * 32 + fr, fq * 8);
#define PG8_SA(b, h) (((b) * 2 + (h)) * HTB)
#define PG8_SB(b, h) ((4 + (b) * 2 + (h)) * HTB)
#define PG8_STAGE(bufoff, gbase, voff) do { _Pragma("unroll") for (int _i = 0; _i < 2; ++_i) \
        __builtin_amdgcn_global_load_lds((const unsigned*)((const char*)(gbase) + (voff)[_i]), (PG8_LAS unsigned*)(lds + (bufoff) + ldsw + _i * 8192), 16, 0, 0); } while (0)
#define PG8_LDA(dst, b, h) do { _Pragma("unroll") for (int m = 0; m < 4; ++m) _Pragma("unroll") for (int k = 0; k < 2; ++k) dst[m][k] = *(const PG8_LAS bf16x8*)(lds + PG8_SA(b, h) + aoff + m * 2048 + k * 1024); } while (0)
#define PG8_LDB(dst, b, h) do { _Pragma("unroll") for (int n = 0; n < 2; ++n) _Pragma("unroll") for (int k = 0; k < 2; ++k) dst[n][k] = *(const PG8_LAS bf16x8*)(lds + PG8_SB(b, h) + boff + n * 2048 + k * 1024); } while (0)
#define PG8_MMA(ai, bj, At, Bt) do { __builtin_amdgcn_s_setprio(1); _Pragma("unroll") for (int m = 0; m < 4; ++m) _Pragma("unroll") for (int n = 0; n < 2; ++n) _Pragma("unroll") for (int k = 0; k < 2; ++k) \
        acc[ai][bj][m][n] = __builtin_amdgcn_mfma_f32_16x16x32_bf16(Bt[n][k], At[m][k], acc[ai][bj][m][n], 0, 0, 0); __builtin_amdgcn_s_setprio(0); } while (0)
#define PG8_WAIT_V(n) asm volatile("s_waitcnt vmcnt(" #n ")" ::: "memory")
#define PG8_WAIT_L(n) asm volatile("s_waitcnt lgkmcnt(" #n ")" ::: "memory")
#define PG8_BAR __builtin_amdgcn_s_barrier()
#define PG8_SCHED __builtin_amdgcn_sched_barrier(0)
    Unit cur, nxt; int ui = 0;
    if (!S.next(0, cur)) return;
    f32x4 acc[2][2][4][2];
#pragma unroll
    for (int a = 0; a < 2; ++a)
#pragma unroll
        for (int b = 0; b < 2; ++b)
#pragma unroll
            for (int m = 0; m < 4; ++m)
#pragma unroll
                for (int n = 0; n < 2; ++n) acc[a][b][m][n] = (f32x4){0.f, 0.f, 0.f, 0.f};
    bf16x8 At[4][2], B0[2][2], B1[2][2];
    const char* cA = (const char*)g.A + (size_t)cur.pm * tstep; const char* cB = (const char*)g.Bt + (size_t)cur.pn * tstep;
    S.a_ready(cur);
    if constexpr (SP2) {
        PG8_STAGE(PG8_SB(0, 0), cB, voffB); PG8_STAGE(PG8_SB(0, 1), cB + hstep, voffB); PG8_STAGE(PG8_SA(0, 0), cA, voffA); PG8_STAGE(PG8_SA(0, 1), cA + hstep, voffA);
        if (wr == 1) PG8_BAR;
        PG8_WAIT_V(2); PG8_BAR;
        PG8_STAGE(PG8_SB(1, 0), cB + kstep, voffB); PG8_STAGE(PG8_SA(1, 0), cA + kstep, voffA); PG8_STAGE(PG8_SB(1, 1), cB + hstep + kstep, voffB);
        PG8_WAIT_V(6); PG8_BAR;
    } else {
        PG8_STAGE(PG8_SB(0, 0), cB, voffB); PG8_STAGE(PG8_SA(0, 0), cA, voffA); PG8_STAGE(PG8_SB(0, 1), cB + hstep, voffB); PG8_STAGE(PG8_SA(0, 1), cA + hstep, voffA);
        if (wr == 1) PG8_BAR;
        PG8_WAIT_V(4); PG8_BAR;
        PG8_STAGE(PG8_SB(1, 0), cB + kstep, voffB); PG8_STAGE(PG8_SA(1, 0), cA + kstep, voffA); PG8_STAGE(PG8_SB(1, 1), cB + hstep + kstep, voffB);
        PG8_WAIT_V(6); PG8_BAR;
    }
    for (;;) {
        const bool has_next = S.next(ui + 1, nxt);
        const char* nA = has_next ? (const char*)g.A + (size_t)nxt.pm * tstep : cA; const char* nB = has_next ? (const char*)g.Bt + (size_t)nxt.pn * tstep : cB;
        for (int t = 0; t < nt; t += 2) {
            const bool last = (t == nt - 2);
            const char* a1 = cA + (size_t)(t + 1) * kstep;
            const char* a2 = last ? nA : cA + (size_t)(t + 2) * kstep; const char* b2 = last ? nB : cB + (size_t)(t + 2) * kstep;
            const char* a3 = a2 + kstep; const char* b3 = b2 + kstep;
            if (last && has_next) S.a_ready(nxt);
            if constexpr (SP2) {
            PG8_LDB(B0, 0, 0); PG8_LDB(B1, 0, 1); PG8_SCHED; PG8_LDA(At, 0, 0); PG8_STAGE(PG8_SA(1, 1), a1 + hstep, voffA);
            PG8_WAIT_V(8); PG8_WAIT_L(0); PG8_BAR; PG8_MMA(0, 0, At, B0); PG8_MMA(0, 1, At, B1); PG8_BAR; PG8_SCHED;
            PG8_LDA(At, 0, 1); PG8_STAGE(PG8_SB(0, 0), b2, voffB); PG8_STAGE(PG8_SB(0, 1), b2 + hstep, voffB); PG8_STAGE(PG8_SA(0, 0), a2, voffA);
            PG8_WAIT_V(8); PG8_WAIT_L(0); PG8_BAR; PG8_MMA(1, 0, At, B0); PG8_MMA(1, 1, At, B1); PG8_BAR; PG8_SCHED;
            PG8_LDB(B0, 1, 0); PG8_LDB(B1, 1, 1); PG8_SCHED; PG8_LDA(At, 1, 0); PG8_STAGE(PG8_SA(0, 1), a2 + hstep, voffA);
            PG8_WAIT_V(8); PG8_WAIT_L(0); PG8_BAR; PG8_MMA(0, 0, At, B0); PG8_MMA(0, 1, At, B1); PG8_BAR; PG8_SCHED;
            PG8_LDA(At, 1, 1); PG8_STAGE(PG8_SB(1, 0), b3, voffB); PG8_STAGE(PG8_SB(1, 1), b3 + hstep, voffB); PG8_STAGE(PG8_SA(1, 0), a3, voffA);
            PG8_WAIT_V(8); PG8_WAIT_L(0); PG8_BAR; PG8_MMA(1, 0, At, B0); PG8_MMA(1, 1, At, B1); PG8_BAR; PG8_SCHED;
            } else {
            PG8_LDB(B0, 0, 0); PG8_SCHED; PG8_LDA(At, 0, 0); PG8_STAGE(PG8_SA(1, 1), a1 + hstep, voffA);
            PG8_WAIT_L(8); PG8_BAR; PG8_WAIT_L(0); PG8_MMA(0, 0, At, B0); PG8_BAR; PG8_SCHED;
            PG8_LDB(B1, 0, 1); PG8_STAGE(PG8_SB(0, 0), b2, voffB);
            PG8_BAR; PG8_WAIT_L(0); PG8_MMA(0, 1, At, B1); PG8_BAR;
            PG8_LDA(At, 0, 1); PG8_STAGE(PG8_SA(0, 0), a2, voffA);
            PG8_BAR; PG8_WAIT_L(0); PG8_MMA(1, 0, At, B0); PG8_BAR; PG8_SCHED;
            PG8_STAGE(PG8_SB(0, 1), b2 + hstep, voffB);
            PG8_WAIT_V(6); PG8_BAR; PG8_MMA(1, 1, At, B1); PG8_BAR;
            PG8_LDB(B0, 1, 0); PG8_SCHED; PG8_LDA(At, 1, 0); PG8_STAGE(PG8_SA(0, 1), a2 + hstep, voffA);
            PG8_WAIT_L(8); PG8_BAR; PG8_WAIT_L(0); PG8_MMA(0, 0, At, B0); PG8_BAR; PG8_SCHED;
            PG8_LDB(B1, 1, 1); PG8_STAGE(PG8_SB(1, 0), b3, voffB);
            PG8_BAR; PG8_WAIT_L(0); PG8_MMA(0, 1, At, B1); PG8_BAR;
            PG8_LDA(At, 1, 1); PG8_STAGE(PG8_SA(1, 0), a3, voffA);
            PG8_BAR; PG8_WAIT_L(0); PG8_MMA(1, 0, At, B0); PG8_BAR; PG8_SCHED;
            PG8_STAGE(PG8_SB(1, 1), b3 + hstep, voffB);
            PG8_WAIT_V(6); PG8_BAR; PG8_MMA(1, 1, At, B1); PG8_BAR;
            }
        }
        if constexpr (ALIGN_EPI) { if (wr == 0) PG8_BAR; }
        if constexpr (!Epi::AFTER_DRAIN) { E(acc, cur, wr, wc, fr, fq); S.done(cur); }
        if (!has_next) break;
#pragma unroll
        for (int a = 0; a < 2; ++a)
#pragma unroll
            for (int b = 0; b < 2; ++b)
#pragma unroll
                for (int m = 0; m < 4; ++m)
#pragma unroll
                    for (int n = 0; n < 2; ++n) acc[a][b][m][n] = (f32x4){0.f, 0.f, 0.f, 0.f};
        cur = nxt; cA = nA; cB = nB; ++ui;
        if constexpr (ALIGN_EPI) { if (wr == 1) PG8_BAR; }
    }
    PG8_WAIT_V(0);
    if constexpr (!ALIGN_EPI) { if (wr == 0) PG8_BAR; }
    PG8_BAR;
#undef PG8_SA
#undef PG8_SB
#undef PG8_STAGE
#undef PG8_LDA
#undef PG8_LDB
#undef PG8_MMA
#undef PG8_WAIT_V
#undef PG8_WAIT_L
#undef PG8_BAR
#undef PG8_SCHED
}
}

constexpr int NWAVES = 8;
constexpr int BATCH = 32, S = 2048, D = 1024, DEPTH = 4, FF = 4096;
constexpr int M = BATCH * S;
constexpr int NP = 2304;
constexpr int DIN = 2108;
constexpr int C_QA = 0, C_CKV = 256, C_QIDX = 384, C_QB = 512, C_KCMP = 1024, C_VCMP = 1152, C_KSLC = 1280, C_VSLC = 1408, C_KWIN = 1536, C_VWIN = 1664,
              C_UC = 1792, C_KIDX = 2048, C_WIDX = 2080, C_GATE = 2084;
constexpr int NC = 127;
constexpr float EPS = 1e-6f;
constexpr float NEGF = -1e30f;

__host__ __device__ __forceinline__ int win_src(int n) {
    if (n < 512) return n;
    if (n < 1024) return 548 + (n - 512);
    if (n < 1792) return 1060 + (n - 1024);
    if (n < 2048) return 1852 + (n - 1792);
    if (n < 2080) return 512 + (n - 2048);
    if (n < 2084) return 544 + (n - 2080);
    if (n < 2108) return 1828 + (n - 2084);
    return -1;
}

constexpr size_t MiB = 1u << 20;
constexpr size_t WS_CTL = 0, CTL_ZERO_BYTES = 1 * MiB;
constexpr size_t WS_W = 2 * MiB;
constexpr size_t W_IN_B = (size_t)NP * D * 2, W_OUT_B = (size_t)D * D * 2, W_UP_B = (size_t)FF * D * 2, W_DN_B = (size_t)D * FF * 2;
constexpr size_t W_LAYER_B = W_IN_B + W_OUT_B + W_UP_B + W_DN_B;
constexpr size_t WS_ROPE = 96 * MiB;
constexpr size_t WS_KC = 102 * MiB, WS_VC = 105 * MiB;
constexpr size_t WS_KCB = 124 * MiB, WS_VCB = 125 * MiB;
constexpr size_t WS_KA = 108 * MiB;
constexpr size_t WS_H = 128 * MiB;
constexpr size_t WS_F = 256 * MiB;
constexpr size_t WS_PROJ = 384 * MiB;
constexpr size_t WS_MIX = 672 * MiB;
constexpr size_t WS_MASK = 800 * MiB;
constexpr size_t WS_HID = 384 * MiB;
constexpr size_t WS_END = 896 * MiB;
static_assert(WS_W + DEPTH * W_LAYER_B <= WS_ROPE, "weights");
static_assert(WS_ROPE + (size_t)M * 24 * 4 <= WS_KC && WS_KC + (size_t)BATCH * NC * 128 * 4 <= WS_VC && WS_VC + (size_t)BATCH * NC * 128 * 4 <= WS_KA && WS_KA + (size_t)M * 128 * 2 <= WS_H, "map");
static_assert(WS_PROJ + (size_t)M * NP * 2 <= WS_MIX && WS_MIX + (size_t)M * D * 2 <= WS_END && WS_HID + (size_t)M * FF * 2 <= WS_END, "map2");

constexpr int CW_BAR = 4096;
constexpr int RING_BYTES = 131072;
constexpr int LDSCTL_OFF = RING_BYTES, MISC_OFF = LDSCTL_OFF + 320;
constexpr int LDS_BYTES = 147456;
constexpr int WSCR = 16384;

#define GAS __attribute__((address_space(1)))
#define LAS __attribute__((address_space(3)))
typedef unsigned short bf16;
typedef unsigned v4u __attribute__((ext_vector_type(4)));
typedef float f32x4 __attribute__((ext_vector_type(4)));
typedef GAS unsigned gu32;
#define LDS_FENCE() asm volatile("s_waitcnt lgkmcnt(0)" ::: "memory")
__device__ __forceinline__ unsigned f2bf(float f) { unsigned u = __builtin_bit_cast(unsigned, f); return (u + 0x7fffu + ((u >> 16) & 1u)) >> 16; }
__device__ __forceinline__ unsigned pk2(float lo, float hi) { return f2bf(lo) | (f2bf(hi) << 16); }
__device__ __forceinline__ float bf2f(bf16 u) { return __builtin_bit_cast(float, (unsigned)u << 16); }
__device__ __forceinline__ float bflo(unsigned u) { return __builtin_bit_cast(float, u << 16); }
__device__ __forceinline__ float bfhi(unsigned u) { return __builtin_bit_cast(float, u & 0xffff0000u); }

#define XB_TMO      128
#define XB_XCNT(j)  (256  + 64 * (j))
#define XB_XSUB(j)  (1280 + 64 * (j))
#define XB_XGEN(j)  (2304 + 64 * (j))
#define XB_TOP      3328
#define XB_TOPGEN   3392
#define XCD_BAR_WORDS 3456
#define XB_SPIN_CAP (1u << 22)

__device__ __forceinline__ unsigned xb_ld(unsigned* p)              { return __hip_atomic_load(p, __ATOMIC_RELAXED, __HIP_MEMORY_SCOPE_AGENT); }
__device__ __forceinline__ unsigned xb_add(unsigned* p, unsigned v) { return __hip_atomic_fetch_add(p, v, __ATOMIC_RELAXED, __HIP_MEMORY_SCOPE_AGENT); }
__device__ __forceinline__ unsigned xb_xcc_id() { return (unsigned)__builtin_amdgcn_s_getreg((3 << 11) | 20) & 0xFu; }
#define XB_SPIN(cond, bar) do { unsigned _sp = 0; while (cond) { __builtin_amdgcn_s_sleep(1); \
    if ((++_sp & 255u) == 0u) { if (xb_ld(&(bar)[XB_TMO])) break; if (_sp > XB_SPIN_CAP) { atomicAdd(&(bar)[XB_TMO], 1u); break; } } } } while (0)

struct XcdBarrier { unsigned* bar; unsigned x; volatile LAS unsigned* st; };

__device__ __forceinline__ XcdBarrier xcd_barrier_post(unsigned* bar, volatile LAS unsigned* st) {
    XcdBarrier b; b.bar = bar; b.x = xb_xcc_id(); b.st = st;
    if (threadIdx.x == 0) (void)xb_add(&bar[XB_XCNT(b.x)], 1u);
    return b;
}
__device__ __forceinline__ void xcd_barrier_complete(unsigned* bar, unsigned x, unsigned& nloc, unsigned& nx) {
    const unsigned G = gridDim.x * gridDim.y * gridDim.z;
    unsigned sum, cnt, mine, sp = 0u;
    for (;;) {
        sum = 0u; cnt = 0u; mine = 0u;
#pragma unroll
        for (unsigned j = 0; j < 16; ++j) { const unsigned c = xb_ld(&bar[XB_XCNT(j)]); sum += c; cnt += (c > 0u) ? 1u : 0u; mine = (j == x) ? c : mine; }
        if (sum == G) break;
        __builtin_amdgcn_s_sleep(1);
        if ((++sp & 255u) == 0u) { if (xb_ld(&bar[XB_TMO])) break; if (sp > XB_SPIN_CAP) { atomicAdd(&bar[XB_TMO], 1u); break; } }
    }
    nloc = mine > 0u ? mine : 1u; nx = cnt > 0u ? cnt : 1u;
}
__device__ __forceinline__ void xcd_barrier(const XcdBarrier& b) {
    asm volatile("s_waitcnt vmcnt(0)" ::: "memory");
    __syncthreads();
    if (threadIdx.x == 0) {
        unsigned* bar = b.bar; asm volatile("" : "+s"(bar));
        __builtin_amdgcn_s_waitcnt(0);
        unsigned nloc = b.st[0], nx = b.st[1];
        if (nloc == 0u) { xcd_barrier_complete(bar, b.x, nloc, nx); b.st[0] = nloc; b.st[1] = nx; }
        const unsigned old = xb_add(&bar[XB_XSUB(b.x)], 1u);
        const unsigned gen = old / nloc;
        if (old + 1u == (gen + 1u) * nloc) {
            __builtin_amdgcn_fence(__ATOMIC_RELEASE, "agent");
            asm volatile("s_waitcnt vmcnt(0)" ::: "memory");
            const unsigned og = xb_add(&bar[XB_TOP], 1u);
            const unsigned tg = og / nx;
            if (og + 1u == (tg + 1u) * nx) xb_add(&bar[XB_TOPGEN], 1u);
            else XB_SPIN(xb_ld(&bar[XB_TOPGEN]) == tg, bar);
            __builtin_amdgcn_fence(__ATOMIC_ACQUIRE, "agent");
            xb_add(&bar[XB_XGEN(b.x)], 1u);
            asm volatile("s_waitcnt vmcnt(0)" ::: "memory");
        } else {
            XB_SPIN(xb_ld(&bar[XB_XGEN(b.x)]) == gen, bar);
            __builtin_amdgcn_fence(__ATOMIC_ACQUIRE, "agent");
            asm volatile("s_waitcnt vmcnt(0)" ::: "memory");
        }
    }
    __syncthreads();
}

struct Frame {
    LAS unsigned char* lds;
    volatile LAS unsigned* MISC;
    gu32* ctl;
    int tid, lane, wave, vcu, G;
    float* out; unsigned char* ws;
};
struct Args { const void* in[20]; float* out; unsigned char* ws; int ph_lo, ph_hi, use_bar, pad; };
#define IN_F(k) ((const float*)args.in[k])
#define P_X_IN IN_F(0)
#define P_POS ((const int*)args.in[1])
#define P_W_IN IN_F(2)
#define P_G_KV_A IN_F(3)
#define P_W_KV_UP IN_F(4)
#define P_W_CMP_K IN_F(5)
#define P_W_CMP_V IN_F(6)
#define P_PE_K IN_F(7)
#define P_PE_V IN_F(8)
#define P_W_POOL IN_F(9)
#define P_POOL_SCALE IN_F(10)
#define P_G_OUT_A IN_F(11)
#define P_G_OUT_B IN_F(12)
#define P_W_OUT IN_F(13)
#define P_G_PRE_MIX IN_F(14)
#define P_G_POST_MIX IN_F(15)
#define P_G_PRE_MLP IN_F(16)
#define P_G_POST_MLP IN_F(17)
#define P_W_UP IN_F(18)
#define P_W_DOWN IN_F(19)
#define B_ROPE ((float*)(ws_ + WS_ROPE))
#define B_KC ((float*)(ws_ + WS_KC))
#define B_VC ((float*)(ws_ + WS_VC))
#define B_KA ((bf16*)(ws_ + WS_KA))
#define B_H ((bf16*)(ws_ + WS_H))
#define B_F ((bf16*)(ws_ + WS_F))
#define B_PROJ ((bf16*)(ws_ + WS_PROJ))
#define B_MIX ((bf16*)(ws_ + WS_MIX))
#define B_HID ((bf16*)(ws_ + WS_HID))

__device__ __forceinline__ float wave_sum(float v) {
#pragma unroll
    for (int o = 1; o < 64; o <<= 1) v += __shfl_xor(v, o);
    return v;
}
__device__ __forceinline__ float wave_max(float v) {
#pragma unroll
    for (int o = 1; o < 64; o <<= 1) v = fmaxf(v, __shfl_xor(v, o));
    return v;
}
__device__ __forceinline__ int wave_sum_i(int v) {
#pragma unroll
    for (int o = 1; o < 64; o <<= 1) v += __shfl_xor(v, o);
    return v;
}

__constant__ double c_rope_inv[12] = {1.0, 0.19392274474868576, 0.03760603093086393, 0.007292664737217109, 0.001414213562373095, 0.0002742481756762073, 5.318295896944988e-05, 1.031338537721246e-05,
                                       1.0, 0.03760603093086393, 0.001414213562373095, 5.318295896944988e-05};
template <int MODE>
__device__ __forceinline__ void transpose_item(const float* W, int K, int Nsrc, int nblk, bf16* WT, LAS float* scr, int item, int lane) {
    const int kb = item / nblk, nb = item % nblk, k0 = 64 * kb, n0 = 32 * nb;
    const int np = n0 + (lane & 31);
    const int src = MODE ? win_src(np) : np;
#pragma unroll 8
    for (int i = 0; i < 32; ++i) { const int kk = 2 * i + (lane >> 5); scr[kk * 33 + (lane & 31)] = (src >= 0) ? W[(size_t)(k0 + kk) * Nsrc + src] : 0.f; }
    LDS_FENCE();
    const int c = lane & 7;
#pragma unroll
    for (int j = 0; j < 4; ++j) { const int n = (lane >> 3) + 8 * j; const LAS float* s = scr + (8 * c) * 33 + n;
        v4u o; o.x = pk2(s[0 * 33], s[1 * 33]); o.y = pk2(s[2 * 33], s[3 * 33]); o.z = pk2(s[4 * 33], s[5 * 33]); o.w = pk2(s[6 * 33], s[7 * 33]);
        *(v4u*)(WT + (size_t)(n0 + n) * K + k0 + 8 * c) = o; }
    LDS_FENCE();
}

__device__ __forceinline__ bf16* w_in_t(unsigned char* ws_, int l)  { return (bf16*)(ws_ + WS_W + (size_t)l * W_LAYER_B); }
__device__ __forceinline__ bf16* w_out_t(unsigned char* ws_, int l) { return (bf16*)(ws_ + WS_W + (size_t)l * W_LAYER_B + W_IN_B); }
__device__ __forceinline__ bf16* w_up_t(unsigned char* ws_, int l)  { return (bf16*)(ws_ + WS_W + (size_t)l * W_LAYER_B + W_IN_B + W_OUT_B); }
__device__ __forceinline__ bf16* w_dn_t(unsigned char* ws_, int l)  { return (bf16*)(ws_ + WS_W + (size_t)l * W_LAYER_B + W_IN_B + W_OUT_B + W_UP_B); }

__device__ __forceinline__ void norm_row_to_bf16(const float* xrow, const float* gain, bf16* orow, int lane) {
    const f32x4* xr = (const f32x4*)xrow + lane;
    f32x4 v[4]; float s = 0.f;
#pragma unroll
    for (int j = 0; j < 4; ++j) { v[j] = xr[64 * j]; s += (v[j].x * v[j].x + v[j].y * v[j].y) + (v[j].z * v[j].z + v[j].w * v[j].w); }
    const float rs = rsqrtf(wave_sum(s) * (1.f / D) + EPS);
    unsigned long long* o8 = (unsigned long long*)orow + lane;
#pragma unroll
    for (int j = 0; j < 4; ++j) { const f32x4 g = ((const f32x4*)gain)[lane + 64 * j];
        o8[64 * j] = (unsigned long long)pk2(v[j].x * rs * g.x, v[j].y * rs * g.y) | ((unsigned long long)pk2(v[j].z * rs * g.z, v[j].w * rs * g.w) << 32); }
}

__device__ __forceinline__ void phase_prologue(Frame& F, const Args& args) {
    unsigned char* ws_ = F.ws; asm volatile("" : "+s"(ws_)); int lane_ = F.lane; asm volatile("" : "+v"(lane_)); (void)ws_;
    LAS float* scr = (LAS float*)(F.lds + F.wave * WSCR);
    const int gw = F.vcu * NWAVES + F.wave, NGW = F.G * NWAVES;
    constexpr int I_IN = (D / 64) * (NP / 32), I_OUT = (D / 64) * (D / 32), I_UP = (D / 64) * (FF / 32), I_DN = (FF / 64) * (D / 32);
    for (int it = gw; it < DEPTH * I_IN; it += NGW) { const int l = it / I_IN, r = it % I_IN; transpose_item<1>(P_W_IN + (size_t)l * D * DIN, D, DIN, NP / 32, w_in_t(ws_, l), scr, r, lane_); }
    for (int it = gw; it < DEPTH * I_OUT; it += NGW) { const int l = it / I_OUT, r = it % I_OUT; transpose_item<0>(P_W_OUT + (size_t)l * D * D, D, D, D / 32, w_out_t(ws_, l), scr, r, lane_); }
    for (int it = gw; it < DEPTH * I_UP; it += NGW) { const int l = it / I_UP, r = it % I_UP; transpose_item<0>(P_W_UP + (size_t)l * D * FF, D, FF, FF / 32, w_up_t(ws_, l), scr, r, lane_); }
    for (int it = gw; it < DEPTH * I_DN; it += NGW) { const int l = it / I_DN, r = it % I_DN; transpose_item<0>(P_W_DOWN + (size_t)l * FF * D, FF, D, D / 32, w_dn_t(ws_, l), scr, r, lane_); }
    for (int e = gw * 64 + lane_; e < M * 12; e += NGW * 64) {
        const int row = e / 12, i = e % 12;
        const double inv = c_rope_inv[i];
        const double a = (double)P_POS[row] * inv;
        const double k = __builtin_rint(a * 0.15915494309189535);
        const float r = (float)(a - k * 6.283185307179586);
        const float c = __builtin_cosf(r), s = __builtin_sinf(r);
        float* t = B_ROPE + (size_t)row * 24;
        if (i < 8) { t[i] = c; t[8 + i] = s; } else { t[16 + (i - 8)] = c; t[20 + (i - 8)] = s; }
    }
    for (int m = gw; m < M; m += NGW) norm_row_to_bf16(P_X_IN + (size_t)m * D, P_G_PRE_MIX, B_H + (size_t)m * D, lane_);
}

__device__ __forceinline__ void phase_prep(Frame& F, const Args& args, int l) {
    unsigned char* ws_ = F.ws; asm volatile("" : "+s"(ws_)); int lane_ = F.lane; asm volatile("" : "+v"(lane_)); (void)ws_;
    LAS float* xs = (LAS float*)(F.lds + F.wave * WSCR);
    const int gw = F.vcu * NWAVES + F.wave, NGW = F.G * NWAVES, lane = lane_;
    const float* gkv = P_G_KV_A + l * 128; const float* Wkv = P_W_KV_UP + (size_t)l * 128 * 128;
    for (int row = gw; row < M; row += NGW) {
        bf16* prow = B_PROJ + (size_t)row * NP;
        const float* tab = B_ROPE + (size_t)row * 24;
        const unsigned u = *(const unsigned*)(prow + C_CKV + 2 * lane);
        const float x0 = bflo(u), x1 = bfhi(u);
        const float rs = rsqrtf(wave_sum(x0 * x0 + x1 * x1) * (1.f / 128.f) + EPS);
        xs[2 * lane] = x0 * rs * gkv[2 * lane]; xs[2 * lane + 1] = x1 * rs * gkv[2 * lane + 1];
        LDS_FENCE();
        float a0 = 0.f, a1 = 0.f;
#pragma unroll 8
        for (int k = 0; k < 128; ++k) { const float xv = xs[k]; a0 += xv * Wkv[k * 128 + lane]; a1 += xv * Wkv[k * 128 + 64 + lane]; }
        LDS_FENCE();
        {
            const float partner = __shfl_xor(a0, 8);
            const int i = lane & 7; const float c = tab[i], s = tab[8 + i];
            float kr = a0;
            if (lane < 8) kr = a0 * c - partner * s; else if (lane < 16) kr = partner * s + a0 * c;
            B_KA[(size_t)row * 128 + lane] = (bf16)f2bf(kr); B_KA[(size_t)row * 128 + 64 + lane] = (bf16)f2bf(a1);
        }
        if (lane < 4) { const int i = lane; const float c = tab[16 + i], s = tab[20 + i];
            const float x1v = bf2f(prow[C_KIDX + i]), x2v = bf2f(prow[C_KIDX + 4 + i]);
            prow[C_KIDX + i] = (bf16)f2bf(x1v * c - x2v * s); prow[C_KIDX + 4 + i] = (bf16)f2bf(x1v * s + x2v * c);
        } else if (lane < 36) { const int idx = lane - 4, which = idx >> 3, i = idx & 7; const int base = ((which < 2) ? C_KSLC : C_KWIN) + (which & 1) * 64;
            const float c = tab[i], s = tab[8 + i];
            const float x1v = bf2f(prow[base + i]), x2v = bf2f(prow[base + 8 + i]);
            prow[base + i] = (bf16)f2bf(x1v * c - x2v * s); prow[base + 8 + i] = (bf16)f2bf(x1v * s + x2v * c);
        }
    }
    for (int it = gw; it < BATCH * 128 * 2; it += NGW) {
        const int kv = it & 1, bc = it >> 1, b = bc >> 7, c = bc & 127;
        bf16* ob = (bf16*)(ws_ + (kv ? WS_VCB : WS_KCB));
        if (c == NC) { ob[((size_t)(b * 2 + 0) * 128 + c) * 64 + lane] = 0; ob[((size_t)(b * 2 + 1) * 128 + c) * 64 + lane] = 0; continue; }
        const float* W = (kv ? P_W_CMP_V : P_W_CMP_K) + (size_t)l * 32 * 64 * 64;
        const float* pe = (kv ? P_PE_V : P_PE_K) + l * 32 * 64;
        float acc0 = 0.f, acc1 = 0.f;
        for (int li = 0; li < 32; ++li) {
            const bf16* prow = B_PROJ + (size_t)(b * S + 16 * c + li) * NP + (kv ? C_VCMP : C_KCMP);
            const float pev = pe[li * 64 + lane];
            const float xv0 = bf2f(prow[lane]) + pev, xv1 = bf2f(prow[64 + lane]) + pev;
            const float* Wl = W + (size_t)li * 64 * 64 + lane;
#pragma unroll 16
            for (int d = 0; d < 64; ++d) { const float w = Wl[d * 64]; acc0 += __shfl(xv0, d) * w; acc1 += __shfl(xv1, d) * w; }
        }
        float* o = (kv ? B_VC : B_KC) + ((size_t)(b * NC + c) * 2) * 64;
        o[lane] = acc0; o[64 + lane] = acc1;
        ob[((size_t)(b * 2 + 0) * 128 + c) * 64 + lane] = (bf16)f2bf(acc0); ob[((size_t)(b * 2 + 1) * 128 + c) * 64 + lane] = (bf16)f2bf(acc1);
    }
}

__device__ __forceinline__ void dsa_token(unsigned char* ws_, int lane_, int b, int t, LAS unsigned char* scr) {
    const int lane = lane_;
    const size_t row = (size_t)b * S + t;
    const bf16* prow = B_PROJ + row * NP;
    LAS float* sc = (LAS float*)scr;
    LAS unsigned* ku = (LAS unsigned*)scr;
    LAS float* qi = (LAS float*)(scr + 8192);
    LAS float* qa = (LAS float*)(scr + 8192 + 512);
    LAS int* list = (LAS int*)(scr + 8192 + 512 + 1024);
    LAS float* pp = (LAS float*)(scr + 8192 + 512 + 1024 + 1024);
    const float* tab = B_ROPE + row * 24;
    { const unsigned u = *(const unsigned*)(prow + C_QIDX + 2 * lane); qi[2 * lane] = bflo(u); qi[2 * lane + 1] = bfhi(u); }
#pragma unroll
    for (int j = 0; j < 2; ++j) { const unsigned u = *(const unsigned*)(prow + C_QA + 2 * lane + 128 * j); qa[2 * lane + 128 * j] = bflo(u); qa[2 * lane + 128 * j + 1] = bfhi(u); }
    LDS_FENCE();
    if (lane < 16) { const int h = lane >> 2, i = lane & 3; const float c = tab[16 + i], s = tab[20 + i]; const float x1 = qi[h * 32 + i], x2 = qi[h * 32 + 4 + i];
        qi[h * 32 + i] = x1 * c - x2 * s; qi[h * 32 + 4 + i] = x1 * s + x2 * c; }
    if (lane >= 32) { const int h = (lane - 32) >> 3, i = lane & 7; const float c = tab[i], s = tab[8 + i]; const float x1 = qa[h * 64 + i], x2 = qa[h * 64 + 8 + i];
        qa[h * 64 + i] = x1 * c - x2 * s; qa[h * 64 + 8 + i] = x1 * s + x2 * c; }
    LDS_FENCE();
    const int nk = t + 1;
    int nsel;
    {
        const unsigned* mr = (const unsigned*)(ws_ + WS_MASK) + row * 64;
        int pos = 0;
        const unsigned long long lt = (1ull << lane) - 1ull;
        for (int s0 = 0; s0 < nk; s0 += 64) {
            const int s = s0 + lane; const bool in = s < nk;
            const bool sel = in && ((mr[s >> 5] >> (s & 31)) & 1u);
            const unsigned long long bsel = __ballot(sel);
            const int pp_ = pos + __popcll(bsel & lt);
            if (sel && pp_ < 256) list[pp_] = s;
            pos += __popcll(bsel);
        }
        nsel = pos < 256 ? pos : 256;
    }
    LDS_FENCE();
    const bf16* kab = B_KA + (size_t)b * S * 128;
    float lg[4][4];
#pragma unroll
    for (int i = 0; i < 4; ++i) {
        const int e = lane + 64 * i;
#pragma unroll
        for (int h = 0; h < 4; ++h) lg[i][h] = NEGF;
        if (e < nsel) {
            const int s = list[e];
            const v4u* kp = (const v4u*)(kab + (size_t)s * 128);
            float acc[4] = {0.f, 0.f, 0.f, 0.f};
#pragma unroll
            for (int q = 0; q < 8; ++q) { const v4u kk = kp[q]; float kf[8];
                kf[0] = bflo(kk.x); kf[1] = bfhi(kk.x); kf[2] = bflo(kk.y); kf[3] = bfhi(kk.y); kf[4] = bflo(kk.z); kf[5] = bfhi(kk.z); kf[6] = bflo(kk.w); kf[7] = bfhi(kk.w);
#pragma unroll
                for (int h = 0; h < 4; ++h)
#pragma unroll
                    for (int dd = 0; dd < 8; ++dd) acc[h] += qa[h * 64 + 8 * q + dd] * kf[dd]; }
#pragma unroll
            for (int h = 0; h < 4; ++h) lg[i][h] = acc[h] * 0.125f;
        }
    }
#pragma unroll
    for (int h = 0; h < 4; ++h) {
        float m = fmaxf(fmaxf(lg[0][h], lg[1][h]), fmaxf(lg[2][h], lg[3][h])); m = wave_max(m);
        float p[4], sum = 0.f;
#pragma unroll
        for (int i = 0; i < 4; ++i) { p[i] = (lane + 64 * i < nsel) ? __expf(lg[i][h] - m) : 0.f; sum += p[i]; }
        sum = wave_sum(sum); const float inv = 1.f / sum;
#pragma unroll
        for (int i = 0; i < 4; ++i) pp[(lane + 64 * i) * 4 + h] = p[i] * inv;
    }
    LDS_FENCE();
    float o[4] = {0.f, 0.f, 0.f, 0.f};
    for (int e = 0; e < nsel; ++e) {
        const int s = list[e];
        const float v = bf2f(kab[(size_t)s * 128 + 64 + lane]);
        const f32x4 p4 = *(const LAS f32x4*)(pp + e * 4);
        o[0] += p4.x * v; o[1] += p4.y * v; o[2] += p4.z * v; o[3] += p4.w * v;
    }
    bf16* orow = B_MIX + row * D;
#pragma unroll
    for (int h = 0; h < 4; ++h) orow[h * 64 + lane] = (bf16)f2bf(o[h]);
    LDS_FENCE();
}


typedef short bf16x8 __attribute__((ext_vector_type(8)));
typedef short s16x4 __attribute__((ext_vector_type(4)));
typedef float f32x16 __attribute__((ext_vector_type(16)));
#define MFMA32(a, b, c) __builtin_amdgcn_mfma_f32_32x32x16_bf16((a), (b), (c), 0, 0, 0)
__device__ __forceinline__ int crow(int r, int hi) { return (r & 3) + 8 * (r >> 2) + 4 * hi; }
__device__ __forceinline__ void wg_barrier() { asm volatile("s_waitcnt lgkmcnt(0)\n\ts_barrier" ::: "memory"); }
typedef float f32x2_t __attribute__((ext_vector_type(2))); typedef __bf16 bf16x2_t __attribute__((ext_vector_type(2)));
__device__ __forceinline__ unsigned cvtpk(float lo, float hi) { const f32x2_t v = {lo, hi}; const bf16x2_t b = __builtin_convertvector(v, bf16x2_t); return __builtin_bit_cast(unsigned, b); }
constexpr float C2 = 0.125f * 1.4426950408889634f;

__device__ __forceinline__ unsigned idxmask(int x, int hi) {
    unsigned m = 0u;
#pragma unroll
    for (int g = 0; g < 4; ++g) { int n = x - (8 * g + 4 * hi); n = n < 0 ? 0 : (n > 4 ? 4 : n); m |= ((1u << n) - 1u) << (4 * g); }
    return m;
}

constexpr int SEL_QF = 0, SEL_PART = 16384;
__device__ __forceinline__ void dsa_select_unit(unsigned char* ws_, int tid_, int b, int qt32, LAS unsigned char* lds) {
    asm volatile("" : "+v"(tid_)); asm volatile("" : "+s"(ws_));
    const int lane = tid_ & 63, wid = __builtin_amdgcn_readfirstlane(tid_ >> 6), r32 = lane & 31, hi = lane >> 5;
    unsigned* maskbuf = (unsigned*)(ws_ + WS_MASK);
    if (qt32 < 8) {
        for (int i = tid_; i < 2048; i += 512) { const int qq = i >> 6, blk = i & 63; const int t = 32 * qt32 + qq; const int d = t - 32 * blk;
            const unsigned w = d < 0 ? 0u : (d >= 31 ? 0xffffffffu : ((2u << d) - 1u));
            maskbuf[((size_t)b * S + t) * 64 + blk] = w; }
        return;
    }
    const size_t qrow = (size_t)b * S + 32 * qt32 + r32;
    const bf16* prow = B_PROJ + qrow * NP;
    {
        const int h = wid >> 1, sk = wid & 1;
        const v4u raw = *(const v4u*)(prow + C_QIDX + h * 32 + 16 * sk + 8 * hi);
        float x[8] = {bflo(raw.x), bfhi(raw.x), bflo(raw.y), bfhi(raw.y), bflo(raw.z), bfhi(raw.z), bflo(raw.w), bfhi(raw.w)};
        if (sk == 0 && hi == 0) { const float* tab = B_ROPE + qrow * 24;
#pragma unroll
            for (int i = 0; i < 4; ++i) { const float c = tab[16 + i], sn = tab[20 + i]; const float x1 = x[i], x2 = x[4 + i]; x[i] = x1 * c - x2 * sn; x[4 + i] = x1 * sn + x2 * c; } }
        v4u hp, lp;
        { unsigned hh[4], ll[4];
#pragma unroll
          for (int k = 0; k < 4; ++k) { const float a = x[2 * k], bb = x[2 * k + 1]; const unsigned ha = f2bf(a), hb = f2bf(bb); hh[k] = ha | (hb << 16);
              ll[k] = pk2(a - bf2f((bf16)ha), bb - bf2f((bf16)hb)); }
          hp = (v4u){hh[0], hh[1], hh[2], hh[3]}; lp = (v4u){ll[0], ll[1], ll[2], ll[3]}; }
        LAS v4u* qf = (LAS v4u*)(lds + SEL_QF);
        qf[((h * 2 + sk) * 2 + 0) * 64 + lane] = hp; qf[((h * 2 + sk) * 2 + 1) * 64 + lane] = lp;
    }
    float w[4];
#pragma unroll
    for (int h = 0; h < 4; ++h) w[h] = bf2f(prow[C_WIDX + h]);
    __syncthreads();
    const int nblk = qt32 + 1;
    const bf16* kbase = B_PROJ + (size_t)b * S * NP + C_KIDX;
    unsigned key[8][16];
#pragma unroll
    for (int i = 0; i < 8; ++i) {
        const int blk = wid + 8 * i;
        if (blk < nblk) {
            const bf16* kp = kbase + (size_t)(32 * blk + r32) * NP + 8 * hi;
            const bf16x8 kf0 = *(const bf16x8*)kp, kf1 = *(const bf16x8*)(kp + 16);
            float sc[16];
            const LAS bf16x8* qf = (const LAS bf16x8*)(lds + SEL_QF);
#pragma unroll
            for (int h = 0; h < 4; ++h) {
                f32x16 acc = {};
                acc = MFMA32(kf0, qf[((h * 2 + 0) * 2 + 0) * 64 + lane], acc);
                acc = MFMA32(kf1, qf[((h * 2 + 1) * 2 + 0) * 64 + lane], acc);
                acc = MFMA32(kf0, qf[((h * 2 + 0) * 2 + 1) * 64 + lane], acc);
                acc = MFMA32(kf1, qf[((h * 2 + 1) * 2 + 1) * 64 + lane], acc);
#pragma unroll
                for (int r = 0; r < 16; ++r) sc[r] = (h == 0) ? w[0] * fmaxf(acc[r], 0.f) : fmaf(w[h], fmaxf(acc[r], 0.f), sc[r]);
            }
#pragma unroll
            for (int r = 0; r < 16; ++r) {
                unsigned bits = __builtin_bit_cast(unsigned, sc[r]);
                if (bits == 0x80000000u) bits = 0u;
                unsigned k = (bits & 0x80000000u) ? ~bits : (bits | 0x80000000u);
                if (blk == qt32 && crow(r, hi) > r32) k = 0u;
                key[i][r] = k;
            }
        } else {
#pragma unroll
            for (int r = 0; r < 16; ++r) key[i][r] = 0u;
        }
    }
    LAS unsigned* part = (LAS unsigned*)(lds + SEL_PART);
    int pbi = 0;
#define SEL_REDUCE(cnt_, tot_) do { LAS unsigned* pb_ = part + (pbi & 1) * 512; ++pbi; pb_[wid * 64 + lane] = (cnt_); wg_barrier(); unsigned t_ = 0u; \
        _Pragma("unroll") for (int w8 = 0; w8 < 8; ++w8) t_ += pb_[w8 * 64 + r32] + pb_[w8 * 64 + 32 + r32]; (tot_) = t_; } while (0)
    unsigned prefix = 0u;
    for (int bit = 31; bit >= 0; --bit) {
        const unsigned cand = prefix | (1u << bit);
        unsigned cnt = 0u;
#pragma unroll
        for (int i = 0; i < 8; ++i) if (wid + 8 * i < nblk) {
#pragma unroll
            for (int r = 0; r < 16; ++r) cnt += (key[i][r] >= cand) ? 1u : 0u; }
        unsigned tot; SEL_REDUCE(cnt, tot);
        if (tot >= 256u) prefix = cand;
    }
    const unsigned thr = prefix;
    unsigned gtm[8], eqm[8]; unsigned cg = 0u;
#pragma unroll
    for (int i = 0; i < 8; ++i) { unsigned g = 0u, e = 0u;
        if (wid + 8 * i < nblk) {
#pragma unroll
            for (int r = 0; r < 16; ++r) { g |= (key[i][r] > thr) ? (1u << r) : 0u; e |= (key[i][r] == thr) ? (1u << r) : 0u; } }
        gtm[i] = g; eqm[i] = e; cg += __builtin_popcount(g); }
    unsigned cgt; SEL_REDUCE(cg, cgt);
    const unsigned rneed = 256u - cgt;
    unsigned Y = 0u;
    for (int bit = 10; bit >= 0; --bit) {
        const unsigned c = Y | (1u << bit);
        unsigned cnt = 0u;
#pragma unroll
        for (int i = 0; i < 8; ++i) cnt += __builtin_popcount(eqm[i] & idxmask((int)c - 32 * (wid + 8 * i), hi));
        unsigned tot; SEL_REDUCE(cnt, tot);
        if (tot < rneed) Y = c;
    }
#undef SEL_REDUCE
#pragma unroll
    for (int i = 0; i < 8; ++i) {
        const int blk = wid + 8 * i;
        const unsigned selm = gtm[i] | (eqm[i] & idxmask((int)Y + 1 - 32 * blk, hi));
        unsigned word = ((selm & 0xFu) | ((selm & 0xF0u) << 4) | ((selm & 0xF00u) << 8) | ((selm & 0xF000u) << 12)) << (4 * hi);
        word |= (unsigned)__shfl_xor((int)word, 32);
        if (hi == 0) maskbuf[qrow * 64 + blk] = word;
    }
    __syncthreads();
}

constexpr int AT_K = 0, AT_V = 16384, AT_WS = 32768;
__device__ __forceinline__ void qkt(f32x16& p0, f32x16& p1, const LAS unsigned char* Kslot, const bf16x8* qr, const f32x16& negm, int r32, int hi) {
    const LAS unsigned char* kb = Kslot + hi * 1024 + r32 * 16;
#pragma unroll
    for (int d0 = 0; d0 < 4; ++d0) {
        const bf16x8 b0 = *(const LAS bf16x8*)(kb + d0 * 2048);
        const bf16x8 b1 = *(const LAS bf16x8*)(kb + d0 * 2048 + 512);
        if (d0 == 0) { p0 = MFMA32(b0, qr[0], negm); p1 = MFMA32(b1, qr[0], negm); }
        else { p0 = MFMA32(b0, qr[d0], p0); p1 = MFMA32(b1, qr[d0], p1); }
    }
}
__device__ __forceinline__ void pv(f32x16* o, unsigned vb, bf16x8 pa0, bf16x8 pa1, bf16x8 pa2, bf16x8 pa3) {
#pragma unroll
    for (int d0 = 0; d0 < 2; ++d0) { s16x4 lo0, lo1, lo2, lo3, hi0, hi1, hi2, hi3;
        asm volatile("ds_read_b64_tr_b16 %0,%8 offset:%c9\n\tds_read_b64_tr_b16 %1,%8 offset:%c10\n\tds_read_b64_tr_b16 %2,%8 offset:%c11\n\tds_read_b64_tr_b16 %3,%8 offset:%c12\n\t"
                     "ds_read_b64_tr_b16 %4,%8 offset:%c13\n\tds_read_b64_tr_b16 %5,%8 offset:%c14\n\tds_read_b64_tr_b16 %6,%8 offset:%c15\n\tds_read_b64_tr_b16 %7,%8 offset:%c16\n\t"
                     "s_waitcnt lgkmcnt(0)"
                     : "=&v"(lo0), "=&v"(hi0), "=&v"(lo1), "=&v"(hi1), "=&v"(lo2), "=&v"(hi2), "=&v"(lo3), "=&v"(hi3)
                     : "v"(vb), "i"(d0 * 4096 + 0), "i"(d0 * 4096 + 512), "i"(d0 * 4096 + 1024), "i"(d0 * 4096 + 1536), "i"(d0 * 4096 + 2048), "i"(d0 * 4096 + 2560), "i"(d0 * 4096 + 3072), "i"(d0 * 4096 + 3584)
                     : "memory");
#define PKV(l_, h_) (bf16x8){l_[0], l_[1], l_[2], l_[3], h_[0], h_[1], h_[2], h_[3]}
        o[d0] = MFMA32(pa0, PKV(lo0, hi0), o[d0]);
        o[d0] = MFMA32(pa1, PKV(lo1, hi1), o[d0]);
        o[d0] = MFMA32(pa2, PKV(lo2, hi2), o[d0]);
        o[d0] = MFMA32(pa3, PKV(lo3, hi3), o[d0]);
#undef PKV
    }
}
struct SmState { float mhat, l; f32x16 o[2]; f32x16 negm; };
__device__ __forceinline__ float rowmax32(const f32x16& p0, const f32x16& p1) {
    float a = fmaxf(p0[0], p1[0]);
#pragma unroll
    for (int r = 1; r < 16; ++r) a = fmaxf(a, fmaxf(p0[r], p1[r]));
    return fmaxf(a, __shfl_xor(a, 32));
}
__device__ __forceinline__ void sm_rescale(SmState& st, f32x16& p0, f32x16& p1, bool first, LAS float* wsf, int r32, int hi) {
    const float rm = rowmax32(p0, p1);
    if (first || __any(rm > 8.f)) {
        const float dl = first ? rm : fmaxf(rm, 0.f);
        st.mhat += dl;
#pragma unroll
        for (int r = 0; r < 16; ++r) { p0[r] -= dl; p1[r] -= dl; st.negm[r] = -st.mhat; }
        if (!first) {
            const float f = __builtin_amdgcn_exp2f(-dl); st.l *= f; if (hi == 0) wsf[r32] = f;
            asm volatile("s_waitcnt lgkmcnt(0)" ::: "memory");
#pragma unroll
            for (int d_ = 0; d_ < 2; ++d_)
#pragma unroll
                for (int r = 0; r < 16; ++r) st.o[d_][r] *= wsf[crow(r, hi)];
            asm volatile("s_waitcnt lgkmcnt(0)" ::: "memory");
        }
    }
}

__device__ __forceinline__ void dsa_attn_unit(unsigned char* ws_, int tid_, int b, int qt, LAS unsigned char* lds) {
    asm volatile("" : "+v"(tid_)); asm volatile("" : "+s"(ws_));
    const int lane = tid_ & 63, wid = __builtin_amdgcn_readfirstlane(tid_ >> 6), r32 = lane & 31, hi = lane >> 5;
    const int h = wid >> 1, qh = wid & 1;
    const size_t qrow = (size_t)b * S + 64 * qt + 32 * qh + r32;
    LAS float* wsf = (LAS float*)(lds + AT_WS) + wid * 64;
    bf16x8 qr[4];
    {
        const bf16* qp = B_PROJ + qrow * NP + C_QA + h * 64 + 8 * hi;
        const float* tab = B_ROPE + qrow * 24;
#pragma unroll
        for (int d0 = 0; d0 < 4; ++d0) {
            const v4u raw = *(const v4u*)(qp + 16 * d0);
            float x[8] = {bflo(raw.x), bfhi(raw.x), bflo(raw.y), bfhi(raw.y), bflo(raw.z), bfhi(raw.z), bflo(raw.w), bfhi(raw.w)};
            if (d0 == 0) {
#pragma unroll
                for (int j = 0; j < 8; ++j) { const float other = __shfl_xor(x[j], 32); const float c = tab[j], sn = tab[8 + j];
                    x[j] = (hi == 0) ? (x[j] * c - other * sn) : (other * sn + x[j] * c); }
            }
            v4u pk; pk.x = cvtpk(x[0] * C2, x[1] * C2); pk.y = cvtpk(x[2] * C2, x[3] * C2); pk.z = cvtpk(x[4] * C2, x[5] * C2); pk.w = cvtpk(x[6] * C2, x[7] * C2);
            qr[d0] = __builtin_bit_cast(bf16x8, pk);
        }
    }
    const bf16* KAb = B_KA + (size_t)b * S * 128;
    const bf16* ksrc = KAb + (size_t)lane * 128 + wid * 8;
    const bf16* vsrc = KAb + (size_t)(16 * (wid & 3) + (lane >> 2)) * 128 + 64 + (wid >> 2) * 32 + (lane & 3) * 8;
#define AT_DMA(t, slot) do { \
        __builtin_amdgcn_global_load_lds((const unsigned*)(ksrc + (size_t)(t) * 64 * 128), (LAS unsigned*)(lds + AT_K + (slot) * 8192 + wid * 1024), 16, 0, 0); \
        __builtin_amdgcn_global_load_lds((const unsigned*)(vsrc + (size_t)(t) * 64 * 128), (LAS unsigned*)(lds + AT_V + (slot) * 8192 + wid * 1024), 16, 0, 0); } while (0)
    const unsigned vb0 = (unsigned)(uintptr_t)(lds + AT_V) + ((lane >> 4) & 1) * 32 + (lane & 3) * 8 + (4 * hi + ((lane & 15) >> 2)) * 64;
    const int NT = qt + 1;
    SmState st; st.mhat = 0.f; st.l = 0.f; st.o[0] = f32x16{}; st.o[1] = f32x16{}; st.negm = f32x16{};
    const unsigned long long* mrow = (const unsigned long long*)((const unsigned*)(ws_ + WS_MASK) + qrow * 64);
    AT_DMA(0, 0);
    unsigned long long mnext = mrow[0];
    for (int t = 0; t < NT; ++t) {
        asm volatile("s_waitcnt vmcnt(0)" ::: "memory");
        wg_barrier();
        const unsigned long long mcur = mnext;
        if (t + 1 < NT) { AT_DMA(t + 1, (t + 1) & 1); mnext = mrow[t + 1]; }
        f32x16 p0, p1;
        qkt(p0, p1, lds + AT_K + (t & 1) * 8192, qr, st.negm, r32, hi);
        sm_rescale(st, p0, p1, t == 0, wsf, r32, hi);
        const unsigned wx = (unsigned)mcur >> (4 * hi), wy = (unsigned)(mcur >> 32) >> (4 * hi);
        float sacc = 0.f;
#pragma unroll
        for (int r = 0; r < 16; ++r) {
            const int c = (r & 3) + 8 * (r >> 2);
            const unsigned k0 = (unsigned)__builtin_amdgcn_sbfe((int)wx, c, 1), k1 = (unsigned)__builtin_amdgcn_sbfe((int)wy, c, 1);
            const float e0 = __builtin_bit_cast(float, __builtin_bit_cast(unsigned, __builtin_amdgcn_exp2f(p0[r])) & k0);
            const float e1 = __builtin_bit_cast(float, __builtin_bit_cast(unsigned, __builtin_amdgcn_exp2f(p1[r])) & k1);
            p0[r] = e0; p1[r] = e1; sacc += e0 + e1;
        }
        st.l += sacc;
        v4u pw0 = {cvtpk(p0[0], p0[1]), cvtpk(p0[2], p0[3]), cvtpk(p0[4], p0[5]), cvtpk(p0[6], p0[7])};
        v4u pw1 = {cvtpk(p0[8], p0[9]), cvtpk(p0[10], p0[11]), cvtpk(p0[12], p0[13]), cvtpk(p0[14], p0[15])};
        v4u pw2 = {cvtpk(p1[0], p1[1]), cvtpk(p1[2], p1[3]), cvtpk(p1[4], p1[5]), cvtpk(p1[6], p1[7])};
        v4u pw3 = {cvtpk(p1[8], p1[9]), cvtpk(p1[10], p1[11]), cvtpk(p1[12], p1[13]), cvtpk(p1[14], p1[15])};
        pv(st.o, vb0 + (t & 1) * 8192, __builtin_bit_cast(bf16x8, pw0), __builtin_bit_cast(bf16x8, pw1), __builtin_bit_cast(bf16x8, pw2), __builtin_bit_cast(bf16x8, pw3));
    }
#undef AT_DMA
    {
        const float lt = st.l + __shfl_xor(st.l, 32);
        if (hi == 0) wsf[r32] = 1.f / lt;
        asm volatile("s_waitcnt lgkmcnt(0)" ::: "memory");
        bf16* ob = B_MIX + ((size_t)b * S + 64 * qt + 32 * qh) * D + h * 64 + r32;
#pragma unroll
        for (int r = 0; r < 16; ++r) { const int rq = crow(r, hi); const float f = wsf[rq];
            ob[(size_t)rq * D] = (bf16)f2bf(st.o[0][r] * f); ob[(size_t)rq * D + 32] = (bf16)f2bf(st.o[1][r] * f); }
    }
    __syncthreads();
}


constexpr int NS_QF = 34816, NS_SELS = 67584, NS_SSUM = 100352, NS_SELM = 108544;
__device__ __forceinline__ unsigned long long mask_range(int lo, int up) {
    const int l2 = lo < 0 ? 0 : lo, u2 = up > 63 ? 63 : up;
    const unsigned long long hm = (u2 >= 63) ? ~0ull : ((2ull << (u2 & 63)) - 1ull);
    const unsigned long long lm = (1ull << (l2 & 63)) - 1ull;
    return (up < 0 || lo > 63 || u2 < l2) ? 0ull : (hm & ~lm);
}
__device__ __forceinline__ void load_q(bf16x8* qr, const bf16* qp, const float* tab, bool rope, int hi) {
#pragma unroll
    for (int d0 = 0; d0 < 4; ++d0) {
        const v4u raw = *(const v4u*)(qp + 16 * d0);
        float x[8] = {bflo(raw.x), bfhi(raw.x), bflo(raw.y), bfhi(raw.y), bflo(raw.z), bfhi(raw.z), bflo(raw.w), bfhi(raw.w)};
        if (d0 == 0) {
#pragma unroll
            for (int j = 0; j < 8; ++j) { const float other = __shfl_xor(x[j], 32); const float c = tab[j], sn = tab[8 + j];
                const float rot = (hi == 0) ? (x[j] * c - other * sn) : (other * sn + x[j] * c); x[j] = rope ? rot : x[j]; }
        }
        v4u pk; pk.x = cvtpk(x[0] * C2, x[1] * C2); pk.y = cvtpk(x[2] * C2, x[3] * C2); pk.z = cvtpk(x[4] * C2, x[5] * C2); pk.w = cvtpk(x[6] * C2, x[7] * C2);
        qr[d0] = __builtin_bit_cast(bf16x8, pk);
    }
}
__device__ __forceinline__ void qkt_lq(f32x16& p0, f32x16& p1, const LAS unsigned char* Kslot, const LAS bf16x8* qf, int lane, int r32, int hi) {
    const LAS unsigned char* kb = Kslot + hi * 1024 + r32 * 16;
    p0 = f32x16{}; p1 = f32x16{};
#pragma unroll
    for (int d0 = 0; d0 < 4; ++d0) {
        const bf16x8 b0 = *(const LAS bf16x8*)(kb + d0 * 2048);
        const bf16x8 b1 = *(const LAS bf16x8*)(kb + d0 * 2048 + 512);
        const bf16x8 q = qf[d0 * 64 + lane];
        p0 = MFMA32(b0, q, p0); p1 = MFMA32(b1, q, p1);
    }
}
template <bool SEL>
__device__ __forceinline__ void tile_step(SmState& st, f32x16& osel, const LAS unsigned char* Kslot, unsigned vb, const LAS bf16x8* qf, unsigned long long mcur, bool first, LAS float* wsf, int lane, int r32, int hi, int ctile) {
    f32x16 p0, p1;
    qkt_lq(p0, p1, Kslot, qf, lane, r32, hi);
    {
        const float rm = rowmax32(p0, p1) - st.mhat;
        if (first || __any(rm > 8.f)) {
            const float dl = first ? rm : fmaxf(rm, 0.f);
            st.mhat += dl;
            if (!first) {
                const float f = __builtin_amdgcn_exp2f(-dl); st.l *= f; if (hi == 0) wsf[r32] = f;
                asm volatile("s_waitcnt lgkmcnt(0)" ::: "memory");
#pragma unroll
                for (int r = 0; r < 16; ++r) { const float ff = wsf[crow(r, hi)]; st.o[0][r] *= ff; st.o[1][r] *= ff; if (SEL) osel[r] *= ff; }
                asm volatile("s_waitcnt lgkmcnt(0)" ::: "memory");
            }
        }
    }
    const unsigned wx = (unsigned)mcur >> (4 * hi), wy = (unsigned)(mcur >> 32) >> (4 * hi);
    float sacc = 0.f;
    const float mh = st.mhat;
#pragma unroll
    for (int r = 0; r < 16; ++r) {
        const int c = (r & 3) + 8 * (r >> 2);
        const unsigned k0 = (unsigned)__builtin_amdgcn_sbfe((int)wx, c, 1), k1 = (unsigned)__builtin_amdgcn_sbfe((int)wy, c, 1);
        const float e0 = __builtin_bit_cast(float, __builtin_bit_cast(unsigned, __builtin_amdgcn_exp2f(p0[r] - mh)) & k0);
        const float e1 = __builtin_bit_cast(float, __builtin_bit_cast(unsigned, __builtin_amdgcn_exp2f(p1[r] - mh)) & k1);
        p0[r] = e0; p1[r] = e1; sacc += e0 + e1;
    }
    st.l += sacc;
    unsigned pw[16];
#pragma unroll
    for (int k = 0; k < 8; ++k) { pw[k] = cvtpk(p0[2 * k], p0[2 * k + 1]); pw[8 + k] = cvtpk(p1[2 * k], p1[2 * k + 1]); }
    pv(st.o, vb, __builtin_bit_cast(bf16x8, (v4u){pw[0], pw[1], pw[2], pw[3]}), __builtin_bit_cast(bf16x8, (v4u){pw[4], pw[5], pw[6], pw[7]}),
       __builtin_bit_cast(bf16x8, (v4u){pw[8], pw[9], pw[10], pw[11]}), __builtin_bit_cast(bf16x8, (v4u){pw[12], pw[13], pw[14], pw[15]}));
    if (SEL) {
        unsigned pl[16];
#pragma unroll
        for (int k = 0; k < 8; ++k) {
            pl[k] = cvtpk(p0[2 * k] - bflo(pw[k]), p0[2 * k + 1] - bfhi(pw[k]));
            pl[8 + k] = cvtpk(p1[2 * k] - bflo(pw[8 + k]), p1[2 * k + 1] - bfhi(pw[8 + k]));
        }
#pragma unroll
        for (int ks = 0; ks < 4; ++ks) {
            unsigned ov[4];
#pragma unroll
            for (int k = 0; k < 4; ++k) {
                const int j0 = 2 * k, j1 = 2 * k + 1;
                const int c0 = 64 * ctile + 16 * ks + 8 * (j0 >> 2) + 4 * hi + (j0 & 3), c1 = 64 * ctile + 16 * ks + 8 * (j1 >> 2) + 4 * hi + (j1 & 3);
                const unsigned a = (c0 >= 4 * r32 - 1 && c0 <= 4 * r32 + 3) ? 0x3F80u : 0u, bq = (c1 >= 4 * r32 - 1 && c1 <= 4 * r32 + 3) ? 0x3F80u : 0u;
                ov[k] = a | (bq << 16);
            }
            const bf16x8 ovf = __builtin_bit_cast(bf16x8, (v4u){ov[0], ov[1], ov[2], ov[3]});
            osel = MFMA32(__builtin_bit_cast(bf16x8, (v4u){pw[4 * ks], pw[4 * ks + 1], pw[4 * ks + 2], pw[4 * ks + 3]}), ovf, osel);
            osel = MFMA32(__builtin_bit_cast(bf16x8, (v4u){pl[4 * ks], pl[4 * ks + 1], pl[4 * ks + 2], pl[4 * ks + 3]}), ovf, osel);
        }
    }
}
__device__ __forceinline__ void sm_reset(SmState& st) { st.mhat = 0.f; st.l = 0.f; st.o[0] = f32x16{}; st.o[1] = f32x16{}; st.negm = f32x16{}; }
__device__ __forceinline__ float sigmoidf_(float x) { return 1.f / (1.f + __expf(-x)); }

template <bool SEL>
__device__ __forceinline__ void nsa_unit(unsigned char* ws_, int tid_, int b, int g, int qt, LAS unsigned char* lds) {
    asm volatile("" : "+v"(tid_)); asm volatile("" : "+s"(ws_));
    const int lane = tid_ & 63, wid = __builtin_amdgcn_readfirstlane(tid_ >> 6), r32 = lane & 31, hi = lane >> 5;
    const int hr = wid >> 1, qh = wid & 1, H = 4 * g + hr;
    const int tq = 64 * qt + 32 * qh + r32;
    const size_t qrow = (size_t)b * S + tq;
    LAS float* wsf = (LAS float*)(lds + AT_WS) + wid * 64;
    const bf16* prow = B_PROJ + qrow * NP;
    const float* tab = B_ROPE + qrow * 24;
    const bf16* qp = prow + C_QB + H * 64 + 8 * hi;
    const unsigned vb0 = (unsigned)(uintptr_t)(lds + AT_V) + ((lane >> 4) & 1) * 32 + (lane & 3) * 8 + (4 * hi + ((lane & 15) >> 2)) * 64;
    const bf16* kcb = (const bf16*)(ws_ + WS_KCB) + (size_t)(b * 2 + g) * 128 * 64;
    const bf16* vcb = (const bf16*)(ws_ + WS_VCB) + (size_t)(b * 2 + g) * 128 * 64;
    const bf16* pb = B_PROJ + (size_t)b * S * NP + g * 64;
    const int vrow = 16 * (wid & 3) + (lane >> 2), vcol = (wid >> 2) * 32 + (lane & 3) * 8;
#define NS_DMA(kp_, vp_, slot_) do { \
        __builtin_amdgcn_global_load_lds((const unsigned*)(kp_), (LAS unsigned*)(lds + AT_K + (slot_) * 8192 + wid * 1024), 16, 0, 0); \
        __builtin_amdgcn_global_load_lds((const unsigned*)(vp_), (LAS unsigned*)(lds + AT_V + (slot_) * 8192 + wid * 1024), 16, 0, 0); } while (0)
#define NS_DMA_CMP(i_, slot_) NS_DMA(kcb + (size_t)(64 * (i_) + lane) * 64 + wid * 8, vcb + (size_t)(64 * (i_) + vrow) * 64 + vcol, slot_)
#define NS_DMA_PROJ(ck_, cv_, j_, slot_) NS_DMA(pb + (size_t)(64 * (j_) + lane) * NP + (ck_) + wid * 8, pb + (size_t)(64 * (j_) + vrow) * NP + (cv_) + vcol, slot_)
#define NS_SYNC() do { asm volatile("s_waitcnt vmcnt(0)" ::: "memory"); wg_barrier(); } while (0)
    const int ncmp = (qt >= 16) ? 2 : 1;
    const int jw0 = (qt > 8) ? qt - 8 : 0;
    int slot = 0;
    NS_DMA_CMP(0, 0);
    LAS bf16x8* qf = (LAS bf16x8*)(lds + NS_QF) + wid * 256;
    { bf16x8 qr[4]; load_q(qr, qp, tab, false, hi);
#pragma unroll
      for (int d0 = 0; d0 < 4; ++d0) qf[d0 * 64 + lane] = qr[d0]; }
    SmState st; sm_reset(st);
    f32x16 osel = {};
    f32x16 oacc[2];
    const int ncv = (tq >= 31) ? (((tq - 31) >> 4) + 1) : 0;
    for (int i = 0; i < ncmp; ++i) {
        NS_SYNC();
        if (i + 1 < ncmp) NS_DMA_CMP(i + 1, slot ^ 1); else NS_DMA_PROJ(C_KWIN, C_VWIN, jw0, slot ^ 1);
        const unsigned long long m = mask_range(0, ncv - 64 * i - 1);
        tile_step<SEL>(st, osel, lds + AT_K + slot * 8192, vb0 + slot * 8192, qf, m, i == 0, wsf, lane, r32, hi, i);
        slot ^= 1;
    }
    {
        const float lt = st.l + __shfl_xor(st.l, 32);
        const float inv = lt > 0.f ? 1.f / lt : 0.f;
        const float g0 = sigmoidf_(bf2f(prow[C_GATE + H * 3 + 0]));
        if (hi == 0) { wsf[r32] = inv; wsf[32 + r32] = inv * g0; }
        asm volatile("s_waitcnt lgkmcnt(0)" ::: "memory");
        LAS float* sels = (LAS float*)(lds + NS_SELS);
#pragma unroll
        for (int r = 0; r < 16; ++r) { const int rq = crow(r, hi); const float f2 = wsf[32 + rq];
            oacc[0][r] = st.o[0][r] * f2; oacc[1][r] = st.o[1][r] * f2;
            if (SEL) sels[(hr * 64 + 32 * qh + rq) * 32 + r32] = osel[r] * wsf[rq]; }
    }
    unsigned mysel, selunion;
    if (SEL) {
        wg_barrier();
        LAS float* sels = (LAS float*)(lds + NS_SELS);
        LAS float* ssum = (LAS float*)(lds + NS_SSUM);
        LAS unsigned* selm = (LAS unsigned*)(lds + NS_SELM);
        const int q = tid_ >> 3, jg = tid_ & 7;
        f32x4 s4 = *(const LAS f32x4*)(sels + (0 * 64 + q) * 32 + 4 * jg);
        s4 += *(const LAS f32x4*)(sels + (1 * 64 + q) * 32 + 4 * jg);
        s4 += *(const LAS f32x4*)(sels + (2 * 64 + q) * 32 + 4 * jg);
        s4 += *(const LAS f32x4*)(sels + (3 * 64 + q) * 32 + 4 * jg);
        *(LAS f32x4*)(ssum + q * 32 + 4 * jg) = s4;
        asm volatile("s_waitcnt lgkmcnt(0)" ::: "memory");
        float sv[32];
#pragma unroll
        for (int k = 0; k < 8; ++k) { const f32x4 v = *(const LAS f32x4*)(ssum + q * 32 + 4 * k); sv[4 * k] = v.x; sv[4 * k + 1] = v.y; sv[4 * k + 2] = v.z; sv[4 * k + 3] = v.w; }
        const float PINF = __builtin_inff();
#pragma unroll
        for (int i = 0; i < 32; ++i) sv[i] = (i > qt) ? -PINF : ((i == 0 || i == qt || i == qt - 1) ? PINF : sv[i]);
        unsigned bits4 = 0u;
#pragma unroll
        for (int jj = 0; jj < 4; ++jj) {
            const int j = 4 * jg + jj;
            float mine = (jj == 0) ? s4.x : (jj == 1) ? s4.y : (jj == 2) ? s4.z : s4.w;
            mine = (j > qt) ? -PINF : ((j == 0 || j == qt || j == qt - 1) ? PINF : mine);
            int rank = 0;
#pragma unroll
            for (int i = 0; i < 32; ++i) rank += ((sv[i] > mine) || (sv[i] == mine && i < j)) ? 1 : 0;
            bits4 |= (rank < 16) ? (1u << jj) : 0u;
        }
        unsigned mm = bits4 << (4 * jg);
        mm |= (unsigned)__shfl_xor((int)mm, 1); mm |= (unsigned)__shfl_xor((int)mm, 2); mm |= (unsigned)__shfl_xor((int)mm, 4);
        if (jg == 0) selm[q] = mm;
        wg_barrier();
        unsigned u = selm[lane];
#pragma unroll
        for (int o_ = 1; o_ < 64; o_ <<= 1) u |= (unsigned)__shfl_xor((int)u, o_);
        selunion = (unsigned)__builtin_amdgcn_readfirstlane((int)u);
        mysel = selm[32 * qh + r32];
    } else {
        mysel = selunion = (2u << qt) - 1u;
    }
    { bf16x8 qr[4]; load_q(qr, qp, tab, true, hi);
#pragma unroll
      for (int d0 = 0; d0 < 4; ++d0) qf[d0 * 64 + lane] = qr[d0]; }
    sm_reset(st);
    unsigned rem = selunion;
    for (int j = jw0; j <= qt; ++j) {
        NS_SYNC();
        if (j < qt) NS_DMA_PROJ(C_KWIN, C_VWIN, j + 1, slot ^ 1); else NS_DMA_PROJ(C_KSLC, C_VSLC, __builtin_ctz(rem), slot ^ 1);
        const unsigned long long m = mask_range(tq - 511 - 64 * j, tq - 64 * j);
        tile_step<false>(st, osel, lds + AT_K + slot * 8192, vb0 + slot * 8192, qf, m, j == jw0, wsf, lane, r32, hi, 0);
        slot ^= 1;
    }
    {
        const float lt = st.l + __shfl_xor(st.l, 32);
        const float g2 = sigmoidf_(bf2f(prow[C_GATE + H * 3 + 2]));
        if (hi == 0) wsf[32 + r32] = lt > 0.f ? g2 / lt : 0.f;
        asm volatile("s_waitcnt lgkmcnt(0)" ::: "memory");
#pragma unroll
        for (int r = 0; r < 16; ++r) { const float f2 = wsf[32 + crow(r, hi)]; oacc[0][r] += st.o[0][r] * f2; oacc[1][r] += st.o[1][r] * f2; }
    }
    sm_reset(st);
    bool firstb = true;
    while (rem) {
        const int j = __builtin_ctz(rem); rem &= rem - 1u;
        NS_SYNC();
        if (rem) NS_DMA_PROJ(C_KSLC, C_VSLC, __builtin_ctz(rem), slot ^ 1);
        const unsigned long long m = ((mysel >> j) & 1u) ? mask_range(0, tq - 64 * j) : 0ull;
        tile_step<false>(st, osel, lds + AT_K + slot * 8192, vb0 + slot * 8192, qf, m, firstb, wsf, lane, r32, hi, 0);
        firstb = false; slot ^= 1;
    }
    {
        const float lt = st.l + __shfl_xor(st.l, 32);
        const float g1 = sigmoidf_(bf2f(prow[C_GATE + H * 3 + 1]));
        if (hi == 0) wsf[32 + r32] = lt > 0.f ? g1 / lt : 0.f;
        asm volatile("s_waitcnt lgkmcnt(0)" ::: "memory");
        bf16* ob = B_MIX + ((size_t)b * S + 64 * qt + 32 * qh) * D + 256 + H * 64 + r32;
#pragma unroll
        for (int r = 0; r < 16; ++r) { const int rq = crow(r, hi); const float f2 = wsf[32 + rq];
            ob[(size_t)rq * D] = (bf16)f2bf(oacc[0][r] + st.o[0][r] * f2); ob[(size_t)rq * D + 32] = (bf16)f2bf(oacc[1][r] + st.o[1][r] * f2); }
    }
    __syncthreads();
#undef NS_DMA
#undef NS_DMA_CMP
#undef NS_DMA_PROJ
#undef NS_SYNC
}

__device__ __forceinline__ void nsa_tile(const bf16* kbase, const bf16* vbase, int s0, bool valid, const LAS float* q, LAS float* pt, float (&m)[4], float (&l)[4], float (&o)[4], int lane) {
    float lg[4] = {NEGF, NEGF, NEGF, NEGF};
    if (valid) {
        const v4u* kp = (const v4u*)(kbase + (size_t)(s0 + lane) * NP);
        float acc[4] = {0.f, 0.f, 0.f, 0.f};
#pragma unroll
        for (int qq = 0; qq < 8; ++qq) { const v4u kk = kp[qq]; float kf[8];
            kf[0] = bflo(kk.x); kf[1] = bfhi(kk.x); kf[2] = bflo(kk.y); kf[3] = bfhi(kk.y); kf[4] = bflo(kk.z); kf[5] = bfhi(kk.z); kf[6] = bflo(kk.w); kf[7] = bfhi(kk.w);
#pragma unroll
            for (int h = 0; h < 4; ++h)
#pragma unroll
                for (int dd = 0; dd < 8; ++dd) acc[h] += q[h * 64 + 8 * qq + dd] * kf[dd]; }
#pragma unroll
        for (int h = 0; h < 4; ++h) lg[h] = acc[h] * 0.125f;
    }
    float p[4];
#pragma unroll
    for (int h = 0; h < 4; ++h) {
        const float tm = wave_max(lg[h]); const float mn = fmaxf(m[h], tm);
        const float alpha = __expf(m[h] - mn);
        p[h] = valid ? __expf(lg[h] - mn) : 0.f;
        l[h] = l[h] * alpha + wave_sum(p[h]); o[h] *= alpha; m[h] = mn;
    }
    *(LAS f32x4*)(pt + lane * 4) = (f32x4){p[0], p[1], p[2], p[3]};
    LDS_FENCE();
#pragma unroll 8
    for (int k = 0; k < 64; ++k) {
        const float v = bf2f(vbase[(size_t)(s0 + k) * NP + lane]);
        const f32x4 p4 = *(const LAS f32x4*)(pt + k * 4);
        o[0] += p4.x * v; o[1] += p4.y * v; o[2] += p4.z * v; o[3] += p4.w * v;
    }
    LDS_FENCE();
}

__device__ __forceinline__ void nsa_token(unsigned char* ws_, int lane_, int b, int t, int g, LAS unsigned char* scr) {
    const int lane = lane_;
    const size_t row = (size_t)b * S + t;
    const bf16* prow = B_PROJ + row * NP;
    LAS float* qn = (LAS float*)scr;
    LAS float* qr = (LAS float*)(scr + 1024);
    LAS float* pc = (LAS float*)(scr + 2048);
    LAS float* ps = (LAS float*)(scr + 4096);
    LAS float* pt = (LAS float*)(scr + 4608);
    const float* tab = B_ROPE + row * 24;
#pragma unroll
    for (int j = 0; j < 2; ++j) { const unsigned u = *(const unsigned*)(prow + C_QB + g * 256 + 2 * lane + 128 * j);
        const float a = bflo(u), c = bfhi(u); qn[2 * lane + 128 * j] = a; qn[2 * lane + 128 * j + 1] = c; qr[2 * lane + 128 * j] = a; qr[2 * lane + 128 * j + 1] = c; }
    LDS_FENCE();
    if (lane < 32) { const int h = lane >> 3, i = lane & 7; const float c = tab[i], s = tab[8 + i]; const float x1 = qn[h * 64 + i], x2 = qn[h * 64 + 8 + i];
        qr[h * 64 + i] = x1 * c - x2 * s; qr[h * 64 + 8 + i] = x1 * s + x2 * c; }
    LDS_FENCE();
    const int ncv = (t >= 31) ? (((t - 31) >> 4) + 1) : 0;
    float ocmp[4] = {0.f, 0.f, 0.f, 0.f};
    {
        float lg[2][4];
#pragma unroll
        for (int ci = 0; ci < 2; ++ci) {
            const int c = lane + 64 * ci;
#pragma unroll
            for (int h = 0; h < 4; ++h) lg[ci][h] = NEGF;
            if (c < ncv) {
                const f32x4* kp = (const f32x4*)(B_KC + ((size_t)(b * NC + c) * 2 + g) * 64);
                float acc[4] = {0.f, 0.f, 0.f, 0.f};
#pragma unroll
                for (int qq = 0; qq < 16; ++qq) { const f32x4 kk = kp[qq];
#pragma unroll
                    for (int h = 0; h < 4; ++h) acc[h] += qn[h * 64 + 4 * qq] * kk.x + qn[h * 64 + 4 * qq + 1] * kk.y + qn[h * 64 + 4 * qq + 2] * kk.z + qn[h * 64 + 4 * qq + 3] * kk.w; }
#pragma unroll
                for (int h = 0; h < 4; ++h) lg[ci][h] = acc[h] * 0.125f;
            }
        }
        float p[2][4];
#pragma unroll
        for (int h = 0; h < 4; ++h) {
            const float mm = wave_max(fmaxf(lg[0][h], lg[1][h]));
            p[0][h] = (lane < ncv) ? __expf(lg[0][h] - mm) : 0.f; p[1][h] = (lane + 64 < ncv) ? __expf(lg[1][h] - mm) : 0.f;
            const float sum = wave_sum(p[0][h] + p[1][h]);
            const float inv = (ncv > 0) ? 1.f / sum : 0.f;
            p[0][h] *= inv; p[1][h] *= inv;
        }
#pragma unroll
        for (int ci = 0; ci < 2; ++ci) { const int c = lane + 64 * ci;
            *(LAS f32x4*)(pc + c * 4) = (f32x4){p[ci][0], p[ci][1], p[ci][2], p[ci][3]};
            ps[c] = (p[ci][0] + p[ci][1]) + (p[ci][2] + p[ci][3]); }
        LDS_FENCE();
        for (int c = 0; c < ncv; ++c) {
            const float v = B_VC[((size_t)(b * NC + c) * 2 + g) * 64 + lane];
            const f32x4 p4 = *(const LAS f32x4*)(pc + c * 4);
            ocmp[0] += p4.x * v; ocmp[1] += p4.y * v; ocmp[2] += p4.z * v; ocmp[3] += p4.w * v;
        }
    }
    const int cur = t >> 6;
    unsigned selmask;
    if (cur < 16) selmask = (2u << cur) - 1u;
    else {
        float sj = -__builtin_inff();
        if (lane < 32 && lane <= cur) {
            const int j = lane;
            if (j == 0 || j == cur || j == cur - 1) sj = __builtin_inff();
            else { const int c0 = 4 * j - 1, c1 = (4 * j + 3 < NC - 1) ? 4 * j + 3 : NC - 1; float a = 0.f; for (int c = c0; c <= c1; ++c) a += ps[c]; sj = a; }
        }
        int rank = 0;
#pragma unroll
        for (int i = 0; i < 32; ++i) { const float si = __shfl(sj, i); rank += ((si > sj) || (si == sj && i < lane)) ? 1 : 0; }
        const bool sel = (lane < 32) && (rank < 16);
        selmask = (unsigned)(__ballot(sel) & 0xffffffffull);
    }
    float ms[4] = {NEGF, NEGF, NEGF, NEGF}, ls[4] = {0.f, 0.f, 0.f, 0.f}, os[4] = {0.f, 0.f, 0.f, 0.f};
    {
        const bf16* kb = B_PROJ + (size_t)b * S * NP + C_KSLC + g * 64;
        const bf16* vb = B_PROJ + (size_t)b * S * NP + C_VSLC + g * 64;
        for (int j = 0; j <= cur; ++j) {
            if (!((selmask >> j) & 1u)) continue;
            nsa_tile(kb, vb, 64 * j, (64 * j + lane) <= t, qr, pt, ms, ls, os, lane);
        }
    }
    float mw[4] = {NEGF, NEGF, NEGF, NEGF}, lw[4] = {0.f, 0.f, 0.f, 0.f}, ow[4] = {0.f, 0.f, 0.f, 0.f};
    {
        const bf16* kb = B_PROJ + (size_t)b * S * NP + C_KWIN + g * 64;
        const bf16* vb = B_PROJ + (size_t)b * S * NP + C_VWIN + g * 64;
        const int lo = (t - 511 > 0) ? t - 511 : 0;
        for (int j = lo >> 6; j <= cur; ++j) {
            const int s = 64 * j + lane;
            nsa_tile(kb, vb, 64 * j, (s >= lo) && (s <= t), qr, pt, mw, lw, ow, lane);
        }
    }
    bf16* orow = B_MIX + row * D + 256 + g * 256;
#pragma unroll
    for (int h = 0; h < 4; ++h) {
        const bf16* gp = prow + C_GATE + (g * 4 + h) * 3;
        const float g0 = 1.f / (1.f + __expf(-bf2f(gp[0]))), g1 = 1.f / (1.f + __expf(-bf2f(gp[1]))), g2 = 1.f / (1.f + __expf(-bf2f(gp[2])));
        const float o = g0 * ocmp[h] + g1 * (os[h] / ls[h]) + g2 * (ow[h] / lw[h]);
        orow[h * 64 + lane] = (bf16)f2bf(o);
    }
    LDS_FENCE();
}

__device__ __forceinline__ void phase_attn(Frame& F, int l) {
    (void)l;
    unsigned char* ws_ = F.ws; asm volatile("" : "+s"(ws_)); int lane_ = F.lane; asm volatile("" : "+v"(lane_)); (void)ws_;
    int tid_ = F.tid; asm volatile("" : "+v"(tid_));
    for (int u = F.vcu; u < BATCH * 64; u += F.G) {
        const int c = u & 255, i = u >> 8; const int b = c >> 3, sft = c & 7; const int base = 16 * (i >> 1); const int qt32 = (i & 1) ? base + 15 - sft : base + sft;
        dsa_select_unit(ws_, tid_, b, qt32, F.lds);
    }
    __syncthreads();
#if DIAG_NAIVE_NSA
    LAS unsigned char* scr = F.lds + F.wave * WSCR;
    const int gw = F.vcu * NWAVES + F.wave, NGW = F.G * NWAVES;
    for (int it = gw; it < 2 * M; it += NGW) {
        const int g = it & 1, tk = it >> 1; const int b = tk / S, t = ((tk % S) + 64 * b) % S;
        nsa_token(ws_, lane_, b, t, g, scr);
    }
#else
    for (int u = F.vcu; u < BATCH * 64; u += F.G) {
        const int c = u & 255, i = u >> 8; const int b = c >> 3, sft = c & 7; const int g = i & 1, k = i >> 1; const int base = 16 * (k >> 1); const int qt = (k & 1) ? base + 15 - sft : base + sft;
        if (qt >= 16) nsa_unit<true>(ws_, tid_, b, g, qt, F.lds); else nsa_unit<false>(ws_, tid_, b, g, qt, F.lds);
    }
#endif
}
__device__ __forceinline__ void phase_dsa_attn(Frame& F) {
    unsigned char* ws_ = F.ws; asm volatile("" : "+s"(ws_));
    int tid_ = F.tid; asm volatile("" : "+v"(tid_));
#if DIAG_NAIVE_ATTN
    { int lane_ = tid_ & 63; LAS unsigned char* scr = F.lds + F.wave * WSCR; const int gw = F.vcu * NWAVES + F.wave, NGW = F.G * NWAVES;
      for (int it = gw; it < M; it += NGW) { const int b = it / S, t = ((it % S) + 64 * b) % S; dsa_token(ws_, lane_, b, t, scr); } }
#else
    for (int u = F.vcu; u < BATCH * 32; u += F.G) {
        const int c = u & 255, i = u >> 8; const int b = c >> 3, sft = c & 7; const int base = 16 * (i >> 1); const int qt = (i & 1) ? base + 15 - sft : base + sft;
        dsa_attn_unit(ws_, tid_, b, qt, F.lds);
    }
#endif
}

__device__ __forceinline__ void phase_merge(Frame& F, const Args& args, int l) {
    unsigned char* ws_ = F.ws; asm volatile("" : "+s"(ws_)); int lane_ = F.lane; asm volatile("" : "+v"(lane_)); (void)ws_;
    LAS float* pl = (LAS float*)(F.lds + F.wave * WSCR);
    const int gw = F.vcu * NWAVES + F.wave, NGW = F.G * NWAVES, lane = lane_;
    const float* wp = P_W_POOL + (size_t)l * 4 * 64 * 64;
    const float* psc = P_POOL_SCALE + l * 256;
    const float* goa = P_G_OUT_A + l * 256; const float* gob = P_G_OUT_B + l * 512;
    for (int row = gw; row < M; row += NGW) {
        const int t = row % S;
        bf16* mrow = B_MIX + (size_t)row * D;
        { const unsigned long long u = *((const unsigned long long*)mrow + lane);
          const float a0 = bflo((unsigned)u), a1 = bfhi((unsigned)u), a2 = bflo((unsigned)(u >> 32)), a3 = bfhi((unsigned)(u >> 32));
          const float rs = rsqrtf(wave_sum((a0 * a0 + a1 * a1) + (a2 * a2 + a3 * a3)) * (1.f / 256.f) + EPS);
          const f32x4 gg = ((const f32x4*)goa)[lane];
          *((unsigned long long*)mrow + lane) = (unsigned long long)pk2(a0 * rs * gg.x, a1 * rs * gg.y) | ((unsigned long long)pk2(a2 * rs * gg.z, a3 * rs * gg.w) << 32); }
        { const v4u u = *((const v4u*)(mrow + 256) + lane);
          float a[8] = {bflo(u.x), bfhi(u.x), bflo(u.y), bfhi(u.y), bflo(u.z), bfhi(u.z), bflo(u.w), bfhi(u.w)};
          float ss = 0.f;
#pragma unroll
          for (int i = 0; i < 8; ++i) ss += a[i] * a[i];
          const float rs = rsqrtf(wave_sum(ss) * (1.f / 512.f) + EPS);
          const f32x4 g0 = ((const f32x4*)gob)[2 * lane], g1 = ((const f32x4*)gob)[2 * lane + 1];
          v4u o; o.x = pk2(a[0] * rs * g0.x, a[1] * rs * g0.y); o.y = pk2(a[2] * rs * g0.z, a[3] * rs * g0.w); o.z = pk2(a[4] * rs * g1.x, a[5] * rs * g1.y); o.w = pk2(a[6] * rs * g1.z, a[7] * rs * g1.w);
          *((v4u*)(mrow + 256) + lane) = o; }
        const bf16* up = B_PROJ + (size_t)row * NP + C_UC;
#pragma unroll
        for (int gi = 0; gi < 4; ++gi) {
            const int w = 2 << gi;
            const float u0 = bf2f(up[gi * 64 + lane]);
            float sum = u0;
            for (int i = 1; i < w; ++i) if (t - i >= 0) sum += bf2f(up[gi * 64 + lane - (size_t)i * NP]);
            const float cntf = (float)((t + 1 < w) ? t + 1 : w);
            pl[gi * 64 + lane] = sum / cntf - u0;
        }
        LDS_FENCE();
        float oc[4]; float ss = 0.f;
#pragma unroll
        for (int gi = 0; gi < 4; ++gi) {
            float a = 0.f; const float* wg = wp + (size_t)gi * 64 * 64 + lane;
#pragma unroll 16
            for (int c = 0; c < 64; ++c) a += pl[gi * 64 + c] * wg[c * 64];
            oc[gi] = a; ss += a * a;
        }
        const float rs = rsqrtf(wave_sum(ss) * (1.f / 256.f) + EPS);
#pragma unroll
        for (int gi = 0; gi < 4; ++gi) mrow[768 + gi * 64 + lane] = (bf16)f2bf(oc[gi] * rs * psc[gi * 64 + lane]);
        LDS_FENCE();
    }
}

__device__ __forceinline__ void phase_finish(Frame& F, const float* xsrc, const float* gpost, const float* gnext  ) {
    unsigned char* ws_ = F.ws; asm volatile("" : "+s"(ws_)); int lane_ = F.lane; asm volatile("" : "+v"(lane_)); (void)ws_;
    const int gw = F.vcu * NWAVES + F.wave, NGW = F.G * NWAVES, lane = lane_;
    for (int row = gw; row < M; row += NGW) {
        const unsigned long long* fr = (const unsigned long long*)(B_F + (size_t)row * D) + lane;
        const f32x4* xr = (const f32x4*)(xsrc + (size_t)row * D) + lane;
        f32x4 f[4], x[4]; float ss = 0.f;
#pragma unroll
        for (int j = 0; j < 4; ++j) { const unsigned long long u = fr[64 * j]; x[j] = xr[64 * j];
            f[j] = (f32x4){bflo((unsigned)u), bfhi((unsigned)u), bflo((unsigned)(u >> 32)), bfhi((unsigned)(u >> 32))};
            ss += (f[j].x * f[j].x + f[j].y * f[j].y) + (f[j].z * f[j].z + f[j].w * f[j].w); }
        const float rs = rsqrtf(wave_sum(ss) * (1.f / D) + EPS);
        float s2 = 0.f;
        f32x4* orow = (f32x4*)(F.out + (size_t)row * D) + lane;
#pragma unroll
        for (int j = 0; j < 4; ++j) { const f32x4 g = ((const f32x4*)gpost)[lane + 64 * j];
            x[j].x += f[j].x * rs * g.x; x[j].y += f[j].y * rs * g.y; x[j].z += f[j].z * rs * g.z; x[j].w += f[j].w * rs * g.w;
            orow[64 * j] = x[j];
            s2 += (x[j].x * x[j].x + x[j].y * x[j].y) + (x[j].z * x[j].z + x[j].w * x[j].w); }
        if (gnext) {
            const float r2 = rsqrtf(wave_sum(s2) * (1.f / D) + EPS);
            unsigned long long* o8 = (unsigned long long*)(B_H + (size_t)row * D) + lane;
#pragma unroll
            for (int j = 0; j < 4; ++j) { const f32x4 g = ((const f32x4*)gnext)[lane + 64 * j];
                o8[64 * j] = (unsigned long long)pk2(x[j].x * r2 * g.x, x[j].y * r2 * g.y) | ((unsigned long long)pk2(x[j].z * r2 * g.z, x[j].w * r2 * g.w) << 32); }
        }
    }
}

template <int ACT>
__device__ __forceinline__ void phase_gemm(Frame& F, const bf16* A, const bf16* Bt, bf16* O, int N, int K) {
    asm volatile("" : "+s"(A), "+s"(Bt), "+s"(O));
    pg8::Gemm g{A, Bt, M, N, K}; pg8::StaticOrder So; So.init(M, N, F.G, (int)blockIdx.x);
    pg8::EpiStore<ACT> E{O, N};
    pg8::gemm_phase<pg8::EpiStore<ACT>, pg8::StaticOrder, true, true>(F.lds, g, So, E);
}

constexpr int PH_PER_LAYER = 10, NPHASES = 1 + DEPTH * PH_PER_LAYER;
__global__ void __launch_bounds__(NWAVES * 64, 2) mk_fwd(Args args) {
    extern __shared__ __attribute__((aligned(16))) unsigned char lds[];
    Frame F;
    F.lds = (LAS unsigned char*)lds;
    F.MISC = (volatile LAS unsigned*)(F.lds + MISC_OFF);
    F.tid = threadIdx.x; F.lane = F.tid & 63; F.wave = __builtin_amdgcn_readfirstlane(F.tid >> 6);
    F.G = gridDim.x; { const int bx = blockIdx.x; F.vcu = (F.G % 8 == 0) ? (bx % 8) * (F.G / 8) + bx / 8 : bx; }
    unsigned char* ws = args.ws; F.ws = ws;
    F.ctl = (gu32*)(ws + WS_CTL);
    F.out = args.out;
    for (int u = F.tid; u < (LDS_BYTES - LDSCTL_OFF) / 4; u += NWAVES * 64) ((LAS unsigned*)(F.lds + LDSCTL_OFF))[u] = 0u;
    __syncthreads();
    XcdBarrier bar; bar.bar = (unsigned*)(F.ctl + CW_BAR); bar.x = 0; bar.st = F.MISC + 8;
    if (args.use_bar) bar = xcd_barrier_post((unsigned*)(F.ctl + CW_BAR), F.MISC + 8);
    const int lo = args.ph_lo, hi = args.ph_hi;
    int pid = 0;
    unsigned char* ws_ = F.ws;
#define PH_ON (pid >= lo && pid < hi)
#define PH_END do { if (PH_ON && pid + 1 < hi) xcd_barrier(bar); ++pid; } while (0)

    if (PH_ON && !(SKIPM & 1)) phase_prologue(F, args);
    PH_END;
    for (int l = 0; l < DEPTH; ++l) {
        if (PH_ON && !(SKIPM & 2)) phase_gemm<0>(F, B_H, w_in_t(ws_, l), B_PROJ, NP, D);
        PH_END;
        if (PH_ON && !(SKIPM & 4)) phase_prep(F, args, l);
        PH_END;
        if (PH_ON && !(SKIPM & 8)) phase_attn(F, l);
        PH_END;
        if (PH_ON && !(SKIPM & 8)) phase_dsa_attn(F);
        PH_END;
        if (PH_ON && !(SKIPM & 16)) phase_merge(F, args, l);
        PH_END;
        if (PH_ON && !(SKIPM & 32)) phase_gemm<0>(F, B_MIX, w_out_t(ws_, l), B_F, D, D);
        PH_END;
        if (PH_ON && !(SKIPM & 64)) phase_finish(F, l == 0 ? P_X_IN : F.out, P_G_POST_MIX + l * D, P_G_PRE_MLP + l * D);
        PH_END;
        if (PH_ON && !(SKIPM & 128)) phase_gemm<2>(F, B_H, w_up_t(ws_, l), B_HID, FF, D);
        PH_END;
        if (PH_ON && !(SKIPM & 256)) phase_gemm<0>(F, B_HID, w_dn_t(ws_, l), B_F, D, FF);
        PH_END;
        if (PH_ON && !(SKIPM & 512)) phase_finish(F, F.out, P_G_POST_MLP + l * D, (l + 1 < DEPTH) ? P_G_PRE_MIX + (l + 1) * D : nullptr);
        PH_END;
    }
#undef PH_ON
#undef PH_END
}

extern "C" void kernel_launch(void* const* d_in, const int* in_sizes, int n_in, void* d_out, int out_size, void* d_ws, size_t ws_size, hipStream_t stream) {
    static int grid = 0;
    if (grid == 0) {
        if (n_in != 20 || in_sizes[0] != M * D || out_size != M * D || ws_size < WS_END) {
            fprintf(stderr, "kernel_launch: unexpected shapes / workspace (n_in %d, in0 %d, out %d, ws %zu < %zu); nothing launched\n", n_in, n_in > 0 ? in_sizes[0] : -1, out_size, ws_size, (size_t)WS_END);
            grid = -1; return; }
        int dev = 0, cus = 0, per_cu = 0;
        if (hipGetDevice(&dev) != hipSuccess || hipDeviceGetAttribute(&cus, hipDeviceAttributeMultiprocessorCount, dev) != hipSuccess) { grid = -1; return; }
        if (hipFuncSetAttribute((const void*)mk_fwd, hipFuncAttributeMaxDynamicSharedMemorySize, LDS_BYTES) != hipSuccess) { fprintf(stderr, "kernel_launch: hipFuncSetAttribute failed\n"); grid = -1; return; }
        if (hipOccupancyMaxActiveBlocksPerMultiprocessor(&per_cu, (const void*)mk_fwd, NWAVES * 64, LDS_BYTES) != hipSuccess || per_cu < 1)
            fprintf(stderr, "kernel_launch: note: occupancy query reports %d workgroups per CU\n", per_cu);
        (void)hipGetLastError();
        grid = cus;
    }
    if (grid < 0) return;
    if (hipMemsetAsync((char*)d_ws + WS_CTL, 0, CTL_ZERO_BYTES, stream) != hipSuccess) return;
    Args a{};
    for (int i = 0; i < 20; ++i) a.in[i] = d_in[i];
    a.out = (float*)d_out; a.ws = (unsigned char*)d_ws; a.pad = 0;
#if MK_MULTI
    for (int p = 0; p < NPHASES; ++p) {
        a.ph_lo = p; a.ph_hi = p + 1; a.use_bar = 0;
        hipLaunchKernelGGL(mk_fwd, dim3(grid), dim3(NWAVES * 64), LDS_BYTES, stream, a);
    }
#else
    a.ph_lo = 0; a.ph_hi = NPHASES; a.use_bar = 1;
    hipLaunchKernelGGL(mk_fwd, dim3(grid), dim3(NWAVES * 64), LDS_BYTES, stream, a);
#endif
}
```

```cpp
#include <hip/hip_runtime.h>
#include <cstdio>
#include <cstdint>

#ifndef PROBE_MASK
#define PROBE_MASK 0
#endif
#ifndef SKIPM
#define SKIPM 0
#endif
#ifndef MK_MULTI
#define MK_MULTI 0
#endif

namespace pg8 {
#define PG8_LAS __attribute__((address_space(3)))
typedef unsigned short bf16_t;
typedef short bf16x8 __attribute__((ext_vector_type(8)));
typedef float f32x4 __attribute__((ext_vector_type(4)));
typedef unsigned u32x4 __attribute__((ext_vector_type(4)));
constexpr int BM = 256, BK = 64, HALF = 128, HTB = HALF * BK * 2, STAGE_BYTES = 8 * HTB, NXCD = 8, WGM = 8;

__host__ __device__ __forceinline__ int lds_byte(int r, int c) { const int st = (r >> 4) * 2 + (c >> 5), rr = r & 15, cc = c & 31, ob = rr * 64 + cc * 2; return st * 1024 + (ob ^ (((ob >> 9) & 1) << 5)); }
__host__ __device__ __forceinline__ void stage_rc(int b, int& R, int& C) { const int st = b / 1024, sb = b % 1024, swz = sb ^ (((sb >> 9) & 1) << 5); R = (st >> 1) * 16 + swz / 64; C = (st & 1) * 32 + (swz % 64) / 2; }
__host__ __device__ __forceinline__ int perm32(int rho) { const int n = rho >> 4, i = rho & 15; return 8 * (i >> 2) + 4 * n + (i & 3); }

struct Unit { int pm, pn; };
struct Gemm { const bf16_t* A; const bf16_t* Bt; int M, N, K; };

struct StaticOrder {
    int nM, nN, nwg, G, c;
    __host__ __device__ void init(int M, int N, int G_, int c_) { nM = M / BM; nN = N / BM; nwg = nM * nN; G = G_; c = c_; }
    __host__ __device__ bool next(int i, Unit& u) const {
        const long L = (long)i * G + c; if (L >= nwg) return false;
        int wgid = (int)L; { const int q = nwg / NXCD, r = nwg % NXCD, xcd = wgid % NXCD, off = wgid / NXCD; wgid = (xcd < r ? xcd * (q + 1) : r * (q + 1) + (xcd - r) * q) + off; }
        const int nig = WGM * nN, gid = wgid / nig, fm = gid * WGM, gsz = (nM - fm) < WGM ? (nM - fm) : WGM;
        u.pm = fm + ((wgid % nig) % gsz); u.pn = (wgid % nig) / gsz; return true;
    }
    __device__ __forceinline__ void a_ready(const Unit&) const {}
    __device__ __forceinline__ void done(const Unit&) const {}
};

__device__ __forceinline__ unsigned cvt_pk_bf16(float lo, float hi) { unsigned r; asm volatile("v_cvt_pk_bf16_f32 %0, %1, %2" : "=v"(r) : "v"(lo), "v"(hi)); return r; }

template <int ACT  > struct EpiStore {
    static constexpr bool PERM = true, AFTER_DRAIN = false;
    bf16_t* O; int ldc;
    __device__ __forceinline__ void operator()(const f32x4 (&acc)[2][2][4][2], const Unit& u, int wr, int wc, int fr, int fq) const {
        const int row0 = u.pm * BM + wr * 64 + fr;
        const int col0 = u.pn * BM + wc * 32 + 8 * fq;
#pragma unroll
        for (int ai = 0; ai < 2; ++ai)
#pragma unroll
            for (int m = 0; m < 4; ++m) { bf16_t* rowp = O + (size_t)(row0 + ai * HALF + m * 16) * ldc + col0;
#pragma unroll
                for (int bj = 0; bj < 2; ++bj) { f32x4 v0 = acc[ai][bj][m][0], v1 = acc[ai][bj][m][1];
                    if (ACT == 2) {
#pragma unroll
                        for (int e = 0; e < 4; ++e) { const float a = fmaxf(v0[e], 0.f), b = fmaxf(v1[e], 0.f); v0[e] = a * a; v1[e] = b * b; } }
                    u32x4 w; w.x = cvt_pk_bf16(v0[0], v0[1]); w.y = cvt_pk_bf16(v0[2], v0[3]); w.z = cvt_pk_bf16(v1[0], v1[1]); w.w = cvt_pk_bf16(v1[2], v1[3]);
                    *(u32x4*)(rowp + bj * HALF) = w; } }
    }
};

template <class Epi, class Sched, bool ALIGN_EPI = false, bool SP2 = false>
__device__ __forceinline__ void gemm_phase(PG8_LAS unsigned char* lds, const Gemm g, const Sched& S, const Epi& E) {
    int tid_ = threadIdx.x; asm volatile("" : "+v"(tid_));
    const int tid = tid_, wid = __builtin_amdgcn_readfirstlane(tid >> 6), lane = tid & 63, wr = wid >> 2, wc = wid & 3, fr = lane & 15, fq = lane >> 4;
    const int K = g.K, nt = K / BK;
    unsigned voffA[2], voffB[2];
#pragma unroll
    for (int i = 0; i < 2; ++i) { int R, C; stage_rc(tid * 16 + i * 8192, R, C); const int Rb = Epi::PERM ? ((R & ~31) + perm32(R & 31)) : R;
        voffA[i] = (unsigned)(R * K + C) * 2u; voffB[i] = (unsigned)(Rb * K + C) * 2u; }
    const size_t kstep = (size_t)(BK * 2);
    const size_t hstep = (size_t)HALF * K * 2;
    const size_t tstep = 2 * hstep;
    const unsigned ldsw = (unsigned)wid * 1024u;
    const int aoff = lds_byte(wr * 64 + fr, fq * 8), boff = lds_byte(wc * 32 + fr, fq * 8);
#define PG8_SA(b, h) (((b) * 2 + (h)) * HTB)
#define PG8_SB(b, h) ((4 + (b) * 2 + (h)) * HTB)
#define PG8_STAGE(bufoff, gbase, voff) do { _Pragma("unroll") for (int _i = 0; _i < 2; ++_i) \
        __builtin_amdgcn_global_load_lds((const unsigned*)((const char*)(gbase) + (voff)[_i]), (PG8_LAS unsigned*)(lds + (bufoff) + ldsw + _i * 8192), 16, 0, 0); } while (0)
#define PG8_LDA(dst, b, h) do { _Pragma("unroll") for (int m = 0; m < 4; ++m) _Pragma("unroll") for (int k = 0; k < 2; ++k) dst[m][k] = *(const PG8_LAS bf16x8*)(lds + PG8_SA(b, h) + aoff + m * 2048 + k * 1024); } while (0)
#define PG8_LDB(dst, b, h) do { _Pragma("unroll") for (int n = 0; n < 2; ++n) _Pragma("unroll") for (int k = 0; k < 2; ++k) dst[n][k] = *(const PG8_LAS bf16x8*)(lds + PG8_SB(b, h) + boff + n * 2048 + k * 1024); } while (0)
#define PG8_MMA(ai, bj, At, Bt) do { __builtin_amdgcn_s_setprio(1); _Pragma("unroll") for (int m = 0; m < 4; ++m) _Pragma("unroll") for (int n = 0; n < 2; ++n) _Pragma("unroll") for (int k = 0; k < 2; ++k) \
        acc[ai][bj][m][n] = __builtin_amdgcn_mfma_f32_16x16x32_bf16(Bt[n][k], At[m][k], acc[ai][bj][m][n], 0, 0, 0); __builtin_amdgcn_s_setprio(0); } while (0)
#define PG8_WAIT_V(n) asm volatile("s_waitcnt vmcnt(" #n ")" ::: "memory")
#define PG8_WAIT_L(n) asm volatile("s_waitcnt lgkmcnt(" #n ")" ::: "memory")
#define PG8_BAR __builtin_amdgcn_s_barrier()
#define PG8_SCHED __builtin_amdgcn_sched_barrier(0)
    Unit cur, nxt; int ui = 0;
    if (!S.next(0, cur)) return;
    f32x4 acc[2][2][4][2];
#pragma unroll
    for (int a = 0; a < 2; ++a)
#pragma unroll
        for (int b = 0; b < 2; ++b)
#pragma unroll
            for (int m = 0; m < 4; ++m)
#pragma unroll
                for (int n = 0; n < 2; ++n) acc[a][b][m][n] = (f32x4){0.f, 0.f, 0.f, 0.f};
    bf16x8 At[4][2], B0[2][2], B1[2][2];
    const char* cA = (const char*)g.A + (size_t)cur.pm * tstep; const char* cB = (const char*)g.Bt + (size_t)cur.pn * tstep;
    S.a_ready(cur);
    if constexpr (SP2) {
        PG8_STAGE(PG8_SB(0, 0), cB, voffB); PG8_STAGE(PG8_SB(0, 1), cB + hstep, voffB); PG8_STAGE(PG8_SA(0, 0), cA, voffA); PG8_STAGE(PG8_SA(0, 1), cA + hstep, voffA);
        if (wr == 1) PG8_BAR;
        PG8_WAIT_V(2); PG8_BAR;
        PG8_STAGE(PG8_SB(1, 0), cB + kstep, voffB); PG8_STAGE(PG8_SA(1, 0), cA + kstep, voffA); PG8_STAGE(PG8_SB(1, 1), cB + hstep + kstep, voffB);
        PG8_WAIT_V(6); PG8_BAR;
    } else {
        PG8_STAGE(PG8_SB(0, 0), cB, voffB); PG8_STAGE(PG8_SA(0, 0), cA, voffA); PG8_STAGE(PG8_SB(0, 1), cB + hstep, voffB); PG8_STAGE(PG8_SA(0, 1), cA + hstep, voffA);
        if (wr == 1) PG8_BAR;
        PG8_WAIT_V(4); PG8_BAR;
        PG8_STAGE(PG8_SB(1, 0), cB + kstep, voffB); PG8_STAGE(PG8_SA(1, 0), cA + kstep, voffA); PG8_STAGE(PG8_SB(1, 1), cB + hstep + kstep, voffB);
        PG8_WAIT_V(6); PG8_BAR;
    }
    for (;;) {
        const bool has_next = S.next(ui + 1, nxt);
        const char* nA = has_next ? (const char*)g.A + (size_t)nxt.pm * tstep : cA; const char* nB = has_next ? (const char*)g.Bt + (size_t)nxt.pn * tstep : cB;
        for (int t = 0; t < nt; t += 2) {
            const bool last = (t == nt - 2);
            const char* a1 = cA + (size_t)(t + 1) * kstep;
            const char* a2 = last ? nA : cA + (size_t)(t + 2) * kstep; const char* b2 = last ? nB : cB + (size_t)(t + 2) * kstep;
            const char* a3 = a2 + kstep; const char* b3 = b2 + kstep;
            if (last && has_next) S.a_ready(nxt);
            if constexpr (SP2) {
            PG8_LDB(B0, 0, 0); PG8_LDB(B1, 0, 1); PG8_SCHED; PG8_LDA(At, 0, 0); PG8_STAGE(PG8_SA(1, 1), a1 + hstep, voffA);
            PG8_WAIT_V(8); PG8_WAIT_L(0); PG8_BAR; PG8_MMA(0, 0, At, B0); PG8_MMA(0, 1, At, B1); PG8_BAR; PG8_SCHED;
            PG8_LDA(At, 0, 1); PG8_STAGE(PG8_SB(0, 0), b2, voffB); PG8_STAGE(PG8_SB(0, 1), b2 + hstep, voffB); PG8_STAGE(PG8_SA(0, 0), a2, voffA);
            PG8_WAIT_V(8); PG8_WAIT_L(0); PG8_BAR; PG8_MMA(1, 0, At, B0); PG8_MMA(1, 1, At, B1); PG8_BAR; PG8_SCHED;
            PG8_LDB(B0, 1, 0); PG8_LDB(B1, 1, 1); PG8_SCHED; PG8_LDA(At, 1, 0); PG8_STAGE(PG8_SA(0, 1), a2 + hstep, voffA);
            PG8_WAIT_V(8); PG8_WAIT_L(0); PG8_BAR; PG8_MMA(0, 0, At, B0); PG8_MMA(0, 1, At, B1); PG8_BAR; PG8_SCHED;
            PG8_LDA(At, 1, 1); PG8_STAGE(PG8_SB(1, 0), b3, voffB); PG8_STAGE(PG8_SB(1, 1), b3 + hstep, voffB); PG8_STAGE(PG8_SA(1, 0), a3, voffA);
            PG8_WAIT_V(8); PG8_WAIT_L(0); PG8_BAR; PG8_MMA(1, 0, At, B0); PG8_MMA(1, 1, At, B1); PG8_BAR; PG8_SCHED;
            } else {
            PG8_LDB(B0, 0, 0); PG8_SCHED; PG8_LDA(At, 0, 0); PG8_STAGE(PG8_SA(1, 1), a1 + hstep, voffA);
            PG8_WAIT_L(8); PG8_BAR; PG8_WAIT_L(0); PG8_MMA(0, 0, At, B0); PG8_BAR; PG8_SCHED;
            PG8_LDB(B1, 0, 1); PG8_STAGE(PG8_SB(0, 0), b2, voffB);
            PG8_BAR; PG8_WAIT_L(0); PG8_MMA(0, 1, At, B1); PG8_BAR;
            PG8_LDA(At, 0, 1); PG8_STAGE(PG8_SA(0, 0), a2, voffA);
            PG8_BAR; PG8_WAIT_L(0); PG8_MMA(1, 0, At, B0); PG8_BAR; PG8_SCHED;
            PG8_STAGE(PG8_SB(0, 1), b2 + hstep, voffB);
            PG8_WAIT_V(6); PG8_BAR; PG8_MMA(1, 1, At, B1); PG8_BAR;
            PG8_LDB(B0, 1, 0); PG8_SCHED; PG8_LDA(At, 1, 0); PG8_STAGE(PG8_SA(0, 1), a2 + hstep, voffA);
            PG8_WAIT_L(8); PG8_BAR; PG8_WAIT_L(0); PG8_MMA(0, 0, At, B0); PG8_BAR; PG8_SCHED;
            PG8_LDB(B1, 1, 1); PG8_STAGE(PG8_SB(1, 0), b3, voffB);
            PG8_BAR; PG8_WAIT_L(0); PG8_MMA(0, 1, At, B1); PG8_BAR;
            PG8_LDA(At, 1, 1); PG8_STAGE(PG8_SA(1, 0), a3, voffA);
            PG8_BAR; PG8_WAIT_L(0); PG8_MMA(1, 0, At, B0); PG8_BAR; PG8_SCHED;
            PG8_STAGE(PG8_SB(1, 1), b3 + hstep, voffB);
            PG8_WAIT_V(6); PG8_BAR; PG8_MMA(1, 1, At, B1); PG8_BAR;
            }
        }
        if constexpr (ALIGN_EPI) { if (wr == 0) PG8_BAR; }
        if constexpr (!Epi::AFTER_DRAIN) { E(acc, cur, wr, wc, fr, fq); S.done(cur); }
        if (!has_next) break;
#pragma unroll
        for (int a = 0; a < 2; ++a)
#pragma unroll
            for (int b = 0; b < 2; ++b)
#pragma unroll
                for (int m = 0; m < 4; ++m)
#pragma unroll
                    for (int n = 0; n < 2; ++n) acc[a][b][m][n] = (f32x4){0.f, 0.f, 0.f, 0.f};
        cur = nxt; cA = nA; cB = nB; ++ui;
        if constexpr (ALIGN_EPI) { if (wr == 1) PG8_BAR; }
    }
    PG8_WAIT_V(0);
    if constexpr (!ALIGN_EPI) { if (wr == 0) PG8_BAR; }
    PG8_BAR;
#undef PG8_SA
#undef PG8_SB
#undef PG8_STAGE
#undef PG8_LDA
#undef PG8_LDB
#undef PG8_MMA
#undef PG8_WAIT_V
#undef PG8_WAIT_L
#undef PG8_BAR
#undef PG8_SCHED
}
}

constexpr int NWAVES = 8;
constexpr int BATCH = 32, S = 2048, D = 1024, DEPTH = 4, FF = 4096;
constexpr int M = BATCH * S;
constexpr int NP = 2304;
constexpr int DIN = 2108;
constexpr int C_QA = 0, C_CKV = 256, C_QIDX = 384, C_QB = 512, C_KCMP = 1024, C_VCMP = 1152, C_KSLC = 1280, C_VSLC = 1408, C_KWIN = 1536, C_VWIN = 1664,
              C_UC = 1792, C_KIDX = 2048, C_WIDX = 2080, C_GATE = 2084, C_KA = 2112, C_VA = 2176;
constexpr int NC = 127;
constexpr float EPS = 1e-6f;
constexpr float NEGF = -1e30f;

__host__ __device__ __forceinline__ int win_src(int n) {
    if (n < 512) return n;
    if (n < 1024) return 548 + (n - 512);
    if (n < 1792) return 1060 + (n - 1024);
    if (n < 2048) return 1852 + (n - 1792);
    if (n < 2080) return 512 + (n - 2048);
    if (n < 2084) return 544 + (n - 2080);
    if (n < 2108) return 1828 + (n - 2084);
    return -1;
}

constexpr size_t MiB = 1u << 20;
constexpr size_t WS_CTL = 0, CTL_ZERO_BYTES = 1 * MiB;
constexpr size_t WS_W = 2 * MiB;
constexpr size_t W_IN_B = (size_t)NP * D * 2, W_OUT_B = (size_t)D * D * 2, W_UP_B = (size_t)FF * D * 2, W_DN_B = (size_t)D * FF * 2;
constexpr size_t W_LAYER_B = W_IN_B + W_OUT_B + W_UP_B + W_DN_B;
constexpr size_t WS_ROPE = 96 * MiB;
constexpr size_t WS_WCT = 102 * MiB;
constexpr size_t WS_CB = 104 * MiB;
constexpr size_t WS_KCB = 124 * MiB, WS_VCB = 125 * MiB;
constexpr size_t WS_KA = 108 * MiB;
constexpr size_t WS_H = 128 * MiB;
constexpr size_t WS_F = 256 * MiB;
constexpr size_t WS_PROJ = 384 * MiB;
constexpr size_t WS_MIX = 672 * MiB;
constexpr size_t WS_MASK = 800 * MiB;
constexpr size_t WS_HID = 384 * MiB;
constexpr size_t WS_END = 896 * MiB;
static_assert(WS_W + DEPTH * W_LAYER_B <= WS_ROPE, "weights");
static_assert(WS_ROPE + (size_t)M * 24 * 4 <= WS_WCT && WS_WCT + (size_t)DEPTH * 2 * 128 * 1024 * 2 <= WS_CB, "map");
static_assert(WS_PROJ + (size_t)M * NP * 2 <= WS_MIX && WS_MIX + (size_t)M * D * 2 <= WS_END && WS_HID + (size_t)M * FF * 2 <= WS_END, "map2");

constexpr int CW_BAR = 4096;
constexpr int RING_BYTES = 131072;
constexpr int LDSCTL_OFF = RING_BYTES, MISC_OFF = LDSCTL_OFF + 320;
constexpr int LDS_BYTES = 147456;
constexpr int WSCR = 16384;

#define GAS __attribute__((address_space(1)))
#define LAS __attribute__((address_space(3)))
typedef unsigned short bf16;
typedef unsigned v4u __attribute__((ext_vector_type(4)));
typedef float f32x4 __attribute__((ext_vector_type(4)));
typedef GAS unsigned gu32;
#define LDS_FENCE() asm volatile("s_waitcnt lgkmcnt(0)" ::: "memory")
__device__ __forceinline__ unsigned f2bf(float f) { unsigned u = __builtin_bit_cast(unsigned, f); return (u + 0x7fffu + ((u >> 16) & 1u)) >> 16; }
__device__ __forceinline__ unsigned pk2(float lo, float hi) { return f2bf(lo) | (f2bf(hi) << 16); }
__device__ __forceinline__ float bf2f(bf16 u) { return __builtin_bit_cast(float, (unsigned)u << 16); }
__device__ __forceinline__ float bflo(unsigned u) { return __builtin_bit_cast(float, u << 16); }
__device__ __forceinline__ float bfhi(unsigned u) { return __builtin_bit_cast(float, u & 0xffff0000u); }

#define XB_TMO      128
#define XB_XCNT(j)  (256  + 64 * (j))
#define XB_XSUB(j)  (1280 + 64 * (j))
#define XB_XGEN(j)  (2304 + 64 * (j))
#define XB_TOP      3328
#define XB_TOPGEN   3392
#define XCD_BAR_WORDS 3456
#define XB_SPIN_CAP (1u << 22)

__device__ __forceinline__ unsigned xb_ld(unsigned* p)              { return __hip_atomic_load(p, __ATOMIC_RELAXED, __HIP_MEMORY_SCOPE_AGENT); }
__device__ __forceinline__ unsigned xb_add(unsigned* p, unsigned v) { return __hip_atomic_fetch_add(p, v, __ATOMIC_RELAXED, __HIP_MEMORY_SCOPE_AGENT); }
__device__ __forceinline__ unsigned xb_xcc_id() { return (unsigned)__builtin_amdgcn_s_getreg((3 << 11) | 20) & 0xFu; }
#define XB_SPIN(cond, bar) do { unsigned _sp = 0; while (cond) { __builtin_amdgcn_s_sleep(1); \
    if ((++_sp & 255u) == 0u) { if (xb_ld(&(bar)[XB_TMO])) break; if (_sp > XB_SPIN_CAP) { atomicAdd(&(bar)[XB_TMO], 1u); break; } } } } while (0)

struct XcdBarrier { unsigned* bar; unsigned x; volatile LAS unsigned* st; };

__device__ __forceinline__ XcdBarrier xcd_barrier_post(unsigned* bar, volatile LAS unsigned* st) {
    XcdBarrier b; b.bar = bar; b.x = xb_xcc_id(); b.st = st;
    if (threadIdx.x == 0) (void)xb_add(&bar[XB_XCNT(b.x)], 1u);
    return b;
}
__device__ __forceinline__ void xcd_barrier_complete(unsigned* bar, unsigned x, unsigned& nloc, unsigned& nx) {
    const unsigned G = gridDim.x * gridDim.y * gridDim.z;
    unsigned sum, cnt, mine, sp = 0u;
    for (;;) {
        sum = 0u; cnt = 0u; mine = 0u;
#pragma unroll
        for (unsigned j = 0; j < 16; ++j) { const unsigned c = xb_ld(&bar[XB_XCNT(j)]); sum += c; cnt += (c > 0u) ? 1u : 0u; mine = (j == x) ? c : mine; }
        if (sum == G) break;
        __builtin_amdgcn_s_sleep(1);
        if ((++sp & 255u) == 0u) { if (xb_ld(&bar[XB_TMO])) break; if (sp > XB_SPIN_CAP) { atomicAdd(&bar[XB_TMO], 1u); break; } }
    }
    nloc = mine > 0u ? mine : 1u; nx = cnt > 0u ? cnt : 1u;
}
__device__ __forceinline__ void xcd_barrier(const XcdBarrier& b) {
    asm volatile("s_waitcnt vmcnt(0)" ::: "memory");
    __syncthreads();
    if (threadIdx.x == 0) {
        unsigned* bar = b.bar; asm volatile("" : "+s"(bar));
        __builtin_amdgcn_s_waitcnt(0);
        unsigned nloc = b.st[0], nx = b.st[1];
        if (nloc == 0u) { xcd_barrier_complete(bar, b.x, nloc, nx); b.st[0] = nloc; b.st[1] = nx; }
        const unsigned old = xb_add(&bar[XB_XSUB(b.x)], 1u);
        const unsigned gen = old / nloc;
        if (old + 1u == (gen + 1u) * nloc) {
            __builtin_amdgcn_fence(__ATOMIC_RELEASE, "agent");
            asm volatile("s_waitcnt vmcnt(0)" ::: "memory");
            const unsigned og = xb_add(&bar[XB_TOP], 1u);
            const unsigned tg = og / nx;
            if (og + 1u == (tg + 1u) * nx) xb_add(&bar[XB_TOPGEN], 1u);
            else XB_SPIN(xb_ld(&bar[XB_TOPGEN]) == tg, bar);
            __builtin_amdgcn_fence(__ATOMIC_ACQUIRE, "agent");
            xb_add(&bar[XB_XGEN(b.x)], 1u);
            asm volatile("s_waitcnt vmcnt(0)" ::: "memory");
        } else {
            XB_SPIN(xb_ld(&bar[XB_XGEN(b.x)]) == gen, bar);
            __builtin_amdgcn_fence(__ATOMIC_ACQUIRE, "agent");
            asm volatile("s_waitcnt vmcnt(0)" ::: "memory");
        }
    }
    __syncthreads();
}

struct Frame {
    LAS unsigned char* lds;
    volatile LAS unsigned* MISC;
    gu32* ctl;
    int tid, lane, wave, vcu, G;
    float* out; unsigned char* ws;
};
struct Args { const void* in[20]; float* out; unsigned char* ws; int ph_lo, ph_hi, use_bar, pad; };
#define IN_F(k) ((const float*)args.in[k])
#define P_X_IN IN_F(0)
#define P_POS ((const int*)args.in[1])
#define P_W_IN IN_F(2)
#define P_G_KV_A IN_F(3)
#define P_W_KV_UP IN_F(4)
#define P_W_CMP_K IN_F(5)
#define P_W_CMP_V IN_F(6)
#define P_PE_K IN_F(7)
#define P_PE_V IN_F(8)
#define P_W_POOL IN_F(9)
#define P_POOL_SCALE IN_F(10)
#define P_G_OUT_A IN_F(11)
#define P_G_OUT_B IN_F(12)
#define P_W_OUT IN_F(13)
#define P_G_PRE_MIX IN_F(14)
#define P_G_POST_MIX IN_F(15)
#define P_G_PRE_MLP IN_F(16)
#define P_G_POST_MLP IN_F(17)
#define P_W_UP IN_F(18)
#define P_W_DOWN IN_F(19)
#define B_ROPE ((float*)(ws_ + WS_ROPE))
#define B_H ((bf16*)(ws_ + WS_H))
#define B_F ((bf16*)(ws_ + WS_F))
#define B_PROJ ((bf16*)(ws_ + WS_PROJ))
#define B_MIX ((bf16*)(ws_ + WS_MIX))
#define B_HID ((bf16*)(ws_ + WS_HID))

__device__ __forceinline__ float wave_sum(float v) {
#pragma unroll
    for (int o = 1; o < 64; o <<= 1) v += __shfl_xor(v, o);
    return v;
}
__device__ __forceinline__ float wave_max(float v) {
#pragma unroll
    for (int o = 1; o < 64; o <<= 1) v = fmaxf(v, __shfl_xor(v, o));
    return v;
}
__device__ __forceinline__ int wave_sum_i(int v) {
#pragma unroll
    for (int o = 1; o < 64; o <<= 1) v += __shfl_xor(v, o);
    return v;
}

__constant__ double c_rope_inv[12] = {1.0, 0.19392274474868576, 0.03760603093086393, 0.007292664737217109, 0.001414213562373095, 0.0002742481756762073, 5.318295896944988e-05, 1.031338537721246e-05,
                                       1.0, 0.03760603093086393, 0.001414213562373095, 5.318295896944988e-05};
template <int MODE>
__device__ __forceinline__ void transpose_item(const float* W, int K, int Nsrc, int nblk, bf16* WT, LAS float* scr, int item, int lane) {
    const int kb = item / nblk, nb = item % nblk, k0 = 64 * kb, n0 = 32 * nb;
    if (MODE && n0 >= C_KA && n0 < C_KA + 128) return;
    const int np = n0 + (lane & 31);
    const int src = MODE ? win_src(np) : np;
#pragma unroll 8
    for (int i = 0; i < 32; ++i) { const int kk = 2 * i + (lane >> 5); scr[kk * 33 + (lane & 31)] = (src >= 0) ? W[(size_t)(k0 + kk) * Nsrc + src] : 0.f; }
    LDS_FENCE();
    const int c = lane & 7;
#pragma unroll
    for (int j = 0; j < 4; ++j) { const int n = (lane >> 3) + 8 * j; const LAS float* s = scr + (8 * c) * 33 + n;
        v4u o; o.x = pk2(s[0 * 33], s[1 * 33]); o.y = pk2(s[2 * 33], s[3 * 33]); o.z = pk2(s[4 * 33], s[5 * 33]); o.w = pk2(s[6 * 33], s[7 * 33]);
        *(v4u*)(WT + (size_t)(n0 + n) * K + k0 + 8 * c) = o; }
    LDS_FENCE();
}

__device__ __forceinline__ bf16* w_in_t(unsigned char* ws_, int l)  { return (bf16*)(ws_ + WS_W + (size_t)l * W_LAYER_B); }
__device__ __forceinline__ bf16* w_out_t(unsigned char* ws_, int l) { return (bf16*)(ws_ + WS_W + (size_t)l * W_LAYER_B + W_IN_B); }
__device__ __forceinline__ bf16* w_up_t(unsigned char* ws_, int l)  { return (bf16*)(ws_ + WS_W + (size_t)l * W_LAYER_B + W_IN_B + W_OUT_B); }
__device__ __forceinline__ bf16* w_dn_t(unsigned char* ws_, int l)  { return (bf16*)(ws_ + WS_W + (size_t)l * W_LAYER_B + W_IN_B + W_OUT_B + W_UP_B); }

__device__ __forceinline__ void norm_row_to_bf16(const float* xrow, const float* gain, bf16* orow, int lane) {
    const f32x4* xr = (const f32x4*)xrow + lane;
    f32x4 v[4]; float s = 0.f;
#pragma unroll
    for (int j = 0; j < 4; ++j) { v[j] = xr[64 * j]; s += (v[j].x * v[j].x + v[j].y * v[j].y) + (v[j].z * v[j].z + v[j].w * v[j].w); }
    const float rs = rsqrtf(wave_sum(s) * (1.f / D) + EPS);
    unsigned long long* o8 = (unsigned long long*)orow + lane;
#pragma unroll
    for (int j = 0; j < 4; ++j) { const f32x4 g = ((const f32x4*)gain)[lane + 64 * j];
        o8[64 * j] = (unsigned long long)pk2(v[j].x * rs * g.x, v[j].y * rs * g.y) | ((unsigned long long)pk2(v[j].z * rs * g.z, v[j].w * rs * g.w) << 32); }
}

__device__ __forceinline__ void phase_prologue(Frame& F, const Args& args) {
    unsigned char* ws_ = F.ws; asm volatile("" : "+s"(ws_)); int lane_ = F.lane; asm volatile("" : "+v"(lane_)); (void)ws_;
    LAS float* scr = (LAS float*)(F.lds + F.wave * WSCR);
    const int gw = F.vcu * NWAVES + F.wave, NGW = F.G * NWAVES;
    constexpr int I_IN = (D / 64) * (NP / 32), I_OUT = (D / 64) * (D / 32), I_UP = (D / 64) * (FF / 32), I_DN = (FF / 64) * (D / 32);
    for (int it = gw; it < DEPTH * I_IN; it += NGW) { const int l = it / I_IN, r = it % I_IN; transpose_item<1>(P_W_IN + (size_t)l * D * DIN, D, DIN, NP / 32, w_in_t(ws_, l), scr, r, lane_); }
    for (int it = gw; it < DEPTH * I_OUT; it += NGW) { const int l = it / I_OUT, r = it % I_OUT; transpose_item<0>(P_W_OUT + (size_t)l * D * D, D, D, D / 32, w_out_t(ws_, l), scr, r, lane_); }
    for (int it = gw; it < DEPTH * I_UP; it += NGW) { const int l = it / I_UP, r = it % I_UP; transpose_item<0>(P_W_UP + (size_t)l * D * FF, D, FF, FF / 32, w_up_t(ws_, l), scr, r, lane_); }
    for (int it = gw; it < DEPTH * I_DN; it += NGW) { const int l = it / I_DN, r = it % I_DN; transpose_item<0>(P_W_DOWN + (size_t)l * FF * D, FF, D, D / 32, w_dn_t(ws_, l), scr, r, lane_); }
    for (int it = gw; it < DEPTH * D * 2; it += NGW) {
        const int l = it / (D * 2), r = it % (D * 2), k = r >> 1, n = lane_ + 64 * (r & 1);
        const float* wi = P_W_IN + ((size_t)l * D + k) * DIN + 256; const float* gk = P_G_KV_A + l * 128; const float* wu = P_W_KV_UP + (size_t)l * 128 * 128 + n;
        float acc = 0.f;
#pragma unroll 8
        for (int j = 0; j < 128; ++j) acc += (wi[j] * gk[j]) * wu[j * 128];
        w_in_t(ws_, l)[(size_t)(C_KA + n) * D + k] = (bf16)f2bf(acc);
    }
    for (int it = gw; it < DEPTH * 2 * 2 * 32; it += NGW) {
        const int lk = it >> 6, part = (it >> 5) & 1, r = it & 31, l = lk >> 1, kv = lk & 1;
        const float* W = (kv ? P_W_CMP_V : P_W_CMP_K) + (size_t)l * 32 * 64 * 64 + (size_t)part * 1024 * 64;
        transpose_item<0>(W, 1024, 64, 2, (bf16*)(ws_ + WS_WCT) + ((size_t)lk * 128 + part * 64) * 1024, scr, r, lane_);
    }
    for (int it = gw; it < DEPTH * 2; it += NGW) {
        const int l = it >> 1, kv = it & 1;
        const float* W = (kv ? P_W_CMP_V : P_W_CMP_K) + (size_t)l * 32 * 64 * 64 + lane_; const float* pe = (kv ? P_PE_V : P_PE_K) + l * 32 * 64;
        float acc = 0.f;
        for (int k = 0; k < 2048; ++k) acc += pe[k] * W[(size_t)k * 64];
        ((float*)(ws_ + WS_CB))[it * 64 + lane_] = acc;
    }
    for (int e = gw * 64 + lane_; e < M * 12; e += NGW * 64) {
        const int row = e / 12, i = e % 12;
        const double inv = c_rope_inv[i];
        const double a = (double)P_POS[row] * inv;
        const double k = __builtin_rint(a * 0.15915494309189535);
        const float r = (float)(a - k * 6.283185307179586);
        const float c = __builtin_cosf(r), s = __builtin_sinf(r);
        float* t = B_ROPE + (size_t)row * 24;
        if (i < 8) { t[i] = c; t[8 + i] = s; } else { t[16 + (i - 8)] = c; t[20 + (i - 8)] = s; }
    }
    for (int m = gw; m < M; m += NGW) norm_row_to_bf16(P_X_IN + (size_t)m * D, P_G_PRE_MIX, B_H + (size_t)m * D, lane_);
}

typedef short bf16x8 __attribute__((ext_vector_type(8)));
typedef short s16x4 __attribute__((ext_vector_type(4)));
typedef float f32x16 __attribute__((ext_vector_type(16)));
#define MFMA32(a, b, c) __builtin_amdgcn_mfma_f32_32x32x16_bf16((a), (b), (c), 0, 0, 0)
__device__ __forceinline__ int crow(int r, int hi) { return (r & 3) + 8 * (r >> 2) + 4 * hi; }
__device__ __forceinline__ void wg_barrier() { asm volatile("s_waitcnt lgkmcnt(0)\n\ts_barrier" ::: "memory"); }

__device__ __forceinline__ void phase_prep(Frame& F, const Args& args, int l) {
    unsigned char* ws_ = F.ws; asm volatile("" : "+s"(ws_)); int lane_ = F.lane; asm volatile("" : "+v"(lane_)); (void)ws_; (void)args;
    int tid_ = F.tid; asm volatile("" : "+v"(tid_));
    const int gw = F.vcu * NWAVES + F.wave, NGW = F.G * NWAVES, lane = lane_;
    for (int row = gw; row < M; row += NGW) {
        bf16* prow = B_PROJ + (size_t)row * NP;
        const float* tab = B_ROPE + (size_t)row * 24;
        const unsigned u = *(const unsigned*)(prow + C_CKV + 2 * lane);
        const float x0 = bflo(u), x1 = bfhi(u);
        const float rs = rsqrtf(wave_sum(x0 * x0 + x1 * x1) * (1.f / 128.f) + EPS);
        const unsigned v = *(const unsigned*)(prow + C_KA + 2 * lane);
        float y0 = bflo(v) * rs, y1 = bfhi(v) * rs;
        {
            const float p0 = __shfl_xor(y0, 4), p1 = __shfl_xor(y1, 4);
            const int i0 = (2 * lane) & 7;
            const float c0 = tab[i0], s0 = tab[8 + i0], c1 = tab[i0 + 1], s1 = tab[8 + i0 + 1];
            if (lane < 4) { y0 = y0 * c0 - p0 * s0; y1 = y1 * c1 - p1 * s1; }
            else if (lane < 8) { y0 = p0 * s0 + y0 * c0; y1 = p1 * s1 + y1 * c1; }
        }
        *(unsigned*)(prow + C_KA + 2 * lane) = pk2(y0, y1);
        if (lane >= 8 && lane < 12) { const int i = lane - 8; const float c = tab[16 + i], s = tab[20 + i];
            const float x1v = bf2f(prow[C_KIDX + i]), x2v = bf2f(prow[C_KIDX + 4 + i]);
            prow[C_KIDX + i] = (bf16)f2bf(x1v * c - x2v * s); prow[C_KIDX + 4 + i] = (bf16)f2bf(x1v * s + x2v * c);
        } else if (lane >= 16 && lane < 48) { const int idx = lane - 16, which = idx >> 3, i = idx & 7; const int base = ((which < 2) ? C_KSLC : C_KWIN) + (which & 1) * 64;
            const float c = tab[i], s = tab[8 + i];
            const float x1v = bf2f(prow[base + i]), x2v = bf2f(prow[base + 8 + i]);
            prow[base + i] = (bf16)f2bf(x1v * c - x2v * s); prow[base + 8 + i] = (bf16)f2bf(x1v * s + x2v * c);
        }
    }
    {
        const int wid = F.wave, r32 = lane & 31, hi = lane >> 5;
        LAS float* P = (LAS float*)F.lds;
        for (int u = F.vcu; u < BATCH * 8; u += F.G) {
            const int b = u >> 3, g = (u >> 2) & 1, kv = (u >> 1) & 1, eh = u & 1;
            const int rt = wid >> 1, part = wid & 1;
            const bf16* ap = B_PROJ + ((size_t)b * S + 16 * (32 * rt + r32)) * NP + (kv ? C_VCMP : C_KCMP) + g * 64 + 8 * hi;
            const bf16* bp = (const bf16*)(ws_ + WS_WCT) + ((size_t)(l * 2 + kv) * 128 + part * 64 + eh * 32 + r32) * 1024 + 8 * hi;
            f32x16 acc = {};
#pragma unroll 8
            for (int ks = 0; ks < 64; ++ks) {
                const bf16x8 a = *(const bf16x8*)(ap + (size_t)(ks >> 2) * NP + 16 * (ks & 3));
                const bf16x8 bq = *(const bf16x8*)(bp + 16 * ks);
                acc = MFMA32(a, bq, acc);
            }
#pragma unroll
            for (int r = 0; r < 16; ++r) P[(part * 128 + 32 * rt + crow(r, hi)) * 32 + r32] = acc[r];
            wg_barrier();
            const float* cb = (const float*)(ws_ + WS_CB) + (l * 2 + kv) * 64 + eh * 32;
            bf16* ob = (bf16*)(ws_ + (kv ? WS_VCB : WS_KCB)) + (size_t)(b * 2 + g) * 128 * 64 + eh * 32;
            for (int idx = tid_; idx < 128 * 32; idx += 512) { const int c = idx >> 5, e = idx & 31;
                const float v = (c < NC) ? (P[c * 32 + e] + P[(128 + c + 1) * 32 + e] + cb[e]) : 0.f;
                ob[c * 64 + e] = (bf16)f2bf(v); }
            wg_barrier();
        }
    }
}

typedef float f32x2_t __attribute__((ext_vector_type(2))); typedef __bf16 bf16x2_t __attribute__((ext_vector_type(2)));
__device__ __forceinline__ unsigned cvtpk(float lo, float hi) { const f32x2_t v = {lo, hi}; const bf16x2_t b = __builtin_convertvector(v, bf16x2_t); return __builtin_bit_cast(unsigned, b); }
constexpr float C2 = 0.125f * 1.4426950408889634f;

__device__ __forceinline__ unsigned idxmask(int x, int hi) {
    unsigned m = 0u;
#pragma unroll
    for (int g = 0; g < 4; ++g) { int n = x - (8 * g + 4 * hi); n = n < 0 ? 0 : (n > 4 ? 4 : n); m |= ((1u << n) - 1u) << (4 * g); }
    return m;
}

constexpr int SEL_QF = 0, SEL_PART = 16384;
__device__ __forceinline__ void dsa_select_unit(unsigned char* ws_, int tid_, int b, int qt32, LAS unsigned char* lds) {
    asm volatile("" : "+v"(tid_)); asm volatile("" : "+s"(ws_));
    const int lane = tid_ & 63, wid = __builtin_amdgcn_readfirstlane(tid_ >> 6), r32 = lane & 31, hi = lane >> 5;
    unsigned* maskbuf = (unsigned*)(ws_ + WS_MASK);
    if (qt32 < 8) {
        for (int i = tid_; i < 2048; i += 512) { const int qq = i >> 6, blk = i & 63; const int t = 32 * qt32 + qq; const int d = t - 32 * blk;
            const unsigned w = d < 0 ? 0u : (d >= 31 ? 0xffffffffu : ((2u << d) - 1u));
            maskbuf[((size_t)b * S + t) * 64 + blk] = w; }
        return;
    }
    const size_t qrow = (size_t)b * S + 32 * qt32 + r32;
    const bf16* prow = B_PROJ + qrow * NP;
    {
        const int h = wid >> 1, sk = wid & 1;
        const v4u raw = *(const v4u*)(prow + C_QIDX + h * 32 + 16 * sk + 8 * hi);
        float x[8] = {bflo(raw.x), bfhi(raw.x), bflo(raw.y), bfhi(raw.y), bflo(raw.z), bfhi(raw.z), bflo(raw.w), bfhi(raw.w)};
        if (sk == 0 && hi == 0) { const float* tab = B_ROPE + qrow * 24;
#pragma unroll
            for (int i = 0; i < 4; ++i) { const float c = tab[16 + i], sn = tab[20 + i]; const float x1 = x[i], x2 = x[4 + i]; x[i] = x1 * c - x2 * sn; x[4 + i] = x1 * sn + x2 * c; } }
        v4u hp, lp;
        { unsigned hh[4], ll[4];
#pragma unroll
          for (int k = 0; k < 4; ++k) { const float a = x[2 * k], bb = x[2 * k + 1]; const unsigned ha = f2bf(a), hb = f2bf(bb); hh[k] = ha | (hb << 16);
              ll[k] = pk2(a - bf2f((bf16)ha), bb - bf2f((bf16)hb)); }
          hp = (v4u){hh[0], hh[1], hh[2], hh[3]}; lp = (v4u){ll[0], ll[1], ll[2], ll[3]}; }
        LAS v4u* qf = (LAS v4u*)(lds + SEL_QF);
        qf[((h * 2 + sk) * 2 + 0) * 64 + lane] = hp; qf[((h * 2 + sk) * 2 + 1) * 64 + lane] = lp;
    }
    float w[4];
#pragma unroll
    for (int h = 0; h < 4; ++h) w[h] = bf2f(prow[C_WIDX + h]);
    __syncthreads();
    const int nblk = qt32 + 1;
    const bf16* kbase = B_PROJ + (size_t)b * S * NP + C_KIDX;
    unsigned key[8][16];
#pragma unroll
    for (int i = 0; i < 8; ++i) {
        const int blk = wid + 8 * i;
        if (blk < nblk) {
            const bf16* kp = kbase + (size_t)(32 * blk + r32) * NP + 8 * hi;
            const bf16x8 kf0 = *(const bf16x8*)kp, kf1 = *(const bf16x8*)(kp + 16);
            float sc[16];
            const LAS bf16x8* qf = (const LAS bf16x8*)(lds + SEL_QF);
#pragma unroll
            for (int h = 0; h < 4; ++h) {
                f32x16 acc = {};
                acc = MFMA32(kf0, qf[((h * 2 + 0) * 2 + 0) * 64 + lane], acc);
                acc = MFMA32(kf1, qf[((h * 2 + 1) * 2 + 0) * 64 + lane], acc);
                acc = MFMA32(kf0, qf[((h * 2 + 0) * 2 + 1) * 64 + lane], acc);
                acc = MFMA32(kf1, qf[((h * 2 + 1) * 2 + 1) * 64 + lane], acc);
#pragma unroll
                for (int r = 0; r < 16; ++r) sc[r] = (h == 0) ? w[0] * fmaxf(acc[r], 0.f) : fmaf(w[h], fmaxf(acc[r], 0.f), sc[r]);
            }
#pragma unroll
            for (int r = 0; r < 16; ++r) {
                unsigned bits = __builtin_bit_cast(unsigned, sc[r]);
                if (bits == 0x80000000u) bits = 0u;
                unsigned k = (bits & 0x80000000u) ? ~bits : (bits | 0x80000000u);
                if (blk == qt32 && crow(r, hi) > r32) k = 0u;
                key[i][r] = k;
            }
        } else {
#pragma unroll
            for (int r = 0; r < 16; ++r) key[i][r] = 0u;
        }
    }
    LAS unsigned* part = (LAS unsigned*)(lds + SEL_PART);
    int pbi = 0;
#define SEL_REDUCE(cnt_, tot_) do { LAS unsigned* pb_ = part + (pbi & 1) * 512; ++pbi; pb_[wid * 64 + lane] = (cnt_); wg_barrier(); unsigned t_ = 0u; \
        _Pragma("unroll") for (int w8 = 0; w8 < 8; ++w8) t_ += pb_[w8 * 64 + r32] + pb_[w8 * 64 + 32 + r32]; (tot_) = t_; } while (0)
    unsigned prefix = 0u;
    for (int bit = 31; bit >= 0; --bit) {
        const unsigned cand = prefix | (1u << bit);
        unsigned cnt = 0u;
#pragma unroll
        for (int i = 0; i < 8; ++i) if (wid + 8 * i < nblk) {
#pragma unroll
            for (int r = 0; r < 16; ++r) cnt += (key[i][r] >= cand) ? 1u : 0u; }
        unsigned tot; SEL_REDUCE(cnt, tot);
        if (tot >= 256u) prefix = cand;
    }
    const unsigned thr = prefix;
    unsigned gtm[8], eqm[8]; unsigned cg = 0u;
#pragma unroll
    for (int i = 0; i < 8; ++i) { unsigned g = 0u, e = 0u;
        if (wid + 8 * i < nblk) {
#pragma unroll
            for (int r = 0; r < 16; ++r) { g |= (key[i][r] > thr) ? (1u << r) : 0u; e |= (key[i][r] == thr) ? (1u << r) : 0u; } }
        gtm[i] = g; eqm[i] = e; cg += __builtin_popcount(g); }
    unsigned cgt; SEL_REDUCE(cg, cgt);
    const unsigned rneed = 256u - cgt;
    unsigned Y = 0u;
    for (int bit = 10; bit >= 0; --bit) {
        const unsigned c = Y | (1u << bit);
        unsigned cnt = 0u;
#pragma unroll
        for (int i = 0; i < 8; ++i) cnt += __builtin_popcount(eqm[i] & idxmask((int)c - 32 * (wid + 8 * i), hi));
        unsigned tot; SEL_REDUCE(cnt, tot);
        if (tot < rneed) Y = c;
    }
#undef SEL_REDUCE
#pragma unroll
    for (int i = 0; i < 8; ++i) {
        const int blk = wid + 8 * i;
        const unsigned selm = gtm[i] | (eqm[i] & idxmask((int)Y + 1 - 32 * blk, hi));
        unsigned word = ((selm & 0xFu) | ((selm & 0xF0u) << 4) | ((selm & 0xF00u) << 8) | ((selm & 0xF000u) << 12)) << (4 * hi);
        word |= (unsigned)__shfl_xor((int)word, 32);
        if (hi == 0) maskbuf[qrow * 64 + blk] = word;
    }
    __syncthreads();
}

constexpr int AT_K = 0, AT_V = 16384, AT_WS = 32768;
__device__ __forceinline__ void qkt(f32x16& p0, f32x16& p1, const LAS unsigned char* Kslot, const bf16x8* qr, const f32x16& negm, int r32, int hi) {
    const LAS unsigned char* kb = Kslot + hi * 1024 + r32 * 16;
#pragma unroll
    for (int d0 = 0; d0 < 4; ++d0) {
        const bf16x8 b0 = *(const LAS bf16x8*)(kb + d0 * 2048);
        const bf16x8 b1 = *(const LAS bf16x8*)(kb + d0 * 2048 + 512);
        if (d0 == 0) { p0 = MFMA32(b0, qr[0], negm); p1 = MFMA32(b1, qr[0], negm); }
        else { p0 = MFMA32(b0, qr[d0], p0); p1 = MFMA32(b1, qr[d0], p1); }
    }
}
__device__ __forceinline__ void pv(f32x16* o, unsigned vb, bf16x8 pa0, bf16x8 pa1, bf16x8 pa2, bf16x8 pa3) {
#pragma unroll
    for (int d0 = 0; d0 < 2; ++d0) { s16x4 lo0, lo1, lo2, lo3, hi0, hi1, hi2, hi3;
        asm volatile("ds_read_b64_tr_b16 %0,%8 offset:%c9\n\tds_read_b64_tr_b16 %1,%8 offset:%c10\n\tds_read_b64_tr_b16 %2,%8 offset:%c11\n\tds_read_b64_tr_b16 %3,%8 offset:%c12\n\t"
                     "ds_read_b64_tr_b16 %4,%8 offset:%c13\n\tds_read_b64_tr_b16 %5,%8 offset:%c14\n\tds_read_b64_tr_b16 %6,%8 offset:%c15\n\tds_read_b64_tr_b16 %7,%8 offset:%c16\n\t"
                     "s_waitcnt lgkmcnt(0)"
                     : "=&v"(lo0), "=&v"(hi0), "=&v"(lo1), "=&v"(hi1), "=&v"(lo2), "=&v"(hi2), "=&v"(lo3), "=&v"(hi3)
                     : "v"(vb), "i"(d0 * 4096 + 0), "i"(d0 * 4096 + 512), "i"(d0 * 4096 + 1024), "i"(d0 * 4096 + 1536), "i"(d0 * 4096 + 2048), "i"(d0 * 4096 + 2560), "i"(d0 * 4096 + 3072), "i"(d0 * 4096 + 3584)
                     : "memory");
#define PKV(l_, h_) (bf16x8){l_[0], l_[1], l_[2], l_[3], h_[0], h_[1], h_[2], h_[3]}
        o[d0] = MFMA32(pa0, PKV(lo0, hi0), o[d0]);
        o[d0] = MFMA32(pa1, PKV(lo1, hi1), o[d0]);
        o[d0] = MFMA32(pa2, PKV(lo2, hi2), o[d0]);
        o[d0] = MFMA32(pa3, PKV(lo3, hi3), o[d0]);
#undef PKV
    }
}
struct SmState { float mhat, l; f32x16 o[2]; f32x16 negm; };
__device__ __forceinline__ float rowmax32(const f32x16& p0, const f32x16& p1) {
    float a = fmaxf(p0[0], p1[0]);
#pragma unroll
    for (int r = 1; r < 16; ++r) a = fmaxf(a, fmaxf(p0[r], p1[r]));
    return fmaxf(a, __shfl_xor(a, 32));
}
__device__ __forceinline__ void sm_rescale(SmState& st, f32x16& p0, f32x16& p1, bool first, LAS float* wsf, int r32, int hi) {
    const float rm = rowmax32(p0, p1);
    if (first || __any(rm > 8.f)) {
        const float dl = first ? rm : fmaxf(rm, 0.f);
        st.mhat += dl;
#pragma unroll
        for (int r = 0; r < 16; ++r) { p0[r] -= dl; p1[r] -= dl; st.negm[r] = -st.mhat; }
        if (!first) {
            const float f = __builtin_amdgcn_exp2f(-dl); st.l *= f; if (hi == 0) wsf[r32] = f;
            asm volatile("s_waitcnt lgkmcnt(0)" ::: "memory");
#pragma unroll
            for (int d_ = 0; d_ < 2; ++d_)
#pragma unroll
                for (int r = 0; r < 16; ++r) st.o[d_][r] *= wsf[crow(r, hi)];
            asm volatile("s_waitcnt lgkmcnt(0)" ::: "memory");
        }
    }
}

__device__ __forceinline__ void dsa_attn_unit(unsigned char* ws_, int tid_, int b, int qt, LAS unsigned char* lds) {
    asm volatile("" : "+v"(tid_)); asm volatile("" : "+s"(ws_));
    const int lane = tid_ & 63, wid = __builtin_amdgcn_readfirstlane(tid_ >> 6), r32 = lane & 31, hi = lane >> 5;
    const int h = wid >> 1, qh = wid & 1;
    const size_t qrow = (size_t)b * S + 64 * qt + 32 * qh + r32;
    LAS float* wsf = (LAS float*)(lds + AT_WS) + wid * 64;
    bf16x8 qr[4];
    {
        const bf16* qp = B_PROJ + qrow * NP + C_QA + h * 64 + 8 * hi;
        const float* tab = B_ROPE + qrow * 24;
#pragma unroll
        for (int d0 = 0; d0 < 4; ++d0) {
            const v4u raw = *(const v4u*)(qp + 16 * d0);
            float x[8] = {bflo(raw.x), bfhi(raw.x), bflo(raw.y), bfhi(raw.y), bflo(raw.z), bfhi(raw.z), bflo(raw.w), bfhi(raw.w)};
            if (d0 == 0) {
#pragma unroll
                for (int j = 0; j < 8; ++j) { const float other = __shfl_xor(x[j], 32); const float c = tab[j], sn = tab[8 + j];
                    x[j] = (hi == 0) ? (x[j] * c - other * sn) : (other * sn + x[j] * c); }
            }
            v4u pk; pk.x = cvtpk(x[0] * C2, x[1] * C2); pk.y = cvtpk(x[2] * C2, x[3] * C2); pk.z = cvtpk(x[4] * C2, x[5] * C2); pk.w = cvtpk(x[6] * C2, x[7] * C2);
            qr[d0] = __builtin_bit_cast(bf16x8, pk);
        }
    }
    const bf16* KAb = B_PROJ + (size_t)b * S * NP;
    const bf16* ksrc = KAb + (size_t)lane * NP + C_KA + wid * 8;
    const bf16* vsrc = KAb + (size_t)(16 * (wid & 3) + (lane >> 2)) * NP + C_VA + (wid >> 2) * 32 + (lane & 3) * 8;
#define AT_DMA(t, slot) do { \
        __builtin_amdgcn_global_load_lds((const unsigned*)(ksrc + (size_t)(t) * 64 * NP), (LAS unsigned*)(lds + AT_K + (slot) * 8192 + wid * 1024), 16, 0, 0); \
        __builtin_amdgcn_global_load_lds((const unsigned*)(vsrc + (size_t)(t) * 64 * NP), (LAS unsigned*)(lds + AT_V + (slot) * 8192 + wid * 1024), 16, 0, 0); } while (0)
    const unsigned vb0 = (unsigned)(uintptr_t)(lds + AT_V) + ((lane >> 4) & 1) * 32 + (lane & 3) * 8 + (4 * hi + ((lane & 15) >> 2)) * 64;
    const int NT = qt + 1;
    SmState st; st.mhat = 0.f; st.l = 0.f; st.o[0] = f32x16{}; st.o[1] = f32x16{}; st.negm = f32x16{};
    const unsigned long long* mrow = (const unsigned long long*)((const unsigned*)(ws_ + WS_MASK) + qrow * 64);
    AT_DMA(0, 0);
    unsigned long long mnext = mrow[0];
    for (int t = 0; t < NT; ++t) {
        asm volatile("s_waitcnt vmcnt(0)" ::: "memory");
        wg_barrier();
        const unsigned long long mcur = mnext;
        if (t + 1 < NT) { AT_DMA(t + 1, (t + 1) & 1); mnext = mrow[t + 1]; }
        f32x16 p0, p1;
        qkt(p0, p1, lds + AT_K + (t & 1) * 8192, qr, st.negm, r32, hi);
        sm_rescale(st, p0, p1, t == 0, wsf, r32, hi);
        const unsigned wx = (unsigned)mcur >> (4 * hi), wy = (unsigned)(mcur >> 32) >> (4 * hi);
        float sacc = 0.f;
#pragma unroll
        for (int r = 0; r < 16; ++r) {
            const int c = (r & 3) + 8 * (r >> 2);
            const unsigned k0 = (unsigned)__builtin_amdgcn_sbfe((int)wx, c, 1), k1 = (unsigned)__builtin_amdgcn_sbfe((int)wy, c, 1);
            const float e0 = __builtin_bit_cast(float, __builtin_bit_cast(unsigned, __builtin_amdgcn_exp2f(p0[r])) & k0);
            const float e1 = __builtin_bit_cast(float, __builtin_bit_cast(unsigned, __builtin_amdgcn_exp2f(p1[r])) & k1);
            p0[r] = e0; p1[r] = e1; sacc += e0 + e1;
        }
        st.l += sacc;
        v4u pw0 = {cvtpk(p0[0], p0[1]), cvtpk(p0[2], p0[3]), cvtpk(p0[4], p0[5]), cvtpk(p0[6], p0[7])};
        v4u pw1 = {cvtpk(p0[8], p0[9]), cvtpk(p0[10], p0[11]), cvtpk(p0[12], p0[13]), cvtpk(p0[14], p0[15])};
        v4u pw2 = {cvtpk(p1[0], p1[1]), cvtpk(p1[2], p1[3]), cvtpk(p1[4], p1[5]), cvtpk(p1[6], p1[7])};
        v4u pw3 = {cvtpk(p1[8], p1[9]), cvtpk(p1[10], p1[11]), cvtpk(p1[12], p1[13]), cvtpk(p1[14], p1[15])};
        pv(st.o, vb0 + (t & 1) * 8192, __builtin_bit_cast(bf16x8, pw0), __builtin_bit_cast(bf16x8, pw1), __builtin_bit_cast(bf16x8, pw2), __builtin_bit_cast(bf16x8, pw3));
    }
#undef AT_DMA
    {
        const float lt = st.l + __shfl_xor(st.l, 32);
        if (hi == 0) wsf[r32] = 1.f / lt;
        asm volatile("s_waitcnt lgkmcnt(0)" ::: "memory");
        bf16* ob = B_MIX + ((size_t)b * S + 64 * qt + 32 * qh) * D + h * 64 + r32;
#pragma unroll
        for (int r = 0; r < 16; ++r) { const int rq = crow(r, hi); const float f = wsf[rq];
            ob[(size_t)rq * D] = (bf16)f2bf(st.o[0][r] * f); ob[(size_t)rq * D + 32] = (bf16)f2bf(st.o[1][r] * f); }
    }
    __syncthreads();
}


constexpr int NS_QF = 34816, NS_SELS = 67584, NS_SSUM = 100352, NS_SELM = 108544;
__device__ __forceinline__ unsigned long long mask_range(int lo, int up) {
    const int l2 = lo < 0 ? 0 : lo, u2 = up > 63 ? 63 : up;
    const unsigned long long hm = (u2 >= 63) ? ~0ull : ((2ull << (u2 & 63)) - 1ull);
    const unsigned long long lm = (1ull << (l2 & 63)) - 1ull;
    return (up < 0 || lo > 63 || u2 < l2) ? 0ull : (hm & ~lm);
}
__device__ __forceinline__ void load_q(bf16x8* qr, const bf16* qp, const float* tab, bool rope, int hi) {
#pragma unroll
    for (int d0 = 0; d0 < 4; ++d0) {
        const v4u raw = *(const v4u*)(qp + 16 * d0);
        float x[8] = {bflo(raw.x), bfhi(raw.x), bflo(raw.y), bfhi(raw.y), bflo(raw.z), bfhi(raw.z), bflo(raw.w), bfhi(raw.w)};
        if (d0 == 0) {
#pragma unroll
            for (int j = 0; j < 8; ++j) { const float other = __shfl_xor(x[j], 32); const float c = tab[j], sn = tab[8 + j];
                const float rot = (hi == 0) ? (x[j] * c - other * sn) : (other * sn + x[j] * c); x[j] = rope ? rot : x[j]; }
        }
        v4u pk; pk.x = cvtpk(x[0] * C2, x[1] * C2); pk.y = cvtpk(x[2] * C2, x[3] * C2); pk.z = cvtpk(x[4] * C2, x[5] * C2); pk.w = cvtpk(x[6] * C2, x[7] * C2);
        qr[d0] = __builtin_bit_cast(bf16x8, pk);
    }
}
__device__ __forceinline__ void qkt_lq(f32x16& p0, f32x16& p1, const LAS unsigned char* Kslot, const LAS bf16x8* qf, int lane, int r32, int hi) {
    const LAS unsigned char* kb = Kslot + hi * 1024 + r32 * 16;
    p0 = f32x16{}; p1 = f32x16{};
#pragma unroll
    for (int d0 = 0; d0 < 4; ++d0) {
        const bf16x8 b0 = *(const LAS bf16x8*)(kb + d0 * 2048);
        const bf16x8 b1 = *(const LAS bf16x8*)(kb + d0 * 2048 + 512);
        const bf16x8 q = qf[d0 * 64 + lane];
        p0 = MFMA32(b0, q, p0); p1 = MFMA32(b1, q, p1);
    }
}
template <bool SEL>
__device__ __forceinline__ void tile_step(SmState& st, f32x16& osel, const LAS unsigned char* Kslot, unsigned vb, const LAS bf16x8* qf, unsigned long long mcur, bool first, LAS float* wsf, int lane, int r32, int hi, int ctile) {
    f32x16 p0, p1;
    qkt_lq(p0, p1, Kslot, qf, lane, r32, hi);
    {
        const float rm = rowmax32(p0, p1) - st.mhat;
        if (first || __any(rm > 8.f)) {
            const float dl = first ? rm : fmaxf(rm, 0.f);
            st.mhat += dl;
            if (!first) {
                const float f = __builtin_amdgcn_exp2f(-dl); st.l *= f; if (hi == 0) wsf[r32] = f;
                asm volatile("s_waitcnt lgkmcnt(0)" ::: "memory");
#pragma unroll
                for (int r = 0; r < 16; ++r) { const float ff = wsf[crow(r, hi)]; st.o[0][r] *= ff; st.o[1][r] *= ff; if (SEL) osel[r] *= ff; }
                asm volatile("s_waitcnt lgkmcnt(0)" ::: "memory");
            }
        }
    }
    const unsigned wx = (unsigned)mcur >> (4 * hi), wy = (unsigned)(mcur >> 32) >> (4 * hi);
    float sacc = 0.f;
    const float mh = st.mhat;
#pragma unroll
    for (int r = 0; r < 16; ++r) {
        const int c = (r & 3) + 8 * (r >> 2);
        const unsigned k0 = (unsigned)__builtin_amdgcn_sbfe((int)wx, c, 1), k1 = (unsigned)__builtin_amdgcn_sbfe((int)wy, c, 1);
        const float e0 = __builtin_bit_cast(float, __builtin_bit_cast(unsigned, __builtin_amdgcn_exp2f(p0[r] - mh)) & k0);
        const float e1 = __builtin_bit_cast(float, __builtin_bit_cast(unsigned, __builtin_amdgcn_exp2f(p1[r] - mh)) & k1);
        p0[r] = e0; p1[r] = e1; sacc += e0 + e1;
    }
    st.l += sacc;
    unsigned pw[16];
#pragma unroll
    for (int k = 0; k < 8; ++k) { pw[k] = cvtpk(p0[2 * k], p0[2 * k + 1]); pw[8 + k] = cvtpk(p1[2 * k], p1[2 * k + 1]); }
    pv(st.o, vb, __builtin_bit_cast(bf16x8, (v4u){pw[0], pw[1], pw[2], pw[3]}), __builtin_bit_cast(bf16x8, (v4u){pw[4], pw[5], pw[6], pw[7]}),
       __builtin_bit_cast(bf16x8, (v4u){pw[8], pw[9], pw[10], pw[11]}), __builtin_bit_cast(bf16x8, (v4u){pw[12], pw[13], pw[14], pw[15]}));
    if (SEL) {
        unsigned pl[16];
#pragma unroll
        for (int k = 0; k < 8; ++k) {
            pl[k] = cvtpk(p0[2 * k] - bflo(pw[k]), p0[2 * k + 1] - bfhi(pw[k]));
            pl[8 + k] = cvtpk(p1[2 * k] - bflo(pw[8 + k]), p1[2 * k + 1] - bfhi(pw[8 + k]));
        }
#pragma unroll
        for (int ks = 0; ks < 4; ++ks) {
            unsigned ov[4];
#pragma unroll
            for (int k = 0; k < 4; ++k) {
                const int j0 = 2 * k, j1 = 2 * k + 1;
                const int c0 = 64 * ctile + 16 * ks + 8 * (j0 >> 2) + 4 * hi + (j0 & 3), c1 = 64 * ctile + 16 * ks + 8 * (j1 >> 2) + 4 * hi + (j1 & 3);
                const unsigned a = (c0 >= 4 * r32 - 1 && c0 <= 4 * r32 + 3) ? 0x3F80u : 0u, bq = (c1 >= 4 * r32 - 1 && c1 <= 4 * r32 + 3) ? 0x3F80u : 0u;
                ov[k] = a | (bq << 16);
            }
            const bf16x8 ovf = __builtin_bit_cast(bf16x8, (v4u){ov[0], ov[1], ov[2], ov[3]});
            osel = MFMA32(__builtin_bit_cast(bf16x8, (v4u){pw[4 * ks], pw[4 * ks + 1], pw[4 * ks + 2], pw[4 * ks + 3]}), ovf, osel);
            osel = MFMA32(__builtin_bit_cast(bf16x8, (v4u){pl[4 * ks], pl[4 * ks + 1], pl[4 * ks + 2], pl[4 * ks + 3]}), ovf, osel);
        }
    }
}
__device__ __forceinline__ void sm_reset(SmState& st) { st.mhat = 0.f; st.l = 0.f; st.o[0] = f32x16{}; st.o[1] = f32x16{}; st.negm = f32x16{}; }
__device__ __forceinline__ float sigmoidf_(float x) { return 1.f / (1.f + __expf(-x)); }

template <bool SEL>
__device__ __forceinline__ void nsa_unit(unsigned char* ws_, int tid_, int b, int g, int qt, LAS unsigned char* lds) {
    asm volatile("" : "+v"(tid_)); asm volatile("" : "+s"(ws_));
    const int lane = tid_ & 63, wid = __builtin_amdgcn_readfirstlane(tid_ >> 6), r32 = lane & 31, hi = lane >> 5;
    const int hr = wid >> 1, qh = wid & 1, H = 4 * g + hr;
    const int tq = 64 * qt + 32 * qh + r32;
    const size_t qrow = (size_t)b * S + tq;
    LAS float* wsf = (LAS float*)(lds + AT_WS) + wid * 64;
    const bf16* prow = B_PROJ + qrow * NP;
    const float* tab = B_ROPE + qrow * 24;
    const bf16* qp = prow + C_QB + H * 64 + 8 * hi;
    const unsigned vb0 = (unsigned)(uintptr_t)(lds + AT_V) + ((lane >> 4) & 1) * 32 + (lane & 3) * 8 + (4 * hi + ((lane & 15) >> 2)) * 64;
    const bf16* kcb = (const bf16*)(ws_ + WS_KCB) + (size_t)(b * 2 + g) * 128 * 64;
    const bf16* vcb = (const bf16*)(ws_ + WS_VCB) + (size_t)(b * 2 + g) * 128 * 64;
    const bf16* pb = B_PROJ + (size_t)b * S * NP + g * 64;
    const int vrow = 16 * (wid & 3) + (lane >> 2), vcol = (wid >> 2) * 32 + (lane & 3) * 8;
#define NS_DMA(kp_, vp_, slot_) do { \
        __builtin_amdgcn_global_load_lds((const unsigned*)(kp_), (LAS unsigned*)(lds + AT_K + (slot_) * 8192 + wid * 1024), 16, 0, 0); \
        __builtin_amdgcn_global_load_lds((const unsigned*)(vp_), (LAS unsigned*)(lds + AT_V + (slot_) * 8192 + wid * 1024), 16, 0, 0); } while (0)
#define NS_DMA_CMP(i_, slot_) NS_DMA(kcb + (size_t)(64 * (i_) + lane) * 64 + wid * 8, vcb + (size_t)(64 * (i_) + vrow) * 64 + vcol, slot_)
#define NS_DMA_PROJ(ck_, cv_, j_, slot_) NS_DMA(pb + (size_t)(64 * (j_) + lane) * NP + (ck_) + wid * 8, pb + (size_t)(64 * (j_) + vrow) * NP + (cv_) + vcol, slot_)
#define NS_SYNC() do { asm volatile("s_waitcnt vmcnt(0)" ::: "memory"); wg_barrier(); } while (0)
    const int ncmp = (qt >= 16) ? 2 : 1;
    const int jw0 = (qt > 8) ? qt - 8 : 0;
    int slot = 0;
    NS_DMA_CMP(0, 0);
    LAS bf16x8* qf = (LAS bf16x8*)(lds + NS_QF) + wid * 256;
    { bf16x8 qr[4]; load_q(qr, qp, tab, false, hi);
#pragma unroll
      for (int d0 = 0; d0 < 4; ++d0) qf[d0 * 64 + lane] = qr[d0]; }
    SmState st; sm_reset(st);
    f32x16 osel = {};
    f32x16 oacc[2];
    const int ncv = (tq >= 31) ? (((tq - 31) >> 4) + 1) : 0;
    for (int i = 0; i < ncmp; ++i) {
        NS_SYNC();
        if (i + 1 < ncmp) NS_DMA_CMP(i + 1, slot ^ 1); else NS_DMA_PROJ(C_KWIN, C_VWIN, jw0, slot ^ 1);
        const unsigned long long m = mask_range(0, ncv - 64 * i - 1);
        tile_step<SEL>(st, osel, lds + AT_K + slot * 8192, vb0 + slot * 8192, qf, m, i == 0, wsf, lane, r32, hi, i);
        slot ^= 1;
    }
    {
        const float lt = st.l + __shfl_xor(st.l, 32);
        const float inv = lt > 0.f ? 1.f / lt : 0.f;
        const float g0 = sigmoidf_(bf2f(prow[C_GATE + H * 3 + 0]));
        if (hi == 0) { wsf[r32] = inv; wsf[32 + r32] = inv * g0; }
        asm volatile("s_waitcnt lgkmcnt(0)" ::: "memory");
        LAS float* sels = (LAS float*)(lds + NS_SELS);
#pragma unroll
        for (int r = 0; r < 16; ++r) { const int rq = crow(r, hi); const float f2 = wsf[32 + rq];
            oacc[0][r] = st.o[0][r] * f2; oacc[1][r] = st.o[1][r] * f2;
            if (SEL) sels[(hr * 64 + 32 * qh + rq) * 32 + r32] = osel[r] * wsf[rq]; }
    }
    unsigned mysel, selunion;
    if (SEL) {
        wg_barrier();
        LAS float* sels = (LAS float*)(lds + NS_SELS);
        LAS float* ssum = (LAS float*)(lds + NS_SSUM);
        LAS unsigned* selm = (LAS unsigned*)(lds + NS_SELM);
        const int q = tid_ >> 3, jg = tid_ & 7;
        f32x4 s4 = *(const LAS f32x4*)(sels + (0 * 64 + q) * 32 + 4 * jg);
        s4 += *(const LAS f32x4*)(sels + (1 * 64 + q) * 32 + 4 * jg);
        s4 += *(const LAS f32x4*)(sels + (2 * 64 + q) * 32 + 4 * jg);
        s4 += *(const LAS f32x4*)(sels + (3 * 64 + q) * 32 + 4 * jg);
        *(LAS f32x4*)(ssum + q * 32 + 4 * jg) = s4;
        asm volatile("s_waitcnt lgkmcnt(0)" ::: "memory");
        float sv[32];
#pragma unroll
        for (int k = 0; k < 8; ++k) { const f32x4 v = *(const LAS f32x4*)(ssum + q * 32 + 4 * k); sv[4 * k] = v.x; sv[4 * k + 1] = v.y; sv[4 * k + 2] = v.z; sv[4 * k + 3] = v.w; }
        const float PINF = __builtin_inff();
#pragma unroll
        for (int i = 0; i < 32; ++i) sv[i] = (i > qt) ? -PINF : ((i == 0 || i == qt || i == qt - 1) ? PINF : sv[i]);
        unsigned bits4 = 0u;
#pragma unroll
        for (int jj = 0; jj < 4; ++jj) {
            const int j = 4 * jg + jj;
            float mine = (jj == 0) ? s4.x : (jj == 1) ? s4.y : (jj == 2) ? s4.z : s4.w;
            mine = (j > qt) ? -PINF : ((j == 0 || j == qt || j == qt - 1) ? PINF : mine);
            int rank = 0;
#pragma unroll
            for (int i = 0; i < 32; ++i) rank += ((sv[i] > mine) || (sv[i] == mine && i < j)) ? 1 : 0;
            bits4 |= (rank < 16) ? (1u << jj) : 0u;
        }
        unsigned mm = bits4 << (4 * jg);
        mm |= (unsigned)__shfl_xor((int)mm, 1); mm |= (unsigned)__shfl_xor((int)mm, 2); mm |= (unsigned)__shfl_xor((int)mm, 4);
        if (jg == 0) selm[q] = mm;
        wg_barrier();
        unsigned u = selm[lane];
#pragma unroll
        for (int o_ = 1; o_ < 64; o_ <<= 1) u |= (unsigned)__shfl_xor((int)u, o_);
        selunion = (unsigned)__builtin_amdgcn_readfirstlane((int)u);
        mysel = selm[32 * qh + r32];
    } else {
        mysel = selunion = (2u << qt) - 1u;
    }
    { bf16x8 qr[4]; load_q(qr, qp, tab, true, hi);
#pragma unroll
      for (int d0 = 0; d0 < 4; ++d0) qf[d0 * 64 + lane] = qr[d0]; }
    sm_reset(st);
    unsigned rem = selunion;
    for (int j = jw0; j <= qt; ++j) {
        NS_SYNC();
        if (j < qt) NS_DMA_PROJ(C_KWIN, C_VWIN, j + 1, slot ^ 1); else NS_DMA_PROJ(C_KSLC, C_VSLC, __builtin_ctz(rem), slot ^ 1);
        const unsigned long long m = mask_range(tq - 511 - 64 * j, tq - 64 * j);
        tile_step<false>(st, osel, lds + AT_K + slot * 8192, vb0 + slot * 8192, qf, m, j == jw0, wsf, lane, r32, hi, 0);
        slot ^= 1;
    }
    {
        const float lt = st.l + __shfl_xor(st.l, 32);
        const float g2 = sigmoidf_(bf2f(prow[C_GATE + H * 3 + 2]));
        if (hi == 0) wsf[32 + r32] = lt > 0.f ? g2 / lt : 0.f;
        asm volatile("s_waitcnt lgkmcnt(0)" ::: "memory");
#pragma unroll
        for (int r = 0; r < 16; ++r) { const float f2 = wsf[32 + crow(r, hi)]; oacc[0][r] += st.o[0][r] * f2; oacc[1][r] += st.o[1][r] * f2; }
    }
    sm_reset(st);
    bool firstb = true;
    while (rem) {
        const int j = __builtin_ctz(rem); rem &= rem - 1u;
        NS_SYNC();
        if (rem) NS_DMA_PROJ(C_KSLC, C_VSLC, __builtin_ctz(rem), slot ^ 1);
        const unsigned long long m = ((mysel >> j) & 1u) ? mask_range(0, tq - 64 * j) : 0ull;
        tile_step<false>(st, osel, lds + AT_K + slot * 8192, vb0 + slot * 8192, qf, m, firstb, wsf, lane, r32, hi, 0);
        firstb = false; slot ^= 1;
    }
    {
        const float lt = st.l + __shfl_xor(st.l, 32);
        const float g1 = sigmoidf_(bf2f(prow[C_GATE + H * 3 + 1]));
        if (hi == 0) wsf[32 + r32] = lt > 0.f ? g1 / lt : 0.f;
        asm volatile("s_waitcnt lgkmcnt(0)" ::: "memory");
        bf16* ob = B_MIX + ((size_t)b * S + 64 * qt + 32 * qh) * D + 256 + H * 64 + r32;
#pragma unroll
        for (int r = 0; r < 16; ++r) { const int rq = crow(r, hi); const float f2 = wsf[32 + rq];
            ob[(size_t)rq * D] = (bf16)f2bf(oacc[0][r] + st.o[0][r] * f2); ob[(size_t)rq * D + 32] = (bf16)f2bf(oacc[1][r] + st.o[1][r] * f2); }
    }
    __syncthreads();
#undef NS_DMA
#undef NS_DMA_CMP
#undef NS_DMA_PROJ
#undef NS_SYNC
}

__device__ __forceinline__ void phase_attn(Frame& F, int l) {
    (void)l;
    unsigned char* ws_ = F.ws; asm volatile("" : "+s"(ws_)); int lane_ = F.lane; asm volatile("" : "+v"(lane_)); (void)ws_;
    int tid_ = F.tid; asm volatile("" : "+v"(tid_));
    for (int u = F.vcu; u < BATCH * 64; u += F.G) {
        const int c = u & 255, i = u >> 8; const int b = c >> 3, sft = c & 7; const int base = 16 * (i >> 1); const int qt32 = (i & 1) ? base + 15 - sft : base + sft;
        dsa_select_unit(ws_, tid_, b, qt32, F.lds);
    }
    __syncthreads();
    for (int u = F.vcu; u < BATCH * 64; u += F.G) {
        const int c = u & 255, i = u >> 8; const int b = c >> 3, sft = c & 7; const int g = i & 1, k = i >> 1; const int base = 16 * (k >> 1); const int qt = (k & 1) ? base + 15 - sft : base + sft;
        if (qt >= 16) nsa_unit<true>(ws_, tid_, b, g, qt, F.lds); else nsa_unit<false>(ws_, tid_, b, g, qt, F.lds);
    }
}
__device__ __forceinline__ void phase_dsa_attn(Frame& F) {
    unsigned char* ws_ = F.ws; asm volatile("" : "+s"(ws_));
    int tid_ = F.tid; asm volatile("" : "+v"(tid_));
    for (int u = F.vcu; u < BATCH * 32; u += F.G) {
        const int c = u & 255, i = u >> 8; const int b = c >> 3, sft = c & 7; const int base = 16 * (i >> 1); const int qt = (i & 1) ? base + 15 - sft : base + sft;
        dsa_attn_unit(ws_, tid_, b, qt, F.lds);
    }
}

constexpr int WP_PITCH = 72;
__device__ __forceinline__ void phase_merge(Frame& F, const Args& args, int l) {
    unsigned char* ws_ = F.ws; asm volatile("" : "+s"(ws_)); int lane_ = F.lane; asm volatile("" : "+v"(lane_)); (void)ws_;
    int tid_ = F.tid; asm volatile("" : "+v"(tid_));
    const int gw = F.vcu * NWAVES + F.wave, NGW = F.G * NWAVES, lane = lane_;
    const float* psc = P_POOL_SCALE + l * 256;
    const float* goa = P_G_OUT_A + l * 256; const float* gob = P_G_OUT_B + l * 512;
    LAS bf16* wp = (LAS bf16*)F.lds;
    {
        const float* wsrc = P_W_POOL + (size_t)l * 4 * 64 * 64;
        for (int idx = tid_; idx < 4 * 64 * 64; idx += 512) { const int g = idx >> 12, c = (idx >> 6) & 63, d = idx & 63; wp[(g * 64 + d) * WP_PITCH + c] = (bf16)f2bf(wsrc[idx]); }
    }
    for (int row = gw; row < M; row += NGW) {
        bf16* mrow = B_MIX + (size_t)row * D;
        { const unsigned long long u = *((const unsigned long long*)mrow + lane);
          const float a0 = bflo((unsigned)u), a1 = bfhi((unsigned)u), a2 = bflo((unsigned)(u >> 32)), a3 = bfhi((unsigned)(u >> 32));
          const float rs = rsqrtf(wave_sum((a0 * a0 + a1 * a1) + (a2 * a2 + a3 * a3)) * (1.f / 256.f) + EPS);
          const f32x4 gg = ((const f32x4*)goa)[lane];
          *((unsigned long long*)mrow + lane) = (unsigned long long)pk2(a0 * rs * gg.x, a1 * rs * gg.y) | ((unsigned long long)pk2(a2 * rs * gg.z, a3 * rs * gg.w) << 32); }
        { const v4u u = *((const v4u*)(mrow + 256) + lane);
          float a[8] = {bflo(u.x), bfhi(u.x), bflo(u.y), bfhi(u.y), bflo(u.z), bfhi(u.z), bflo(u.w), bfhi(u.w)};
          float ss = 0.f;
#pragma unroll
          for (int i = 0; i < 8; ++i) ss += a[i] * a[i];
          const float rs = rsqrtf(wave_sum(ss) * (1.f / 512.f) + EPS);
          const f32x4 g0 = ((const f32x4*)gob)[2 * lane], g1 = ((const f32x4*)gob)[2 * lane + 1];
          v4u o; o.x = pk2(a[0] * rs * g0.x, a[1] * rs * g0.y); o.y = pk2(a[2] * rs * g0.z, a[3] * rs * g0.w); o.z = pk2(a[4] * rs * g1.x, a[5] * rs * g1.y); o.w = pk2(a[6] * rs * g1.z, a[7] * rs * g1.w);
          *((v4u*)(mrow + 256) + lane) = o; }
    }
    __syncthreads();
    {
        const int r32 = lane & 31, hi = lane >> 5;
        for (int tile = gw; tile < M / 32; tile += NGW) {
            const int row = 32 * tile + r32, t = row % S;
            const bf16* up = B_PROJ + (size_t)row * NP + C_UC + 8 * hi;
            f32x16 acc[4][2];
#pragma unroll
            for (int g = 0; g < 4; ++g) {
                acc[g][0] = f32x16{}; acc[g][1] = f32x16{};
                const int w = 2 << g;
                const float icnt = 1.f / (float)((t + 1 < w) ? t + 1 : w);
#pragma unroll
                for (int ks = 0; ks < 4; ++ks) {
                    const bf16* p0 = up + g * 64 + 16 * ks;
                    const v4u u0 = *(const v4u*)p0;
                    float cur[8] = {bflo(u0.x), bfhi(u0.x), bflo(u0.y), bfhi(u0.y), bflo(u0.z), bfhi(u0.z), bflo(u0.w), bfhi(u0.w)};
                    float sum[8];
#pragma unroll
                    for (int j = 0; j < 8; ++j) sum[j] = cur[j];
#pragma unroll
                    for (int i = 1; i < w; ++i) {
                        if (t - i >= 0) { const v4u ui = *(const v4u*)(p0 - (size_t)i * NP);
                            sum[0] += bflo(ui.x); sum[1] += bfhi(ui.x); sum[2] += bflo(ui.y); sum[3] += bfhi(ui.y); sum[4] += bflo(ui.z); sum[5] += bfhi(ui.z); sum[6] += bflo(ui.w); sum[7] += bfhi(ui.w); }
                    }
                    v4u pk; pk.x = cvtpk(sum[0] * icnt - cur[0], sum[1] * icnt - cur[1]); pk.y = cvtpk(sum[2] * icnt - cur[2], sum[3] * icnt - cur[3]);
                    pk.z = cvtpk(sum[4] * icnt - cur[4], sum[5] * icnt - cur[5]); pk.w = cvtpk(sum[6] * icnt - cur[6], sum[7] * icnt - cur[7]);
                    const bf16x8 af = __builtin_bit_cast(bf16x8, pk);
#pragma unroll
                    for (int nb = 0; nb < 2; ++nb) {
                        const bf16x8 bfr = *(const LAS bf16x8*)(wp + (g * 64 + 32 * nb + r32) * WP_PITCH + 16 * ks + 8 * hi);
                        acc[g][nb] = MFMA32(af, bfr, acc[g][nb]);
                    }
                }
            }
            float ss[16];
#pragma unroll
            for (int r = 0; r < 16; ++r) { float a = 0.f;
#pragma unroll
                for (int g = 0; g < 4; ++g) a += acc[g][0][r] * acc[g][0][r] + acc[g][1][r] * acc[g][1][r];
#pragma unroll
                for (int o_ = 1; o_ < 32; o_ <<= 1) a += __shfl_xor(a, o_);
                ss[r] = rsqrtf(a * (1.f / 256.f) + EPS); }
            bf16* ob = B_MIX + (size_t)(32 * tile) * D + 768 + r32;
#pragma unroll
            for (int g = 0; g < 4; ++g)
#pragma unroll
                for (int nb = 0; nb < 2; ++nb) { const float sc = psc[g * 64 + 32 * nb + r32];
#pragma unroll
                    for (int r = 0; r < 16; ++r) ob[(size_t)crow(r, hi) * D + g * 64 + 32 * nb] = (bf16)f2bf(acc[g][nb][r] * ss[r] * sc); }
        }
    }
    __syncthreads();
}

__device__ __forceinline__ void phase_finish(Frame& F, const float* xsrc, const float* gpost, const float* gnext  ) {
    unsigned char* ws_ = F.ws; asm volatile("" : "+s"(ws_)); int lane_ = F.lane; asm volatile("" : "+v"(lane_)); (void)ws_;
    const int gw = F.vcu * NWAVES + F.wave, NGW = F.G * NWAVES, lane = lane_;
    for (int row = gw; row < M; row += NGW) {
        const unsigned long long* fr = (const unsigned long long*)(B_F + (size_t)row * D) + lane;
        const f32x4* xr = (const f32x4*)(xsrc + (size_t)row * D) + lane;
        f32x4 f[4], x[4]; float ss = 0.f;
#pragma unroll
        for (int j = 0; j < 4; ++j) { const unsigned long long u = fr[64 * j]; x[j] = xr[64 * j];
            f[j] = (f32x4){bflo((unsigned)u), bfhi((unsigned)u), bflo((unsigned)(u >> 32)), bfhi((unsigned)(u >> 32))};
            ss += (f[j].x * f[j].x + f[j].y * f[j].y) + (f[j].z * f[j].z + f[j].w * f[j].w); }
        const float rs = rsqrtf(wave_sum(ss) * (1.f / D) + EPS);
        float s2 = 0.f;
        f32x4* orow = (f32x4*)(F.out + (size_t)row * D) + lane;
#pragma unroll
        for (int j = 0; j < 4; ++j) { const f32x4 g = ((const f32x4*)gpost)[lane + 64 * j];
            x[j].x += f[j].x * rs * g.x; x[j].y += f[j].y * rs * g.y; x[j].z += f[j].z * rs * g.z; x[j].w += f[j].w * rs * g.w;
            orow[64 * j] = x[j];
            s2 += (x[j].x * x[j].x + x[j].y * x[j].y) + (x[j].z * x[j].z + x[j].w * x[j].w); }
        if (gnext) {
            const float r2 = rsqrtf(wave_sum(s2) * (1.f / D) + EPS);
            unsigned long long* o8 = (unsigned long long*)(B_H + (size_t)row * D) + lane;
#pragma unroll
            for (int j = 0; j < 4; ++j) { const f32x4 g = ((const f32x4*)gnext)[lane + 64 * j];
                o8[64 * j] = (unsigned long long)pk2(x[j].x * r2 * g.x, x[j].y * r2 * g.y) | ((unsigned long long)pk2(x[j].z * r2 * g.z, x[j].w * r2 * g.w) << 32); }
        }
    }
}

template <int ACT>
__device__ __forceinline__ void phase_gemm(Frame& F, const bf16* A, const bf16* Bt, bf16* O, int N, int K) {
    asm volatile("" : "+s"(A), "+s"(Bt), "+s"(O));
    pg8::Gemm g{A, Bt, M, N, K}; pg8::StaticOrder So; So.init(M, N, F.G, (int)blockIdx.x);
    pg8::EpiStore<ACT> E{O, N};
    pg8::gemm_phase<pg8::EpiStore<ACT>, pg8::StaticOrder, true, true>(F.lds, g, So, E);
}

constexpr int PH_PER_LAYER = 10, NPHASES = 1 + DEPTH * PH_PER_LAYER;
__global__ void __launch_bounds__(NWAVES * 64, 2) mk_fwd(Args args) {
    extern __shared__ __attribute__((aligned(16))) unsigned char lds[];
    Frame F;
    F.lds = (LAS unsigned char*)lds;
    F.MISC = (volatile LAS unsigned*)(F.lds + MISC_OFF);
    F.tid = threadIdx.x; F.lane = F.tid & 63; F.wave = __builtin_amdgcn_readfirstlane(F.tid >> 6);
    F.G = gridDim.x; { const int bx = blockIdx.x; F.vcu = (F.G % 8 == 0) ? (bx % 8) * (F.G / 8) + bx / 8 : bx; }
    unsigned char* ws = args.ws; F.ws = ws;
    F.ctl = (gu32*)(ws + WS_CTL);
    F.out = args.out;
    for (int u = F.tid; u < (LDS_BYTES - LDSCTL_OFF) / 4; u += NWAVES * 64) ((LAS unsigned*)(F.lds + LDSCTL_OFF))[u] = 0u;
    __syncthreads();
    XcdBarrier bar; bar.bar = (unsigned*)(F.ctl + CW_BAR); bar.x = 0; bar.st = F.MISC + 8;
    if (args.use_bar) bar = xcd_barrier_post((unsigned*)(F.ctl + CW_BAR), F.MISC + 8);
    const int lo = args.ph_lo, hi = args.ph_hi;
    int pid = 0;
    unsigned char* ws_ = F.ws;
#define PH_ON (pid >= lo && pid < hi)
#if PROBE_MASK
    unsigned long long pr_last = __builtin_amdgcn_s_memrealtime(), pr_acc = 0ull;
#define PH_END(kind) do { if (PH_ON && pid + 1 < hi) xcd_barrier(bar); ++pid; \
        { const unsigned long long now_ = __builtin_amdgcn_s_memrealtime(); if ((PROBE_MASK >> (kind)) & 1) pr_acc += now_ - pr_last; pr_last = now_; } } while (0)
#else
#define PH_END(kind) do { if (PH_ON && pid + 1 < hi) xcd_barrier(bar); ++pid; } while (0)
#endif

    if (PH_ON && !(SKIPM & 1)) phase_prologue(F, args);
    PH_END(0);
    for (int l = 0; l < DEPTH; ++l) {
        if (PH_ON && !(SKIPM & 2)) phase_gemm<0>(F, B_H, w_in_t(ws_, l), B_PROJ, NP, D);
        PH_END(1);
        if (PH_ON && !(SKIPM & 4)) phase_prep(F, args, l);
        PH_END(2);
        if (PH_ON && !(SKIPM & 8)) phase_attn(F, l);
        PH_END(3);
        if (PH_ON && !(SKIPM & 8)) phase_dsa_attn(F);
        PH_END(4);
        if (PH_ON && !(SKIPM & 16)) phase_merge(F, args, l);
        PH_END(5);
        if (PH_ON && !(SKIPM & 32)) phase_gemm<0>(F, B_MIX, w_out_t(ws_, l), B_F, D, D);
        PH_END(6);
        if (PH_ON && !(SKIPM & 64)) phase_finish(F, l == 0 ? P_X_IN : F.out, P_G_POST_MIX + l * D, P_G_PRE_MLP + l * D);
        PH_END(7);
        if (PH_ON && !(SKIPM & 128)) phase_gemm<2>(F, B_H, w_up_t(ws_, l), B_HID, FF, D);
        PH_END(8);
        if (PH_ON && !(SKIPM & 256)) phase_gemm<0>(F, B_HID, w_dn_t(ws_, l), B_F, D, FF);
        PH_END(9);
        if (PH_ON && !(SKIPM & 512)) phase_finish(F, F.out, P_G_POST_MLP + l * D, (l + 1 < DEPTH) ? P_G_PRE_MIX + (l + 1) * D : nullptr);
        PH_END(10);
    }
#if PROBE_MASK
    if (blockIdx.x == 0 && F.tid == 0) { const unsigned long long t0_ = __builtin_amdgcn_s_memrealtime(); while (__builtin_amdgcn_s_memrealtime() - t0_ < pr_acc) __builtin_amdgcn_s_sleep(8); }
#endif
#undef PH_ON
#undef PH_END
}

extern "C" void kernel_launch(void* const* d_in, const int* in_sizes, int n_in, void* d_out, int out_size, void* d_ws, size_t ws_size, hipStream_t stream) {
    static int grid = 0;
    if (grid == 0) {
        if (n_in != 20 || in_sizes[0] != M * D || out_size != M * D || ws_size < WS_END) {
            fprintf(stderr, "kernel_launch: unexpected shapes / workspace (n_in %d, in0 %d, out %d, ws %zu < %zu); nothing launched\n", n_in, n_in > 0 ? in_sizes[0] : -1, out_size, ws_size, (size_t)WS_END);
            grid = -1; return; }
        int dev = 0, cus = 0, per_cu = 0;
        if (hipGetDevice(&dev) != hipSuccess || hipDeviceGetAttribute(&cus, hipDeviceAttributeMultiprocessorCount, dev) != hipSuccess) { grid = -1; return; }
        if (hipFuncSetAttribute((const void*)mk_fwd, hipFuncAttributeMaxDynamicSharedMemorySize, LDS_BYTES) != hipSuccess) { fprintf(stderr, "kernel_launch: hipFuncSetAttribute failed\n"); grid = -1; return; }
        if (hipOccupancyMaxActiveBlocksPerMultiprocessor(&per_cu, (const void*)mk_fwd, NWAVES * 64, LDS_BYTES) != hipSuccess || per_cu < 1)
            fprintf(stderr, "kernel_launch: note: occupancy query reports %d workgroups per CU\n", per_cu);
        (void)hipGetLastError();
        grid = cus;
    }
    if (grid < 0) return;
    if (hipMemsetAsync((char*)d_ws + WS_CTL, 0, CTL_ZERO_BYTES, stream) != hipSuccess) return;
    Args a{};
    for (int i = 0; i < 20; ++i) a.in[i] = d_in[i];
    a.out = (float*)d_out; a.ws = (unsigned char*)d_ws; a.pad = 0;
#if MK_MULTI
    for (int p = 0; p < NPHASES; ++p) {
        a.ph_lo = p; a.ph_hi = p + 1; a.use_bar = 0;
        hipLaunchKernelGGL(mk_fwd, dim3(grid), dim3(NWAVES * 64), LDS_BYTES, stream, a);
    }
#else
    a.ph_lo = 0; a.ph_hi = NPHASES; a.use_bar = 1;
    hipLaunchKernelGGL(mk_fwd, dim3(grid), dim3(NWAVES * 64), LDS_BYTES, stream, a);
#endif
}
```

```cpp
#include <hip/hip_runtime.h>
#include <cstdio>
#include <cstdint>

#ifndef PROBE_MASK
#define PROBE_MASK 0
#endif
#ifndef SKIPM
#define SKIPM 0
#endif
#ifndef MK_MULTI
#define MK_MULTI 0
#endif

namespace pg8 {
#define PG8_LAS __attribute__((address_space(3)))
typedef unsigned short bf16_t;
typedef short bf16x8 __attribute__((ext_vector_type(8)));
typedef float f32x4 __attribute__((ext_vector_type(4)));
typedef unsigned u32x4 __attribute__((ext_vector_type(4)));
constexpr int BM = 256, BK = 64, HALF = 128, HTB = HALF * BK * 2, STAGE_BYTES = 8 * HTB, NXCD = 8, WGM = 8;

__host__ __device__ __forceinline__ int lds_byte(int r, int c) { const int st = (r >> 4) * 2 + (c >> 5), rr = r & 15, cc = c & 31, ob = rr * 64 + cc * 2; return st * 1024 + (ob ^ (((ob >> 9) & 1) << 5)); }
__host__ __device__ __forceinline__ void stage_rc(int b, int& R, int& C) { const int st = b / 1024, sb = b % 1024, swz = sb ^ (((sb >> 9) & 1) << 5); R = (st >> 1) * 16 + swz / 64; C = (st & 1) * 32 + (swz % 64) / 2; }
__host__ __device__ __forceinline__ int perm32(int rho) { const int n = rho >> 4, i = rho & 15; return 8 * (i >> 2) + 4 * n + (i & 3); }

struct Unit { int pm, pn; };
struct Gemm { const bf16_t* A; const bf16_t* Bt; int M, N, K; };

struct StaticOrder {
    int nM, nN, nwg, G, c;
    __host__ __device__ void init(int M, int N, int G_, int c_) { nM = M / BM; nN = N / BM; nwg = nM * nN; G = G_; c = c_; }
    __host__ __device__ bool next(int i, Unit& u) const {
        const long L = (long)i * G + c; if (L >= nwg) return false;
        int wgid = (int)L; { const int q = nwg / NXCD, r = nwg % NXCD, xcd = wgid % NXCD, off = wgid / NXCD; wgid = (xcd < r ? xcd * (q + 1) : r * (q + 1) + (xcd - r) * q) + off; }
        const int nig = WGM * nN, gid = wgid / nig, fm = gid * WGM, gsz = (nM - fm) < WGM ? (nM - fm) : WGM;
        u.pm = fm + ((wgid % nig) % gsz); u.pn = (wgid % nig) / gsz; return true;
    }
    __device__ __forceinline__ void a_ready(const Unit&) const {}
    __device__ __forceinline__ void done(const Unit&) const {}
};

__device__ __forceinline__ unsigned cvt_pk_bf16(float lo, float hi) { unsigned r; asm volatile("v_cvt_pk_bf16_f32 %0, %1, %2" : "=v"(r) : "v"(lo), "v"(hi)); return r; }

template <int ACT  > struct EpiStore {
    static constexpr bool PERM = true, AFTER_DRAIN = false;
    bf16_t* O; int ldc;
    __device__ __forceinline__ void operator()(const f32x4 (&acc)[2][2][4][2], const Unit& u, int wr, int wc, int fr, int fq) const {
        const int row0 = u.pm * BM + wr * 64 + fr;
        const int col0 = u.pn * BM + wc * 32 + 8 * fq;
#pragma unroll
        for (int ai = 0; ai < 2; ++ai)
#pragma unroll
            for (int m = 0; m < 4; ++m) { bf16_t* rowp = O + (size_t)(row0 + ai * HALF + m * 16) * ldc + col0;
#pragma unroll
                for (int bj = 0; bj < 2; ++bj) { f32x4 v0 = acc[ai][bj][m][0], v1 = acc[ai][bj][m][1];
                    if (ACT == 2) {
#pragma unroll
                        for (int e = 0; e < 4; ++e) { const float a = fmaxf(v0[e], 0.f), b = fmaxf(v1[e], 0.f); v0[e] = a * a; v1[e] = b * b; } }
                    u32x4 w; w.x = cvt_pk_bf16(v0[0], v0[1]); w.y = cvt_pk_bf16(v0[2], v0[3]); w.z = cvt_pk_bf16(v1[0], v1[1]); w.w = cvt_pk_bf16(v1[2], v1[3]);
                    *(u32x4*)(rowp + bj * HALF) = w; } }
    }
};

template <class Epi, class Sched, bool ALIGN_EPI = false, bool SP2 = false>
__device__ __forceinline__ void gemm_phase(PG8_LAS unsigned char* lds, const Gemm g, const Sched& S, const Epi& E) {
    int tid_ = threadIdx.x; asm volatile("" : "+v"(tid_));
    const int tid = tid_, wid = __builtin_amdgcn_readfirstlane(tid >> 6), lane = tid & 63, wr = wid >> 2, wc = wid & 3, fr = lane & 15, fq = lane >> 4;
    const int K = g.K, nt = K / BK;
    unsigned voffA[2], voffB[2];
#pragma unroll
    for (int i = 0; i < 2; ++i) { int R, C; stage_rc(tid * 16 + i * 8192, R, C); const int Rb = Epi::PERM ? ((R & ~31) + perm32(R & 31)) : R;
        voffA[i] = (unsigned)(R * K + C) * 2u; voffB[i] = (unsigned)(Rb * K + C) * 2u; }
    const size_t kstep = (size_t)(BK * 2);
    const size_t hstep = (size_t)HALF * K * 2;
    const size_t tstep = 2 * hstep;
    const unsigned ldsw = (unsigned)wid * 1024u;
    const int aoff = lds_byte(wr * 64 + fr, fq * 8), boff = lds_byte(wc * 32 + fr, fq * 8);
#define PG8_SA(b, h) (((b) * 2 + (h)) * HTB)
#define PG8_SB(b, h) ((4 + (b) * 2 + (h)) * HTB)
#define PG8_STAGE(bufoff, gbase, voff) do { _Pragma("unroll") for (int _i = 0; _i < 2; ++_i) \
        __builtin_amdgcn_global_load_lds((const unsigned*)((const char*)(gbase) + (voff)[_i]), (PG8_LAS unsigned*)(lds + (bufoff) + ldsw + _i * 8192), 16, 0, 0); } while (0)
#define PG8_LDA(dst, b, h) do { _Pragma("unroll") for (int m = 0; m < 4; ++m) _Pragma("unroll") for (int k = 0; k < 2; ++k) dst[m][k] = *(const PG8_LAS bf16x8*)(lds + PG8_SA(b, h) + aoff + m * 2048 + k * 1024); } while (0)
#define PG8_LDB(dst, b, h) do { _Pragma("unroll") for (int n = 0; n < 2; ++n) _Pragma("unroll") for (int k = 0; k < 2; ++k) dst[n][k] = *(const PG8_LAS bf16x8*)(lds + PG8_SB(b, h) + boff + n * 2048 + k * 1024); } while (0)
#define PG8_MMA(ai, bj, At, Bt) do { __builtin_amdgcn_s_setprio(1); _Pragma("unroll") for (int m = 0; m < 4; ++m) _Pragma("unroll") for (int n = 0; n < 2; ++n) _Pragma("unroll") for (int k = 0; k < 2; ++k) \
        acc[ai][bj][m][n] = __builtin_amdgcn_mfma_f32_16x16x32_bf16(Bt[n][k], At[m][k], acc[ai][bj][m][n], 0, 0, 0); __builtin_amdgcn_s_setprio(0); } while (0)
#define PG8_WAIT_V(n) asm volatile("s_waitcnt vmcnt(" #n ")" ::: "memory")
#define PG8_WAIT_L(n) asm volatile("s_waitcnt lgkmcnt(" #n ")" ::: "memory")
#define PG8_BAR __builtin_amdgcn_s_barrier()
#define PG8_SCHED __builtin_amdgcn_sched_barrier(0)
    Unit cur, nxt; int ui = 0;
    if (!S.next(0, cur)) return;
    f32x4 acc[2][2][4][2];
#pragma unroll
    for (int a = 0; a < 2; ++a)
#pragma unroll
        for (int b = 0; b < 2; ++b)
#pragma unroll
            for (int m = 0; m < 4; ++m)
#pragma unroll
                for (int n = 0; n < 2; ++n) acc[a][b][m][n] = (f32x4){0.f, 0.f, 0.f, 0.f};
    bf16x8 At[4][2], B0[2][2], B1[2][2];
    const char* cA = (const char*)g.A + (size_t)cur.pm * tstep; const char* cB = (const char*)g.Bt + (size_t)cur.pn * tstep;
    S.a_ready(cur);
    if constexpr (SP2) {
        PG8_STAGE(PG8_SB(0, 0), cB, voffB); PG8_STAGE(PG8_SB(0, 1), cB + hstep, voffB); PG8_STAGE(PG8_SA(0, 0), cA, voffA); PG8_STAGE(PG8_SA(0, 1), cA + hstep, voffA);
        if (wr == 1) PG8_BAR;
        PG8_WAIT_V(2); PG8_BAR;
        PG8_STAGE(PG8_SB(1, 0), cB + kstep, voffB); PG8_STAGE(PG8_SA(1, 0), cA + kstep, voffA); PG8_STAGE(PG8_SB(1, 1), cB + hstep + kstep, voffB);
        PG8_WAIT_V(6); PG8_BAR;
    } else {
        PG8_STAGE(PG8_SB(0, 0), cB, voffB); PG8_STAGE(PG8_SA(0, 0), cA, voffA); PG8_STAGE(PG8_SB(0, 1), cB + hstep, voffB); PG8_STAGE(PG8_SA(0, 1), cA + hstep, voffA);
        if (wr == 1) PG8_BAR;
        PG8_WAIT_V(4); PG8_BAR;
        PG8_STAGE(PG8_SB(1, 0), cB + kstep, voffB); PG8_STAGE(PG8_SA(1, 0), cA + kstep, voffA); PG8_STAGE(PG8_SB(1, 1), cB + hstep + kstep, voffB);
        PG8_WAIT_V(6); PG8_BAR;
    }
    for (;;) {
        const bool has_next = S.next(ui + 1, nxt);
        const char* nA = has_next ? (const char*)g.A + (size_t)nxt.pm * tstep : cA; const char* nB = has_next ? (const char*)g.Bt + (size_t)nxt.pn * tstep : cB;
        for (int t = 0; t < nt; t += 2) {
            const bool last = (t == nt - 2);
            const char* a1 = cA + (size_t)(t + 1) * kstep;
            const char* a2 = last ? nA : cA + (size_t)(t + 2) * kstep; const char* b2 = last ? nB : cB + (size_t)(t + 2) * kstep;
            const char* a3 = a2 + kstep; const char* b3 = b2 + kstep;
            if (last && has_next) S.a_ready(nxt);
            if constexpr (SP2) {
            PG8_LDB(B0, 0, 0); PG8_LDB(B1, 0, 1); PG8_SCHED; PG8_LDA(At, 0, 0); PG8_STAGE(PG8_SA(1, 1), a1 + hstep, voffA);
            PG8_WAIT_V(8); PG8_WAIT_L(0); PG8_BAR; PG8_MMA(0, 0, At, B0); PG8_MMA(0, 1, At, B1); PG8_BAR; PG8_SCHED;
            PG8_LDA(At, 0, 1); PG8_STAGE(PG8_SB(0, 0), b2, voffB); PG8_STAGE(PG8_SB(0, 1), b2 + hstep, voffB); PG8_STAGE(PG8_SA(0, 0), a2, voffA);
            PG8_WAIT_V(8); PG8_WAIT_L(0); PG8_BAR; PG8_MMA(1, 0, At, B0); PG8_MMA(1, 1, At, B1); PG8_BAR; PG8_SCHED;
            PG8_LDB(B0, 1, 0); PG8_LDB(B1, 1, 1); PG8_SCHED; PG8_LDA(At, 1, 0); PG8_STAGE(PG8_SA(0, 1), a2 + hstep, voffA);
            PG8_WAIT_V(8); PG8_WAIT_L(0); PG8_BAR; PG8_MMA(0, 0, At, B0); PG8_MMA(0, 1, At, B1); PG8_BAR; PG8_SCHED;
            PG8_LDA(At, 1, 1); PG8_STAGE(PG8_SB(1, 0), b3, voffB); PG8_STAGE(PG8_SB(1, 1), b3 + hstep, voffB); PG8_STAGE(PG8_SA(1, 0), a3, voffA);
            PG8_WAIT_V(8); PG8_WAIT_L(0); PG8_BAR; PG8_MMA(1, 0, At, B0); PG8_MMA(1, 1, At, B1); PG8_BAR; PG8_SCHED;
            } else {
            PG8_LDB(B0, 0, 0); PG8_SCHED; PG8_LDA(At, 0, 0); PG8_STAGE(PG8_SA(1, 1), a1 + hstep, voffA);
            PG8_WAIT_L(8); PG8_BAR; PG8_WAIT_L(0); PG8_MMA(0, 0, At, B0); PG8_BAR; PG8_SCHED;
            PG8_LDB(B1, 0, 1); PG8_STAGE(PG8_SB(0, 0), b2, voffB);
            PG8_BAR; PG8_WAIT_L(0); PG8_MMA(0, 1, At, B1); PG8_BAR;
            PG8_LDA(At, 0, 1); PG8_STAGE(PG8_SA(0, 0), a2, voffA);
            PG8_BAR; PG8_WAIT_L(0); PG8_MMA(1, 0, At, B0); PG8_BAR; PG8_SCHED;
            PG8_STAGE(PG8_SB(0, 1), b2 + hstep, voffB);
            PG8_WAIT_V(6); PG8_BAR; PG8_MMA(1, 1, At, B1); PG8_BAR;
            PG8_LDB(B0, 1, 0); PG8_SCHED; PG8_LDA(At, 1, 0); PG8_STAGE(PG8_SA(0, 1), a2 + hstep, voffA);
            PG8_WAIT_L(8); PG8_BAR; PG8_WAIT_L(0); PG8_MMA(0, 0, At, B0); PG8_BAR; PG8_SCHED;
            PG8_LDB(B1, 1, 1); PG8_STAGE(PG8_SB(1, 0), b3, voffB);
            PG8_BAR; PG8_WAIT_L(0); PG8_MMA(0, 1, At, B1); PG8_BAR;
            PG8_LDA(At, 1, 1); PG8_STAGE(PG8_SA(1, 0), a3, voffA);
            PG8_BAR; PG8_WAIT_L(0); PG8_MMA(1, 0, At, B0); PG8_BAR; PG8_SCHED;
            PG8_STAGE(PG8_SB(1, 1), b3 + hstep, voffB);
            PG8_WAIT_V(6); PG8_BAR; PG8_MMA(1, 1, At, B1); PG8_BAR;
            }
        }
        if constexpr (ALIGN_EPI) { if (wr == 0) PG8_BAR; }
        if constexpr (!Epi::AFTER_DRAIN) { E(acc, cur, wr, wc, fr, fq); S.done(cur); }
        if (!has_next) break;
#pragma unroll
        for (int a = 0; a < 2; ++a)
#pragma unroll
            for (int b = 0; b < 2; ++b)
#pragma unroll
                for (int m = 0; m < 4; ++m)
#pragma unroll
                    for (int n = 0; n < 2; ++n) acc[a][b][m][n] = (f32x4){0.f, 0.f, 0.f, 0.f};
        cur = nxt; cA = nA; cB = nB; ++ui;
        if constexpr (ALIGN_EPI) { if (wr == 1) PG8_BAR; }
    }
    PG8_WAIT_V(0);
    if constexpr (!ALIGN_EPI) { if (wr == 0) PG8_BAR; }
    PG8_BAR;
#undef PG8_SA
#undef PG8_SB
#undef PG8_STAGE
#undef PG8_LDA
#undef PG8_LDB
#undef PG8_MMA
#undef PG8_WAIT_V
#undef PG8_WAIT_L
#undef PG8_BAR
#undef PG8_SCHED
}
}

constexpr int NWAVES = 8;
constexpr int BATCH = 32, S = 2048, D = 1024, DEPTH = 4, FF = 4096;
constexpr int M = BATCH * S;
constexpr int NP = 2304;
constexpr int DIN = 2108;
constexpr int C_QA = 0, C_CKV = 256, C_QIDX = 384, C_QB = 512, C_KCMP = 1024, C_VCMP = 1152, C_KSLC = 1280, C_VSLC = 1408, C_KWIN = 1536, C_VWIN = 1664,
              C_UC = 1792, C_KIDX = 2048, C_WIDX = 2080, C_GATE = 2084, C_KA = 2112, C_VA = 2176;
constexpr int NC = 127;
constexpr float EPS = 1e-6f;
constexpr float NEGF = -1e30f;

__host__ __device__ __forceinline__ int win_src(int n) {
    if (n < 512) return n;
    if (n < 1024) return 548 + (n - 512);
    if (n < 1792) return 1060 + (n - 1024);
    if (n < 2048) return 1852 + (n - 1792);
    if (n < 2080) return 512 + (n - 2048);
    if (n < 2084) return 544 + (n - 2080);
    if (n < 2108) return 1828 + (n - 2084);
    return -1;
}

constexpr size_t MiB = 1u << 20;
constexpr size_t WS_CTL = 0, CTL_ZERO_BYTES = 1 * MiB;
constexpr size_t WS_W = 2 * MiB;
constexpr size_t W_IN_B = (size_t)NP * D * 2, W_OUT_B = (size_t)D * D * 2, W_UP_B = (size_t)FF * D * 2, W_DN_B = (size_t)D * FF * 2;
constexpr size_t W_LAYER_B = W_IN_B + W_OUT_B + W_UP_B + W_DN_B;
constexpr size_t WS_ROPE = 96 * MiB;
constexpr size_t WS_WCT = 102 * MiB;
constexpr size_t WS_CB = 104 * MiB;
constexpr size_t WS_KCB = 124 * MiB, WS_VCB = 125 * MiB;
constexpr size_t WS_KA = 108 * MiB;
constexpr size_t WS_H = 128 * MiB;
constexpr size_t WS_F = 256 * MiB;
constexpr size_t WS_PROJ = 384 * MiB;
constexpr size_t WS_MIX = 672 * MiB;
constexpr size_t WS_MASK = 800 * MiB;
constexpr size_t WS_HID = 384 * MiB;
constexpr size_t WS_XB = 896 * MiB;
constexpr size_t WS_END = 1024 * MiB;
static_assert(WS_W + DEPTH * W_LAYER_B <= WS_ROPE, "weights");
static_assert(WS_ROPE + (size_t)M * 24 * 4 <= WS_WCT && WS_WCT + (size_t)DEPTH * 2 * 128 * 1024 * 2 <= WS_CB, "map");
static_assert(WS_PROJ + (size_t)M * NP * 2 <= WS_MIX && WS_MIX + (size_t)M * D * 2 <= WS_END && WS_HID + (size_t)M * FF * 2 <= WS_END, "map2");

constexpr int CW_BAR = 4096;
constexpr int RING_BYTES = 131072;
constexpr int LDSCTL_OFF = RING_BYTES, MISC_OFF = LDSCTL_OFF + 320;
constexpr int LDS_BYTES = 147456;
constexpr int WSCR = 16384;

#define GAS __attribute__((address_space(1)))
#define LAS __attribute__((address_space(3)))
typedef unsigned short bf16;
typedef unsigned v4u __attribute__((ext_vector_type(4)));
typedef float f32x4 __attribute__((ext_vector_type(4)));
typedef GAS unsigned gu32;
#define LDS_FENCE() asm volatile("s_waitcnt lgkmcnt(0)" ::: "memory")
__device__ __forceinline__ unsigned f2bf(float f) { unsigned u = __builtin_bit_cast(unsigned, f); return (u + 0x7fffu + ((u >> 16) & 1u)) >> 16; }
__device__ __forceinline__ unsigned pk2(float lo, float hi) { return f2bf(lo) | (f2bf(hi) << 16); }
__device__ __forceinline__ float bf2f(bf16 u) { return __builtin_bit_cast(float, (unsigned)u << 16); }
__device__ __forceinline__ float bflo(unsigned u) { return __builtin_bit_cast(float, u << 16); }
__device__ __forceinline__ float bfhi(unsigned u) { return __builtin_bit_cast(float, u & 0xffff0000u); }

#define XB_TMO      128
#define XB_XCNT(j)  (256  + 64 * (j))
#define XB_XSUB(j)  (1280 + 64 * (j))
#define XB_XGEN(j)  (2304 + 64 * (j))
#define XB_TOP      3328
#define XB_TOPGEN   3392
#define XCD_BAR_WORDS 3456
#define XB_SPIN_CAP (1u << 22)

__device__ __forceinline__ unsigned xb_ld(unsigned* p)              { return __hip_atomic_load(p, __ATOMIC_RELAXED, __HIP_MEMORY_SCOPE_AGENT); }
__device__ __forceinline__ unsigned xb_add(unsigned* p, unsigned v) { return __hip_atomic_fetch_add(p, v, __ATOMIC_RELAXED, __HIP_MEMORY_SCOPE_AGENT); }
__device__ __forceinline__ unsigned xb_xcc_id() { return (unsigned)__builtin_amdgcn_s_getreg((3 << 11) | 20) & 0xFu; }
#define XB_SPIN(cond, bar) do { unsigned _sp = 0; while (cond) { __builtin_amdgcn_s_sleep(1); \
    if ((++_sp & 255u) == 0u) { if (xb_ld(&(bar)[XB_TMO])) break; if (_sp > XB_SPIN_CAP) { atomicAdd(&(bar)[XB_TMO], 1u); break; } } } } while (0)

struct XcdBarrier { unsigned* bar; unsigned x; volatile LAS unsigned* st; };

__device__ __forceinline__ XcdBarrier xcd_barrier_post(unsigned* bar, volatile LAS unsigned* st) {
    XcdBarrier b; b.bar = bar; b.x = xb_xcc_id(); b.st = st;
    if (threadIdx.x == 0) (void)xb_add(&bar[XB_XCNT(b.x)], 1u);
    return b;
}
__device__ __forceinline__ void xcd_barrier_complete(unsigned* bar, unsigned x, unsigned& nloc, unsigned& nx) {
    const unsigned G = gridDim.x * gridDim.y * gridDim.z;
    unsigned sum, cnt, mine, sp = 0u;
    for (;;) {
        sum = 0u; cnt = 0u; mine = 0u;
#pragma unroll
        for (unsigned j = 0; j < 16; ++j) { const unsigned c = xb_ld(&bar[XB_XCNT(j)]); sum += c; cnt += (c > 0u) ? 1u : 0u; mine = (j == x) ? c : mine; }
        if (sum == G) break;
        __builtin_amdgcn_s_sleep(1);
        if ((++sp & 255u) == 0u) { if (xb_ld(&bar[XB_TMO])) break; if (sp > XB_SPIN_CAP) { atomicAdd(&bar[XB_TMO], 1u); break; } }
    }
    nloc = mine > 0u ? mine : 1u; nx = cnt > 0u ? cnt : 1u;
}
__device__ __forceinline__ void xcd_barrier(const XcdBarrier& b) {
    asm volatile("s_waitcnt vmcnt(0)" ::: "memory");
    __syncthreads();
    if (threadIdx.x == 0) {
        unsigned* bar = b.bar; asm volatile("" : "+s"(bar));
        __builtin_amdgcn_s_waitcnt(0);
        unsigned nloc = b.st[0], nx = b.st[1];
        if (nloc == 0u) { xcd_barrier_complete(bar, b.x, nloc, nx); b.st[0] = nloc; b.st[1] = nx; }
        const unsigned old = xb_add(&bar[XB_XSUB(b.x)], 1u);
        const unsigned gen = old / nloc;
        if (old + 1u == (gen + 1u) * nloc) {
            __builtin_amdgcn_fence(__ATOMIC_RELEASE, "agent");
            asm volatile("s_waitcnt vmcnt(0)" ::: "memory");
            const unsigned og = xb_add(&bar[XB_TOP], 1u);
            const unsigned tg = og / nx;
            if (og + 1u == (tg + 1u) * nx) xb_add(&bar[XB_TOPGEN], 1u);
            else XB_SPIN(xb_ld(&bar[XB_TOPGEN]) == tg, bar);
            __builtin_amdgcn_fence(__ATOMIC_ACQUIRE, "agent");
            xb_add(&bar[XB_XGEN(b.x)], 1u);
            asm volatile("s_waitcnt vmcnt(0)" ::: "memory");
        } else {
            XB_SPIN(xb_ld(&bar[XB_XGEN(b.x)]) == gen, bar);
            __builtin_amdgcn_fence(__ATOMIC_ACQUIRE, "agent");
            asm volatile("s_waitcnt vmcnt(0)" ::: "memory");
        }
    }
    __syncthreads();
}

struct Frame {
    LAS unsigned char* lds;
    volatile LAS unsigned* MISC;
    gu32* ctl;
    int tid, lane, wave, vcu, G;
    float* out; unsigned char* ws;
};
struct Args { const void* in[20]; float* out; unsigned char* ws; int ph_lo, ph_hi, use_bar, pad; };
#define IN_F(k) ((const float*)args.in[k])
#define P_X_IN IN_F(0)
#define P_POS ((const int*)args.in[1])
#define P_W_IN IN_F(2)
#define P_G_KV_A IN_F(3)
#define P_W_KV_UP IN_F(4)
#define P_W_CMP_K IN_F(5)
#define P_W_CMP_V IN_F(6)
#define P_PE_K IN_F(7)
#define P_PE_V IN_F(8)
#define P_W_POOL IN_F(9)
#define P_POOL_SCALE IN_F(10)
#define P_G_OUT_A IN_F(11)
#define P_G_OUT_B IN_F(12)
#define P_W_OUT IN_F(13)
#define P_G_PRE_MIX IN_F(14)
#define P_G_POST_MIX IN_F(15)
#define P_G_PRE_MLP IN_F(16)
#define P_G_POST_MLP IN_F(17)
#define P_W_UP IN_F(18)
#define P_W_DOWN IN_F(19)
#define B_ROPE ((float*)(ws_ + WS_ROPE))
#define B_H ((bf16*)(ws_ + WS_H))
#define B_F ((bf16*)(ws_ + WS_F))
#define B_PROJ ((bf16*)(ws_ + WS_PROJ))
#define B_MIX ((bf16*)(ws_ + WS_MIX))
#define B_HID ((bf16*)(ws_ + WS_HID))

__device__ __forceinline__ float wave_sum(float v) {
#pragma unroll
    for (int o = 1; o < 64; o <<= 1) v += __shfl_xor(v, o);
    return v;
}
__device__ __forceinline__ float wave_max(float v) {
#pragma unroll
    for (int o = 1; o < 64; o <<= 1) v = fmaxf(v, __shfl_xor(v, o));
    return v;
}
__device__ __forceinline__ int wave_sum_i(int v) {
#pragma unroll
    for (int o = 1; o < 64; o <<= 1) v += __shfl_xor(v, o);
    return v;
}

__constant__ double c_rope_inv[12] = {1.0, 0.19392274474868576, 0.03760603093086393, 0.007292664737217109, 0.001414213562373095, 0.0002742481756762073, 5.318295896944988e-05, 1.031338537721246e-05,
                                       1.0, 0.03760603093086393, 0.001414213562373095, 5.318295896944988e-05};
template <int MODE>
__device__ __forceinline__ void transpose_item(const float* W, int K, int Nsrc, int nblk, bf16* WT, LAS float* scr, int item, int lane) {
    const int kb = item / nblk, nb = item % nblk, k0 = 64 * kb, n0 = 32 * nb;
    if (MODE && n0 >= C_KA && n0 < C_KA + 128) return;
    const int np = n0 + (lane & 31);
    const int src = MODE ? win_src(np) : np;
#pragma unroll 8
    for (int i = 0; i < 32; ++i) { const int kk = 2 * i + (lane >> 5); scr[kk * 33 + (lane & 31)] = (src >= 0) ? W[(size_t)(k0 + kk) * Nsrc + src] : 0.f; }
    LDS_FENCE();
    const int c = lane & 7;
#pragma unroll
    for (int j = 0; j < 4; ++j) { const int n = (lane >> 3) + 8 * j; const LAS float* s = scr + (8 * c) * 33 + n;
        v4u o; o.x = pk2(s[0 * 33], s[1 * 33]); o.y = pk2(s[2 * 33], s[3 * 33]); o.z = pk2(s[4 * 33], s[5 * 33]); o.w = pk2(s[6 * 33], s[7 * 33]);
        *(v4u*)(WT + (size_t)(n0 + n) * K + k0 + 8 * c) = o; }
    LDS_FENCE();
}

__device__ __forceinline__ bf16* w_in_t(unsigned char* ws_, int l)  { return (bf16*)(ws_ + WS_W + (size_t)l * W_LAYER_B); }
__device__ __forceinline__ bf16* w_out_t(unsigned char* ws_, int l) { return (bf16*)(ws_ + WS_W + (size_t)l * W_LAYER_B + W_IN_B); }
__device__ __forceinline__ bf16* w_up_t(unsigned char* ws_, int l)  { return (bf16*)(ws_ + WS_W + (size_t)l * W_LAYER_B + W_IN_B + W_OUT_B); }
__device__ __forceinline__ bf16* w_dn_t(unsigned char* ws_, int l)  { return (bf16*)(ws_ + WS_W + (size_t)l * W_LAYER_B + W_IN_B + W_OUT_B + W_UP_B); }

__device__ __forceinline__ void norm_row_to_bf16(const float* xrow, const float* gain, bf16* orow, int lane) {
    const f32x4* xr = (const f32x4*)xrow + lane;
    f32x4 v[4]; float s = 0.f;
#pragma unroll
    for (int j = 0; j < 4; ++j) { v[j] = xr[64 * j]; s += (v[j].x * v[j].x + v[j].y * v[j].y) + (v[j].z * v[j].z + v[j].w * v[j].w); }
    const float rs = rsqrtf(wave_sum(s) * (1.f / D) + EPS);
    unsigned long long* o8 = (unsigned long long*)orow + lane;
#pragma unroll
    for (int j = 0; j < 4; ++j) { const f32x4 g = ((const f32x4*)gain)[lane + 64 * j];
        o8[64 * j] = (unsigned long long)pk2(v[j].x * rs * g.x, v[j].y * rs * g.y) | ((unsigned long long)pk2(v[j].z * rs * g.z, v[j].w * rs * g.w) << 32); }
}

__device__ __forceinline__ void phase_prologue(Frame& F, const Args& args) {
    unsigned char* ws_ = F.ws; asm volatile("" : "+s"(ws_)); int lane_ = F.lane; asm volatile("" : "+v"(lane_)); (void)ws_;
    LAS float* scr = (LAS float*)(F.lds + F.wave * WSCR);
    const int gw = F.vcu * NWAVES + F.wave, NGW = F.G * NWAVES;
    constexpr int I_IN = (D / 64) * (NP / 32), I_OUT = (D / 64) * (D / 32), I_UP = (D / 64) * (FF / 32), I_DN = (FF / 64) * (D / 32);
    for (int it = gw; it < DEPTH * I_IN; it += NGW) { const int l = it / I_IN, r = it % I_IN; transpose_item<1>(P_W_IN + (size_t)l * D * DIN, D, DIN, NP / 32, w_in_t(ws_, l), scr, r, lane_); }
    for (int it = gw; it < DEPTH * I_OUT; it += NGW) { const int l = it / I_OUT, r = it % I_OUT; transpose_item<0>(P_W_OUT + (size_t)l * D * D, D, D, D / 32, w_out_t(ws_, l), scr, r, lane_); }
    for (int it = gw; it < DEPTH * I_UP; it += NGW) { const int l = it / I_UP, r = it % I_UP; transpose_item<0>(P_W_UP + (size_t)l * D * FF, D, FF, FF / 32, w_up_t(ws_, l), scr, r, lane_); }
    for (int it = gw; it < DEPTH * I_DN; it += NGW) { const int l = it / I_DN, r = it % I_DN; transpose_item<0>(P_W_DOWN + (size_t)l * FF * D, FF, D, D / 32, w_dn_t(ws_, l), scr, r, lane_); }
    for (int it = gw; it < DEPTH * D * 2; it += NGW) {
        const int l = it / (D * 2), r = it % (D * 2), k = r >> 1, n = lane_ + 64 * (r & 1);
        const float* wi = P_W_IN + ((size_t)l * D + k) * DIN + 256; const float* gk = P_G_KV_A + l * 128; const float* wu = P_W_KV_UP + (size_t)l * 128 * 128 + n;
        float acc = 0.f;
#pragma unroll 8
        for (int j = 0; j < 128; ++j) acc += (wi[j] * gk[j]) * wu[j * 128];
        w_in_t(ws_, l)[(size_t)(C_KA + n) * D + k] = (bf16)f2bf(acc);
    }
    for (int it = gw; it < DEPTH * 2 * 2 * 32; it += NGW) {
        const int lk = it >> 6, part = (it >> 5) & 1, r = it & 31, l = lk >> 1, kv = lk & 1;
        const float* W = (kv ? P_W_CMP_V : P_W_CMP_K) + (size_t)l * 32 * 64 * 64 + (size_t)part * 1024 * 64;
        transpose_item<0>(W, 1024, 64, 2, (bf16*)(ws_ + WS_WCT) + ((size_t)lk * 128 + part * 64) * 1024, scr, r, lane_);
    }
    for (int it = gw; it < DEPTH * 2; it += NGW) {
        const int l = it >> 1, kv = it & 1;
        const float* W = (kv ? P_W_CMP_V : P_W_CMP_K) + (size_t)l * 32 * 64 * 64 + lane_; const float* pe = (kv ? P_PE_V : P_PE_K) + l * 32 * 64;
        float acc = 0.f;
        for (int k = 0; k < 2048; ++k) acc += pe[k] * W[(size_t)k * 64];
        ((float*)(ws_ + WS_CB))[it * 64 + lane_] = acc;
    }
    for (int e = gw * 64 + lane_; e < M * 12; e += NGW * 64) {
        const int row = e / 12, i = e % 12;
        const double inv = c_rope_inv[i];
        const double a = (double)P_POS[row] * inv;
        const double k = __builtin_rint(a * 0.15915494309189535);
        const float r = (float)(a - k * 6.283185307179586);
        const float c = __builtin_cosf(r), s = __builtin_sinf(r);
        float* t = B_ROPE + (size_t)row * 24;
        if (i < 8) { t[i] = c; t[8 + i] = s; } else { t[16 + (i - 8)] = c; t[20 + (i - 8)] = s; }
    }
    for (int m = gw; m < M; m += NGW) norm_row_to_bf16(P_X_IN + (size_t)m * D, P_G_PRE_MIX, B_H + (size_t)m * D, lane_);
}

typedef short bf16x8 __attribute__((ext_vector_type(8)));
typedef short s16x4 __attribute__((ext_vector_type(4)));
typedef float f32x16 __attribute__((ext_vector_type(16)));
#define MFMA32(a, b, c) __builtin_amdgcn_mfma_f32_32x32x16_bf16((a), (b), (c), 0, 0, 0)
__device__ __forceinline__ int crow(int r, int hi) { return (r & 3) + 8 * (r >> 2) + 4 * hi; }
__device__ __forceinline__ void wg_barrier() { asm volatile("s_waitcnt lgkmcnt(0)\n\ts_barrier" ::: "memory"); }

__device__ __forceinline__ void phase_prep(Frame& F, const Args& args, int l) {
    unsigned char* ws_ = F.ws; asm volatile("" : "+s"(ws_)); int lane_ = F.lane; asm volatile("" : "+v"(lane_)); (void)ws_; (void)args;
    int tid_ = F.tid; asm volatile("" : "+v"(tid_));
    const int gw = F.vcu * NWAVES + F.wave, NGW = F.G * NWAVES, lane = lane_;
    for (int row = gw; row < M; row += NGW) {
        bf16* prow = B_PROJ + (size_t)row * NP;
        const float* tab = B_ROPE + (size_t)row * 24;
        const unsigned u = *(const unsigned*)(prow + C_CKV + 2 * lane);
        const float x0 = bflo(u), x1 = bfhi(u);
        const float rs = rsqrtf(wave_sum(x0 * x0 + x1 * x1) * (1.f / 128.f) + EPS);
        const unsigned v = *(const unsigned*)(prow + C_KA + 2 * lane);
        float y0 = bflo(v) * rs, y1 = bfhi(v) * rs;
        {
            const float p0 = __shfl_xor(y0, 4), p1 = __shfl_xor(y1, 4);
            const int i0 = (2 * lane) & 7;
            const float c0 = tab[i0], s0 = tab[8 + i0], c1 = tab[i0 + 1], s1 = tab[8 + i0 + 1];
            if (lane < 4) { y0 = y0 * c0 - p0 * s0; y1 = y1 * c1 - p1 * s1; }
            else if (lane < 8) { y0 = p0 * s0 + y0 * c0; y1 = p1 * s1 + y1 * c1; }
        }
        *(unsigned*)(prow + C_KA + 2 * lane) = pk2(y0, y1);
        if (lane >= 8 && lane < 12) { const int i = lane - 8; const float c = tab[16 + i], s = tab[20 + i];
            const float x1v = bf2f(prow[C_KIDX + i]), x2v = bf2f(prow[C_KIDX + 4 + i]);
            prow[C_KIDX + i] = (bf16)f2bf(x1v * c - x2v * s); prow[C_KIDX + 4 + i] = (bf16)f2bf(x1v * s + x2v * c);
        } else if (lane >= 16 && lane < 48) { const int idx = lane - 16, which = idx >> 3, i = idx & 7; const int base = ((which < 2) ? C_KSLC : C_KWIN) + (which & 1) * 64;
            const float c = tab[i], s = tab[8 + i];
            const float x1v = bf2f(prow[base + i]), x2v = bf2f(prow[base + 8 + i]);
            prow[base + i] = (bf16)f2bf(x1v * c - x2v * s); prow[base + 8 + i] = (bf16)f2bf(x1v * s + x2v * c);
        }
    }
    {
        const int wid = F.wave, r32 = lane & 31, hi = lane >> 5;
        LAS float* P = (LAS float*)F.lds;
        for (int u = F.vcu; u < BATCH * 8; u += F.G) {
            const int b = u >> 3, g = (u >> 2) & 1, kv = (u >> 1) & 1, eh = u & 1;
            const int rt = wid >> 1, part = wid & 1;
            const bf16* ap = B_PROJ + ((size_t)b * S + 16 * (32 * rt + r32)) * NP + (kv ? C_VCMP : C_KCMP) + g * 64 + 8 * hi;
            const bf16* bp = (const bf16*)(ws_ + WS_WCT) + ((size_t)(l * 2 + kv) * 128 + part * 64 + eh * 32 + r32) * 1024 + 8 * hi;
            f32x16 acc = {};
#pragma unroll 8
            for (int ks = 0; ks < 64; ++ks) {
                const bf16x8 a = *(const bf16x8*)(ap + (size_t)(ks >> 2) * NP + 16 * (ks & 3));
                const bf16x8 bq = *(const bf16x8*)(bp + 16 * ks);
                acc = MFMA32(a, bq, acc);
            }
#pragma unroll
            for (int r = 0; r < 16; ++r) P[(part * 128 + 32 * rt + crow(r, hi)) * 32 + r32] = acc[r];
            wg_barrier();
            const float* cb = (const float*)(ws_ + WS_CB) + (l * 2 + kv) * 64 + eh * 32;
            bf16* ob = (bf16*)(ws_ + (kv ? WS_VCB : WS_KCB)) + (size_t)(b * 2 + g) * 128 * 64 + eh * 32;
            for (int idx = tid_; idx < 128 * 32; idx += 512) { const int c = idx >> 5, e = idx & 31;
                const float v = (c < NC) ? (P[c * 32 + e] + P[(128 + c + 1) * 32 + e] + cb[e]) : 0.f;
                ob[c * 64 + e] = (bf16)f2bf(v); }
            wg_barrier();
        }
    }
}

typedef float f32x2_t __attribute__((ext_vector_type(2))); typedef __bf16 bf16x2_t __attribute__((ext_vector_type(2)));
__device__ __forceinline__ unsigned cvtpk(float lo, float hi) { const f32x2_t v = {lo, hi}; const bf16x2_t b = __builtin_convertvector(v, bf16x2_t); return __builtin_bit_cast(unsigned, b); }
constexpr float C2 = 0.125f * 1.4426950408889634f;

__device__ __forceinline__ unsigned idxmask(int x, int hi) {
    unsigned m = 0u;
#pragma unroll
    for (int g = 0; g < 4; ++g) { int n = x - (8 * g + 4 * hi); n = n < 0 ? 0 : (n > 4 ? 4 : n); m |= ((1u << n) - 1u) << (4 * g); }
    return m;
}

constexpr int SEL_QF = 0, SEL_PART = 16384, SEL_HIST = 20480, SEL_HP = 260, SEL_RES = SEL_HIST + 32 * SEL_HP * 4;
__device__ __forceinline__ void dsa_select_unit(unsigned char* ws_, int tid_, int b, int qt32, LAS unsigned char* lds) {
    asm volatile("" : "+v"(tid_)); asm volatile("" : "+s"(ws_));
    const int lane = tid_ & 63, wid = __builtin_amdgcn_readfirstlane(tid_ >> 6), r32 = lane & 31, hi = lane >> 5;
    unsigned* maskbuf = (unsigned*)(ws_ + WS_MASK);
    if (qt32 < 8) {
        for (int i = tid_; i < 2048; i += 512) { const int qq = i >> 6, blk = i & 63; const int t = 32 * qt32 + qq; const int d = t - 32 * blk;
            const unsigned w = d < 0 ? 0u : (d >= 31 ? 0xffffffffu : ((2u << d) - 1u));
            maskbuf[((size_t)b * S + t) * 64 + blk] = w; }
        return;
    }
    const size_t qrow = (size_t)b * S + 32 * qt32 + r32;
    const bf16* prow = B_PROJ + qrow * NP;
    {
        const int h = wid >> 1, sk = wid & 1;
        const v4u raw = *(const v4u*)(prow + C_QIDX + h * 32 + 16 * sk + 8 * hi);
        float x[8] = {bflo(raw.x), bfhi(raw.x), bflo(raw.y), bfhi(raw.y), bflo(raw.z), bfhi(raw.z), bflo(raw.w), bfhi(raw.w)};
        if (sk == 0 && hi == 0) { const float* tab = B_ROPE + qrow * 24;
#pragma unroll
            for (int i = 0; i < 4; ++i) { const float c = tab[16 + i], sn = tab[20 + i]; const float x1 = x[i], x2 = x[4 + i]; x[i] = x1 * c - x2 * sn; x[4 + i] = x1 * sn + x2 * c; } }
        v4u hp, lp;
        { unsigned hh[4], ll[4];
#pragma unroll
          for (int k = 0; k < 4; ++k) { const float a = x[2 * k], bb = x[2 * k + 1]; const unsigned ha = f2bf(a), hb = f2bf(bb); hh[k] = ha | (hb << 16);
              ll[k] = pk2(a - bf2f((bf16)ha), bb - bf2f((bf16)hb)); }
          hp = (v4u){hh[0], hh[1], hh[2], hh[3]}; lp = (v4u){ll[0], ll[1], ll[2], ll[3]}; }
        LAS v4u* qf = (LAS v4u*)(lds + SEL_QF);
        qf[((h * 2 + sk) * 2 + 0) * 64 + lane] = hp; qf[((h * 2 + sk) * 2 + 1) * 64 + lane] = lp;
    }
    float w[4];
#pragma unroll
    for (int h = 0; h < 4; ++h) w[h] = bf2f(prow[C_WIDX + h]);
    __syncthreads();
    const int nblk = qt32 + 1;
    const bf16* kbase = B_PROJ + (size_t)b * S * NP + C_KIDX;
    unsigned key[8][16];
#pragma unroll
    for (int i = 0; i < 8; ++i) {
        const int blk = wid + 8 * i;
        if (blk < nblk) {
            const bf16* kp = kbase + (size_t)(32 * blk + r32) * NP + 8 * hi;
            const bf16x8 kf0 = *(const bf16x8*)kp, kf1 = *(const bf16x8*)(kp + 16);
            float sc[16];
            const LAS bf16x8* qf = (const LAS bf16x8*)(lds + SEL_QF);
#pragma unroll
            for (int h = 0; h < 4; ++h) {
                f32x16 acc = {};
                acc = MFMA32(kf0, qf[((h * 2 + 0) * 2 + 0) * 64 + lane], acc);
                acc = MFMA32(kf1, qf[((h * 2 + 1) * 2 + 0) * 64 + lane], acc);
                acc = MFMA32(kf0, qf[((h * 2 + 0) * 2 + 1) * 64 + lane], acc);
                acc = MFMA32(kf1, qf[((h * 2 + 1) * 2 + 1) * 64 + lane], acc);
#pragma unroll
                for (int r = 0; r < 16; ++r) sc[r] = (h == 0) ? w[0] * fmaxf(acc[r], 0.f) : fmaf(w[h], fmaxf(acc[r], 0.f), sc[r]);
            }
#pragma unroll
            for (int r = 0; r < 16; ++r) {
                unsigned bits = __builtin_bit_cast(unsigned, sc[r]);
                if (bits == 0x80000000u) bits = 0u;
                unsigned k = (bits & 0x80000000u) ? ~bits : (bits | 0x80000000u);
                if (blk == qt32 && crow(r, hi) > r32) k = 0u;
                key[i][r] = k;
            }
        } else {
#pragma unroll
            for (int r = 0; r < 16; ++r) key[i][r] = 0u;
        }
    }
    LAS unsigned* part = (LAS unsigned*)(lds + SEL_PART);
    int pbi = 0;
#define SEL_REDUCE(cnt_, tot_) do { LAS unsigned* pb_ = part + (pbi & 1) * 512; ++pbi; pb_[wid * 64 + lane] = (cnt_); wg_barrier(); unsigned t_ = 0u; \
        _Pragma("unroll") for (int w8 = 0; w8 < 8; ++w8) t_ += pb_[w8 * 64 + r32] + pb_[w8 * 64 + 32 + r32]; (tot_) = t_; } while (0)
    LAS unsigned* hist = (LAS unsigned*)(lds + SEL_HIST);
    LAS unsigned* resd = (LAS unsigned*)(lds + SEL_RES);
    for (int i = tid_; i < 32 * SEL_HP / 4; i += 512) ((LAS v4u*)hist)[i] = (v4u){0u, 0u, 0u, 0u};
    wg_barrier();
    unsigned pfx = 0u, need = 256u;
    LAS unsigned* hrow = hist + r32 * SEL_HP;
#pragma unroll 1
    for (int pass = 0; pass < 4; ++pass) {
        const int shift = 24 - 8 * pass;
#pragma unroll
        for (int i = 0; i < 8; ++i) if (wid + 8 * i < nblk) {
#pragma unroll
            for (int r = 0; r < 16; ++r) {
                const unsigned k = key[i][r];
                const unsigned dg = (k >> shift) & 255u;
                const bool match = (pass == 0) || ((k >> (shift + 8)) == pfx);
                __hip_atomic_fetch_add(hrow + (match ? dg : 256u), 1u, __ATOMIC_RELAXED, __HIP_MEMORY_SCOPE_WORKGROUP);
            } }
        wg_barrier();
#pragma unroll 1
        for (int qq = 0; qq < 4; ++qq) {
            const int q = 4 * wid + qq;
            LAS v4u* hq = (LAS v4u*)(hist + q * SEL_HP) + lane;
            const v4u h4 = *hq;
            unsigned T = (h4.x + h4.y) + (h4.z + h4.w);
#pragma unroll
            for (int off = 1; off < 64; off <<= 1) { const unsigned t_ = (unsigned)__shfl_down((int)T, off); if (lane + off < 64) T += t_; }
            const unsigned needq = (pass == 0) ? 256u : resd[32 + q];
            const unsigned long long bal = __ballot(T >= needq);
            const int Ls = 63 - __builtin_clzll(bal | 1ull);
            const unsigned above = (unsigned)__shfl((int)T, (Ls + 1) & 63);
            if (lane == Ls) {
                const unsigned ab0 = (Ls < 63) ? above : 0u;
                const unsigned rem = needq - ab0; const unsigned c3 = h4.w, c2 = c3 + h4.z, c1 = c2 + h4.y;
                int d; unsigned ab;
                if (rem <= c3) { d = 3; ab = 0u; } else if (rem <= c2) { d = 2; ab = c3; } else if (rem <= c1) { d = 1; ab = c2; } else { d = 0; ab = c1; }
                resd[q] = (unsigned)(4 * Ls + d); resd[32 + q] = rem - ab;
            }
            *hq = (v4u){0u, 0u, 0u, 0u};
            if (lane == 0) hist[q * SEL_HP + 256] = 0u;
        }
        wg_barrier();
        pfx = (pfx << 8) | resd[r32]; need = resd[32 + r32];
    }
    const unsigned thr = pfx;
    unsigned gtm[8], eqm[8];
#pragma unroll
    for (int i = 0; i < 8; ++i) { unsigned g = 0u, e = 0u;
        if (wid + 8 * i < nblk) {
#pragma unroll
            for (int r = 0; r < 16; ++r) { g |= (key[i][r] > thr) ? (1u << r) : 0u; e |= (key[i][r] == thr) ? (1u << r) : 0u; } }
        gtm[i] = g; eqm[i] = e; }
    const unsigned rneed = need;
    unsigned Y = 0u;
    for (int bit = 10; bit >= 0; --bit) {
        const unsigned c = Y | (1u << bit);
        unsigned cnt = 0u;
#pragma unroll
        for (int i = 0; i < 8; ++i) cnt += __builtin_popcount(eqm[i] & idxmask((int)c - 32 * (wid + 8 * i), hi));
        unsigned tot; SEL_REDUCE(cnt, tot);
        if (tot < rneed) Y = c;
    }
#undef SEL_REDUCE
#pragma unroll
    for (int i = 0; i < 8; ++i) {
        const int blk = wid + 8 * i;
        const unsigned selm = gtm[i] | (eqm[i] & idxmask((int)Y + 1 - 32 * blk, hi));
        unsigned word = ((selm & 0xFu) | ((selm & 0xF0u) << 4) | ((selm & 0xF00u) << 8) | ((selm & 0xF000u) << 12)) << (4 * hi);
        word |= (unsigned)__shfl_xor((int)word, 32);
        if (hi == 0) maskbuf[qrow * 64 + blk] = word;
    }
    __syncthreads();
}

constexpr int AT_K = 0, AT_V = 24576, AT_WS = 49152;
__device__ __forceinline__ void qkt(f32x16& p0, f32x16& p1, const LAS unsigned char* Kslot, const bf16x8* qr, const f32x16& negm, int r32, int hi) {
    const LAS unsigned char* kb = Kslot + hi * 1024 + r32 * 16;
#pragma unroll
    for (int d0 = 0; d0 < 4; ++d0) {
        const bf16x8 b0 = *(const LAS bf16x8*)(kb + d0 * 2048);
        const bf16x8 b1 = *(const LAS bf16x8*)(kb + d0 * 2048 + 512);
        if (d0 == 0) { p0 = MFMA32(b0, qr[0], negm); p1 = MFMA32(b1, qr[0], negm); }
        else { p0 = MFMA32(b0, qr[d0], p0); p1 = MFMA32(b1, qr[d0], p1); }
    }
}
__device__ __forceinline__ void pv(f32x16* o, unsigned vb, bf16x8 pa0, bf16x8 pa1, bf16x8 pa2, bf16x8 pa3) {
#pragma unroll
    for (int d0 = 0; d0 < 2; ++d0) { s16x4 lo0, lo1, lo2, lo3, hi0, hi1, hi2, hi3;
        asm volatile("ds_read_b64_tr_b16 %0,%8 offset:%c9\n\tds_read_b64_tr_b16 %1,%8 offset:%c10\n\tds_read_b64_tr_b16 %2,%8 offset:%c11\n\tds_read_b64_tr_b16 %3,%8 offset:%c12\n\t"
                     "ds_read_b64_tr_b16 %4,%8 offset:%c13\n\tds_read_b64_tr_b16 %5,%8 offset:%c14\n\tds_read_b64_tr_b16 %6,%8 offset:%c15\n\tds_read_b64_tr_b16 %7,%8 offset:%c16\n\t"
                     "s_waitcnt lgkmcnt(0)"
                     : "=&v"(lo0), "=&v"(hi0), "=&v"(lo1), "=&v"(hi1), "=&v"(lo2), "=&v"(hi2), "=&v"(lo3), "=&v"(hi3)
                     : "v"(vb), "i"(d0 * 4096 + 0), "i"(d0 * 4096 + 512), "i"(d0 * 4096 + 1024), "i"(d0 * 4096 + 1536), "i"(d0 * 4096 + 2048), "i"(d0 * 4096 + 2560), "i"(d0 * 4096 + 3072), "i"(d0 * 4096 + 3584)
                     : "memory");
#define PKV(l_, h_) (bf16x8){l_[0], l_[1], l_[2], l_[3], h_[0], h_[1], h_[2], h_[3]}
        o[d0] = MFMA32(pa0, PKV(lo0, hi0), o[d0]);
        o[d0] = MFMA32(pa1, PKV(lo1, hi1), o[d0]);
        o[d0] = MFMA32(pa2, PKV(lo2, hi2), o[d0]);
        o[d0] = MFMA32(pa3, PKV(lo3, hi3), o[d0]);
#undef PKV
    }
}
struct SmState { float mhat, l; f32x16 o[2]; f32x16 negm; };
__device__ __forceinline__ float rowmax32(const f32x16& p0, const f32x16& p1) {
    float a = fmaxf(p0[0], p1[0]);
#pragma unroll
    for (int r = 1; r < 16; ++r) a = fmaxf(a, fmaxf(p0[r], p1[r]));
    return fmaxf(a, __shfl_xor(a, 32));
}
__device__ __forceinline__ void sm_rescale(SmState& st, f32x16& p0, f32x16& p1, bool first, LAS float* wsf, int r32, int hi) {
    const float rm = rowmax32(p0, p1);
    if (first || __any(rm > 8.f)) {
        const float dl = first ? rm : fmaxf(rm, 0.f);
        st.mhat += dl;
#pragma unroll
        for (int r = 0; r < 16; ++r) { p0[r] -= dl; p1[r] -= dl; st.negm[r] = -st.mhat; }
        if (!first) {
            const float f = __builtin_amdgcn_exp2f(-dl); st.l *= f; if (hi == 0) wsf[r32] = f;
            asm volatile("s_waitcnt lgkmcnt(0)" ::: "memory");
#pragma unroll
            for (int d_ = 0; d_ < 2; ++d_)
#pragma unroll
                for (int r = 0; r < 16; ++r) st.o[d_][r] *= wsf[crow(r, hi)];
            asm volatile("s_waitcnt lgkmcnt(0)" ::: "memory");
        }
    }
}

__device__ __forceinline__ void dsa_attn_unit(unsigned char* ws_, int tid_, int b, int qt, LAS unsigned char* lds) {
    asm volatile("" : "+v"(tid_)); asm volatile("" : "+s"(ws_));
    const int lane = tid_ & 63, wid = __builtin_amdgcn_readfirstlane(tid_ >> 6), r32 = lane & 31, hi = lane >> 5;
    const int h = wid >> 1, qh = wid & 1;
    const size_t qrow = (size_t)b * S + 64 * qt + 32 * qh + r32;
    LAS float* wsf = (LAS float*)(lds + AT_WS) + wid * 64;
    bf16x8 qr[4];
    {
        const bf16* qp = B_PROJ + qrow * NP + C_QA + h * 64 + 8 * hi;
        const float* tab = B_ROPE + qrow * 24;
#pragma unroll
        for (int d0 = 0; d0 < 4; ++d0) {
            const v4u raw = *(const v4u*)(qp + 16 * d0);
            float x[8] = {bflo(raw.x), bfhi(raw.x), bflo(raw.y), bfhi(raw.y), bflo(raw.z), bfhi(raw.z), bflo(raw.w), bfhi(raw.w)};
            if (d0 == 0) {
#pragma unroll
                for (int j = 0; j < 8; ++j) { const float other = __shfl_xor(x[j], 32); const float c = tab[j], sn = tab[8 + j];
                    x[j] = (hi == 0) ? (x[j] * c - other * sn) : (other * sn + x[j] * c); }
            }
            v4u pk; pk.x = cvtpk(x[0] * C2, x[1] * C2); pk.y = cvtpk(x[2] * C2, x[3] * C2); pk.z = cvtpk(x[4] * C2, x[5] * C2); pk.w = cvtpk(x[6] * C2, x[7] * C2);
            qr[d0] = __builtin_bit_cast(bf16x8, pk);
        }
    }
    const bf16* KAb = B_PROJ + (size_t)b * S * NP;
    const bf16* ksrc = KAb + (size_t)lane * NP + C_KA + wid * 8;
    const bf16* vsrc = KAb + (size_t)(16 * (wid & 3) + (lane >> 2)) * NP + C_VA + (wid >> 2) * 32 + (lane & 3) * 8;
#define AT_DMA(t, slot) do { \
        __builtin_amdgcn_global_load_lds((const unsigned*)(ksrc + (size_t)(t) * 64 * NP), (LAS unsigned*)(lds + AT_K + (slot) * 8192 + wid * 1024), 16, 0, 0); \
        __builtin_amdgcn_global_load_lds((const unsigned*)(vsrc + (size_t)(t) * 64 * NP), (LAS unsigned*)(lds + AT_V + (slot) * 8192 + wid * 1024), 16, 0, 0); } while (0)
    const unsigned vb0 = (unsigned)(uintptr_t)(lds + AT_V) + ((lane >> 4) & 1) * 32 + (lane & 3) * 8 + (4 * hi + ((lane & 15) >> 2)) * 64;
    const int NT = qt + 1;
    SmState st; st.mhat = 0.f; st.l = 0.f; st.o[0] = f32x16{}; st.o[1] = f32x16{}; st.negm = f32x16{};
    const unsigned long long* mrow = (const unsigned long long*)((const unsigned*)(ws_ + WS_MASK) + qrow * 64);
    AT_DMA(0, 0);
    unsigned long long m0 = mrow[0], m1 = 0ull, m2 = 0ull;
    if (NT > 1) { AT_DMA(1, 1); m1 = mrow[1]; }
    int cs = 0, is = 2;
    for (int t = 0; t < NT; ++t) {
        if (t + 1 < NT) asm volatile("s_waitcnt vmcnt(3)" ::: "memory"); else asm volatile("s_waitcnt vmcnt(0)" ::: "memory");
        wg_barrier();
        if (t + 2 < NT) { AT_DMA(t + 2, is); m2 = mrow[t + 2]; }
        const unsigned long long mcur = m0;
        m0 = m1; m1 = m2;
        const int csl = cs; cs = (cs == 2) ? 0 : cs + 1; is = (is == 2) ? 0 : is + 1;
        f32x16 p0, p1;
        qkt(p0, p1, lds + AT_K + csl * 8192, qr, st.negm, r32, hi);
        sm_rescale(st, p0, p1, t == 0, wsf, r32, hi);
        const unsigned wx = (unsigned)mcur >> (4 * hi), wy = (unsigned)(mcur >> 32) >> (4 * hi);
        float sacc = 0.f;
#pragma unroll
        for (int r = 0; r < 16; ++r) {
            const int c = (r & 3) + 8 * (r >> 2);
            const unsigned k0 = (unsigned)__builtin_amdgcn_sbfe((int)wx, c, 1), k1 = (unsigned)__builtin_amdgcn_sbfe((int)wy, c, 1);
            const float e0 = __builtin_bit_cast(float, __builtin_bit_cast(unsigned, __builtin_amdgcn_exp2f(p0[r])) & k0);
            const float e1 = __builtin_bit_cast(float, __builtin_bit_cast(unsigned, __builtin_amdgcn_exp2f(p1[r])) & k1);
            p0[r] = e0; p1[r] = e1; sacc += e0 + e1;
        }
        st.l += sacc;
        v4u pw0 = {cvtpk(p0[0], p0[1]), cvtpk(p0[2], p0[3]), cvtpk(p0[4], p0[5]), cvtpk(p0[6], p0[7])};
        v4u pw1 = {cvtpk(p0[8], p0[9]), cvtpk(p0[10], p0[11]), cvtpk(p0[12], p0[13]), cvtpk(p0[14], p0[15])};
        v4u pw2 = {cvtpk(p1[0], p1[1]), cvtpk(p1[2], p1[3]), cvtpk(p1[4], p1[5]), cvtpk(p1[6], p1[7])};
        v4u pw3 = {cvtpk(p1[8], p1[9]), cvtpk(p1[10], p1[11]), cvtpk(p1[12], p1[13]), cvtpk(p1[14], p1[15])};
        pv(st.o, vb0 + csl * 8192, __builtin_bit_cast(bf16x8, pw0), __builtin_bit_cast(bf16x8, pw1), __builtin_bit_cast(bf16x8, pw2), __builtin_bit_cast(bf16x8, pw3));
    }
#undef AT_DMA
    {
        const float lt = st.l + __shfl_xor(st.l, 32);
        if (hi == 0) wsf[r32] = 1.f / lt;
        asm volatile("s_waitcnt lgkmcnt(0)" ::: "memory");
        bf16* ob = B_MIX + ((size_t)b * S + 64 * qt + 32 * qh) * D + h * 64 + r32;
#pragma unroll
        for (int r = 0; r < 16; ++r) { const int rq = crow(r, hi); const float f = wsf[rq];
            ob[(size_t)rq * D] = (bf16)f2bf(st.o[0][r] * f); ob[(size_t)rq * D + 32] = (bf16)f2bf(st.o[1][r] * f); }
    }
    __syncthreads();
}


constexpr int NS_QF = 51200, NS_SELS = 83968, NS_SSUM = 116736, NS_SELM = 124928;
__device__ __forceinline__ unsigned long long mask_range(int lo, int up) {
    const int l2 = lo < 0 ? 0 : lo, u2 = up > 63 ? 63 : up;
    const unsigned long long hm = (u2 >= 63) ? ~0ull : ((2ull << (u2 & 63)) - 1ull);
    const unsigned long long lm = (1ull << (l2 & 63)) - 1ull;
    return (up < 0 || lo > 63 || u2 < l2) ? 0ull : (hm & ~lm);
}
__device__ __forceinline__ void load_q(bf16x8* qr, const bf16* qp, const float* tab, bool rope, int hi) {
#pragma unroll
    for (int d0 = 0; d0 < 4; ++d0) {
        const v4u raw = *(const v4u*)(qp + 16 * d0);
        float x[8] = {bflo(raw.x), bfhi(raw.x), bflo(raw.y), bfhi(raw.y), bflo(raw.z), bfhi(raw.z), bflo(raw.w), bfhi(raw.w)};
        if (d0 == 0) {
#pragma unroll
            for (int j = 0; j < 8; ++j) { const float other = __shfl_xor(x[j], 32); const float c = tab[j], sn = tab[8 + j];
                const float rot = (hi == 0) ? (x[j] * c - other * sn) : (other * sn + x[j] * c); x[j] = rope ? rot : x[j]; }
        }
        v4u pk; pk.x = cvtpk(x[0] * C2, x[1] * C2); pk.y = cvtpk(x[2] * C2, x[3] * C2); pk.z = cvtpk(x[4] * C2, x[5] * C2); pk.w = cvtpk(x[6] * C2, x[7] * C2);
        qr[d0] = __builtin_bit_cast(bf16x8, pk);
    }
}
__device__ __forceinline__ void qkt_lq(f32x16& p0, f32x16& p1, const LAS unsigned char* Kslot, const LAS bf16x8* qf, int lane, int r32, int hi) {
    const LAS unsigned char* kb = Kslot + hi * 1024 + r32 * 16;
    p0 = f32x16{}; p1 = f32x16{};
#pragma unroll
    for (int d0 = 0; d0 < 4; ++d0) {
        const bf16x8 b0 = *(const LAS bf16x8*)(kb + d0 * 2048);
        const bf16x8 b1 = *(const LAS bf16x8*)(kb + d0 * 2048 + 512);
        const bf16x8 q = qf[d0 * 64 + lane];
        p0 = MFMA32(b0, q, p0); p1 = MFMA32(b1, q, p1);
    }
}
template <bool SEL>
__device__ __forceinline__ void tile_step(SmState& st, f32x16& osel, const LAS unsigned char* Kslot, unsigned vb, const LAS bf16x8* qf, unsigned long long mcur, bool first, LAS float* wsf, int lane, int r32, int hi, int ctile) {
    f32x16 p0, p1;
    qkt_lq(p0, p1, Kslot, qf, lane, r32, hi);
    {
        const float rm = rowmax32(p0, p1) - st.mhat;
        if (first || __any(rm > 8.f)) {
            const float dl = first ? rm : fmaxf(rm, 0.f);
            st.mhat += dl;
            if (!first) {
                const float f = __builtin_amdgcn_exp2f(-dl); st.l *= f; if (hi == 0) wsf[r32] = f;
                asm volatile("s_waitcnt lgkmcnt(0)" ::: "memory");
#pragma unroll
                for (int r = 0; r < 16; ++r) { const float ff = wsf[crow(r, hi)]; st.o[0][r] *= ff; st.o[1][r] *= ff; if (SEL) osel[r] *= ff; }
                asm volatile("s_waitcnt lgkmcnt(0)" ::: "memory");
            }
        }
    }
    const unsigned wx = (unsigned)mcur >> (4 * hi), wy = (unsigned)(mcur >> 32) >> (4 * hi);
    float sacc = 0.f;
    const float mh = st.mhat;
#pragma unroll
    for (int r = 0; r < 16; ++r) {
        const int c = (r & 3) + 8 * (r >> 2);
        const unsigned k0 = (unsigned)__builtin_amdgcn_sbfe((int)wx, c, 1), k1 = (unsigned)__builtin_amdgcn_sbfe((int)wy, c, 1);
        const float e0 = __builtin_bit_cast(float, __builtin_bit_cast(unsigned, __builtin_amdgcn_exp2f(p0[r] - mh)) & k0);
        const float e1 = __builtin_bit_cast(float, __builtin_bit_cast(unsigned, __builtin_amdgcn_exp2f(p1[r] - mh)) & k1);
        p0[r] = e0; p1[r] = e1; sacc += e0 + e1;
    }
    st.l += sacc;
    unsigned pw[16];
#pragma unroll
    for (int k = 0; k < 8; ++k) { pw[k] = cvtpk(p0[2 * k], p0[2 * k + 1]); pw[8 + k] = cvtpk(p1[2 * k], p1[2 * k + 1]); }
    pv(st.o, vb, __builtin_bit_cast(bf16x8, (v4u){pw[0], pw[1], pw[2], pw[3]}), __builtin_bit_cast(bf16x8, (v4u){pw[4], pw[5], pw[6], pw[7]}),
       __builtin_bit_cast(bf16x8, (v4u){pw[8], pw[9], pw[10], pw[11]}), __builtin_bit_cast(bf16x8, (v4u){pw[12], pw[13], pw[14], pw[15]}));
    if (SEL) {
        unsigned pl[16];
#pragma unroll
        for (int k = 0; k < 8; ++k) {
            pl[k] = cvtpk(p0[2 * k] - bflo(pw[k]), p0[2 * k + 1] - bfhi(pw[k]));
            pl[8 + k] = cvtpk(p1[2 * k] - bflo(pw[8 + k]), p1[2 * k + 1] - bfhi(pw[8 + k]));
        }
#pragma unroll
        for (int ks = 0; ks < 4; ++ks) {
            unsigned ov[4];
#pragma unroll
            for (int k = 0; k < 4; ++k) {
                const int j0 = 2 * k, j1 = 2 * k + 1;
                const int c0 = 64 * ctile + 16 * ks + 8 * (j0 >> 2) + 4 * hi + (j0 & 3), c1 = 64 * ctile + 16 * ks + 8 * (j1 >> 2) + 4 * hi + (j1 & 3);
                const unsigned a = (c0 >= 4 * r32 - 1 && c0 <= 4 * r32 + 3) ? 0x3F80u : 0u, bq = (c1 >= 4 * r32 - 1 && c1 <= 4 * r32 + 3) ? 0x3F80u : 0u;
                ov[k] = a | (bq << 16);
            }
            const bf16x8 ovf = __builtin_bit_cast(bf16x8, (v4u){ov[0], ov[1], ov[2], ov[3]});
            osel = MFMA32(__builtin_bit_cast(bf16x8, (v4u){pw[4 * ks], pw[4 * ks + 1], pw[4 * ks + 2], pw[4 * ks + 3]}), ovf, osel);
            osel = MFMA32(__builtin_bit_cast(bf16x8, (v4u){pl[4 * ks], pl[4 * ks + 1], pl[4 * ks + 2], pl[4 * ks + 3]}), ovf, osel);
        }
    }
}
__device__ __forceinline__ void sm_reset(SmState& st) { st.mhat = 0.f; st.l = 0.f; st.o[0] = f32x16{}; st.o[1] = f32x16{}; st.negm = f32x16{}; }
__device__ __forceinline__ float sigmoidf_(float x) { return 1.f / (1.f + __expf(-x)); }

template <bool SEL>
__device__ __forceinline__ void nsa_unit(unsigned char* ws_, int tid_, int b, int g, int qt, LAS unsigned char* lds) {
    asm volatile("" : "+v"(tid_)); asm volatile("" : "+s"(ws_));
    const int lane = tid_ & 63, wid = __builtin_amdgcn_readfirstlane(tid_ >> 6), r32 = lane & 31, hi = lane >> 5;
    const int hr = wid >> 1, qh = wid & 1, H = 4 * g + hr;
    const int tq = 64 * qt + 32 * qh + r32;
    const size_t qrow = (size_t)b * S + tq;
    LAS float* wsf = (LAS float*)(lds + AT_WS) + wid * 64;
    const bf16* prow = B_PROJ + qrow * NP;
    const float* tab = B_ROPE + qrow * 24;
    const bf16* qp = prow + C_QB + H * 64 + 8 * hi;
    const unsigned vb0 = (unsigned)(uintptr_t)(lds + AT_V) + ((lane >> 4) & 1) * 32 + (lane & 3) * 8 + (4 * hi + ((lane & 15) >> 2)) * 64;
    const bf16* kcb = (const bf16*)(ws_ + WS_KCB) + (size_t)(b * 2 + g) * 128 * 64;
    const bf16* vcb = (const bf16*)(ws_ + WS_VCB) + (size_t)(b * 2 + g) * 128 * 64;
    const bf16* pb = B_PROJ + (size_t)b * S * NP + g * 64;
    const int vrow = 16 * (wid & 3) + (lane >> 2), vcol = (wid >> 2) * 32 + (lane & 3) * 8;
#define NS_DMA(kp_, vp_, slot_) do { \
        __builtin_amdgcn_global_load_lds((const unsigned*)(kp_), (LAS unsigned*)(lds + AT_K + (slot_) * 8192 + wid * 1024), 16, 0, 0); \
        __builtin_amdgcn_global_load_lds((const unsigned*)(vp_), (LAS unsigned*)(lds + AT_V + (slot_) * 8192 + wid * 1024), 16, 0, 0); } while (0)
#define NS_DMA_CMP(i_, slot_) NS_DMA(kcb + (size_t)(64 * (i_) + lane) * 64 + wid * 8, vcb + (size_t)(64 * (i_) + vrow) * 64 + vcol, slot_)
#define NS_DMA_PROJ(ck_, cv_, j_, slot_) NS_DMA(pb + (size_t)(64 * (j_) + lane) * NP + (ck_) + wid * 8, pb + (size_t)(64 * (j_) + vrow) * NP + (cv_) + vcol, slot_)
    const int ncmp = (qt >= 16) ? 2 : 1;
    const int jw0 = (qt > 8) ? qt - 8 : 0, nwin = qt - jw0 + 1;
    const float g0 = sigmoidf_(bf2f(prow[C_GATE + H * 3 + 0])), g1 = sigmoidf_(bf2f(prow[C_GATE + H * 3 + 1])), g2 = sigmoidf_(bf2f(prow[C_GATE + H * 3 + 2]));
    int nissued = 0, islot = 0, ti = 0, cslot = 0;
    unsigned remI = SEL ? 0u : ((2u << qt) - 1u);
#define NS_ISSUE() do { \
        if (nissued < ncmp) { NS_DMA_CMP(nissued, islot); } \
        else if (nissued < ncmp + nwin) { NS_DMA_PROJ(C_KWIN, C_VWIN, jw0 + nissued - ncmp, islot); } \
        else if (remI) { const int j_ = __builtin_ctz(remI); remI &= remI - 1u; NS_DMA_PROJ(C_KSLC, C_VSLC, j_, islot); } \
        else break; \
        ++nissued; islot = (islot == 2) ? 0 : islot + 1; } while (0)
#define NS_TOP() do { if (nissued > ti + 1) asm volatile("s_waitcnt vmcnt(2)" ::: "memory"); else asm volatile("s_waitcnt vmcnt(0)" ::: "memory"); wg_barrier(); NS_ISSUE(); } while (0)
#define NS_ADV() do { ++ti; cslot = (cslot == 2) ? 0 : cslot + 1; } while (0)
    NS_ISSUE(); NS_ISSUE();
    LAS bf16x8* qf = (LAS bf16x8*)(lds + NS_QF) + wid * 256;
    { bf16x8 qr[4]; load_q(qr, qp, tab, false, hi);
#pragma unroll
      for (int d0 = 0; d0 < 4; ++d0) qf[d0 * 64 + lane] = qr[d0]; }
    SmState st; sm_reset(st);
    f32x16 osel = {};
    f32x16 oacc[2];
    const int ncv = (tq >= 31) ? (((tq - 31) >> 4) + 1) : 0;
    for (int i = 0; i < ncmp; ++i) {
        NS_TOP();
        const unsigned long long m = mask_range(0, ncv - 64 * i - 1);
        tile_step<SEL>(st, osel, lds + AT_K + cslot * 8192, vb0 + cslot * 8192, qf, m, i == 0, wsf, lane, r32, hi, i);
        NS_ADV();
    }
    {
        const float lt = st.l + __shfl_xor(st.l, 32);
        const float inv = lt > 0.f ? 1.f / lt : 0.f;
        if (hi == 0) { wsf[r32] = inv; wsf[32 + r32] = inv * g0; }
        asm volatile("s_waitcnt lgkmcnt(0)" ::: "memory");
        LAS float* sels = (LAS float*)(lds + NS_SELS);
#pragma unroll
        for (int r = 0; r < 16; ++r) { const int rq = crow(r, hi); const float f2 = wsf[32 + rq];
            oacc[0][r] = st.o[0][r] * f2; oacc[1][r] = st.o[1][r] * f2;
            if (SEL) sels[(hr * 64 + 32 * qh + rq) * 32 + r32] = osel[r] * wsf[rq]; }
    }
    unsigned mysel, selunion;
    if (SEL) {
        wg_barrier();
        LAS float* sels = (LAS float*)(lds + NS_SELS);
        LAS float* ssum = (LAS float*)(lds + NS_SSUM);
        LAS unsigned* selm = (LAS unsigned*)(lds + NS_SELM);
        const int q = tid_ >> 3, jg = tid_ & 7;
        f32x4 s4 = *(const LAS f32x4*)(sels + (0 * 64 + q) * 32 + 4 * jg);
        s4 += *(const LAS f32x4*)(sels + (1 * 64 + q) * 32 + 4 * jg);
        s4 += *(const LAS f32x4*)(sels + (2 * 64 + q) * 32 + 4 * jg);
        s4 += *(const LAS f32x4*)(sels + (3 * 64 + q) * 32 + 4 * jg);
        *(LAS f32x4*)(ssum + q * 32 + 4 * jg) = s4;
        asm volatile("s_waitcnt lgkmcnt(0)" ::: "memory");
        float sv[32];
#pragma unroll
        for (int k = 0; k < 8; ++k) { const f32x4 v = *(const LAS f32x4*)(ssum + q * 32 + 4 * k); sv[4 * k] = v.x; sv[4 * k + 1] = v.y; sv[4 * k + 2] = v.z; sv[4 * k + 3] = v.w; }
        const float PINF = __builtin_inff();
#pragma unroll
        for (int i = 0; i < 32; ++i) sv[i] = (i > qt) ? -PINF : ((i == 0 || i == qt || i == qt - 1) ? PINF : sv[i]);
        unsigned bits4 = 0u;
#pragma unroll
        for (int jj = 0; jj < 4; ++jj) {
            const int j = 4 * jg + jj;
            float mine = (jj == 0) ? s4.x : (jj == 1) ? s4.y : (jj == 2) ? s4.z : s4.w;
            mine = (j > qt) ? -PINF : ((j == 0 || j == qt || j == qt - 1) ? PINF : mine);
            int rank = 0;
#pragma unroll
            for (int i = 0; i < 32; ++i) rank += ((sv[i] > mine) || (sv[i] == mine && i < j)) ? 1 : 0;
            bits4 |= (rank < 16) ? (1u << jj) : 0u;
        }
        unsigned mm = bits4 << (4 * jg);
        mm |= (unsigned)__shfl_xor((int)mm, 1); mm |= (unsigned)__shfl_xor((int)mm, 2); mm |= (unsigned)__shfl_xor((int)mm, 4);
        if (jg == 0) selm[q] = mm;
        wg_barrier();
        unsigned u = selm[lane];
#pragma unroll
        for (int o_ = 1; o_ < 64; o_ <<= 1) u |= (unsigned)__shfl_xor((int)u, o_);
        selunion = (unsigned)__builtin_amdgcn_readfirstlane((int)u);
        mysel = selm[32 * qh + r32];
    } else {
        mysel = selunion = (2u << qt) - 1u;
    }
    { bf16x8 qr[4]; load_q(qr, qp, tab, true, hi);
#pragma unroll
      for (int d0 = 0; d0 < 4; ++d0) qf[d0 * 64 + lane] = qr[d0]; }
    sm_reset(st);
    if (SEL) remI = selunion;
    for (int j = jw0; j <= qt; ++j) {
        NS_TOP();
        const unsigned long long m = mask_range(tq - 511 - 64 * j, tq - 64 * j);
        tile_step<false>(st, osel, lds + AT_K + cslot * 8192, vb0 + cslot * 8192, qf, m, j == jw0, wsf, lane, r32, hi, 0);
        NS_ADV();
    }
    {
        const float lt = st.l + __shfl_xor(st.l, 32);
        if (hi == 0) wsf[32 + r32] = lt > 0.f ? g2 / lt : 0.f;
        asm volatile("s_waitcnt lgkmcnt(0)" ::: "memory");
#pragma unroll
        for (int r = 0; r < 16; ++r) { const float f2 = wsf[32 + crow(r, hi)]; oacc[0][r] += st.o[0][r] * f2; oacc[1][r] += st.o[1][r] * f2; }
    }
    sm_reset(st);
    bool firstb = true;
    unsigned rem = selunion;
    while (rem) {
        const int j = __builtin_ctz(rem); rem &= rem - 1u;
        NS_TOP();
        const unsigned long long m = ((mysel >> j) & 1u) ? mask_range(0, tq - 64 * j) : 0ull;
        tile_step<false>(st, osel, lds + AT_K + cslot * 8192, vb0 + cslot * 8192, qf, m, firstb, wsf, lane, r32, hi, 0);
        firstb = false; NS_ADV();
    }
    {
        const float lt = st.l + __shfl_xor(st.l, 32);
        if (hi == 0) wsf[32 + r32] = lt > 0.f ? g1 / lt : 0.f;
        asm volatile("s_waitcnt lgkmcnt(0)" ::: "memory");
        bf16* ob = B_MIX + ((size_t)b * S + 64 * qt + 32 * qh) * D + 256 + H * 64 + r32;
#pragma unroll
        for (int r = 0; r < 16; ++r) { const int rq = crow(r, hi); const float f2 = wsf[32 + rq];
            ob[(size_t)rq * D] = (bf16)f2bf(oacc[0][r] + st.o[0][r] * f2); ob[(size_t)rq * D + 32] = (bf16)f2bf(oacc[1][r] + st.o[1][r] * f2); }
    }
    __syncthreads();
#undef NS_DMA
#undef NS_DMA_CMP
#undef NS_DMA_PROJ
#undef NS_ISSUE
#undef NS_TOP
#undef NS_ADV
}

__device__ __forceinline__ void phase_attn(Frame& F, int l) {
    (void)l;
    unsigned char* ws_ = F.ws; asm volatile("" : "+s"(ws_)); int lane_ = F.lane; asm volatile("" : "+v"(lane_)); (void)ws_;
    int tid_ = F.tid; asm volatile("" : "+v"(tid_));
    for (int u = F.vcu; u < BATCH * 64; u += F.G) {
        const int c = u & 255, i = u >> 8; const int b = c >> 3, sft = c & 7; const int base = 16 * (i >> 1); const int qt32 = (i & 1) ? base + 15 - sft : base + sft;
        dsa_select_unit(ws_, tid_, b, qt32, F.lds);
    }
    __syncthreads();
#if PROBE_MASK
    if (blockIdx.x == 0 && F.tid == 0) { const unsigned long long ts_ = __builtin_amdgcn_s_memrealtime(); F.MISC[16] = (unsigned)ts_; F.MISC[17] = (unsigned)(ts_ >> 32); }
#endif
    for (int u = F.vcu; u < BATCH * 64; u += F.G) {
        const int c = u & 255, i = u >> 8; const int b = c >> 3, sft = c & 7; const int g = i & 1, k = i >> 1; const int base = 16 * (k >> 1); const int qt = (k & 1) ? base + 15 - sft : base + sft;
        if (qt >= 16) nsa_unit<true>(ws_, tid_, b, g, qt, F.lds); else nsa_unit<false>(ws_, tid_, b, g, qt, F.lds);
    }
}
__device__ __forceinline__ void phase_dsa_attn(Frame& F) {
    unsigned char* ws_ = F.ws; asm volatile("" : "+s"(ws_));
    int tid_ = F.tid; asm volatile("" : "+v"(tid_));
    for (int u = F.vcu; u < BATCH * 32; u += F.G) {
        const int c = u & 255, i = u >> 8; const int b = c >> 3, sft = c & 7; const int base = 16 * (i >> 1); const int qt = (i & 1) ? base + 15 - sft : base + sft;
        dsa_attn_unit(ws_, tid_, b, qt, F.lds);
    }
}

constexpr int WP_PITCH = 72;
__device__ __forceinline__ void phase_merge(Frame& F, const Args& args, int l) {
    unsigned char* ws_ = F.ws; asm volatile("" : "+s"(ws_)); int lane_ = F.lane; asm volatile("" : "+v"(lane_)); (void)ws_;
    int tid_ = F.tid; asm volatile("" : "+v"(tid_));
    const int gw = F.vcu * NWAVES + F.wave, NGW = F.G * NWAVES, lane = lane_;
    const float* psc = P_POOL_SCALE + l * 256;
    const float* goa = P_G_OUT_A + l * 256; const float* gob = P_G_OUT_B + l * 512;
    LAS bf16* wp = (LAS bf16*)F.lds;
    {
        const float* wsrc = P_W_POOL + (size_t)l * 4 * 64 * 64;
        for (int idx = tid_; idx < 4 * 64 * 64; idx += 512) { const int g = idx >> 12, c = (idx >> 6) & 63, d = idx & 63; wp[(g * 64 + d) * WP_PITCH + c] = (bf16)f2bf(wsrc[idx]); }
    }
    for (int row = gw; row < M; row += NGW) {
        bf16* mrow = B_MIX + (size_t)row * D;
        { const unsigned long long u = *((const unsigned long long*)mrow + lane);
          const float a0 = bflo((unsigned)u), a1 = bfhi((unsigned)u), a2 = bflo((unsigned)(u >> 32)), a3 = bfhi((unsigned)(u >> 32));
          const float rs = rsqrtf(wave_sum((a0 * a0 + a1 * a1) + (a2 * a2 + a3 * a3)) * (1.f / 256.f) + EPS);
          const f32x4 gg = ((const f32x4*)goa)[lane];
          *((unsigned long long*)mrow + lane) = (unsigned long long)pk2(a0 * rs * gg.x, a1 * rs * gg.y) | ((unsigned long long)pk2(a2 * rs * gg.z, a3 * rs * gg.w) << 32); }
        { const v4u u = *((const v4u*)(mrow + 256) + lane);
          float a[8] = {bflo(u.x), bfhi(u.x), bflo(u.y), bfhi(u.y), bflo(u.z), bfhi(u.z), bflo(u.w), bfhi(u.w)};
          float ss = 0.f;
#pragma unroll
          for (int i = 0; i < 8; ++i) ss += a[i] * a[i];
          const float rs = rsqrtf(wave_sum(ss) * (1.f / 512.f) + EPS);
          const f32x4 g0 = ((const f32x4*)gob)[2 * lane], g1 = ((const f32x4*)gob)[2 * lane + 1];
          v4u o; o.x = pk2(a[0] * rs * g0.x, a[1] * rs * g0.y); o.y = pk2(a[2] * rs * g0.z, a[3] * rs * g0.w); o.z = pk2(a[4] * rs * g1.x, a[5] * rs * g1.y); o.w = pk2(a[6] * rs * g1.z, a[7] * rs * g1.w);
          *((v4u*)(mrow + 256) + lane) = o; }
    }
    __syncthreads();
    {
        const int r32 = lane & 31, hi = lane >> 5;
        for (int tile = gw; tile < M / 32; tile += NGW) {
            const int row = 32 * tile + r32, t = row % S;
            const bf16* up = B_PROJ + (size_t)row * NP + C_UC + 8 * hi;
            f32x16 acc[4][2];
#pragma unroll
            for (int g = 0; g < 4; ++g) {
                acc[g][0] = f32x16{}; acc[g][1] = f32x16{};
                const int w = 2 << g;
                const float icnt = 1.f / (float)((t + 1 < w) ? t + 1 : w);
#pragma unroll
                for (int ks = 0; ks < 4; ++ks) {
                    const bf16* p0 = up + g * 64 + 16 * ks;
                    const v4u u0 = *(const v4u*)p0;
                    float cur[8] = {bflo(u0.x), bfhi(u0.x), bflo(u0.y), bfhi(u0.y), bflo(u0.z), bfhi(u0.z), bflo(u0.w), bfhi(u0.w)};
                    float sum[8];
#pragma unroll
                    for (int j = 0; j < 8; ++j) sum[j] = cur[j];
#pragma unroll
                    for (int i = 1; i < w; ++i) {
                        if (t - i >= 0) { const v4u ui = *(const v4u*)(p0 - (size_t)i * NP);
                            sum[0] += bflo(ui.x); sum[1] += bfhi(ui.x); sum[2] += bflo(ui.y); sum[3] += bfhi(ui.y); sum[4] += bflo(ui.z); sum[5] += bfhi(ui.z); sum[6] += bflo(ui.w); sum[7] += bfhi(ui.w); }
                    }
                    v4u pk; pk.x = cvtpk(sum[0] * icnt - cur[0], sum[1] * icnt - cur[1]); pk.y = cvtpk(sum[2] * icnt - cur[2], sum[3] * icnt - cur[3]);
                    pk.z = cvtpk(sum[4] * icnt - cur[4], sum[5] * icnt - cur[5]); pk.w = cvtpk(sum[6] * icnt - cur[6], sum[7] * icnt - cur[7]);
                    const bf16x8 af = __builtin_bit_cast(bf16x8, pk);
#pragma unroll
                    for (int nb = 0; nb < 2; ++nb) {
                        const bf16x8 bfr = *(const LAS bf16x8*)(wp + (g * 64 + 32 * nb + r32) * WP_PITCH + 16 * ks + 8 * hi);
                        acc[g][nb] = MFMA32(af, bfr, acc[g][nb]);
                    }
                }
            }
            float ss[16];
#pragma unroll
            for (int r = 0; r < 16; ++r) { float a = 0.f;
#pragma unroll
                for (int g = 0; g < 4; ++g) a += acc[g][0][r] * acc[g][0][r] + acc[g][1][r] * acc[g][1][r];
#pragma unroll
                for (int o_ = 1; o_ < 32; o_ <<= 1) a += __shfl_xor(a, o_);
                ss[r] = rsqrtf(a * (1.f / 256.f) + EPS); }
            bf16* ob = B_MIX + (size_t)(32 * tile) * D + 768 + r32;
#pragma unroll
            for (int g = 0; g < 4; ++g)
#pragma unroll
                for (int nb = 0; nb < 2; ++nb) { const float sc = psc[g * 64 + 32 * nb + r32];
#pragma unroll
                    for (int r = 0; r < 16; ++r) ob[(size_t)crow(r, hi) * D + g * 64 + 32 * nb] = (bf16)f2bf(acc[g][nb][r] * ss[r] * sc); }
        }
    }
    __syncthreads();
}

template <bool XIN_F32, bool OUT_F32>
__device__ __forceinline__ void phase_finish(Frame& F, const float* xsrc, const float* gpost, const float* gnext  ) {
    unsigned char* ws_ = F.ws; asm volatile("" : "+s"(ws_)); int lane_ = F.lane; asm volatile("" : "+v"(lane_)); (void)ws_;
    const int gw = F.vcu * NWAVES + F.wave, NGW = F.G * NWAVES, lane = lane_;
    bf16* xb = (bf16*)(ws_ + WS_XB);
    for (int row = gw; row < M; row += NGW) {
        const unsigned long long* fr = (const unsigned long long*)(B_F + (size_t)row * D) + lane;
        f32x4 f[4], x[4]; float ss = 0.f;
#pragma unroll
        for (int j = 0; j < 4; ++j) { const unsigned long long u = fr[64 * j];
            if (XIN_F32) x[j] = ((const f32x4*)(xsrc + (size_t)row * D) + lane)[64 * j];
            else { const unsigned long long ux = ((const unsigned long long*)(xb + (size_t)row * D) + lane)[64 * j];
                   x[j] = (f32x4){bflo((unsigned)ux), bfhi((unsigned)ux), bflo((unsigned)(ux >> 32)), bfhi((unsigned)(ux >> 32))}; }
            f[j] = (f32x4){bflo((unsigned)u), bfhi((unsigned)u), bflo((unsigned)(u >> 32)), bfhi((unsigned)(u >> 32))};
            ss += (f[j].x * f[j].x + f[j].y * f[j].y) + (f[j].z * f[j].z + f[j].w * f[j].w); }
        const float rs = rsqrtf(wave_sum(ss) * (1.f / D) + EPS);
        float s2 = 0.f;
#pragma unroll
        for (int j = 0; j < 4; ++j) { const f32x4 g = ((const f32x4*)gpost)[lane + 64 * j];
            x[j].x += f[j].x * rs * g.x; x[j].y += f[j].y * rs * g.y; x[j].z += f[j].z * rs * g.z; x[j].w += f[j].w * rs * g.w;
            if (OUT_F32) ((f32x4*)(F.out + (size_t)row * D) + lane)[64 * j] = x[j];
            else ((unsigned long long*)(xb + (size_t)row * D) + lane)[64 * j] = (unsigned long long)pk2(x[j].x, x[j].y) | ((unsigned long long)pk2(x[j].z, x[j].w) << 32);
            s2 += (x[j].x * x[j].x + x[j].y * x[j].y) + (x[j].z * x[j].z + x[j].w * x[j].w); }
        if (gnext) {
            const float r2 = rsqrtf(wave_sum(s2) * (1.f / D) + EPS);
            unsigned long long* o8 = (unsigned long long*)(B_H + (size_t)row * D) + lane;
#pragma unroll
            for (int j = 0; j < 4; ++j) { const f32x4 g = ((const f32x4*)gnext)[lane + 64 * j];
                o8[64 * j] = (unsigned long long)pk2(x[j].x * r2 * g.x, x[j].y * r2 * g.y) | ((unsigned long long)pk2(x[j].z * r2 * g.z, x[j].w * r2 * g.w) << 32); }
        }
    }
}

template <int ACT>
__device__ __forceinline__ void phase_gemm(Frame& F, const bf16* A, const bf16* Bt, bf16* O, int N, int K) {
    asm volatile("" : "+s"(A), "+s"(Bt), "+s"(O));
    pg8::Gemm g{A, Bt, M, N, K}; pg8::StaticOrder So; So.init(M, N, F.G, (int)blockIdx.x);
    pg8::EpiStore<ACT> E{O, N};
    pg8::gemm_phase<pg8::EpiStore<ACT>, pg8::StaticOrder, true, true>(F.lds, g, So, E);
}

constexpr int PH_PER_LAYER = 10, NPHASES = 1 + DEPTH * PH_PER_LAYER;
__global__ void __launch_bounds__(NWAVES * 64, 2) mk_fwd(Args args) {
    extern __shared__ __attribute__((aligned(16))) unsigned char lds[];
    Frame F;
    F.lds = (LAS unsigned char*)lds;
    F.MISC = (volatile LAS unsigned*)(F.lds + MISC_OFF);
    F.tid = threadIdx.x; F.lane = F.tid & 63; F.wave = __builtin_amdgcn_readfirstlane(F.tid >> 6);
    F.G = gridDim.x; { const int bx = blockIdx.x; F.vcu = (F.G % 8 == 0) ? (bx % 8) * (F.G / 8) + bx / 8 : bx; }
    unsigned char* ws = args.ws; F.ws = ws;
    F.ctl = (gu32*)(ws + WS_CTL);
    F.out = args.out;
    for (int u = F.tid; u < (LDS_BYTES - LDSCTL_OFF) / 4; u += NWAVES * 64) ((LAS unsigned*)(F.lds + LDSCTL_OFF))[u] = 0u;
    __syncthreads();
    XcdBarrier bar; bar.bar = (unsigned*)(F.ctl + CW_BAR); bar.x = 0; bar.st = F.MISC + 8;
    if (args.use_bar) bar = xcd_barrier_post((unsigned*)(F.ctl + CW_BAR), F.MISC + 8);
    const int lo = args.ph_lo, hi = args.ph_hi;
    int pid = 0;
    unsigned char* ws_ = F.ws;
#define PH_ON (pid >= lo && pid < hi)
#if PROBE_MASK
    unsigned long long pr_last = __builtin_amdgcn_s_memrealtime(), pr_acc = 0ull;
#define PH_END(kind) do { if (PH_ON && pid + 1 < hi) xcd_barrier(bar); ++pid; \
        { const unsigned long long now_ = __builtin_amdgcn_s_memrealtime(); \
          if ((kind) == 3 && blockIdx.x == 0 && F.tid == 0) { const unsigned long long sp_ = (unsigned long long)F.MISC[16] | ((unsigned long long)F.MISC[17] << 32); \
              if ((PROBE_MASK >> 11) & 1) pr_acc += sp_ - pr_last; if ((PROBE_MASK >> 3) & 1) pr_acc += now_ - sp_; } \
          else if ((PROBE_MASK >> (kind)) & 1) pr_acc += now_ - pr_last; pr_last = now_; } } while (0)
#else
#define PH_END(kind) do { if (PH_ON && pid + 1 < hi) xcd_barrier(bar); ++pid; } while (0)
#endif

    if (PH_ON && !(SKIPM & 1)) phase_prologue(F, args);
    PH_END(0);
    for (int l = 0; l < DEPTH; ++l) {
        if (PH_ON && !(SKIPM & 2)) phase_gemm<0>(F, B_H, w_in_t(ws_, l), B_PROJ, NP, D);
        PH_END(1);
        if (PH_ON && !(SKIPM & 4)) phase_prep(F, args, l);
        PH_END(2);
        if (PH_ON && !(SKIPM & 8)) phase_attn(F, l);
        PH_END(3);
        if (PH_ON && !(SKIPM & 8)) phase_dsa_attn(F);
        PH_END(4);
        if (PH_ON && !(SKIPM & 16)) phase_merge(F, args, l);
        PH_END(5);
        if (PH_ON && !(SKIPM & 32)) phase_gemm<0>(F, B_MIX, w_out_t(ws_, l), B_F, D, D);
        PH_END(6);
        if (PH_ON && !(SKIPM & 64)) { if (l == 0) phase_finish<true, false>(F, P_X_IN, P_G_POST_MIX + l * D, P_G_PRE_MLP + l * D); else phase_finish<false, false>(F, nullptr, P_G_POST_MIX + l * D, P_G_PRE_MLP + l * D); }
        PH_END(7);
        if (PH_ON && !(SKIPM & 128)) phase_gemm<2>(F, B_H, w_up_t(ws_, l), B_HID, FF, D);
        PH_END(8);
        if (PH_ON && !(SKIPM & 256)) phase_gemm<0>(F, B_HID, w_dn_t(ws_, l), B_F, D, FF);
        PH_END(9);
        if (PH_ON && !(SKIPM & 512)) { if (l + 1 < DEPTH) phase_finish<false, false>(F, nullptr, P_G_POST_MLP + l * D, P_G_PRE_MIX + (l + 1) * D); else phase_finish<false, true>(F, nullptr, P_G_POST_MLP + l * D, nullptr); }
        PH_END(10);
    }
#if PROBE_MASK
    if (blockIdx.x == 0 && F.tid == 0) { const unsigned long long t0_ = __builtin_amdgcn_s_memrealtime(); while (__builtin_amdgcn_s_memrealtime() - t0_ < pr_acc) __builtin_amdgcn_s_sleep(8); }
#endif
#undef PH_ON
#undef PH_END
}

extern "C" void kernel_launch(void* const* d_in, const int* in_sizes, int n_in, void* d_out, int out_size, void* d_ws, size_t ws_size, hipStream_t stream) {
    static int grid = 0;
    if (grid == 0) {
        if (n_in != 20 || in_sizes[0] != M * D || out_size != M * D || ws_size < WS_END) {
            fprintf(stderr, "kernel_launch: unexpected shapes / workspace (n_in %d, in0 %d, out %d, ws %zu < %zu); nothing launched\n", n_in, n_in > 0 ? in_sizes[0] : -1, out_size, ws_size, (size_t)WS_END);
            grid = -1; return; }
        int dev = 0, cus = 0, per_cu = 0;
        if (hipGetDevice(&dev) != hipSuccess || hipDeviceGetAttribute(&cus, hipDeviceAttributeMultiprocessorCount, dev) != hipSuccess) { grid = -1; return; }
        if (hipFuncSetAttribute((const void*)mk_fwd, hipFuncAttributeMaxDynamicSharedMemorySize, LDS_BYTES) != hipSuccess) { fprintf(stderr, "kernel_launch: hipFuncSetAttribute failed\n"); grid = -1; return; }
        if (hipOccupancyMaxActiveBlocksPerMultiprocessor(&per_cu, (const void*)mk_fwd, NWAVES * 64, LDS_BYTES) != hipSuccess || per_cu < 1)
            fprintf(stderr, "kernel_launch: note: occupancy query reports %d workgroups per CU\n", per_cu);
        (void)hipGetLastError();
        grid = cus;
    }
    if (grid < 0) return;
    if (hipMemsetAsync((char*)d_ws + WS_CTL, 0, CTL_ZERO_BYTES, stream) != hipSuccess) return;
    Args a{};
    for (int i = 0; i < 20; ++i) a.in[i] = d_in[i];
    a.out = (float*)d_out; a.ws = (unsigned char*)d_ws; a.pad = 0;
#if MK_MULTI
    for (int p = 0; p < NPHASES; ++p) {
        a.ph_lo = p; a.ph_hi = p + 1; a.use_bar = 0;
        hipLaunchKernelGGL(mk_fwd, dim3(grid), dim3(NWAVES * 64), LDS_BYTES, stream, a);
    }
#else
    a.ph_lo = 0; a.ph_hi = NPHASES; a.use_bar = 1;
    hipLaunchKernelGGL(mk_fwd, dim3(grid), dim3(NWAVES * 64), LDS_BYTES, stream, a);
#endif
}
```

```cpp
#include <hip/hip_runtime.h>
#include <cstdio>
#include <cstdint>

#ifndef PROBE_MASK
#define PROBE_MASK 0
#endif
#ifndef SKIPM
#define SKIPM 0
#endif
#ifndef MK_MULTI
#define MK_MULTI 0
#endif

__device__ __forceinline__ int lane_id() { int l; asm volatile("v_mbcnt_lo_u32_b32 %0, -1, 0\n\tv_mbcnt_hi_u32_b32 %0, -1, %0" : "=v"(l)); return l; }
namespace pg8 {
#define PG8_LAS __attribute__((address_space(3)))
typedef unsigned short bf16_t;
typedef short bf16x8 __attribute__((ext_vector_type(8)));
typedef float f32x4 __attribute__((ext_vector_type(4)));
typedef unsigned u32x4 __attribute__((ext_vector_type(4)));
constexpr int BM = 256, BK = 64, HALF = 128, HTB = HALF * BK * 2, STAGE_BYTES = 8 * HTB, NXCD = 8, WGM = 8;

__host__ __device__ __forceinline__ int lds_byte(int r, int c) { const int st = (r >> 4) * 2 + (c >> 5), rr = r & 15, cc = c & 31, ob = rr * 64 + cc * 2; return st * 1024 + (ob ^ (((ob >> 9) & 1) << 5)); }
__host__ __device__ __forceinline__ void stage_rc(int b, int& R, int& C) { const int st = b / 1024, sb = b % 1024, swz = sb ^ (((sb >> 9) & 1) << 5); R = (st >> 1) * 16 + swz / 64; C = (st & 1) * 32 + (swz % 64) / 2; }
__host__ __device__ __forceinline__ int perm32(int rho) { const int n = rho >> 4, i = rho & 15; return 8 * (i >> 2) + 4 * n + (i & 3); }

struct Unit { int pm, pn; };
struct Gemm { const bf16_t* A; const bf16_t* Bt; int M, N, K; };

struct StaticOrder {
    int nM, nN, nwg, G, c;
    __host__ __device__ void init(int M, int N, int G_, int c_) { nM = M / BM; nN = N / BM; nwg = nM * nN; G = G_; c = c_; }
    __host__ __device__ bool next(int i, Unit& u) const {
        const long L = (long)i * G + c; if (L >= nwg) return false;
        int wgid = (int)L; { const int q = nwg / NXCD, r = nwg % NXCD, xcd = wgid % NXCD, off = wgid / NXCD; wgid = (xcd < r ? xcd * (q + 1) : r * (q + 1) + (xcd - r) * q) + off; }
        const int nig = WGM * nN, gid = wgid / nig, fm = gid * WGM, gsz = (nM - fm) < WGM ? (nM - fm) : WGM;
        u.pm = fm + ((wgid % nig) % gsz); u.pn = (wgid % nig) / gsz; return true;
    }
    __device__ __forceinline__ void a_ready(const Unit&) const {}
    __device__ __forceinline__ void done(const Unit&) const {}
};

__device__ __forceinline__ unsigned cvt_pk_bf16(float lo, float hi) { unsigned r; asm volatile("v_cvt_pk_bf16_f32 %0, %1, %2" : "=v"(r) : "v"(lo), "v"(hi)); return r; }

template <int ACT  > struct EpiStore {
    static constexpr bool PERM = true, AFTER_DRAIN = false;
    bf16_t* O; int ldc;
    __device__ __forceinline__ void operator()(const f32x4 (&acc)[2][2][4][2], const Unit& u, int wr, int wc, int fr, int fq) const {
        const int row0 = u.pm * BM + wr * 64 + fr;
        const int col0 = u.pn * BM + wc * 32 + 8 * fq;
#pragma unroll
        for (int ai = 0; ai < 2; ++ai)
#pragma unroll
            for (int m = 0; m < 4; ++m) { bf16_t* rowp = O + (size_t)(row0 + ai * HALF + m * 16) * ldc + col0;
#pragma unroll
                for (int bj = 0; bj < 2; ++bj) { f32x4 v0 = acc[ai][bj][m][0], v1 = acc[ai][bj][m][1];
                    if (ACT == 2) {
#pragma unroll
                        for (int e = 0; e < 4; ++e) { const float a = fmaxf(v0[e], 0.f), b = fmaxf(v1[e], 0.f); v0[e] = a * a; v1[e] = b * b; } }
                    u32x4 w; w.x = cvt_pk_bf16(v0[0], v0[1]); w.y = cvt_pk_bf16(v0[2], v0[3]); w.z = cvt_pk_bf16(v1[0], v1[1]); w.w = cvt_pk_bf16(v1[2], v1[3]);
                    *(u32x4*)(rowp + bj * HALF) = w; } }
    }
};

template <class Epi, class Sched, bool ALIGN_EPI = false, bool SP2 = false>
__device__ __forceinline__ void gemm_phase(PG8_LAS unsigned char* lds, const Gemm g, const Sched& S, const Epi& E, int wave_) {
    int tid_ = wave_ * 64 + lane_id(); asm volatile("" : "+v"(tid_));
    const int tid = tid_, wid = __builtin_amdgcn_readfirstlane(tid >> 6), lane = tid & 63, wr = wid >> 2, wc = wid & 3, fr = lane & 15, fq = lane >> 4;
    const int K = g.K, nt = K / BK;
    unsigned voffA[2], voffB[2];
#pragma unroll
    for (int i = 0; i < 2; ++i) { int R, C; stage_rc(tid * 16 + i * 8192, R, C); const int Rb = Epi::PERM ? ((R & ~31) + perm32(R & 31)) : R;
        voffA[i] = (unsigned)(R * K + C) * 2u; voffB[i] = (unsigned)(Rb * K + C) * 2u; }
    const size_t kstep = (size_t)(BK * 2);
    const size_t hstep = (size_t)HALF * K * 2;
    const size_t tstep = 2 * hstep;
    const unsigned ldsw = (unsigned)wid * 1024u;
    const int aoff = lds_byte(wr * 64 + fr, fq * 8), boff = lds_byte(wc * 32 + fr, fq * 8);
#define PG8_SA(b, h) (((b) * 2 + (h)) * HTB)
#define PG8_SB(b, h) ((4 + (b) * 2 + (h)) * HTB)
#define PG8_STAGE(bufoff, gbase, voff) do { _Pragma("unroll") for (int _i = 0; _i < 2; ++_i) \
        __builtin_amdgcn_global_load_lds((const unsigned*)((const char*)(gbase) + (voff)[_i]), (PG8_LAS unsigned*)(lds + (bufoff) + ldsw + _i * 8192), 16, 0, 0); } while (0)
#define PG8_LDA(dst, b, h) do { _Pragma("unroll") for (int m = 0; m < 4; ++m) _Pragma("unroll") for (int k = 0; k < 2; ++k) dst[m][k] = *(const PG8_LAS bf16x8*)(lds + PG8_SA(b, h) + aoff + m * 2048 + k * 1024); } while (0)
#define PG8_LDB(dst, b, h) do { _Pragma("unroll") for (int n = 0; n < 2; ++n) _Pragma("unroll") for (int k = 0; k < 2; ++k) dst[n][k] = *(const PG8_LAS bf16x8*)(lds + PG8_SB(b, h) + boff + n * 2048 + k * 1024); } while (0)
#define PG8_MMA(ai, bj, At, Bt) do { __builtin_amdgcn_s_setprio(1); _Pragma("unroll") for (int m = 0; m < 4; ++m) _Pragma("unroll") for (int n = 0; n < 2; ++n) _Pragma("unroll") for (int k = 0; k < 2; ++k) \
        acc[ai][bj][m][n] = __builtin_amdgcn_mfma_f32_16x16x32_bf16(Bt[n][k], At[m][k], acc[ai][bj][m][n], 0, 0, 0); __builtin_amdgcn_s_setprio(0); } while (0)
#define PG8_WAIT_V(n) asm volatile("s_waitcnt vmcnt(" #n ")" ::: "memory")
#define PG8_WAIT_L(n) asm volatile("s_waitcnt lgkmcnt(" #n ")" ::: "memory")
#define PG8_BAR __builtin_amdgcn_s_barrier()
#define PG8_SCHED __builtin_amdgcn_sched_barrier(0)
    Unit cur, nxt; int ui = 0;
    if (!S.next(0, cur)) return;
    f32x4 acc[2][2][4][2];
#pragma unroll
    for (int a = 0; a < 2; ++a)
#pragma unroll
        for (int b = 0; b < 2; ++b)
#pragma unroll
            for (int m = 0; m < 4; ++m)
#pragma unroll
                for (int n = 0; n < 2; ++n) acc[a][b][m][n] = (f32x4){0.f, 0.f, 0.f, 0.f};
    bf16x8 At[4][2], B0[2][2], B1[2][2];
    const char* cA = (const char*)g.A + (size_t)cur.pm * tstep; const char* cB = (const char*)g.Bt + (size_t)cur.pn * tstep;
    S.a_ready(cur);
    if constexpr (SP2) {
        PG8_STAGE(PG8_SB(0, 0), cB, voffB); PG8_STAGE(PG8_SB(0, 1), cB + hstep, voffB); PG8_STAGE(PG8_SA(0, 0), cA, voffA); PG8_STAGE(PG8_SA(0, 1), cA + hstep, voffA);
        if (wr == 1) PG8_BAR;
        PG8_WAIT_V(2); PG8_BAR;
        PG8_STAGE(PG8_SB(1, 0), cB + kstep, voffB); PG8_STAGE(PG8_SA(1, 0), cA + kstep, voffA); PG8_STAGE(PG8_SB(1, 1), cB + hstep + kstep, voffB);
        PG8_WAIT_V(6); PG8_BAR;
    } else {
        PG8_STAGE(PG8_SB(0, 0), cB, voffB); PG8_STAGE(PG8_SA(0, 0), cA, voffA); PG8_STAGE(PG8_SB(0, 1), cB + hstep, voffB); PG8_STAGE(PG8_SA(0, 1), cA + hstep, voffA);
        if (wr == 1) PG8_BAR;
        PG8_WAIT_V(4); PG8_BAR;
        PG8_STAGE(PG8_SB(1, 0), cB + kstep, voffB); PG8_STAGE(PG8_SA(1, 0), cA + kstep, voffA); PG8_STAGE(PG8_SB(1, 1), cB + hstep + kstep, voffB);
        PG8_WAIT_V(6); PG8_BAR;
    }
    for (;;) {
        const bool has_next = S.next(ui + 1, nxt);
        const char* nA = has_next ? (const char*)g.A + (size_t)nxt.pm * tstep : cA; const char* nB = has_next ? (const char*)g.Bt + (size_t)nxt.pn * tstep : cB;
        for (int t = 0; t < nt; t += 2) {
            const bool last = (t == nt - 2);
            const char* a1 = cA + (size_t)(t + 1) * kstep;
            const char* a2 = last ? nA : cA + (size_t)(t + 2) * kstep; const char* b2 = last ? nB : cB + (size_t)(t + 2) * kstep;
            const char* a3 = a2 + kstep; const char* b3 = b2 + kstep;
            if (last && has_next) S.a_ready(nxt);
            if constexpr (SP2) {
            PG8_LDB(B0, 0, 0); PG8_LDB(B1, 0, 1); PG8_SCHED; PG8_LDA(At, 0, 0); PG8_STAGE(PG8_SA(1, 1), a1 + hstep, voffA);
            PG8_WAIT_V(8); PG8_WAIT_L(0); PG8_BAR; PG8_MMA(0, 0, At, B0); PG8_MMA(0, 1, At, B1); PG8_BAR; PG8_SCHED;
            PG8_LDA(At, 0, 1); PG8_STAGE(PG8_SB(0, 0), b2, voffB); PG8_STAGE(PG8_SB(0, 1), b2 + hstep, voffB); PG8_STAGE(PG8_SA(0, 0), a2, voffA);
            PG8_WAIT_V(8); PG8_WAIT_L(0); PG8_BAR; PG8_MMA(1, 0, At, B0); PG8_MMA(1, 1, At, B1); PG8_BAR; PG8_SCHED;
            PG8_LDB(B0, 1, 0); PG8_LDB(B1, 1, 1); PG8_SCHED; PG8_LDA(At, 1, 0); PG8_STAGE(PG8_SA(0, 1), a2 + hstep, voffA);
            PG8_WAIT_V(8); PG8_WAIT_L(0); PG8_BAR; PG8_MMA(0, 0, At, B0); PG8_MMA(0, 1, At, B1); PG8_BAR; PG8_SCHED;
            PG8_LDA(At, 1, 1); PG8_STAGE(PG8_SB(1, 0), b3, voffB); PG8_STAGE(PG8_SB(1, 1), b3 + hstep, voffB); PG8_STAGE(PG8_SA(1, 0), a3, voffA);
            PG8_WAIT_V(8); PG8_WAIT_L(0); PG8_BAR; PG8_MMA(1, 0, At, B0); PG8_MMA(1, 1, At, B1); PG8_BAR; PG8_SCHED;
            } else {
            PG8_LDB(B0, 0, 0); PG8_SCHED; PG8_LDA(At, 0, 0); PG8_STAGE(PG8_SA(1, 1), a1 + hstep, voffA);
            PG8_WAIT_L(8); PG8_BAR; PG8_WAIT_L(0); PG8_MMA(0, 0, At, B0); PG8_BAR; PG8_SCHED;
            PG8_LDB(B1, 0, 1); PG8_STAGE(PG8_SB(0, 0), b2, voffB);
            PG8_BAR; PG8_WAIT_L(0); PG8_MMA(0, 1, At, B1); PG8_BAR;
            PG8_LDA(At, 0, 1); PG8_STAGE(PG8_SA(0, 0), a2, voffA);
            PG8_BAR; PG8_WAIT_L(0); PG8_MMA(1, 0, At, B0); PG8_BAR; PG8_SCHED;
            PG8_STAGE(PG8_SB(0, 1), b2 + hstep, voffB);
            PG8_WAIT_V(6); PG8_BAR; PG8_MMA(1, 1, At, B1); PG8_BAR;
            PG8_LDB(B0, 1, 0); PG8_SCHED; PG8_LDA(At, 1, 0); PG8_STAGE(PG8_SA(0, 1), a2 + hstep, voffA);
            PG8_WAIT_L(8); PG8_BAR; PG8_WAIT_L(0); PG8_MMA(0, 0, At, B0); PG8_BAR; PG8_SCHED;
            PG8_LDB(B1, 1, 1); PG8_STAGE(PG8_SB(1, 0), b3, voffB);
            PG8_BAR; PG8_WAIT_L(0); PG8_MMA(0, 1, At, B1); PG8_BAR;
            PG8_LDA(At, 1, 1); PG8_STAGE(PG8_SA(1, 0), a3, voffA);
            PG8_BAR; PG8_WAIT_L(0); PG8_MMA(1, 0, At, B0); PG8_BAR; PG8_SCHED;
            PG8_STAGE(PG8_SB(1, 1), b3 + hstep, voffB);
            PG8_WAIT_V(6); PG8_BAR; PG8_MMA(1, 1, At, B1); PG8_BAR;
            }
        }
        if constexpr (ALIGN_EPI) { if (wr == 0) PG8_BAR; }
        if constexpr (!Epi::AFTER_DRAIN) { E(acc, cur, wr, wc, fr, fq); S.done(cur); }
        if (!has_next) break;
#pragma unroll
        for (int a = 0; a < 2; ++a)
#pragma unroll
            for (int b = 0; b < 2; ++b)
#pragma unroll
                for (int m = 0; m < 4; ++m)
#pragma unroll
                    for (int n = 0; n < 2; ++n) acc[a][b][m][n] = (f32x4){0.f, 0.f, 0.f, 0.f};
        cur = nxt; cA = nA; cB = nB; ++ui;
        if constexpr (ALIGN_EPI) { if (wr == 1) PG8_BAR; }
    }
    PG8_WAIT_V(0);
    if constexpr (!ALIGN_EPI) { if (wr == 0) PG8_BAR; }
    PG8_BAR;
#undef PG8_SA
#undef PG8_SB
#undef PG8_STAGE
#undef PG8_LDA
#undef PG8_LDB
#undef PG8_MMA
#undef PG8_WAIT_V
#undef PG8_WAIT_L
#undef PG8_BAR
#undef PG8_SCHED
}
}

constexpr int NWAVES = 8;
constexpr int BATCH = 32, S = 2048, D = 1024, DEPTH = 4, FF = 4096;
constexpr int M = BATCH * S;
constexpr int NP = 2304;
constexpr int DIN = 2108;
constexpr int C_QA = 0, C_CKV = 256, C_QIDX = 384, C_QB = 512, C_KCMP = 1024, C_VCMP = 1152, C_KSLC = 1280, C_VSLC = 1408, C_KWIN = 1536, C_VWIN = 1664,
              C_UC = 1792, C_KIDX = 2048, C_WIDX = 2080, C_GATE = 2084, C_KA = 2112, C_VA = 2176;
constexpr int NC = 127;
constexpr float EPS = 1e-6f;
constexpr float NEGF = -1e30f;

__host__ __device__ __forceinline__ int win_src(int n) {
    if (n < 512) return n;
    if (n < 1024) return 548 + (n - 512);
    if (n < 1792) return 1060 + (n - 1024);
    if (n < 2048) return 1852 + (n - 1792);
    if (n < 2080) return 512 + (n - 2048);
    if (n < 2084) return 544 + (n - 2080);
    if (n < 2108) return 1828 + (n - 2084);
    return -1;
}

constexpr size_t MiB = 1u << 20;
constexpr size_t WS_CTL = 0, CTL_ZERO_BYTES = 1 * MiB;
constexpr size_t WS_W = 2 * MiB;
constexpr size_t W_IN_B = (size_t)NP * D * 2, W_OUT_B = (size_t)D * D * 2, W_UP_B = (size_t)FF * D * 2, W_DN_B = (size_t)D * FF * 2;
constexpr size_t W_LAYER_B = W_IN_B + W_OUT_B + W_UP_B + W_DN_B;
constexpr size_t WS_ROPE = 96 * MiB;
constexpr size_t WS_WCT = 102 * MiB;
constexpr size_t WS_CB = 104 * MiB;
constexpr size_t WS_KCB = 124 * MiB, WS_VCB = 125 * MiB;
constexpr size_t WS_KA = 108 * MiB;
constexpr size_t WS_H = 128 * MiB;
constexpr size_t WS_F = 256 * MiB;
constexpr size_t WS_PROJ = 384 * MiB;
constexpr size_t WS_MIX = 672 * MiB;
constexpr size_t WS_MASK = 800 * MiB;
constexpr size_t WS_HID = 384 * MiB;
constexpr size_t WS_XB = 896 * MiB;
constexpr size_t WS_END = 1024 * MiB;
static_assert(WS_W + DEPTH * W_LAYER_B <= WS_ROPE, "weights");
static_assert(WS_ROPE + (size_t)M * 24 * 4 <= WS_WCT && WS_WCT + (size_t)DEPTH * 2 * 128 * 1024 * 2 <= WS_CB, "map");
static_assert(WS_PROJ + (size_t)M * NP * 2 <= WS_MIX && WS_MIX + (size_t)M * D * 2 <= WS_END && WS_HID + (size_t)M * FF * 2 <= WS_END, "map2");

constexpr int CW_BAR = 4096;
constexpr int RING_BYTES = 131072;
constexpr int LDSCTL_OFF = RING_BYTES, MISC_OFF = LDSCTL_OFF + 320;
constexpr int LDS_BYTES = 147456;
constexpr int WSCR = 16384;

#define GAS __attribute__((address_space(1)))
#define LAS __attribute__((address_space(3)))
typedef unsigned short bf16;
typedef unsigned v4u __attribute__((ext_vector_type(4)));
typedef float f32x4 __attribute__((ext_vector_type(4)));
typedef GAS unsigned gu32;
#define LDS_FENCE() asm volatile("s_waitcnt lgkmcnt(0)" ::: "memory")
__device__ __forceinline__ unsigned f2bf(float f) { unsigned u = __builtin_bit_cast(unsigned, f); return (u + 0x7fffu + ((u >> 16) & 1u)) >> 16; }
__device__ __forceinline__ unsigned pk2(float lo, float hi) { return f2bf(lo) | (f2bf(hi) << 16); }
__device__ __forceinline__ float bf2f(bf16 u) { return __builtin_bit_cast(float, (unsigned)u << 16); }
__device__ __forceinline__ float bflo(unsigned u) { return __builtin_bit_cast(float, u << 16); }
__device__ __forceinline__ float bfhi(unsigned u) { return __builtin_bit_cast(float, u & 0xffff0000u); }

#define XB_TMO      128
#define XB_XCNT(j)  (256  + 64 * (j))
#define XB_XSUB(j)  (1280 + 64 * (j))
#define XB_XGEN(j)  (2304 + 64 * (j))
#define XB_TOP      3328
#define XB_TOPGEN   3392
#define XCD_BAR_WORDS 3456
#define XB_SPIN_CAP (1u << 22)

__device__ __forceinline__ unsigned xb_ld(unsigned* p)              { return __hip_atomic_load(p, __ATOMIC_RELAXED, __HIP_MEMORY_SCOPE_AGENT); }
__device__ __forceinline__ unsigned xb_add(unsigned* p, unsigned v) { return __hip_atomic_fetch_add(p, v, __ATOMIC_RELAXED, __HIP_MEMORY_SCOPE_AGENT); }
__device__ __forceinline__ unsigned xb_xcc_id() { return (unsigned)__builtin_amdgcn_s_getreg((3 << 11) | 20) & 0xFu; }
#define XB_SPIN(cond, bar) do { unsigned _sp = 0; while (cond) { __builtin_amdgcn_s_sleep(1); \
    if ((++_sp & 255u) == 0u) { if (xb_ld(&(bar)[XB_TMO])) break; if (_sp > XB_SPIN_CAP) { atomicAdd(&(bar)[XB_TMO], 1u); break; } } } } while (0)

struct XcdBarrier { unsigned* bar; unsigned x; volatile LAS unsigned* st; int wv; };

__device__ __forceinline__ XcdBarrier xcd_barrier_post(unsigned* bar, volatile LAS unsigned* st) {
    XcdBarrier b; b.bar = bar; b.x = xb_xcc_id(); b.st = st; b.wv = 0;
    if (threadIdx.x == 0) (void)xb_add(&bar[XB_XCNT(b.x)], 1u);
    return b;
}
__device__ __forceinline__ void xcd_barrier_complete(unsigned* bar, unsigned x, unsigned& nloc, unsigned& nx) {
    const unsigned G = gridDim.x * gridDim.y * gridDim.z;
    unsigned sum, cnt, mine, sp = 0u;
    for (;;) {
        sum = 0u; cnt = 0u; mine = 0u;
#pragma unroll
        for (unsigned j = 0; j < 16; ++j) { const unsigned c = xb_ld(&bar[XB_XCNT(j)]); sum += c; cnt += (c > 0u) ? 1u : 0u; mine = (j == x) ? c : mine; }
        if (sum == G) break;
        __builtin_amdgcn_s_sleep(1);
        if ((++sp & 255u) == 0u) { if (xb_ld(&bar[XB_TMO])) break; if (sp > XB_SPIN_CAP) { atomicAdd(&bar[XB_TMO], 1u); break; } }
    }
    nloc = mine > 0u ? mine : 1u; nx = cnt > 0u ? cnt : 1u;
}
__device__ __forceinline__ void xcd_barrier(const XcdBarrier& b) {
    asm volatile("s_waitcnt vmcnt(0)" ::: "memory");
    __syncthreads();
    if (b.wv == 0 && lane_id() == 0) {
        unsigned* bar = b.bar; asm volatile("" : "+s"(bar));
        __builtin_amdgcn_s_waitcnt(0);
        unsigned nloc = b.st[0], nx = b.st[1];
        if (nloc == 0u) { xcd_barrier_complete(bar, b.x, nloc, nx); b.st[0] = nloc; b.st[1] = nx; }
        const unsigned old = xb_add(&bar[XB_XSUB(b.x)], 1u);
        const unsigned gen = old / nloc;
        if (old + 1u == (gen + 1u) * nloc) {
            __builtin_amdgcn_fence(__ATOMIC_RELEASE, "agent");
            asm volatile("s_waitcnt vmcnt(0)" ::: "memory");
            const unsigned og = xb_add(&bar[XB_TOP], 1u);
            const unsigned tg = og / nx;
            if (og + 1u == (tg + 1u) * nx) xb_add(&bar[XB_TOPGEN], 1u);
            else XB_SPIN(xb_ld(&bar[XB_TOPGEN]) == tg, bar);
            __builtin_amdgcn_fence(__ATOMIC_ACQUIRE, "agent");
            xb_add(&bar[XB_XGEN(b.x)], 1u);
            asm volatile("s_waitcnt vmcnt(0)" ::: "memory");
        } else {
            XB_SPIN(xb_ld(&bar[XB_XGEN(b.x)]) == gen, bar);
            __builtin_amdgcn_fence(__ATOMIC_ACQUIRE, "agent");
            asm volatile("s_waitcnt vmcnt(0)" ::: "memory");
        }
    }
    __syncthreads();
}

struct Frame {
    LAS unsigned char* lds;
    volatile LAS unsigned* MISC;
    gu32* ctl;
    int wave, vcu, G;
    float* out; unsigned char* ws;
};
struct Args { const void* in[20]; float* out; unsigned char* ws; int ph_lo, ph_hi, use_bar, pad; };
#define IN_F(k) ((const float*)args.in[k])
#define P_X_IN IN_F(0)
#define P_POS ((const int*)args.in[1])
#define P_W_IN IN_F(2)
#define P_G_KV_A IN_F(3)
#define P_W_KV_UP IN_F(4)
#define P_W_CMP_K IN_F(5)
#define P_W_CMP_V IN_F(6)
#define P_PE_K IN_F(7)
#define P_PE_V IN_F(8)
#define P_W_POOL IN_F(9)
#define P_POOL_SCALE IN_F(10)
#define P_G_OUT_A IN_F(11)
#define P_G_OUT_B IN_F(12)
#define P_W_OUT IN_F(13)
#define P_G_PRE_MIX IN_F(14)
#define P_G_POST_MIX IN_F(15)
#define P_G_PRE_MLP IN_F(16)
#define P_G_POST_MLP IN_F(17)
#define P_W_UP IN_F(18)
#define P_W_DOWN IN_F(19)
#define B_ROPE ((float*)(ws_ + WS_ROPE))
#define B_H ((bf16*)(ws_ + WS_H))
#define B_F ((bf16*)(ws_ + WS_F))
#define B_PROJ ((bf16*)(ws_ + WS_PROJ))
#define B_MIX ((bf16*)(ws_ + WS_MIX))
#define B_HID ((bf16*)(ws_ + WS_HID))

template <int CTRL> __device__ __forceinline__ int dpp_i(int v) { return __builtin_amdgcn_update_dpp(0, v, CTRL, 0xF, 0xF, true); }
template <int CTRL> __device__ __forceinline__ float dpp_f(float v) { return __builtin_bit_cast(float, dpp_i<CTRL>(__builtin_bit_cast(int, v))); }
__device__ __forceinline__ int swz16_i(int v) { return __builtin_amdgcn_ds_swizzle(v, (16 << 10) | 0x1F); }
__device__ __forceinline__ float swz16_f(float v) { return __builtin_bit_cast(float, swz16_i(__builtin_bit_cast(int, v))); }
struct HalfPair { unsigned lo, hi; };
__device__ __forceinline__ HalfPair halves_u(unsigned v) { const auto rr = __builtin_amdgcn_permlane32_swap(v, v, false, false); HalfPair h; h.lo = rr[0]; h.hi = rr[1]; return h; }
__device__ __forceinline__ float other_half_f(float v, int hi) { const HalfPair h = halves_u(__builtin_bit_cast(unsigned, v)); return __builtin_bit_cast(float, hi ? h.lo : h.hi); }
__device__ __forceinline__ float sum32(float v) {
    v += dpp_f<0xB1>(v); v += dpp_f<0x4E>(v); v += dpp_f<0x141>(v); v += dpp_f<0x140>(v); v += swz16_f(v); return v; }
__device__ __forceinline__ float wave_sum(float v) { v = sum32(v); const HalfPair h = halves_u(__builtin_bit_cast(unsigned, v)); return __builtin_bit_cast(float, h.lo) + __builtin_bit_cast(float, h.hi); }
__device__ __forceinline__ float max_halves(float v) { const HalfPair h = halves_u(__builtin_bit_cast(unsigned, v)); return fmaxf(__builtin_bit_cast(float, h.lo), __builtin_bit_cast(float, h.hi)); }
__device__ __forceinline__ unsigned or_halves(unsigned v) { const HalfPair h = halves_u(v); return h.lo | h.hi; }
__device__ __forceinline__ unsigned or32(unsigned v) { v |= (unsigned)dpp_i<0xB1>((int)v); v |= (unsigned)dpp_i<0x4E>((int)v); v |= (unsigned)dpp_i<0x141>((int)v); v |= (unsigned)dpp_i<0x140>((int)v); v |= (unsigned)swz16_i((int)v); return v; }

__constant__ double c_rope_inv[12] = {1.0, 0.19392274474868576, 0.03760603093086393, 0.007292664737217109, 0.001414213562373095, 0.0002742481756762073, 5.318295896944988e-05, 1.031338537721246e-05,
                                       1.0, 0.03760603093086393, 0.001414213562373095, 5.318295896944988e-05};
template <int MODE>
__device__ __forceinline__ void transpose_item(const float* W, int K, int Nsrc, int nblk, bf16* WT, LAS float* scr, int item, int lane) {
    const int kb = item / nblk, nb = item % nblk, k0 = 64 * kb, n0 = 32 * nb;
    if (MODE && n0 >= C_KA && n0 < C_KA + 128) return;
    const int np = n0 + (lane & 31);
    const int src = MODE ? win_src(np) : np;
#pragma unroll 8
    for (int i = 0; i < 32; ++i) { const int kk = 2 * i + (lane >> 5); scr[kk * 33 + (lane & 31)] = (src >= 0) ? W[(size_t)(k0 + kk) * Nsrc + src] : 0.f; }
    LDS_FENCE();
    const int c = lane & 7;
#pragma unroll
    for (int j = 0; j < 4; ++j) { const int n = (lane >> 3) + 8 * j; const LAS float* s = scr + (8 * c) * 33 + n;
        v4u o; o.x = pk2(s[0 * 33], s[1 * 33]); o.y = pk2(s[2 * 33], s[3 * 33]); o.z = pk2(s[4 * 33], s[5 * 33]); o.w = pk2(s[6 * 33], s[7 * 33]);
        *(v4u*)(WT + (size_t)(n0 + n) * K + k0 + 8 * c) = o; }
    LDS_FENCE();
}

__device__ __forceinline__ bf16* w_in_t(unsigned char* ws_, int l)  { return (bf16*)(ws_ + WS_W + (size_t)l * W_LAYER_B); }
__device__ __forceinline__ bf16* w_out_t(unsigned char* ws_, int l) { return (bf16*)(ws_ + WS_W + (size_t)l * W_LAYER_B + W_IN_B); }
__device__ __forceinline__ bf16* w_up_t(unsigned char* ws_, int l)  { return (bf16*)(ws_ + WS_W + (size_t)l * W_LAYER_B + W_IN_B + W_OUT_B); }
__device__ __forceinline__ bf16* w_dn_t(unsigned char* ws_, int l)  { return (bf16*)(ws_ + WS_W + (size_t)l * W_LAYER_B + W_IN_B + W_OUT_B + W_UP_B); }

__device__ __forceinline__ void norm_row_to_bf16(const float* xrow, const float* gain, bf16* orow, int lane) {
    const f32x4* xr = (const f32x4*)xrow + lane;
    f32x4 v[4]; float s = 0.f;
#pragma unroll
    for (int j = 0; j < 4; ++j) { v[j] = xr[64 * j]; s += (v[j].x * v[j].x + v[j].y * v[j].y) + (v[j].z * v[j].z + v[j].w * v[j].w); }
    const float rs = rsqrtf(wave_sum(s) * (1.f / D) + EPS);
    unsigned long long* o8 = (unsigned long long*)orow + lane;
#pragma unroll
    for (int j = 0; j < 4; ++j) { const f32x4 g = ((const f32x4*)gain)[lane + 64 * j];
        o8[64 * j] = (unsigned long long)pk2(v[j].x * rs * g.x, v[j].y * rs * g.y) | ((unsigned long long)pk2(v[j].z * rs * g.z, v[j].w * rs * g.w) << 32); }
}

__device__ __forceinline__ void phase_prologue(Frame& F, const Args& args) {
    unsigned char* ws_ = F.ws; asm volatile("" : "+s"(ws_)); int lane_ = lane_id(); asm volatile("" : "+v"(lane_)); (void)ws_;
    LAS float* scr = (LAS float*)(F.lds + F.wave * WSCR);
    const int gw = F.vcu * NWAVES + F.wave, NGW = F.G * NWAVES;
    constexpr int I_IN = (D / 64) * (NP / 32), I_OUT = (D / 64) * (D / 32), I_UP = (D / 64) * (FF / 32), I_DN = (FF / 64) * (D / 32);
    for (int it = gw; it < DEPTH * I_IN; it += NGW) { const int l = it / I_IN, r = it % I_IN; transpose_item<1>(P_W_IN + (size_t)l * D * DIN, D, DIN, NP / 32, w_in_t(ws_, l), scr, r, lane_); }
    for (int it = gw; it < DEPTH * I_OUT; it += NGW) { const int l = it / I_OUT, r = it % I_OUT; transpose_item<0>(P_W_OUT + (size_t)l * D * D, D, D, D / 32, w_out_t(ws_, l), scr, r, lane_); }
    for (int it = gw; it < DEPTH * I_UP; it += NGW) { const int l = it / I_UP, r = it % I_UP; transpose_item<0>(P_W_UP + (size_t)l * D * FF, D, FF, FF / 32, w_up_t(ws_, l), scr, r, lane_); }
    for (int it = gw; it < DEPTH * I_DN; it += NGW) { const int l = it / I_DN, r = it % I_DN; transpose_item<0>(P_W_DOWN + (size_t)l * FF * D, FF, D, D / 32, w_dn_t(ws_, l), scr, r, lane_); }
    for (int it = gw; it < DEPTH * D * 2; it += NGW) {
        const int l = it / (D * 2), r = it % (D * 2), k = r >> 1, n = lane_ + 64 * (r & 1);
        const float* wi = P_W_IN + ((size_t)l * D + k) * DIN + 256; const float* gk = P_G_KV_A + l * 128; const float* wu = P_W_KV_UP + (size_t)l * 128 * 128 + n;
        float acc = 0.f;
#pragma unroll 8
        for (int j = 0; j < 128; ++j) acc += (wi[j] * gk[j]) * wu[j * 128];
        w_in_t(ws_, l)[(size_t)(C_KA + n) * D + k] = (bf16)f2bf(acc);
    }
    for (int it = gw; it < DEPTH * 2 * 2 * 32; it += NGW) {
        const int lk = it >> 6, part = (it >> 5) & 1, r = it & 31, l = lk >> 1, kv = lk & 1;
        const float* W = (kv ? P_W_CMP_V : P_W_CMP_K) + (size_t)l * 32 * 64 * 64 + (size_t)part * 1024 * 64;
        transpose_item<0>(W, 1024, 64, 2, (bf16*)(ws_ + WS_WCT) + ((size_t)lk * 128 + part * 64) * 1024, scr, r, lane_);
    }
    for (int it = gw; it < DEPTH * 2; it += NGW) {
        const int l = it >> 1, kv = it & 1;
        const float* W = (kv ? P_W_CMP_V : P_W_CMP_K) + (size_t)l * 32 * 64 * 64 + lane_; const float* pe = (kv ? P_PE_V : P_PE_K) + l * 32 * 64;
        float acc = 0.f;
        for (int k = 0; k < 2048; ++k) acc += pe[k] * W[(size_t)k * 64];
        ((float*)(ws_ + WS_CB))[it * 64 + lane_] = acc;
    }
    for (int e = gw * 64 + lane_; e < M * 12; e += NGW * 64) {
        const int row = e / 12, i = e % 12;
        const double inv = c_rope_inv[i];
        const double a = (double)P_POS[row] * inv;
        const double k = __builtin_rint(a * 0.15915494309189535);
        const float r = (float)(a - k * 6.283185307179586);
        const float c = __builtin_cosf(r), s = __builtin_sinf(r);
        float* t = B_ROPE + (size_t)row * 24;
        if (i < 8) { t[i] = c; t[8 + i] = s; } else { t[16 + (i - 8)] = c; t[20 + (i - 8)] = s; }
    }
    for (int m = gw; m < M; m += NGW) norm_row_to_bf16(P_X_IN + (size_t)m * D, P_G_PRE_MIX, B_H + (size_t)m * D, lane_);
}

typedef short bf16x8 __attribute__((ext_vector_type(8)));
typedef short s16x4 __attribute__((ext_vector_type(4)));
typedef float f32x16 __attribute__((ext_vector_type(16)));
#define MFMA32(a, b, c) __builtin_amdgcn_mfma_f32_32x32x16_bf16((a), (b), (c), 0, 0, 0)
__device__ __forceinline__ int crow(int r, int hi) { return (r & 3) + 8 * (r >> 2) + 4 * hi; }
__device__ __forceinline__ void wg_barrier() { asm volatile("s_waitcnt lgkmcnt(0)\n\ts_barrier" ::: "memory"); }

__device__ __forceinline__ void phase_prep(Frame& F, const Args& args, int l) {
    unsigned char* ws_ = F.ws; asm volatile("" : "+s"(ws_)); int lane_ = lane_id(); asm volatile("" : "+v"(lane_)); (void)ws_; (void)args;
    int tid_ = F.wave * 64 + lane_id(); asm volatile("" : "+v"(tid_));
    const int gw = F.vcu * NWAVES + F.wave, NGW = F.G * NWAVES, lane = lane_;
    {
        const bool r_idx = (lane >= 8 && lane < 12), r_kv = (lane >= 16 && lane < 48);
        const int ii = r_idx ? lane - 8 : ((lane - 16) & 7);
        const int which = (lane - 16) >> 3;
        const int c1 = r_idx ? C_KIDX + ii : (((which < 2) ? C_KSLC : C_KWIN) + (which & 1) * 64 + ii);
        const int c2 = c1 + (r_idx ? 4 : 8);
        const int tc = r_idx ? 16 + ii : ii, ts = r_idx ? 20 + ii : 8 + ii;
        const int i0 = (2 * lane) & 7;
        constexpr int RB = 4;
        for (int row0 = gw * RB; row0 < M; row0 += NGW * RB) {
            unsigned u[RB], v[RB]; float tc0[RB], ts0[RB], tc1[RB], ts1[RB], rc[RB], rsn[RB]; bf16 e1[RB], e2[RB];
#pragma unroll
            for (int k = 0; k < RB; ++k) { bf16* prow = B_PROJ + (size_t)(row0 + k) * NP; const float* tab = B_ROPE + (size_t)(row0 + k) * 24;
                u[k] = *(const unsigned*)(prow + C_CKV + 2 * lane); v[k] = *(const unsigned*)(prow + C_KA + 2 * lane);
                tc0[k] = tab[i0]; ts0[k] = tab[8 + i0]; tc1[k] = tab[i0 + 1]; ts1[k] = tab[8 + i0 + 1];
                rc[k] = 0.f; rsn[k] = 0.f; e1[k] = 0; e2[k] = 0;
                if (r_idx || r_kv) { rc[k] = tab[tc]; rsn[k] = tab[ts]; e1[k] = prow[c1]; e2[k] = prow[c2]; } }
#pragma unroll
            for (int k = 0; k < RB; ++k) { bf16* prow = B_PROJ + (size_t)(row0 + k) * NP;
                const float x0 = bflo(u[k]), x1 = bfhi(u[k]);
                const float rs = rsqrtf(wave_sum(x0 * x0 + x1 * x1) * (1.f / 128.f) + EPS);
                float y0 = bflo(v[k]) * rs, y1 = bfhi(v[k]) * rs;
                const float p0 = __builtin_bit_cast(float, __builtin_amdgcn_ds_swizzle(__builtin_bit_cast(int, y0), (4 << 10) | 0x1F)), p1 = __builtin_bit_cast(float, __builtin_amdgcn_ds_swizzle(__builtin_bit_cast(int, y1), (4 << 10) | 0x1F));
                if (lane < 4) { y0 = y0 * tc0[k] - p0 * ts0[k]; y1 = y1 * tc1[k] - p1 * ts1[k]; }
                else if (lane < 8) { y0 = p0 * ts0[k] + y0 * tc0[k]; y1 = p1 * ts1[k] + y1 * tc1[k]; }
                *(unsigned*)(prow + C_KA + 2 * lane) = pk2(y0, y1);
                if (r_idx || r_kv) { const float x1v = bf2f(e1[k]), x2v = bf2f(e2[k]);
                    prow[c1] = (bf16)f2bf(x1v * rc[k] - x2v * rsn[k]); prow[c2] = (bf16)f2bf(x1v * rsn[k] + x2v * rc[k]); }
            }
        }
    }
    {
        const int wid = F.wave, r32 = lane & 31, hi = lane >> 5;
        LAS float* P = (LAS float*)F.lds;
        for (int u = F.vcu; u < BATCH * 8; u += F.G) {
            const int b = u >> 3, g = (u >> 2) & 1, kv = (u >> 1) & 1, eh = u & 1;
            const int rt = wid >> 1, part = wid & 1;
            const bf16* ap = B_PROJ + ((size_t)b * S + 16 * (32 * rt + r32)) * NP + (kv ? C_VCMP : C_KCMP) + g * 64 + 8 * hi;
            const bf16* bp = (const bf16*)(ws_ + WS_WCT) + ((size_t)(l * 2 + kv) * 128 + part * 64 + eh * 32 + r32) * 1024 + 8 * hi;
            f32x16 acc = {};
#pragma unroll 8
            for (int ks = 0; ks < 64; ++ks) {
                const bf16x8 a = *(const bf16x8*)(ap + (size_t)(ks >> 2) * NP + 16 * (ks & 3));
                const bf16x8 bq = *(const bf16x8*)(bp + 16 * ks);
                acc = MFMA32(a, bq, acc);
            }
#pragma unroll
            for (int r = 0; r < 16; ++r) P[(part * 128 + 32 * rt + crow(r, hi)) * 32 + r32] = acc[r];
            wg_barrier();
            const float* cb = (const float*)(ws_ + WS_CB) + (l * 2 + kv) * 64 + eh * 32;
            bf16* ob = (bf16*)(ws_ + (kv ? WS_VCB : WS_KCB)) + (size_t)(b * 2 + g) * 128 * 64 + eh * 32;
            for (int idx = tid_; idx < 128 * 32; idx += 512) { const int c = idx >> 5, e = idx & 31;
                const float v = (c < NC) ? (P[c * 32 + e] + P[(128 + c + 1) * 32 + e] + cb[e]) : 0.f;
                ob[c * 64 + e] = (bf16)f2bf(v); }
            wg_barrier();
        }
    }
}

typedef float f32x2_t __attribute__((ext_vector_type(2))); typedef __bf16 bf16x2_t __attribute__((ext_vector_type(2)));
__device__ __forceinline__ unsigned cvtpk(float lo, float hi) { const f32x2_t v = {lo, hi}; const bf16x2_t b = __builtin_convertvector(v, bf16x2_t); return __builtin_bit_cast(unsigned, b); }
constexpr float C2 = 0.125f * 1.4426950408889634f;

__device__ __forceinline__ unsigned idxmask(int x, int hi) {
    unsigned m = 0u;
#pragma unroll
    for (int g = 0; g < 4; ++g) { int n = x - (8 * g + 4 * hi); n = n < 0 ? 0 : (n > 4 ? 4 : n); m |= ((1u << n) - 1u) << (4 * g); }
    return m;
}

constexpr int SEL_QF = 0, SEL_PART = 16384, SEL_HIST = 20480, SEL_HP = 260, SEL_RES = SEL_HIST + 32 * SEL_HP * 4;
__device__ __forceinline__ void dsa_select_unit(unsigned char* ws_, int tid_, int b, int qt32, LAS unsigned char* lds) {
    asm volatile("" : "+v"(tid_)); asm volatile("" : "+s"(ws_));
    const int lane = tid_ & 63, wid = __builtin_amdgcn_readfirstlane(tid_ >> 6), r32 = lane & 31, hi = lane >> 5;
    unsigned* maskbuf = (unsigned*)(ws_ + WS_MASK);
    if (qt32 < 8) {
        for (int i = tid_; i < 2048; i += 512) { const int qq = i >> 6, blk = i & 63; const int t = 32 * qt32 + qq; const int d = t - 32 * blk;
            const unsigned w = d < 0 ? 0u : (d >= 31 ? 0xffffffffu : ((2u << d) - 1u));
            maskbuf[((size_t)b * S + t) * 64 + blk] = w; }
        return;
    }
    const size_t qrow = (size_t)b * S + 32 * qt32 + r32;
    const bf16* prow = B_PROJ + qrow * NP;
    {
        const int h = wid >> 1, sk = wid & 1;
        const v4u raw = *(const v4u*)(prow + C_QIDX + h * 32 + 16 * sk + 8 * hi);
        float x[8] = {bflo(raw.x), bfhi(raw.x), bflo(raw.y), bfhi(raw.y), bflo(raw.z), bfhi(raw.z), bflo(raw.w), bfhi(raw.w)};
        if (sk == 0 && hi == 0) { const float* tab = B_ROPE + qrow * 24;
#pragma unroll
            for (int i = 0; i < 4; ++i) { const float c = tab[16 + i], sn = tab[20 + i]; const float x1 = x[i], x2 = x[4 + i]; x[i] = x1 * c - x2 * sn; x[4 + i] = x1 * sn + x2 * c; } }
        v4u hp, lp;
        { unsigned hh[4], ll[4];
#pragma unroll
          for (int k = 0; k < 4; ++k) { const float a = x[2 * k], bb = x[2 * k + 1]; const unsigned ha = f2bf(a), hb = f2bf(bb); hh[k] = ha | (hb << 16);
              ll[k] = pk2(a - bf2f((bf16)ha), bb - bf2f((bf16)hb)); }
          hp = (v4u){hh[0], hh[1], hh[2], hh[3]}; lp = (v4u){ll[0], ll[1], ll[2], ll[3]}; }
        LAS v4u* qf = (LAS v4u*)(lds + SEL_QF);
        qf[((h * 2 + sk) * 2 + 0) * 64 + lane] = hp; qf[((h * 2 + sk) * 2 + 1) * 64 + lane] = lp;
    }
    float w[4];
#pragma unroll
    for (int h = 0; h < 4; ++h) w[h] = bf2f(prow[C_WIDX + h]);
    __syncthreads();
    const int nblk = qt32 + 1;
    const bf16* kbase = B_PROJ + (size_t)b * S * NP + C_KIDX;
    unsigned key[8][16];
#pragma unroll
    for (int i = 0; i < 8; ++i) {
        const int blk = wid + 8 * i;
        if (blk < nblk) {
            const bf16* kp = kbase + (size_t)(32 * blk + r32) * NP + 8 * hi;
            const bf16x8 kf0 = *(const bf16x8*)kp, kf1 = *(const bf16x8*)(kp + 16);
            float sc[16];
            const LAS bf16x8* qf = (const LAS bf16x8*)(lds + SEL_QF);
#pragma unroll
            for (int h = 0; h < 4; ++h) {
                f32x16 acc = {};
                acc = MFMA32(kf0, qf[((h * 2 + 0) * 2 + 0) * 64 + lane], acc);
                acc = MFMA32(kf1, qf[((h * 2 + 1) * 2 + 0) * 64 + lane], acc);
                acc = MFMA32(kf0, qf[((h * 2 + 0) * 2 + 1) * 64 + lane], acc);
                acc = MFMA32(kf1, qf[((h * 2 + 1) * 2 + 1) * 64 + lane], acc);
#pragma unroll
                for (int r = 0; r < 16; ++r) sc[r] = (h == 0) ? w[0] * fmaxf(acc[r], 0.f) : fmaf(w[h], fmaxf(acc[r], 0.f), sc[r]);
            }
#pragma unroll
            for (int r = 0; r < 16; ++r) {
                unsigned bits = __builtin_bit_cast(unsigned, sc[r]);
                if (bits == 0x80000000u) bits = 0u;
                unsigned k = (bits & 0x80000000u) ? ~bits : (bits | 0x80000000u);
                if (blk == qt32 && crow(r, hi) > r32) k = 0u;
                key[i][r] = k;
            }
        } else {
#pragma unroll
            for (int r = 0; r < 16; ++r) key[i][r] = 0u;
        }
    }
    LAS unsigned* part = (LAS unsigned*)(lds + SEL_PART);
    int pbi = 0;
#define SEL_REDUCE(cnt_, tot_) do { LAS unsigned* pb_ = part + (pbi & 1) * 512; ++pbi; pb_[wid * 64 + lane] = (cnt_); wg_barrier(); unsigned t_ = 0u; \
        _Pragma("unroll") for (int w8 = 0; w8 < 8; ++w8) t_ += pb_[w8 * 64 + r32] + pb_[w8 * 64 + 32 + r32]; (tot_) = t_; } while (0)
    LAS unsigned* hist = (LAS unsigned*)(lds + SEL_HIST);
    LAS unsigned* resd = (LAS unsigned*)(lds + SEL_RES);
    for (int i = tid_; i < 32 * SEL_HP / 4; i += 512) ((LAS v4u*)hist)[i] = (v4u){0u, 0u, 0u, 0u};
    wg_barrier();
    unsigned pfx = 0u, need = 256u;
    LAS unsigned* hrow = hist + r32 * SEL_HP;
#pragma unroll 1
    for (int pass = 0; pass < 4; ++pass) {
        const int shift = 24 - 8 * pass;
#pragma unroll
        for (int i = 0; i < 8; ++i) if (wid + 8 * i < nblk) {
#pragma unroll
            for (int r = 0; r < 16; ++r) {
                const unsigned k = key[i][r];
                const unsigned dg = (k >> shift) & 255u;
                const bool match = (pass == 0) || ((k >> (shift + 8)) == pfx);
                __hip_atomic_fetch_add(hrow + (match ? dg : 256u), 1u, __ATOMIC_RELAXED, __HIP_MEMORY_SCOPE_WORKGROUP);
            } }
        wg_barrier();
#pragma unroll 1
        for (int qq = 0; qq < 4; ++qq) {
            const int q = 4 * wid + qq;
            LAS v4u* hq = (LAS v4u*)(hist + q * SEL_HP) + lane;
            const v4u h4 = *hq;
            unsigned T = (h4.x + h4.y) + (h4.z + h4.w);
#pragma unroll
            for (int off = 1; off < 64; off <<= 1) { const unsigned t_ = (unsigned)__shfl_down((int)T, off); if (lane + off < 64) T += t_; }
            const unsigned needq = (pass == 0) ? 256u : resd[32 + q];
            const unsigned long long bal = __ballot(T >= needq);
            const int Ls = 63 - __builtin_clzll(bal | 1ull);
            const unsigned above = (unsigned)__shfl((int)T, (Ls + 1) & 63);
            if (lane == Ls) {
                const unsigned ab0 = (Ls < 63) ? above : 0u;
                const unsigned rem = needq - ab0; const unsigned c3 = h4.w, c2 = c3 + h4.z, c1 = c2 + h4.y;
                int d; unsigned ab;
                if (rem <= c3) { d = 3; ab = 0u; } else if (rem <= c2) { d = 2; ab = c3; } else if (rem <= c1) { d = 1; ab = c2; } else { d = 0; ab = c1; }
                resd[q] = (unsigned)(4 * Ls + d); resd[32 + q] = rem - ab;
            }
            *hq = (v4u){0u, 0u, 0u, 0u};
            if (lane == 0) hist[q * SEL_HP + 256] = 0u;
        }
        wg_barrier();
        pfx = (pfx << 8) | resd[r32]; need = resd[32 + r32];
    }
    const unsigned thr = pfx;
    unsigned gtm[8], eqm[8];
#pragma unroll
    for (int i = 0; i < 8; ++i) { unsigned g = 0u, e = 0u;
        if (wid + 8 * i < nblk) {
#pragma unroll
            for (int r = 0; r < 16; ++r) { g |= (key[i][r] > thr) ? (1u << r) : 0u; e |= (key[i][r] == thr) ? (1u << r) : 0u; } }
        gtm[i] = g; eqm[i] = e; }
    const unsigned rneed = need;
    unsigned Y = 0u;
    for (int bit = 10; bit >= 0; --bit) {
        const unsigned c = Y | (1u << bit);
        unsigned cnt = 0u;
#pragma unroll
        for (int i = 0; i < 8; ++i) cnt += __builtin_popcount(eqm[i] & idxmask((int)c - 32 * (wid + 8 * i), hi));
        unsigned tot; SEL_REDUCE(cnt, tot);
        if (tot < rneed) Y = c;
    }
#undef SEL_REDUCE
#pragma unroll
    for (int i = 0; i < 8; ++i) {
        const int blk = wid + 8 * i;
        const unsigned selm = gtm[i] | (eqm[i] & idxmask((int)Y + 1 - 32 * blk, hi));
        unsigned word = ((selm & 0xFu) | ((selm & 0xF0u) << 4) | ((selm & 0xF00u) << 8) | ((selm & 0xF000u) << 12)) << (4 * hi);
        word = or_halves(word);
        if (hi == 0) maskbuf[qrow * 64 + blk] = word;
    }
    __syncthreads();
}

constexpr int AT_K = 0, AT_V = 24576, AT_WS = 49152;
__device__ __forceinline__ void pv(f32x16* o, f32x16& lacc, unsigned vb, bf16x8 pa0, bf16x8 pa1, bf16x8 pa2, bf16x8 pa3) {
    { const bf16x8 ones = {0x3F80, 0x3F80, 0x3F80, 0x3F80, 0x3F80, 0x3F80, 0x3F80, 0x3F80};
      lacc = MFMA32(pa0, ones, lacc); lacc = MFMA32(pa1, ones, lacc); lacc = MFMA32(pa2, ones, lacc); lacc = MFMA32(pa3, ones, lacc); }
#pragma unroll
    for (int d0 = 0; d0 < 2; ++d0) { s16x4 lo0, lo1, lo2, lo3, hi0, hi1, hi2, hi3;
        asm volatile("ds_read_b64_tr_b16 %0,%8 offset:%c9\n\tds_read_b64_tr_b16 %1,%8 offset:%c10\n\tds_read_b64_tr_b16 %2,%8 offset:%c11\n\tds_read_b64_tr_b16 %3,%8 offset:%c12\n\t"
                     "ds_read_b64_tr_b16 %4,%8 offset:%c13\n\tds_read_b64_tr_b16 %5,%8 offset:%c14\n\tds_read_b64_tr_b16 %6,%8 offset:%c15\n\tds_read_b64_tr_b16 %7,%8 offset:%c16\n\t"
                     "s_waitcnt lgkmcnt(0)"
                     : "=&v"(lo0), "=&v"(hi0), "=&v"(lo1), "=&v"(hi1), "=&v"(lo2), "=&v"(hi2), "=&v"(lo3), "=&v"(hi3)
                     : "v"(vb), "i"(d0 * 4096 + 0), "i"(d0 * 4096 + 512), "i"(d0 * 4096 + 1024), "i"(d0 * 4096 + 1536), "i"(d0 * 4096 + 2048), "i"(d0 * 4096 + 2560), "i"(d0 * 4096 + 3072), "i"(d0 * 4096 + 3584)
                     : "memory");
#define PKV(l_, h_) (bf16x8){l_[0], l_[1], l_[2], l_[3], h_[0], h_[1], h_[2], h_[3]}
        o[d0] = MFMA32(pa0, PKV(lo0, hi0), o[d0]);
        o[d0] = MFMA32(pa1, PKV(lo1, hi1), o[d0]);
        o[d0] = MFMA32(pa2, PKV(lo2, hi2), o[d0]);
        o[d0] = MFMA32(pa3, PKV(lo3, hi3), o[d0]);
#undef PKV
    }
}
struct SmState { float mhat; f32x16 o[2]; f32x16 lacc; };
__device__ __forceinline__ unsigned bfe1(unsigned w, int c) { int r; asm("v_bfe_i32 %0, %1, %2, 1" : "=v"(r) : "v"(w), "n"(c)); return (unsigned)r; }
__device__ __forceinline__ float rowmax32(const f32x16& p0, const f32x16& p1) {
    float a = fmaxf(p0[0], p1[0]);
#pragma unroll
    for (int r = 1; r < 16; ++r) a = fmaxf(a, fmaxf(p0[r], p1[r]));
    return max_halves(a);
}
constexpr int NS_QF = 53248, NS_SELS = 86016, NS_SSUM = 118784, NS_SELM = 126976;
__device__ __forceinline__ unsigned range32(int lo, int up) {
    const int l2 = lo < 0 ? 0 : lo, u2 = up > 31 ? 31 : up;
    const unsigned hm = (u2 >= 31) ? ~0u : ((2u << (u2 & 31)) - 1u);
    const unsigned lm = (1u << (l2 & 31)) - 1u;
    return (up < 0 || lo > 31 || u2 < l2) ? 0u : (hm & ~lm);
}
struct M64 { unsigned x, y; };
__device__ __forceinline__ M64 mask_range(int lo, int up) { M64 m; m.x = range32(lo, up); m.y = range32(lo - 32, up - 32); return m; }
__device__ __forceinline__ void load_q(bf16x8* qr, const bf16* qp, const float* tab, bool rope, int hi) {
#pragma unroll
    for (int d0 = 0; d0 < 4; ++d0) {
        const v4u raw = *(const v4u*)(qp + 16 * d0);
        float x[8] = {bflo(raw.x), bfhi(raw.x), bflo(raw.y), bfhi(raw.y), bflo(raw.z), bfhi(raw.z), bflo(raw.w), bfhi(raw.w)};
        if (d0 == 0) {
#pragma unroll
            for (int j = 0; j < 8; ++j) { const float other = other_half_f(x[j], hi); const float c = tab[j], sn = tab[8 + j];
                const float rot = (hi == 0) ? (x[j] * c - other * sn) : (other * sn + x[j] * c); x[j] = rope ? rot : x[j]; }
        }
        v4u pk; pk.x = cvtpk(x[0] * C2, x[1] * C2); pk.y = cvtpk(x[2] * C2, x[3] * C2); pk.z = cvtpk(x[4] * C2, x[5] * C2); pk.w = cvtpk(x[6] * C2, x[7] * C2);
        qr[d0] = __builtin_bit_cast(bf16x8, pk);
    }
}
__device__ __forceinline__ void qkt_lq(f32x16& p0, f32x16& p1, const LAS unsigned char* Kslot, const LAS bf16x8* qf, int lane, int r32, int hi) {
    const LAS unsigned char* kb = Kslot + hi * 1024 + r32 * 16;
    p0 = f32x16{}; p1 = f32x16{};
#pragma unroll
    for (int d0 = 0; d0 < 4; ++d0) {
        const bf16x8 b0 = *(const LAS bf16x8*)(kb + d0 * 2048);
        const bf16x8 b1 = *(const LAS bf16x8*)(kb + d0 * 2048 + 512);
        const bf16x8 q = qf[d0 * 64 + lane];
        p0 = MFMA32(b0, q, p0); p1 = MFMA32(b1, q, p1);
    }
}
template <bool SEL>
__device__ __forceinline__ void softmax_pv(SmState& st, f32x16& osel, f32x16& p0, f32x16& p1, unsigned vb, const M64 mcur, bool first, LAS float* wsf, int r32, int hi, int ctile) {
    if (first) {
        float rm = fmaxf(p0[0], p1[0]);
#pragma unroll
        for (int r = 1; r < 16; ++r) rm = fmaxf(rm, fmaxf(p0[r], p1[r]));
        st.mhat = max_halves(rm);
    }
    {
        const float mh0 = st.mhat;
#pragma unroll
        for (int r = 0; r < 16; ++r) { p0[r] -= mh0; p1[r] -= mh0; }
    }
    const unsigned wx = mcur.x >> (4 * hi), wy = mcur.y >> (4 * hi);
#pragma unroll
    for (int r = 0; r < 16; ++r) {
        const int c = (r & 3) + 8 * (r >> 2);
        p0[r] = __builtin_bit_cast(float, __builtin_bit_cast(unsigned, __builtin_amdgcn_exp2f(p0[r])) & bfe1(wx, c));
        p1[r] = __builtin_bit_cast(float, __builtin_bit_cast(unsigned, __builtin_amdgcn_exp2f(p1[r])) & bfe1(wy, c));
    }
    unsigned pw[16];
#pragma unroll
    for (int k = 0; k < 8; ++k) { pw[k] = cvtpk(p0[2 * k], p0[2 * k + 1]); pw[8 + k] = cvtpk(p1[2 * k], p1[2 * k + 1]); }
    if (SEL) {
#pragma unroll
        for (int ks = 0; ks < 4; ++ks) {
            unsigned ov[4], pl[4];
#pragma unroll
            for (int k = 0; k < 4; ++k) {
                const int j0 = 2 * k, j1 = 2 * k + 1;
                const int c0 = 64 * ctile + 16 * ks + 8 * (j0 >> 2) + 4 * hi + (j0 & 3), c1 = 64 * ctile + 16 * ks + 8 * (j1 >> 2) + 4 * hi + (j1 & 3);
                const unsigned a = (c0 >= 4 * r32 - 1 && c0 <= 4 * r32 + 3) ? 0x3F80u : 0u, bq = (c1 >= 4 * r32 - 1 && c1 <= 4 * r32 + 3) ? 0x3F80u : 0u;
                ov[k] = a | (bq << 16);
                const int e = 4 * ks + k;
                const float v0 = (e < 8) ? p0[2 * e] : p1[2 * (e - 8)], v1 = (e < 8) ? p0[2 * e + 1] : p1[2 * (e - 8) + 1];
                pl[k] = cvtpk(v0 - bflo(pw[e]), v1 - bfhi(pw[e]));
            }
            const bf16x8 ovf = __builtin_bit_cast(bf16x8, (v4u){ov[0], ov[1], ov[2], ov[3]});
            osel = MFMA32(__builtin_bit_cast(bf16x8, (v4u){pw[4 * ks], pw[4 * ks + 1], pw[4 * ks + 2], pw[4 * ks + 3]}), ovf, osel);
            osel = MFMA32(__builtin_bit_cast(bf16x8, (v4u){pl[0], pl[1], pl[2], pl[3]}), ovf, osel);
        }
    }
    pv(st.o, st.lacc, vb, __builtin_bit_cast(bf16x8, (v4u){pw[0], pw[1], pw[2], pw[3]}), __builtin_bit_cast(bf16x8, (v4u){pw[4], pw[5], pw[6], pw[7]}),
       __builtin_bit_cast(bf16x8, (v4u){pw[8], pw[9], pw[10], pw[11]}), __builtin_bit_cast(bf16x8, (v4u){pw[12], pw[13], pw[14], pw[15]}));
}
template <bool SEL>
__device__ __forceinline__ void tile_step(SmState& st, f32x16& osel, const LAS unsigned char* Kslot, unsigned vb, const LAS bf16x8* qf, const M64 mcur, bool first, LAS float* wsf, int lane, int r32, int hi, int ctile) {
    f32x16 p0, p1;
    qkt_lq(p0, p1, Kslot, qf, lane, r32, hi);
    softmax_pv<SEL>(st, osel, p0, p1, vb, mcur, first, wsf, r32, hi, ctile);
}
__device__ __forceinline__ void qkt_rq(f32x16& p0, f32x16& p1, const LAS unsigned char* Kslot, const bf16x8* qr, int r32, int hi) {
    const LAS unsigned char* kb = Kslot + hi * 1024 + r32 * 16;
    p0 = f32x16{}; p1 = f32x16{};
#pragma unroll
    for (int d0 = 0; d0 < 4; ++d0) {
        const bf16x8 b0 = *(const LAS bf16x8*)(kb + d0 * 2048);
        const bf16x8 b1 = *(const LAS bf16x8*)(kb + d0 * 2048 + 512);
        p0 = MFMA32(b0, qr[d0], p0); p1 = MFMA32(b1, qr[d0], p1);
    }
}
__device__ __forceinline__ void sm_reset(SmState& st) { st.mhat = 0.f; st.o[0] = f32x16{}; st.o[1] = f32x16{}; st.lacc = f32x16{}; }
__device__ __forceinline__ float sigmoidf_(float x) { return 1.f / (1.f + __expf(-x)); }

__device__ __forceinline__ void dsa_attn_unit(unsigned char* ws_, int tid_, int b, int qt, LAS unsigned char* lds) {
    asm volatile("" : "+v"(tid_)); asm volatile("" : "+s"(ws_));
    const int lane = tid_ & 63, wid = __builtin_amdgcn_readfirstlane(tid_ >> 6), r32 = lane & 31, hi = lane >> 5;
    const int h = wid >> 1, qh = wid & 1;
    const size_t qrow = (size_t)b * S + 64 * qt + 32 * qh + r32;
    LAS float* wsf = (LAS float*)(lds + AT_WS) + wid * 128;
    bf16x8 qr[4];
    {
        const bf16* qp = B_PROJ + qrow * NP + C_QA + h * 64 + 8 * hi;
        const float* tab = B_ROPE + qrow * 24;
#pragma unroll
        for (int d0 = 0; d0 < 4; ++d0) {
            const v4u raw = *(const v4u*)(qp + 16 * d0);
            float x[8] = {bflo(raw.x), bfhi(raw.x), bflo(raw.y), bfhi(raw.y), bflo(raw.z), bfhi(raw.z), bflo(raw.w), bfhi(raw.w)};
            if (d0 == 0) {
#pragma unroll
                for (int j = 0; j < 8; ++j) { const float other = other_half_f(x[j], hi); const float c = tab[j], sn = tab[8 + j];
                    x[j] = (hi == 0) ? (x[j] * c - other * sn) : (other * sn + x[j] * c); }
            }
            v4u pk; pk.x = cvtpk(x[0] * C2, x[1] * C2); pk.y = cvtpk(x[2] * C2, x[3] * C2); pk.z = cvtpk(x[4] * C2, x[5] * C2); pk.w = cvtpk(x[6] * C2, x[7] * C2);
            qr[d0] = __builtin_bit_cast(bf16x8, pk);
        }
    }
    LAS bf16x8* qf = (LAS bf16x8*)(lds + NS_QF) + wid * 256;
#pragma unroll
    for (int d0 = 0; d0 < 4; ++d0) qf[d0 * 64 + lane] = qr[d0];
    const bf16* KAb = B_PROJ + (size_t)b * S * NP;
    const bf16* ksrc = KAb + (size_t)lane * NP + C_KA + wid * 8;
    const bf16* vsrc = KAb + (size_t)(16 * (wid & 3) + (lane >> 2)) * NP + C_VA + (wid >> 2) * 32 + (lane & 3) * 8;
#define AT_DMA(t, slot) do { \
        __builtin_amdgcn_global_load_lds((const unsigned*)(ksrc + (size_t)(t) * 64 * NP), (LAS unsigned*)(lds + AT_K + (slot) * 8192 + wid * 1024), 16, 0, 0); \
        __builtin_amdgcn_global_load_lds((const unsigned*)(vsrc + (size_t)(t) * 64 * NP), (LAS unsigned*)(lds + AT_V + (slot) * 8192 + wid * 1024), 16, 0, 0); } while (0)
    const unsigned vb0 = (unsigned)(uintptr_t)(lds + AT_V) + ((lane >> 4) & 1) * 32 + (lane & 3) * 8 + (4 * hi + ((lane & 15) >> 2)) * 64;
    const int NT = qt + 1;
    SmState st; sm_reset(st);
    const unsigned long long* mrow = (const unsigned long long*)((const unsigned*)(ws_ + WS_MASK) + qrow * 64);
    AT_DMA(0, 0);
    unsigned long long m0 = mrow[0], m1 = 0ull, m2 = 0ull;
    if (NT > 1) { AT_DMA(1, 1); m1 = mrow[1]; }
    int cs = 0, is = 2;
    f32x16 osel_unused = {};
#define AT_NEXT(c_) (((c_) == 2) ? 0 : (c_) + 1)
    for (int t = 0; t < NT; ++t) {
        asm volatile("s_waitcnt vmcnt(0)" ::: "memory"); wg_barrier();
        if (t + 2 < NT) { AT_DMA(t + 2, is); m2 = mrow[t + 2]; }
        const unsigned long long mcur_ = m0; m0 = m1; m1 = m2;
        f32x16 p0, p1;
        qkt_lq(p0, p1, lds + AT_K + cs * 8192, qf, lane, r32, hi);
        softmax_pv<false>(st, osel_unused, p0, p1, vb0 + cs * 8192, (M64){(unsigned)mcur_, (unsigned)(mcur_ >> 32)}, t == 0, wsf, r32, hi, 0);
        cs = AT_NEXT(cs); is = AT_NEXT(is);
    }
#undef AT_NEXT
#undef AT_DMA
    {
        bf16* ob = B_MIX + ((size_t)b * S + 64 * qt + 32 * qh) * D + h * 64 + r32;
#pragma unroll
        for (int r = 0; r < 16; ++r) { const int rq = crow(r, hi); const float f = __builtin_amdgcn_rcpf(st.lacc[r]);
            ob[(size_t)rq * D] = (bf16)f2bf(st.o[0][r] * f); ob[(size_t)rq * D + 32] = (bf16)f2bf(st.o[1][r] * f); }
    }
    __syncthreads();
}


template <bool SEL>
__device__ __forceinline__ void nsa_unit(unsigned char* ws_, int tid_, int b, int g, int qt, LAS unsigned char* lds) {
    asm volatile("" : "+v"(tid_)); asm volatile("" : "+s"(ws_));
    const int lane = tid_ & 63, wid = __builtin_amdgcn_readfirstlane(tid_ >> 6), r32 = lane & 31, hi = lane >> 5;
    const int hr = wid >> 1, qh = wid & 1, H = 4 * g + hr;
    const int tq = 64 * qt + 32 * qh + r32;
    const size_t qrow = (size_t)b * S + tq;
    LAS float* wsf = (LAS float*)(lds + AT_WS) + wid * 128;
    const unsigned vb0 = (unsigned)(uintptr_t)(lds + AT_V) + ((lane >> 4) & 1) * 32 + (lane & 3) * 8 + (4 * hi + ((lane & 15) >> 2)) * 64;
    const bf16* kcb = (const bf16*)(ws_ + WS_KCB) + (size_t)(b * 2 + g) * 128 * 64;
    const bf16* vcb = (const bf16*)(ws_ + WS_VCB) + (size_t)(b * 2 + g) * 128 * 64;
    const bf16* pb = B_PROJ + (size_t)b * S * NP + g * 64;
    const int vrow = 16 * (wid & 3) + (lane >> 2), vcol = (wid >> 2) * 32 + (lane & 3) * 8;
#define NS_DMA(kp_, vp_, slot_) do { \
        __builtin_amdgcn_global_load_lds((const unsigned*)(kp_), (LAS unsigned*)(lds + AT_K + (slot_) * 8192 + wid * 1024), 16, 0, 0); \
        __builtin_amdgcn_global_load_lds((const unsigned*)(vp_), (LAS unsigned*)(lds + AT_V + (slot_) * 8192 + wid * 1024), 16, 0, 0); } while (0)
#define NS_DMA_CMP(i_, slot_) NS_DMA(kcb + (size_t)(64 * (i_) + lane) * 64 + wid * 8, vcb + (size_t)(64 * (i_) + vrow) * 64 + vcol, slot_)
#define NS_DMA_PROJ(ck_, cv_, j_, slot_) NS_DMA(pb + (size_t)(64 * (j_) + lane) * NP + (ck_) + wid * 8, pb + (size_t)(64 * (j_) + vrow) * NP + (cv_) + vcol, slot_)
    const int ncmp = (qt >= 16) ? 2 : 1;
    const int jw0 = (qt > 8) ? qt - 8 : 0, nwin = qt - jw0 + 1;
    if (hi == 0) { const bf16* gp = B_PROJ + qrow * NP + C_GATE + H * 3;
        wsf[64 + r32] = sigmoidf_(bf2f(gp[0])); wsf[96 + r32] = sigmoidf_(bf2f(gp[2])); wsf[32 + r32] = sigmoidf_(bf2f(gp[1])); }
    int nissued = 0, islot = 0, ti = 0, cslot = 0;
    unsigned remI = SEL ? 0u : ((2u << qt) - 1u);
#define NS_ISSUE() do { \
        if (nissued < ncmp) { NS_DMA_CMP(nissued, islot); } \
        else if (nissued < ncmp + nwin) { NS_DMA_PROJ(C_KWIN, C_VWIN, jw0 + nissued - ncmp, islot); } \
        else if (remI) { const int j_ = __builtin_ctz(remI); remI &= remI - 1u; NS_DMA_PROJ(C_KSLC, C_VSLC, j_, islot); } \
        else break; \
        ++nissued; islot = (islot == 2) ? 0 : islot + 1; } while (0)
#define NS_TOP() do { asm volatile("s_waitcnt vmcnt(0)" ::: "memory"); wg_barrier(); NS_ISSUE(); } while (0)
#define NS_ADV() do { ++ti; cslot = (cslot == 2) ? 0 : cslot + 1; } while (0)
    NS_ISSUE(); NS_ISSUE();
    LAS bf16x8* qf = (LAS bf16x8*)(lds + NS_QF) + wid * 256;
    { bf16x8 qr[4]; load_q(qr, B_PROJ + qrow * NP + C_QB + H * 64 + 8 * hi, B_ROPE + qrow * 24, false, hi);
#pragma unroll
      for (int d0 = 0; d0 < 4; ++d0) qf[d0 * 64 + lane] = qr[d0]; }
    SmState st; sm_reset(st);
    f32x16 osel = {};
    unsigned oaccp[16];
    const int ncv = (tq >= 31) ? (((tq - 31) >> 4) + 1) : 0;
    for (int i = 0; i < ncmp; ++i) {
        NS_TOP();
        const M64 m = mask_range(0, ncv - 64 * i - 1);
        tile_step<SEL>(st, osel, lds + AT_K + cslot * 8192, vb0 + cslot * 8192, qf, m, i == 0, wsf, lane, r32, hi, i);
        NS_ADV();
    }
    {
        asm volatile("s_waitcnt lgkmcnt(0)" ::: "memory");
        LAS float* sels = (LAS float*)(lds + NS_SELS);
#pragma unroll
        for (int r = 0; r < 16; ++r) { const int rq = crow(r, hi); const float lt = st.lacc[r]; const float inv = lt > 0.f ? __builtin_amdgcn_rcpf(lt) : 0.f; const float f2 = wsf[64 + rq] * inv;
            oaccp[r] = cvtpk(st.o[0][r] * f2, st.o[1][r] * f2);
            if (SEL) sels[(hr * 64 + 32 * qh + rq) * 32 + r32] = osel[r] * inv; }
        asm volatile("s_waitcnt lgkmcnt(0)" ::: "memory");
    }
    unsigned mysel, selunion;
    if (SEL) {
        wg_barrier();
        LAS float* sels = (LAS float*)(lds + NS_SELS);
        LAS float* ssum = (LAS float*)(lds + NS_SSUM);
        LAS unsigned* selm = (LAS unsigned*)(lds + NS_SELM);
        const int q = tid_ >> 3, jg = tid_ & 7;
        f32x4 s4 = *(const LAS f32x4*)(sels + (0 * 64 + q) * 32 + 4 * jg);
        s4 += *(const LAS f32x4*)(sels + (1 * 64 + q) * 32 + 4 * jg);
        s4 += *(const LAS f32x4*)(sels + (2 * 64 + q) * 32 + 4 * jg);
        s4 += *(const LAS f32x4*)(sels + (3 * 64 + q) * 32 + 4 * jg);
        *(LAS f32x4*)(ssum + q * 32 + 4 * jg) = s4;
        asm volatile("s_waitcnt lgkmcnt(0)" ::: "memory");
        float sv[32];
#pragma unroll
        for (int k = 0; k < 8; ++k) { const f32x4 v = *(const LAS f32x4*)(ssum + q * 32 + 4 * k); sv[4 * k] = v.x; sv[4 * k + 1] = v.y; sv[4 * k + 2] = v.z; sv[4 * k + 3] = v.w; }
        const float PINF = __builtin_inff();
#pragma unroll
        for (int i = 0; i < 32; ++i) sv[i] = (i > qt) ? -PINF : ((i == 0 || i == qt || i == qt - 1) ? PINF : sv[i]);
        unsigned bits4 = 0u;
#pragma unroll
        for (int jj = 0; jj < 4; ++jj) {
            const int j = 4 * jg + jj;
            float mine = (jj == 0) ? s4.x : (jj == 1) ? s4.y : (jj == 2) ? s4.z : s4.w;
            mine = (j > qt) ? -PINF : ((j == 0 || j == qt || j == qt - 1) ? PINF : mine);
            int rank = 0;
#pragma unroll
            for (int i = 0; i < 32; ++i) rank += ((sv[i] > mine) || (sv[i] == mine && i < j)) ? 1 : 0;
            bits4 |= (rank < 16) ? (1u << jj) : 0u;
        }
        unsigned mm = bits4 << (4 * jg);
        mm |= (unsigned)dpp_i<0xB1>((int)mm); mm |= (unsigned)dpp_i<0x4E>((int)mm); mm |= (unsigned)dpp_i<0x141>((int)mm);
        if (jg == 0) selm[q] = mm;
        wg_barrier();
        unsigned u = selm[lane];
        u = or_halves(or32(u));
        selunion = (unsigned)__builtin_amdgcn_readfirstlane((int)u);
        mysel = selm[32 * qh + r32];
    } else {
        mysel = selunion = (2u << qt) - 1u;
    }
    { bf16x8 qr[4]; load_q(qr, B_PROJ + qrow * NP + C_QB + H * 64 + 8 * hi, B_ROPE + qrow * 24, true, hi);
#pragma unroll
      for (int d0 = 0; d0 < 4; ++d0) qf[d0 * 64 + lane] = qr[d0]; }
    sm_reset(st);
    if (SEL) remI = selunion;
    for (int j = jw0; j <= qt; ++j) {
        NS_TOP();
        const M64 m = mask_range(tq - 511 - 64 * j, tq - 64 * j);
        tile_step<false>(st, osel, lds + AT_K + cslot * 8192, vb0 + cslot * 8192, qf, m, j == jw0, wsf, lane, r32, hi, 0);
        NS_ADV();
    }
    {
        asm volatile("s_waitcnt lgkmcnt(0)" ::: "memory");
#pragma unroll
        for (int r = 0; r < 16; ++r) { const float lt = st.lacc[r]; const float f2 = lt > 0.f ? wsf[96 + crow(r, hi)] * __builtin_amdgcn_rcpf(lt) : 0.f; oaccp[r] = cvtpk(bflo(oaccp[r]) + st.o[0][r] * f2, bfhi(oaccp[r]) + st.o[1][r] * f2); }
        asm volatile("s_waitcnt lgkmcnt(0)" ::: "memory");
    }
    sm_reset(st);
    bool firstb = true;
    unsigned rem = selunion;
    while (rem) {
        const int j = __builtin_ctz(rem); rem &= rem - 1u;
        NS_TOP();
        M64 m = mask_range(0, tq - 64 * j); if (!((mysel >> j) & 1u)) { m.x = 0u; m.y = 0u; }
        tile_step<false>(st, osel, lds + AT_K + cslot * 8192, vb0 + cslot * 8192, qf, m, firstb, wsf, lane, r32, hi, 0);
        firstb = false; NS_ADV();
    }
    {
        asm volatile("s_waitcnt lgkmcnt(0)" ::: "memory");
        bf16* ob = B_MIX + ((size_t)b * S + 64 * qt + 32 * qh) * D + 256 + H * 64 + r32;
#pragma unroll
        for (int r = 0; r < 16; ++r) { const int rq = crow(r, hi); const float lt = st.lacc[r]; const float f2 = lt > 0.f ? wsf[32 + rq] * __builtin_amdgcn_rcpf(lt) : 0.f;
            ob[(size_t)rq * D] = (bf16)f2bf(bflo(oaccp[r]) + st.o[0][r] * f2); ob[(size_t)rq * D + 32] = (bf16)f2bf(bfhi(oaccp[r]) + st.o[1][r] * f2); }
    }
    __syncthreads();
#undef NS_DMA
#undef NS_DMA_CMP
#undef NS_DMA_PROJ
#undef NS_ISSUE
#undef NS_TOP
#undef NS_ADV
}

__device__ __forceinline__ void phase_attn(Frame& F, int l) {
    (void)l;
    unsigned char* ws_ = F.ws; asm volatile("" : "+s"(ws_)); int lane_ = lane_id(); asm volatile("" : "+v"(lane_)); (void)ws_;
    int tid_ = F.wave * 64 + lane_id(); asm volatile("" : "+v"(tid_));
    for (int u = F.vcu; u < BATCH * 64; u += F.G) {
        const int c = u & 255, i = u >> 8; const int b = c >> 3, sft = c & 7; const int base = 16 * (i >> 1); const int qt32 = (i & 1) ? base + 15 - sft : base + sft;
        dsa_select_unit(ws_, tid_, b, qt32, F.lds);
    }
    __syncthreads();
#if PROBE_MASK
    if (blockIdx.x == 0 && F.wave == 0 && lane_id() == 0) { const unsigned long long ts_ = __builtin_amdgcn_s_memrealtime(); F.MISC[16] = (unsigned)ts_; F.MISC[17] = (unsigned)(ts_ >> 32); }
#endif
    for (int u = F.vcu; u < BATCH * 64; u += F.G) {
        const int c = u & 255, i = u >> 8; const int b = c >> 3, sft = c & 7; const int g = i & 1, k = i >> 1; const int base = 16 * (k >> 1); const int qt = (k & 1) ? base + 15 - sft : base + sft;
        if (qt >= 16) nsa_unit<true>(ws_, tid_, b, g, qt, F.lds); else nsa_unit<false>(ws_, tid_, b, g, qt, F.lds);
    }
}
__device__ __forceinline__ void phase_dsa_attn(Frame& F) {
    unsigned char* ws_ = F.ws; asm volatile("" : "+s"(ws_));
    int tid_ = F.wave * 64 + lane_id(); asm volatile("" : "+v"(tid_));
    for (int u = F.vcu; u < BATCH * 32; u += F.G) {
        const int c = u & 255, i = u >> 8; const int b = c >> 3, sft = c & 7; const int base = 16 * (i >> 1); const int qt = (i & 1) ? base + 15 - sft : base + sft;
        dsa_attn_unit(ws_, tid_, b, qt, F.lds);
    }
}

constexpr int WP_PITCH = 72;
__device__ __forceinline__ void phase_merge(Frame& F, const Args& args, int l) {
    unsigned char* ws_ = F.ws; asm volatile("" : "+s"(ws_)); int lane_ = lane_id(); asm volatile("" : "+v"(lane_)); (void)ws_;
    int tid_ = F.wave * 64 + lane_id(); asm volatile("" : "+v"(tid_));
    const int gw = F.vcu * NWAVES + F.wave, NGW = F.G * NWAVES, lane = lane_;
    const float* psc = P_POOL_SCALE + l * 256;
    const float* goa = P_G_OUT_A + l * 256; const float* gob = P_G_OUT_B + l * 512;
    LAS bf16* wp = (LAS bf16*)F.lds;
    {
        const float* wsrc = P_W_POOL + (size_t)l * 4 * 64 * 64;
        for (int idx = tid_; idx < 4 * 64 * 64; idx += 512) { const int g = idx >> 12, c = (idx >> 6) & 63, d = idx & 63; wp[(g * 64 + d) * WP_PITCH + c] = (bf16)f2bf(wsrc[idx]); }
    }
    {
        constexpr int RB = 4;
        const f32x4 gga = ((const f32x4*)goa)[lane]; const f32x4 gb0 = ((const f32x4*)gob)[2 * lane], gb1 = ((const f32x4*)gob)[2 * lane + 1];
        for (int row0 = gw * RB; row0 < M; row0 += NGW * RB) {
            unsigned long long ua[RB]; v4u ub[RB];
#pragma unroll
            for (int k = 0; k < RB; ++k) { const bf16* mrow = B_MIX + (size_t)(row0 + k) * D; ua[k] = *((const unsigned long long*)mrow + lane); ub[k] = *((const v4u*)(mrow + 256) + lane); }
#pragma unroll
            for (int k = 0; k < RB; ++k) { bf16* mrow = B_MIX + (size_t)(row0 + k) * D;
                { const unsigned long long u = ua[k];
                  const float a0 = bflo((unsigned)u), a1 = bfhi((unsigned)u), a2 = bflo((unsigned)(u >> 32)), a3 = bfhi((unsigned)(u >> 32));
                  const float rs = rsqrtf(wave_sum((a0 * a0 + a1 * a1) + (a2 * a2 + a3 * a3)) * (1.f / 256.f) + EPS);
                  *((unsigned long long*)mrow + lane) = (unsigned long long)pk2(a0 * rs * gga.x, a1 * rs * gga.y) | ((unsigned long long)pk2(a2 * rs * gga.z, a3 * rs * gga.w) << 32); }
                { const v4u u = ub[k];
                  float a[8] = {bflo(u.x), bfhi(u.x), bflo(u.y), bfhi(u.y), bflo(u.z), bfhi(u.z), bflo(u.w), bfhi(u.w)};
                  float ss = 0.f;
#pragma unroll
                  for (int i = 0; i < 8; ++i) ss += a[i] * a[i];
                  const float rs = rsqrtf(wave_sum(ss) * (1.f / 512.f) + EPS);
                  v4u o; o.x = pk2(a[0] * rs * gb0.x, a[1] * rs * gb0.y); o.y = pk2(a[2] * rs * gb0.z, a[3] * rs * gb0.w); o.z = pk2(a[4] * rs * gb1.x, a[5] * rs * gb1.y); o.w = pk2(a[6] * rs * gb1.z, a[7] * rs * gb1.w);
                  *((v4u*)(mrow + 256) + lane) = o; }
            }
        }
    }
    __syncthreads();
    {
        const int r32 = lane & 31, hi = lane >> 5;
        for (int tile = gw; tile < M / 32; tile += NGW) {
            const int row = 32 * tile + r32, t = row % S;
            const bf16* up = B_PROJ + (size_t)row * NP + C_UC + 8 * hi;
            f32x16 acc[4][2];
#pragma unroll
            for (int g = 0; g < 4; ++g) {
                acc[g][0] = f32x16{}; acc[g][1] = f32x16{};
                const int w = 2 << g;
                const float icnt = 1.f / (float)((t + 1 < w) ? t + 1 : w);
#pragma unroll
                for (int ks = 0; ks < 4; ++ks) {
                    const bf16* p0 = up + g * 64 + 16 * ks;
                    const v4u u0 = *(const v4u*)p0;
                    float cur[8] = {bflo(u0.x), bfhi(u0.x), bflo(u0.y), bfhi(u0.y), bflo(u0.z), bfhi(u0.z), bflo(u0.w), bfhi(u0.w)};
                    float sum[8];
#pragma unroll
                    for (int j = 0; j < 8; ++j) sum[j] = cur[j];
#pragma unroll
                    for (int i = 1; i < w; ++i) {
                        if (t - i >= 0) { const v4u ui = *(const v4u*)(p0 - (size_t)i * NP);
                            sum[0] += bflo(ui.x); sum[1] += bfhi(ui.x); sum[2] += bflo(ui.y); sum[3] += bfhi(ui.y); sum[4] += bflo(ui.z); sum[5] += bfhi(ui.z); sum[6] += bflo(ui.w); sum[7] += bfhi(ui.w); }
                    }
                    v4u pk; pk.x = cvtpk(sum[0] * icnt - cur[0], sum[1] * icnt - cur[1]); pk.y = cvtpk(sum[2] * icnt - cur[2], sum[3] * icnt - cur[3]);
                    pk.z = cvtpk(sum[4] * icnt - cur[4], sum[5] * icnt - cur[5]); pk.w = cvtpk(sum[6] * icnt - cur[6], sum[7] * icnt - cur[7]);
                    const bf16x8 af = __builtin_bit_cast(bf16x8, pk);
#pragma unroll
                    for (int nb = 0; nb < 2; ++nb) {
                        const bf16x8 bfr = *(const LAS bf16x8*)(wp + (g * 64 + 32 * nb + r32) * WP_PITCH + 16 * ks + 8 * hi);
                        acc[g][nb] = MFMA32(af, bfr, acc[g][nb]);
                    }
                }
            }
            float ss[16];
#pragma unroll
            for (int r = 0; r < 16; ++r) { float a = 0.f;
#pragma unroll
                for (int g = 0; g < 4; ++g) a += acc[g][0][r] * acc[g][0][r] + acc[g][1][r] * acc[g][1][r];
                a = sum32(a);
                ss[r] = rsqrtf(a * (1.f / 256.f) + EPS); }
            bf16* ob = B_MIX + (size_t)(32 * tile) * D + 768 + r32;
#pragma unroll
            for (int g = 0; g < 4; ++g)
#pragma unroll
                for (int nb = 0; nb < 2; ++nb) { const float sc = psc[g * 64 + 32 * nb + r32];
#pragma unroll
                    for (int r = 0; r < 16; ++r) ob[(size_t)crow(r, hi) * D + g * 64 + 32 * nb] = (bf16)f2bf(acc[g][nb][r] * ss[r] * sc); }
        }
    }
    __syncthreads();
}

template <bool XIN_F32, bool OUT_F32>
__device__ __forceinline__ void phase_finish(Frame& F, const float* xsrc, const float* gpost, const float* gnext  ) {
    unsigned char* ws_ = F.ws; asm volatile("" : "+s"(ws_)); int lane_ = lane_id(); asm volatile("" : "+v"(lane_)); (void)ws_;
    const int gw = F.vcu * NWAVES + F.wave, NGW = F.G * NWAVES, lane = lane_;
    bf16* xb = (bf16*)(ws_ + WS_XB);
    constexpr int RB = 4;
    for (int row0 = gw * RB; row0 < M; row0 += NGW * RB) {
        unsigned long long fu[RB][4]; f32x4 x[RB][4];
#pragma unroll
        for (int k = 0; k < RB; ++k) { const size_t row = (size_t)(row0 + k);
#pragma unroll
            for (int j = 0; j < 4; ++j) { fu[k][j] = ((const unsigned long long*)(B_F + row * D) + lane)[64 * j];
                if (XIN_F32) x[k][j] = ((const f32x4*)(xsrc + row * D) + lane)[64 * j];
                else { const unsigned long long ux = ((const unsigned long long*)(xb + row * D) + lane)[64 * j];
                       x[k][j] = (f32x4){bflo((unsigned)ux), bfhi((unsigned)ux), bflo((unsigned)(ux >> 32)), bfhi((unsigned)(ux >> 32))}; } } }
#pragma unroll
        for (int k = 0; k < RB; ++k) { const size_t row = (size_t)(row0 + k);
            f32x4 f[4]; float ss = 0.f;
#pragma unroll
            for (int j = 0; j < 4; ++j) { const unsigned long long u = fu[k][j];
                f[j] = (f32x4){bflo((unsigned)u), bfhi((unsigned)u), bflo((unsigned)(u >> 32)), bfhi((unsigned)(u >> 32))};
                ss += (f[j].x * f[j].x + f[j].y * f[j].y) + (f[j].z * f[j].z + f[j].w * f[j].w); }
            const float rs = rsqrtf(wave_sum(ss) * (1.f / D) + EPS);
            float s2 = 0.f;
#pragma unroll
            for (int j = 0; j < 4; ++j) { const f32x4 g = ((const f32x4*)gpost)[lane + 64 * j]; f32x4 xv = x[k][j];
                xv.x += f[j].x * rs * g.x; xv.y += f[j].y * rs * g.y; xv.z += f[j].z * rs * g.z; xv.w += f[j].w * rs * g.w;
                if (OUT_F32) ((f32x4*)(F.out + row * D) + lane)[64 * j] = xv;
                else ((unsigned long long*)(xb + row * D) + lane)[64 * j] = (unsigned long long)pk2(xv.x, xv.y) | ((unsigned long long)pk2(xv.z, xv.w) << 32);
                x[k][j] = xv;
                s2 += (xv.x * xv.x + xv.y * xv.y) + (xv.z * xv.z + xv.w * xv.w); }
            if (gnext) {
                const float r2 = rsqrtf(wave_sum(s2) * (1.f / D) + EPS);
                unsigned long long* o8 = (unsigned long long*)(B_H + row * D) + lane;
#pragma unroll
                for (int j = 0; j < 4; ++j) { const f32x4 g = ((const f32x4*)gnext)[lane + 64 * j]; const f32x4 xv = x[k][j];
                    o8[64 * j] = (unsigned long long)pk2(xv.x * r2 * g.x, xv.y * r2 * g.y) | ((unsigned long long)pk2(xv.z * r2 * g.z, xv.w * r2 * g.w) << 32); }
            }
        }
    }
}

template <int ACT>
__device__ __forceinline__ void phase_gemm(Frame& F, const bf16* A, const bf16* Bt, bf16* O, int N, int K) {
    asm volatile("" : "+s"(A), "+s"(Bt), "+s"(O));
    pg8::Gemm g{A, Bt, M, N, K}; pg8::StaticOrder So; So.init(M, N, F.G, (int)blockIdx.x);
    pg8::EpiStore<ACT> E{O, N};
    pg8::gemm_phase<pg8::EpiStore<ACT>, pg8::StaticOrder, true, true>(F.lds, g, So, E, F.wave);
}

constexpr int PH_PER_LAYER = 10, NPHASES = 1 + DEPTH * PH_PER_LAYER;
__global__ void __launch_bounds__(NWAVES * 64, 2) mk_fwd(Args args) {
    extern __shared__ __attribute__((aligned(16))) unsigned char lds[];
    Frame F;
    F.lds = (LAS unsigned char*)lds;
    F.MISC = (volatile LAS unsigned*)(F.lds + MISC_OFF);
    { const int t0_ = threadIdx.x; F.wave = __builtin_amdgcn_readfirstlane(t0_ >> 6);
      for (int u = t0_; u < (LDS_BYTES - LDSCTL_OFF) / 4; u += NWAVES * 64) ((LAS unsigned*)(F.lds + LDSCTL_OFF))[u] = 0u; }
    F.G = gridDim.x; { const int bx = blockIdx.x; F.vcu = (F.G % 8 == 0) ? (bx % 8) * (F.G / 8) + bx / 8 : bx; }
    unsigned char* ws = args.ws; F.ws = ws;
    F.ctl = (gu32*)(ws + WS_CTL);
    F.out = args.out;
    __syncthreads();
    XcdBarrier bar; bar.bar = (unsigned*)(F.ctl + CW_BAR); bar.x = 0; bar.st = F.MISC + 8; bar.wv = 0;
    if (args.use_bar) bar = xcd_barrier_post((unsigned*)(F.ctl + CW_BAR), F.MISC + 8);
    bar.wv = F.wave;
    const int lo = args.ph_lo, hi = args.ph_hi;
    int pid = 0;
    unsigned char* ws_ = F.ws;
#define PH_ON (pid >= lo && pid < hi)
#if PROBE_MASK
    unsigned long long pr_last = __builtin_amdgcn_s_memrealtime(), pr_acc = 0ull;
#define PH_END(kind) do { if (PH_ON && pid + 1 < hi) xcd_barrier(bar); ++pid; \
        { const unsigned long long now_ = __builtin_amdgcn_s_memrealtime(); \
          if ((kind) == 3 && blockIdx.x == 0 && F.wave == 0 && lane_id() == 0) { const unsigned long long sp_ = (unsigned long long)F.MISC[16] | ((unsigned long long)F.MISC[17] << 32); \
              if ((PROBE_MASK >> 11) & 1) pr_acc += sp_ - pr_last; if ((PROBE_MASK >> 3) & 1) pr_acc += now_ - sp_; } \
          else if ((PROBE_MASK >> (kind)) & 1) pr_acc += now_ - pr_last; pr_last = now_; } } while (0)
#else
#define PH_END(kind) do { if (PH_ON && pid + 1 < hi) xcd_barrier(bar); ++pid; } while (0)
#endif

    if (PH_ON && !(SKIPM & 1)) phase_prologue(F, args);
    PH_END(0);
    for (int l = 0; l < DEPTH; ++l) {
        if (PH_ON && !(SKIPM & 2)) phase_gemm<0>(F, B_H, w_in_t(ws_, l), B_PROJ, NP, D);
        PH_END(1);
        if (PH_ON && !(SKIPM & 4)) phase_prep(F, args, l);
        PH_END(2);
        if (PH_ON && !(SKIPM & 8)) phase_attn(F, l);
        PH_END(3);
        if (PH_ON && !(SKIPM & 8)) phase_dsa_attn(F);
        PH_END(4);
        if (PH_ON && !(SKIPM & 16)) phase_merge(F, args, l);
        PH_END(5);
        if (PH_ON && !(SKIPM & 32)) phase_gemm<0>(F, B_MIX, w_out_t(ws_, l), B_F, D, D);
        PH_END(6);
        if (PH_ON && !(SKIPM & 64)) { if (l == 0) phase_finish<true, false>(F, P_X_IN, P_G_POST_MIX + l * D, P_G_PRE_MLP + l * D); else phase_finish<false, false>(F, nullptr, P_G_POST_MIX + l * D, P_G_PRE_MLP + l * D); }
        PH_END(7);
        if (PH_ON && !(SKIPM & 128)) phase_gemm<2>(F, B_H, w_up_t(ws_, l), B_HID, FF, D);
        PH_END(8);
        if (PH_ON && !(SKIPM & 256)) phase_gemm<0>(F, B_HID, w_dn_t(ws_, l), B_F, D, FF);
        PH_END(9);
        if (PH_ON && !(SKIPM & 512)) { if (l + 1 < DEPTH) phase_finish<false, false>(F, nullptr, P_G_POST_MLP + l * D, P_G_PRE_MIX + (l + 1) * D); else phase_finish<false, true>(F, nullptr, P_G_POST_MLP + l * D, nullptr); }
        PH_END(10);
    }
#if PROBE_MASK
    if (blockIdx.x == 0 && F.wave == 0 && lane_id() == 0) { const unsigned long long t0_ = __builtin_amdgcn_s_memrealtime(); while (__builtin_amdgcn_s_memrealtime() - t0_ < pr_acc) __builtin_amdgcn_s_sleep(8); }
#endif
#undef PH_ON
#undef PH_END
}

extern "C" void kernel_launch(void* const* d_in, const int* in_sizes, int n_in, void* d_out, int out_size, void* d_ws, size_t ws_size, hipStream_t stream) {
    static int grid = 0;
    if (grid == 0) {
        if (n_in != 20 || in_sizes[0] != M * D || out_size != M * D || ws_size < WS_END) {
            fprintf(stderr, "kernel_launch: unexpected shapes / workspace (n_in %d, in0 %d, out %d, ws %zu < %zu); nothing launched\n", n_in, n_in > 0 ? in_sizes[0] : -1, out_size, ws_size, (size_t)WS_END);
            grid = -1; return; }
        int dev = 0, cus = 0, per_cu = 0;
        if (hipGetDevice(&dev) != hipSuccess || hipDeviceGetAttribute(&cus, hipDeviceAttributeMultiprocessorCount, dev) != hipSuccess) { grid = -1; return; }
        if (hipFuncSetAttribute((const void*)mk_fwd, hipFuncAttributeMaxDynamicSharedMemorySize, LDS_BYTES) != hipSuccess) { fprintf(stderr, "kernel_launch: hipFuncSetAttribute failed\n"); grid = -1; return; }
        if (hipOccupancyMaxActiveBlocksPerMultiprocessor(&per_cu, (const void*)mk_fwd, NWAVES * 64, LDS_BYTES) != hipSuccess || per_cu < 1)
            fprintf(stderr, "kernel_launch: note: occupancy query reports %d workgroups per CU\n", per_cu);
        (void)hipGetLastError();
        grid = cus;
    }
    if (grid < 0) return;
    if (hipMemsetAsync((char*)d_ws + WS_CTL, 0, CTL_ZERO_BYTES, stream) != hipSuccess) return;
    Args a{};
    for (int i = 0; i < 20; ++i) a.in[i] = d_in[i];
    a.out = (float*)d_out; a.ws = (unsigned char*)d_ws; a.pad = 0;
#if MK_MULTI
    for (int p = 0; p < NPHASES; ++p) {
        a.ph_lo = p; a.ph_hi = p + 1; a.use_bar = 0;
        hipLaunchKernelGGL(mk_fwd, dim3(grid), dim3(NWAVES * 64), LDS_BYTES, stream, a);
    }
#else
    a.ph_lo = 0; a.ph_hi = NPHASES; a.use_bar = 1;
    hipLaunchKernelGGL(mk_fwd, dim3(grid), dim3(NWAVES * 64), LDS_BYTES, stream, a);
#endif
}
```

```cpp
#include <hip/hip_runtime.h>
#include <cstdio>
#include <cstdint>

#define FASTMASK_OFF 0
#ifndef PROBE_MASK
#define PROBE_MASK 0
#endif
#ifndef SKIPM
#define SKIPM 0
#endif
#ifndef MK_MULTI
#define MK_MULTI 0
#endif

__device__ __forceinline__ int lane_id() { int l; asm volatile("v_mbcnt_lo_u32_b32 %0, -1, 0\n\tv_mbcnt_hi_u32_b32 %0, -1, %0" : "=v"(l)); return l; }
namespace pg8 {
#define PG8_LAS __attribute__((address_space(3)))
typedef unsigned short bf16_t;
typedef short bf16x8 __attribute__((ext_vector_type(8)));
typedef float f32x4 __attribute__((ext_vector_type(4)));
typedef unsigned u32x4 __attribute__((ext_vector_type(4)));
constexpr int BM = 256, BK = 64, HALF = 128, HTB = HALF * BK * 2, STAGE_BYTES = 8 * HTB, NXCD = 8, WGM = 8;

__host__ __device__ __forceinline__ int lds_byte(int r, int c) { const int st = (r >> 4) * 2 + (c >> 5), rr = r & 15, cc = c & 31, ob = rr * 64 + cc * 2; return st * 1024 + (ob ^ (((ob >> 9) & 1) << 5)); }
__host__ __device__ __forceinline__ void stage_rc(int b, int& R, int& C) { const int st = b / 1024, sb = b % 1024, swz = sb ^ (((sb >> 9) & 1) << 5); R = (st >> 1) * 16 + swz / 64; C = (st & 1) * 32 + (swz % 64) / 2; }
__host__ __device__ __forceinline__ int perm32(int rho) { const int n = rho >> 4, i = rho & 15; return 8 * (i >> 2) + 4 * n + (i & 3); }

struct Unit { int pm, pn; };
struct Gemm { const bf16_t* A; const bf16_t* Bt; int M, N, K; };

struct StaticOrder {
    int nM, nN, nwg, G, c;
    __host__ __device__ void init(int M, int N, int G_, int c_) { nM = M / BM; nN = N / BM; nwg = nM * nN; G = G_; c = c_; }
    __host__ __device__ bool next(int i, Unit& u) const {
        const long L = (long)i * G + c; if (L >= nwg) return false;
        int wgid = (int)L; { const int q = nwg / NXCD, r = nwg % NXCD, xcd = wgid % NXCD, off = wgid / NXCD; wgid = (xcd < r ? xcd * (q + 1) : r * (q + 1) + (xcd - r) * q) + off; }
        const int nig = WGM * nN, gid = wgid / nig, fm = gid * WGM, gsz = (nM - fm) < WGM ? (nM - fm) : WGM;
        u.pm = fm + ((wgid % nig) % gsz); u.pn = (wgid % nig) / gsz; return true;
    }
    __device__ __forceinline__ void a_ready(const Unit&) const {}
    __device__ __forceinline__ void done(const Unit&) const {}
};

__device__ __forceinline__ unsigned cvt_pk_bf16(float lo, float hi) { unsigned r; asm volatile("v_cvt_pk_bf16_f32 %0, %1, %2" : "=v"(r) : "v"(lo), "v"(hi)); return r; }

template <int ACT  > struct EpiStore {
    static constexpr bool PERM = true, AFTER_DRAIN = false;
    bf16_t* O; int ldc;
    __device__ __forceinline__ void operator()(const f32x4 (&acc)[2][2][4][2], const Unit& u, int wr, int wc, int fr, int fq) const {
        const int row0 = u.pm * BM + wr * 64 + fr;
        const int col0 = u.pn * BM + wc * 32 + 8 * fq;
#pragma unroll
        for (int ai = 0; ai < 2; ++ai)
#pragma unroll
            for (int m = 0; m < 4; ++m) { bf16_t* rowp = O + (size_t)(row0 + ai * HALF + m * 16) * ldc + col0;
#pragma unroll
                for (int bj = 0; bj < 2; ++bj) { f32x4 v0 = acc[ai][bj][m][0], v1 = acc[ai][bj][m][1];
                    if (ACT == 2) {
#pragma unroll
                        for (int e = 0; e < 4; ++e) { const float a = fmaxf(v0[e], 0.f), b = fmaxf(v1[e], 0.f); v0[e] = a * a; v1[e] = b * b; } }
                    u32x4 w; w.x = cvt_pk_bf16(v0[0], v0[1]); w.y = cvt_pk_bf16(v0[2], v0[3]); w.z = cvt_pk_bf16(v1[0], v1[1]); w.w = cvt_pk_bf16(v1[2], v1[3]);
                    *(u32x4*)(rowp + bj * HALF) = w; } }
    }
};

template <class Epi, class Sched, bool ALIGN_EPI = false, bool SP2 = false>
__device__ __forceinline__ void gemm_phase(PG8_LAS unsigned char* lds, const Gemm g, const Sched& S, const Epi& E, int wave_) {
    int tid_ = wave_ * 64 + lane_id(); asm volatile("" : "+v"(tid_));
    const int tid = tid_, wid = __builtin_amdgcn_readfirstlane(tid >> 6), lane = tid & 63, wr = wid >> 2, wc = wid & 3, fr = lane & 15, fq = lane >> 4;
    const int K = g.K, nt = K / BK;
    unsigned voffA[2], voffB[2];
#pragma unroll
    for (int i = 0; i < 2; ++i) { int R, C; stage_rc(tid * 16 + i * 8192, R, C); const int Rb = Epi::PERM ? ((R & ~31) + perm32(R & 31)) : R;
        voffA[i] = (unsigned)(R * K + C) * 2u; voffB[i] = (unsigned)(Rb * K + C) * 2u; }
    const size_t kstep = (size_t)(BK * 2);
    const size_t hstep = (size_t)HALF * K * 2;
    const size_t tstep = 2 * hstep;
    const unsigned ldsw = (unsigned)wid * 1024u;
    const int aoff = lds_byte(wr * 64 + fr, fq * 8), boff = lds_byte(wc * 32 + fr, fq * 8);
#define PG8_SA(b, h) (((b) * 2 + (h)) * HTB)
#define PG8_SB(b, h) ((4 + (b) * 2 + (h)) * HTB)
#define PG8_STAGE(bufoff, gbase, voff) do { _Pragma("unroll") for (int _i = 0; _i < 2; ++_i) \
        __builtin_amdgcn_global_load_lds((const unsigned*)((const char*)(gbase) + (voff)[_i]), (PG8_LAS unsigned*)(lds + (bufoff) + ldsw + _i * 8192), 16, 0, 0); } while (0)
#define PG8_LDA(dst, b, h) do { _Pragma("unroll") for (int m = 0; m < 4; ++m) _Pragma("unroll") for (int k = 0; k < 2; ++k) dst[m][k] = *(const PG8_LAS bf16x8*)(lds + PG8_SA(b, h) + aoff + m * 2048 + k * 1024); } while (0)
#define PG8_LDB(dst, b, h) do { _Pragma("unroll") for (int n = 0; n < 2; ++n) _Pragma("unroll") for (int k = 0; k < 2; ++k) dst[n][k] = *(const PG8_LAS bf16x8*)(lds + PG8_SB(b, h) + boff + n * 2048 + k * 1024); } while (0)
#define PG8_MMA(ai, bj, At, Bt) do { __builtin_amdgcn_s_setprio(1); _Pragma("unroll") for (int m = 0; m < 4; ++m) _Pragma("unroll") for (int n = 0; n < 2; ++n) _Pragma("unroll") for (int k = 0; k < 2; ++k) \
        acc[ai][bj][m][n] = __builtin_amdgcn_mfma_f32_16x16x32_bf16(Bt[n][k], At[m][k], acc[ai][bj][m][n], 0, 0, 0); __builtin_amdgcn_s_setprio(0); } while (0)
#define PG8_WAIT_V(n) asm volatile("s_waitcnt vmcnt(" #n ")" ::: "memory")
#define PG8_WAIT_L(n) asm volatile("s_waitcnt lgkmcnt(" #n ")" ::: "memory")
#define PG8_BAR __builtin_amdgcn_s_barrier()
#define PG8_SCHED __builtin_amdgcn_sched_barrier(0)
    Unit cur, nxt; int ui = 0;
    if (!S.next(0, cur)) return;
    f32x4 acc[2][2][4][2];
#pragma unroll
    for (int a = 0; a < 2; ++a)
#pragma unroll
        for (int b = 0; b < 2; ++b)
#pragma unroll
            for (int m = 0; m < 4; ++m)
#pragma unroll
                for (int n = 0; n < 2; ++n) acc[a][b][m][n] = (f32x4){0.f, 0.f, 0.f, 0.f};
    bf16x8 At[4][2], B0[2][2], B1[2][2];
    const char* cA = (const char*)g.A + (size_t)cur.pm * tstep; const char* cB = (const char*)g.Bt + (size_t)cur.pn * tstep;
    S.a_ready(cur);
    if constexpr (SP2) {
        PG8_STAGE(PG8_SB(0, 0), cB, voffB); PG8_STAGE(PG8_SB(0, 1), cB + hstep, voffB); PG8_STAGE(PG8_SA(0, 0), cA, voffA); PG8_STAGE(PG8_SA(0, 1), cA + hstep, voffA);
        if (wr == 1) PG8_BAR;
        PG8_WAIT_V(2); PG8_BAR;
        PG8_STAGE(PG8_SB(1, 0), cB + kstep, voffB); PG8_STAGE(PG8_SA(1, 0), cA + kstep, voffA); PG8_STAGE(PG8_SB(1, 1), cB + hstep + kstep, voffB);
        PG8_WAIT_V(6); PG8_BAR;
    } else {
        PG8_STAGE(PG8_SB(0, 0), cB, voffB); PG8_STAGE(PG8_SA(0, 0), cA, voffA); PG8_STAGE(PG8_SB(0, 1), cB + hstep, voffB); PG8_STAGE(PG8_SA(0, 1), cA + hstep, voffA);
        if (wr == 1) PG8_BAR;
        PG8_WAIT_V(4); PG8_BAR;
        PG8_STAGE(PG8_SB(1, 0), cB + kstep, voffB); PG8_STAGE(PG8_SA(1, 0), cA + kstep, voffA); PG8_STAGE(PG8_SB(1, 1), cB + hstep + kstep, voffB);
        PG8_WAIT_V(6); PG8_BAR;
    }
    for (;;) {
        const bool has_next = S.next(ui + 1, nxt);
        const char* nA = has_next ? (const char*)g.A + (size_t)nxt.pm * tstep : cA; const char* nB = has_next ? (const char*)g.Bt + (size_t)nxt.pn * tstep : cB;
        for (int t = 0; t < nt; t += 2) {
            const bool last = (t == nt - 2);
            const char* a1 = cA + (size_t)(t + 1) * kstep;
            const char* a2 = last ? nA : cA + (size_t)(t + 2) * kstep; const char* b2 = last ? nB : cB + (size_t)(t + 2) * kstep;
            const char* a3 = a2 + kstep; const char* b3 = b2 + kstep;
            if (last && has_next) S.a_ready(nxt);
            if constexpr (SP2) {
            PG8_LDB(B0, 0, 0); PG8_LDB(B1, 0, 1); PG8_SCHED; PG8_LDA(At, 0, 0); PG8_STAGE(PG8_SA(1, 1), a1 + hstep, voffA);
            PG8_WAIT_V(8); PG8_WAIT_L(0); PG8_BAR; PG8_MMA(0, 0, At, B0); PG8_MMA(0, 1, At, B1); PG8_BAR; PG8_SCHED;
            PG8_LDA(At, 0, 1); PG8_STAGE(PG8_SB(0, 0), b2, voffB); PG8_STAGE(PG8_SB(0, 1), b2 + hstep, voffB); PG8_STAGE(PG8_SA(0, 0), a2, voffA);
            PG8_WAIT_V(8); PG8_WAIT_L(0); PG8_BAR; PG8_MMA(1, 0, At, B0); PG8_MMA(1, 1, At, B1); PG8_BAR; PG8_SCHED;
            PG8_LDB(B0, 1, 0); PG8_LDB(B1, 1, 1); PG8_SCHED; PG8_LDA(At, 1, 0); PG8_STAGE(PG8_SA(0, 1), a2 + hstep, voffA);
            PG8_WAIT_V(8); PG8_WAIT_L(0); PG8_BAR; PG8_MMA(0, 0, At, B0); PG8_MMA(0, 1, At, B1); PG8_BAR; PG8_SCHED;
            PG8_LDA(At, 1, 1); PG8_STAGE(PG8_SB(1, 0), b3, voffB); PG8_STAGE(PG8_SB(1, 1), b3 + hstep, voffB); PG8_STAGE(PG8_SA(1, 0), a3, voffA);
            PG8_WAIT_V(8); PG8_WAIT_L(0); PG8_BAR; PG8_MMA(1, 0, At, B0); PG8_MMA(1, 1, At, B1); PG8_BAR; PG8_SCHED;
            } else {
            PG8_LDB(B0, 0, 0); PG8_SCHED; PG8_LDA(At, 0, 0); PG8_STAGE(PG8_SA(1, 1), a1 + hstep, voffA);
            PG8_WAIT_L(8); PG8_BAR; PG8_WAIT_L(0); PG8_MMA(0, 0, At, B0); PG8_BAR; PG8_SCHED;
            PG8_LDB(B1, 0, 1); PG8_STAGE(PG8_SB(0, 0), b2, voffB);
            PG8_BAR; PG8_WAIT_L(0); PG8_MMA(0, 1, At, B1); PG8_BAR;
            PG8_LDA(At, 0, 1); PG8_STAGE(PG8_SA(0, 0), a2, voffA);
            PG8_BAR; PG8_WAIT_L(0); PG8_MMA(1, 0, At, B0); PG8_BAR; PG8_SCHED;
            PG8_STAGE(PG8_SB(0, 1), b2 + hstep, voffB);
            PG8_WAIT_V(6); PG8_BAR; PG8_MMA(1, 1, At, B1); PG8_BAR;
            PG8_LDB(B0, 1, 0); PG8_SCHED; PG8_LDA(At, 1, 0); PG8_STAGE(PG8_SA(0, 1), a2 + hstep, voffA);
            PG8_WAIT_L(8); PG8_BAR; PG8_WAIT_L(0); PG8_MMA(0, 0, At, B0); PG8_BAR; PG8_SCHED;
            PG8_LDB(B1, 1, 1); PG8_STAGE(PG8_SB(1, 0), b3, voffB);
            PG8_BAR; PG8_WAIT_L(0); PG8_MMA(0, 1, At, B1); PG8_BAR;
            PG8_LDA(At, 1, 1); PG8_STAGE(PG8_SA(1, 0), a3, voffA);
            PG8_BAR; PG8_WAIT_L(0); PG8_MMA(1, 0, At, B0); PG8_BAR; PG8_SCHED;
            PG8_STAGE(PG8_SB(1, 1), b3 + hstep, voffB);
            PG8_WAIT_V(6); PG8_BAR; PG8_MMA(1, 1, At, B1); PG8_BAR;
            }
        }
        if constexpr (ALIGN_EPI) { if (wr == 0) PG8_BAR; }
        if constexpr (!Epi::AFTER_DRAIN) { E(acc, cur, wr, wc, fr, fq); S.done(cur); }
        if (!has_next) break;
#pragma unroll
        for (int a = 0; a < 2; ++a)
#pragma unroll
            for (int b = 0; b < 2; ++b)
#pragma unroll
                for (int m = 0; m < 4; ++m)
#pragma unroll
                    for (int n = 0; n < 2; ++n) acc[a][b][m][n] = (f32x4){0.f, 0.f, 0.f, 0.f};
        cur = nxt; cA = nA; cB = nB; ++ui;
        if constexpr (ALIGN_EPI) { if (wr == 1) PG8_BAR; }
    }
    PG8_WAIT_V(0);
    if constexpr (!ALIGN_EPI) { if (wr == 0) PG8_BAR; }
    PG8_BAR;
#undef PG8_SA
#undef PG8_SB
#undef PG8_STAGE
#undef PG8_LDA
#undef PG8_LDB
#undef PG8_MMA
#undef PG8_WAIT_V
#undef PG8_WAIT_L
#undef PG8_BAR
#undef PG8_SCHED
}
}

constexpr int NWAVES = 8;
constexpr int BATCH = 32, S = 2048, D = 1024, DEPTH = 4, FF = 4096;
constexpr int M = BATCH * S;
constexpr int NP = 2304;
constexpr int DIN = 2108;
constexpr int C_QA = 0, C_CKV = 256, C_QIDX = 384, C_QB = 512, C_KCMP = 1024, C_VCMP = 1152, C_KSLC = 1280, C_VSLC = 1408, C_KWIN = 1536, C_VWIN = 1664,
              C_UC = 1792, C_KIDX = 2048, C_WIDX = 2080, C_GATE = 2084, C_KA = 2112, C_VA = 2176;
constexpr int NC = 127;
constexpr float EPS = 1e-6f;
constexpr float NEGF = -1e30f;

__host__ __device__ __forceinline__ int win_src(int n) {
    if (n < 512) return n;
    if (n < 1024) return 548 + (n - 512);
    if (n < 1792) return 1060 + (n - 1024);
    if (n < 2048) return 1852 + (n - 1792);
    if (n < 2080) return 512 + (n - 2048);
    if (n < 2084) return 544 + (n - 2080);
    if (n < 2108) return 1828 + (n - 2084);
    return -1;
}

constexpr size_t MiB = 1u << 20;
constexpr size_t WS_CTL = 0, CTL_ZERO_BYTES = 1 * MiB;
constexpr size_t WS_W = 2 * MiB;
constexpr size_t W_IN_B = (size_t)NP * D * 2, W_OUT_B = (size_t)D * D * 2, W_UP_B = (size_t)FF * D * 2, W_DN_B = (size_t)D * FF * 2;
constexpr size_t W_LAYER_B = W_IN_B + W_OUT_B + W_UP_B + W_DN_B;
constexpr size_t WS_ROPE = 96 * MiB;
constexpr size_t WS_WCT = 102 * MiB;
constexpr size_t WS_CB = 104 * MiB;
constexpr size_t WS_KCB = 124 * MiB, WS_VCB = 125 * MiB;
constexpr size_t WS_KA = 108 * MiB;
constexpr size_t WS_H = 128 * MiB;
constexpr size_t WS_F = 256 * MiB;
constexpr size_t WS_PROJ = 384 * MiB;
constexpr size_t WS_MIX = 672 * MiB;
constexpr size_t WS_MASK = 800 * MiB;
constexpr size_t WS_HID = 384 * MiB;
constexpr size_t WS_XB = 896 * MiB;
constexpr size_t WS_END = 1024 * MiB;
static_assert(WS_W + DEPTH * W_LAYER_B <= WS_ROPE, "weights");
static_assert(WS_ROPE + (size_t)M * 24 * 4 <= WS_WCT && WS_WCT + (size_t)DEPTH * 2 * 128 * 1024 * 2 <= WS_CB, "map");
static_assert(WS_PROJ + (size_t)M * NP * 2 <= WS_MIX && WS_MIX + (size_t)M * D * 2 <= WS_END && WS_HID + (size_t)M * FF * 2 <= WS_END, "map2");

constexpr int CW_BAR = 4096;
constexpr int RING_BYTES = 131072;
constexpr int LDSCTL_OFF = RING_BYTES, MISC_OFF = LDSCTL_OFF + 320;
constexpr int LDS_BYTES = 147456;
constexpr int WSCR = 16384;

#define GAS __attribute__((address_space(1)))
#define LAS __attribute__((address_space(3)))
typedef unsigned short bf16;
typedef unsigned v4u __attribute__((ext_vector_type(4)));
typedef float f32x4 __attribute__((ext_vector_type(4)));
typedef GAS unsigned gu32;
#define LDS_FENCE() asm volatile("s_waitcnt lgkmcnt(0)" ::: "memory")
__device__ __forceinline__ unsigned f2bf(float f) { unsigned u = __builtin_bit_cast(unsigned, f); return (u + 0x7fffu + ((u >> 16) & 1u)) >> 16; }
__device__ __forceinline__ unsigned pk2(float lo, float hi) { return f2bf(lo) | (f2bf(hi) << 16); }
__device__ __forceinline__ float bf2f(bf16 u) { return __builtin_bit_cast(float, (unsigned)u << 16); }
__device__ __forceinline__ float bflo(unsigned u) { return __builtin_bit_cast(float, u << 16); }
__device__ __forceinline__ float bfhi(unsigned u) { return __builtin_bit_cast(float, u & 0xffff0000u); }

#define XB_TMO      128
#define XB_XCNT(j)  (256  + 64 * (j))
#define XB_XSUB(j)  (1280 + 64 * (j))
#define XB_XGEN(j)  (2304 + 64 * (j))
#define XB_TOP      3328
#define XB_TOPGEN   3392
#define XCD_BAR_WORDS 3456
#define XB_SPIN_CAP (1u << 22)

__device__ __forceinline__ unsigned xb_ld(unsigned* p)              { return __hip_atomic_load(p, __ATOMIC_RELAXED, __HIP_MEMORY_SCOPE_AGENT); }
__device__ __forceinline__ unsigned xb_add(unsigned* p, unsigned v) { return __hip_atomic_fetch_add(p, v, __ATOMIC_RELAXED, __HIP_MEMORY_SCOPE_AGENT); }
__device__ __forceinline__ unsigned xb_xcc_id() { return (unsigned)__builtin_amdgcn_s_getreg((3 << 11) | 20) & 0xFu; }
#define XB_SPIN(cond, bar) do { unsigned _sp = 0; while (cond) { __builtin_amdgcn_s_sleep(1); \
    if ((++_sp & 255u) == 0u) { if (xb_ld(&(bar)[XB_TMO])) break; if (_sp > XB_SPIN_CAP) { atomicAdd(&(bar)[XB_TMO], 1u); break; } } } } while (0)

struct XcdBarrier { unsigned* bar; unsigned x; volatile LAS unsigned* st; int wv; };

__device__ __forceinline__ XcdBarrier xcd_barrier_post(unsigned* bar, volatile LAS unsigned* st) {
    XcdBarrier b; b.bar = bar; b.x = xb_xcc_id(); b.st = st; b.wv = 0;
    if (threadIdx.x == 0) (void)xb_add(&bar[XB_XCNT(b.x)], 1u);
    return b;
}
__device__ __forceinline__ void xcd_barrier_complete(unsigned* bar, unsigned x, unsigned& nloc, unsigned& nx) {
    const unsigned G = gridDim.x * gridDim.y * gridDim.z;
    unsigned sum, cnt, mine, sp = 0u;
    for (;;) {
        sum = 0u; cnt = 0u; mine = 0u;
#pragma unroll
        for (unsigned j = 0; j < 16; ++j) { const unsigned c = xb_ld(&bar[XB_XCNT(j)]); sum += c; cnt += (c > 0u) ? 1u : 0u; mine = (j == x) ? c : mine; }
        if (sum == G) break;
        __builtin_amdgcn_s_sleep(1);
        if ((++sp & 255u) == 0u) { if (xb_ld(&bar[XB_TMO])) break; if (sp > XB_SPIN_CAP) { atomicAdd(&bar[XB_TMO], 1u); break; } }
    }
    nloc = mine > 0u ? mine : 1u; nx = cnt > 0u ? cnt : 1u;
}
__device__ __forceinline__ void xcd_barrier(const XcdBarrier& b) {
    asm volatile("s_waitcnt vmcnt(0)" ::: "memory");
    __syncthreads();
    if (b.wv == 0 && lane_id() == 0) {
        unsigned* bar = b.bar; asm volatile("" : "+s"(bar));
        __builtin_amdgcn_s_waitcnt(0);
        unsigned nloc = b.st[0], nx = b.st[1];
        if (nloc == 0u) { xcd_barrier_complete(bar, b.x, nloc, nx); b.st[0] = nloc; b.st[1] = nx; }
        const unsigned old = xb_add(&bar[XB_XSUB(b.x)], 1u);
        const unsigned gen = old / nloc;
        if (old + 1u == (gen + 1u) * nloc) {
            __builtin_amdgcn_fence(__ATOMIC_RELEASE, "agent");
            asm volatile("s_waitcnt vmcnt(0)" ::: "memory");
            const unsigned og = xb_add(&bar[XB_TOP], 1u);
            const unsigned tg = og / nx;
            if (og + 1u == (tg + 1u) * nx) xb_add(&bar[XB_TOPGEN], 1u);
            else XB_SPIN(xb_ld(&bar[XB_TOPGEN]) == tg, bar);
            __builtin_amdgcn_fence(__ATOMIC_ACQUIRE, "agent");
            xb_add(&bar[XB_XGEN(b.x)], 1u);
            asm volatile("s_waitcnt vmcnt(0)" ::: "memory");
        } else {
            XB_SPIN(xb_ld(&bar[XB_XGEN(b.x)]) == gen, bar);
            __builtin_amdgcn_fence(__ATOMIC_ACQUIRE, "agent");
            asm volatile("s_waitcnt vmcnt(0)" ::: "memory");
        }
    }
    __syncthreads();
}

struct Frame {
    LAS unsigned char* lds;
    volatile LAS unsigned* MISC;
    gu32* ctl;
    int wave, vcu, G;
    float* out; unsigned char* ws;
};
struct Args { const void* in[20]; float* out; unsigned char* ws; int ph_lo, ph_hi, use_bar, pad; };
#define IN_F(k) ((const float*)args.in[k])
#define P_X_IN IN_F(0)
#define P_POS ((const int*)args.in[1])
#define P_W_IN IN_F(2)
#define P_G_KV_A IN_F(3)
#define P_W_KV_UP IN_F(4)
#define P_W_CMP_K IN_F(5)
#define P_W_CMP_V IN_F(6)
#define P_PE_K IN_F(7)
#define P_PE_V IN_F(8)
#define P_W_POOL IN_F(9)
#define P_POOL_SCALE IN_F(10)
#define P_G_OUT_A IN_F(11)
#define P_G_OUT_B IN_F(12)
#define P_W_OUT IN_F(13)
#define P_G_PRE_MIX IN_F(14)
#define P_G_POST_MIX IN_F(15)
#define P_G_PRE_MLP IN_F(16)
#define P_G_POST_MLP IN_F(17)
#define P_W_UP IN_F(18)
#define P_W_DOWN IN_F(19)
#define B_ROPE ((float*)(ws_ + WS_ROPE))
#define B_H ((bf16*)(ws_ + WS_H))
#define B_F ((bf16*)(ws_ + WS_F))
#define B_PROJ ((bf16*)(ws_ + WS_PROJ))
#define B_MIX ((bf16*)(ws_ + WS_MIX))
#define B_HID ((bf16*)(ws_ + WS_HID))

template <int CTRL> __device__ __forceinline__ int dpp_i(int v) { return __builtin_amdgcn_update_dpp(0, v, CTRL, 0xF, 0xF, true); }
template <int CTRL> __device__ __forceinline__ float dpp_f(float v) { return __builtin_bit_cast(float, dpp_i<CTRL>(__builtin_bit_cast(int, v))); }
__device__ __forceinline__ int swz16_i(int v) { return __builtin_amdgcn_ds_swizzle(v, (16 << 10) | 0x1F); }
__device__ __forceinline__ float swz16_f(float v) { return __builtin_bit_cast(float, swz16_i(__builtin_bit_cast(int, v))); }
struct HalfPair { unsigned lo, hi; };
__device__ __forceinline__ HalfPair halves_u(unsigned v) { const auto rr = __builtin_amdgcn_permlane32_swap(v, v, false, false); HalfPair h; h.lo = rr[0]; h.hi = rr[1]; return h; }
__device__ __forceinline__ float other_half_f(float v, int hi) { const HalfPair h = halves_u(__builtin_bit_cast(unsigned, v)); return __builtin_bit_cast(float, hi ? h.lo : h.hi); }
__device__ __forceinline__ float sum32(float v) {
    v += dpp_f<0xB1>(v); v += dpp_f<0x4E>(v); v += dpp_f<0x141>(v); v += dpp_f<0x140>(v); v += swz16_f(v); return v; }
__device__ __forceinline__ float wave_sum(float v) { v = sum32(v); const HalfPair h = halves_u(__builtin_bit_cast(unsigned, v)); return __builtin_bit_cast(float, h.lo) + __builtin_bit_cast(float, h.hi); }
__device__ __forceinline__ float max_halves(float v) { const HalfPair h = halves_u(__builtin_bit_cast(unsigned, v)); return fmaxf(__builtin_bit_cast(float, h.lo), __builtin_bit_cast(float, h.hi)); }
__device__ __forceinline__ unsigned or_halves(unsigned v) { const HalfPair h = halves_u(v); return h.lo | h.hi; }
__device__ __forceinline__ unsigned or32(unsigned v) { v |= (unsigned)dpp_i<0xB1>((int)v); v |= (unsigned)dpp_i<0x4E>((int)v); v |= (unsigned)dpp_i<0x141>((int)v); v |= (unsigned)dpp_i<0x140>((int)v); v |= (unsigned)swz16_i((int)v); return v; }

__constant__ double c_rope_inv[12] = {1.0, 0.19392274474868576, 0.03760603093086393, 0.007292664737217109, 0.001414213562373095, 0.0002742481756762073, 5.318295896944988e-05, 1.031338537721246e-05,
                                       1.0, 0.03760603093086393, 0.001414213562373095, 5.318295896944988e-05};
template <int MODE>
__device__ __forceinline__ void transpose_item(const float* W, int K, int Nsrc, int nblk, bf16* WT, LAS float* scr, int item, int lane) {
    const int kb = item / nblk, nb = item % nblk, k0 = 64 * kb, n0 = 32 * nb;
    if (MODE && n0 >= C_KA && n0 < C_KA + 128) return;
    const int np = n0 + (lane & 31);
    const int src = MODE ? win_src(np) : np;
#pragma unroll 8
    for (int i = 0; i < 32; ++i) { const int kk = 2 * i + (lane >> 5); scr[kk * 33 + (lane & 31)] = (src >= 0) ? W[(size_t)(k0 + kk) * Nsrc + src] : 0.f; }
    LDS_FENCE();
    const int c = lane & 7;
#pragma unroll
    for (int j = 0; j < 4; ++j) { const int n = (lane >> 3) + 8 * j; const LAS float* s = scr + (8 * c) * 33 + n;
        v4u o; o.x = pk2(s[0 * 33], s[1 * 33]); o.y = pk2(s[2 * 33], s[3 * 33]); o.z = pk2(s[4 * 33], s[5 * 33]); o.w = pk2(s[6 * 33], s[7 * 33]);
        *(v4u*)(WT + (size_t)(n0 + n) * K + k0 + 8 * c) = o; }
    LDS_FENCE();
}

__device__ __forceinline__ bf16* w_in_t(unsigned char* ws_, int l)  { return (bf16*)(ws_ + WS_W + (size_t)l * W_LAYER_B); }
__device__ __forceinline__ bf16* w_out_t(unsigned char* ws_, int l) { return (bf16*)(ws_ + WS_W + (size_t)l * W_LAYER_B + W_IN_B); }
__device__ __forceinline__ bf16* w_up_t(unsigned char* ws_, int l)  { return (bf16*)(ws_ + WS_W + (size_t)l * W_LAYER_B + W_IN_B + W_OUT_B); }
__device__ __forceinline__ bf16* w_dn_t(unsigned char* ws_, int l)  { return (bf16*)(ws_ + WS_W + (size_t)l * W_LAYER_B + W_IN_B + W_OUT_B + W_UP_B); }

__device__ __forceinline__ void norm_row_to_bf16(const float* xrow, const float* gain, bf16* orow, int lane) {
    const f32x4* xr = (const f32x4*)xrow + lane;
    f32x4 v[4]; float s = 0.f;
#pragma unroll
    for (int j = 0; j < 4; ++j) { v[j] = xr[64 * j]; s += (v[j].x * v[j].x + v[j].y * v[j].y) + (v[j].z * v[j].z + v[j].w * v[j].w); }
    const float rs = rsqrtf(wave_sum(s) * (1.f / D) + EPS);
    unsigned long long* o8 = (unsigned long long*)orow + lane;
#pragma unroll
    for (int j = 0; j < 4; ++j) { const f32x4 g = ((const f32x4*)gain)[lane + 64 * j];
        o8[64 * j] = (unsigned long long)pk2(v[j].x * rs * g.x, v[j].y * rs * g.y) | ((unsigned long long)pk2(v[j].z * rs * g.z, v[j].w * rs * g.w) << 32); }
}

__device__ __forceinline__ void phase_prologue(Frame& F, const Args& args) {
    unsigned char* ws_ = F.ws; asm volatile("" : "+s"(ws_)); int lane_ = lane_id(); asm volatile("" : "+v"(lane_)); (void)ws_;
    LAS float* scr = (LAS float*)(F.lds + F.wave * WSCR);
    const int gw = F.vcu * NWAVES + F.wave, NGW = F.G * NWAVES;
    constexpr int I_IN = (D / 64) * (NP / 32), I_OUT = (D / 64) * (D / 32), I_UP = (D / 64) * (FF / 32), I_DN = (FF / 64) * (D / 32);
    for (int it = gw; it < DEPTH * I_IN; it += NGW) { const int l = it / I_IN, r = it % I_IN; transpose_item<1>(P_W_IN + (size_t)l * D * DIN, D, DIN, NP / 32, w_in_t(ws_, l), scr, r, lane_); }
    for (int it = gw; it < DEPTH * I_OUT; it += NGW) { const int l = it / I_OUT, r = it % I_OUT; transpose_item<0>(P_W_OUT + (size_t)l * D * D, D, D, D / 32, w_out_t(ws_, l), scr, r, lane_); }
    for (int it = gw; it < DEPTH * I_UP; it += NGW) { const int l = it / I_UP, r = it % I_UP; transpose_item<0>(P_W_UP + (size_t)l * D * FF, D, FF, FF / 32, w_up_t(ws_, l), scr, r, lane_); }
    for (int it = gw; it < DEPTH * I_DN; it += NGW) { const int l = it / I_DN, r = it % I_DN; transpose_item<0>(P_W_DOWN + (size_t)l * FF * D, FF, D, D / 32, w_dn_t(ws_, l), scr, r, lane_); }
    for (int it = gw; it < DEPTH * D * 2; it += NGW) {
        const int l = it / (D * 2), r = it % (D * 2), k = r >> 1, n = lane_ + 64 * (r & 1);
        const float* wi = P_W_IN + ((size_t)l * D + k) * DIN + 256; const float* gk = P_G_KV_A + l * 128; const float* wu = P_W_KV_UP + (size_t)l * 128 * 128 + n;
        float acc = 0.f;
#pragma unroll 8
        for (int j = 0; j < 128; ++j) acc += (wi[j] * gk[j]) * wu[j * 128];
        w_in_t(ws_, l)[(size_t)(C_KA + n) * D + k] = (bf16)f2bf(acc);
    }
    for (int it = gw; it < DEPTH * 2 * 2 * 32; it += NGW) {
        const int lk = it >> 6, part = (it >> 5) & 1, r = it & 31, l = lk >> 1, kv = lk & 1;
        const float* W = (kv ? P_W_CMP_V : P_W_CMP_K) + (size_t)l * 32 * 64 * 64 + (size_t)part * 1024 * 64;
        transpose_item<0>(W, 1024, 64, 2, (bf16*)(ws_ + WS_WCT) + ((size_t)lk * 128 + part * 64) * 1024, scr, r, lane_);
    }
    for (int it = gw; it < DEPTH * 2; it += NGW) {
        const int l = it >> 1, kv = it & 1;
        const float* W = (kv ? P_W_CMP_V : P_W_CMP_K) + (size_t)l * 32 * 64 * 64 + lane_; const float* pe = (kv ? P_PE_V : P_PE_K) + l * 32 * 64;
        float acc = 0.f;
        for (int k = 0; k < 2048; ++k) acc += pe[k] * W[(size_t)k * 64];
        ((float*)(ws_ + WS_CB))[it * 64 + lane_] = acc;
    }
    for (int e = gw * 64 + lane_; e < M * 12; e += NGW * 64) {
        const int row = e / 12, i = e % 12;
        const double inv = c_rope_inv[i];
        const double a = (double)P_POS[row] * inv;
        const double k = __builtin_rint(a * 0.15915494309189535);
        const float r = (float)(a - k * 6.283185307179586);
        const float c = __builtin_cosf(r), s = __builtin_sinf(r);
        float* t = B_ROPE + (size_t)row * 24;
        if (i < 8) { t[i] = c; t[8 + i] = s; } else { t[16 + (i - 8)] = c; t[20 + (i - 8)] = s; }
    }
    for (int m = gw; m < M; m += NGW) norm_row_to_bf16(P_X_IN + (size_t)m * D, P_G_PRE_MIX, B_H + (size_t)m * D, lane_);
}

typedef short bf16x8 __attribute__((ext_vector_type(8)));
typedef short s16x4 __attribute__((ext_vector_type(4)));
typedef float f32x16 __attribute__((ext_vector_type(16)));
#define MFMA32(a, b, c) __builtin_amdgcn_mfma_f32_32x32x16_bf16((a), (b), (c), 0, 0, 0)
__device__ __forceinline__ int crow(int r, int hi) { return (r & 3) + 8 * (r >> 2) + 4 * hi; }
__device__ __forceinline__ void wg_barrier() { asm volatile("s_waitcnt lgkmcnt(0)\n\ts_barrier" ::: "memory"); }

__device__ __forceinline__ void phase_prep(Frame& F, const Args& args, int l) {
    unsigned char* ws_ = F.ws; asm volatile("" : "+s"(ws_)); int lane_ = lane_id(); asm volatile("" : "+v"(lane_)); (void)ws_; (void)args;
    int tid_ = F.wave * 64 + lane_id(); asm volatile("" : "+v"(tid_));
    const int gw = F.vcu * NWAVES + F.wave, NGW = F.G * NWAVES, lane = lane_;
    {
        const bool r_idx = (lane >= 8 && lane < 12), r_kv = (lane >= 16 && lane < 48);
        const int ii = r_idx ? lane - 8 : ((lane - 16) & 7);
        const int which = (lane - 16) >> 3;
        const int c1 = r_idx ? C_KIDX + ii : (((which < 2) ? C_KSLC : C_KWIN) + (which & 1) * 64 + ii);
        const int c2 = c1 + (r_idx ? 4 : 8);
        const int tc = r_idx ? 16 + ii : ii, ts = r_idx ? 20 + ii : 8 + ii;
        const int i0 = (2 * lane) & 7;
        constexpr int RB = 4;
        for (int row0 = gw * RB; row0 < M; row0 += NGW * RB) {
            unsigned u[RB], v[RB]; float tc0[RB], ts0[RB], tc1[RB], ts1[RB], rc[RB], rsn[RB]; bf16 e1[RB], e2[RB];
#pragma unroll
            for (int k = 0; k < RB; ++k) { bf16* prow = B_PROJ + (size_t)(row0 + k) * NP; const float* tab = B_ROPE + (size_t)(row0 + k) * 24;
                u[k] = *(const unsigned*)(prow + C_CKV + 2 * lane); v[k] = *(const unsigned*)(prow + C_KA + 2 * lane);
                tc0[k] = tab[i0]; ts0[k] = tab[8 + i0]; tc1[k] = tab[i0 + 1]; ts1[k] = tab[8 + i0 + 1];
                rc[k] = 0.f; rsn[k] = 0.f; e1[k] = 0; e2[k] = 0;
                if (r_idx || r_kv) { rc[k] = tab[tc]; rsn[k] = tab[ts]; e1[k] = prow[c1]; e2[k] = prow[c2]; } }
#pragma unroll
            for (int k = 0; k < RB; ++k) { bf16* prow = B_PROJ + (size_t)(row0 + k) * NP;
                const float x0 = bflo(u[k]), x1 = bfhi(u[k]);
                const float rs = rsqrtf(wave_sum(x0 * x0 + x1 * x1) * (1.f / 128.f) + EPS);
                float y0 = bflo(v[k]) * rs, y1 = bfhi(v[k]) * rs;
                const float p0 = __builtin_bit_cast(float, __builtin_amdgcn_ds_swizzle(__builtin_bit_cast(int, y0), (4 << 10) | 0x1F)), p1 = __builtin_bit_cast(float, __builtin_amdgcn_ds_swizzle(__builtin_bit_cast(int, y1), (4 << 10) | 0x1F));
                if (lane < 4) { y0 = y0 * tc0[k] - p0 * ts0[k]; y1 = y1 * tc1[k] - p1 * ts1[k]; }
                else if (lane < 8) { y0 = p0 * ts0[k] + y0 * tc0[k]; y1 = p1 * ts1[k] + y1 * tc1[k]; }
                *(unsigned*)(prow + C_KA + 2 * lane) = pk2(y0, y1);
                if (r_idx || r_kv) { const float x1v = bf2f(e1[k]), x2v = bf2f(e2[k]);
                    prow[c1] = (bf16)f2bf(x1v * rc[k] - x2v * rsn[k]); prow[c2] = (bf16)f2bf(x1v * rsn[k] + x2v * rc[k]); }
            }
        }
    }
    {
        const int wid = F.wave, r32 = lane & 31, hi = lane >> 5;
        LAS float* P = (LAS float*)F.lds;
        for (int u = F.vcu; u < BATCH * 8; u += F.G) {
            const int b = u >> 3, g = (u >> 2) & 1, kv = (u >> 1) & 1, eh = u & 1;
            const int rt = wid >> 1, part = wid & 1;
            const bf16* ap = B_PROJ + ((size_t)b * S + 16 * (32 * rt + r32)) * NP + (kv ? C_VCMP : C_KCMP) + g * 64 + 8 * hi;
            const bf16* bp = (const bf16*)(ws_ + WS_WCT) + ((size_t)(l * 2 + kv) * 128 + part * 64 + eh * 32 + r32) * 1024 + 8 * hi;
            f32x16 acc = {};
#pragma unroll 8
            for (int ks = 0; ks < 64; ++ks) {
                const bf16x8 a = *(const bf16x8*)(ap + (size_t)(ks >> 2) * NP + 16 * (ks & 3));
                const bf16x8 bq = *(const bf16x8*)(bp + 16 * ks);
                acc = MFMA32(a, bq, acc);
            }
#pragma unroll
            for (int r = 0; r < 16; ++r) P[(part * 128 + 32 * rt + crow(r, hi)) * 32 + r32] = acc[r];
            wg_barrier();
            const float* cb = (const float*)(ws_ + WS_CB) + (l * 2 + kv) * 64 + eh * 32;
            bf16* ob = (bf16*)(ws_ + (kv ? WS_VCB : WS_KCB)) + (size_t)(b * 2 + g) * 128 * 64 + eh * 32;
            for (int idx = tid_; idx < 128 * 32; idx += 512) { const int c = idx >> 5, e = idx & 31;
                const float v = (c < NC) ? (P[c * 32 + e] + P[(128 + c + 1) * 32 + e] + cb[e]) : 0.f;
                ob[c * 64 + e] = (bf16)f2bf(v); }
            wg_barrier();
        }
    }
}

typedef float f32x2_t __attribute__((ext_vector_type(2))); typedef __bf16 bf16x2_t __attribute__((ext_vector_type(2)));
__device__ __forceinline__ unsigned cvtpk(float lo, float hi) { const f32x2_t v = {lo, hi}; const bf16x2_t b = __builtin_convertvector(v, bf16x2_t); return __builtin_bit_cast(unsigned, b); }
constexpr float C2 = 0.125f * 1.4426950408889634f;

__device__ __forceinline__ unsigned idxmask(int x, int hi) {
    unsigned m = 0u;
#pragma unroll
    for (int g = 0; g < 4; ++g) { int n = x - (8 * g + 4 * hi); n = n < 0 ? 0 : (n > 4 ? 4 : n); m |= ((1u << n) - 1u) << (4 * g); }
    return m;
}

constexpr int SEL_QF = 0, SEL_PART = 16384, SEL_HIST = 20480, SEL_HP = 260, SEL_RES = SEL_HIST + 32 * SEL_HP * 4;
__device__ __forceinline__ void dsa_select_unit(unsigned char* ws_, int tid_, int b, int qt32, LAS unsigned char* lds) {
    asm volatile("" : "+v"(tid_)); asm volatile("" : "+s"(ws_));
    const int lane = tid_ & 63, wid = __builtin_amdgcn_readfirstlane(tid_ >> 6), r32 = lane & 31, hi = lane >> 5;
    unsigned* maskbuf = (unsigned*)(ws_ + WS_MASK);
    if (qt32 < 8) {
        for (int i = tid_; i < 2048; i += 512) { const int qq = i >> 6, blk = i & 63; const int t = 32 * qt32 + qq; const int d = t - 32 * blk;
            const unsigned w = d < 0 ? 0u : (d >= 31 ? 0xffffffffu : ((2u << d) - 1u));
            maskbuf[((size_t)b * S + t) * 64 + blk] = w; }
        return;
    }
    const size_t qrow = (size_t)b * S + 32 * qt32 + r32;
    const bf16* prow = B_PROJ + qrow * NP;
    {
        const int h = wid >> 1, sk = wid & 1;
        const v4u raw = *(const v4u*)(prow + C_QIDX + h * 32 + 16 * sk + 8 * hi);
        float x[8] = {bflo(raw.x), bfhi(raw.x), bflo(raw.y), bfhi(raw.y), bflo(raw.z), bfhi(raw.z), bflo(raw.w), bfhi(raw.w)};
        if (sk == 0 && hi == 0) { const float* tab = B_ROPE + qrow * 24;
#pragma unroll
            for (int i = 0; i < 4; ++i) { const float c = tab[16 + i], sn = tab[20 + i]; const float x1 = x[i], x2 = x[4 + i]; x[i] = x1 * c - x2 * sn; x[4 + i] = x1 * sn + x2 * c; } }
        v4u hp, lp;
        { unsigned hh[4], ll[4];
#pragma unroll
          for (int k = 0; k < 4; ++k) { const float a = x[2 * k], bb = x[2 * k + 1]; const unsigned ha = f2bf(a), hb = f2bf(bb); hh[k] = ha | (hb << 16);
              ll[k] = pk2(a - bf2f((bf16)ha), bb - bf2f((bf16)hb)); }
          hp = (v4u){hh[0], hh[1], hh[2], hh[3]}; lp = (v4u){ll[0], ll[1], ll[2], ll[3]}; }
        LAS v4u* qf = (LAS v4u*)(lds + SEL_QF);
        qf[((h * 2 + sk) * 2 + 0) * 64 + lane] = hp; qf[((h * 2 + sk) * 2 + 1) * 64 + lane] = lp;
    }
    float w[4];
#pragma unroll
    for (int h = 0; h < 4; ++h) w[h] = bf2f(prow[C_WIDX + h]);
    __syncthreads();
    const int nblk = qt32 + 1;
    const bf16* kbase = B_PROJ + (size_t)b * S * NP + C_KIDX;
    unsigned key[8][16];
#pragma unroll
    for (int i = 0; i < 8; ++i) {
        const int blk = wid + 8 * i;
        if (blk < nblk) {
            const bf16* kp = kbase + (size_t)(32 * blk + r32) * NP + 8 * hi;
            const bf16x8 kf0 = *(const bf16x8*)kp, kf1 = *(const bf16x8*)(kp + 16);
            float sc[16];
            const LAS bf16x8* qf = (const LAS bf16x8*)(lds + SEL_QF);
#pragma unroll
            for (int h = 0; h < 4; ++h) {
                f32x16 acc = {};
                acc = MFMA32(kf0, qf[((h * 2 + 0) * 2 + 0) * 64 + lane], acc);
                acc = MFMA32(kf1, qf[((h * 2 + 1) * 2 + 0) * 64 + lane], acc);
                acc = MFMA32(kf0, qf[((h * 2 + 0) * 2 + 1) * 64 + lane], acc);
                acc = MFMA32(kf1, qf[((h * 2 + 1) * 2 + 1) * 64 + lane], acc);
#pragma unroll
                for (int r = 0; r < 16; ++r) sc[r] = (h == 0) ? w[0] * fmaxf(acc[r], 0.f) : fmaf(w[h], fmaxf(acc[r], 0.f), sc[r]);
            }
#pragma unroll
            for (int r = 0; r < 16; ++r) {
                unsigned bits = __builtin_bit_cast(unsigned, sc[r]);
                if (bits == 0x80000000u) bits = 0u;
                unsigned k = (bits & 0x80000000u) ? ~bits : (bits | 0x80000000u);
                if (blk == qt32 && crow(r, hi) > r32) k = 0u;
                key[i][r] = k;
            }
        } else {
#pragma unroll
            for (int r = 0; r < 16; ++r) key[i][r] = 0u;
        }
    }
    LAS unsigned* part = (LAS unsigned*)(lds + SEL_PART);
    int pbi = 0;
#define SEL_REDUCE(cnt_, tot_) do { LAS unsigned* pb_ = part + (pbi & 1) * 512; ++pbi; pb_[wid * 64 + lane] = (cnt_); wg_barrier(); unsigned t_ = 0u; \
        _Pragma("unroll") for (int w8 = 0; w8 < 8; ++w8) t_ += pb_[w8 * 64 + r32] + pb_[w8 * 64 + 32 + r32]; (tot_) = t_; } while (0)
    LAS unsigned* hist = (LAS unsigned*)(lds + SEL_HIST);
    LAS unsigned* resd = (LAS unsigned*)(lds + SEL_RES);
    for (int i = tid_; i < 32 * SEL_HP / 4; i += 512) ((LAS v4u*)hist)[i] = (v4u){0u, 0u, 0u, 0u};
    wg_barrier();
    unsigned pfx = 0u, need = 256u;
    LAS unsigned* hrow = hist + r32 * SEL_HP;
#pragma unroll 1
    for (int pass = 0; pass < 4; ++pass) {
        const int shift = 24 - 8 * pass;
#pragma unroll
        for (int i = 0; i < 8; ++i) if (wid + 8 * i < nblk) {
#pragma unroll
            for (int r = 0; r < 16; ++r) {
                const unsigned k = key[i][r];
                const unsigned dg = (k >> shift) & 255u;
                const bool match = (pass == 0) || ((k >> (shift + 8)) == pfx);
                __hip_atomic_fetch_add(hrow + (match ? dg : 256u), 1u, __ATOMIC_RELAXED, __HIP_MEMORY_SCOPE_WORKGROUP);
            } }
        wg_barrier();
#pragma unroll 1
        for (int qq = 0; qq < 4; ++qq) {
            const int q = 4 * wid + qq;
            LAS v4u* hq = (LAS v4u*)(hist + q * SEL_HP) + lane;
            const v4u h4 = *hq;
            unsigned T = (h4.x + h4.y) + (h4.z + h4.w);
#pragma unroll
            for (int off = 1; off < 64; off <<= 1) { const unsigned t_ = (unsigned)__shfl_down((int)T, off); if (lane + off < 64) T += t_; }
            const unsigned needq = (pass == 0) ? 256u : resd[32 + q];
            const unsigned long long bal = __ballot(T >= needq);
            const int Ls = 63 - __builtin_clzll(bal | 1ull);
            const unsigned above = (unsigned)__shfl((int)T, (Ls + 1) & 63);
            if (lane == Ls) {
                const unsigned ab0 = (Ls < 63) ? above : 0u;
                const unsigned rem = needq - ab0; const unsigned c3 = h4.w, c2 = c3 + h4.z, c1 = c2 + h4.y;
                int d; unsigned ab;
                if (rem <= c3) { d = 3; ab = 0u; } else if (rem <= c2) { d = 2; ab = c3; } else if (rem <= c1) { d = 1; ab = c2; } else { d = 0; ab = c1; }
                resd[q] = (unsigned)(4 * Ls + d); resd[32 + q] = rem - ab;
            }
            *hq = (v4u){0u, 0u, 0u, 0u};
            if (lane == 0) hist[q * SEL_HP + 256] = 0u;
        }
        wg_barrier();
        pfx = (pfx << 8) | resd[r32]; need = resd[32 + r32];
    }
    const unsigned thr = pfx;
    unsigned gtm[8], eqm[8];
#pragma unroll
    for (int i = 0; i < 8; ++i) { unsigned g = 0u, e = 0u;
        if (wid + 8 * i < nblk) {
#pragma unroll
            for (int r = 0; r < 16; ++r) { g |= (key[i][r] > thr) ? (1u << r) : 0u; e |= (key[i][r] == thr) ? (1u << r) : 0u; } }
        gtm[i] = g; eqm[i] = e; }
    const unsigned rneed = need;
    unsigned Y = 0u;
    for (int bit = 10; bit >= 0; --bit) {
        const unsigned c = Y | (1u << bit);
        unsigned cnt = 0u;
#pragma unroll
        for (int i = 0; i < 8; ++i) cnt += __builtin_popcount(eqm[i] & idxmask((int)c - 32 * (wid + 8 * i), hi));
        unsigned tot; SEL_REDUCE(cnt, tot);
        if (tot < rneed) Y = c;
    }
#undef SEL_REDUCE
#pragma unroll
    for (int i = 0; i < 8; ++i) {
        const int blk = wid + 8 * i;
        const unsigned selm = gtm[i] | (eqm[i] & idxmask((int)Y + 1 - 32 * blk, hi));
        unsigned word = ((selm & 0xFu) | ((selm & 0xF0u) << 4) | ((selm & 0xF00u) << 8) | ((selm & 0xF000u) << 12)) << (4 * hi);
        word = or_halves(word);
        if (hi == 0) maskbuf[qrow * 64 + blk] = word;
    }
    __syncthreads();
}

constexpr int AT_K = 0, AT_V = 24576, AT_WS = 49152;
__device__ __forceinline__ void pv(f32x16* o, f32x16& lacc, unsigned vb, bf16x8 pa0, bf16x8 pa1, bf16x8 pa2, bf16x8 pa3) {
    { const bf16x8 ones = {0x3F80, 0x3F80, 0x3F80, 0x3F80, 0x3F80, 0x3F80, 0x3F80, 0x3F80};
      lacc = MFMA32(pa0, ones, lacc); lacc = MFMA32(pa1, ones, lacc); lacc = MFMA32(pa2, ones, lacc); lacc = MFMA32(pa3, ones, lacc); }
#pragma unroll
    for (int d0 = 0; d0 < 2; ++d0) { s16x4 lo0, lo1, lo2, lo3, hi0, hi1, hi2, hi3;
        asm volatile("ds_read_b64_tr_b16 %0,%8 offset:%c9\n\tds_read_b64_tr_b16 %1,%8 offset:%c10\n\tds_read_b64_tr_b16 %2,%8 offset:%c11\n\tds_read_b64_tr_b16 %3,%8 offset:%c12\n\t"
                     "ds_read_b64_tr_b16 %4,%8 offset:%c13\n\tds_read_b64_tr_b16 %5,%8 offset:%c14\n\tds_read_b64_tr_b16 %6,%8 offset:%c15\n\tds_read_b64_tr_b16 %7,%8 offset:%c16\n\t"
                     "s_waitcnt lgkmcnt(0)"
                     : "=&v"(lo0), "=&v"(hi0), "=&v"(lo1), "=&v"(hi1), "=&v"(lo2), "=&v"(hi2), "=&v"(lo3), "=&v"(hi3)
                     : "v"(vb), "i"(d0 * 4096 + 0), "i"(d0 * 4096 + 512), "i"(d0 * 4096 + 1024), "i"(d0 * 4096 + 1536), "i"(d0 * 4096 + 2048), "i"(d0 * 4096 + 2560), "i"(d0 * 4096 + 3072), "i"(d0 * 4096 + 3584)
                     : "memory");
#define PKV(l_, h_) (bf16x8){l_[0], l_[1], l_[2], l_[3], h_[0], h_[1], h_[2], h_[3]}
        o[d0] = MFMA32(pa0, PKV(lo0, hi0), o[d0]);
        o[d0] = MFMA32(pa1, PKV(lo1, hi1), o[d0]);
        o[d0] = MFMA32(pa2, PKV(lo2, hi2), o[d0]);
        o[d0] = MFMA32(pa3, PKV(lo3, hi3), o[d0]);
#undef PKV
    }
}
struct SmState { float mhat; f32x16 o[2]; f32x16 lacc; };
__device__ __forceinline__ unsigned bfe1(unsigned w, int c) { int r; asm("v_bfe_i32 %0, %1, %2, 1" : "=v"(r) : "v"(w), "n"(c)); return (unsigned)r; }
__device__ __forceinline__ float rowmax32(const f32x16& p0, const f32x16& p1) {
    float a = fmaxf(p0[0], p1[0]);
#pragma unroll
    for (int r = 1; r < 16; ++r) a = fmaxf(a, fmaxf(p0[r], p1[r]));
    return max_halves(a);
}
constexpr int NS_QF = 53248, NS_SELS = 86016, NS_SSUM = 118784, NS_SELM = 126976;
__device__ __forceinline__ unsigned range32(int lo, int up) {
    const int l2 = lo < 0 ? 0 : lo, u2 = up > 31 ? 31 : up;
    const unsigned hm = (u2 >= 31) ? ~0u : ((2u << (u2 & 31)) - 1u);
    const unsigned lm = (1u << (l2 & 31)) - 1u;
    return (up < 0 || lo > 31 || u2 < l2) ? 0u : (hm & ~lm);
}
struct M64 { unsigned x, y; };
__device__ __forceinline__ M64 mask_range(int lo, int up) { M64 m; m.x = range32(lo, up); m.y = range32(lo - 32, up - 32); return m; }
__device__ __forceinline__ void load_q(bf16x8* qr, const bf16* qp, const float* tab, bool rope, int hi) {
#pragma unroll
    for (int d0 = 0; d0 < 4; ++d0) {
        const v4u raw = *(const v4u*)(qp + 16 * d0);
        float x[8] = {bflo(raw.x), bfhi(raw.x), bflo(raw.y), bfhi(raw.y), bflo(raw.z), bfhi(raw.z), bflo(raw.w), bfhi(raw.w)};
        if (d0 == 0) {
#pragma unroll
            for (int j = 0; j < 8; ++j) { const float other = other_half_f(x[j], hi); const float c = tab[j], sn = tab[8 + j];
                const float rot = (hi == 0) ? (x[j] * c - other * sn) : (other * sn + x[j] * c); x[j] = rope ? rot : x[j]; }
        }
        v4u pk; pk.x = cvtpk(x[0] * C2, x[1] * C2); pk.y = cvtpk(x[2] * C2, x[3] * C2); pk.z = cvtpk(x[4] * C2, x[5] * C2); pk.w = cvtpk(x[6] * C2, x[7] * C2);
        qr[d0] = __builtin_bit_cast(bf16x8, pk);
    }
}
__device__ __forceinline__ void qkt_lq(f32x16& p0, f32x16& p1, const LAS unsigned char* Kslot, const LAS bf16x8* qf, int lane, int r32, int hi) {
    const LAS unsigned char* kb = Kslot + hi * 1024 + r32 * 16;
    p0 = f32x16{}; p1 = f32x16{};
#pragma unroll
    for (int d0 = 0; d0 < 4; ++d0) {
        const bf16x8 b0 = *(const LAS bf16x8*)(kb + d0 * 2048);
        const bf16x8 b1 = *(const LAS bf16x8*)(kb + d0 * 2048 + 512);
        const bf16x8 q = qf[d0 * 64 + lane];
        p0 = MFMA32(b0, q, p0); p1 = MFMA32(b1, q, p1);
    }
}
template <bool SEL>
__device__ __forceinline__ void softmax_pv(SmState& st, f32x16& osel, f32x16& p0, f32x16& p1, unsigned vb, const M64 mcur, bool first, LAS float* wsf, int r32, int hi, int ctile) {
    (void)first; (void)wsf; (void)r32;
    const unsigned wx = mcur.x >> (4 * hi), wy = mcur.y >> (4 * hi);
    unsigned e0[16], e1[16];
#pragma unroll
    for (int r = 0; r < 16; ++r) { e0[r] = __builtin_bit_cast(unsigned, __builtin_amdgcn_exp2f(p0[r])); e1[r] = __builtin_bit_cast(unsigned, __builtin_amdgcn_exp2f(p1[r])); }
    if (FASTMASK_OFF || !__all((mcur.x & mcur.y) == ~0u)) {
#pragma unroll
        for (int r = 0; r < 16; ++r) { const int c = (r & 3) + 8 * (r >> 2); e0[r] &= bfe1(wx, c); e1[r] &= bfe1(wy, c); }
    }
#pragma unroll
    for (int r = 0; r < 16; ++r) { p0[r] = __builtin_bit_cast(float, e0[r]); p1[r] = __builtin_bit_cast(float, e1[r]); }
    unsigned pw[16];
#pragma unroll
    for (int k = 0; k < 8; ++k) { pw[k] = cvtpk(p0[2 * k], p0[2 * k + 1]); pw[8 + k] = cvtpk(p1[2 * k], p1[2 * k + 1]); }
    if (SEL) {
#pragma unroll
        for (int ks = 0; ks < 4; ++ks) {
            unsigned ov[4], pl[4];
#pragma unroll
            for (int k = 0; k < 4; ++k) {
                const int j0 = 2 * k, j1 = 2 * k + 1;
                const int c0 = 64 * ctile + 16 * ks + 8 * (j0 >> 2) + 4 * hi + (j0 & 3), c1 = 64 * ctile + 16 * ks + 8 * (j1 >> 2) + 4 * hi + (j1 & 3);
                const unsigned a = (c0 >= 4 * r32 - 1 && c0 <= 4 * r32 + 3) ? 0x3F80u : 0u, bq = (c1 >= 4 * r32 - 1 && c1 <= 4 * r32 + 3) ? 0x3F80u : 0u;
                ov[k] = a | (bq << 16);
                const int e = 4 * ks + k;
                const float v0 = (e < 8) ? p0[2 * e] : p1[2 * (e - 8)], v1 = (e < 8) ? p0[2 * e + 1] : p1[2 * (e - 8) + 1];
                pl[k] = cvtpk(v0 - bflo(pw[e]), v1 - bfhi(pw[e]));
            }
            const bf16x8 ovf = __builtin_bit_cast(bf16x8, (v4u){ov[0], ov[1], ov[2], ov[3]});
            osel = MFMA32(__builtin_bit_cast(bf16x8, (v4u){pw[4 * ks], pw[4 * ks + 1], pw[4 * ks + 2], pw[4 * ks + 3]}), ovf, osel);
            osel = MFMA32(__builtin_bit_cast(bf16x8, (v4u){pl[0], pl[1], pl[2], pl[3]}), ovf, osel);
        }
    }
    pv(st.o, st.lacc, vb, __builtin_bit_cast(bf16x8, (v4u){pw[0], pw[1], pw[2], pw[3]}), __builtin_bit_cast(bf16x8, (v4u){pw[4], pw[5], pw[6], pw[7]}),
       __builtin_bit_cast(bf16x8, (v4u){pw[8], pw[9], pw[10], pw[11]}), __builtin_bit_cast(bf16x8, (v4u){pw[12], pw[13], pw[14], pw[15]}));
}
template <bool SEL>
__device__ __forceinline__ void tile_step(SmState& st, f32x16& osel, const LAS unsigned char* Kslot, unsigned vb, const LAS bf16x8* qf, const M64 mcur, bool first, LAS float* wsf, int lane, int r32, int hi, int ctile) {
    f32x16 p0, p1;
    qkt_lq(p0, p1, Kslot, qf, lane, r32, hi);
    softmax_pv<SEL>(st, osel, p0, p1, vb, mcur, first, wsf, r32, hi, ctile);
}
__device__ __forceinline__ void qkt_rq(f32x16& p0, f32x16& p1, const LAS unsigned char* Kslot, const bf16x8* qr, int r32, int hi) {
    const LAS unsigned char* kb = Kslot + hi * 1024 + r32 * 16;
    p0 = f32x16{}; p1 = f32x16{};
#pragma unroll
    for (int d0 = 0; d0 < 4; ++d0) {
        const bf16x8 b0 = *(const LAS bf16x8*)(kb + d0 * 2048);
        const bf16x8 b1 = *(const LAS bf16x8*)(kb + d0 * 2048 + 512);
        p0 = MFMA32(b0, qr[d0], p0); p1 = MFMA32(b1, qr[d0], p1);
    }
}
__device__ __forceinline__ void sm_reset(SmState& st) { st.mhat = 0.f; st.o[0] = f32x16{}; st.o[1] = f32x16{}; st.lacc = f32x16{}; }
__device__ __forceinline__ float sigmoidf_(float x) { return 1.f / (1.f + __expf(-x)); }

__device__ __forceinline__ void dsa_attn_unit(unsigned char* ws_, int tid_, int b, int qt, LAS unsigned char* lds) {
    asm volatile("" : "+v"(tid_)); asm volatile("" : "+s"(ws_));
    const int lane = tid_ & 63, wid = __builtin_amdgcn_readfirstlane(tid_ >> 6), r32 = lane & 31, hi = lane >> 5;
    const int h = wid >> 1, qh = wid & 1;
    const size_t qrow = (size_t)b * S + 64 * qt + 32 * qh + r32;
    LAS float* wsf = (LAS float*)(lds + AT_WS) + wid * 128;
    bf16x8 qr[4];
    {
        const bf16* qp = B_PROJ + qrow * NP + C_QA + h * 64 + 8 * hi;
        const float* tab = B_ROPE + qrow * 24;
#pragma unroll
        for (int d0 = 0; d0 < 4; ++d0) {
            const v4u raw = *(const v4u*)(qp + 16 * d0);
            float x[8] = {bflo(raw.x), bfhi(raw.x), bflo(raw.y), bfhi(raw.y), bflo(raw.z), bfhi(raw.z), bflo(raw.w), bfhi(raw.w)};
            if (d0 == 0) {
#pragma unroll
                for (int j = 0; j < 8; ++j) { const float other = other_half_f(x[j], hi); const float c = tab[j], sn = tab[8 + j];
                    x[j] = (hi == 0) ? (x[j] * c - other * sn) : (other * sn + x[j] * c); }
            }
            v4u pk; pk.x = cvtpk(x[0] * C2, x[1] * C2); pk.y = cvtpk(x[2] * C2, x[3] * C2); pk.z = cvtpk(x[4] * C2, x[5] * C2); pk.w = cvtpk(x[6] * C2, x[7] * C2);
            qr[d0] = __builtin_bit_cast(bf16x8, pk);
        }
    }
    LAS bf16x8* qf = (LAS bf16x8*)(lds + NS_QF) + wid * 256;
#pragma unroll
    for (int d0 = 0; d0 < 4; ++d0) qf[d0 * 64 + lane] = qr[d0];
    const bf16* KAb = B_PROJ + (size_t)b * S * NP;
    const bf16* ksrc = KAb + (size_t)lane * NP + C_KA + wid * 8;
    const bf16* vsrc = KAb + (size_t)(16 * (wid & 3) + (lane >> 2)) * NP + C_VA + (wid >> 2) * 32 + (lane & 3) * 8;
#define AT_DMA(t, slot) do { \
        __builtin_amdgcn_global_load_lds((const unsigned*)(ksrc + (size_t)(t) * 64 * NP), (LAS unsigned*)(lds + AT_K + (slot) * 8192 + wid * 1024), 16, 0, 0); \
        __builtin_amdgcn_global_load_lds((const unsigned*)(vsrc + (size_t)(t) * 64 * NP), (LAS unsigned*)(lds + AT_V + (slot) * 8192 + wid * 1024), 16, 0, 0); } while (0)
    const unsigned vb0 = (unsigned)(uintptr_t)(lds + AT_V) + ((lane >> 4) & 1) * 32 + (lane & 3) * 8 + (4 * hi + ((lane & 15) >> 2)) * 64;
    const int NT = qt + 1;
    SmState st; sm_reset(st);
    const unsigned long long* mrow = (const unsigned long long*)((const unsigned*)(ws_ + WS_MASK) + qrow * 64);
    AT_DMA(0, 0);
    unsigned long long m0 = mrow[0], m1 = 0ull, m2 = 0ull;
    if (NT > 1) { AT_DMA(1, 1); m1 = mrow[1]; }
    int cs = 0, is = 2;
    f32x16 osel_unused = {};
#define AT_NEXT(c_) (((c_) == 2) ? 0 : (c_) + 1)
    for (int t = 0; t < NT; ++t) {
        if (t + 1 < NT) asm volatile("s_waitcnt vmcnt(3)" ::: "memory"); else asm volatile("s_waitcnt vmcnt(0)" ::: "memory");
        wg_barrier();
        if (t + 2 < NT) { AT_DMA(t + 2, is); m2 = mrow[t + 2]; }
        const unsigned long long mcur_ = m0; m0 = m1; m1 = m2;
        f32x16 p0, p1;
        qkt_lq(p0, p1, lds + AT_K + cs * 8192, qf, lane, r32, hi);
        softmax_pv<false>(st, osel_unused, p0, p1, vb0 + cs * 8192, (M64){(unsigned)mcur_, (unsigned)(mcur_ >> 32)}, t == 0, wsf, r32, hi, 0);
        cs = AT_NEXT(cs); is = AT_NEXT(is);
    }
#undef AT_NEXT
#undef AT_DMA
    {
        bf16* ob = B_MIX + ((size_t)b * S + 64 * qt + 32 * qh) * D + h * 64 + r32;
#pragma unroll
        for (int r = 0; r < 16; ++r) { const int rq = crow(r, hi); const float f = __builtin_amdgcn_rcpf(st.lacc[r]);
            ob[(size_t)rq * D] = (bf16)f2bf(st.o[0][r] * f); ob[(size_t)rq * D + 32] = (bf16)f2bf(st.o[1][r] * f); }
    }
    __syncthreads();
}


template <bool SEL>
__device__ __forceinline__ void nsa_unit(unsigned char* ws_, int tid_, int b, int g, int qt, LAS unsigned char* lds) {
    asm volatile("" : "+v"(tid_)); asm volatile("" : "+s"(ws_));
    const int lane = tid_ & 63, wid = __builtin_amdgcn_readfirstlane(tid_ >> 6), r32 = lane & 31, hi = lane >> 5;
    const int hr = wid >> 1, qh = wid & 1, H = 4 * g + hr;
    const int tq = 64 * qt + 32 * qh + r32;
    const size_t qrow = (size_t)b * S + tq;
    LAS float* wsf = (LAS float*)(lds + AT_WS) + wid * 128;
    const unsigned vb0 = (unsigned)(uintptr_t)(lds + AT_V) + ((lane >> 4) & 1) * 32 + (lane & 3) * 8 + (4 * hi + ((lane & 15) >> 2)) * 64;
    const bf16* kcb = (const bf16*)(ws_ + WS_KCB) + (size_t)(b * 2 + g) * 128 * 64;
    const bf16* vcb = (const bf16*)(ws_ + WS_VCB) + (size_t)(b * 2 + g) * 128 * 64;
    const bf16* pb = B_PROJ + (size_t)b * S * NP + g * 64;
    const int vrow = 16 * (wid & 3) + (lane >> 2), vcol = (wid >> 2) * 32 + (lane & 3) * 8;
#define NS_DMA(kp_, vp_, slot_) do { \
        __builtin_amdgcn_global_load_lds((const unsigned*)(kp_), (LAS unsigned*)(lds + AT_K + (slot_) * 8192 + wid * 1024), 16, 0, 0); \
        __builtin_amdgcn_global_load_lds((const unsigned*)(vp_), (LAS unsigned*)(lds + AT_V + (slot_) * 8192 + wid * 1024), 16, 0, 0); } while (0)
#define NS_DMA_CMP(i_, slot_) NS_DMA(kcb + (size_t)(64 * (i_) + lane) * 64 + wid * 8, vcb + (size_t)(64 * (i_) + vrow) * 64 + vcol, slot_)
#define NS_DMA_PROJ(ck_, cv_, j_, slot_) NS_DMA(pb + (size_t)(64 * (j_) + lane) * NP + (ck_) + wid * 8, pb + (size_t)(64 * (j_) + vrow) * NP + (cv_) + vcol, slot_)
    const int ncmp = (qt >= 16) ? 2 : 1;
    const int jw0 = (qt > 8) ? qt - 8 : 0, nwin = qt - jw0 + 1;
    if (hi == 0) { const bf16* gp = B_PROJ + qrow * NP + C_GATE + H * 3;
        wsf[64 + r32] = sigmoidf_(bf2f(gp[0])); wsf[96 + r32] = sigmoidf_(bf2f(gp[2])); wsf[32 + r32] = sigmoidf_(bf2f(gp[1])); }
    int nissued = 0, islot = 0, ti = 0, cslot = 0;
    unsigned remI = SEL ? 0u : ((2u << qt) - 1u);
#define NS_ISSUE() do { \
        if (nissued < ncmp) { NS_DMA_CMP(nissued, islot); } \
        else if (nissued < ncmp + nwin) { NS_DMA_PROJ(C_KWIN, C_VWIN, jw0 + nissued - ncmp, islot); } \
        else if (remI) { const int j_ = __builtin_ctz(remI); remI &= remI - 1u; NS_DMA_PROJ(C_KSLC, C_VSLC, j_, islot); } \
        else break; \
        ++nissued; islot = (islot == 2) ? 0 : islot + 1; } while (0)
#define NS_TOP() do { if (nissued > ti + 1) asm volatile("s_waitcnt vmcnt(2)" ::: "memory"); else asm volatile("s_waitcnt vmcnt(0)" ::: "memory"); wg_barrier(); NS_ISSUE(); } while (0)
#define NS_ADV() do { ++ti; cslot = (cslot == 2) ? 0 : cslot + 1; } while (0)
    NS_ISSUE(); NS_ISSUE();
    LAS bf16x8* qf = (LAS bf16x8*)(lds + NS_QF) + wid * 256;
    { bf16x8 qr[4]; load_q(qr, B_PROJ + qrow * NP + C_QB + H * 64 + 8 * hi, B_ROPE + qrow * 24, false, hi);
#pragma unroll
      for (int d0 = 0; d0 < 4; ++d0) qf[d0 * 64 + lane] = qr[d0]; }
    SmState st; sm_reset(st);
    f32x16 osel = {};
    unsigned oaccp[16];
    const int ncv = (tq >= 31) ? (((tq - 31) >> 4) + 1) : 0;
    for (int i = 0; i < ncmp; ++i) {
        NS_TOP();
        const M64 m = mask_range(0, ncv - 64 * i - 1);
        tile_step<SEL>(st, osel, lds + AT_K + cslot * 8192, vb0 + cslot * 8192, qf, m, i == 0, wsf, lane, r32, hi, i);
        NS_ADV();
    }
    {
        asm volatile("s_waitcnt lgkmcnt(0)" ::: "memory");
        LAS float* sels = (LAS float*)(lds + NS_SELS);
#pragma unroll
        for (int r = 0; r < 16; ++r) { const int rq = crow(r, hi); const float lt = st.lacc[r]; const float inv = lt > 0.f ? __builtin_amdgcn_rcpf(lt) : 0.f; const float f2 = wsf[64 + rq] * inv;
            oaccp[r] = cvtpk(st.o[0][r] * f2, st.o[1][r] * f2);
            if (SEL) sels[(hr * 64 + 32 * qh + rq) * 32 + r32] = osel[r] * inv; }
        asm volatile("s_waitcnt lgkmcnt(0)" ::: "memory");
    }
    unsigned mysel, selunion;
    if (SEL) {
        wg_barrier();
        LAS float* sels = (LAS float*)(lds + NS_SELS);
        LAS float* ssum = (LAS float*)(lds + NS_SSUM);
        LAS unsigned* selm = (LAS unsigned*)(lds + NS_SELM);
        const int q = tid_ >> 3, jg = tid_ & 7;
        f32x4 s4 = *(const LAS f32x4*)(sels + (0 * 64 + q) * 32 + 4 * jg);
        s4 += *(const LAS f32x4*)(sels + (1 * 64 + q) * 32 + 4 * jg);
        s4 += *(const LAS f32x4*)(sels + (2 * 64 + q) * 32 + 4 * jg);
        s4 += *(const LAS f32x4*)(sels + (3 * 64 + q) * 32 + 4 * jg);
        *(LAS f32x4*)(ssum + q * 32 + 4 * jg) = s4;
        asm volatile("s_waitcnt lgkmcnt(0)" ::: "memory");
        float sv[32];
#pragma unroll
        for (int k = 0; k < 8; ++k) { const f32x4 v = *(const LAS f32x4*)(ssum + q * 32 + 4 * k); sv[4 * k] = v.x; sv[4 * k + 1] = v.y; sv[4 * k + 2] = v.z; sv[4 * k + 3] = v.w; }
        const float PINF = __builtin_inff();
#pragma unroll
        for (int i = 0; i < 32; ++i) sv[i] = (i > qt) ? -PINF : ((i == 0 || i == qt || i == qt - 1) ? PINF : sv[i]);
        unsigned bits4 = 0u;
#pragma unroll
        for (int jj = 0; jj < 4; ++jj) {
            const int j = 4 * jg + jj;
            float mine = (jj == 0) ? s4.x : (jj == 1) ? s4.y : (jj == 2) ? s4.z : s4.w;
            mine = (j > qt) ? -PINF : ((j == 0 || j == qt || j == qt - 1) ? PINF : mine);
            int rank = 0;
#pragma unroll
            for (int i = 0; i < 32; ++i) rank += ((sv[i] > mine) || (sv[i] == mine && i < j)) ? 1 : 0;
            bits4 |= (rank < 16) ? (1u << jj) : 0u;
        }
        unsigned mm = bits4 << (4 * jg);
        mm |= (unsigned)dpp_i<0xB1>((int)mm); mm |= (unsigned)dpp_i<0x4E>((int)mm); mm |= (unsigned)dpp_i<0x141>((int)mm);
        if (jg == 0) selm[q] = mm;
        wg_barrier();
        unsigned u = selm[lane];
        u = or_halves(or32(u));
        selunion = (unsigned)__builtin_amdgcn_readfirstlane((int)u);
        mysel = selm[32 * qh + r32];
    } else {
        mysel = selunion = (2u << qt) - 1u;
    }
    { bf16x8 qr[4]; load_q(qr, B_PROJ + qrow * NP + C_QB + H * 64 + 8 * hi, B_ROPE + qrow * 24, true, hi);
#pragma unroll
      for (int d0 = 0; d0 < 4; ++d0) qf[d0 * 64 + lane] = qr[d0]; }
    sm_reset(st);
    if (SEL) remI = selunion;
    for (int j = jw0; j <= qt; ++j) {
        NS_TOP();
        const M64 m = mask_range(tq - 511 - 64 * j, tq - 64 * j);
        tile_step<false>(st, osel, lds + AT_K + cslot * 8192, vb0 + cslot * 8192, qf, m, j == jw0, wsf, lane, r32, hi, 0);
        NS_ADV();
    }
    {
        asm volatile("s_waitcnt lgkmcnt(0)" ::: "memory");
#pragma unroll
        for (int r = 0; r < 16; ++r) { const float lt = st.lacc[r]; const float f2 = lt > 0.f ? wsf[96 + crow(r, hi)] * __builtin_amdgcn_rcpf(lt) : 0.f; oaccp[r] = cvtpk(bflo(oaccp[r]) + st.o[0][r] * f2, bfhi(oaccp[r]) + st.o[1][r] * f2); }
        asm volatile("s_waitcnt lgkmcnt(0)" ::: "memory");
    }
    sm_reset(st);
    bool firstb = true;
    unsigned rem = selunion;
    while (rem) {
        const int j = __builtin_ctz(rem); rem &= rem - 1u;
        NS_TOP();
        M64 m = mask_range(0, tq - 64 * j); if (!((mysel >> j) & 1u)) { m.x = 0u; m.y = 0u; }
        tile_step<false>(st, osel, lds + AT_K + cslot * 8192, vb0 + cslot * 8192, qf, m, firstb, wsf, lane, r32, hi, 0);
        firstb = false; NS_ADV();
    }
    {
        asm volatile("s_waitcnt lgkmcnt(0)" ::: "memory");
        bf16* ob = B_MIX + ((size_t)b * S + 64 * qt + 32 * qh) * D + 256 + H * 64 + r32;
#pragma unroll
        for (int r = 0; r < 16; ++r) { const int rq = crow(r, hi); const float lt = st.lacc[r]; const float f2 = lt > 0.f ? wsf[32 + rq] * __builtin_amdgcn_rcpf(lt) : 0.f;
            ob[(size_t)rq * D] = (bf16)f2bf(bflo(oaccp[r]) + st.o[0][r] * f2); ob[(size_t)rq * D + 32] = (bf16)f2bf(bfhi(oaccp[r]) + st.o[1][r] * f2); }
    }
    __syncthreads();
#undef NS_DMA
#undef NS_DMA_CMP
#undef NS_DMA_PROJ
#undef NS_ISSUE
#undef NS_TOP
#undef NS_ADV
}

__device__ __forceinline__ void phase_attn(Frame& F, int l) {
    (void)l;
    unsigned char* ws_ = F.ws; asm volatile("" : "+s"(ws_)); int lane_ = lane_id(); asm volatile("" : "+v"(lane_)); (void)ws_;
    int tid_ = F.wave * 64 + lane_id(); asm volatile("" : "+v"(tid_));
    for (int u = F.vcu; u < BATCH * 64; u += F.G) {
        const int c = u & 255, i = u >> 8; const int b = c >> 3, sft = c & 7; const int base = 16 * (i >> 1); const int qt32 = (i & 1) ? base + 15 - sft : base + sft;
        dsa_select_unit(ws_, tid_, b, qt32, F.lds);
    }
    __syncthreads();
#if PROBE_MASK
    if (blockIdx.x == 0 && F.wave == 0 && lane_id() == 0) { const unsigned long long ts_ = __builtin_amdgcn_s_memrealtime(); F.MISC[16] = (unsigned)ts_; F.MISC[17] = (unsigned)(ts_ >> 32); }
#endif
    for (int u = F.vcu; u < BATCH * 64; u += F.G) {
        const int c = u & 255, i = u >> 8; const int b = c >> 3, sft = c & 7; const int g = i & 1, k = i >> 1; const int base = 16 * (k >> 1); const int qt = (k & 1) ? base + 15 - sft : base + sft;
        if (qt >= 16) nsa_unit<true>(ws_, tid_, b, g, qt, F.lds); else nsa_unit<false>(ws_, tid_, b, g, qt, F.lds);
    }
}
__device__ __forceinline__ void phase_dsa_attn(Frame& F) {
    unsigned char* ws_ = F.ws; asm volatile("" : "+s"(ws_));
    int tid_ = F.wave * 64 + lane_id(); asm volatile("" : "+v"(tid_));
    for (int u = F.vcu; u < BATCH * 32; u += F.G) {
        const int c = u & 255, i = u >> 8; const int b = c >> 3, sft = c & 7; const int base = 16 * (i >> 1); const int qt = (i & 1) ? base + 15 - sft : base + sft;
        dsa_attn_unit(ws_, tid_, b, qt, F.lds);
    }
}

constexpr int WP_PITCH = 72;
__device__ __forceinline__ void phase_merge(Frame& F, const Args& args, int l) {
    unsigned char* ws_ = F.ws; asm volatile("" : "+s"(ws_)); int lane_ = lane_id(); asm volatile("" : "+v"(lane_)); (void)ws_;
    int tid_ = F.wave * 64 + lane_id(); asm volatile("" : "+v"(tid_));
    const int gw = F.vcu * NWAVES + F.wave, NGW = F.G * NWAVES, lane = lane_;
    const float* psc = P_POOL_SCALE + l * 256;
    const float* goa = P_G_OUT_A + l * 256; const float* gob = P_G_OUT_B + l * 512;
    LAS bf16* wp = (LAS bf16*)F.lds;
    {
        const float* wsrc = P_W_POOL + (size_t)l * 4 * 64 * 64;
        for (int idx = tid_; idx < 4 * 64 * 64; idx += 512) { const int g = idx >> 12, c = (idx >> 6) & 63, d = idx & 63; wp[(g * 64 + d) * WP_PITCH + c] = (bf16)f2bf(wsrc[idx]); }
    }
    {
        constexpr int RB = 4;
        const f32x4 gga = ((const f32x4*)goa)[lane]; const f32x4 gb0 = ((const f32x4*)gob)[2 * lane], gb1 = ((const f32x4*)gob)[2 * lane + 1];
        for (int row0 = gw * RB; row0 < M; row0 += NGW * RB) {
            unsigned long long ua[RB]; v4u ub[RB];
#pragma unroll
            for (int k = 0; k < RB; ++k) { const bf16* mrow = B_MIX + (size_t)(row0 + k) * D; ua[k] = *((const unsigned long long*)mrow + lane); ub[k] = *((const v4u*)(mrow + 256) + lane); }
#pragma unroll
            for (int k = 0; k < RB; ++k) { bf16* mrow = B_MIX + (size_t)(row0 + k) * D;
                { const unsigned long long u = ua[k];
                  const float a0 = bflo((unsigned)u), a1 = bfhi((unsigned)u), a2 = bflo((unsigned)(u >> 32)), a3 = bfhi((unsigned)(u >> 32));
                  const float rs = rsqrtf(wave_sum((a0 * a0 + a1 * a1) + (a2 * a2 + a3 * a3)) * (1.f / 256.f) + EPS);
                  *((unsigned long long*)mrow + lane) = (unsigned long long)pk2(a0 * rs * gga.x, a1 * rs * gga.y) | ((unsigned long long)pk2(a2 * rs * gga.z, a3 * rs * gga.w) << 32); }
                { const v4u u = ub[k];
                  float a[8] = {bflo(u.x), bfhi(u.x), bflo(u.y), bfhi(u.y), bflo(u.z), bfhi(u.z), bflo(u.w), bfhi(u.w)};
                  float ss = 0.f;
#pragma unroll
                  for (int i = 0; i < 8; ++i) ss += a[i] * a[i];
                  const float rs = rsqrtf(wave_sum(ss) * (1.f / 512.f) + EPS);
                  v4u o; o.x = pk2(a[0] * rs * gb0.x, a[1] * rs * gb0.y); o.y = pk2(a[2] * rs * gb0.z, a[3] * rs * gb0.w); o.z = pk2(a[4] * rs * gb1.x, a[5] * rs * gb1.y); o.w = pk2(a[6] * rs * gb1.z, a[7] * rs * gb1.w);
                  *((v4u*)(mrow + 256) + lane) = o; }
            }
        }
    }
    __syncthreads();
    {
        const int r32 = lane & 31, hi = lane >> 5;
        for (int tile = gw; tile < M / 32; tile += NGW) {
            const int row = 32 * tile + r32, t = row % S;
            const bf16* up = B_PROJ + (size_t)row * NP + C_UC + 8 * hi;
            f32x16 acc[4][2];
#pragma unroll
            for (int g = 0; g < 4; ++g) {
                acc[g][0] = f32x16{}; acc[g][1] = f32x16{};
                const int w = 2 << g;
                const float icnt = 1.f / (float)((t + 1 < w) ? t + 1 : w);
#pragma unroll
                for (int ks = 0; ks < 4; ++ks) {
                    const bf16* p0 = up + g * 64 + 16 * ks;
                    const v4u u0 = *(const v4u*)p0;
                    float cur[8] = {bflo(u0.x), bfhi(u0.x), bflo(u0.y), bfhi(u0.y), bflo(u0.z), bfhi(u0.z), bflo(u0.w), bfhi(u0.w)};
                    float sum[8];
#pragma unroll
                    for (int j = 0; j < 8; ++j) sum[j] = cur[j];
#pragma unroll
                    for (int i = 1; i < w; ++i) {
                        if (t - i >= 0) { const v4u ui = *(const v4u*)(p0 - (size_t)i * NP);
                            sum[0] += bflo(ui.x); sum[1] += bfhi(ui.x); sum[2] += bflo(ui.y); sum[3] += bfhi(ui.y); sum[4] += bflo(ui.z); sum[5] += bfhi(ui.z); sum[6] += bflo(ui.w); sum[7] += bfhi(ui.w); }
                    }
                    v4u pk; pk.x = cvtpk(sum[0] * icnt - cur[0], sum[1] * icnt - cur[1]); pk.y = cvtpk(sum[2] * icnt - cur[2], sum[3] * icnt - cur[3]);
                    pk.z = cvtpk(sum[4] * icnt - cur[4], sum[5] * icnt - cur[5]); pk.w = cvtpk(sum[6] * icnt - cur[6], sum[7] * icnt - cur[7]);
                    const bf16x8 af = __builtin_bit_cast(bf16x8, pk);
#pragma unroll
                    for (int nb = 0; nb < 2; ++nb) {
                        const bf16x8 bfr = *(const LAS bf16x8*)(wp + (g * 64 + 32 * nb + r32) * WP_PITCH + 16 * ks + 8 * hi);
                        acc[g][nb] = MFMA32(af, bfr, acc[g][nb]);
                    }
                }
            }
            float ss[16];
#pragma unroll
            for (int r = 0; r < 16; ++r) { float a = 0.f;
#pragma unroll
                for (int g = 0; g < 4; ++g) a += acc[g][0][r] * acc[g][0][r] + acc[g][1][r] * acc[g][1][r];
                a = sum32(a);
                ss[r] = rsqrtf(a * (1.f / 256.f) + EPS); }
            bf16* ob = B_MIX + (size_t)(32 * tile) * D + 768 + r32;
#pragma unroll
            for (int g = 0; g < 4; ++g)
#pragma unroll
                for (int nb = 0; nb < 2; ++nb) { const float sc = psc[g * 64 + 32 * nb + r32];
#pragma unroll
                    for (int r = 0; r < 16; ++r) ob[(size_t)crow(r, hi) * D + g * 64 + 32 * nb] = (bf16)f2bf(acc[g][nb][r] * ss[r] * sc); }
        }
    }
    __syncthreads();
}

template <bool XIN_F32, bool OUT_F32>
__device__ __forceinline__ void phase_finish(Frame& F, const float* xsrc, const float* gpost, const float* gnext  ) {
    unsigned char* ws_ = F.ws; asm volatile("" : "+s"(ws_)); int lane_ = lane_id(); asm volatile("" : "+v"(lane_)); (void)ws_;
    const int gw = F.vcu * NWAVES + F.wave, NGW = F.G * NWAVES, lane = lane_;
    bf16* xb = (bf16*)(ws_ + WS_XB);
    constexpr int RB = 4;
    for (int row0 = gw * RB; row0 < M; row0 += NGW * RB) {
        v4u fu[RB][2]; float x[RB][2][8];
#pragma unroll
        for (int k = 0; k < RB; ++k) { const size_t row = (size_t)(row0 + k);
#pragma unroll
            for (int j = 0; j < 2; ++j) { fu[k][j] = *((const v4u*)(B_F + row * D + 512 * j) + lane);
                if (XIN_F32) { const f32x4 a = *((const f32x4*)(xsrc + row * D + 512 * j) + 2 * lane), c = *((const f32x4*)(xsrc + row * D + 512 * j) + 2 * lane + 1);
                    x[k][j][0] = a.x; x[k][j][1] = a.y; x[k][j][2] = a.z; x[k][j][3] = a.w; x[k][j][4] = c.x; x[k][j][5] = c.y; x[k][j][6] = c.z; x[k][j][7] = c.w; }
                else { const v4u ux = *((const v4u*)(xb + row * D + 512 * j) + lane);
                    x[k][j][0] = bflo(ux.x); x[k][j][1] = bfhi(ux.x); x[k][j][2] = bflo(ux.y); x[k][j][3] = bfhi(ux.y); x[k][j][4] = bflo(ux.z); x[k][j][5] = bfhi(ux.z); x[k][j][6] = bflo(ux.w); x[k][j][7] = bfhi(ux.w); } } }
        float gp[2][8], gn[2][8];
#pragma unroll
        for (int j = 0; j < 2; ++j) { const f32x4 a = *((const f32x4*)(gpost + 512 * j) + 2 * lane), c = *((const f32x4*)(gpost + 512 * j) + 2 * lane + 1);
            gp[j][0] = a.x; gp[j][1] = a.y; gp[j][2] = a.z; gp[j][3] = a.w; gp[j][4] = c.x; gp[j][5] = c.y; gp[j][6] = c.z; gp[j][7] = c.w;
            if (gnext) { const f32x4 a2 = *((const f32x4*)(gnext + 512 * j) + 2 * lane), c2 = *((const f32x4*)(gnext + 512 * j) + 2 * lane + 1);
                gn[j][0] = a2.x; gn[j][1] = a2.y; gn[j][2] = a2.z; gn[j][3] = a2.w; gn[j][4] = c2.x; gn[j][5] = c2.y; gn[j][6] = c2.z; gn[j][7] = c2.w; }
            else {
#pragma unroll
                for (int e = 0; e < 8; ++e) gn[j][e] = 0.f; } }
#pragma unroll
        for (int k = 0; k < RB; ++k) { const size_t row = (size_t)(row0 + k);
            float f[2][8]; float ss = 0.f;
#pragma unroll
            for (int j = 0; j < 2; ++j) { const v4u u = fu[k][j];
                f[j][0] = bflo(u.x); f[j][1] = bfhi(u.x); f[j][2] = bflo(u.y); f[j][3] = bfhi(u.y); f[j][4] = bflo(u.z); f[j][5] = bfhi(u.z); f[j][6] = bflo(u.w); f[j][7] = bfhi(u.w);
#pragma unroll
                for (int e = 0; e < 8; ++e) ss += f[j][e] * f[j][e]; }
            const float rs = rsqrtf(wave_sum(ss) * (1.f / D) + EPS);
            float s2 = 0.f;
#pragma unroll
            for (int j = 0; j < 2; ++j) {
#pragma unroll
                for (int e = 0; e < 8; ++e) { const float xv = x[k][j][e] + f[j][e] * rs * gp[j][e]; x[k][j][e] = xv; s2 += xv * xv; }
                if (OUT_F32) { f32x4* o = (f32x4*)(F.out + row * D + 512 * j) + 2 * lane;
                    o[0] = (f32x4){x[k][j][0], x[k][j][1], x[k][j][2], x[k][j][3]}; o[1] = (f32x4){x[k][j][4], x[k][j][5], x[k][j][6], x[k][j][7]}; }
                else *((v4u*)(xb + row * D + 512 * j) + lane) = (v4u){pk2(x[k][j][0], x[k][j][1]), pk2(x[k][j][2], x[k][j][3]), pk2(x[k][j][4], x[k][j][5]), pk2(x[k][j][6], x[k][j][7])};
            }
            if (gnext) {
                const float r2 = rsqrtf(wave_sum(s2) * (1.f / D) + EPS);
#pragma unroll
                for (int j = 0; j < 2; ++j)
                    *((v4u*)(B_H + row * D + 512 * j) + lane) = (v4u){pk2(x[k][j][0] * r2 * gn[j][0], x[k][j][1] * r2 * gn[j][1]), pk2(x[k][j][2] * r2 * gn[j][2], x[k][j][3] * r2 * gn[j][3]),
                                                                      pk2(x[k][j][4] * r2 * gn[j][4], x[k][j][5] * r2 * gn[j][5]), pk2(x[k][j][6] * r2 * gn[j][6], x[k][j][7] * r2 * gn[j][7])};
            }
        }
    }
}

template <int ACT>
__device__ __forceinline__ void phase_gemm(Frame& F, const bf16* A, const bf16* Bt, bf16* O, int N, int K) {
    asm volatile("" : "+s"(A), "+s"(Bt), "+s"(O));
    pg8::Gemm g{A, Bt, M, N, K}; pg8::StaticOrder So; So.init(M, N, F.G, (int)blockIdx.x);
    pg8::EpiStore<ACT> E{O, N};
    pg8::gemm_phase<pg8::EpiStore<ACT>, pg8::StaticOrder, true, true>(F.lds, g, So, E, F.wave);
}

constexpr int PH_PER_LAYER = 10, NPHASES = 1 + DEPTH * PH_PER_LAYER;
__global__ void __launch_bounds__(NWAVES * 64, 2) mk_fwd(Args args) {
    extern __shared__ __attribute__((aligned(16))) unsigned char lds[];
    Frame F;
    F.lds = (LAS unsigned char*)lds;
    F.MISC = (volatile LAS unsigned*)(F.lds + MISC_OFF);
    { const int t0_ = threadIdx.x; F.wave = __builtin_amdgcn_readfirstlane(t0_ >> 6);
      for (int u = t0_; u < (LDS_BYTES - LDSCTL_OFF) / 4; u += NWAVES * 64) ((LAS unsigned*)(F.lds + LDSCTL_OFF))[u] = 0u; }
    F.G = gridDim.x; { const int bx = blockIdx.x; F.vcu = (F.G % 8 == 0) ? (bx % 8) * (F.G / 8) + bx / 8 : bx; }
    unsigned char* ws = args.ws; F.ws = ws;
    F.ctl = (gu32*)(ws + WS_CTL);
    F.out = args.out;
    __syncthreads();
    XcdBarrier bar; bar.bar = (unsigned*)(F.ctl + CW_BAR); bar.x = 0; bar.st = F.MISC + 8; bar.wv = 0;
    if (args.use_bar) bar = xcd_barrier_post((unsigned*)(F.ctl + CW_BAR), F.MISC + 8);
    bar.wv = F.wave;
    const int lo = args.ph_lo, hi = args.ph_hi;
    int pid = 0;
    unsigned char* ws_ = F.ws;
#define PH_ON (pid >= lo && pid < hi)
#if PROBE_MASK
    if (blockIdx.x == 0 && F.wave == 0 && lane_id() == 0) { const unsigned long long t_ = __builtin_amdgcn_s_memrealtime(); F.MISC[18] = (unsigned)t_; F.MISC[19] = (unsigned)(t_ >> 32); F.MISC[20] = 0u; F.MISC[21] = 0u; }
#define PH_END(kind) do { if (PH_ON && pid + 1 < hi) xcd_barrier(bar); ++pid; \
        if (blockIdx.x == 0 && F.wave == 0 && lane_id() == 0) { const unsigned long long now_ = __builtin_amdgcn_s_memrealtime(); \
          const unsigned long long last_ = (unsigned long long)F.MISC[18] | ((unsigned long long)F.MISC[19] << 32); unsigned long long acc_ = (unsigned long long)F.MISC[20] | ((unsigned long long)F.MISC[21] << 32); \
          if ((kind) == 3) { const unsigned long long sp_ = (unsigned long long)F.MISC[16] | ((unsigned long long)F.MISC[17] << 32); \
              if ((PROBE_MASK >> 11) & 1) acc_ += sp_ - last_; if ((PROBE_MASK >> 3) & 1) acc_ += now_ - sp_; } \
          else if ((PROBE_MASK >> (kind)) & 1) acc_ += now_ - last_; \
          F.MISC[18] = (unsigned)now_; F.MISC[19] = (unsigned)(now_ >> 32); F.MISC[20] = (unsigned)acc_; F.MISC[21] = (unsigned)(acc_ >> 32); } } while (0)
#else
#define PH_END(kind) do { if (PH_ON && pid + 1 < hi) xcd_barrier(bar); ++pid; } while (0)
#endif

    if (PH_ON && !(SKIPM & 1)) phase_prologue(F, args);
    PH_END(0);
    for (int l = 0; l < DEPTH; ++l) {
        if (PH_ON && !(SKIPM & 2)) phase_gemm<0>(F, B_H, w_in_t(ws_, l), B_PROJ, NP, D);
        PH_END(1);
        if (PH_ON && !(SKIPM & 4)) phase_prep(F, args, l);
        PH_END(2);
        if (PH_ON && !(SKIPM & 8)) phase_attn(F, l);
        PH_END(3);
        if (PH_ON && !(SKIPM & 8)) phase_dsa_attn(F);
        PH_END(4);
        if (PH_ON && !(SKIPM & 16)) phase_merge(F, args, l);
        PH_END(5);
        if (PH_ON && !(SKIPM & 32)) phase_gemm<0>(F, B_MIX, w_out_t(ws_, l), B_F, D, D);
        PH_END(6);
        if (PH_ON && !(SKIPM & 64)) { if (l == 0) phase_finish<true, false>(F, P_X_IN, P_G_POST_MIX + l * D, P_G_PRE_MLP + l * D); else phase_finish<false, false>(F, nullptr, P_G_POST_MIX + l * D, P_G_PRE_MLP + l * D); }
        PH_END(7);
        if (PH_ON && !(SKIPM & 128)) phase_gemm<2>(F, B_H, w_up_t(ws_, l), B_HID, FF, D);
        PH_END(8);
        if (PH_ON && !(SKIPM & 256)) phase_gemm<0>(F, B_HID, w_dn_t(ws_, l), B_F, D, FF);
        PH_END(9);
        if (PH_ON && !(SKIPM & 512)) { if (l + 1 < DEPTH) phase_finish<false, false>(F, nullptr, P_G_POST_MLP + l * D, P_G_PRE_MIX + (l + 1) * D); else phase_finish<false, true>(F, nullptr, P_G_POST_MLP + l * D, nullptr); }
        PH_END(10);
    }
#if PROBE_MASK
    if (blockIdx.x == 0 && F.wave == 0 && lane_id() == 0) { const unsigned long long pr_acc = (unsigned long long)F.MISC[20] | ((unsigned long long)F.MISC[21] << 32);
        const unsigned long long t0_ = __builtin_amdgcn_s_memrealtime(); while (__builtin_amdgcn_s_memrealtime() - t0_ < pr_acc) __builtin_amdgcn_s_sleep(8); }
#endif
#undef PH_ON
#undef PH_END
}

extern "C" void kernel_launch(void* const* d_in, const int* in_sizes, int n_in, void* d_out, int out_size, void* d_ws, size_t ws_size, hipStream_t stream) {
    static int grid = 0;
    if (grid == 0) {
        if (n_in != 20 || in_sizes[0] != M * D || out_size != M * D || ws_size < WS_END) {
            fprintf(stderr, "kernel_launch: unexpected shapes / workspace (n_in %d, in0 %d, out %d, ws %zu < %zu); nothing launched\n", n_in, n_in > 0 ? in_sizes[0] : -1, out_size, ws_size, (size_t)WS_END);
            grid = -1; return; }
        int dev = 0, cus = 0, per_cu = 0;
        if (hipGetDevice(&dev) != hipSuccess || hipDeviceGetAttribute(&cus, hipDeviceAttributeMultiprocessorCount, dev) != hipSuccess) { grid = -1; return; }
        if (hipFuncSetAttribute((const void*)mk_fwd, hipFuncAttributeMaxDynamicSharedMemorySize, LDS_BYTES) != hipSuccess) { fprintf(stderr, "kernel_launch: hipFuncSetAttribute failed\n"); grid = -1; return; }
        if (hipOccupancyMaxActiveBlocksPerMultiprocessor(&per_cu, (const void*)mk_fwd, NWAVES * 64, LDS_BYTES) != hipSuccess || per_cu < 1)
            fprintf(stderr, "kernel_launch: note: occupancy query reports %d workgroups per CU\n", per_cu);
        (void)hipGetLastError();
        grid = cus;
    }
    if (grid < 0) return;
    if (hipMemsetAsync((char*)d_ws + WS_CTL, 0, CTL_ZERO_BYTES, stream) != hipSuccess) return;
    Args a{};
    for (int i = 0; i < 20; ++i) a.in[i] = d_in[i];
    a.out = (float*)d_out; a.ws = (unsigned char*)d_ws; a.pad = 0;
#if MK_MULTI
    for (int p = 0; p < NPHASES; ++p) {
        a.ph_lo = p; a.ph_hi = p + 1; a.use_bar = 0;
        hipLaunchKernelGGL(mk_fwd, dim3(grid), dim3(NWAVES * 64), LDS_BYTES, stream, a);
    }
#else
    a.ph_lo = 0; a.ph_hi = NPHASES; a.use_bar = 1;
    hipLaunchKernelGGL(mk_fwd, dim3(grid), dim3(NWAVES * 64), LDS_BYTES, stream, a);
#endif
}
```

```cpp
#include <hip/hip_runtime.h>
#include <cstdio>
#include <cstdint>

#define FASTMASK_OFF 0
#ifndef PROBE_MASK
#define PROBE_MASK 0
#endif
#ifndef SKIPM
#define SKIPM 0
#endif
#ifndef MK_MULTI
#define MK_MULTI 0
#endif

__device__ __forceinline__ int lane_id() { int l; asm volatile("v_mbcnt_lo_u32_b32 %0, -1, 0\n\tv_mbcnt_hi_u32_b32 %0, -1, %0" : "=v"(l)); return l; }
namespace pg8 {
#define PG8_LAS __attribute__((address_space(3)))
typedef unsigned short bf16_t;
typedef short bf16x8 __attribute__((ext_vector_type(8)));
typedef float f32x4 __attribute__((ext_vector_type(4)));
typedef unsigned u32x4 __attribute__((ext_vector_type(4)));
constexpr int BM = 256, BK = 64, HALF = 128, HTB = HALF * BK * 2, STAGE_BYTES = 8 * HTB, NXCD = 8, WGM = 8;

__host__ __device__ __forceinline__ int lds_byte(int r, int c) { const int st = (r >> 4) * 2 + (c >> 5), rr = r & 15, cc = c & 31, ob = rr * 64 + cc * 2; return st * 1024 + (ob ^ (((ob >> 9) & 1) << 5)); }
__host__ __device__ __forceinline__ void stage_rc(int b, int& R, int& C) { const int st = b / 1024, sb = b % 1024, swz = sb ^ (((sb >> 9) & 1) << 5); R = (st >> 1) * 16 + swz / 64; C = (st & 1) * 32 + (swz % 64) / 2; }
__host__ __device__ __forceinline__ int perm32(int rho) { const int n = rho >> 4, i = rho & 15; return 8 * (i >> 2) + 4 * n + (i & 3); }

struct Unit { int pm, pn; };
struct Gemm { const bf16_t* A; const bf16_t* Bt; int M, N, K; };

struct StaticOrder {
    int nM, nN, nwg, G, c;
    __host__ __device__ void init(int M, int N, int G_, int c_) { nM = M / BM; nN = N / BM; nwg = nM * nN; G = G_; c = c_; }
    __host__ __device__ bool next(int i, Unit& u) const {
        const long L = (long)i * G + c; if (L >= nwg) return false;
        int wgid = (int)L; { const int q = nwg / NXCD, r = nwg % NXCD, xcd = wgid % NXCD, off = wgid / NXCD; wgid = (xcd < r ? xcd * (q + 1) : r * (q + 1) + (xcd - r) * q) + off; }
        const int nig = WGM * nN, gid = wgid / nig, fm = gid * WGM, gsz = (nM - fm) < WGM ? (nM - fm) : WGM;
        u.pm = fm + ((wgid % nig) % gsz); u.pn = (wgid % nig) / gsz; return true;
    }
    __device__ __forceinline__ void a_ready(const Unit&) const {}
    __device__ __forceinline__ void done(const Unit&) const {}
};

__device__ __forceinline__ unsigned cvt_pk_bf16(float lo, float hi) { unsigned r; asm volatile("v_cvt_pk_bf16_f32 %0, %1, %2" : "=v"(r) : "v"(lo), "v"(hi)); return r; }

template <int ACT  > struct EpiStore {
    static constexpr bool PERM = true, AFTER_DRAIN = false;
    bf16_t* O; int ldc; const float* rs;
    __device__ __forceinline__ void operator()(const f32x4 (&acc)[2][2][4][2], const Unit& u, int wr, int wc, int fr, int fq) const {
        const int row0 = u.pm * BM + wr * 64 + fr;
        const int col0 = u.pn * BM + wc * 32 + 8 * fq;
#pragma unroll
        for (int ai = 0; ai < 2; ++ai)
#pragma unroll
            for (int m = 0; m < 4; ++m) { const int row = row0 + ai * HALF + m * 16; bf16_t* rowp = O + (size_t)row * ldc + col0;
                const float sc = rs ? rs[row] : 1.f;
#pragma unroll
                for (int bj = 0; bj < 2; ++bj) { f32x4 v0 = acc[ai][bj][m][0] * sc, v1 = acc[ai][bj][m][1] * sc;
                    if (ACT == 2) {
#pragma unroll
                        for (int e = 0; e < 4; ++e) { const float a = fmaxf(v0[e], 0.f), b = fmaxf(v1[e], 0.f); v0[e] = a * a; v1[e] = b * b; } }
                    u32x4 w; w.x = cvt_pk_bf16(v0[0], v0[1]); w.y = cvt_pk_bf16(v0[2], v0[3]); w.z = cvt_pk_bf16(v1[0], v1[1]); w.w = cvt_pk_bf16(v1[2], v1[3]);
                    *(u32x4*)(rowp + bj * HALF) = w; }
                asm volatile("" ::: "memory"); }
    }
};

template <class Epi, class Sched, bool ALIGN_EPI = false, bool SP2 = false>
__device__ __forceinline__ void gemm_phase(PG8_LAS unsigned char* lds, const Gemm g, const Sched& S, const Epi& E, int wave_) {
    int tid_ = wave_ * 64 + lane_id(); asm volatile("" : "+v"(tid_));
    const int tid = tid_, wid = __builtin_amdgcn_readfirstlane(tid >> 6), lane = tid & 63, wr = wid >> 2, wc = wid & 3, fr = lane & 15, fq = lane >> 4;
    const int K = g.K, nt = K / BK;
    unsigned voffA[2], voffB[2];
#pragma unroll
    for (int i = 0; i < 2; ++i) { int R, C; stage_rc(tid * 16 + i * 8192, R, C); const int Rb = Epi::PERM ? ((R & ~31) + perm32(R & 31)) : R;
        voffA[i] = (unsigned)(R * K + C) * 2u; voffB[i] = (unsigned)(Rb * K + C) * 2u; }
    const size_t kstep = (size_t)(BK * 2);
    const size_t hstep = (size_t)HALF * K * 2;
    const size_t tstep = 2 * hstep;
    const unsigned ldsw = (unsigned)wid * 1024u;
    const int aoff = lds_byte(wr * 64 + fr, fq * 8), boff = lds_byte(wc * 32 + fr, fq * 8);
#define PG8_SA(b, h) (((b) * 2 + (h)) * HTB)
#define PG8_SB(b, h) ((4 + (b) * 2 + (h)) * HTB)
#define PG8_STAGE(bufoff, gbase, voff) do { _Pragma("unroll") for (int _i = 0; _i < 2; ++_i) \
        __builtin_amdgcn_global_load_lds((const unsigned*)((const char*)(gbase) + (voff)[_i]), (PG8_LAS unsigned*)(lds + (bufoff) + ldsw + _i * 8192), 16, 0, 0); } while (0)
#define PG8_LDA(dst, b, h) do { _Pragma("unroll") for (int m = 0; m < 4; ++m) _Pragma("unroll") for (int k = 0; k < 2; ++k) dst[m][k] = *(const PG8_LAS bf16x8*)(lds + PG8_SA(b, h) + aoff + m * 2048 + k * 1024); } while (0)
#define PG8_LDB(dst, b, h) do { _Pragma("unroll") for (int n = 0; n < 2; ++n) _Pragma("unroll") for (int k = 0; k < 2; ++k) dst[n][k] = *(const PG8_LAS bf16x8*)(lds + PG8_SB(b, h) + boff + n * 2048 + k * 1024); } while (0)
#define PG8_MMA(ai, bj, At, Bt) do { __builtin_amdgcn_s_setprio(1); _Pragma("unroll") for (int m = 0; m < 4; ++m) _Pragma("unroll") for (int n = 0; n < 2; ++n) _Pragma("unroll") for (int k = 0; k < 2; ++k) \
        acc[ai][bj][m][n] = __builtin_amdgcn_mfma_f32_16x16x32_bf16(Bt[n][k], At[m][k], acc[ai][bj][m][n], 0, 0, 0); __builtin_amdgcn_s_setprio(0); } while (0)
#define PG8_WAIT_V(n) asm volatile("s_waitcnt vmcnt(" #n ")" ::: "memory")
#define PG8_WAIT_L(n) asm volatile("s_waitcnt lgkmcnt(" #n ")" ::: "memory")
#define PG8_BAR __builtin_amdgcn_s_barrier()
#define PG8_SCHED __builtin_amdgcn_sched_barrier(0)
    Unit cur, nxt; int ui = 0;
    if (!S.next(0, cur)) return;
    f32x4 acc[2][2][4][2];
#pragma unroll
    for (int a = 0; a < 2; ++a)
#pragma unroll
        for (int b = 0; b < 2; ++b)
#pragma unroll
            for (int m = 0; m < 4; ++m)
#pragma unroll
                for (int n = 0; n < 2; ++n) acc[a][b][m][n] = (f32x4){0.f, 0.f, 0.f, 0.f};
    bf16x8 At[4][2], B0[2][2], B1[2][2];
    const char* cA = (const char*)g.A + (size_t)cur.pm * tstep; const char* cB = (const char*)g.Bt + (size_t)cur.pn * tstep;
    S.a_ready(cur);
    if constexpr (SP2) {
        PG8_STAGE(PG8_SB(0, 0), cB, voffB); PG8_STAGE(PG8_SB(0, 1), cB + hstep, voffB); PG8_STAGE(PG8_SA(0, 0), cA, voffA); PG8_STAGE(PG8_SA(0, 1), cA + hstep, voffA);
        if (wr == 1) PG8_BAR;
        PG8_WAIT_V(2); PG8_BAR;
        PG8_STAGE(PG8_SB(1, 0), cB + kstep, voffB); PG8_STAGE(PG8_SA(1, 0), cA + kstep, voffA); PG8_STAGE(PG8_SB(1, 1), cB + hstep + kstep, voffB);
        PG8_WAIT_V(6); PG8_BAR;
    } else {
        PG8_STAGE(PG8_SB(0, 0), cB, voffB); PG8_STAGE(PG8_SA(0, 0), cA, voffA); PG8_STAGE(PG8_SB(0, 1), cB + hstep, voffB); PG8_STAGE(PG8_SA(0, 1), cA + hstep, voffA);
        if (wr == 1) PG8_BAR;
        PG8_WAIT_V(4); PG8_BAR;
        PG8_STAGE(PG8_SB(1, 0), cB + kstep, voffB); PG8_STAGE(PG8_SA(1, 0), cA + kstep, voffA); PG8_STAGE(PG8_SB(1, 1), cB + hstep + kstep, voffB);
        PG8_WAIT_V(6); PG8_BAR;
    }
    for (;;) {
        const bool has_next = S.next(ui + 1, nxt);
        const char* nA = has_next ? (const char*)g.A + (size_t)nxt.pm * tstep : cA; const char* nB = has_next ? (const char*)g.Bt + (size_t)nxt.pn * tstep : cB;
        for (int t = 0; t < nt; t += 2) {
            const bool last = (t == nt - 2);
            const char* a1 = cA + (size_t)(t + 1) * kstep;
            const char* a2 = last ? nA : cA + (size_t)(t + 2) * kstep; const char* b2 = last ? nB : cB + (size_t)(t + 2) * kstep;
            const char* a3 = a2 + kstep; const char* b3 = b2 + kstep;
            if (last && has_next) S.a_ready(nxt);
            if constexpr (SP2) {
            PG8_LDB(B0, 0, 0); PG8_LDB(B1, 0, 1); PG8_SCHED; PG8_LDA(At, 0, 0); PG8_STAGE(PG8_SA(1, 1), a1 + hstep, voffA);
            PG8_WAIT_V(8); PG8_WAIT_L(0); PG8_BAR; PG8_MMA(0, 0, At, B0); PG8_MMA(0, 1, At, B1); PG8_BAR; PG8_SCHED;
            PG8_LDA(At, 0, 1); PG8_STAGE(PG8_SB(0, 0), b2, voffB); PG8_STAGE(PG8_SB(0, 1), b2 + hstep, voffB); PG8_STAGE(PG8_SA(0, 0), a2, voffA);
            PG8_WAIT_V(8); PG8_WAIT_L(0); PG8_BAR; PG8_MMA(1, 0, At, B0); PG8_MMA(1, 1, At, B1); PG8_BAR; PG8_SCHED;
            PG8_LDB(B0, 1, 0); PG8_LDB(B1, 1, 1); PG8_SCHED; PG8_LDA(At, 1, 0); PG8_STAGE(PG8_SA(0, 1), a2 + hstep, voffA);
            PG8_WAIT_V(8); PG8_WAIT_L(0); PG8_BAR; PG8_MMA(0, 0, At, B0); PG8_MMA(0, 1, At, B1); PG8_BAR; PG8_SCHED;
            PG8_LDA(At, 1, 1); PG8_STAGE(PG8_SB(1, 0), b3, voffB); PG8_STAGE(PG8_SB(1, 1), b3 + hstep, voffB); PG8_STAGE(PG8_SA(1, 0), a3, voffA);
            PG8_WAIT_V(8); PG8_WAIT_L(0); PG8_BAR; PG8_MMA(1, 0, At, B0); PG8_MMA(1, 1, At, B1); PG8_BAR; PG8_SCHED;
            } else {
            PG8_LDB(B0, 0, 0); PG8_SCHED; PG8_LDA(At, 0, 0); PG8_STAGE(PG8_SA(1, 1), a1 + hstep, voffA);
            PG8_WAIT_L(8); PG8_BAR; PG8_WAIT_L(0); PG8_MMA(0, 0, At, B0); PG8_BAR; PG8_SCHED;
            PG8_LDB(B1, 0, 1); PG8_STAGE(PG8_SB(0, 0), b2, voffB);
            PG8_BAR; PG8_WAIT_L(0); PG8_MMA(0, 1, At, B1); PG8_BAR;
            PG8_LDA(At, 0, 1); PG8_STAGE(PG8_SA(0, 0), a2, voffA);
            PG8_BAR; PG8_WAIT_L(0); PG8_MMA(1, 0, At, B0); PG8_BAR; PG8_SCHED;
            PG8_STAGE(PG8_SB(0, 1), b2 + hstep, voffB);
            PG8_WAIT_V(6); PG8_BAR; PG8_MMA(1, 1, At, B1); PG8_BAR;
            PG8_LDB(B0, 1, 0); PG8_SCHED; PG8_LDA(At, 1, 0); PG8_STAGE(PG8_SA(0, 1), a2 + hstep, voffA);
            PG8_WAIT_L(8); PG8_BAR; PG8_WAIT_L(0); PG8_MMA(0, 0, At, B0); PG8_BAR; PG8_SCHED;
            PG8_LDB(B1, 1, 1); PG8_STAGE(PG8_SB(1, 0), b3, voffB);
            PG8_BAR; PG8_WAIT_L(0); PG8_MMA(0, 1, At, B1); PG8_BAR;
            PG8_LDA(At, 1, 1); PG8_STAGE(PG8_SA(1, 0), a3, voffA);
            PG8_BAR; PG8_WAIT_L(0); PG8_MMA(1, 0, At, B0); PG8_BAR; PG8_SCHED;
            PG8_STAGE(PG8_SB(1, 1), b3 + hstep, voffB);
            PG8_WAIT_V(6); PG8_BAR; PG8_MMA(1, 1, At, B1); PG8_BAR;
            }
        }
        if constexpr (ALIGN_EPI) { if (wr == 0) PG8_BAR; }
        if constexpr (!Epi::AFTER_DRAIN) { E(acc, cur, wr, wc, fr, fq); S.done(cur); }
        if (!has_next) break;
#pragma unroll
        for (int a = 0; a < 2; ++a)
#pragma unroll
            for (int b = 0; b < 2; ++b)
#pragma unroll
                for (int m = 0; m < 4; ++m)
#pragma unroll
                    for (int n = 0; n < 2; ++n) acc[a][b][m][n] = (f32x4){0.f, 0.f, 0.f, 0.f};
        cur = nxt; cA = nA; cB = nB; ++ui;
        if constexpr (ALIGN_EPI) { if (wr == 1) PG8_BAR; }
    }
    PG8_WAIT_V(0);
    if constexpr (!ALIGN_EPI) { if (wr == 0) PG8_BAR; }
    PG8_BAR;
#undef PG8_SA
#undef PG8_SB
#undef PG8_STAGE
#undef PG8_LDA
#undef PG8_LDB
#undef PG8_MMA
#undef PG8_WAIT_V
#undef PG8_WAIT_L
#undef PG8_BAR
#undef PG8_SCHED
}
}

constexpr int NWAVES = 8;
constexpr int BATCH = 32, S = 2048, D = 1024, DEPTH = 4, FF = 4096;
constexpr int M = BATCH * S;
constexpr int NP = 2304;
constexpr int DIN = 2108;
constexpr int C_QA = 0, C_CKV = 256, C_QIDX = 384, C_QB = 512, C_KCMP = 1024, C_VCMP = 1152, C_KSLC = 1280, C_VSLC = 1408, C_KWIN = 1536, C_VWIN = 1664,
              C_UC = 1792, C_KIDX = 2048, C_WIDX = 2080, C_GATE = 2084, C_KA = 2112, C_VA = 2176;
constexpr int NC = 127;
constexpr float EPS = 1e-6f;
constexpr float NEGF = -1e30f;

__host__ __device__ __forceinline__ int win_src(int n) {
    if (n < 512) return n;
    if (n < 1024) return 548 + (n - 512);
    if (n < 1792) return 1060 + (n - 1024);
    if (n < 2048) return 1852 + (n - 1792);
    if (n < 2080) return 512 + (n - 2048);
    if (n < 2084) return 544 + (n - 2080);
    if (n < 2108) return 1828 + (n - 2084);
    return -1;
}

constexpr size_t MiB = 1u << 20;
constexpr size_t WS_CTL = 0, CTL_ZERO_BYTES = 1 * MiB;
constexpr size_t WS_W = 2 * MiB;
constexpr size_t W_IN_B = (size_t)NP * D * 2, W_OUT_B = (size_t)D * D * 2, W_UP_B = (size_t)FF * D * 2, W_DN_B = (size_t)D * FF * 2;
constexpr size_t W_LAYER_B = W_IN_B + W_OUT_B + W_UP_B + W_DN_B;
constexpr size_t WS_ROPE = 96 * MiB;
constexpr size_t WS_WCT = 102 * MiB;
constexpr size_t WS_CB = 104 * MiB;
constexpr size_t WS_KCB = 124 * MiB, WS_VCB = 125 * MiB;
constexpr size_t WS_KA = 108 * MiB;
constexpr size_t WS_RS = 126 * MiB;
constexpr size_t WS_H = 128 * MiB;
constexpr size_t WS_F = 256 * MiB;
constexpr size_t WS_PROJ = 384 * MiB;
constexpr size_t WS_MIX = 672 * MiB;
constexpr size_t WS_MASK = 800 * MiB;
constexpr size_t WS_HID = 384 * MiB;
constexpr size_t WS_XB = 896 * MiB;
constexpr size_t WS_END = 1024 * MiB;
static_assert(WS_W + DEPTH * W_LAYER_B <= WS_ROPE, "weights");
static_assert(WS_ROPE + (size_t)M * 24 * 4 <= WS_WCT && WS_WCT + (size_t)DEPTH * 2 * 128 * 1024 * 2 <= WS_CB, "map");
static_assert(WS_PROJ + (size_t)M * NP * 2 <= WS_MIX && WS_MIX + (size_t)M * D * 2 <= WS_END && WS_HID + (size_t)M * FF * 2 <= WS_END, "map2");

constexpr int CW_BAR = 4096;
constexpr int RING_BYTES = 131072;
constexpr int LDSCTL_OFF = RING_BYTES, MISC_OFF = LDSCTL_OFF + 320;
constexpr int LDS_BYTES = 147456;
constexpr int WSCR = 16384;

#define GAS __attribute__((address_space(1)))
#define LAS __attribute__((address_space(3)))
typedef unsigned short bf16;
typedef unsigned v4u __attribute__((ext_vector_type(4)));
typedef float f32x4 __attribute__((ext_vector_type(4)));
typedef GAS unsigned gu32;
#define LDS_FENCE() asm volatile("s_waitcnt lgkmcnt(0)" ::: "memory")
__device__ __forceinline__ unsigned f2bf(float f) { unsigned u = __builtin_bit_cast(unsigned, f); return (u + 0x7fffu + ((u >> 16) & 1u)) >> 16; }
__device__ __forceinline__ unsigned pk2(float lo, float hi) { return f2bf(lo) | (f2bf(hi) << 16); }
__device__ __forceinline__ float bf2f(bf16 u) { return __builtin_bit_cast(float, (unsigned)u << 16); }
__device__ __forceinline__ float bflo(unsigned u) { return __builtin_bit_cast(float, u << 16); }
__device__ __forceinline__ float bfhi(unsigned u) { return __builtin_bit_cast(float, u & 0xffff0000u); }

#define XB_TMO      128
#define XB_XCNT(j)  (256  + 64 * (j))
#define XB_XSUB(j)  (1280 + 64 * (j))
#define XB_XGEN(j)  (2304 + 64 * (j))
#define XB_TOP      3328
#define XB_TOPGEN   3392
#define XCD_BAR_WORDS 3456
#define XB_SPIN_CAP (1u << 22)

__device__ __forceinline__ unsigned xb_ld(unsigned* p)              { return __hip_atomic_load(p, __ATOMIC_RELAXED, __HIP_MEMORY_SCOPE_AGENT); }
__device__ __forceinline__ unsigned xb_add(unsigned* p, unsigned v) { return __hip_atomic_fetch_add(p, v, __ATOMIC_RELAXED, __HIP_MEMORY_SCOPE_AGENT); }
__device__ __forceinline__ unsigned xb_xcc_id() { return (unsigned)__builtin_amdgcn_s_getreg((3 << 11) | 20) & 0xFu; }
#define XB_SPIN(cond, bar) do { unsigned _sp = 0; while (cond) { __builtin_amdgcn_s_sleep(1); \
    if ((++_sp & 255u) == 0u) { if (xb_ld(&(bar)[XB_TMO])) break; if (_sp > XB_SPIN_CAP) { atomicAdd(&(bar)[XB_TMO], 1u); break; } } } } while (0)

struct XcdBarrier { unsigned* bar; unsigned x; volatile LAS unsigned* st; int wv; };

__device__ __forceinline__ XcdBarrier xcd_barrier_post(unsigned* bar, volatile LAS unsigned* st) {
    XcdBarrier b; b.bar = bar; b.x = xb_xcc_id(); b.st = st; b.wv = 0;
    if (threadIdx.x == 0) (void)xb_add(&bar[XB_XCNT(b.x)], 1u);
    return b;
}
__device__ __forceinline__ void xcd_barrier_complete(unsigned* bar, unsigned x, unsigned& nloc, unsigned& nx) {
    const unsigned G = gridDim.x * gridDim.y * gridDim.z;
    unsigned sum, cnt, mine, sp = 0u;
    for (;;) {
        sum = 0u; cnt = 0u; mine = 0u;
#pragma unroll
        for (unsigned j = 0; j < 16; ++j) { const unsigned c = xb_ld(&bar[XB_XCNT(j)]); sum += c; cnt += (c > 0u) ? 1u : 0u; mine = (j == x) ? c : mine; }
        if (sum == G) break;
        __builtin_amdgcn_s_sleep(1);
        if ((++sp & 255u) == 0u) { if (xb_ld(&bar[XB_TMO])) break; if (sp > XB_SPIN_CAP) { atomicAdd(&bar[XB_TMO], 1u); break; } }
    }
    nloc = mine > 0u ? mine : 1u; nx = cnt > 0u ? cnt : 1u;
}
__device__ __forceinline__ void xcd_barrier(const XcdBarrier& b) {
    asm volatile("s_waitcnt vmcnt(0)" ::: "memory");
    __syncthreads();
    if (b.wv == 0 && lane_id() == 0) {
        unsigned* bar = b.bar; asm volatile("" : "+s"(bar));
        __builtin_amdgcn_s_waitcnt(0);
        unsigned nloc = b.st[0], nx = b.st[1];
        unsigned bx_ = b.x; asm volatile("" : "+s"(bx_));
        if (nloc == 0u) { xcd_barrier_complete(bar, bx_, nloc, nx); b.st[0] = nloc; b.st[1] = nx; }
        const unsigned old = xb_add(&bar[XB_XSUB(bx_)], 1u);
        const unsigned gen = old / nloc;
        if (old + 1u == (gen + 1u) * nloc) {
            __builtin_amdgcn_fence(__ATOMIC_RELEASE, "agent");
            asm volatile("s_waitcnt vmcnt(0)" ::: "memory");
            const unsigned og = xb_add(&bar[XB_TOP], 1u);
            const unsigned tg = og / nx;
            if (og + 1u == (tg + 1u) * nx) xb_add(&bar[XB_TOPGEN], 1u);
            else XB_SPIN(xb_ld(&bar[XB_TOPGEN]) == tg, bar);
            __builtin_amdgcn_fence(__ATOMIC_ACQUIRE, "agent");
            xb_add(&bar[XB_XGEN(bx_)], 1u);
            asm volatile("s_waitcnt vmcnt(0)" ::: "memory");
        } else {
            XB_SPIN(xb_ld(&bar[XB_XGEN(bx_)]) == gen, bar);
            __builtin_amdgcn_fence(__ATOMIC_ACQUIRE, "agent");
            asm volatile("s_waitcnt vmcnt(0)" ::: "memory");
        }
    }
    __syncthreads();
}

struct Frame {
    LAS unsigned char* lds;
    volatile LAS unsigned* MISC;
    gu32* ctl;
    int wave, vcu, G;
    float* out; unsigned char* ws;
};
struct Args { const void* in[20]; float* out; unsigned char* ws; int ph_lo, ph_hi, use_bar, pad; };
#define IN_F(k) ((const float*)args.in[k])
#define P_X_IN IN_F(0)
#define P_POS ((const int*)args.in[1])
#define P_W_IN IN_F(2)
#define P_G_KV_A IN_F(3)
#define P_W_KV_UP IN_F(4)
#define P_W_CMP_K IN_F(5)
#define P_W_CMP_V IN_F(6)
#define P_PE_K IN_F(7)
#define P_PE_V IN_F(8)
#define P_W_POOL IN_F(9)
#define P_POOL_SCALE IN_F(10)
#define P_G_OUT_A IN_F(11)
#define P_G_OUT_B IN_F(12)
#define P_W_OUT IN_F(13)
#define P_G_PRE_MIX IN_F(14)
#define P_G_POST_MIX IN_F(15)
#define P_G_PRE_MLP IN_F(16)
#define P_G_POST_MLP IN_F(17)
#define P_W_UP IN_F(18)
#define P_W_DOWN IN_F(19)
#define B_ROPE ((float*)(ws_ + WS_ROPE))
#define B_H ((bf16*)(ws_ + WS_H))
#define B_F ((bf16*)(ws_ + WS_F))
#define B_PROJ ((bf16*)(ws_ + WS_PROJ))
#define B_MIX ((bf16*)(ws_ + WS_MIX))
#define B_HID ((bf16*)(ws_ + WS_HID))

template <int CTRL> __device__ __forceinline__ int dpp_i(int v) { return __builtin_amdgcn_update_dpp(0, v, CTRL, 0xF, 0xF, true); }
template <int CTRL> __device__ __forceinline__ float dpp_f(float v) { return __builtin_bit_cast(float, dpp_i<CTRL>(__builtin_bit_cast(int, v))); }
__device__ __forceinline__ int swz16_i(int v) { return __builtin_amdgcn_ds_swizzle(v, (16 << 10) | 0x1F); }
__device__ __forceinline__ float swz16_f(float v) { return __builtin_bit_cast(float, swz16_i(__builtin_bit_cast(int, v))); }
struct HalfPair { unsigned lo, hi; };
__device__ __forceinline__ HalfPair halves_u(unsigned v) { const auto rr = __builtin_amdgcn_permlane32_swap(v, v, false, false); HalfPair h; h.lo = rr[0]; h.hi = rr[1]; return h; }
__device__ __forceinline__ float other_half_f(float v, int hi) { const HalfPair h = halves_u(__builtin_bit_cast(unsigned, v)); return __builtin_bit_cast(float, hi ? h.lo : h.hi); }
__device__ __forceinline__ float sum32(float v) {
    v += dpp_f<0xB1>(v); v += dpp_f<0x4E>(v); v += dpp_f<0x141>(v); v += dpp_f<0x140>(v); v += swz16_f(v); return v; }
__device__ __forceinline__ float wave_sum(float v) { v = sum32(v); const HalfPair h = halves_u(__builtin_bit_cast(unsigned, v)); return __builtin_bit_cast(float, h.lo) + __builtin_bit_cast(float, h.hi); }
__device__ __forceinline__ float max_halves(float v) { const HalfPair h = halves_u(__builtin_bit_cast(unsigned, v)); return fmaxf(__builtin_bit_cast(float, h.lo), __builtin_bit_cast(float, h.hi)); }
__device__ __forceinline__ unsigned or_halves(unsigned v) { const HalfPair h = halves_u(v); return h.lo | h.hi; }
__device__ __forceinline__ unsigned or32(unsigned v) { v |= (unsigned)dpp_i<0xB1>((int)v); v |= (unsigned)dpp_i<0x4E>((int)v); v |= (unsigned)dpp_i<0x141>((int)v); v |= (unsigned)dpp_i<0x140>((int)v); v |= (unsigned)swz16_i((int)v); return v; }

__constant__ double c_rope_inv[12] = {1.0, 0.19392274474868576, 0.03760603093086393, 0.007292664737217109, 0.001414213562373095, 0.0002742481756762073, 5.318295896944988e-05, 1.031338537721246e-05,
                                       1.0, 0.03760603093086393, 0.001414213562373095, 5.318295896944988e-05};
template <int MODE, bool GAIN = false>
__device__ __forceinline__ void transpose_item(const float* W, int K, int Nsrc, int nblk, bf16* WT, LAS float* scr, int item, int lane, const float* gk = nullptr) {
    const int kb = item / nblk, nb = item % nblk, k0 = 64 * kb, n0 = 32 * nb;
    if (MODE && n0 >= C_KA && n0 < C_KA + 128) return;
    const int np = n0 + (lane & 31);
    const int src = MODE ? win_src(np) : np;
#pragma unroll 4
    for (int i = 0; i < 32; ++i) { const int kk = 2 * i + (lane >> 5); scr[kk * 33 + (lane & 31)] = (src >= 0) ? W[(size_t)(k0 + kk) * Nsrc + src] * (GAIN ? gk[k0 + kk] : 1.f) : 0.f; }
    LDS_FENCE();
    const int c = lane & 7;
#pragma unroll
    for (int j = 0; j < 4; ++j) { const int n = (lane >> 3) + 8 * j; const LAS float* s = scr + (8 * c) * 33 + n;
        v4u o; o.x = pk2(s[0 * 33], s[1 * 33]); o.y = pk2(s[2 * 33], s[3 * 33]); o.z = pk2(s[4 * 33], s[5 * 33]); o.w = pk2(s[6 * 33], s[7 * 33]);
        *(v4u*)(WT + (size_t)(n0 + n) * K + k0 + 8 * c) = o; }
    LDS_FENCE();
}

__device__ __forceinline__ bf16* w_in_t(unsigned char* ws_, int l)  { return (bf16*)(ws_ + WS_W + (size_t)l * W_LAYER_B); }
__device__ __forceinline__ bf16* w_out_t(unsigned char* ws_, int l) { return (bf16*)(ws_ + WS_W + (size_t)l * W_LAYER_B + W_IN_B); }
__device__ __forceinline__ bf16* w_up_t(unsigned char* ws_, int l)  { return (bf16*)(ws_ + WS_W + (size_t)l * W_LAYER_B + W_IN_B + W_OUT_B); }
__device__ __forceinline__ bf16* w_dn_t(unsigned char* ws_, int l)  { return (bf16*)(ws_ + WS_W + (size_t)l * W_LAYER_B + W_IN_B + W_OUT_B + W_UP_B); }

__device__ __forceinline__ void phase_prologue(Frame& F, const Args& args) {
    unsigned char* ws_ = F.ws; asm volatile("" : "+s"(ws_)); int lane_ = lane_id(); asm volatile("" : "+v"(lane_)); (void)ws_;
    LAS float* scr = (LAS float*)(F.lds + F.wave * WSCR);
    const int gw = F.vcu * NWAVES + F.wave, NGW = F.G * NWAVES;
    constexpr int I_IN = (D / 64) * (NP / 32), I_OUT = (D / 64) * (D / 32), I_UP = (D / 64) * (FF / 32), I_DN = (FF / 64) * (D / 32);
    for (int it = gw; it < DEPTH * I_IN; it += NGW) { const int l = it / I_IN, r = it % I_IN; transpose_item<1, true>(P_W_IN + (size_t)l * D * DIN, D, DIN, NP / 32, w_in_t(ws_, l), scr, r, lane_, P_G_PRE_MIX + l * D); }
    for (int it = gw; it < DEPTH * I_OUT; it += NGW) { const int l = it / I_OUT, r = it % I_OUT; transpose_item<0>(P_W_OUT + (size_t)l * D * D, D, D, D / 32, w_out_t(ws_, l), scr, r, lane_); }
    for (int it = gw; it < DEPTH * I_UP; it += NGW) { const int l = it / I_UP, r = it % I_UP; transpose_item<0, true>(P_W_UP + (size_t)l * D * FF, D, FF, FF / 32, w_up_t(ws_, l), scr, r, lane_, P_G_PRE_MLP + l * D); }
    for (int it = gw; it < DEPTH * I_DN; it += NGW) { const int l = it / I_DN, r = it % I_DN; transpose_item<0>(P_W_DOWN + (size_t)l * FF * D, FF, D, D / 32, w_dn_t(ws_, l), scr, r, lane_); }
    for (int it = gw; it < DEPTH * D * 2; it += NGW) {
        const int l = it / (D * 2), r = it % (D * 2), k = r >> 1, n = lane_ + 64 * (r & 1);
        const float* wi = P_W_IN + ((size_t)l * D + k) * DIN + 256; const float* gk = P_G_KV_A + l * 128; const float* wu = P_W_KV_UP + (size_t)l * 128 * 128 + n;
        float acc = 0.f;
#pragma unroll 8
        for (int j = 0; j < 128; ++j) acc += (wi[j] * gk[j]) * wu[j * 128];
        w_in_t(ws_, l)[(size_t)(C_KA + n) * D + k] = (bf16)f2bf(acc * P_G_PRE_MIX[l * D + k]);
    }
    for (int it = gw; it < DEPTH * 2 * 2 * 32; it += NGW) {
        const int lk = it >> 6, part = (it >> 5) & 1, r = it & 31, l = lk >> 1, kv = lk & 1;
        const float* W = (kv ? P_W_CMP_V : P_W_CMP_K) + (size_t)l * 32 * 64 * 64 + (size_t)part * 1024 * 64;
        transpose_item<0>(W, 1024, 64, 2, (bf16*)(ws_ + WS_WCT) + ((size_t)lk * 128 + part * 64) * 1024, scr, r, lane_);
    }
    for (int it = gw; it < DEPTH * 2; it += NGW) {
        const int l = it >> 1, kv = it & 1;
        const float* W = (kv ? P_W_CMP_V : P_W_CMP_K) + (size_t)l * 32 * 64 * 64 + lane_; const float* pe = (kv ? P_PE_V : P_PE_K) + l * 32 * 64;
        float acc = 0.f;
        for (int k = 0; k < 2048; ++k) acc += pe[k] * W[(size_t)k * 64];
        ((float*)(ws_ + WS_CB))[it * 64 + lane_] = acc;
    }
}
__device__ __forceinline__ void phase_prologue_b(Frame& F, const Args& args) {
    unsigned char* ws_ = F.ws; asm volatile("" : "+s"(ws_)); int lane_ = lane_id(); asm volatile("" : "+v"(lane_)); (void)ws_;
    const int gw = F.vcu * NWAVES + F.wave, NGW = F.G * NWAVES;
    for (int e = gw * 64 + lane_; e < M * 12; e += NGW * 64) {
        const int row = e / 12, i = e % 12;
        const double inv = c_rope_inv[i];
        const double a = (double)P_POS[row] * inv;
        const double k = __builtin_rint(a * 0.15915494309189535);
        const float r = (float)(a - k * 6.283185307179586);
        const float c = __builtin_cosf(r), s = __builtin_sinf(r);
        float* t = B_ROPE + (size_t)row * 24;
        if (i < 8) { t[i] = c; t[8 + i] = s; } else { t[16 + (i - 8)] = c; t[20 + (i - 8)] = s; }
    }
    for (int m = gw; m < M; m += NGW) {
        const f32x4* xr = (const f32x4*)(P_X_IN + (size_t)m * D) + lane_;
        f32x4 v[4]; float sq = 0.f;
#pragma unroll
        for (int j = 0; j < 4; ++j) { v[j] = xr[64 * j]; sq += (v[j].x * v[j].x + v[j].y * v[j].y) + (v[j].z * v[j].z + v[j].w * v[j].w); }
        const float rsv = rsqrtf(wave_sum(sq) * (1.f / D) + EPS);
        unsigned long long* o8 = (unsigned long long*)((bf16*)(ws_ + WS_XB) + (size_t)m * D) + lane_;
#pragma unroll
        for (int j = 0; j < 4; ++j) o8[64 * j] = (unsigned long long)pk2(v[j].x, v[j].y) | ((unsigned long long)pk2(v[j].z, v[j].w) << 32);
        if (lane_ == 0) ((float*)(ws_ + WS_RS))[m] = rsv;
    }
}

typedef short bf16x8 __attribute__((ext_vector_type(8)));
typedef short s16x4 __attribute__((ext_vector_type(4)));
typedef float f32x16 __attribute__((ext_vector_type(16)));
#define MFMA32(a, b, c) __builtin_amdgcn_mfma_f32_32x32x16_bf16((a), (b), (c), 0, 0, 0)
__device__ __forceinline__ int crow(int r, int hi) { return (r & 3) + 8 * (r >> 2) + 4 * hi; }
__device__ __forceinline__ void wg_barrier() { asm volatile("s_waitcnt lgkmcnt(0)\n\ts_barrier" ::: "memory"); }

__device__ __forceinline__ void phase_prep(Frame& F, const Args& args, int l) {
    unsigned char* ws_ = F.ws; asm volatile("" : "+s"(ws_)); int lane_ = lane_id(); asm volatile("" : "+v"(lane_)); (void)ws_; (void)args;
    int tid_ = F.wave * 64 + lane_id(); asm volatile("" : "+v"(tid_));
    const int gw = F.vcu * NWAVES + F.wave, NGW = F.G * NWAVES, lane = lane_;
    {
        const int sub = lane >> 4, q = lane & 15;
        const bool r_idx = (q == 2), r_kv = (q >= 4 && q < 8), r_ka = (q < 2);
        const int which = q - 4;
        const int cbase = r_idx ? C_KIDX : (((which < 2) ? C_KSLC : C_KWIN) + (which & 1) * 64);
        constexpr int RB = 4;
        for (int row0 = gw * (4 * RB); row0 < M; row0 += NGW * (4 * RB)) {
            v4u cu[RB], ku[RB], e1[RB], e2[RB]; f32x4 t0[RB], t1[RB], t2[RB], t3[RB];
#pragma unroll
            for (int k = 0; k < RB; ++k) { const size_t row = (size_t)(row0 + 4 * k + sub); bf16* prow = B_PROJ + row * NP; const f32x4* tab = (const f32x4*)(B_ROPE + row * 24);
                cu[k] = *(const v4u*)(prow + C_CKV + 8 * q); ku[k] = *(const v4u*)(prow + C_KA + 8 * q);
                e1[k] = (v4u){0u, 0u, 0u, 0u}; e2[k] = e1[k]; t0[k] = (f32x4){0.f, 0.f, 0.f, 0.f}; t1[k] = t0[k]; t2[k] = t0[k]; t3[k] = t0[k];
                if (r_ka || r_kv) { t0[k] = tab[0]; t1[k] = tab[1]; t2[k] = tab[2]; t3[k] = tab[3]; }
                if (r_idx) { t0[k] = tab[4]; t2[k] = tab[5]; }
                if (r_idx || r_kv) e1[k] = *(const v4u*)(prow + cbase);
                if (r_kv) e2[k] = *(const v4u*)(prow + cbase + 8); }
#pragma unroll
            for (int k = 0; k < RB; ++k) { const size_t row = (size_t)(row0 + 4 * k + sub); bf16* prow = B_PROJ + row * NP;
                float x[8] = {bflo(cu[k].x), bfhi(cu[k].x), bflo(cu[k].y), bfhi(cu[k].y), bflo(cu[k].z), bfhi(cu[k].z), bflo(cu[k].w), bfhi(cu[k].w)};
                float ss = 0.f;
#pragma unroll
                for (int e = 0; e < 8; ++e) ss += x[e] * x[e];
                ss += dpp_f<0xB1>(ss); ss += dpp_f<0x4E>(ss); ss += dpp_f<0x141>(ss); ss += dpp_f<0x140>(ss);
                const float rs = rsqrtf(ss * (1.f / 128.f) + EPS);
                float y[8] = {bflo(ku[k].x) * rs, bfhi(ku[k].x) * rs, bflo(ku[k].y) * rs, bfhi(ku[k].y) * rs, bflo(ku[k].z) * rs, bfhi(ku[k].z) * rs, bflo(ku[k].w) * rs, bfhi(ku[k].w) * rs};
                const float cs[8] = {t0[k].x, t0[k].y, t0[k].z, t0[k].w, t1[k].x, t1[k].y, t1[k].z, t1[k].w};
                const float sn[8] = {t2[k].x, t2[k].y, t2[k].z, t2[k].w, t3[k].x, t3[k].y, t3[k].z, t3[k].w};
#pragma unroll
                for (int e = 0; e < 8; ++e) { const float pr = dpp_f<0xB1>(y[e]);
                    const float r0 = y[e] * cs[e] - pr * sn[e], r1 = pr * sn[e] + y[e] * cs[e];
                    y[e] = r_ka ? ((q == 0) ? r0 : r1) : y[e]; }
                *(v4u*)(prow + C_KA + 8 * q) = (v4u){pk2(y[0], y[1]), pk2(y[2], y[3]), pk2(y[4], y[5]), pk2(y[6], y[7])};
                if (r_idx) {
                    float z[8] = {bflo(e1[k].x), bfhi(e1[k].x), bflo(e1[k].y), bfhi(e1[k].y), bflo(e1[k].z), bfhi(e1[k].z), bflo(e1[k].w), bfhi(e1[k].w)};
                    const float ci[4] = {t0[k].x, t0[k].y, t0[k].z, t0[k].w}, si[4] = {t2[k].x, t2[k].y, t2[k].z, t2[k].w};
                    float o[8];
#pragma unroll
                    for (int i = 0; i < 4; ++i) { o[i] = z[i] * ci[i] - z[4 + i] * si[i]; o[4 + i] = z[i] * si[i] + z[4 + i] * ci[i]; }
                    *(v4u*)(prow + cbase) = (v4u){pk2(o[0], o[1]), pk2(o[2], o[3]), pk2(o[4], o[5]), pk2(o[6], o[7])};
                } else if (r_kv) {
                    float z1[8] = {bflo(e1[k].x), bfhi(e1[k].x), bflo(e1[k].y), bfhi(e1[k].y), bflo(e1[k].z), bfhi(e1[k].z), bflo(e1[k].w), bfhi(e1[k].w)};
                    float z2[8] = {bflo(e2[k].x), bfhi(e2[k].x), bflo(e2[k].y), bfhi(e2[k].y), bflo(e2[k].z), bfhi(e2[k].z), bflo(e2[k].w), bfhi(e2[k].w)};
                    float o1[8], o2[8];
#pragma unroll
                    for (int i = 0; i < 8; ++i) { o1[i] = z1[i] * cs[i] - z2[i] * sn[i]; o2[i] = z1[i] * sn[i] + z2[i] * cs[i]; }
                    *(v4u*)(prow + cbase) = (v4u){pk2(o1[0], o1[1]), pk2(o1[2], o1[3]), pk2(o1[4], o1[5]), pk2(o1[6], o1[7])};
                    *(v4u*)(prow + cbase + 8) = (v4u){pk2(o2[0], o2[1]), pk2(o2[2], o2[3]), pk2(o2[4], o2[5]), pk2(o2[6], o2[7])};
                }
            }
        }
    }
    {
        const int wid = F.wave, r32 = lane & 31, hi = lane >> 5;
        LAS float* P = (LAS float*)F.lds;
        for (int u = F.vcu; u < BATCH * 8; u += F.G) {
            const int b = u >> 3, g = (u >> 2) & 1, kv = (u >> 1) & 1, eh = u & 1;
            const int rt = wid >> 1, part = wid & 1;
            const bf16* ap = B_PROJ + ((size_t)b * S + 16 * (32 * rt + r32)) * NP + (kv ? C_VCMP : C_KCMP) + g * 64 + 8 * hi;
            const bf16* bp = (const bf16*)(ws_ + WS_WCT) + ((size_t)(l * 2 + kv) * 128 + part * 64 + eh * 32 + r32) * 1024 + 8 * hi;
            f32x16 acc = {};
#pragma unroll 8
            for (int ks = 0; ks < 64; ++ks) {
                const bf16x8 a = *(const bf16x8*)(ap + (size_t)(ks >> 2) * NP + 16 * (ks & 3));
                const bf16x8 bq = *(const bf16x8*)(bp + 16 * ks);
                acc = MFMA32(a, bq, acc);
            }
#pragma unroll
            for (int r = 0; r < 16; ++r) P[(part * 128 + 32 * rt + crow(r, hi)) * 32 + r32] = acc[r];
            wg_barrier();
            const float* cb = (const float*)(ws_ + WS_CB) + (l * 2 + kv) * 64 + eh * 32;
            bf16* ob = (bf16*)(ws_ + (kv ? WS_VCB : WS_KCB)) + (size_t)(b * 2 + g) * 128 * 64 + eh * 32;
            for (int idx = tid_; idx < 128 * 32; idx += 512) { const int c = idx >> 5, e = idx & 31;
                const float v = (c < NC) ? (P[c * 32 + e] + P[(128 + c + 1) * 32 + e] + cb[e]) : 0.f;
                ob[c * 64 + e] = (bf16)f2bf(v); }
            wg_barrier();
        }
    }
}

typedef float f32x2_t __attribute__((ext_vector_type(2))); typedef __bf16 bf16x2_t __attribute__((ext_vector_type(2)));
__device__ __forceinline__ unsigned cvtpk(float lo, float hi) { const f32x2_t v = {lo, hi}; const bf16x2_t b = __builtin_convertvector(v, bf16x2_t); return __builtin_bit_cast(unsigned, b); }
constexpr float C2 = 0.125f * 1.4426950408889634f;

__device__ __forceinline__ unsigned idxmask(int x, int hi) {
    unsigned m = 0u;
#pragma unroll
    for (int g = 0; g < 4; ++g) { int n = x - (8 * g + 4 * hi); n = n < 0 ? 0 : (n > 4 ? 4 : n); m |= ((1u << n) - 1u) << (4 * g); }
    return m;
}

constexpr int SEL_QF = 0, SEL_PART = 16384, SEL_HIST = 20480, SEL_HP = 260, SEL_RES = SEL_HIST + 32 * SEL_HP * 4;
__device__ __forceinline__ void dsa_select_unit(unsigned char* ws_, int tid_, int b, int qt32, LAS unsigned char* lds) {
    asm volatile("" : "+v"(tid_)); asm volatile("" : "+s"(ws_));
    const int lane = tid_ & 63, wid = __builtin_amdgcn_readfirstlane(tid_ >> 6), r32 = lane & 31, hi = lane >> 5;
    unsigned* maskbuf = (unsigned*)(ws_ + WS_MASK);
    if (qt32 < 8) {
        for (int i = tid_; i < 2048; i += 512) { const int qq = i >> 6, blk = i & 63; const int t = 32 * qt32 + qq; const int d = t - 32 * blk;
            const unsigned w = d < 0 ? 0u : (d >= 31 ? 0xffffffffu : ((2u << d) - 1u));
            maskbuf[((size_t)b * S + t) * 64 + blk] = w; }
        return;
    }
    const size_t qrow = (size_t)b * S + 32 * qt32 + r32;
    const bf16* prow = B_PROJ + qrow * NP;
    {
        const int h = wid >> 1, sk = wid & 1;
        const v4u raw = *(const v4u*)(prow + C_QIDX + h * 32 + 16 * sk + 8 * hi);
        float x[8] = {bflo(raw.x), bfhi(raw.x), bflo(raw.y), bfhi(raw.y), bflo(raw.z), bfhi(raw.z), bflo(raw.w), bfhi(raw.w)};
        if (sk == 0 && hi == 0) { const float* tab = B_ROPE + qrow * 24;
#pragma unroll
            for (int i = 0; i < 4; ++i) { const float c = tab[16 + i], sn = tab[20 + i]; const float x1 = x[i], x2 = x[4 + i]; x[i] = x1 * c - x2 * sn; x[4 + i] = x1 * sn + x2 * c; } }
        v4u hp, lp;
        { unsigned hh[4], ll[4];
#pragma unroll
          for (int k = 0; k < 4; ++k) { const float a = x[2 * k], bb = x[2 * k + 1]; const unsigned ha = f2bf(a), hb = f2bf(bb); hh[k] = ha | (hb << 16);
              ll[k] = pk2(a - bf2f((bf16)ha), bb - bf2f((bf16)hb)); }
          hp = (v4u){hh[0], hh[1], hh[2], hh[3]}; lp = (v4u){ll[0], ll[1], ll[2], ll[3]}; }
        LAS v4u* qf = (LAS v4u*)(lds + SEL_QF);
        qf[((h * 2 + sk) * 2 + 0) * 64 + lane] = hp; qf[((h * 2 + sk) * 2 + 1) * 64 + lane] = lp;
    }
    float w[4];
#pragma unroll
    for (int h = 0; h < 4; ++h) w[h] = bf2f(prow[C_WIDX + h]);
    __syncthreads();
    const int nblk = qt32 + 1;
    const bf16* kbase = B_PROJ + (size_t)b * S * NP + C_KIDX;
    unsigned key[8][16];
#pragma unroll
    for (int i = 0; i < 8; ++i) {
        const int blk = wid + 8 * i;
        if (blk < nblk) {
            const bf16* kp = kbase + (size_t)(32 * blk + r32) * NP + 8 * hi;
            const bf16x8 kf0 = *(const bf16x8*)kp, kf1 = *(const bf16x8*)(kp + 16);
            float sc[16];
            const LAS bf16x8* qf = (const LAS bf16x8*)(lds + SEL_QF);
#pragma unroll
            for (int h = 0; h < 4; ++h) {
                f32x16 acc = {};
                acc = MFMA32(kf0, qf[((h * 2 + 0) * 2 + 0) * 64 + lane], acc);
                acc = MFMA32(kf1, qf[((h * 2 + 1) * 2 + 0) * 64 + lane], acc);
                acc = MFMA32(kf0, qf[((h * 2 + 0) * 2 + 1) * 64 + lane], acc);
                acc = MFMA32(kf1, qf[((h * 2 + 1) * 2 + 1) * 64 + lane], acc);
#pragma unroll
                for (int r = 0; r < 16; ++r) sc[r] = (h == 0) ? w[0] * fmaxf(acc[r], 0.f) : fmaf(w[h], fmaxf(acc[r], 0.f), sc[r]);
            }
#pragma unroll
            for (int r = 0; r < 16; ++r) {
                unsigned bits = __builtin_bit_cast(unsigned, sc[r]);
                if (bits == 0x80000000u) bits = 0u;
                unsigned k = (bits & 0x80000000u) ? ~bits : (bits | 0x80000000u);
                if (blk == qt32 && crow(r, hi) > r32) k = 0u;
                key[i][r] = k;
            }
        } else {
#pragma unroll
            for (int r = 0; r < 16; ++r) key[i][r] = 0u;
        }
    }
    LAS unsigned* part = (LAS unsigned*)(lds + SEL_PART);
    int pbi = 0;
#define SEL_REDUCE(cnt_, tot_) do { LAS unsigned* pb_ = part + (pbi & 1) * 512; ++pbi; pb_[wid * 64 + lane] = (cnt_); wg_barrier(); unsigned t_ = 0u; \
        _Pragma("unroll") for (int w8 = 0; w8 < 8; ++w8) t_ += pb_[w8 * 64 + r32] + pb_[w8 * 64 + 32 + r32]; (tot_) = t_; } while (0)
    LAS unsigned* hist = (LAS unsigned*)(lds + SEL_HIST);
    LAS unsigned* resd = (LAS unsigned*)(lds + SEL_RES);
    for (int i = tid_; i < 32 * SEL_HP / 4; i += 512) ((LAS v4u*)hist)[i] = (v4u){0u, 0u, 0u, 0u};
    wg_barrier();
    unsigned pfx = 0u, need = 256u;
    LAS unsigned* hrow = hist + r32 * SEL_HP;
#pragma unroll 1
    for (int pass = 0; pass < 4; ++pass) {
        const int shift = 24 - 8 * pass;
#pragma unroll
        for (int i = 0; i < 8; ++i) if (wid + 8 * i < nblk) {
#pragma unroll
            for (int r = 0; r < 16; ++r) {
                const unsigned k = key[i][r];
                const unsigned dg = (k >> shift) & 255u;
                const bool match = (pass == 0) || ((k >> (shift + 8)) == pfx);
                __hip_atomic_fetch_add(hrow + (match ? dg : 256u), 1u, __ATOMIC_RELAXED, __HIP_MEMORY_SCOPE_WORKGROUP);
            } }
        wg_barrier();
#pragma unroll 1
        for (int qq = 0; qq < 4; ++qq) {
            const int q = 4 * wid + qq;
            LAS v4u* hq = (LAS v4u*)(hist + q * SEL_HP) + lane;
            const v4u h4 = *hq;
            unsigned T = (h4.x + h4.y) + (h4.z + h4.w);
#pragma unroll
            for (int off = 1; off < 64; off <<= 1) { const unsigned t_ = (unsigned)__shfl_down((int)T, off); if (lane + off < 64) T += t_; }
            const unsigned needq = (pass == 0) ? 256u : resd[32 + q];
            const unsigned long long bal = __ballot(T >= needq);
            const int Ls = 63 - __builtin_clzll(bal | 1ull);
            const unsigned above = (unsigned)__shfl((int)T, (Ls + 1) & 63);
            if (lane == Ls) {
                const unsigned ab0 = (Ls < 63) ? above : 0u;
                const unsigned rem = needq - ab0; const unsigned c3 = h4.w, c2 = c3 + h4.z, c1 = c2 + h4.y;
                int d; unsigned ab;
                if (rem <= c3) { d = 3; ab = 0u; } else if (rem <= c2) { d = 2; ab = c3; } else if (rem <= c1) { d = 1; ab = c2; } else { d = 0; ab = c1; }
                resd[q] = (unsigned)(4 * Ls + d); resd[32 + q] = rem - ab;
            }
            *hq = (v4u){0u, 0u, 0u, 0u};
            if (lane == 0) hist[q * SEL_HP + 256] = 0u;
        }
        wg_barrier();
        pfx = (pfx << 8) | resd[r32]; need = resd[32 + r32];
    }
    const unsigned thr = pfx;
    unsigned gtm[8], eqm[8];
#pragma unroll
    for (int i = 0; i < 8; ++i) { unsigned g = 0u, e = 0u;
        if (wid + 8 * i < nblk) {
#pragma unroll
            for (int r = 0; r < 16; ++r) { g |= (key[i][r] > thr) ? (1u << r) : 0u; e |= (key[i][r] == thr) ? (1u << r) : 0u; } }
        gtm[i] = g; eqm[i] = e; }
    const unsigned rneed = need;
    unsigned pc[8];
#pragma unroll
    for (int i = 0; i < 8; ++i) pc[i] = __builtin_popcount(eqm[i]);
    unsigned Y = 0u;
    for (int bit = 10; bit >= 5; --bit) {
        const unsigned c = Y | (1u << bit); const int cb = (int)(c >> 5);
        unsigned cnt = 0u;
#pragma unroll
        for (int i = 0; i < 8; ++i) cnt += (wid + 8 * i < cb) ? pc[i] : 0u;
        unsigned tot; SEL_REDUCE(cnt, tot);
        if (tot < rneed) Y = c;
    }
    {
        const int yb = (int)(Y >> 5);
        unsigned cbase = 0u, em = 0u;
#pragma unroll
        for (int i = 0; i < 8; ++i) { cbase += (wid + 8 * i < yb) ? pc[i] : 0u; em |= (wid + 8 * i == yb) ? eqm[i] : 0u; }
        for (int bit = 4; bit >= 0; --bit) {
            const unsigned c = Y | (1u << bit);
            const unsigned cnt = cbase + __builtin_popcount(em & idxmask((int)(c & 31u), hi));
            unsigned tot; SEL_REDUCE(cnt, tot);
            if (tot < rneed) Y = c;
        }
    }
#undef SEL_REDUCE
#pragma unroll
    for (int i = 0; i < 8; ++i) {
        const int blk = wid + 8 * i;
        const unsigned selm = gtm[i] | (eqm[i] & idxmask((int)Y + 1 - 32 * blk, hi));
        unsigned word = ((selm & 0xFu) | ((selm & 0xF0u) << 4) | ((selm & 0xF00u) << 8) | ((selm & 0xF000u) << 12)) << (4 * hi);
        word = or_halves(word);
        if (hi == 0) maskbuf[qrow * 64 + blk] = word;
    }
    __syncthreads();
}

constexpr int AT_K = 0, AT_V = 24576, AT_WS = 49152;
__device__ __forceinline__ void pv(f32x16* o, f32x16& lacc, unsigned vb, bf16x8 pa0, bf16x8 pa1, bf16x8 pa2, bf16x8 pa3) {
    { const bf16x8 ones = {0x3F80, 0x3F80, 0x3F80, 0x3F80, 0x3F80, 0x3F80, 0x3F80, 0x3F80};
      lacc = MFMA32(pa0, ones, lacc); lacc = MFMA32(pa1, ones, lacc); lacc = MFMA32(pa2, ones, lacc); lacc = MFMA32(pa3, ones, lacc); }
#pragma unroll
    for (int d0 = 0; d0 < 2; ++d0) { s16x4 lo0, lo1, lo2, lo3, hi0, hi1, hi2, hi3;
        asm volatile("ds_read_b64_tr_b16 %0,%8 offset:%c9\n\tds_read_b64_tr_b16 %1,%8 offset:%c10\n\tds_read_b64_tr_b16 %2,%8 offset:%c11\n\tds_read_b64_tr_b16 %3,%8 offset:%c12\n\t"
                     "ds_read_b64_tr_b16 %4,%8 offset:%c13\n\tds_read_b64_tr_b16 %5,%8 offset:%c14\n\tds_read_b64_tr_b16 %6,%8 offset:%c15\n\tds_read_b64_tr_b16 %7,%8 offset:%c16\n\t"
                     "s_waitcnt lgkmcnt(0)"
                     : "=&v"(lo0), "=&v"(hi0), "=&v"(lo1), "=&v"(hi1), "=&v"(lo2), "=&v"(hi2), "=&v"(lo3), "=&v"(hi3)
                     : "v"(vb), "i"(d0 * 4096 + 0), "i"(d0 * 4096 + 512), "i"(d0 * 4096 + 1024), "i"(d0 * 4096 + 1536), "i"(d0 * 4096 + 2048), "i"(d0 * 4096 + 2560), "i"(d0 * 4096 + 3072), "i"(d0 * 4096 + 3584)
                     : "memory");
#define PKV(l_, h_) (bf16x8){l_[0], l_[1], l_[2], l_[3], h_[0], h_[1], h_[2], h_[3]}
        o[d0] = MFMA32(pa0, PKV(lo0, hi0), o[d0]);
        o[d0] = MFMA32(pa1, PKV(lo1, hi1), o[d0]);
        o[d0] = MFMA32(pa2, PKV(lo2, hi2), o[d0]);
        o[d0] = MFMA32(pa3, PKV(lo3, hi3), o[d0]);
#undef PKV
    }
}
struct SmState { float mhat; f32x16 o[2]; f32x16 lacc; };
__device__ __forceinline__ unsigned bfe1(unsigned w, int c) { int r; asm("v_bfe_i32 %0, %1, %2, 1" : "=v"(r) : "v"(w), "n"(c)); return (unsigned)r; }
__device__ __forceinline__ float rowmax32(const f32x16& p0, const f32x16& p1) {
    float a = fmaxf(p0[0], p1[0]);
#pragma unroll
    for (int r = 1; r < 16; ++r) a = fmaxf(a, fmaxf(p0[r], p1[r]));
    return max_halves(a);
}
constexpr int NS_QF = 53248, NS_SELS = 86016, NS_SSUM = 118784, NS_SELM = 126976;
__device__ __forceinline__ unsigned range32(int lo, int up) {
    const int l2 = lo < 0 ? 0 : lo, u2 = up > 31 ? 31 : up;
    const unsigned hm = (u2 >= 31) ? ~0u : ((2u << (u2 & 31)) - 1u);
    const unsigned lm = (1u << (l2 & 31)) - 1u;
    return (up < 0 || lo > 31 || u2 < l2) ? 0u : (hm & ~lm);
}
struct M64 { unsigned x, y; };
__device__ __forceinline__ M64 mask_range(int lo, int up) { M64 m; m.x = range32(lo, up); m.y = range32(lo - 32, up - 32); return m; }
__device__ __forceinline__ void load_q(bf16x8* qr, const bf16* qp, const float* tab, bool rope, int hi) {
#pragma unroll
    for (int d0 = 0; d0 < 4; ++d0) {
        const v4u raw = *(const v4u*)(qp + 16 * d0);
        float x[8] = {bflo(raw.x), bfhi(raw.x), bflo(raw.y), bfhi(raw.y), bflo(raw.z), bfhi(raw.z), bflo(raw.w), bfhi(raw.w)};
        if (d0 == 0) {
#pragma unroll
            for (int j = 0; j < 8; ++j) { const float other = other_half_f(x[j], hi); const float c = tab[j], sn = tab[8 + j];
                const float rot = (hi == 0) ? (x[j] * c - other * sn) : (other * sn + x[j] * c); x[j] = rope ? rot : x[j]; }
        }
        v4u pk; pk.x = cvtpk(x[0] * C2, x[1] * C2); pk.y = cvtpk(x[2] * C2, x[3] * C2); pk.z = cvtpk(x[4] * C2, x[5] * C2); pk.w = cvtpk(x[6] * C2, x[7] * C2);
        qr[d0] = __builtin_bit_cast(bf16x8, pk);
    }
}
__device__ __forceinline__ void qkt_lq(f32x16& p0, f32x16& p1, const LAS unsigned char* Kslot, const LAS bf16x8* qf, int lane, int r32, int hi) {
    const LAS unsigned char* kb = Kslot + hi * 1024 + r32 * 16;
    p0 = f32x16{}; p1 = f32x16{};
#pragma unroll
    for (int d0 = 0; d0 < 4; ++d0) {
        const bf16x8 b0 = *(const LAS bf16x8*)(kb + d0 * 2048);
        const bf16x8 b1 = *(const LAS bf16x8*)(kb + d0 * 2048 + 512);
        const bf16x8 q = qf[d0 * 64 + lane];
        p0 = MFMA32(b0, q, p0); p1 = MFMA32(b1, q, p1);
        if (d0 & 1) __builtin_amdgcn_sched_barrier(0);
    }
}
template <bool SEL>
__device__ __forceinline__ void softmax_pv(SmState& st, f32x16& osel, f32x16& p0, f32x16& p1, unsigned vb, const M64 mcur, bool first, LAS float* wsf, int r32, int hi, int ctile) {
    (void)first; (void)wsf; (void)r32;
    const unsigned wx = mcur.x >> (4 * hi), wy = mcur.y >> (4 * hi);
    unsigned e0[16], e1[16];
#pragma unroll
    for (int r = 0; r < 16; ++r) { e0[r] = __builtin_bit_cast(unsigned, __builtin_amdgcn_exp2f(p0[r])); e1[r] = __builtin_bit_cast(unsigned, __builtin_amdgcn_exp2f(p1[r])); }
    if (FASTMASK_OFF || !__all((mcur.x & mcur.y) == ~0u)) {
#pragma unroll
        for (int r = 0; r < 16; ++r) { const int c = (r & 3) + 8 * (r >> 2); e0[r] &= bfe1(wx, c); e1[r] &= bfe1(wy, c); }
    }
#pragma unroll
    for (int r = 0; r < 16; ++r) { p0[r] = __builtin_bit_cast(float, e0[r]); p1[r] = __builtin_bit_cast(float, e1[r]); }
    unsigned pw[16];
#pragma unroll
    for (int k = 0; k < 8; ++k) { pw[k] = cvtpk(p0[2 * k], p0[2 * k + 1]); pw[8 + k] = cvtpk(p1[2 * k], p1[2 * k + 1]); }
    if (SEL) {
#pragma unroll
        for (int ks = 0; ks < 4; ++ks) {
            unsigned ov[4], pl[4];
#pragma unroll
            for (int k = 0; k < 4; ++k) {
                const int j0 = 2 * k, j1 = 2 * k + 1;
                const int c0 = 64 * ctile + 16 * ks + 8 * (j0 >> 2) + 4 * hi + (j0 & 3), c1 = 64 * ctile + 16 * ks + 8 * (j1 >> 2) + 4 * hi + (j1 & 3);
                const unsigned a = (c0 >= 4 * r32 - 1 && c0 <= 4 * r32 + 3) ? 0x3F80u : 0u, bq = (c1 >= 4 * r32 - 1 && c1 <= 4 * r32 + 3) ? 0x3F80u : 0u;
                ov[k] = a | (bq << 16);
                const int e = 4 * ks + k;
                const float v0 = (e < 8) ? p0[2 * e] : p1[2 * (e - 8)], v1 = (e < 8) ? p0[2 * e + 1] : p1[2 * (e - 8) + 1];
                pl[k] = cvtpk(v0 - bflo(pw[e]), v1 - bfhi(pw[e]));
            }
            const bf16x8 ovf = __builtin_bit_cast(bf16x8, (v4u){ov[0], ov[1], ov[2], ov[3]});
            osel = MFMA32(__builtin_bit_cast(bf16x8, (v4u){pw[4 * ks], pw[4 * ks + 1], pw[4 * ks + 2], pw[4 * ks + 3]}), ovf, osel);
            osel = MFMA32(__builtin_bit_cast(bf16x8, (v4u){pl[0], pl[1], pl[2], pl[3]}), ovf, osel);
        }
    }
    pv(st.o, st.lacc, vb, __builtin_bit_cast(bf16x8, (v4u){pw[0], pw[1], pw[2], pw[3]}), __builtin_bit_cast(bf16x8, (v4u){pw[4], pw[5], pw[6], pw[7]}),
       __builtin_bit_cast(bf16x8, (v4u){pw[8], pw[9], pw[10], pw[11]}), __builtin_bit_cast(bf16x8, (v4u){pw[12], pw[13], pw[14], pw[15]}));
}
template <bool SEL>
__device__ __forceinline__ void tile_step(SmState& st, f32x16& osel, const LAS unsigned char* Kslot, unsigned vb, const LAS bf16x8* qf, const M64 mcur, bool first, LAS float* wsf, int lane, int r32, int hi, int ctile) {
    f32x16 p0, p1;
    qkt_lq(p0, p1, Kslot, qf, lane, r32, hi);
    softmax_pv<SEL>(st, osel, p0, p1, vb, mcur, first, wsf, r32, hi, ctile);
}
__device__ __forceinline__ void qkt_rq(f32x16& p0, f32x16& p1, const LAS unsigned char* Kslot, const bf16x8* qr, int r32, int hi) {
    const LAS unsigned char* kb = Kslot + hi * 1024 + r32 * 16;
    p0 = f32x16{}; p1 = f32x16{};
#pragma unroll
    for (int d0 = 0; d0 < 4; ++d0) {
        const bf16x8 b0 = *(const LAS bf16x8*)(kb + d0 * 2048);
        const bf16x8 b1 = *(const LAS bf16x8*)(kb + d0 * 2048 + 512);
        p0 = MFMA32(b0, qr[d0], p0); p1 = MFMA32(b1, qr[d0], p1);
    }
}
__device__ __forceinline__ void sm_reset(SmState& st) { st.mhat = 0.f; st.o[0] = f32x16{}; st.o[1] = f32x16{}; st.lacc = f32x16{}; }
__device__ __forceinline__ float sigmoidf_(float x) { return 1.f / (1.f + __expf(-x)); }

__device__ __forceinline__ void dsa_attn_unit(unsigned char* ws_, int tid_, int b, int qt, LAS unsigned char* lds) {
    asm volatile("" : "+v"(tid_)); asm volatile("" : "+s"(ws_));
    const int lane = tid_ & 63, wid = __builtin_amdgcn_readfirstlane(tid_ >> 6), r32 = lane & 31, hi = lane >> 5;
    const int h = wid >> 1, qh = wid & 1;
    const size_t qrow = (size_t)b * S + 64 * qt + 32 * qh + r32;
    LAS float* wsf = (LAS float*)(lds + AT_WS) + wid * 128;
    bf16x8 qr[4];
    {
        const bf16* qp = B_PROJ + qrow * NP + C_QA + h * 64 + 8 * hi;
        const float* tab = B_ROPE + qrow * 24;
#pragma unroll
        for (int d0 = 0; d0 < 4; ++d0) {
            const v4u raw = *(const v4u*)(qp + 16 * d0);
            float x[8] = {bflo(raw.x), bfhi(raw.x), bflo(raw.y), bfhi(raw.y), bflo(raw.z), bfhi(raw.z), bflo(raw.w), bfhi(raw.w)};
            if (d0 == 0) {
#pragma unroll
                for (int j = 0; j < 8; ++j) { const float other = other_half_f(x[j], hi); const float c = tab[j], sn = tab[8 + j];
                    x[j] = (hi == 0) ? (x[j] * c - other * sn) : (other * sn + x[j] * c); }
            }
            v4u pk; pk.x = cvtpk(x[0] * C2, x[1] * C2); pk.y = cvtpk(x[2] * C2, x[3] * C2); pk.z = cvtpk(x[4] * C2, x[5] * C2); pk.w = cvtpk(x[6] * C2, x[7] * C2);
            qr[d0] = __builtin_bit_cast(bf16x8, pk);
        }
    }
    LAS bf16x8* qf = (LAS bf16x8*)(lds + NS_QF) + wid * 256;
#pragma unroll
    for (int d0 = 0; d0 < 4; ++d0) qf[d0 * 64 + lane] = qr[d0];
    const bf16* KAb = B_PROJ + (size_t)b * S * NP;
    const bf16* ksrc = KAb + (size_t)lane * NP + C_KA + wid * 8;
    const bf16* vsrc = KAb + (size_t)(16 * (wid & 3) + (lane >> 2)) * NP + C_VA + (wid >> 2) * 32 + (lane & 3) * 8;
#define AT_DMA(t, slot) do { \
        __builtin_amdgcn_global_load_lds((const unsigned*)(ksrc + (size_t)(t) * 64 * NP), (LAS unsigned*)(lds + AT_K + (slot) * 8192 + wid * 1024), 16, 0, 0); \
        __builtin_amdgcn_global_load_lds((const unsigned*)(vsrc + (size_t)(t) * 64 * NP), (LAS unsigned*)(lds + AT_V + (slot) * 8192 + wid * 1024), 16, 0, 0); } while (0)
    const unsigned vb0 = (unsigned)(uintptr_t)(lds + AT_V) + ((lane >> 4) & 1) * 32 + (lane & 3) * 8 + (4 * hi + ((lane & 15) >> 2)) * 64;
    const int NT = qt + 1;
    SmState st; sm_reset(st);
    const unsigned long long* mrow = (const unsigned long long*)((const unsigned*)(ws_ + WS_MASK) + qrow * 64);
    AT_DMA(0, 0);
    unsigned long long m0 = mrow[0], m1 = 0ull, m2 = 0ull;
    if (NT > 1) { AT_DMA(1, 1); m1 = mrow[1]; }
    int cs = 0, is = 2;
    f32x16 osel_unused = {};
#define AT_NEXT(c_) (((c_) == 2) ? 0 : (c_) + 1)
    for (int t = 0; t < NT; ++t) {
        if (t + 1 < NT) asm volatile("s_waitcnt vmcnt(3)" ::: "memory"); else asm volatile("s_waitcnt vmcnt(0)" ::: "memory");
        wg_barrier();
        if (t + 2 < NT) { AT_DMA(t + 2, is); m2 = mrow[t + 2]; }
        const unsigned long long mcur_ = m0; m0 = m1; m1 = m2;
        f32x16 p0, p1;
        qkt_lq(p0, p1, lds + AT_K + cs * 8192, qf, lane, r32, hi);
        softmax_pv<false>(st, osel_unused, p0, p1, vb0 + cs * 8192, (M64){(unsigned)mcur_, (unsigned)(mcur_ >> 32)}, t == 0, wsf, r32, hi, 0);
        cs = AT_NEXT(cs); is = AT_NEXT(is);
    }
#undef AT_NEXT
#undef AT_DMA
    {
        bf16* ob = B_MIX + ((size_t)b * S + 64 * qt + 32 * qh) * D + h * 64 + r32;
#pragma unroll
        for (int r = 0; r < 16; ++r) { const int rq = crow(r, hi); const float f = __builtin_amdgcn_rcpf(st.lacc[r]);
            ob[(size_t)rq * D] = (bf16)f2bf(st.o[0][r] * f); ob[(size_t)rq * D + 32] = (bf16)f2bf(st.o[1][r] * f); }
    }
    __syncthreads();
}


template <bool SEL>
__device__ __forceinline__ void nsa_unit(unsigned char* ws_, int tid_, int b, int g, int qt, LAS unsigned char* lds) {
    asm volatile("" : "+v"(tid_)); asm volatile("" : "+s"(ws_));
    const int lane = tid_ & 63, wid = __builtin_amdgcn_readfirstlane(tid_ >> 6), r32 = lane & 31, hi = lane >> 5;
    const int hr = wid >> 1, qh = wid & 1, H = 4 * g + hr;
    const int tq = 64 * qt + 32 * qh + r32;
    const size_t qrow = (size_t)b * S + tq;
    LAS float* wsf = (LAS float*)(lds + AT_WS) + wid * 128;
    const unsigned vb0 = (unsigned)(uintptr_t)(lds + AT_V) + ((lane >> 4) & 1) * 32 + (lane & 3) * 8 + (4 * hi + ((lane & 15) >> 2)) * 64;
    const bf16* kcb = (const bf16*)(ws_ + WS_KCB) + (size_t)(b * 2 + g) * 128 * 64;
    const bf16* vcb = (const bf16*)(ws_ + WS_VCB) + (size_t)(b * 2 + g) * 128 * 64;
    const bf16* pb = B_PROJ + (size_t)b * S * NP + g * 64;
    const int vrow = 16 * (wid & 3) + (lane >> 2), vcol = (wid >> 2) * 32 + (lane & 3) * 8;
#define NS_DMA(kp_, vp_, slot_) do { \
        __builtin_amdgcn_global_load_lds((const unsigned*)(kp_), (LAS unsigned*)(lds + AT_K + (slot_) * 8192 + wid * 1024), 16, 0, 0); \
        __builtin_amdgcn_global_load_lds((const unsigned*)(vp_), (LAS unsigned*)(lds + AT_V + (slot_) * 8192 + wid * 1024), 16, 0, 0); } while (0)
#define NS_DMA_CMP(i_, slot_) NS_DMA(kcb + (size_t)(64 * (i_) + lane) * 64 + wid * 8, vcb + (size_t)(64 * (i_) + vrow) * 64 + vcol, slot_)
#define NS_DMA_PROJ(ck_, cv_, j_, slot_) NS_DMA(pb + (size_t)(64 * (j_) + lane) * NP + (ck_) + wid * 8, pb + (size_t)(64 * (j_) + vrow) * NP + (cv_) + vcol, slot_)
    const int ncmp = (qt >= 16) ? 2 : 1;
    const int jw0 = (qt > 8) ? qt - 8 : 0, nwin = qt - jw0 + 1;
    if (hi == 0) { const bf16* gp = B_PROJ + qrow * NP + C_GATE + H * 3;
        wsf[64 + r32] = sigmoidf_(bf2f(gp[0])); wsf[96 + r32] = sigmoidf_(bf2f(gp[2])); wsf[32 + r32] = sigmoidf_(bf2f(gp[1])); }
    int nissued = 0, islot = 0, ti = 0, cslot = 0;
    unsigned remI = SEL ? 0u : ((2u << qt) - 1u);
#define NS_ISSUE() do { \
        if (nissued < ncmp) { NS_DMA_CMP(nissued, islot); } \
        else if (nissued < ncmp + nwin) { NS_DMA_PROJ(C_KWIN, C_VWIN, jw0 + nissued - ncmp, islot); } \
        else if (remI) { const int j_ = __builtin_ctz(remI); remI &= remI - 1u; NS_DMA_PROJ(C_KSLC, C_VSLC, j_, islot); } \
        else break; \
        ++nissued; islot = (islot == 2) ? 0 : islot + 1; } while (0)
#define NS_TOP() do { if (nissued > ti + 1) asm volatile("s_waitcnt vmcnt(2)" ::: "memory"); else asm volatile("s_waitcnt vmcnt(0)" ::: "memory"); wg_barrier(); NS_ISSUE(); } while (0)
#define NS_ADV() do { ++ti; cslot = (cslot == 2) ? 0 : cslot + 1; } while (0)
    NS_ISSUE(); NS_ISSUE();
    LAS bf16x8* qf = (LAS bf16x8*)(lds + NS_QF) + wid * 256;
    { bf16x8 qr[4]; load_q(qr, B_PROJ + qrow * NP + C_QB + H * 64 + 8 * hi, B_ROPE + qrow * 24, false, hi);
#pragma unroll
      for (int d0 = 0; d0 < 4; ++d0) qf[d0 * 64 + lane] = qr[d0]; }
    SmState st; sm_reset(st);
    f32x16 osel = {};
    unsigned oaccp[16];
    const int ncv = (tq >= 31) ? (((tq - 31) >> 4) + 1) : 0;
    for (int i = 0; i < ncmp; ++i) {
        NS_TOP();
        const M64 m = mask_range(0, ncv - 64 * i - 1);
        tile_step<SEL>(st, osel, lds + AT_K + cslot * 8192, vb0 + cslot * 8192, qf, m, i == 0, wsf, lane, r32, hi, i);
        NS_ADV();
    }
    {
        asm volatile("s_waitcnt lgkmcnt(0)" ::: "memory");
        LAS float* sels = (LAS float*)(lds + NS_SELS);
#pragma unroll
        for (int r = 0; r < 16; ++r) { const int rq = crow(r, hi); const float lt = st.lacc[r]; const float inv = lt > 0.f ? __builtin_amdgcn_rcpf(lt) : 0.f; const float f2 = wsf[64 + rq] * inv;
            oaccp[r] = cvtpk(st.o[0][r] * f2, st.o[1][r] * f2);
            if (SEL) sels[(hr * 64 + 32 * qh + rq) * 32 + r32] = osel[r] * inv; }
        asm volatile("s_waitcnt lgkmcnt(0)" ::: "memory");
    }
    unsigned selunion;
    if (SEL) {
        wg_barrier();
        LAS float* sels = (LAS float*)(lds + NS_SELS);
        LAS float* ssum = (LAS float*)(lds + NS_SSUM);
        LAS unsigned* selm = (LAS unsigned*)(lds + NS_SELM);
        const int q = tid_ >> 3, jg = tid_ & 7;
        f32x4 s4 = *(const LAS f32x4*)(sels + (0 * 64 + q) * 32 + 4 * jg);
        s4 += *(const LAS f32x4*)(sels + (1 * 64 + q) * 32 + 4 * jg);
        s4 += *(const LAS f32x4*)(sels + (2 * 64 + q) * 32 + 4 * jg);
        s4 += *(const LAS f32x4*)(sels + (3 * 64 + q) * 32 + 4 * jg);
        *(LAS f32x4*)(ssum + q * 32 + 4 * jg) = s4;
        asm volatile("s_waitcnt lgkmcnt(0)" ::: "memory");
        float sv[32];
#pragma unroll
        for (int k = 0; k < 8; ++k) { const f32x4 v = *(const LAS f32x4*)(ssum + q * 32 + 4 * k); sv[4 * k] = v.x; sv[4 * k + 1] = v.y; sv[4 * k + 2] = v.z; sv[4 * k + 3] = v.w; }
        const float PINF = __builtin_inff();
#pragma unroll
        for (int i = 0; i < 32; ++i) sv[i] = (i > qt) ? -PINF : ((i == 0 || i == qt || i == qt - 1) ? PINF : sv[i]);
        unsigned bits4 = 0u;
#pragma unroll
        for (int jj = 0; jj < 4; ++jj) {
            const int j = 4 * jg + jj;
            float mine = (jj == 0) ? s4.x : (jj == 1) ? s4.y : (jj == 2) ? s4.z : s4.w;
            mine = (j > qt) ? -PINF : ((j == 0 || j == qt || j == qt - 1) ? PINF : mine);
            int rank = 0;
#pragma unroll
            for (int i = 0; i < 32; ++i) rank += ((sv[i] > mine) || (sv[i] == mine && i < j)) ? 1 : 0;
            bits4 |= (rank < 16) ? (1u << jj) : 0u;
        }
        unsigned mm = bits4 << (4 * jg);
        mm |= (unsigned)dpp_i<0xB1>((int)mm); mm |= (unsigned)dpp_i<0x4E>((int)mm); mm |= (unsigned)dpp_i<0x141>((int)mm);
        if (jg == 0) selm[q] = mm;
        wg_barrier();
        unsigned u = selm[lane];
        u = or_halves(or32(u));
        selunion = (unsigned)__builtin_amdgcn_readfirstlane((int)u);
    } else {
        selunion = (2u << qt) - 1u;
    }
    { bf16x8 qr[4]; load_q(qr, B_PROJ + qrow * NP + C_QB + H * 64 + 8 * hi, B_ROPE + qrow * 24, true, hi);
#pragma unroll
      for (int d0 = 0; d0 < 4; ++d0) qf[d0 * 64 + lane] = qr[d0]; }
    sm_reset(st);
    if (SEL) remI = selunion;
    for (int j = jw0; j <= qt; ++j) {
        NS_TOP();
        const M64 m = mask_range(tq - 511 - 64 * j, tq - 64 * j);
        tile_step<false>(st, osel, lds + AT_K + cslot * 8192, vb0 + cslot * 8192, qf, m, j == jw0, wsf, lane, r32, hi, 0);
        NS_ADV();
    }
    {
        asm volatile("s_waitcnt lgkmcnt(0)" ::: "memory");
#pragma unroll
        for (int r = 0; r < 16; ++r) { const float lt = st.lacc[r]; const float f2 = lt > 0.f ? wsf[96 + crow(r, hi)] * __builtin_amdgcn_rcpf(lt) : 0.f; oaccp[r] = cvtpk(bflo(oaccp[r]) + st.o[0][r] * f2, bfhi(oaccp[r]) + st.o[1][r] * f2); }
        asm volatile("s_waitcnt lgkmcnt(0)" ::: "memory");
    }
    sm_reset(st);
    bool firstb = true;
    unsigned rem = selunion;
    while (rem) {
        const int j = __builtin_ctz(rem); rem &= rem - 1u;
        NS_TOP();
        const unsigned mysel_ = SEL ? ((const LAS unsigned*)(lds + NS_SELM))[32 * qh + r32] : ((2u << qt) - 1u);
        M64 m = mask_range(0, tq - 64 * j); if (!((mysel_ >> j) & 1u)) { m.x = 0u; m.y = 0u; }
        tile_step<false>(st, osel, lds + AT_K + cslot * 8192, vb0 + cslot * 8192, qf, m, firstb, wsf, lane, r32, hi, 0);
        firstb = false; NS_ADV();
    }
    {
        asm volatile("s_waitcnt lgkmcnt(0)" ::: "memory");
        bf16* ob = B_MIX + ((size_t)b * S + 64 * qt + 32 * qh) * D + 256 + H * 64 + r32;
#pragma unroll
        for (int r = 0; r < 16; ++r) { const int rq = crow(r, hi); const float lt = st.lacc[r]; const float f2 = lt > 0.f ? wsf[32 + rq] * __builtin_amdgcn_rcpf(lt) : 0.f;
            ob[(size_t)rq * D] = (bf16)f2bf(bflo(oaccp[r]) + st.o[0][r] * f2); ob[(size_t)rq * D + 32] = (bf16)f2bf(bfhi(oaccp[r]) + st.o[1][r] * f2); }
    }
    __syncthreads();
#undef NS_DMA
#undef NS_DMA_CMP
#undef NS_DMA_PROJ
#undef NS_ISSUE
#undef NS_TOP
#undef NS_ADV
}

__device__ __forceinline__ void phase_attn(Frame& F, int l) {
    (void)l;
    unsigned char* ws_ = F.ws; asm volatile("" : "+s"(ws_)); int lane_ = lane_id(); asm volatile("" : "+v"(lane_)); (void)ws_;
    int tid_ = F.wave * 64 + lane_id(); asm volatile("" : "+v"(tid_));
    for (int u = F.vcu; u < BATCH * 64; u += F.G) {
        const int c = u & 255, i = u >> 8; const int b = c >> 3, sft = c & 7; const int base = 16 * (i >> 1); const int qt32 = (i & 1) ? base + 15 - sft : base + sft;
        dsa_select_unit(ws_, tid_, b, qt32, F.lds);
    }
    __syncthreads();
#if PROBE_MASK
    if (blockIdx.x == 0 && F.wave == 0 && lane_id() == 0) { const unsigned long long ts_ = __builtin_amdgcn_s_memrealtime(); F.MISC[16] = (unsigned)ts_; F.MISC[17] = (unsigned)(ts_ >> 32); }
#endif
    for (int u = F.vcu; u < BATCH * 64; u += F.G) {
        const int c = u & 255, i = u >> 8; const int b = c >> 3, sft = c & 7; const int g = i & 1, k = i >> 1; const int base = 16 * (k >> 1); const int qt = (k & 1) ? base + 15 - sft : base + sft;
        if (qt >= 16) nsa_unit<true>(ws_, tid_, b, g, qt, F.lds); else nsa_unit<false>(ws_, tid_, b, g, qt, F.lds);
    }
}
__device__ __forceinline__ void phase_dsa_attn(Frame& F) {
    unsigned char* ws_ = F.ws; asm volatile("" : "+s"(ws_));
    int tid_ = F.wave * 64 + lane_id(); asm volatile("" : "+v"(tid_));
    for (int u = F.vcu; u < BATCH * 32; u += F.G) {
        const int c = u & 255, i = u >> 8; const int b = c >> 3, sft = c & 7; const int base = 16 * (i >> 1); const int qt = (i & 1) ? base + 15 - sft : base + sft;
        dsa_attn_unit(ws_, tid_, b, qt, F.lds);
    }
}

constexpr int WP_PITCH = 72;
__device__ __forceinline__ void phase_merge(Frame& F, const Args& args, int l) {
    unsigned char* ws_ = F.ws; asm volatile("" : "+s"(ws_)); int lane_ = lane_id(); asm volatile("" : "+v"(lane_)); (void)ws_;
    int tid_ = F.wave * 64 + lane_id(); asm volatile("" : "+v"(tid_));
    const int gw = F.vcu * NWAVES + F.wave, NGW = F.G * NWAVES, lane = lane_;
    const float* psc = P_POOL_SCALE + l * 256;
    const float* goa = P_G_OUT_A + l * 256; const float* gob = P_G_OUT_B + l * 512;
    LAS bf16* wp = (LAS bf16*)F.lds;
    {
        const float* wsrc = P_W_POOL + (size_t)l * 4 * 64 * 64;
        for (int idx = tid_; idx < 4 * 64 * 64; idx += 512) { const int g = idx >> 12, c = (idx >> 6) & 63, d = idx & 63; wp[(g * 64 + d) * WP_PITCH + c] = (bf16)f2bf(wsrc[idx]); }
    }
    {
        constexpr int RB = 4;
        const f32x4 gga = ((const f32x4*)goa)[lane]; const f32x4 gb0 = ((const f32x4*)gob)[2 * lane], gb1 = ((const f32x4*)gob)[2 * lane + 1];
        for (int row0 = gw * RB; row0 < M; row0 += NGW * RB) {
            unsigned long long ua[RB]; v4u ub[RB];
#pragma unroll
            for (int k = 0; k < RB; ++k) { const bf16* mrow = B_MIX + (size_t)(row0 + k) * D; ua[k] = *((const unsigned long long*)mrow + lane); ub[k] = *((const v4u*)(mrow + 256) + lane); }
#pragma unroll
            for (int k = 0; k < RB; ++k) { bf16* mrow = B_MIX + (size_t)(row0 + k) * D;
                { const unsigned long long u = ua[k];
                  const float a0 = bflo((unsigned)u), a1 = bfhi((unsigned)u), a2 = bflo((unsigned)(u >> 32)), a3 = bfhi((unsigned)(u >> 32));
                  const float rs = rsqrtf(wave_sum((a0 * a0 + a1 * a1) + (a2 * a2 + a3 * a3)) * (1.f / 256.f) + EPS);
                  *((unsigned long long*)mrow + lane) = (unsigned long long)pk2(a0 * rs * gga.x, a1 * rs * gga.y) | ((unsigned long long)pk2(a2 * rs * gga.z, a3 * rs * gga.w) << 32); }
                { const v4u u = ub[k];
                  float a[8] = {bflo(u.x), bfhi(u.x), bflo(u.y), bfhi(u.y), bflo(u.z), bfhi(u.z), bflo(u.w), bfhi(u.w)};
                  float ss = 0.f;
#pragma unroll
                  for (int i = 0; i < 8; ++i) ss += a[i] * a[i];
                  const float rs = rsqrtf(wave_sum(ss) * (1.f / 512.f) + EPS);
                  v4u o; o.x = pk2(a[0] * rs * gb0.x, a[1] * rs * gb0.y); o.y = pk2(a[2] * rs * gb0.z, a[3] * rs * gb0.w); o.z = pk2(a[4] * rs * gb1.x, a[5] * rs * gb1.y); o.w = pk2(a[6] * rs * gb1.z, a[7] * rs * gb1.w);
                  *((v4u*)(mrow + 256) + lane) = o; }
            }
        }
    }
    __syncthreads();
    {
        const int r32 = lane & 31, hi = lane >> 5;
        for (int tile = gw; tile < M / 32; tile += NGW) {
            const int row = 32 * tile + r32, t = row % S;
            const bf16* up = B_PROJ + (size_t)row * NP + C_UC + 8 * hi;
            f32x16 acc[4][2];
#pragma unroll
            for (int g = 0; g < 4; ++g) {
                acc[g][0] = f32x16{}; acc[g][1] = f32x16{};
                const int w = 2 << g;
                const float icnt = 1.f / (float)((t + 1 < w) ? t + 1 : w);
#pragma unroll
                for (int ks = 0; ks < 4; ++ks) {
                    const bf16* p0 = up + g * 64 + 16 * ks;
                    const v4u u0 = *(const v4u*)p0;
                    float cur[8] = {bflo(u0.x), bfhi(u0.x), bflo(u0.y), bfhi(u0.y), bflo(u0.z), bfhi(u0.z), bflo(u0.w), bfhi(u0.w)};
                    float sum[8];
#pragma unroll
                    for (int j = 0; j < 8; ++j) sum[j] = cur[j];
#pragma unroll
                    for (int i = 1; i < w; ++i) {
                        if (t - i >= 0) { const v4u ui = *(const v4u*)(p0 - (size_t)i * NP);
                            sum[0] += bflo(ui.x); sum[1] += bfhi(ui.x); sum[2] += bflo(ui.y); sum[3] += bfhi(ui.y); sum[4] += bflo(ui.z); sum[5] += bfhi(ui.z); sum[6] += bflo(ui.w); sum[7] += bfhi(ui.w); }
                    }
                    v4u pk; pk.x = cvtpk(sum[0] * icnt - cur[0], sum[1] * icnt - cur[1]); pk.y = cvtpk(sum[2] * icnt - cur[2], sum[3] * icnt - cur[3]);
                    pk.z = cvtpk(sum[4] * icnt - cur[4], sum[5] * icnt - cur[5]); pk.w = cvtpk(sum[6] * icnt - cur[6], sum[7] * icnt - cur[7]);
                    const bf16x8 af = __builtin_bit_cast(bf16x8, pk);
#pragma unroll
                    for (int nb = 0; nb < 2; ++nb) {
                        const bf16x8 bfr = *(const LAS bf16x8*)(wp + (g * 64 + 32 * nb + r32) * WP_PITCH + 16 * ks + 8 * hi);
                        acc[g][nb] = MFMA32(af, bfr, acc[g][nb]);
                    }
                }
            }
            float ss[16];
#pragma unroll
            for (int r = 0; r < 16; ++r) { float a = 0.f;
#pragma unroll
                for (int g = 0; g < 4; ++g) a += acc[g][0][r] * acc[g][0][r] + acc[g][1][r] * acc[g][1][r];
                a = sum32(a);
                ss[r] = rsqrtf(a * (1.f / 256.f) + EPS); }
            bf16* ob = B_MIX + (size_t)(32 * tile) * D + 768 + r32;
#pragma unroll
            for (int g = 0; g < 4; ++g)
#pragma unroll
                for (int nb = 0; nb < 2; ++nb) { const float sc = psc[g * 64 + 32 * nb + r32];
#pragma unroll
                    for (int r = 0; r < 16; ++r) ob[(size_t)crow(r, hi) * D + g * 64 + 32 * nb] = (bf16)f2bf(acc[g][nb][r] * ss[r] * sc); }
        }
    }
    __syncthreads();
}

template <bool XIN_F32, bool OUT_F32>
__device__ __forceinline__ void phase_finish(Frame& F, const float* xsrc, const float* gpost, const float* gnext  ) {
    unsigned char* ws_ = F.ws; asm volatile("" : "+s"(ws_)); int lane_ = lane_id(); asm volatile("" : "+v"(lane_)); (void)ws_;
    const int gw = F.vcu * NWAVES + F.wave, NGW = F.G * NWAVES, lane = lane_;
    bf16* xb = (bf16*)(ws_ + WS_XB);
    constexpr int RB = 4;
    for (int row0 = gw * RB; row0 < M; row0 += NGW * RB) {
        v4u fu[RB][2]; float x[RB][2][8];
#pragma unroll
        for (int k = 0; k < RB; ++k) { const size_t row = (size_t)(row0 + k);
#pragma unroll
            for (int j = 0; j < 2; ++j) { fu[k][j] = *((const v4u*)(B_F + row * D + 512 * j) + lane);
                if (XIN_F32) { const f32x4 a = *((const f32x4*)(xsrc + row * D + 512 * j) + 2 * lane), c = *((const f32x4*)(xsrc + row * D + 512 * j) + 2 * lane + 1);
                    x[k][j][0] = a.x; x[k][j][1] = a.y; x[k][j][2] = a.z; x[k][j][3] = a.w; x[k][j][4] = c.x; x[k][j][5] = c.y; x[k][j][6] = c.z; x[k][j][7] = c.w; }
                else { const v4u ux = *((const v4u*)(xb + row * D + 512 * j) + lane);
                    x[k][j][0] = bflo(ux.x); x[k][j][1] = bfhi(ux.x); x[k][j][2] = bflo(ux.y); x[k][j][3] = bfhi(ux.y); x[k][j][4] = bflo(ux.z); x[k][j][5] = bfhi(ux.z); x[k][j][6] = bflo(ux.w); x[k][j][7] = bfhi(ux.w); } } }
        float gp[2][8];
#pragma unroll
        for (int j = 0; j < 2; ++j) { const f32x4 a = *((const f32x4*)(gpost + 512 * j) + 2 * lane), c = *((const f32x4*)(gpost + 512 * j) + 2 * lane + 1);
            gp[j][0] = a.x; gp[j][1] = a.y; gp[j][2] = a.z; gp[j][3] = a.w; gp[j][4] = c.x; gp[j][5] = c.y; gp[j][6] = c.z; gp[j][7] = c.w;
 }
#pragma unroll
        for (int k = 0; k < RB; ++k) { const size_t row = (size_t)(row0 + k);
            float f[2][8]; float ss = 0.f;
#pragma unroll
            for (int j = 0; j < 2; ++j) { const v4u u = fu[k][j];
                f[j][0] = bflo(u.x); f[j][1] = bfhi(u.x); f[j][2] = bflo(u.y); f[j][3] = bfhi(u.y); f[j][4] = bflo(u.z); f[j][5] = bfhi(u.z); f[j][6] = bflo(u.w); f[j][7] = bfhi(u.w);
#pragma unroll
                for (int e = 0; e < 8; ++e) ss += f[j][e] * f[j][e]; }
            const float rs = rsqrtf(wave_sum(ss) * (1.f / D) + EPS);
            float s2 = 0.f;
#pragma unroll
            for (int j = 0; j < 2; ++j) {
#pragma unroll
                for (int e = 0; e < 8; ++e) { const float xv = x[k][j][e] + f[j][e] * rs * gp[j][e]; x[k][j][e] = xv; s2 += xv * xv; }
                if (OUT_F32) { f32x4* o = (f32x4*)(F.out + row * D + 512 * j) + 2 * lane;
                    o[0] = (f32x4){x[k][j][0], x[k][j][1], x[k][j][2], x[k][j][3]}; o[1] = (f32x4){x[k][j][4], x[k][j][5], x[k][j][6], x[k][j][7]}; }
                else *((v4u*)(xb + row * D + 512 * j) + lane) = (v4u){pk2(x[k][j][0], x[k][j][1]), pk2(x[k][j][2], x[k][j][3]), pk2(x[k][j][4], x[k][j][5]), pk2(x[k][j][6], x[k][j][7])};
            }
            if (gnext) { const float r2 = rsqrtf(wave_sum(s2) * (1.f / D) + EPS); if (lane == 0) ((float*)(ws_ + WS_RS))[row] = r2; }
        }
    }
}

template <int ACT>
__device__ __forceinline__ void phase_gemm(Frame& F, const bf16* A, const bf16* Bt, bf16* O, int N, int K, const float* rs) {
    asm volatile("" : "+s"(A), "+s"(Bt), "+s"(O), "+s"(rs));
    int bx_ = (int)blockIdx.x, gg_ = F.G; asm volatile("" : "+s"(bx_), "+s"(gg_));
    pg8::Gemm g{A, Bt, M, N, K}; pg8::StaticOrder So; So.init(M, N, gg_, bx_);
    pg8::EpiStore<ACT> E{O, N, rs};
    pg8::gemm_phase<pg8::EpiStore<ACT>, pg8::StaticOrder, true, true>(F.lds, g, So, E, F.wave);
}

constexpr int PH_PER_LAYER = 10, NPHASES = 2 + DEPTH * PH_PER_LAYER;
__global__ void __launch_bounds__(NWAVES * 64, 2) mk_fwd(Args args) {
    extern __shared__ __attribute__((aligned(16))) unsigned char lds[];
    Frame F;
    F.lds = (LAS unsigned char*)lds;
    F.MISC = (volatile LAS unsigned*)(F.lds + MISC_OFF);
    { const int t0_ = threadIdx.x; F.wave = __builtin_amdgcn_readfirstlane(t0_ >> 6);
      for (int u = t0_; u < (LDS_BYTES - LDSCTL_OFF) / 4; u += NWAVES * 64) ((LAS unsigned*)(F.lds + LDSCTL_OFF))[u] = 0u; }
    F.G = gridDim.x; { const int bx = blockIdx.x; F.vcu = (F.G % 8 == 0) ? (bx % 8) * (F.G / 8) + bx / 8 : bx; }
    unsigned char* ws = args.ws; F.ws = ws;
    F.ctl = (gu32*)(ws + WS_CTL);
    F.out = args.out;
    __syncthreads();
    XcdBarrier bar; bar.bar = (unsigned*)(F.ctl + CW_BAR); bar.x = 0; bar.st = F.MISC + 8; bar.wv = 0;
    if (args.use_bar) bar = xcd_barrier_post((unsigned*)(F.ctl + CW_BAR), F.MISC + 8);
    bar.wv = F.wave;
    const int lo = args.ph_lo, hi = args.ph_hi;
    int pid = 0;
    unsigned char* ws_ = F.ws;
#define PH_ON (pid >= lo && pid < hi)
#if PROBE_MASK
    if (blockIdx.x == 0 && F.wave == 0 && lane_id() == 0) { const unsigned long long t_ = __builtin_amdgcn_s_memrealtime(); F.MISC[18] = (unsigned)t_; F.MISC[19] = (unsigned)(t_ >> 32); F.MISC[20] = 0u; F.MISC[21] = 0u; }
#define PH_END(kind) do { if (PH_ON && pid + 1 < hi) xcd_barrier(bar); ++pid; \
        if (blockIdx.x == 0 && F.wave == 0 && lane_id() == 0) { const unsigned long long now_ = __builtin_amdgcn_s_memrealtime(); \
          const unsigned long long last_ = (unsigned long long)F.MISC[18] | ((unsigned long long)F.MISC[19] << 32); unsigned long long acc_ = (unsigned long long)F.MISC[20] | ((unsigned long long)F.MISC[21] << 32); \
          if ((kind) == 3) { const unsigned long long sp_ = (unsigned long long)F.MISC[16] | ((unsigned long long)F.MISC[17] << 32); \
              if ((PROBE_MASK >> 11) & 1) acc_ += sp_ - last_; if ((PROBE_MASK >> 3) & 1) acc_ += now_ - sp_; } \
          else if ((PROBE_MASK >> (kind)) & 1) acc_ += now_ - last_; \
          F.MISC[18] = (unsigned)now_; F.MISC[19] = (unsigned)(now_ >> 32); F.MISC[20] = (unsigned)acc_; F.MISC[21] = (unsigned)(acc_ >> 32); } } while (0)
#else
#define PH_END(kind) do { if (PH_ON && pid + 1 < hi) xcd_barrier(bar); ++pid; } while (0)
#endif

    if (PH_ON && !(SKIPM & 1)) phase_prologue(F, args);
    PH_END(0);
    if (PH_ON && !(SKIPM & 1)) phase_prologue_b(F, args);
    PH_END(0);
    for (int l = 0; l < DEPTH; ++l) {
        unsigned char* ws_ = F.ws; asm volatile("" : "+s"(ws_));
        if (PH_ON && !(SKIPM & 2)) phase_gemm<0>(F, (const bf16*)(ws_ + WS_XB), w_in_t(ws_, l), B_PROJ, NP, D, (const float*)(ws_ + WS_RS));
        PH_END(1);
        if (PH_ON && !(SKIPM & 4)) phase_prep(F, args, l);
        PH_END(2);
        if (PH_ON && !(SKIPM & 8)) phase_attn(F, l);
        PH_END(3);
        if (PH_ON && !(SKIPM & 8)) phase_dsa_attn(F);
        PH_END(4);
        if (PH_ON && !(SKIPM & 16)) phase_merge(F, args, l);
        PH_END(5);
        if (PH_ON && !(SKIPM & 32)) phase_gemm<0>(F, B_MIX, w_out_t(ws_, l), B_F, D, D, nullptr);
        PH_END(6);
        if (PH_ON && !(SKIPM & 64)) { if (l == 0) phase_finish<true, false>(F, P_X_IN, P_G_POST_MIX + l * D, P_G_PRE_MLP + l * D); else phase_finish<false, false>(F, nullptr, P_G_POST_MIX + l * D, P_G_PRE_MLP + l * D); }
        PH_END(7);
        if (PH_ON && !(SKIPM & 128)) phase_gemm<2>(F, (const bf16*)(ws_ + WS_XB), w_up_t(ws_, l), B_HID, FF, D, (const float*)(ws_ + WS_RS));
        PH_END(8);
        if (PH_ON && !(SKIPM & 256)) phase_gemm<0>(F, B_HID, w_dn_t(ws_, l), B_F, D, FF, nullptr);
        PH_END(9);
        if (PH_ON && !(SKIPM & 512)) { if (l + 1 < DEPTH) phase_finish<false, false>(F, nullptr, P_G_POST_MLP + l * D, P_G_PRE_MIX + (l + 1) * D); else phase_finish<false, true>(F, nullptr, P_G_POST_MLP + l * D, nullptr); }
        PH_END(10);
    }
#if PROBE_MASK
    if (blockIdx.x == 0 && F.wave == 0 && lane_id() == 0) { const unsigned long long pr_acc = (unsigned long long)F.MISC[20] | ((unsigned long long)F.MISC[21] << 32);
        const unsigned long long t0_ = __builtin_amdgcn_s_memrealtime(); while (__builtin_amdgcn_s_memrealtime() - t0_ < pr_acc) __builtin_amdgcn_s_sleep(8); }
#endif
#undef PH_ON
#undef PH_END
}

extern "C" void kernel_launch(void* const* d_in, const int* in_sizes, int n_in, void* d_out, int out_size, void* d_ws, size_t ws_size, hipStream_t stream) {
    static int grid = 0;
    if (grid == 0) {
        if (n_in != 20 || in_sizes[0] != M * D || out_size != M * D || ws_size < WS_END) {
            fprintf(stderr, "kernel_launch: unexpected shapes / workspace (n_in %d, in0 %d, out %d, ws %zu < %zu); nothing launched\n", n_in, n_in > 0 ? in_sizes[0] : -1, out_size, ws_size, (size_t)WS_END);
            grid = -1; return; }
        int dev = 0, cus = 0, per_cu = 0;
        if (hipGetDevice(&dev) != hipSuccess || hipDeviceGetAttribute(&cus, hipDeviceAttributeMultiprocessorCount, dev) != hipSuccess) { grid = -1; return; }
        if (hipFuncSetAttribute((const void*)mk_fwd, hipFuncAttributeMaxDynamicSharedMemorySize, LDS_BYTES) != hipSuccess) { fprintf(stderr, "kernel_launch: hipFuncSetAttribute failed\n"); grid = -1; return; }
        if (hipOccupancyMaxActiveBlocksPerMultiprocessor(&per_cu, (const void*)mk_fwd, NWAVES * 64, LDS_BYTES) != hipSuccess || per_cu < 1)
            fprintf(stderr, "kernel_launch: note: occupancy query reports %d workgroups per CU\n", per_cu);
        (void)hipGetLastError();
        grid = cus;
    }
    if (grid < 0) return;
    if (hipMemsetAsync((char*)d_ws + WS_CTL, 0, CTL_ZERO_BYTES, stream) != hipSuccess) return;
    Args a{};
    for (int i = 0; i < 20; ++i) a.in[i] = d_in[i];
    a.out = (float*)d_out; a.ws = (unsigned char*)d_ws; a.pad = 0;
#if MK_MULTI
    for (int p = 0; p < NPHASES; ++p) {
        a.ph_lo = p; a.ph_hi = p + 1; a.use_bar = 0;
        hipLaunchKernelGGL(mk_fwd, dim3(grid), dim3(NWAVES * 64), LDS_BYTES, stream, a);
    }
#else
    a.ph_lo = 0; a.ph_hi = NPHASES; a.use_bar = 1;
    hipLaunchKernelGGL(mk_fwd, dim3(grid), dim3(NWAVES * 64), LDS_BYTES, stream, a);
#endif
}
```

```cpp
#include <hip/hip_runtime.h>
#include <cstdio>
#include <cstdint>

#define FASTMASK_OFF 0
#ifndef PROBE_MASK
#define PROBE_MASK 0
#endif
#ifndef SKIPM
#define SKIPM 0
#endif
#ifndef MK_MULTI
#define MK_MULTI 0
#endif

__device__ __forceinline__ int lane_id() { int l; asm volatile("v_mbcnt_lo_u32_b32 %0, -1, 0\n\tv_mbcnt_hi_u32_b32 %0, -1, %0" : "=v"(l)); return l; }
namespace pg8 {
#define PG8_LAS __attribute__((address_space(3)))
typedef unsigned short bf16_t;
typedef short bf16x8 __attribute__((ext_vector_type(8)));
typedef float f32x4 __attribute__((ext_vector_type(4)));
typedef unsigned u32x4 __attribute__((ext_vector_type(4)));
constexpr int BM = 256, BK = 64, HALF = 128, HTB = HALF * BK * 2, STAGE_BYTES = 8 * HTB, NXCD = 8, WGM = 8;

__host__ __device__ __forceinline__ int lds_byte(int r, int c) { const int st = (r >> 4) * 2 + (c >> 5), rr = r & 15, cc = c & 31, ob = rr * 64 + cc * 2; return st * 1024 + (ob ^ (((ob >> 9) & 1) << 5)); }
__host__ __device__ __forceinline__ void stage_rc(int b, int& R, int& C) { const int st = b / 1024, sb = b % 1024, swz = sb ^ (((sb >> 9) & 1) << 5); R = (st >> 1) * 16 + swz / 64; C = (st & 1) * 32 + (swz % 64) / 2; }
__host__ __device__ __forceinline__ int perm32(int rho) { const int n = rho >> 4, i = rho & 15; return 8 * (i >> 2) + 4 * n + (i & 3); }

struct Unit { int pm, pn; };
struct Gemm { const bf16_t* A; const bf16_t* Bt; int M, N, K; };

struct StaticOrder {
    int nM, nN, nwg, G, c;
    __host__ __device__ void init(int M, int N, int G_, int c_) { nM = M / BM; nN = N / BM; nwg = nM * nN; G = G_; c = c_; }
    __host__ __device__ bool next(int i, Unit& u) const {
        const long L = (long)i * G + c; if (L >= nwg) return false;
        int wgid = (int)L; { const int q = nwg / NXCD, r = nwg % NXCD, xcd = wgid % NXCD, off = wgid / NXCD; wgid = (xcd < r ? xcd * (q + 1) : r * (q + 1) + (xcd - r) * q) + off; }
        const int nig = WGM * nN, gid = wgid / nig, fm = gid * WGM, gsz = (nM - fm) < WGM ? (nM - fm) : WGM;
        u.pm = fm + ((wgid % nig) % gsz); u.pn = (wgid % nig) / gsz; return true;
    }
    __device__ __forceinline__ void a_ready(const Unit&) const {}
    __device__ __forceinline__ void done(const Unit&) const {}
};

__device__ __forceinline__ unsigned cvt_pk_bf16(float lo, float hi) { unsigned r; asm volatile("v_cvt_pk_bf16_f32 %0, %1, %2" : "=v"(r) : "v"(lo), "v"(hi)); return r; }

template <int ACT  > struct EpiStore {
    static constexpr bool PERM = true, AFTER_DRAIN = false;
    bf16_t* O; int ldc; const float* rs;
    __device__ __forceinline__ void operator()(const f32x4 (&acc)[2][2][4][2], const Unit& u, int wr, int wc, int fr, int fq) const {
        const int row0 = u.pm * BM + wr * 64 + fr;
        const int col0 = u.pn * BM + wc * 32 + 8 * fq;
        float sc[2][4];
#pragma unroll
        for (int ai = 0; ai < 2; ++ai)
#pragma unroll
            for (int m = 0; m < 4; ++m) sc[ai][m] = rs ? rs[row0 + ai * HALF + m * 16] : 1.f;
#pragma unroll
        for (int ai = 0; ai < 2; ++ai)
#pragma unroll
            for (int m = 0; m < 4; ++m) { const int row = row0 + ai * HALF + m * 16; bf16_t* rowp = O + (size_t)row * ldc + col0;
#pragma unroll
                for (int bj = 0; bj < 2; ++bj) { f32x4 v0 = acc[ai][bj][m][0] * sc[ai][m], v1 = acc[ai][bj][m][1] * sc[ai][m];
                    if (ACT == 2) {
#pragma unroll
                        for (int e = 0; e < 4; ++e) { const float a = fmaxf(v0[e], 0.f), b = fmaxf(v1[e], 0.f); v0[e] = a * a; v1[e] = b * b; } }
                    u32x4 w; w.x = cvt_pk_bf16(v0[0], v0[1]); w.y = cvt_pk_bf16(v0[2], v0[3]); w.z = cvt_pk_bf16(v1[0], v1[1]); w.w = cvt_pk_bf16(v1[2], v1[3]);
                    *(u32x4*)(rowp + bj * HALF) = w; } }
    }
};

template <class Epi, class Sched, bool ALIGN_EPI = false, bool SP2 = false>
__device__ __forceinline__ void gemm_phase(PG8_LAS unsigned char* lds, const Gemm g, const Sched& S, const Epi& E, int wave_) {
    int tid_ = wave_ * 64 + lane_id(); asm volatile("" : "+v"(tid_));
    const int tid = tid_, wid = __builtin_amdgcn_readfirstlane(tid >> 6), lane = tid & 63, wr = wid >> 2, wc = wid & 3, fr = lane & 15, fq = lane >> 4;
    const int K = g.K, nt = K / BK;
    unsigned voffA[2], voffB[2];
#pragma unroll
    for (int i = 0; i < 2; ++i) { int R, C; stage_rc(tid * 16 + i * 8192, R, C); const int Rb = Epi::PERM ? ((R & ~31) + perm32(R & 31)) : R;
        voffA[i] = (unsigned)(R * K + C) * 2u; voffB[i] = (unsigned)(Rb * K + C) * 2u; }
    const size_t kstep = (size_t)(BK * 2);
    const size_t hstep = (size_t)HALF * K * 2;
    const size_t tstep = 2 * hstep;
    const unsigned ldsw = (unsigned)wid * 1024u;
    const int aoff = lds_byte(wr * 64 + fr, fq * 8), boff = lds_byte(wc * 32 + fr, fq * 8);
#define PG8_SA(b, h) (((b) * 2 + (h)) * HTB)
#define PG8_SB(b, h) ((4 + (b) * 2 + (h)) * HTB)
#define PG8_STAGE(bufoff, gbase, voff) do { _Pragma("unroll") for (int _i = 0; _i < 2; ++_i) \
        __builtin_amdgcn_global_load_lds((const unsigned*)((const char*)(gbase) + (voff)[_i]), (PG8_LAS unsigned*)(lds + (bufoff) + ldsw + _i * 8192), 16, 0, 0); } while (0)
#define PG8_LDA(dst, b, h) do { _Pragma("unroll") for (int m = 0; m < 4; ++m) _Pragma("unroll") for (int k = 0; k < 2; ++k) dst[m][k] = *(const PG8_LAS bf16x8*)(lds + PG8_SA(b, h) + aoff + m * 2048 + k * 1024); } while (0)
#define PG8_LDB(dst, b, h) do { _Pragma("unroll") for (int n = 0; n < 2; ++n) _Pragma("unroll") for (int k = 0; k < 2; ++k) dst[n][k] = *(const PG8_LAS bf16x8*)(lds + PG8_SB(b, h) + boff + n * 2048 + k * 1024); } while (0)
#define PG8_MMA(ai, bj, At, Bt) do { __builtin_amdgcn_s_setprio(1); _Pragma("unroll") for (int m = 0; m < 4; ++m) _Pragma("unroll") for (int n = 0; n < 2; ++n) _Pragma("unroll") for (int k = 0; k < 2; ++k) \
        acc[ai][bj][m][n] = __builtin_amdgcn_mfma_f32_16x16x32_bf16(Bt[n][k], At[m][k], acc[ai][bj][m][n], 0, 0, 0); __builtin_amdgcn_s_setprio(0); } while (0)
#define PG8_WAIT_V(n) asm volatile("s_waitcnt vmcnt(" #n ")" ::: "memory")
#define PG8_WAIT_L(n) asm volatile("s_waitcnt lgkmcnt(" #n ")" ::: "memory")
#define PG8_BAR __builtin_amdgcn_s_barrier()
#define PG8_SCHED __builtin_amdgcn_sched_barrier(0)
    Unit cur, nxt; int ui = 0;
    if (!S.next(0, cur)) return;
    f32x4 acc[2][2][4][2];
#pragma unroll
    for (int a = 0; a < 2; ++a)
#pragma unroll
        for (int b = 0; b < 2; ++b)
#pragma unroll
            for (int m = 0; m < 4; ++m)
#pragma unroll
                for (int n = 0; n < 2; ++n) acc[a][b][m][n] = (f32x4){0.f, 0.f, 0.f, 0.f};
    bf16x8 At[4][2], B0[2][2], B1[2][2];
    const char* cA = (const char*)g.A + (size_t)cur.pm * tstep; const char* cB = (const char*)g.Bt + (size_t)cur.pn * tstep;
    S.a_ready(cur);
    if constexpr (SP2) {
        PG8_STAGE(PG8_SB(0, 0), cB, voffB); PG8_STAGE(PG8_SB(0, 1), cB + hstep, voffB); PG8_STAGE(PG8_SA(0, 0), cA, voffA); PG8_STAGE(PG8_SA(0, 1), cA + hstep, voffA);
        if (wr == 1) PG8_BAR;
        PG8_WAIT_V(2); PG8_BAR;
        PG8_STAGE(PG8_SB(1, 0), cB + kstep, voffB); PG8_STAGE(PG8_SA(1, 0), cA + kstep, voffA); PG8_STAGE(PG8_SB(1, 1), cB + hstep + kstep, voffB);
        PG8_WAIT_V(6); PG8_BAR;
    } else {
        PG8_STAGE(PG8_SB(0, 0), cB, voffB); PG8_STAGE(PG8_SA(0, 0), cA, voffA); PG8_STAGE(PG8_SB(0, 1), cB + hstep, voffB); PG8_STAGE(PG8_SA(0, 1), cA + hstep, voffA);
        if (wr == 1) PG8_BAR;
        PG8_WAIT_V(4); PG8_BAR;
        PG8_STAGE(PG8_SB(1, 0), cB + kstep, voffB); PG8_STAGE(PG8_SA(1, 0), cA + kstep, voffA); PG8_STAGE(PG8_SB(1, 1), cB + hstep + kstep, voffB);
        PG8_WAIT_V(6); PG8_BAR;
    }
    for (;;) {
        const bool has_next = S.next(ui + 1, nxt);
        const char* nA = has_next ? (const char*)g.A + (size_t)nxt.pm * tstep : cA; const char* nB = has_next ? (const char*)g.Bt + (size_t)nxt.pn * tstep : cB;
        for (int t = 0; t < nt; t += 2) {
            const bool last = (t == nt - 2);
            const char* a1 = cA + (size_t)(t + 1) * kstep;
            const char* a2 = last ? nA : cA + (size_t)(t + 2) * kstep; const char* b2 = last ? nB : cB + (size_t)(t + 2) * kstep;
            const char* a3 = a2 + kstep; const char* b3 = b2 + kstep;
            if (last && has_next) S.a_ready(nxt);
            if constexpr (SP2) {
            PG8_LDB(B0, 0, 0); PG8_LDB(B1, 0, 1); PG8_SCHED; PG8_LDA(At, 0, 0); PG8_STAGE(PG8_SA(1, 1), a1 + hstep, voffA);
            PG8_WAIT_V(8); PG8_WAIT_L(0); PG8_BAR; PG8_MMA(0, 0, At, B0); PG8_MMA(0, 1, At, B1); PG8_BAR; PG8_SCHED;
            PG8_LDA(At, 0, 1); PG8_STAGE(PG8_SB(0, 0), b2, voffB); PG8_STAGE(PG8_SB(0, 1), b2 + hstep, voffB); PG8_STAGE(PG8_SA(0, 0), a2, voffA);
            PG8_WAIT_V(8); PG8_WAIT_L(0); PG8_BAR; PG8_MMA(1, 0, At, B0); PG8_MMA(1, 1, At, B1); PG8_BAR; PG8_SCHED;
            PG8_LDB(B0, 1, 0); PG8_LDB(B1, 1, 1); PG8_SCHED; PG8_LDA(At, 1, 0); PG8_STAGE(PG8_SA(0, 1), a2 + hstep, voffA);
            PG8_WAIT_V(8); PG8_WAIT_L(0); PG8_BAR; PG8_MMA(0, 0, At, B0); PG8_MMA(0, 1, At, B1); PG8_BAR; PG8_SCHED;
            PG8_LDA(At, 1, 1); PG8_STAGE(PG8_SB(1, 0), b3, voffB); PG8_STAGE(PG8_SB(1, 1), b3 + hstep, voffB); PG8_STAGE(PG8_SA(1, 0), a3, voffA);
            PG8_WAIT_V(8); PG8_WAIT_L(0); PG8_BAR; PG8_MMA(1, 0, At, B0); PG8_MMA(1, 1, At, B1); PG8_BAR; PG8_SCHED;
            } else {
            PG8_LDB(B0, 0, 0); PG8_SCHED; PG8_LDA(At, 0, 0); PG8_STAGE(PG8_SA(1, 1), a1 + hstep, voffA);
            PG8_WAIT_L(8); PG8_BAR; PG8_WAIT_L(0); PG8_MMA(0, 0, At, B0); PG8_BAR; PG8_SCHED;
            PG8_LDB(B1, 0, 1); PG8_STAGE(PG8_SB(0, 0), b2, voffB);
            PG8_BAR; PG8_WAIT_L(0); PG8_MMA(0, 1, At, B1); PG8_BAR;
            PG8_LDA(At, 0, 1); PG8_STAGE(PG8_SA(0, 0), a2, voffA);
            PG8_BAR; PG8_WAIT_L(0); PG8_MMA(1, 0, At, B0); PG8_BAR; PG8_SCHED;
            PG8_STAGE(PG8_SB(0, 1), b2 + hstep, voffB);
            PG8_WAIT_V(6); PG8_BAR; PG8_MMA(1, 1, At, B1); PG8_BAR;
            PG8_LDB(B0, 1, 0); PG8_SCHED; PG8_LDA(At, 1, 0); PG8_STAGE(PG8_SA(0, 1), a2 + hstep, voffA);
            PG8_WAIT_L(8); PG8_BAR; PG8_WAIT_L(0); PG8_MMA(0, 0, At, B0); PG8_BAR; PG8_SCHED;
            PG8_LDB(B1, 1, 1); PG8_STAGE(PG8_SB(1, 0), b3, voffB);
            PG8_BAR; PG8_WAIT_L(0); PG8_MMA(0, 1, At, B1); PG8_BAR;
            PG8_LDA(At, 1, 1); PG8_STAGE(PG8_SA(1, 0), a3, voffA);
            PG8_BAR; PG8_WAIT_L(0); PG8_MMA(1, 0, At, B0); PG8_BAR; PG8_SCHED;
            PG8_STAGE(PG8_SB(1, 1), b3 + hstep, voffB);
            PG8_WAIT_V(6); PG8_BAR; PG8_MMA(1, 1, At, B1); PG8_BAR;
            }
        }
        if constexpr (ALIGN_EPI) { if (wr == 0) PG8_BAR; }
        if constexpr (!Epi::AFTER_DRAIN) { E(acc, cur, wr, wc, fr, fq); S.done(cur); }
        if (!has_next) break;
#pragma unroll
        for (int a = 0; a < 2; ++a)
#pragma unroll
            for (int b = 0; b < 2; ++b)
#pragma unroll
                for (int m = 0; m < 4; ++m)
#pragma unroll
                    for (int n = 0; n < 2; ++n) acc[a][b][m][n] = (f32x4){0.f, 0.f, 0.f, 0.f};
        cur = nxt; cA = nA; cB = nB; ++ui;
        if constexpr (ALIGN_EPI) { if (wr == 1) PG8_BAR; }
    }
    PG8_WAIT_V(0);
    if constexpr (!ALIGN_EPI) { if (wr == 0) PG8_BAR; }
    PG8_BAR;
#undef PG8_SA
#undef PG8_SB
#undef PG8_STAGE
#undef PG8_LDA
#undef PG8_LDB
#undef PG8_MMA
#undef PG8_WAIT_V
#undef PG8_WAIT_L
#undef PG8_BAR
#undef PG8_SCHED
}
}

constexpr int NWAVES = 8;
constexpr int BATCH = 32, S = 2048, D = 1024, DEPTH = 4, FF = 4096;
constexpr int M = BATCH * S;
constexpr int NP = 2304;
constexpr int DIN = 2108;
constexpr int C_QA = 0, C_CKV = 256, C_QIDX = 384, C_QB = 512, C_KCMP = 1024, C_VCMP = 1152, C_KSLC = 1280, C_VSLC = 1408, C_KWIN = 1536, C_VWIN = 1664,
              C_UC = 1792, C_KIDX = 2048, C_WIDX = 2080, C_GATE = 2084, C_KA = 2112, C_VA = 2176;
constexpr int NC = 127;
constexpr float EPS = 1e-6f;
constexpr float NEGF = -1e30f;

__host__ __device__ __forceinline__ int win_src(int n) {
    if (n < 512) return n;
    if (n < 1024) return 548 + (n - 512);
    if (n < 1792) return 1060 + (n - 1024);
    if (n < 2048) return 1852 + (n - 1792);
    if (n < 2080) return 512 + (n - 2048);
    if (n < 2084) return 544 + (n - 2080);
    if (n < 2108) return 1828 + (n - 2084);
    return -1;
}

constexpr size_t MiB = 1u << 20;
constexpr size_t WS_CTL = 0, CTL_ZERO_BYTES = 1 * MiB;
constexpr size_t WS_W = 2 * MiB;
constexpr size_t W_IN_B = (size_t)NP * D * 2, W_OUT_B = (size_t)D * D * 2, W_UP_B = (size_t)FF * D * 2, W_DN_B = (size_t)D * FF * 2;
constexpr size_t W_LAYER_B = W_IN_B + W_OUT_B + W_UP_B + W_DN_B;
constexpr size_t WS_ROPE = 96 * MiB;
constexpr size_t WS_WCT = 102 * MiB;
constexpr size_t WS_CB = 104 * MiB;
constexpr size_t WS_KCB = 124 * MiB, WS_VCB = 125 * MiB;
constexpr size_t WS_KA = 108 * MiB;
constexpr size_t WS_RS = 126 * MiB;
constexpr size_t WS_H = 128 * MiB;
constexpr size_t WS_F = 256 * MiB;
constexpr size_t WS_PROJ = 384 * MiB;
constexpr size_t WS_MIX = 672 * MiB;
constexpr size_t WS_MASK = 800 * MiB;
constexpr size_t WS_HID = 384 * MiB;
constexpr size_t WS_XB = 896 * MiB;
constexpr size_t WS_END = 1024 * MiB;
static_assert(WS_W + DEPTH * W_LAYER_B <= WS_ROPE, "weights");
static_assert(WS_ROPE + (size_t)M * 24 * 4 <= WS_WCT && WS_WCT + (size_t)DEPTH * 2 * 128 * 1024 * 2 <= WS_CB, "map");
static_assert(WS_PROJ + (size_t)M * NP * 2 <= WS_MIX && WS_MIX + (size_t)M * D * 2 <= WS_END && WS_HID + (size_t)M * FF * 2 <= WS_END, "map2");

constexpr int CW_BAR = 4096;
constexpr int RING_BYTES = 131072;
constexpr int LDSCTL_OFF = RING_BYTES, MISC_OFF = LDSCTL_OFF + 320;
constexpr int LDS_BYTES = 147456;
constexpr int WSCR = 16384;

#define GAS __attribute__((address_space(1)))
#define LAS __attribute__((address_space(3)))
typedef unsigned short bf16;
typedef unsigned v4u __attribute__((ext_vector_type(4)));
typedef float f32x4 __attribute__((ext_vector_type(4)));
typedef GAS unsigned gu32;
#define LDS_FENCE() asm volatile("s_waitcnt lgkmcnt(0)" ::: "memory")
__device__ __forceinline__ unsigned f2bf(float f) { unsigned u = __builtin_bit_cast(unsigned, f); return (u + 0x7fffu + ((u >> 16) & 1u)) >> 16; }
__device__ __forceinline__ unsigned pk2(float lo, float hi) { return f2bf(lo) | (f2bf(hi) << 16); }
__device__ __forceinline__ float bf2f(bf16 u) { return __builtin_bit_cast(float, (unsigned)u << 16); }
__device__ __forceinline__ float bflo(unsigned u) { return __builtin_bit_cast(float, u << 16); }
__device__ __forceinline__ float bfhi(unsigned u) { return __builtin_bit_cast(float, u & 0xffff0000u); }

#define XB_TMO      128
#define XB_XCNT(j)  (256  + 64 * (j))
#define XB_XSUB(j)  (1280 + 64 * (j))
#define XB_XGEN(j)  (2304 + 64 * (j))
#define XB_TOP      3328
#define XB_TOPGEN   3392
#define XCD_BAR_WORDS 3456
#define XB_SPIN_CAP (1u << 22)

__device__ __forceinline__ unsigned xb_ld(unsigned* p)              { return __hip_atomic_load(p, __ATOMIC_RELAXED, __HIP_MEMORY_SCOPE_AGENT); }
__device__ __forceinline__ unsigned xb_add(unsigned* p, unsigned v) { return __hip_atomic_fetch_add(p, v, __ATOMIC_RELAXED, __HIP_MEMORY_SCOPE_AGENT); }
__device__ __forceinline__ unsigned xb_xcc_id() { return (unsigned)__builtin_amdgcn_s_getreg((3 << 11) | 20) & 0xFu; }
#define XB_SPIN(cond, bar) do { unsigned _sp = 0; while (cond) { __builtin_amdgcn_s_sleep(1); \
    if ((++_sp & 255u) == 0u) { if (xb_ld(&(bar)[XB_TMO])) break; if (_sp > XB_SPIN_CAP) { atomicAdd(&(bar)[XB_TMO], 1u); break; } } } } while (0)

struct XcdBarrier { unsigned* bar; unsigned x; volatile LAS unsigned* st; int wv; };

__device__ __forceinline__ XcdBarrier xcd_barrier_post(unsigned* bar, volatile LAS unsigned* st) {
    XcdBarrier b; b.bar = bar; b.x = xb_xcc_id(); b.st = st; b.wv = 0;
    if (threadIdx.x == 0) (void)xb_add(&bar[XB_XCNT(b.x)], 1u);
    return b;
}
__device__ __forceinline__ void xcd_barrier_complete(unsigned* bar, unsigned x, unsigned& nloc, unsigned& nx) {
    const unsigned G = gridDim.x * gridDim.y * gridDim.z;
    unsigned sum, cnt, mine, sp = 0u;
    for (;;) {
        sum = 0u; cnt = 0u; mine = 0u;
#pragma unroll
        for (unsigned j = 0; j < 16; ++j) { const unsigned c = xb_ld(&bar[XB_XCNT(j)]); sum += c; cnt += (c > 0u) ? 1u : 0u; mine = (j == x) ? c : mine; }
        if (sum == G) break;
        __builtin_amdgcn_s_sleep(1);
        if ((++sp & 255u) == 0u) { if (xb_ld(&bar[XB_TMO])) break; if (sp > XB_SPIN_CAP) { atomicAdd(&bar[XB_TMO], 1u); break; } }
    }
    nloc = mine > 0u ? mine : 1u; nx = cnt > 0u ? cnt : 1u;
}
__device__ __forceinline__ void xcd_barrier(const XcdBarrier& b) {
    asm volatile("s_waitcnt vmcnt(0)" ::: "memory");
    __syncthreads();
    if (b.wv == 0 && lane_id() == 0) {
        unsigned* bar = b.bar; asm volatile("" : "+s"(bar));
        __builtin_amdgcn_s_waitcnt(0);
        unsigned nloc = b.st[0], nx = b.st[1];
        unsigned bx_ = b.x; asm volatile("" : "+s"(bx_));
        if (nloc == 0u) { xcd_barrier_complete(bar, bx_, nloc, nx); b.st[0] = nloc; b.st[1] = nx; }
        const unsigned old = xb_add(&bar[XB_XSUB(bx_)], 1u);
        const unsigned gen = old / nloc;
        if (old + 1u == (gen + 1u) * nloc) {
            __builtin_amdgcn_fence(__ATOMIC_RELEASE, "agent");
            asm volatile("s_waitcnt vmcnt(0)" ::: "memory");
            const unsigned og = xb_add(&bar[XB_TOP], 1u);
            const unsigned tg = og / nx;
            if (og + 1u == (tg + 1u) * nx) xb_add(&bar[XB_TOPGEN], 1u);
            else XB_SPIN(xb_ld(&bar[XB_TOPGEN]) == tg, bar);
            __builtin_amdgcn_fence(__ATOMIC_ACQUIRE, "agent");
            xb_add(&bar[XB_XGEN(bx_)], 1u);
            asm volatile("s_waitcnt vmcnt(0)" ::: "memory");
        } else {
            XB_SPIN(xb_ld(&bar[XB_XGEN(bx_)]) == gen, bar);
            __builtin_amdgcn_fence(__ATOMIC_ACQUIRE, "agent");
            asm volatile("s_waitcnt vmcnt(0)" ::: "memory");
        }
    }
    __syncthreads();
}

struct Frame {
    LAS unsigned char* lds;
    volatile LAS unsigned* MISC;
    gu32* ctl;
    int wave, vcu, G;
    float* out; unsigned char* ws;
};
struct Args { const void* in[20]; float* out; unsigned char* ws; int ph_lo, ph_hi, use_bar, pad; };
#define IN_F(k) ((const float*)args.in[k])
#define P_X_IN IN_F(0)
#define P_POS ((const int*)args.in[1])
#define P_W_IN IN_F(2)
#define P_G_KV_A IN_F(3)
#define P_W_KV_UP IN_F(4)
#define P_W_CMP_K IN_F(5)
#define P_W_CMP_V IN_F(6)
#define P_PE_K IN_F(7)
#define P_PE_V IN_F(8)
#define P_W_POOL IN_F(9)
#define P_POOL_SCALE IN_F(10)
#define P_G_OUT_A IN_F(11)
#define P_G_OUT_B IN_F(12)
#define P_W_OUT IN_F(13)
#define P_G_PRE_MIX IN_F(14)
#define P_G_POST_MIX IN_F(15)
#define P_G_PRE_MLP IN_F(16)
#define P_G_POST_MLP IN_F(17)
#define P_W_UP IN_F(18)
#define P_W_DOWN IN_F(19)
#define B_ROPE ((float*)(ws_ + WS_ROPE))
#define B_H ((bf16*)(ws_ + WS_H))
#define B_F ((bf16*)(ws_ + WS_F))
#define B_PROJ ((bf16*)(ws_ + WS_PROJ))
#define B_MIX ((bf16*)(ws_ + WS_MIX))
#define B_HID ((bf16*)(ws_ + WS_HID))

template <int CTRL> __device__ __forceinline__ int dpp_i(int v) { return __builtin_amdgcn_update_dpp(0, v, CTRL, 0xF, 0xF, true); }
template <int CTRL> __device__ __forceinline__ float dpp_f(float v) { return __builtin_bit_cast(float, dpp_i<CTRL>(__builtin_bit_cast(int, v))); }
__device__ __forceinline__ int swz16_i(int v) { return __builtin_amdgcn_ds_swizzle(v, (16 << 10) | 0x1F); }
__device__ __forceinline__ float swz16_f(float v) { return __builtin_bit_cast(float, swz16_i(__builtin_bit_cast(int, v))); }
struct HalfPair { unsigned lo, hi; };
__device__ __forceinline__ HalfPair halves_u(unsigned v) { const auto rr = __builtin_amdgcn_permlane32_swap(v, v, false, false); HalfPair h; h.lo = rr[0]; h.hi = rr[1]; return h; }
__device__ __forceinline__ float other_half_f(float v, int hi) { const HalfPair h = halves_u(__builtin_bit_cast(unsigned, v)); return __builtin_bit_cast(float, hi ? h.lo : h.hi); }
__device__ __forceinline__ float sum32(float v) {
    v += dpp_f<0xB1>(v); v += dpp_f<0x4E>(v); v += dpp_f<0x141>(v); v += dpp_f<0x140>(v); v += swz16_f(v); return v; }
__device__ __forceinline__ float wave_sum(float v) { v = sum32(v); const HalfPair h = halves_u(__builtin_bit_cast(unsigned, v)); return __builtin_bit_cast(float, h.lo) + __builtin_bit_cast(float, h.hi); }
__device__ __forceinline__ float max_halves(float v) { const HalfPair h = halves_u(__builtin_bit_cast(unsigned, v)); return fmaxf(__builtin_bit_cast(float, h.lo), __builtin_bit_cast(float, h.hi)); }
__device__ __forceinline__ unsigned or_halves(unsigned v) { const HalfPair h = halves_u(v); return h.lo | h.hi; }
__device__ __forceinline__ unsigned or32(unsigned v) { v |= (unsigned)dpp_i<0xB1>((int)v); v |= (unsigned)dpp_i<0x4E>((int)v); v |= (unsigned)dpp_i<0x141>((int)v); v |= (unsigned)dpp_i<0x140>((int)v); v |= (unsigned)swz16_i((int)v); return v; }

__constant__ double c_rope_inv[12] = {1.0, 0.19392274474868576, 0.03760603093086393, 0.007292664737217109, 0.001414213562373095, 0.0002742481756762073, 5.318295896944988e-05, 1.031338537721246e-05,
                                       1.0, 0.03760603093086393, 0.001414213562373095, 5.318295896944988e-05};
template <int MODE, bool GAIN = false>
__device__ __forceinline__ void transpose_item(const float* W, int K, int Nsrc, int nblk, bf16* WT, LAS float* scr, int item, int lane, const float* gk = nullptr) {
    const int kb = item / nblk, nb = item % nblk, k0 = 64 * kb, n0 = 32 * nb;
    if (MODE && n0 >= C_KA && n0 < C_KA + 128) return;
    const int np = n0 + (lane & 31);
    const int src = MODE ? win_src(np) : np;
#pragma unroll 16
    for (int i = 0; i < 32; ++i) { const int kk = 2 * i + (lane >> 5); scr[kk * 33 + (lane & 31)] = (src >= 0) ? W[(size_t)(k0 + kk) * Nsrc + src] * (GAIN ? gk[k0 + kk] : 1.f) : 0.f; }
    LDS_FENCE();
    const int c = lane & 7;
#pragma unroll
    for (int j = 0; j < 4; ++j) { const int n = (lane >> 3) + 8 * j; const LAS float* s = scr + (8 * c) * 33 + n;
        v4u o; o.x = pk2(s[0 * 33], s[1 * 33]); o.y = pk2(s[2 * 33], s[3 * 33]); o.z = pk2(s[4 * 33], s[5 * 33]); o.w = pk2(s[6 * 33], s[7 * 33]);
        *(v4u*)(WT + (size_t)(n0 + n) * K + k0 + 8 * c) = o; }
    LDS_FENCE();
}

__device__ __forceinline__ bf16* w_in_t(unsigned char* ws_, int l)  { return (bf16*)(ws_ + WS_W + (size_t)l * W_LAYER_B); }
__device__ __forceinline__ bf16* w_out_t(unsigned char* ws_, int l) { return (bf16*)(ws_ + WS_W + (size_t)l * W_LAYER_B + W_IN_B); }
__device__ __forceinline__ bf16* w_up_t(unsigned char* ws_, int l)  { return (bf16*)(ws_ + WS_W + (size_t)l * W_LAYER_B + W_IN_B + W_OUT_B); }
__device__ __forceinline__ bf16* w_dn_t(unsigned char* ws_, int l)  { return (bf16*)(ws_ + WS_W + (size_t)l * W_LAYER_B + W_IN_B + W_OUT_B + W_UP_B); }

__device__ __forceinline__ void phase_prologue(Frame& F, const Args& args) {
    unsigned char* ws_ = F.ws; asm volatile("" : "+s"(ws_)); int lane_ = lane_id(); asm volatile("" : "+v"(lane_)); (void)ws_;
    LAS float* scr = (LAS float*)(F.lds + F.wave * WSCR);
    const int gw = F.vcu * NWAVES + F.wave, NGW = F.G * NWAVES;
    constexpr int I_IN = (D / 64) * (NP / 32), I_OUT = (D / 64) * (D / 32), I_UP = (D / 64) * (FF / 32), I_DN = (FF / 64) * (D / 32);
    for (int it = gw; it < DEPTH * I_IN; it += NGW) { const int l = it / I_IN, r = it % I_IN; transpose_item<1, true>(P_W_IN + (size_t)l * D * DIN, D, DIN, NP / 32, w_in_t(ws_, l), scr, r, lane_, P_G_PRE_MIX + l * D); }
    for (int it = gw; it < DEPTH * I_OUT; it += NGW) { const int l = it / I_OUT, r = it % I_OUT; transpose_item<0>(P_W_OUT + (size_t)l * D * D, D, D, D / 32, w_out_t(ws_, l), scr, r, lane_); }
    for (int it = gw; it < DEPTH * I_UP; it += NGW) { const int l = it / I_UP, r = it % I_UP; transpose_item<0, true>(P_W_UP + (size_t)l * D * FF, D, FF, FF / 32, w_up_t(ws_, l), scr, r, lane_, P_G_PRE_MLP + l * D); }
    for (int it = gw; it < DEPTH * I_DN; it += NGW) { const int l = it / I_DN, r = it % I_DN; transpose_item<0>(P_W_DOWN + (size_t)l * FF * D, FF, D, D / 32, w_dn_t(ws_, l), scr, r, lane_); }
    for (int it = gw; it < DEPTH * D * 2; it += NGW) {
        const int l = it / (D * 2), r = it % (D * 2), k = r >> 1, n = lane_ + 64 * (r & 1);
        const float* wi = P_W_IN + ((size_t)l * D + k) * DIN + 256; const float* gk = P_G_KV_A + l * 128; const float* wu = P_W_KV_UP + (size_t)l * 128 * 128 + n;
        float acc = 0.f;
#pragma unroll 32
        for (int j = 0; j < 128; ++j) acc += (wi[j] * gk[j]) * wu[j * 128];
        w_in_t(ws_, l)[(size_t)(C_KA + n) * D + k] = (bf16)f2bf(acc * P_G_PRE_MIX[l * D + k]);
    }
    for (int it = gw; it < DEPTH * 2 * 2 * 32; it += NGW) {
        const int lk = it >> 6, part = (it >> 5) & 1, r = it & 31, l = lk >> 1, kv = lk & 1;
        const float* W = (kv ? P_W_CMP_V : P_W_CMP_K) + (size_t)l * 32 * 64 * 64 + (size_t)part * 1024 * 64;
        transpose_item<0>(W, 1024, 64, 2, (bf16*)(ws_ + WS_WCT) + ((size_t)lk * 128 + part * 64) * 1024, scr, r, lane_);
    }
    {
        __syncthreads();
        LAS float* part = (LAS float*)F.lds;
        for (int it = F.vcu; it < DEPTH * 2; it += F.G) {
            const int l = it >> 1, kv = it & 1;
            const float* W = (kv ? P_W_CMP_V : P_W_CMP_K) + (size_t)l * 32 * 64 * 64 + lane_; const float* pe = (kv ? P_PE_V : P_PE_K) + l * 32 * 64;
            float acc = 0.f;
#pragma unroll 16
            for (int k = F.wave * 256; k < F.wave * 256 + 256; ++k) acc += pe[k] * W[(size_t)k * 64];
            part[F.wave * 64 + lane_] = acc;
            __syncthreads();
            if (F.wave == 0) { float t = 0.f;
#pragma unroll
                for (int w8 = 0; w8 < 8; ++w8) t += part[w8 * 64 + lane_];
                ((float*)(ws_ + WS_CB))[it * 64 + lane_] = t; }
            __syncthreads();
        }
    }
}
__device__ __forceinline__ void phase_prologue_b(Frame& F, const Args& args) {
    unsigned char* ws_ = F.ws; asm volatile("" : "+s"(ws_)); int lane_ = lane_id(); asm volatile("" : "+v"(lane_)); (void)ws_;
    const int gw = F.vcu * NWAVES + F.wave, NGW = F.G * NWAVES;
    for (int e = gw * 64 + lane_; e < M * 12; e += NGW * 64) {
        const int row = e / 12, i = e % 12;
        const double inv = c_rope_inv[i];
        const double a = (double)P_POS[row] * inv;
        const double k = __builtin_rint(a * 0.15915494309189535);
        const float r = (float)(a - k * 6.283185307179586);
        const float c = __builtin_cosf(r), s = __builtin_sinf(r);
        float* t = B_ROPE + (size_t)row * 24;
        if (i < 8) { t[i] = c; t[8 + i] = s; } else { t[16 + (i - 8)] = c; t[20 + (i - 8)] = s; }
    }
    for (int m0 = gw * 4; m0 < M; m0 += NGW * 4) {
        f32x4 v[4][4];
#pragma unroll
        for (int k = 0; k < 4; ++k) { const f32x4* xr = (const f32x4*)(P_X_IN + (size_t)(m0 + k) * D) + lane_;
#pragma unroll
            for (int j = 0; j < 4; ++j) v[k][j] = xr[64 * j]; }
#pragma unroll
        for (int k = 0; k < 4; ++k) { float sq = 0.f;
#pragma unroll
            for (int j = 0; j < 4; ++j) sq += (v[k][j].x * v[k][j].x + v[k][j].y * v[k][j].y) + (v[k][j].z * v[k][j].z + v[k][j].w * v[k][j].w);
            const float rsv = rsqrtf(wave_sum(sq) * (1.f / D) + EPS);
            unsigned long long* o8 = (unsigned long long*)((bf16*)(ws_ + WS_XB) + (size_t)(m0 + k) * D) + lane_;
#pragma unroll
            for (int j = 0; j < 4; ++j) o8[64 * j] = (unsigned long long)pk2(v[k][j].x, v[k][j].y) | ((unsigned long long)pk2(v[k][j].z, v[k][j].w) << 32);
            if (lane_ == 0) ((float*)(ws_ + WS_RS))[m0 + k] = rsv; }
    }
}

typedef short bf16x8 __attribute__((ext_vector_type(8)));
typedef short s16x4 __attribute__((ext_vector_type(4)));
typedef float f32x16 __attribute__((ext_vector_type(16)));
#define MFMA32(a, b, c) __builtin_amdgcn_mfma_f32_32x32x16_bf16((a), (b), (c), 0, 0, 0)
__device__ __forceinline__ int crow(int r, int hi) { return (r & 3) + 8 * (r >> 2) + 4 * hi; }
__device__ __forceinline__ void wg_barrier() { asm volatile("s_waitcnt lgkmcnt(0)\n\ts_barrier" ::: "memory"); }

__device__ __forceinline__ void phase_prep(Frame& F, const Args& args, int l) {
    unsigned char* ws_ = F.ws; asm volatile("" : "+s"(ws_)); int lane_ = lane_id(); asm volatile("" : "+v"(lane_)); (void)ws_; (void)args;
    int tid_ = F.wave * 64 + lane_id(); asm volatile("" : "+v"(tid_));
    const int gw = F.vcu * NWAVES + F.wave, NGW = F.G * NWAVES, lane = lane_;
    {
        const int sub = lane >> 4, q = lane & 15;
        const bool r_idx = (q == 2), r_kv = (q >= 4 && q < 8), r_ka = (q < 2);
        const int which = q - 4;
        const int cbase = r_idx ? C_KIDX : (((which < 2) ? C_KSLC : C_KWIN) + (which & 1) * 64);
        constexpr int RB = 4;
        for (int row0 = gw * (4 * RB); row0 < M; row0 += NGW * (4 * RB)) {
            v4u cu[RB], ku[RB], e1[RB], e2[RB]; f32x4 t0[RB], t1[RB], t2[RB], t3[RB];
#pragma unroll
            for (int k = 0; k < RB; ++k) { const size_t row = (size_t)(row0 + 4 * k + sub); bf16* prow = B_PROJ + row * NP; const f32x4* tab = (const f32x4*)(B_ROPE + row * 24);
                cu[k] = *(const v4u*)(prow + C_CKV + 8 * q); ku[k] = *(const v4u*)(prow + C_KA + 8 * q);
                e1[k] = (v4u){0u, 0u, 0u, 0u}; e2[k] = e1[k]; t0[k] = (f32x4){0.f, 0.f, 0.f, 0.f}; t1[k] = t0[k]; t2[k] = t0[k]; t3[k] = t0[k];
                if (r_ka || r_kv) { t0[k] = tab[0]; t1[k] = tab[1]; t2[k] = tab[2]; t3[k] = tab[3]; }
                if (r_idx) { t0[k] = tab[4]; t2[k] = tab[5]; }
                if (r_idx || r_kv) e1[k] = *(const v4u*)(prow + cbase);
                if (r_kv) e2[k] = *(const v4u*)(prow + cbase + 8); }
#pragma unroll
            for (int k = 0; k < RB; ++k) { const size_t row = (size_t)(row0 + 4 * k + sub); bf16* prow = B_PROJ + row * NP;
                float x[8] = {bflo(cu[k].x), bfhi(cu[k].x), bflo(cu[k].y), bfhi(cu[k].y), bflo(cu[k].z), bfhi(cu[k].z), bflo(cu[k].w), bfhi(cu[k].w)};
                float ss = 0.f;
#pragma unroll
                for (int e = 0; e < 8; ++e) ss += x[e] * x[e];
                ss += dpp_f<0xB1>(ss); ss += dpp_f<0x4E>(ss); ss += dpp_f<0x141>(ss); ss += dpp_f<0x140>(ss);
                const float rs = rsqrtf(ss * (1.f / 128.f) + EPS);
                float y[8] = {bflo(ku[k].x) * rs, bfhi(ku[k].x) * rs, bflo(ku[k].y) * rs, bfhi(ku[k].y) * rs, bflo(ku[k].z) * rs, bfhi(ku[k].z) * rs, bflo(ku[k].w) * rs, bfhi(ku[k].w) * rs};
                const float cs[8] = {t0[k].x, t0[k].y, t0[k].z, t0[k].w, t1[k].x, t1[k].y, t1[k].z, t1[k].w};
                const float sn[8] = {t2[k].x, t2[k].y, t2[k].z, t2[k].w, t3[k].x, t3[k].y, t3[k].z, t3[k].w};
#pragma unroll
                for (int e = 0; e < 8; ++e) { const float pr = dpp_f<0xB1>(y[e]);
                    const float r0 = y[e] * cs[e] - pr * sn[e], r1 = pr * sn[e] + y[e] * cs[e];
                    y[e] = r_ka ? ((q == 0) ? r0 : r1) : y[e]; }
                *(v4u*)(prow + C_KA + 8 * q) = (v4u){pk2(y[0], y[1]), pk2(y[2], y[3]), pk2(y[4], y[5]), pk2(y[6], y[7])};
                if (r_idx) {
                    float z[8] = {bflo(e1[k].x), bfhi(e1[k].x), bflo(e1[k].y), bfhi(e1[k].y), bflo(e1[k].z), bfhi(e1[k].z), bflo(e1[k].w), bfhi(e1[k].w)};
                    const float ci[4] = {t0[k].x, t0[k].y, t0[k].z, t0[k].w}, si[4] = {t2[k].x, t2[k].y, t2[k].z, t2[k].w};
                    float o[8];
#pragma unroll
                    for (int i = 0; i < 4; ++i) { o[i] = z[i] * ci[i] - z[4 + i] * si[i]; o[4 + i] = z[i] * si[i] + z[4 + i] * ci[i]; }
                    *(v4u*)(prow + cbase) = (v4u){pk2(o[0], o[1]), pk2(o[2], o[3]), pk2(o[4], o[5]), pk2(o[6], o[7])};
                } else if (r_kv) {
                    float z1[8] = {bflo(e1[k].x), bfhi(e1[k].x), bflo(e1[k].y), bfhi(e1[k].y), bflo(e1[k].z), bfhi(e1[k].z), bflo(e1[k].w), bfhi(e1[k].w)};
                    float z2[8] = {bflo(e2[k].x), bfhi(e2[k].x), bflo(e2[k].y), bfhi(e2[k].y), bflo(e2[k].z), bfhi(e2[k].z), bflo(e2[k].w), bfhi(e2[k].w)};
                    float o1[8], o2[8];
#pragma unroll
                    for (int i = 0; i < 8; ++i) { o1[i] = z1[i] * cs[i] - z2[i] * sn[i]; o2[i] = z1[i] * sn[i] + z2[i] * cs[i]; }
                    *(v4u*)(prow + cbase) = (v4u){pk2(o1[0], o1[1]), pk2(o1[2], o1[3]), pk2(o1[4], o1[5]), pk2(o1[6], o1[7])};
                    *(v4u*)(prow + cbase + 8) = (v4u){pk2(o2[0], o2[1]), pk2(o2[2], o2[3]), pk2(o2[4], o2[5]), pk2(o2[6], o2[7])};
                }
            }
        }
    }
    {
        const int wid = F.wave, r32 = lane & 31, hi = lane >> 5;
        LAS float* P = (LAS float*)F.lds;
        for (int u = F.vcu; u < BATCH * 8; u += F.G) {
            const int b = u >> 3, g = (u >> 2) & 1, kv = (u >> 1) & 1, eh = u & 1;
            const int rt = wid >> 1, part = wid & 1;
            const bf16* ap = B_PROJ + ((size_t)b * S + 16 * (32 * rt + r32)) * NP + (kv ? C_VCMP : C_KCMP) + g * 64 + 8 * hi;
            const bf16* bp = (const bf16*)(ws_ + WS_WCT) + ((size_t)(l * 2 + kv) * 128 + part * 64 + eh * 32 + r32) * 1024 + 8 * hi;
            f32x16 acc = {};
#pragma unroll 8
            for (int ks = 0; ks < 64; ++ks) {
                const bf16x8 a = *(const bf16x8*)(ap + (size_t)(ks >> 2) * NP + 16 * (ks & 3));
                const bf16x8 bq = *(const bf16x8*)(bp + 16 * ks);
                acc = MFMA32(a, bq, acc);
            }
#pragma unroll
            for (int r = 0; r < 16; ++r) P[(part * 128 + 32 * rt + crow(r, hi)) * 32 + r32] = acc[r];
            wg_barrier();
            const float* cb = (const float*)(ws_ + WS_CB) + (l * 2 + kv) * 64 + eh * 32;
            bf16* ob = (bf16*)(ws_ + (kv ? WS_VCB : WS_KCB)) + (size_t)(b * 2 + g) * 128 * 64 + eh * 32;
            for (int idx = tid_; idx < 128 * 32; idx += 512) { const int c = idx >> 5, e = idx & 31;
                const float v = (c < NC) ? (P[c * 32 + e] + P[(128 + c + 1) * 32 + e] + cb[e]) : 0.f;
                ob[c * 64 + e] = (bf16)f2bf(v); }
            wg_barrier();
        }
    }
}

typedef float f32x2_t __attribute__((ext_vector_type(2))); typedef __bf16 bf16x2_t __attribute__((ext_vector_type(2)));
__device__ __forceinline__ unsigned cvtpk(float lo, float hi) { const f32x2_t v = {lo, hi}; const bf16x2_t b = __builtin_convertvector(v, bf16x2_t); return __builtin_bit_cast(unsigned, b); }
constexpr float C2 = 0.125f * 1.4426950408889634f;

__device__ __forceinline__ unsigned idxmask(int x, int hi) {
    unsigned m = 0u;
#pragma unroll
    for (int g = 0; g < 4; ++g) { int n = x - (8 * g + 4 * hi); n = n < 0 ? 0 : (n > 4 ? 4 : n); m |= ((1u << n) - 1u) << (4 * g); }
    return m;
}

constexpr int SEL_QF = 0, SEL_PART = 16384, SEL_HIST = 20480, SEL_HP = 260, SEL_RES = SEL_HIST + 32 * SEL_HP * 4;
__device__ __forceinline__ void dsa_select_unit(unsigned char* ws_, int tid_, int b, int qt32, LAS unsigned char* lds) {
    asm volatile("" : "+v"(tid_)); asm volatile("" : "+s"(ws_));
    const int lane = tid_ & 63, wid = __builtin_amdgcn_readfirstlane(tid_ >> 6), r32 = lane & 31, hi = lane >> 5;
    unsigned* maskbuf = (unsigned*)(ws_ + WS_MASK);
    if (qt32 < 8) {
        for (int i = tid_; i < 2048; i += 512) { const int qq = i >> 6, blk = i & 63; const int t = 32 * qt32 + qq; const int d = t - 32 * blk;
            const unsigned w = d < 0 ? 0u : (d >= 31 ? 0xffffffffu : ((2u << d) - 1u));
            maskbuf[((size_t)b * S + t) * 64 + blk] = w; }
        return;
    }
    const size_t qrow = (size_t)b * S + 32 * qt32 + r32;
    const bf16* prow = B_PROJ + qrow * NP;
    {
        const int h = wid >> 1, sk = wid & 1;
        const v4u raw = *(const v4u*)(prow + C_QIDX + h * 32 + 16 * sk + 8 * hi);
        float x[8] = {bflo(raw.x), bfhi(raw.x), bflo(raw.y), bfhi(raw.y), bflo(raw.z), bfhi(raw.z), bflo(raw.w), bfhi(raw.w)};
        if (sk == 0 && hi == 0) { const float* tab = B_ROPE + qrow * 24;
#pragma unroll
            for (int i = 0; i < 4; ++i) { const float c = tab[16 + i], sn = tab[20 + i]; const float x1 = x[i], x2 = x[4 + i]; x[i] = x1 * c - x2 * sn; x[4 + i] = x1 * sn + x2 * c; } }
        v4u hp, lp;
        { unsigned hh[4], ll[4];
#pragma unroll
          for (int k = 0; k < 4; ++k) { const float a = x[2 * k], bb = x[2 * k + 1]; const unsigned ha = f2bf(a), hb = f2bf(bb); hh[k] = ha | (hb << 16);
              ll[k] = pk2(a - bf2f((bf16)ha), bb - bf2f((bf16)hb)); }
          hp = (v4u){hh[0], hh[1], hh[2], hh[3]}; lp = (v4u){ll[0], ll[1], ll[2], ll[3]}; }
        LAS v4u* qf = (LAS v4u*)(lds + SEL_QF);
        qf[((h * 2 + sk) * 2 + 0) * 64 + lane] = hp; qf[((h * 2 + sk) * 2 + 1) * 64 + lane] = lp;
    }
    float w[4];
#pragma unroll
    for (int h = 0; h < 4; ++h) w[h] = bf2f(prow[C_WIDX + h]);
    __syncthreads();
    const int nblk = qt32 + 1;
    const bf16* kbase = B_PROJ + (size_t)b * S * NP + C_KIDX;
    unsigned key[8][16];
#pragma unroll
    for (int i = 0; i < 8; ++i) {
        const int blk = wid + 8 * i;
        if (blk < nblk) {
            const bf16* kp = kbase + (size_t)(32 * blk + r32) * NP + 8 * hi;
            const bf16x8 kf0 = *(const bf16x8*)kp, kf1 = *(const bf16x8*)(kp + 16);
            float sc[16];
            const LAS bf16x8* qf = (const LAS bf16x8*)(lds + SEL_QF);
#pragma unroll
            for (int h = 0; h < 4; ++h) {
                f32x16 acc = {};
                acc = MFMA32(kf0, qf[((h * 2 + 0) * 2 + 0) * 64 + lane], acc);
                acc = MFMA32(kf1, qf[((h * 2 + 1) * 2 + 0) * 64 + lane], acc);
                acc = MFMA32(kf0, qf[((h * 2 + 0) * 2 + 1) * 64 + lane], acc);
                acc = MFMA32(kf1, qf[((h * 2 + 1) * 2 + 1) * 64 + lane], acc);
#pragma unroll
                for (int r = 0; r < 16; ++r) sc[r] = (h == 0) ? w[0] * fmaxf(acc[r], 0.f) : fmaf(w[h], fmaxf(acc[r], 0.f), sc[r]);
            }
#pragma unroll
            for (int r = 0; r < 16; ++r) {
                unsigned bits = __builtin_bit_cast(unsigned, sc[r]);
                if (bits == 0x80000000u) bits = 0u;
                unsigned k = (bits & 0x80000000u) ? ~bits : (bits | 0x80000000u);
                if (blk == qt32 && crow(r, hi) > r32) k = 0u;
                key[i][r] = k;
            }
        } else {
#pragma unroll
            for (int r = 0; r < 16; ++r) key[i][r] = 0u;
        }
    }
    LAS unsigned* part = (LAS unsigned*)(lds + SEL_PART);
    int pbi = 0;
#define SEL_REDUCE(cnt_, tot_) do { LAS unsigned* pb_ = part + (pbi & 1) * 512; ++pbi; pb_[wid * 64 + lane] = (cnt_); wg_barrier(); unsigned t_ = 0u; \
        _Pragma("unroll") for (int w8 = 0; w8 < 8; ++w8) t_ += pb_[w8 * 64 + r32] + pb_[w8 * 64 + 32 + r32]; (tot_) = t_; } while (0)
    LAS unsigned* hist = (LAS unsigned*)(lds + SEL_HIST);
    LAS unsigned* resd = (LAS unsigned*)(lds + SEL_RES);
    { unsigned z_ = 0u; asm volatile("" : "+v"(z_)); const v4u zz = {z_, z_, z_, z_}; for (int i = tid_; i < 32 * SEL_HP / 4; i += 512) ((LAS v4u*)hist)[i] = zz; }
    wg_barrier();
    unsigned pfx = 0u, need = 256u;
    LAS unsigned* hrow = hist + r32 * SEL_HP;
#pragma unroll 1
    for (int pass = 0; pass < 4; ++pass) {
        const int shift = 24 - 8 * pass;
#pragma unroll
        for (int i = 0; i < 8; ++i) if (wid + 8 * i < nblk) {
#pragma unroll
            for (int r = 0; r < 16; ++r) {
                const unsigned k = key[i][r];
                const unsigned dg = (k >> shift) & 255u;
                const bool match = (pass == 0) || ((k >> (shift + 8)) == pfx);
                __hip_atomic_fetch_add(hrow + (match ? dg : 256u), 1u, __ATOMIC_RELAXED, __HIP_MEMORY_SCOPE_WORKGROUP);
            } }
        wg_barrier();
        {
            const int qq = lane >> 4, t16 = lane & 15, q = 4 * wid + qq;
            LAS v4u* hq = (LAS v4u*)(hist + q * SEL_HP + 16 * t16);
            unsigned g4[4];
#pragma unroll
            for (int i = 0; i < 4; ++i) { const v4u hv = hq[i]; g4[i] = (hv.x + hv.y) + (hv.z + hv.w); }
            const unsigned sL = (g4[0] + g4[1]) + (g4[2] + g4[3]);
            unsigned T = sL;
            T += (unsigned)dpp_i<0x101>((int)T); T += (unsigned)dpp_i<0x102>((int)T); T += (unsigned)dpp_i<0x104>((int)T); T += (unsigned)dpp_i<0x108>((int)T);
            const unsigned needq = (pass == 0) ? 256u : resd[32 + q];
            const unsigned long long bal = __ballot(T >= needq);
            const unsigned rowbits = (unsigned)(bal >> (16 * qq)) & 0xFFFFu;
            const int ts = 31 - __builtin_clz(rowbits | 1u);
            {
                const unsigned rem = needq - (T - sL);
                unsigned c = 0u; int gs = 0; unsigned abg = 0u; bool found = false;
#pragma unroll
                for (int i = 3; i >= 0; --i) { const unsigned cn = c + g4[i]; if (!found && rem <= cn) { gs = i; abg = c; found = true; } c = cn; }
                const v4u hv = hq[gs];
                const unsigned r2 = rem - abg;
                const unsigned c3 = hv.w, c2 = c3 + hv.z, c1 = c2 + hv.y;
                int d; unsigned ab;
                if (r2 <= c3) { d = 3; ab = 0u; } else if (r2 <= c2) { d = 2; ab = c3; } else if (r2 <= c1) { d = 1; ab = c2; } else { d = 0; ab = c1; }
                asm volatile("s_waitcnt lgkmcnt(0)" ::: "memory");
                if (t16 == ts) { resd[q] = 16u * (unsigned)ts + 4u * (unsigned)gs + (unsigned)d; resd[32 + q] = r2 - ab; }
            }
            { unsigned z_ = 0u; asm volatile("" : "+v"(z_)); const v4u zz = {z_, z_, z_, z_};
              hq[0] = zz; hq[1] = zz; hq[2] = zz; hq[3] = zz; if (t16 == 0) hist[q * SEL_HP + 256] = z_; }
        }
        wg_barrier();
        pfx = (pfx << 8) | resd[r32]; need = resd[32 + r32];
    }
    const unsigned thr = pfx;
    unsigned gtm[8], eqm[8];
#pragma unroll
    for (int i = 0; i < 8; ++i) { unsigned g = 0u, e = 0u;
        if (wid + 8 * i < nblk) {
#pragma unroll
            for (int r = 0; r < 16; ++r) { g |= (key[i][r] > thr) ? (1u << r) : 0u; e |= (key[i][r] == thr) ? (1u << r) : 0u; } }
        gtm[i] = g; eqm[i] = e; }
    const unsigned rneed = need;
    unsigned pc[8];
#pragma unroll
    for (int i = 0; i < 8; ++i) pc[i] = __builtin_popcount(eqm[i]);
    unsigned Y = 0u;
    for (int bit = 10; bit >= 5; --bit) {
        const unsigned c = Y | (1u << bit); const int cb = (int)(c >> 5);
        unsigned cnt = 0u;
#pragma unroll
        for (int i = 0; i < 8; ++i) cnt += (wid + 8 * i < cb) ? pc[i] : 0u;
        unsigned tot; SEL_REDUCE(cnt, tot);
        if (tot < rneed) Y = c;
    }
    {
        const int yb = (int)(Y >> 5);
        unsigned cbase = 0u, em = 0u;
#pragma unroll
        for (int i = 0; i < 8; ++i) { cbase += (wid + 8 * i < yb) ? pc[i] : 0u; em |= (wid + 8 * i == yb) ? eqm[i] : 0u; }
        for (int bit = 4; bit >= 0; --bit) {
            const unsigned c = Y | (1u << bit);
            const unsigned cnt = cbase + __builtin_popcount(em & idxmask((int)(c & 31u), hi));
            unsigned tot; SEL_REDUCE(cnt, tot);
            if (tot < rneed) Y = c;
        }
    }
#undef SEL_REDUCE
#pragma unroll
    for (int i = 0; i < 8; ++i) {
        const int blk = wid + 8 * i;
        const unsigned selm = gtm[i] | (eqm[i] & idxmask((int)Y + 1 - 32 * blk, hi));
        unsigned word = ((selm & 0xFu) | ((selm & 0xF0u) << 4) | ((selm & 0xF00u) << 8) | ((selm & 0xF000u) << 12)) << (4 * hi);
        word = or_halves(word);
        if (hi == 0) maskbuf[qrow * 64 + blk] = word;
    }
    __syncthreads();
}

constexpr int AT_K = 0, AT_V = 24576, AT_WS = 49152;
__device__ __forceinline__ void pv(f32x16* o, f32x16& lacc, unsigned vb, bf16x8 pa0, bf16x8 pa1, bf16x8 pa2, bf16x8 pa3) {
    { const bf16x8 ones = {0x3F80, 0x3F80, 0x3F80, 0x3F80, 0x3F80, 0x3F80, 0x3F80, 0x3F80};
      lacc = MFMA32(pa0, ones, lacc); lacc = MFMA32(pa1, ones, lacc); lacc = MFMA32(pa2, ones, lacc); lacc = MFMA32(pa3, ones, lacc); }
#pragma unroll
    for (int d0 = 0; d0 < 2; ++d0) { s16x4 lo0, lo1, lo2, lo3, hi0, hi1, hi2, hi3;
        asm volatile("ds_read_b64_tr_b16 %0,%8 offset:%c9\n\tds_read_b64_tr_b16 %1,%8 offset:%c10\n\tds_read_b64_tr_b16 %2,%8 offset:%c11\n\tds_read_b64_tr_b16 %3,%8 offset:%c12\n\t"
                     "ds_read_b64_tr_b16 %4,%8 offset:%c13\n\tds_read_b64_tr_b16 %5,%8 offset:%c14\n\tds_read_b64_tr_b16 %6,%8 offset:%c15\n\tds_read_b64_tr_b16 %7,%8 offset:%c16\n\t"
                     "s_waitcnt lgkmcnt(0)"
                     : "=&v"(lo0), "=&v"(hi0), "=&v"(lo1), "=&v"(hi1), "=&v"(lo2), "=&v"(hi2), "=&v"(lo3), "=&v"(hi3)
                     : "v"(vb), "i"(d0 * 4096 + 0), "i"(d0 * 4096 + 512), "i"(d0 * 4096 + 1024), "i"(d0 * 4096 + 1536), "i"(d0 * 4096 + 2048), "i"(d0 * 4096 + 2560), "i"(d0 * 4096 + 3072), "i"(d0 * 4096 + 3584)
                     : "memory");
#define PKV(l_, h_) (bf16x8){l_[0], l_[1], l_[2], l_[3], h_[0], h_[1], h_[2], h_[3]}
        o[d0] = MFMA32(pa0, PKV(lo0, hi0), o[d0]);
        o[d0] = MFMA32(pa1, PKV(lo1, hi1), o[d0]);
        o[d0] = MFMA32(pa2, PKV(lo2, hi2), o[d0]);
        o[d0] = MFMA32(pa3, PKV(lo3, hi3), o[d0]);
#undef PKV
    }
}
struct SmState { float mhat; f32x16 o[2]; f32x16 lacc; };
__device__ __forceinline__ unsigned bfe1(unsigned w, int c) { int r; asm("v_bfe_i32 %0, %1, %2, 1" : "=v"(r) : "v"(w), "n"(c)); return (unsigned)r; }
__device__ __forceinline__ float rowmax32(const f32x16& p0, const f32x16& p1) {
    float a = fmaxf(p0[0], p1[0]);
#pragma unroll
    for (int r = 1; r < 16; ++r) a = fmaxf(a, fmaxf(p0[r], p1[r]));
    return max_halves(a);
}
constexpr int NS_QF = 53248, NS_SELS = 86016, NS_SSUM = 118784, NS_SELM = 126976;
__device__ __forceinline__ unsigned range32(int lo, int up) {
    const int l2 = lo < 0 ? 0 : lo, u2 = up > 31 ? 31 : up;
    const unsigned hm = (u2 >= 31) ? ~0u : ((2u << (u2 & 31)) - 1u);
    const unsigned lm = (1u << (l2 & 31)) - 1u;
    return (up < 0 || lo > 31 || u2 < l2) ? 0u : (hm & ~lm);
}
struct M64 { unsigned x, y; };
__device__ __forceinline__ M64 mask_range(int lo, int up) { M64 m; m.x = range32(lo, up); m.y = range32(lo - 32, up - 32); return m; }
__device__ __forceinline__ void load_q(bf16x8* qr, const bf16* qp, const float* tab, bool rope, int hi) {
#pragma unroll
    for (int d0 = 0; d0 < 4; ++d0) {
        const v4u raw = *(const v4u*)(qp + 16 * d0);
        float x[8] = {bflo(raw.x), bfhi(raw.x), bflo(raw.y), bfhi(raw.y), bflo(raw.z), bfhi(raw.z), bflo(raw.w), bfhi(raw.w)};
        if (d0 == 0) {
#pragma unroll
            for (int j = 0; j < 8; ++j) { const float other = other_half_f(x[j], hi); const float c = tab[j], sn = tab[8 + j];
                const float rot = (hi == 0) ? (x[j] * c - other * sn) : (other * sn + x[j] * c); x[j] = rope ? rot : x[j]; }
        }
        v4u pk; pk.x = cvtpk(x[0] * C2, x[1] * C2); pk.y = cvtpk(x[2] * C2, x[3] * C2); pk.z = cvtpk(x[4] * C2, x[5] * C2); pk.w = cvtpk(x[6] * C2, x[7] * C2);
        qr[d0] = __builtin_bit_cast(bf16x8, pk);
    }
}
__device__ __forceinline__ void qkt_lq(f32x16& p0, f32x16& p1, const LAS unsigned char* Kslot, const LAS bf16x8* qf, int lane, int r32, int hi) {
    const LAS unsigned char* kb = Kslot + hi * 1024 + r32 * 16;
    p0 = f32x16{}; p1 = f32x16{};
#pragma unroll
    for (int d0 = 0; d0 < 4; ++d0) {
        const bf16x8 b0 = *(const LAS bf16x8*)(kb + d0 * 2048);
        const bf16x8 b1 = *(const LAS bf16x8*)(kb + d0 * 2048 + 512);
        const bf16x8 q = qf[d0 * 64 + lane];
        p0 = MFMA32(b0, q, p0); p1 = MFMA32(b1, q, p1);
        if (d0 & 1) __builtin_amdgcn_sched_barrier(0);
    }
}
template <bool SEL>
__device__ __forceinline__ void softmax_pv(SmState& st, f32x16& osel, f32x16& p0, f32x16& p1, unsigned vb, const M64 mcur, bool first, LAS float* wsf, int r32, int hi, int ctile) {
    (void)first; (void)wsf; (void)r32;
    const unsigned wx = mcur.x >> (4 * hi), wy = mcur.y >> (4 * hi);
    unsigned e0[16], e1[16];
#pragma unroll
    for (int r = 0; r < 16; ++r) { e0[r] = __builtin_bit_cast(unsigned, __builtin_amdgcn_exp2f(p0[r])); e1[r] = __builtin_bit_cast(unsigned, __builtin_amdgcn_exp2f(p1[r])); }
    const bool lane_uniform = !SEL && __all((mcur.x == mcur.y) && ((mcur.x + 1u) <= 1u));
    if (!lane_uniform && !__all((mcur.x & mcur.y) == ~0u)) {
#pragma unroll
        for (int r = 0; r < 16; ++r) { const int c = (r & 3) + 8 * (r >> 2); e0[r] &= bfe1(wx, c); e1[r] &= bfe1(wy, c); }
    }
    unsigned pw[16];
#pragma unroll
    for (int k = 0; k < 8; ++k) { pw[k] = cvtpk(__builtin_bit_cast(float, e0[2 * k]), __builtin_bit_cast(float, e0[2 * k + 1])); pw[8 + k] = cvtpk(__builtin_bit_cast(float, e1[2 * k]), __builtin_bit_cast(float, e1[2 * k + 1])); }
    if (lane_uniform) {
#pragma unroll
        for (int k = 0; k < 16; ++k) pw[k] &= mcur.x;
    }
    if (SEL) {
#pragma unroll
        for (int ks = 0; ks < 4; ++ks) {
            unsigned ov[4], pl[4];
#pragma unroll
            for (int k = 0; k < 4; ++k) {
                const int j0 = 2 * k, j1 = 2 * k + 1;
                const int c0 = 64 * ctile + 16 * ks + 8 * (j0 >> 2) + 4 * hi + (j0 & 3), c1 = 64 * ctile + 16 * ks + 8 * (j1 >> 2) + 4 * hi + (j1 & 3);
                const unsigned a = (c0 >= 4 * r32 - 1 && c0 <= 4 * r32 + 3) ? 0x3F80u : 0u, bq = (c1 >= 4 * r32 - 1 && c1 <= 4 * r32 + 3) ? 0x3F80u : 0u;
                ov[k] = a | (bq << 16);
                const int e = 4 * ks + k;
                const float v0 = __builtin_bit_cast(float, (e < 8) ? e0[2 * e] : e1[2 * (e - 8)]), v1 = __builtin_bit_cast(float, (e < 8) ? e0[2 * e + 1] : e1[2 * (e - 8) + 1]);
                pl[k] = cvtpk(v0 - bflo(pw[e]), v1 - bfhi(pw[e]));
            }
            const bf16x8 ovf = __builtin_bit_cast(bf16x8, (v4u){ov[0], ov[1], ov[2], ov[3]});
            osel = MFMA32(__builtin_bit_cast(bf16x8, (v4u){pw[4 * ks], pw[4 * ks + 1], pw[4 * ks + 2], pw[4 * ks + 3]}), ovf, osel);
            osel = MFMA32(__builtin_bit_cast(bf16x8, (v4u){pl[0], pl[1], pl[2], pl[3]}), ovf, osel);
        }
    }
    pv(st.o, st.lacc, vb, __builtin_bit_cast(bf16x8, (v4u){pw[0], pw[1], pw[2], pw[3]}), __builtin_bit_cast(bf16x8, (v4u){pw[4], pw[5], pw[6], pw[7]}),
       __builtin_bit_cast(bf16x8, (v4u){pw[8], pw[9], pw[10], pw[11]}), __builtin_bit_cast(bf16x8, (v4u){pw[12], pw[13], pw[14], pw[15]}));
}
template <bool SEL>
__device__ __forceinline__ void tile_step(SmState& st, f32x16& osel, const LAS unsigned char* Kslot, unsigned vb, const LAS bf16x8* qf, const M64 mcur, bool first, LAS float* wsf, int lane, int r32, int hi, int ctile) {
    f32x16 p0, p1;
    qkt_lq(p0, p1, Kslot, qf, lane, r32, hi);
    softmax_pv<SEL>(st, osel, p0, p1, vb, mcur, first, wsf, r32, hi, ctile);
}
__device__ __forceinline__ void qkt_rq(f32x16& p0, f32x16& p1, const LAS unsigned char* Kslot, const bf16x8* qr, int r32, int hi) {
    const LAS unsigned char* kb = Kslot + hi * 1024 + r32 * 16;
    p0 = f32x16{}; p1 = f32x16{};
#pragma unroll
    for (int d0 = 0; d0 < 4; ++d0) {
        const bf16x8 b0 = *(const LAS bf16x8*)(kb + d0 * 2048);
        const bf16x8 b1 = *(const LAS bf16x8*)(kb + d0 * 2048 + 512);
        p0 = MFMA32(b0, qr[d0], p0); p1 = MFMA32(b1, qr[d0], p1);
    }
}
__device__ __forceinline__ void sm_reset(SmState& st) { st.mhat = 0.f; st.o[0] = f32x16{}; st.o[1] = f32x16{}; st.lacc = f32x16{}; }
__device__ __forceinline__ float sigmoidf_(float x) { return 1.f / (1.f + __expf(-x)); }

__device__ __forceinline__ void dsa_attn_unit(unsigned char* ws_, int tid_, int b, int qt, LAS unsigned char* lds) {
    asm volatile("" : "+v"(tid_)); asm volatile("" : "+s"(ws_));
    const int lane = tid_ & 63, wid = __builtin_amdgcn_readfirstlane(tid_ >> 6), r32 = lane & 31, hi = lane >> 5;
    const int h = wid >> 1, qh = wid & 1;
    const size_t qrow = (size_t)b * S + 64 * qt + 32 * qh + r32;
    LAS float* wsf = (LAS float*)(lds + AT_WS) + wid * 128;
    bf16x8 qr[4];
    {
        const bf16* qp = B_PROJ + qrow * NP + C_QA + h * 64 + 8 * hi;
        const float* tab = B_ROPE + qrow * 24;
#pragma unroll
        for (int d0 = 0; d0 < 4; ++d0) {
            const v4u raw = *(const v4u*)(qp + 16 * d0);
            float x[8] = {bflo(raw.x), bfhi(raw.x), bflo(raw.y), bfhi(raw.y), bflo(raw.z), bfhi(raw.z), bflo(raw.w), bfhi(raw.w)};
            if (d0 == 0) {
#pragma unroll
                for (int j = 0; j < 8; ++j) { const float other = other_half_f(x[j], hi); const float c = tab[j], sn = tab[8 + j];
                    x[j] = (hi == 0) ? (x[j] * c - other * sn) : (other * sn + x[j] * c); }
            }
            v4u pk; pk.x = cvtpk(x[0] * C2, x[1] * C2); pk.y = cvtpk(x[2] * C2, x[3] * C2); pk.z = cvtpk(x[4] * C2, x[5] * C2); pk.w = cvtpk(x[6] * C2, x[7] * C2);
            qr[d0] = __builtin_bit_cast(bf16x8, pk);
        }
    }
    LAS bf16x8* qf = (LAS bf16x8*)(lds + NS_QF) + wid * 256;
#pragma unroll
    for (int d0 = 0; d0 < 4; ++d0) qf[d0 * 64 + lane] = qr[d0];
    const bf16* KAb = B_PROJ + (size_t)b * S * NP;
    const bf16* ksrc = KAb + (size_t)lane * NP + C_KA + wid * 8;
    const bf16* vsrc = KAb + (size_t)(16 * (wid & 3) + (lane >> 2)) * NP + C_VA + (wid >> 2) * 32 + (lane & 3) * 8;
#define AT_DMA(t, slot) do { \
        __builtin_amdgcn_global_load_lds((const unsigned*)(ksrc + (size_t)(t) * 64 * NP), (LAS unsigned*)(lds + AT_K + (slot) * 8192 + wid * 1024), 16, 0, 0); \
        __builtin_amdgcn_global_load_lds((const unsigned*)(vsrc + (size_t)(t) * 64 * NP), (LAS unsigned*)(lds + AT_V + (slot) * 8192 + wid * 1024), 16, 0, 0); } while (0)
    const unsigned vb0 = (unsigned)(uintptr_t)(lds + AT_V) + ((lane >> 4) & 1) * 32 + (lane & 3) * 8 + (4 * hi + ((lane & 15) >> 2)) * 64;
    const int NT = qt + 1;
    SmState st; sm_reset(st);
    const unsigned long long* mrow = (const unsigned long long*)((const unsigned*)(ws_ + WS_MASK) + qrow * 64);
    AT_DMA(0, 0);
    unsigned long long m0 = mrow[0], m1 = 0ull, m2 = 0ull;
    if (NT > 1) { AT_DMA(1, 1); m1 = mrow[1]; }
    int cs = 0, is = 2;
    f32x16 osel_unused = {};
#define AT_NEXT(c_) (((c_) == 2) ? 0 : (c_) + 1)
    for (int t = 0; t < NT; ++t) {
        if (t + 1 < NT) asm volatile("s_waitcnt vmcnt(3)" ::: "memory"); else asm volatile("s_waitcnt vmcnt(0)" ::: "memory");
        wg_barrier();
        if (t + 2 < NT) { AT_DMA(t + 2, is); m2 = mrow[t + 2]; }
        const unsigned long long mcur_ = m0; m0 = m1; m1 = m2;
        f32x16 p0, p1;
        qkt_lq(p0, p1, lds + AT_K + cs * 8192, qf, lane, r32, hi);
        softmax_pv<false>(st, osel_unused, p0, p1, vb0 + cs * 8192, (M64){(unsigned)mcur_, (unsigned)(mcur_ >> 32)}, t == 0, wsf, r32, hi, 0);
        cs = AT_NEXT(cs); is = AT_NEXT(is);
    }
#undef AT_NEXT
#undef AT_DMA
    {
        bf16* ob = B_MIX + ((size_t)b * S + 64 * qt + 32 * qh) * D + h * 64 + r32;
#pragma unroll
        for (int r = 0; r < 16; ++r) { const int rq = crow(r, hi); const float f = __builtin_amdgcn_rcpf(st.lacc[r]);
            ob[(size_t)rq * D] = (bf16)f2bf(st.o[0][r] * f); ob[(size_t)rq * D + 32] = (bf16)f2bf(st.o[1][r] * f); }
    }
    __syncthreads();
}


template <bool SEL>
__device__ __forceinline__ void nsa_unit(unsigned char* ws_, int tid_, int b, int g, int qt, LAS unsigned char* lds) {
    asm volatile("" : "+v"(tid_)); asm volatile("" : "+s"(ws_));
    const int lane = tid_ & 63, wid = __builtin_amdgcn_readfirstlane(tid_ >> 6), r32 = lane & 31, hi = lane >> 5;
    const int hr = wid >> 1, qh = wid & 1, H = 4 * g + hr;
    const int tq = 64 * qt + 32 * qh + r32;
    const size_t qrow = (size_t)b * S + tq;
    LAS float* wsf = (LAS float*)(lds + AT_WS) + wid * 128;
    const unsigned vb0 = (unsigned)(uintptr_t)(lds + AT_V) + ((lane >> 4) & 1) * 32 + (lane & 3) * 8 + (4 * hi + ((lane & 15) >> 2)) * 64;
    const bf16* kcb = (const bf16*)(ws_ + WS_KCB) + (size_t)(b * 2 + g) * 128 * 64;
    const bf16* vcb = (const bf16*)(ws_ + WS_VCB) + (size_t)(b * 2 + g) * 128 * 64;
    const bf16* pb = B_PROJ + (size_t)b * S * NP + g * 64;
    const int vrow = 16 * (wid & 3) + (lane >> 2), vcol = (wid >> 2) * 32 + (lane & 3) * 8;
#define NS_DMA(kp_, vp_, slot_) do { \
        __builtin_amdgcn_global_load_lds((const unsigned*)(kp_), (LAS unsigned*)(lds + AT_K + (slot_) * 8192 + wid * 1024), 16, 0, 0); \
        __builtin_amdgcn_global_load_lds((const unsigned*)(vp_), (LAS unsigned*)(lds + AT_V + (slot_) * 8192 + wid * 1024), 16, 0, 0); } while (0)
#define NS_DMA_CMP(i_, slot_) NS_DMA(kcb + (size_t)(64 * (i_) + lane) * 64 + wid * 8, vcb + (size_t)(64 * (i_) + vrow) * 64 + vcol, slot_)
#define NS_DMA_PROJ(ck_, cv_, j_, slot_) NS_DMA(pb + (size_t)(64 * (j_) + lane) * NP + (ck_) + wid * 8, pb + (size_t)(64 * (j_) + vrow) * NP + (cv_) + vcol, slot_)
    const int ncmp = (qt >= 16) ? 2 : 1;
    const int jw0 = (qt > 8) ? qt - 8 : 0, nwin = qt - jw0 + 1;
    if (hi == 0) { const bf16* gp = B_PROJ + qrow * NP + C_GATE + H * 3;
        wsf[64 + r32] = sigmoidf_(bf2f(gp[0])); wsf[96 + r32] = sigmoidf_(bf2f(gp[2])); wsf[32 + r32] = sigmoidf_(bf2f(gp[1])); }
    int nissued = 0, islot = 0, ti = 0, cslot = 0;
    unsigned remI = SEL ? 0u : ((2u << qt) - 1u);
#define NS_ISSUE() do { \
        if (nissued < ncmp) { NS_DMA_CMP(nissued, islot); } \
        else if (nissued < ncmp + nwin) { NS_DMA_PROJ(C_KWIN, C_VWIN, jw0 + nissued - ncmp, islot); } \
        else if (remI) { const int j_ = __builtin_ctz(remI); remI &= remI - 1u; NS_DMA_PROJ(C_KSLC, C_VSLC, j_, islot); } \
        else break; \
        ++nissued; islot = (islot == 2) ? 0 : islot + 1; } while (0)
#define NS_TOP() do { if (nissued > ti + 1) asm volatile("s_waitcnt vmcnt(2)" ::: "memory"); else asm volatile("s_waitcnt vmcnt(0)" ::: "memory"); wg_barrier(); NS_ISSUE(); } while (0)
#define NS_ADV() do { ++ti; cslot = (cslot == 2) ? 0 : cslot + 1; } while (0)
    NS_ISSUE(); NS_ISSUE();
    LAS bf16x8* qf = (LAS bf16x8*)(lds + NS_QF) + wid * 256;
    { bf16x8 qr[4]; load_q(qr, B_PROJ + qrow * NP + C_QB + H * 64 + 8 * hi, B_ROPE + qrow * 24, false, hi);
#pragma unroll
      for (int d0 = 0; d0 < 4; ++d0) qf[d0 * 64 + lane] = qr[d0]; }
    SmState st; sm_reset(st);
    f32x16 osel = {};
    unsigned oaccp[16];
    const int ncv = (tq >= 31) ? (((tq - 31) >> 4) + 1) : 0;
    for (int i = 0; i < ncmp; ++i) {
        NS_TOP();
        const M64 m = mask_range(0, ncv - 64 * i - 1);
        tile_step<SEL>(st, osel, lds + AT_K + cslot * 8192, vb0 + cslot * 8192, qf, m, i == 0, wsf, lane, r32, hi, i);
        NS_ADV();
    }
    {
        asm volatile("s_waitcnt lgkmcnt(0)" ::: "memory");
        LAS float* sels = (LAS float*)(lds + NS_SELS);
#pragma unroll
        for (int r = 0; r < 16; ++r) { const int rq = crow(r, hi); const float lt = st.lacc[r]; const float inv = lt > 0.f ? __builtin_amdgcn_rcpf(lt) : 0.f; const float f2 = wsf[64 + rq] * inv;
            oaccp[r] = cvtpk(st.o[0][r] * f2, st.o[1][r] * f2);
            if (SEL) sels[(hr * 64 + 32 * qh + rq) * 32 + r32] = osel[r] * inv; }
        asm volatile("s_waitcnt lgkmcnt(0)" ::: "memory");
    }
    unsigned selunion;
    if (SEL) {
        wg_barrier();
        LAS float* sels = (LAS float*)(lds + NS_SELS);
        LAS float* ssum = (LAS float*)(lds + NS_SSUM);
        LAS unsigned* selm = (LAS unsigned*)(lds + NS_SELM);
        const int q = tid_ >> 3, jg = tid_ & 7;
        f32x4 s4 = *(const LAS f32x4*)(sels + (0 * 64 + q) * 32 + 4 * jg);
        s4 += *(const LAS f32x4*)(sels + (1 * 64 + q) * 32 + 4 * jg);
        s4 += *(const LAS f32x4*)(sels + (2 * 64 + q) * 32 + 4 * jg);
        s4 += *(const LAS f32x4*)(sels + (3 * 64 + q) * 32 + 4 * jg);
        *(LAS f32x4*)(ssum + q * 32 + 4 * jg) = s4;
        asm volatile("s_waitcnt lgkmcnt(0)" ::: "memory");
        float sv[32];
#pragma unroll
        for (int k = 0; k < 8; ++k) { const f32x4 v = *(const LAS f32x4*)(ssum + q * 32 + 4 * k); sv[4 * k] = v.x; sv[4 * k + 1] = v.y; sv[4 * k + 2] = v.z; sv[4 * k + 3] = v.w; }
        const float PINF = __builtin_inff();
#pragma unroll
        for (int i = 0; i < 32; ++i) sv[i] = (i > qt) ? -PINF : ((i == 0 || i == qt || i == qt - 1) ? PINF : sv[i]);
        unsigned bits4 = 0u;
#pragma unroll
        for (int jj = 0; jj < 4; ++jj) {
            const int j = 4 * jg + jj;
            float mine = (jj == 0) ? s4.x : (jj == 1) ? s4.y : (jj == 2) ? s4.z : s4.w;
            mine = (j > qt) ? -PINF : ((j == 0 || j == qt || j == qt - 1) ? PINF : mine);
            int rank = 0;
#pragma unroll
            for (int i = 0; i < 32; ++i) rank += ((sv[i] > mine) || (sv[i] == mine && i < j)) ? 1 : 0;
            bits4 |= (rank < 16) ? (1u << jj) : 0u;
        }
        unsigned mm = bits4 << (4 * jg);
        mm |= (unsigned)dpp_i<0xB1>((int)mm); mm |= (unsigned)dpp_i<0x4E>((int)mm); mm |= (unsigned)dpp_i<0x141>((int)mm);
        if (jg == 0) selm[q] = mm;
        wg_barrier();
        unsigned u = selm[lane];
        u = or_halves(or32(u));
        selunion = (unsigned)__builtin_amdgcn_readfirstlane((int)u);
    } else {
        selunion = (2u << qt) - 1u;
    }
    { bf16x8 qr[4]; load_q(qr, B_PROJ + qrow * NP + C_QB + H * 64 + 8 * hi, B_ROPE + qrow * 24, true, hi);
#pragma unroll
      for (int d0 = 0; d0 < 4; ++d0) qf[d0 * 64 + lane] = qr[d0]; }
    sm_reset(st);
    if (SEL) remI = selunion;
    for (int j = jw0; j <= qt; ++j) {
        NS_TOP();
        const M64 m = mask_range(tq - 511 - 64 * j, tq - 64 * j);
        tile_step<false>(st, osel, lds + AT_K + cslot * 8192, vb0 + cslot * 8192, qf, m, j == jw0, wsf, lane, r32, hi, 0);
        NS_ADV();
    }
    {
        asm volatile("s_waitcnt lgkmcnt(0)" ::: "memory");
#pragma unroll
        for (int r = 0; r < 16; ++r) { const float lt = st.lacc[r]; const float f2 = lt > 0.f ? wsf[96 + crow(r, hi)] * __builtin_amdgcn_rcpf(lt) : 0.f; oaccp[r] = cvtpk(bflo(oaccp[r]) + st.o[0][r] * f2, bfhi(oaccp[r]) + st.o[1][r] * f2); }
        asm volatile("s_waitcnt lgkmcnt(0)" ::: "memory");
    }
    sm_reset(st);
    bool firstb = true;
    unsigned rem = selunion;
    while (rem) {
        const int j = __builtin_ctz(rem); rem &= rem - 1u;
        NS_TOP();
        const unsigned mysel_ = SEL ? ((const LAS unsigned*)(lds + NS_SELM))[32 * qh + r32] : ((2u << qt) - 1u);
        M64 m = mask_range(0, tq - 64 * j); if (!((mysel_ >> j) & 1u)) { m.x = 0u; m.y = 0u; }
        tile_step<false>(st, osel, lds + AT_K + cslot * 8192, vb0 + cslot * 8192, qf, m, firstb, wsf, lane, r32, hi, 0);
        firstb = false; NS_ADV();
    }
    {
        asm volatile("s_waitcnt lgkmcnt(0)" ::: "memory");
        bf16* ob = B_MIX + ((size_t)b * S + 64 * qt + 32 * qh) * D + 256 + H * 64 + r32;
#pragma unroll
        for (int r = 0; r < 16; ++r) { const int rq = crow(r, hi); const float lt = st.lacc[r]; const float f2 = lt > 0.f ? wsf[32 + rq] * __builtin_amdgcn_rcpf(lt) : 0.f;
            ob[(size_t)rq * D] = (bf16)f2bf(bflo(oaccp[r]) + st.o[0][r] * f2); ob[(size_t)rq * D + 32] = (bf16)f2bf(bfhi(oaccp[r]) + st.o[1][r] * f2); }
    }
    __syncthreads();
#undef NS_DMA
#undef NS_DMA_CMP
#undef NS_DMA_PROJ
#undef NS_ISSUE
#undef NS_TOP
#undef NS_ADV
}

__device__ __forceinline__ void phase_attn(Frame& F, int l) {
    (void)l;
    unsigned char* ws_ = F.ws; asm volatile("" : "+s"(ws_)); int lane_ = lane_id(); asm volatile("" : "+v"(lane_)); (void)ws_;
    int tid_ = F.wave * 64 + lane_id(); asm volatile("" : "+v"(tid_));
    for (int u = F.vcu; u < BATCH * 64; u += F.G) {
        const int c = u & 255, i = u >> 8; const int b = c >> 3, sft = c & 7; const int base = 16 * (i >> 1); const int qt32 = (i & 1) ? base + 15 - sft : base + sft;
        dsa_select_unit(ws_, tid_, b, qt32, F.lds);
    }
    __syncthreads();
#if PROBE_MASK
    if (blockIdx.x == 0 && F.wave == 0 && lane_id() == 0) { const unsigned long long ts_ = __builtin_amdgcn_s_memrealtime(); F.MISC[16] = (unsigned)ts_; F.MISC[17] = (unsigned)(ts_ >> 32); }
#endif
    for (int u = F.vcu; u < BATCH * 64; u += F.G) {
        const int c = u & 255, i = u >> 8; const int b = c >> 3, sft = c & 7; const int g = i & 1, k = i >> 1; const int base = 16 * (k >> 1); const int qt = (k & 1) ? base + 15 - sft : base + sft;
        if (qt >= 16) nsa_unit<true>(ws_, tid_, b, g, qt, F.lds); else nsa_unit<false>(ws_, tid_, b, g, qt, F.lds);
    }
}
__device__ __forceinline__ void phase_dsa_attn(Frame& F) {
    unsigned char* ws_ = F.ws; asm volatile("" : "+s"(ws_));
    int tid_ = F.wave * 64 + lane_id(); asm volatile("" : "+v"(tid_));
    for (int u = F.vcu; u < BATCH * 32; u += F.G) {
        const int c = u & 255, i = u >> 8; const int b = c >> 3, sft = c & 7; const int base = 16 * (i >> 1); const int qt = (i & 1) ? base + 15 - sft : base + sft;
        dsa_attn_unit(ws_, tid_, b, qt, F.lds);
    }
}

constexpr int WP_PITCH = 72;
__device__ __forceinline__ void phase_merge(Frame& F, const Args& args, int l) {
    unsigned char* ws_ = F.ws; asm volatile("" : "+s"(ws_)); int lane_ = lane_id(); asm volatile("" : "+v"(lane_)); (void)ws_;
    int tid_ = F.wave * 64 + lane_id(); asm volatile("" : "+v"(tid_));
    const int gw = F.vcu * NWAVES + F.wave, NGW = F.G * NWAVES, lane = lane_;
    const float* psc = P_POOL_SCALE + l * 256;
    const float* goa = P_G_OUT_A + l * 256; const float* gob = P_G_OUT_B + l * 512;
    LAS bf16* wp = (LAS bf16*)F.lds;
    {
        const float* wsrc = P_W_POOL + (size_t)l * 4 * 64 * 64;
        for (int idx = tid_; idx < 4 * 64 * 64; idx += 512) { const int g = idx >> 12, c = (idx >> 6) & 63, d = idx & 63; wp[(g * 64 + d) * WP_PITCH + c] = (bf16)f2bf(wsrc[idx]); }
    }
    {
        constexpr int RB = 4;
        const f32x4 gga = ((const f32x4*)goa)[lane]; const f32x4 gb0 = ((const f32x4*)gob)[2 * lane], gb1 = ((const f32x4*)gob)[2 * lane + 1];
        for (int row0 = gw * RB; row0 < M; row0 += NGW * RB) {
            unsigned long long ua[RB]; v4u ub[RB];
#pragma unroll
            for (int k = 0; k < RB; ++k) { const bf16* mrow = B_MIX + (size_t)(row0 + k) * D; ua[k] = *((const unsigned long long*)mrow + lane); ub[k] = *((const v4u*)(mrow + 256) + lane); }
#pragma unroll
            for (int k = 0; k < RB; ++k) { bf16* mrow = B_MIX + (size_t)(row0 + k) * D;
                { const unsigned long long u = ua[k];
                  const float a0 = bflo((unsigned)u), a1 = bfhi((unsigned)u), a2 = bflo((unsigned)(u >> 32)), a3 = bfhi((unsigned)(u >> 32));
                  const float rs = rsqrtf(wave_sum((a0 * a0 + a1 * a1) + (a2 * a2 + a3 * a3)) * (1.f / 256.f) + EPS);
                  *((unsigned long long*)mrow + lane) = (unsigned long long)pk2(a0 * rs * gga.x, a1 * rs * gga.y) | ((unsigned long long)pk2(a2 * rs * gga.z, a3 * rs * gga.w) << 32); }
                { const v4u u = ub[k];
                  float a[8] = {bflo(u.x), bfhi(u.x), bflo(u.y), bfhi(u.y), bflo(u.z), bfhi(u.z), bflo(u.w), bfhi(u.w)};
                  float ss = 0.f;
#pragma unroll
                  for (int i = 0; i < 8; ++i) ss += a[i] * a[i];
                  const float rs = rsqrtf(wave_sum(ss) * (1.f / 512.f) + EPS);
                  v4u o; o.x = pk2(a[0] * rs * gb0.x, a[1] * rs * gb0.y); o.y = pk2(a[2] * rs * gb0.z, a[3] * rs * gb0.w); o.z = pk2(a[4] * rs * gb1.x, a[5] * rs * gb1.y); o.w = pk2(a[6] * rs * gb1.z, a[7] * rs * gb1.w);
                  *((v4u*)(mrow + 256) + lane) = o; }
            }
        }
    }
    __syncthreads();
    {
        const int r32 = lane & 31, hi = lane >> 5;
        for (int tile = gw; tile < M / 32; tile += NGW) {
            const int row = 32 * tile + r32, t = row % S;
            const bf16* up = B_PROJ + (size_t)row * NP + C_UC + 8 * hi;
            f32x16 acc[4][2];
#pragma unroll
            for (int g = 0; g < 4; ++g) {
                acc[g][0] = f32x16{}; acc[g][1] = f32x16{};
                const int w = 2 << g;
                const float icnt = 1.f / (float)((t + 1 < w) ? t + 1 : w);
#pragma unroll
                for (int ks = 0; ks < 4; ++ks) {
                    const bf16* p0 = up + g * 64 + 16 * ks;
                    const v4u u0 = *(const v4u*)p0;
                    float cur[8] = {bflo(u0.x), bfhi(u0.x), bflo(u0.y), bfhi(u0.y), bflo(u0.z), bfhi(u0.z), bflo(u0.w), bfhi(u0.w)};
                    float sum[8];
#pragma unroll
                    for (int j = 0; j < 8; ++j) sum[j] = cur[j];
#pragma unroll
                    for (int i = 1; i < w; ++i) {
                        if (t - i >= 0) { const v4u ui = *(const v4u*)(p0 - (size_t)i * NP);
                            sum[0] += bflo(ui.x); sum[1] += bfhi(ui.x); sum[2] += bflo(ui.y); sum[3] += bfhi(ui.y); sum[4] += bflo(ui.z); sum[5] += bfhi(ui.z); sum[6] += bflo(ui.w); sum[7] += bfhi(ui.w); }
                    }
                    v4u pk; pk.x = cvtpk(sum[0] * icnt - cur[0], sum[1] * icnt - cur[1]); pk.y = cvtpk(sum[2] * icnt - cur[2], sum[3] * icnt - cur[3]);
                    pk.z = cvtpk(sum[4] * icnt - cur[4], sum[5] * icnt - cur[5]); pk.w = cvtpk(sum[6] * icnt - cur[6], sum[7] * icnt - cur[7]);
                    const bf16x8 af = __builtin_bit_cast(bf16x8, pk);
#pragma unroll
                    for (int nb = 0; nb < 2; ++nb) {
                        const bf16x8 bfr = *(const LAS bf16x8*)(wp + (g * 64 + 32 * nb + r32) * WP_PITCH + 16 * ks + 8 * hi);
                        acc[g][nb] = MFMA32(af, bfr, acc[g][nb]);
                    }
                }
            }
            float ss[16];
#pragma unroll
            for (int r = 0; r < 16; ++r) { float a = 0.f;
#pragma unroll
                for (int g = 0; g < 4; ++g) a += acc[g][0][r] * acc[g][0][r] + acc[g][1][r] * acc[g][1][r];
                a = sum32(a);
                ss[r] = rsqrtf(a * (1.f / 256.f) + EPS); }
            bf16* ob = B_MIX + (size_t)(32 * tile) * D + 768 + r32;
#pragma unroll
            for (int g = 0; g < 4; ++g)
#pragma unroll
                for (int nb = 0; nb < 2; ++nb) { const float sc = psc[g * 64 + 32 * nb + r32];
#pragma unroll
                    for (int r = 0; r < 16; ++r) ob[(size_t)crow(r, hi) * D + g * 64 + 32 * nb] = (bf16)f2bf(acc[g][nb][r] * ss[r] * sc); }
        }
    }
    __syncthreads();
}

template <bool XIN_F32, bool OUT_F32>
__device__ __forceinline__ void phase_finish(Frame& F, const float* xsrc, const float* gpost, const float* gnext  ) {
    unsigned char* ws_ = F.ws; asm volatile("" : "+s"(ws_)); int lane_ = lane_id(); asm volatile("" : "+v"(lane_)); (void)ws_;
    const int gw = F.vcu * NWAVES + F.wave, NGW = F.G * NWAVES, lane = lane_;
    bf16* xb = (bf16*)(ws_ + WS_XB);
    constexpr int RB = 4;
    for (int row0 = gw * RB; row0 < M; row0 += NGW * RB) {
        v4u fu[RB][2]; float x[RB][2][8];
#pragma unroll
        for (int k = 0; k < RB; ++k) { const size_t row = (size_t)(row0 + k);
#pragma unroll
            for (int j = 0; j < 2; ++j) { fu[k][j] = *((const v4u*)(B_F + row * D + 512 * j) + lane);
                if (XIN_F32) { const f32x4 a = *((const f32x4*)(xsrc + row * D + 512 * j) + 2 * lane), c = *((const f32x4*)(xsrc + row * D + 512 * j) + 2 * lane + 1);
                    x[k][j][0] = a.x; x[k][j][1] = a.y; x[k][j][2] = a.z; x[k][j][3] = a.w; x[k][j][4] = c.x; x[k][j][5] = c.y; x[k][j][6] = c.z; x[k][j][7] = c.w; }
                else { const v4u ux = *((const v4u*)(xb + row * D + 512 * j) + lane);
                    x[k][j][0] = bflo(ux.x); x[k][j][1] = bfhi(ux.x); x[k][j][2] = bflo(ux.y); x[k][j][3] = bfhi(ux.y); x[k][j][4] = bflo(ux.z); x[k][j][5] = bfhi(ux.z); x[k][j][6] = bflo(ux.w); x[k][j][7] = bfhi(ux.w); } } }
        float gp[2][8];
#pragma unroll
        for (int j = 0; j < 2; ++j) { const f32x4 a = *((const f32x4*)(gpost + 512 * j) + 2 * lane), c = *((const f32x4*)(gpost + 512 * j) + 2 * lane + 1);
            gp[j][0] = a.x; gp[j][1] = a.y; gp[j][2] = a.z; gp[j][3] = a.w; gp[j][4] = c.x; gp[j][5] = c.y; gp[j][6] = c.z; gp[j][7] = c.w;
 }
#pragma unroll
        for (int k = 0; k < RB; ++k) { const size_t row = (size_t)(row0 + k);
            float f[2][8]; float ss = 0.f;
#pragma unroll
            for (int j = 0; j < 2; ++j) { const v4u u = fu[k][j];
                f[j][0] = bflo(u.x); f[j][1] = bfhi(u.x); f[j][2] = bflo(u.y); f[j][3] = bfhi(u.y); f[j][4] = bflo(u.z); f[j][5] = bfhi(u.z); f[j][6] = bflo(u.w); f[j][7] = bfhi(u.w);
#pragma unroll
                for (int e = 0; e < 8; ++e) ss += f[j][e] * f[j][e]; }
            const float rs = rsqrtf(wave_sum(ss) * (1.f / D) + EPS);
            float s2 = 0.f;
#pragma unroll
            for (int j = 0; j < 2; ++j) {
#pragma unroll
                for (int e = 0; e < 8; ++e) { const float xv = x[k][j][e] + f[j][e] * rs * gp[j][e]; x[k][j][e] = xv; s2 += xv * xv; }
                if (OUT_F32) { f32x4* o = (f32x4*)(F.out + row * D + 512 * j) + 2 * lane;
                    o[0] = (f32x4){x[k][j][0], x[k][j][1], x[k][j][2], x[k][j][3]}; o[1] = (f32x4){x[k][j][4], x[k][j][5], x[k][j][6], x[k][j][7]}; }
                else *((v4u*)(xb + row * D + 512 * j) + lane) = (v4u){pk2(x[k][j][0], x[k][j][1]), pk2(x[k][j][2], x[k][j][3]), pk2(x[k][j][4], x[k][j][5]), pk2(x[k][j][6], x[k][j][7])};
            }
            if (gnext) { const float r2 = rsqrtf(wave_sum(s2) * (1.f / D) + EPS); if (lane == 0) ((float*)(ws_ + WS_RS))[row] = r2; }
        }
    }
}

template <int ACT>
__device__ __forceinline__ void phase_gemm(Frame& F, const bf16* A, const bf16* Bt, bf16* O, int N, int K, const float* rs) {
    asm volatile("" : "+s"(A), "+s"(Bt), "+s"(O), "+s"(rs));
    int bx_ = (int)blockIdx.x, gg_ = F.G; asm volatile("" : "+s"(bx_), "+s"(gg_));
    pg8::Gemm g{A, Bt, M, N, K}; pg8::StaticOrder So; So.init(M, N, gg_, bx_);
    pg8::EpiStore<ACT> E{O, N, rs};
    pg8::gemm_phase<pg8::EpiStore<ACT>, pg8::StaticOrder, true, true>(F.lds, g, So, E, F.wave);
}

constexpr int PH_PER_LAYER = 10, NPHASES = 2 + DEPTH * PH_PER_LAYER;
__global__ void __launch_bounds__(NWAVES * 64, 2) mk_fwd(Args args) {
    extern __shared__ __attribute__((aligned(16))) unsigned char lds[];
    Frame F;
    F.lds = (LAS unsigned char*)lds;
    F.MISC = (volatile LAS unsigned*)(F.lds + MISC_OFF);
    { const int t0_ = threadIdx.x; F.wave = __builtin_amdgcn_readfirstlane(t0_ >> 6);
      for (int u = t0_; u < (LDS_BYTES - LDSCTL_OFF) / 4; u += NWAVES * 64) ((LAS unsigned*)(F.lds + LDSCTL_OFF))[u] = 0u; }
    F.G = gridDim.x; { const int bx = blockIdx.x; F.vcu = (F.G % 8 == 0) ? (bx % 8) * (F.G / 8) + bx / 8 : bx; }
    unsigned char* ws = args.ws; F.ws = ws;
    F.ctl = (gu32*)(ws + WS_CTL);
    F.out = args.out;
    __syncthreads();
    XcdBarrier bar; bar.bar = (unsigned*)(F.ctl + CW_BAR); bar.x = 0; bar.st = F.MISC + 8; bar.wv = 0;
    if (args.use_bar) bar = xcd_barrier_post((unsigned*)(F.ctl + CW_BAR), F.MISC + 8);
    bar.wv = F.wave;
    const int lo = args.ph_lo, hi = args.ph_hi;
    int pid = 0;
    unsigned char* ws_ = F.ws;
#define PH_ON (pid >= lo && pid < hi)
#if PROBE_MASK
    if (blockIdx.x == 0 && F.wave == 0 && lane_id() == 0) { const unsigned long long t_ = __builtin_amdgcn_s_memrealtime(); F.MISC[18] = (unsigned)t_; F.MISC[19] = (unsigned)(t_ >> 32); F.MISC[20] = 0u; F.MISC[21] = 0u; }
#define PH_END(kind) do { if (PH_ON && pid + 1 < hi) xcd_barrier(bar); ++pid; \
        if (blockIdx.x == 0 && F.wave == 0 && lane_id() == 0) { const unsigned long long now_ = __builtin_amdgcn_s_memrealtime(); \
          const unsigned long long last_ = (unsigned long long)F.MISC[18] | ((unsigned long long)F.MISC[19] << 32); unsigned long long acc_ = (unsigned long long)F.MISC[20] | ((unsigned long long)F.MISC[21] << 32); \
          if ((kind) == 3) { const unsigned long long sp_ = (unsigned long long)F.MISC[16] | ((unsigned long long)F.MISC[17] << 32); \
              if ((PROBE_MASK >> 11) & 1) acc_ += sp_ - last_; if ((PROBE_MASK >> 3) & 1) acc_ += now_ - sp_; } \
          else if ((PROBE_MASK >> (kind)) & 1) acc_ += now_ - last_; \
          F.MISC[18] = (unsigned)now_; F.MISC[19] = (unsigned)(now_ >> 32); F.MISC[20] = (unsigned)acc_; F.MISC[21] = (unsigned)(acc_ >> 32); } } while (0)
#else
#define PH_END(kind) do { if (PH_ON && pid + 1 < hi) xcd_barrier(bar); ++pid; } while (0)
#endif

    if (PH_ON && !(SKIPM & 1)) phase_prologue(F, args);
    PH_END(0);
    if (PH_ON && !(SKIPM & 1)) phase_prologue_b(F, args);
    PH_END(0);
    for (int l = 0; l < DEPTH; ++l) {
        unsigned char* ws_ = F.ws; asm volatile("" : "+s"(ws_));
        if (PH_ON && !(SKIPM & 2)) phase_gemm<0>(F, (const bf16*)(ws_ + WS_XB), w_in_t(ws_, l), B_PROJ, NP, D, (const float*)(ws_ + WS_RS));
        PH_END(1);
        if (PH_ON && !(SKIPM & 4)) phase_prep(F, args, l);
        PH_END(2);
        if (PH_ON && !(SKIPM & 8)) phase_attn(F, l);
        PH_END(3);
        if (PH_ON && !(SKIPM & 8)) phase_dsa_attn(F);
        PH_END(4);
        if (PH_ON && !(SKIPM & 16)) phase_merge(F, args, l);
        PH_END(5);
        if (PH_ON && !(SKIPM & 32)) phase_gemm<0>(F, B_MIX, w_out_t(ws_, l), B_F, D, D, nullptr);
        PH_END(6);
        if (PH_ON && !(SKIPM & 64)) { if (l == 0) phase_finish<true, false>(F, P_X_IN, P_G_POST_MIX + l * D, P_G_PRE_MLP + l * D); else phase_finish<false, false>(F, nullptr, P_G_POST_MIX + l * D, P_G_PRE_MLP + l * D); }
        PH_END(7);
        if (PH_ON && !(SKIPM & 128)) phase_gemm<2>(F, (const bf16*)(ws_ + WS_XB), w_up_t(ws_, l), B_HID, FF, D, (const float*)(ws_ + WS_RS));
        PH_END(8);
        if (PH_ON && !(SKIPM & 256)) phase_gemm<0>(F, B_HID, w_dn_t(ws_, l), B_F, D, FF, nullptr);
        PH_END(9);
        if (PH_ON && !(SKIPM & 512)) { if (l + 1 < DEPTH) phase_finish<false, false>(F, nullptr, P_G_POST_MLP + l * D, P_G_PRE_MIX + (l + 1) * D); else phase_finish<false, true>(F, nullptr, P_G_POST_MLP + l * D, nullptr); }
        PH_END(10);
    }
#if PROBE_MASK
    if (blockIdx.x == 0 && F.wave == 0 && lane_id() == 0) { const unsigned long long pr_acc = (unsigned long long)F.MISC[20] | ((unsigned long long)F.MISC[21] << 32);
        const unsigned long long t0_ = __builtin_amdgcn_s_memrealtime(); while (__builtin_amdgcn_s_memrealtime() - t0_ < pr_acc) __builtin_amdgcn_s_sleep(8); }
#endif
#undef PH_ON
#undef PH_END
}

extern "C" void kernel_launch(void* const* d_in, const int* in_sizes, int n_in, void* d_out, int out_size, void* d_ws, size_t ws_size, hipStream_t stream) {
    static int grid = 0;
    if (grid == 0) {
        if (n_in != 20 || in_sizes[0] != M * D || out_size != M * D || ws_size < WS_END) {
            fprintf(stderr, "kernel_launch: unexpected shapes / workspace (n_in %d, in0 %d, out %d, ws %zu < %zu); nothing launched\n", n_in, n_in > 0 ? in_sizes[0] : -1, out_size, ws_size, (size_t)WS_END);
            grid = -1; return; }
        int dev = 0, cus = 0, per_cu = 0;
        if (hipGetDevice(&dev) != hipSuccess || hipDeviceGetAttribute(&cus, hipDeviceAttributeMultiprocessorCount, dev) != hipSuccess) { grid = -1; return; }
        if (hipFuncSetAttribute((const void*)mk_fwd, hipFuncAttributeMaxDynamicSharedMemorySize, LDS_BYTES) != hipSuccess) { fprintf(stderr, "kernel_launch: hipFuncSetAttribute failed\n"); grid = -1; return; }
        if (hipOccupancyMaxActiveBlocksPerMultiprocessor(&per_cu, (const void*)mk_fwd, NWAVES * 64, LDS_BYTES) != hipSuccess || per_cu < 1)
            fprintf(stderr, "kernel_launch: note: occupancy query reports %d workgroups per CU\n", per_cu);
        (void)hipGetLastError();
        grid = cus;
    }
    if (grid < 0) return;
    if (hipMemsetAsync((char*)d_ws + WS_CTL, 0, CTL_ZERO_BYTES, stream) != hipSuccess) return;
    Args a{};
    for (int i = 0; i < 20; ++i) a.in[i] = d_in[i];
    a.out = (float*)d_out; a.ws = (unsigned char*)d_ws; a.pad = 0;
#if MK_MULTI
    for (int p = 0; p < NPHASES; ++p) {
        a.ph_lo = p; a.ph_hi = p + 1; a.use_bar = 0;
        hipLaunchKernelGGL(mk_fwd, dim3(grid), dim3(NWAVES * 64), LDS_BYTES, stream, a);
    }
#else
    a.ph_lo = 0; a.ph_hi = NPHASES; a.use_bar = 1;
    hipLaunchKernelGGL(mk_fwd, dim3(grid), dim3(NWAVES * 64), LDS_BYTES, stream, a);
#endif
}
```

```cpp
#include <hip/hip_runtime.h>
#include <cstdio>
#include <cstdint>

#ifndef PROBE_MASK
#define PROBE_MASK 0
#endif
#ifndef SKIPM
#define SKIPM 0
#endif
#ifndef MK_MULTI
#define MK_MULTI 0
#endif

__device__ __forceinline__ int lane_id() { int l; asm volatile("v_mbcnt_lo_u32_b32 %0, -1, 0\n\tv_mbcnt_hi_u32_b32 %0, -1, %0" : "=v"(l)); return l; }
namespace pg8 {
#define PG8_LAS __attribute__((address_space(3)))
typedef unsigned short bf16_t;
typedef short bf16x8 __attribute__((ext_vector_type(8)));
typedef float f32x4 __attribute__((ext_vector_type(4)));
typedef unsigned u32x4 __attribute__((ext_vector_type(4)));
constexpr int BM = 256, BK = 64, HALF = 128, HTB = HALF * BK * 2, STAGE_BYTES = 8 * HTB, NXCD = 8, WGM = 8;

__host__ __device__ __forceinline__ int lds_byte(int r, int c) { const int st = (r >> 4) * 2 + (c >> 5), rr = r & 15, cc = c & 31, ob = rr * 64 + cc * 2; return st * 1024 + (ob ^ (((ob >> 9) & 1) << 5)); }
__host__ __device__ __forceinline__ void stage_rc(int b, int& R, int& C) { const int st = b / 1024, sb = b % 1024, swz = sb ^ (((sb >> 9) & 1) << 5); R = (st >> 1) * 16 + swz / 64; C = (st & 1) * 32 + (swz % 64) / 2; }
__host__ __device__ __forceinline__ int perm32(int rho) { const int n = rho >> 4, i = rho & 15; return 8 * (i >> 2) + 4 * n + (i & 3); }

struct Unit { int pm, pn; };
struct Gemm { const bf16_t* A; const bf16_t* Bt; int M, N, K; };

struct StaticOrder {
    int nM, nN, nwg, G, c;
    __host__ __device__ void init(int M, int N, int G_, int c_) { nM = M / BM; nN = N / BM; nwg = nM * nN; G = G_; c = c_; }
    __host__ __device__ bool next(int i, Unit& u) const {
        const long L = (long)i * G + c; if (L >= nwg) return false;
        int wgid = (int)L; { const int q = nwg / NXCD, r = nwg % NXCD, xcd = wgid % NXCD, off = wgid / NXCD; wgid = (xcd < r ? xcd * (q + 1) : r * (q + 1) + (xcd - r) * q) + off; }
        const int nig = WGM * nN, gid = wgid / nig, fm = gid * WGM, gsz = (nM - fm) < WGM ? (nM - fm) : WGM;
        u.pm = fm + ((wgid % nig) % gsz); u.pn = (wgid % nig) / gsz; return true;
    }
    __device__ __forceinline__ void a_ready(const Unit&) const {}
    __device__ __forceinline__ void done(const Unit&) const {}
};

__device__ __forceinline__ unsigned cvt_pk_bf16(float lo, float hi) { unsigned r; asm volatile("v_cvt_pk_bf16_f32 %0, %1, %2" : "=v"(r) : "v"(lo), "v"(hi)); return r; }

template <int ACT  > struct EpiStore {
    static constexpr bool PERM = true, AFTER_DRAIN = false;
    bf16_t* O; int ldc; const float* rs;
    __device__ __forceinline__ void operator()(const f32x4 (&acc)[2][2][4][2], const Unit& u, int wr, int wc, int fr, int fq) const {
        const int row0 = u.pm * BM + wr * 64 + fr;
        const int col0 = u.pn * BM + wc * 32 + 8 * fq;
        float sc[2][4];
#pragma unroll
        for (int ai = 0; ai < 2; ++ai)
#pragma unroll
            for (int m = 0; m < 4; ++m) sc[ai][m] = rs ? rs[row0 + ai * HALF + m * 16] : 1.f;
#pragma unroll
        for (int ai = 0; ai < 2; ++ai)
#pragma unroll
            for (int m = 0; m < 4; ++m) { const int row = row0 + ai * HALF + m * 16; bf16_t* rowp = O + (size_t)row * ldc + col0;
#pragma unroll
                for (int bj = 0; bj < 2; ++bj) { f32x4 v0 = acc[ai][bj][m][0] * sc[ai][m], v1 = acc[ai][bj][m][1] * sc[ai][m];
                    if (ACT == 2) {
#pragma unroll
                        for (int e = 0; e < 4; ++e) { const float a = fmaxf(v0[e], 0.f), b = fmaxf(v1[e], 0.f); v0[e] = a * a; v1[e] = b * b; } }
                    u32x4 w; w.x = cvt_pk_bf16(v0[0], v0[1]); w.y = cvt_pk_bf16(v0[2], v0[3]); w.z = cvt_pk_bf16(v1[0], v1[1]); w.w = cvt_pk_bf16(v1[2], v1[3]);
                    *(u32x4*)(rowp + bj * HALF) = w; } }
    }
};

template <class Epi, class Sched, bool ALIGN_EPI = false, bool SP2 = false>
__device__ __forceinline__ void gemm_phase(PG8_LAS unsigned char* lds, const Gemm g, const Sched& S, const Epi& E, int wave_) {
    int tid_ = wave_ * 64 + lane_id(); asm volatile("" : "+v"(tid_));
    const int tid = tid_, wid = __builtin_amdgcn_readfirstlane(tid >> 6), lane = tid & 63, wr = wid >> 2, wc = wid & 3, fr = lane & 15, fq = lane >> 4;
    const int K = g.K, nt = K / BK;
    unsigned voffA[2], voffB[2];
#pragma unroll
    for (int i = 0; i < 2; ++i) { int R, C; stage_rc(tid * 16 + i * 8192, R, C); const int Rb = Epi::PERM ? ((R & ~31) + perm32(R & 31)) : R;
        voffA[i] = (unsigned)(R * K + C) * 2u; voffB[i] = (unsigned)(Rb * K + C) * 2u; }
    const size_t kstep = (size_t)(BK * 2);
    const size_t hstep = (size_t)HALF * K * 2;
    const size_t tstep = 2 * hstep;
    const unsigned ldsw = (unsigned)wid * 1024u;
    const int aoff = lds_byte(wr * 64 + fr, fq * 8), boff = lds_byte(wc * 32 + fr, fq * 8);
#define PG8_SA(b, h) (((b) * 2 + (h)) * HTB)
#define PG8_SB(b, h) ((4 + (b) * 2 + (h)) * HTB)
#define PG8_STAGE(bufoff, gbase, voff) do { _Pragma("unroll") for (int _i = 0; _i < 2; ++_i) \
        __builtin_amdgcn_global_load_lds((const unsigned*)((const char*)(gbase) + (voff)[_i]), (PG8_LAS unsigned*)(lds + (bufoff) + ldsw + _i * 8192), 16, 0, 0); } while (0)
#define PG8_LDA(dst, b, h) do { _Pragma("unroll") for (int m = 0; m < 4; ++m) _Pragma("unroll") for (int k = 0; k < 2; ++k) dst[m][k] = *(const PG8_LAS bf16x8*)(lds + PG8_SA(b, h) + aoff + m * 2048 + k * 1024); } while (0)
#define PG8_LDB(dst, b, h) do { _Pragma("unroll") for (int n = 0; n < 2; ++n) _Pragma("unroll") for (int k = 0; k < 2; ++k) dst[n][k] = *(const PG8_LAS bf16x8*)(lds + PG8_SB(b, h) + boff + n * 2048 + k * 1024); } while (0)
#define PG8_MMA(ai, bj, At, Bt) do { __builtin_amdgcn_s_setprio(1); _Pragma("unroll") for (int m = 0; m < 4; ++m) _Pragma("unroll") for (int n = 0; n < 2; ++n) _Pragma("unroll") for (int k = 0; k < 2; ++k) \
        acc[ai][bj][m][n] = __builtin_amdgcn_mfma_f32_16x16x32_bf16(Bt[n][k], At[m][k], acc[ai][bj][m][n], 0, 0, 0); __builtin_amdgcn_s_setprio(0); } while (0)
#define PG8_WAIT_V(n) asm volatile("s_waitcnt vmcnt(" #n ")" ::: "memory")
#define PG8_WAIT_L(n) asm volatile("s_waitcnt lgkmcnt(" #n ")" ::: "memory")
#define PG8_BAR __builtin_amdgcn_s_barrier()
#define PG8_SCHED __builtin_amdgcn_sched_barrier(0)
    Unit cur, nxt; int ui = 0;
    if (!S.next(0, cur)) return;
    f32x4 acc[2][2][4][2];
#pragma unroll
    for (int a = 0; a < 2; ++a)
#pragma unroll
        for (int b = 0; b < 2; ++b)
#pragma unroll
            for (int m = 0; m < 4; ++m)
#pragma unroll
                for (int n = 0; n < 2; ++n) acc[a][b][m][n] = (f32x4){0.f, 0.f, 0.f, 0.f};
    bf16x8 At[4][2], B0[2][2], B1[2][2];
    const char* cA = (const char*)g.A + (size_t)cur.pm * tstep; const char* cB = (const char*)g.Bt + (size_t)cur.pn * tstep;
    S.a_ready(cur);
    if constexpr (SP2) {
        PG8_STAGE(PG8_SB(0, 0), cB, voffB); PG8_STAGE(PG8_SB(0, 1), cB + hstep, voffB); PG8_STAGE(PG8_SA(0, 0), cA, voffA); PG8_STAGE(PG8_SA(0, 1), cA + hstep, voffA);
        if (wr == 1) PG8_BAR;
        PG8_WAIT_V(2); PG8_BAR;
        PG8_STAGE(PG8_SB(1, 0), cB + kstep, voffB); PG8_STAGE(PG8_SA(1, 0), cA + kstep, voffA); PG8_STAGE(PG8_SB(1, 1), cB + hstep + kstep, voffB);
        PG8_WAIT_V(6); PG8_BAR;
    } else {
        PG8_STAGE(PG8_SB(0, 0), cB, voffB); PG8_STAGE(PG8_SA(0, 0), cA, voffA); PG8_STAGE(PG8_SB(0, 1), cB + hstep, voffB); PG8_STAGE(PG8_SA(0, 1), cA + hstep, voffA);
        if (wr == 1) PG8_BAR;
        PG8_WAIT_V(4); PG8_BAR;
        PG8_STAGE(PG8_SB(1, 0), cB + kstep, voffB); PG8_STAGE(PG8_SA(1, 0), cA + kstep, voffA); PG8_STAGE(PG8_SB(1, 1), cB + hstep + kstep, voffB);
        PG8_WAIT_V(6); PG8_BAR;
    }
    for (;;) {
        const bool has_next = S.next(ui + 1, nxt);
        const char* nA = has_next ? (const char*)g.A + (size_t)nxt.pm * tstep : cA; const char* nB = has_next ? (const char*)g.Bt + (size_t)nxt.pn * tstep : cB;
        for (int t = 0; t < nt; t += 2) {
            const bool last = (t == nt - 2);
            const char* a1 = cA + (size_t)(t + 1) * kstep;
            const char* a2 = last ? nA : cA + (size_t)(t + 2) * kstep; const char* b2 = last ? nB : cB + (size_t)(t + 2) * kstep;
            const char* a3 = a2 + kstep; const char* b3 = b2 + kstep;
            if (last && has_next) S.a_ready(nxt);
            if constexpr (SP2) {
            PG8_LDB(B0, 0, 0); PG8_LDB(B1, 0, 1); PG8_SCHED; PG8_LDA(At, 0, 0); PG8_STAGE(PG8_SA(1, 1), a1 + hstep, voffA);
            PG8_WAIT_V(8); PG8_WAIT_L(0); PG8_BAR; PG8_MMA(0, 0, At, B0); PG8_MMA(0, 1, At, B1); PG8_BAR; PG8_SCHED;
            PG8_LDA(At, 0, 1); PG8_STAGE(PG8_SB(0, 0), b2, voffB); PG8_STAGE(PG8_SB(0, 1), b2 + hstep, voffB); PG8_STAGE(PG8_SA(0, 0), a2, voffA);
            PG8_WAIT_V(8); PG8_WAIT_L(0); PG8_BAR; PG8_MMA(1, 0, At, B0); PG8_MMA(1, 1, At, B1); PG8_BAR; PG8_SCHED;
            PG8_LDB(B0, 1, 0); PG8_LDB(B1, 1, 1); PG8_SCHED; PG8_LDA(At, 1, 0); PG8_STAGE(PG8_SA(0, 1), a2 + hstep, voffA);
            PG8_WAIT_V(8); PG8_WAIT_L(0); PG8_BAR; PG8_MMA(0, 0, At, B0); PG8_MMA(0, 1, At, B1); PG8_BAR; PG8_SCHED;
            PG8_LDA(At, 1, 1); PG8_STAGE(PG8_SB(1, 0), b3, voffB); PG8_STAGE(PG8_SB(1, 1), b3 + hstep, voffB); PG8_STAGE(PG8_SA(1, 0), a3, voffA);
            PG8_WAIT_V(8); PG8_WAIT_L(0); PG8_BAR; PG8_MMA(1, 0, At, B0); PG8_MMA(1, 1, At, B1); PG8_BAR; PG8_SCHED;
            } else {
            PG8_LDB(B0, 0, 0); PG8_SCHED; PG8_LDA(At, 0, 0); PG8_STAGE(PG8_SA(1, 1), a1 + hstep, voffA);
            PG8_WAIT_L(8); PG8_BAR; PG8_WAIT_L(0); PG8_MMA(0, 0, At, B0); PG8_BAR; PG8_SCHED;
            PG8_LDB(B1, 0, 1); PG8_STAGE(PG8_SB(0, 0), b2, voffB);
            PG8_BAR; PG8_WAIT_L(0); PG8_MMA(0, 1, At, B1); PG8_BAR;
            PG8_LDA(At, 0, 1); PG8_STAGE(PG8_SA(0, 0), a2, voffA);
            PG8_BAR; PG8_WAIT_L(0); PG8_MMA(1, 0, At, B0); PG8_BAR; PG8_SCHED;
            PG8_STAGE(PG8_SB(0, 1), b2 + hstep, voffB);
            PG8_WAIT_V(6); PG8_BAR; PG8_MMA(1, 1, At, B1); PG8_BAR;
            PG8_LDB(B0, 1, 0); PG8_SCHED; PG8_LDA(At, 1, 0); PG8_STAGE(PG8_SA(0, 1), a2 + hstep, voffA);
            PG8_WAIT_L(8); PG8_BAR; PG8_WAIT_L(0); PG8_MMA(0, 0, At, B0); PG8_BAR; PG8_SCHED;
            PG8_LDB(B1, 1, 1); PG8_STAGE(PG8_SB(1, 0), b3, voffB);
            PG8_BAR; PG8_WAIT_L(0); PG8_MMA(0, 1, At, B1); PG8_BAR;
            PG8_LDA(At, 1, 1); PG8_STAGE(PG8_SA(1, 0), a3, voffA);
            PG8_BAR; PG8_WAIT_L(0); PG8_MMA(1, 0, At, B0); PG8_BAR; PG8_SCHED;
            PG8_STAGE(PG8_SB(1, 1), b3 + hstep, voffB);
            PG8_WAIT_V(6); PG8_BAR; PG8_MMA(1, 1, At, B1); PG8_BAR;
            }
        }
        if constexpr (ALIGN_EPI) { if (wr == 0) PG8_BAR; }
        if constexpr (!Epi::AFTER_DRAIN) { E(acc, cur, wr, wc, fr, fq); S.done(cur); }
        if (!has_next) break;
#pragma unroll
        for (int a = 0; a < 2; ++a)
#pragma unroll
            for (int b = 0; b < 2; ++b)
#pragma unroll
                for (int m = 0; m < 4; ++m)
#pragma unroll
                    for (int n = 0; n < 2; ++n) acc[a][b][m][n] = (f32x4){0.f, 0.f, 0.f, 0.f};
        cur = nxt; cA = nA; cB = nB; ++ui;
        if constexpr (ALIGN_EPI) { if (wr == 1) PG8_BAR; }
    }
    PG8_WAIT_V(0);
    if constexpr (!ALIGN_EPI) { if (wr == 0) PG8_BAR; }
    PG8_BAR;
#undef PG8_SA
#undef PG8_SB
#undef PG8_STAGE
#undef PG8_LDA
#undef PG8_LDB
#undef PG8_MMA
#undef PG8_WAIT_V
#undef PG8_WAIT_L
#undef PG8_BAR
#undef PG8_SCHED
}
}

constexpr int NWAVES = 8;
constexpr int BATCH = 32, S = 2048, D = 1024, DEPTH = 4, FF = 4096;
constexpr int M = BATCH * S;
constexpr int NP = 2304;
constexpr int DIN = 2108;
constexpr int C_QA = 0, C_CKV = 256, C_QIDX = 384, C_QB = 512, C_KCMP = 1024, C_VCMP = 1152, C_KSLC = 1280, C_VSLC = 1408, C_KWIN = 1536, C_VWIN = 1664,
              C_UC = 1792, C_KIDX = 2048, C_WIDX = 2080, C_GATE = 2084, C_KA = 2112, C_VA = 2176;
constexpr int NC = 127;
constexpr float EPS = 1e-6f;
constexpr float NEGF = -1e30f;

__host__ __device__ __forceinline__ int win_src(int n) {
    if (n < 512) return n;
    if (n < 1024) return 548 + (n - 512);
    if (n < 1792) return 1060 + (n - 1024);
    if (n < 2048) return 1852 + (n - 1792);
    if (n < 2080) return 512 + (n - 2048);
    if (n < 2084) return 544 + (n - 2080);
    if (n < 2108) return 1828 + (n - 2084);
    return -1;
}

constexpr size_t MiB = 1u << 20;
constexpr size_t WS_CTL = 0, CTL_ZERO_BYTES = 1 * MiB;
constexpr size_t WS_W = 2 * MiB;
constexpr size_t W_IN_B = (size_t)NP * D * 2, W_OUT_B = (size_t)D * D * 2, W_UP_B = (size_t)FF * D * 2, W_DN_B = (size_t)D * FF * 2;
constexpr size_t W_LAYER_B = W_IN_B + W_OUT_B + W_UP_B + W_DN_B;
constexpr size_t WS_ROPE = 96 * MiB;
constexpr size_t WS_WCT = 102 * MiB;
constexpr size_t WS_CB = 104 * MiB;
constexpr size_t WS_KCB = 124 * MiB, WS_VCB = 125 * MiB;
constexpr size_t WS_KA = 108 * MiB;
constexpr size_t WS_RS = 126 * MiB;
constexpr size_t WS_F = 256 * MiB;
constexpr size_t WS_PROJ = 384 * MiB;
constexpr size_t WS_MIX = 672 * MiB;
constexpr size_t WS_MASK = 800 * MiB;
constexpr size_t WS_HID = 384 * MiB;
constexpr size_t WS_XB = 896 * MiB;
constexpr size_t WS_END = 1024 * MiB;
static_assert(WS_W + DEPTH * W_LAYER_B <= WS_ROPE, "weights");
static_assert(WS_ROPE + (size_t)M * 24 * 4 <= WS_WCT && WS_WCT + (size_t)DEPTH * 2 * 128 * 1024 * 2 <= WS_CB, "map");
static_assert(WS_PROJ + (size_t)M * NP * 2 <= WS_MIX && WS_MIX + (size_t)M * D * 2 <= WS_END && WS_HID + (size_t)M * FF * 2 <= WS_END, "map2");

constexpr int CW_BAR = 4096;
constexpr int RING_BYTES = 131072;
constexpr int LDSCTL_OFF = RING_BYTES, MISC_OFF = LDSCTL_OFF + 320;
constexpr int LDS_BYTES = 147456;
constexpr int WSCR = 16384;

#define GAS __attribute__((address_space(1)))
#define LAS __attribute__((address_space(3)))
typedef unsigned short bf16;
typedef unsigned v4u __attribute__((ext_vector_type(4)));
typedef float f32x4 __attribute__((ext_vector_type(4)));
typedef GAS unsigned gu32;
#define LDS_FENCE() asm volatile("s_waitcnt lgkmcnt(0)" ::: "memory")
__device__ __forceinline__ unsigned f2bf(float f) { unsigned u = __builtin_bit_cast(unsigned, f); return (u + 0x7fffu + ((u >> 16) & 1u)) >> 16; }
__device__ __forceinline__ unsigned pk2(float lo, float hi) { return f2bf(lo) | (f2bf(hi) << 16); }
__device__ __forceinline__ float bf2f(bf16 u) { return __builtin_bit_cast(float, (unsigned)u << 16); }
__device__ __forceinline__ float bflo(unsigned u) { return __builtin_bit_cast(float, u << 16); }
__device__ __forceinline__ float bfhi(unsigned u) { return __builtin_bit_cast(float, u & 0xffff0000u); }

#define XB_TMO      128
#define XB_XCNT(j)  (256  + 64 * (j))
#define XB_XSUB(j)  (1280 + 64 * (j))
#define XB_XGEN(j)  (2304 + 64 * (j))
#define XB_TOP      3328
#define XB_TOPGEN   3392
#define XCD_BAR_WORDS 3456
#define XB_SPIN_CAP (1u << 22)

__device__ __forceinline__ unsigned xb_ld(unsigned* p)              { return __hip_atomic_load(p, __ATOMIC_RELAXED, __HIP_MEMORY_SCOPE_AGENT); }
__device__ __forceinline__ unsigned xb_add(unsigned* p, unsigned v) { return __hip_atomic_fetch_add(p, v, __ATOMIC_RELAXED, __HIP_MEMORY_SCOPE_AGENT); }
__device__ __forceinline__ unsigned xb_xcc_id() { return (unsigned)__builtin_amdgcn_s_getreg((3 << 11) | 20) & 0xFu; }
#define XB_SPIN(cond, bar) do { unsigned _sp = 0; while (cond) { __builtin_amdgcn_s_sleep(1); \
    if ((++_sp & 255u) == 0u) { if (xb_ld(&(bar)[XB_TMO])) break; if (_sp > XB_SPIN_CAP) { atomicAdd(&(bar)[XB_TMO], 1u); break; } } } } while (0)

struct XcdBarrier { unsigned* bar; unsigned x; volatile LAS unsigned* st; int wv; };

__device__ __forceinline__ XcdBarrier xcd_barrier_post(unsigned* bar, volatile LAS unsigned* st) {
    XcdBarrier b; b.bar = bar; b.x = xb_xcc_id(); b.st = st; b.wv = 0;
    if (threadIdx.x == 0) (void)xb_add(&bar[XB_XCNT(b.x)], 1u);
    return b;
}
__device__ __forceinline__ void xcd_barrier_complete(unsigned* bar, unsigned x, unsigned& nloc, unsigned& nx) {
    const unsigned G = gridDim.x * gridDim.y * gridDim.z;
    unsigned sum, cnt, mine, sp = 0u;
    for (;;) {
        sum = 0u; cnt = 0u; mine = 0u;
#pragma unroll
        for (unsigned j = 0; j < 16; ++j) { const unsigned c = xb_ld(&bar[XB_XCNT(j)]); sum += c; cnt += (c > 0u) ? 1u : 0u; mine = (j == x) ? c : mine; }
        if (sum == G) break;
        __builtin_amdgcn_s_sleep(1);
        if ((++sp & 255u) == 0u) { if (xb_ld(&bar[XB_TMO])) break; if (sp > XB_SPIN_CAP) { atomicAdd(&bar[XB_TMO], 1u); break; } }
    }
    nloc = mine > 0u ? mine : 1u; nx = cnt > 0u ? cnt : 1u;
}
__device__ __forceinline__ void xcd_barrier(const XcdBarrier& b) {
    asm volatile("s_waitcnt vmcnt(0)" ::: "memory");
    __syncthreads();
    if (b.wv == 0 && lane_id() == 0) {
        unsigned* bar = b.bar; asm volatile("" : "+s"(bar));
        __builtin_amdgcn_s_waitcnt(0);
        unsigned nloc = b.st[0], nx = b.st[1];
        unsigned bx_ = b.x; asm volatile("" : "+s"(bx_));
        if (nloc == 0u) { xcd_barrier_complete(bar, bx_, nloc, nx); b.st[0] = nloc; b.st[1] = nx; }
        const unsigned old = xb_add(&bar[XB_XSUB(bx_)], 1u);
        const unsigned gen = old / nloc;
        if (old + 1u == (gen + 1u) * nloc) {
            __builtin_amdgcn_fence(__ATOMIC_RELEASE, "agent");
            asm volatile("s_waitcnt vmcnt(0)" ::: "memory");
            const unsigned og = xb_add(&bar[XB_TOP], 1u);
            const unsigned tg = og / nx;
            if (og + 1u == (tg + 1u) * nx) xb_add(&bar[XB_TOPGEN], 1u);
            else XB_SPIN(xb_ld(&bar[XB_TOPGEN]) == tg, bar);
            __builtin_amdgcn_fence(__ATOMIC_ACQUIRE, "agent");
            xb_add(&bar[XB_XGEN(bx_)], 1u);
            asm volatile("s_waitcnt vmcnt(0)" ::: "memory");
        } else {
            XB_SPIN(xb_ld(&bar[XB_XGEN(bx_)]) == gen, bar);
            __builtin_amdgcn_fence(__ATOMIC_ACQUIRE, "agent");
            asm volatile("s_waitcnt vmcnt(0)" ::: "memory");
        }
    }
    __syncthreads();
}

struct Frame {
    LAS unsigned char* lds;
    volatile LAS unsigned* MISC;
    gu32* ctl;
    int wave, vcu, G;
    float* out; unsigned char* ws;
};
struct Args { const void* in[20]; float* out; unsigned char* ws; int ph_lo, ph_hi, use_bar, pad; };
#define IN_F(k) ((const float*)args.in[k])
#define P_X_IN IN_F(0)
#define P_POS ((const int*)args.in[1])
#define P_W_IN IN_F(2)
#define P_G_KV_A IN_F(3)
#define P_W_KV_UP IN_F(4)
#define P_W_CMP_K IN_F(5)
#define P_W_CMP_V IN_F(6)
#define P_PE_K IN_F(7)
#define P_PE_V IN_F(8)
#define P_W_POOL IN_F(9)
#define P_POOL_SCALE IN_F(10)
#define P_G_OUT_A IN_F(11)
#define P_G_OUT_B IN_F(12)
#define P_W_OUT IN_F(13)
#define P_G_PRE_MIX IN_F(14)
#define P_G_POST_MIX IN_F(15)
#define P_G_PRE_MLP IN_F(16)
#define P_G_POST_MLP IN_F(17)
#define P_W_UP IN_F(18)
#define P_W_DOWN IN_F(19)
#define B_ROPE ((float*)(ws_ + WS_ROPE))
#define B_F ((bf16*)(ws_ + WS_F))
#define B_PROJ ((bf16*)(ws_ + WS_PROJ))
#define B_MIX ((bf16*)(ws_ + WS_MIX))
#define B_HID ((bf16*)(ws_ + WS_HID))

template <int CTRL> __device__ __forceinline__ int dpp_i(int v) { return __builtin_amdgcn_update_dpp(0, v, CTRL, 0xF, 0xF, true); }
template <int CTRL> __device__ __forceinline__ float dpp_f(float v) { return __builtin_bit_cast(float, dpp_i<CTRL>(__builtin_bit_cast(int, v))); }
__device__ __forceinline__ int swz16_i(int v) { return __builtin_amdgcn_ds_swizzle(v, (16 << 10) | 0x1F); }
__device__ __forceinline__ float swz16_f(float v) { return __builtin_bit_cast(float, swz16_i(__builtin_bit_cast(int, v))); }
struct HalfPair { unsigned lo, hi; };
__device__ __forceinline__ HalfPair halves_u(unsigned v) { const auto rr = __builtin_amdgcn_permlane32_swap(v, v, false, false); HalfPair h; h.lo = rr[0]; h.hi = rr[1]; return h; }
__device__ __forceinline__ float other_half_f(float v, int hi) { const HalfPair h = halves_u(__builtin_bit_cast(unsigned, v)); return __builtin_bit_cast(float, hi ? h.lo : h.hi); }
__device__ __forceinline__ float sum32(float v) {
    v += dpp_f<0xB1>(v); v += dpp_f<0x4E>(v); v += dpp_f<0x141>(v); v += dpp_f<0x140>(v); v += swz16_f(v); return v; }
__device__ __forceinline__ float wave_sum(float v) { v = sum32(v); const HalfPair h = halves_u(__builtin_bit_cast(unsigned, v)); return __builtin_bit_cast(float, h.lo) + __builtin_bit_cast(float, h.hi); }
__device__ __forceinline__ float max_halves(float v) { const HalfPair h = halves_u(__builtin_bit_cast(unsigned, v)); return fmaxf(__builtin_bit_cast(float, h.lo), __builtin_bit_cast(float, h.hi)); }
__device__ __forceinline__ unsigned or_halves(unsigned v) { const HalfPair h = halves_u(v); return h.lo | h.hi; }
__device__ __forceinline__ unsigned or32(unsigned v) { v |= (unsigned)dpp_i<0xB1>((int)v); v |= (unsigned)dpp_i<0x4E>((int)v); v |= (unsigned)dpp_i<0x141>((int)v); v |= (unsigned)dpp_i<0x140>((int)v); v |= (unsigned)swz16_i((int)v); return v; }

__constant__ double c_rope_inv[12] = {1.0, 0.19392274474868576, 0.03760603093086393, 0.007292664737217109, 0.001414213562373095, 0.0002742481756762073, 5.318295896944988e-05, 1.031338537721246e-05,
                                       1.0, 0.03760603093086393, 0.001414213562373095, 5.318295896944988e-05};
template <int MODE, bool GAIN = false>
__device__ __forceinline__ void transpose_item(const float* W, int K, int Nsrc, int nblk, bf16* WT, LAS float* scr, int item, int lane, const float* gk = nullptr) {
    const int kb = item / nblk, nb = item % nblk, k0 = 64 * kb, n0 = 32 * nb;
    if (MODE && n0 >= C_KA && n0 < C_KA + 128) return;
    const int np = n0 + (lane & 31);
    const int src = MODE ? win_src(np) : np;
#pragma unroll 16
    for (int i = 0; i < 32; ++i) { const int kk = 2 * i + (lane >> 5); scr[kk * 33 + (lane & 31)] = (src >= 0) ? W[(size_t)(k0 + kk) * Nsrc + src] * (GAIN ? gk[k0 + kk] : 1.f) : 0.f; }
    LDS_FENCE();
    const int c = lane & 7;
#pragma unroll
    for (int j = 0; j < 4; ++j) { const int n = (lane >> 3) + 8 * j; const LAS float* s = scr + (8 * c) * 33 + n;
        v4u o; o.x = pk2(s[0 * 33], s[1 * 33]); o.y = pk2(s[2 * 33], s[3 * 33]); o.z = pk2(s[4 * 33], s[5 * 33]); o.w = pk2(s[6 * 33], s[7 * 33]);
        *(v4u*)(WT + (size_t)(n0 + n) * K + k0 + 8 * c) = o; }
    LDS_FENCE();
}

__device__ __forceinline__ bf16* w_in_t(unsigned char* ws_, int l)  { return (bf16*)(ws_ + WS_W + (size_t)l * W_LAYER_B); }
__device__ __forceinline__ bf16* w_out_t(unsigned char* ws_, int l) { return (bf16*)(ws_ + WS_W + (size_t)l * W_LAYER_B + W_IN_B); }
__device__ __forceinline__ bf16* w_up_t(unsigned char* ws_, int l)  { return (bf16*)(ws_ + WS_W + (size_t)l * W_LAYER_B + W_IN_B + W_OUT_B); }
__device__ __forceinline__ bf16* w_dn_t(unsigned char* ws_, int l)  { return (bf16*)(ws_ + WS_W + (size_t)l * W_LAYER_B + W_IN_B + W_OUT_B + W_UP_B); }

__device__ __forceinline__ void phase_prologue(Frame& F, const Args& args) {
    unsigned char* ws_ = F.ws; asm volatile("" : "+s"(ws_)); int lane_ = lane_id(); asm volatile("" : "+v"(lane_)); (void)ws_;
    LAS float* scr = (LAS float*)(F.lds + F.wave * WSCR);
    const int gw = F.vcu * NWAVES + F.wave, NGW = F.G * NWAVES;
    constexpr int I_IN = (D / 64) * (NP / 32), I_OUT = (D / 64) * (D / 32), I_UP = (D / 64) * (FF / 32), I_DN = (FF / 64) * (D / 32);
    for (int it = gw; it < DEPTH * I_IN; it += NGW) { const int l = it / I_IN, r = it % I_IN; transpose_item<1, true>(P_W_IN + (size_t)l * D * DIN, D, DIN, NP / 32, w_in_t(ws_, l), scr, r, lane_, P_G_PRE_MIX + l * D); }
    for (int it = gw; it < DEPTH * I_OUT; it += NGW) { const int l = it / I_OUT, r = it % I_OUT; transpose_item<0>(P_W_OUT + (size_t)l * D * D, D, D, D / 32, w_out_t(ws_, l), scr, r, lane_); }
    for (int it = gw; it < DEPTH * I_UP; it += NGW) { const int l = it / I_UP, r = it % I_UP; transpose_item<0, true>(P_W_UP + (size_t)l * D * FF, D, FF, FF / 32, w_up_t(ws_, l), scr, r, lane_, P_G_PRE_MLP + l * D); }
    for (int it = gw; it < DEPTH * I_DN; it += NGW) { const int l = it / I_DN, r = it % I_DN; transpose_item<0>(P_W_DOWN + (size_t)l * FF * D, FF, D, D / 32, w_dn_t(ws_, l), scr, r, lane_); }
    for (int it = gw; it < DEPTH * D * 2; it += NGW) {
        const int l = it / (D * 2), r = it % (D * 2), k = r >> 1, n = lane_ + 64 * (r & 1);
        const float* wi = P_W_IN + ((size_t)l * D + k) * DIN + 256; const float* gk = P_G_KV_A + l * 128; const float* wu = P_W_KV_UP + (size_t)l * 128 * 128 + n;
        float acc = 0.f;
#pragma unroll 32
        for (int j = 0; j < 128; ++j) acc += (wi[j] * gk[j]) * wu[j * 128];
        w_in_t(ws_, l)[(size_t)(C_KA + n) * D + k] = (bf16)f2bf(acc * P_G_PRE_MIX[l * D + k]);
    }
    for (int it = gw; it < DEPTH * 2 * 2 * 32; it += NGW) {
        const int lk = it >> 6, part = (it >> 5) & 1, r = it & 31, l = lk >> 1, kv = lk & 1;
        const float* W = (kv ? P_W_CMP_V : P_W_CMP_K) + (size_t)l * 32 * 64 * 64 + (size_t)part * 1024 * 64;
        transpose_item<0>(W, 1024, 64, 2, (bf16*)(ws_ + WS_WCT) + ((size_t)lk * 128 + part * 64) * 1024, scr, r, lane_);
    }
    {
        __syncthreads();
        LAS float* part = (LAS float*)F.lds;
        for (int it = F.vcu; it < DEPTH * 2; it += F.G) {
            const int l = it >> 1, kv = it & 1;
            const float* W = (kv ? P_W_CMP_V : P_W_CMP_K) + (size_t)l * 32 * 64 * 64 + lane_; const float* pe = (kv ? P_PE_V : P_PE_K) + l * 32 * 64;
            float acc = 0.f;
#pragma unroll 16
            for (int k = F.wave * 256; k < F.wave * 256 + 256; ++k) acc += pe[k] * W[(size_t)k * 64];
            part[F.wave * 64 + lane_] = acc;
            __syncthreads();
            if (F.wave == 0) { float t = 0.f;
#pragma unroll
                for (int w8 = 0; w8 < 8; ++w8) t += part[w8 * 64 + lane_];
                ((float*)(ws_ + WS_CB))[it * 64 + lane_] = t; }
            __syncthreads();
        }
    }
}
__device__ __forceinline__ void phase_prologue_b(Frame& F, const Args& args) {
    unsigned char* ws_ = F.ws; asm volatile("" : "+s"(ws_)); int lane_ = lane_id(); asm volatile("" : "+v"(lane_)); (void)ws_;
    const int gw = F.vcu * NWAVES + F.wave, NGW = F.G * NWAVES;
    for (int e = gw * 64 + lane_; e < M * 12; e += NGW * 64) {
        const int row = e / 12, i = e % 12;
        const double inv = c_rope_inv[i];
        const double a = (double)P_POS[row] * inv;
        const double k = __builtin_rint(a * 0.15915494309189535);
        const float r = (float)(a - k * 6.283185307179586);
        const float c = __builtin_cosf(r), s = __builtin_sinf(r);
        float* t = B_ROPE + (size_t)row * 24;
        if (i < 8) { t[i] = c; t[8 + i] = s; } else { t[16 + (i - 8)] = c; t[20 + (i - 8)] = s; }
    }
    for (int m0 = gw * 4; m0 < M; m0 += NGW * 4) {
        f32x4 v[4][4];
#pragma unroll
        for (int k = 0; k < 4; ++k) { const f32x4* xr = (const f32x4*)(P_X_IN + (size_t)(m0 + k) * D) + lane_;
#pragma unroll
            for (int j = 0; j < 4; ++j) v[k][j] = xr[64 * j]; }
#pragma unroll
        for (int k = 0; k < 4; ++k) { float sq = 0.f;
#pragma unroll
            for (int j = 0; j < 4; ++j) sq += (v[k][j].x * v[k][j].x + v[k][j].y * v[k][j].y) + (v[k][j].z * v[k][j].z + v[k][j].w * v[k][j].w);
            const float rsv = rsqrtf(wave_sum(sq) * (1.f / D) + EPS);
            unsigned long long* o8 = (unsigned long long*)((bf16*)(ws_ + WS_XB) + (size_t)(m0 + k) * D) + lane_;
#pragma unroll
            for (int j = 0; j < 4; ++j) o8[64 * j] = (unsigned long long)pk2(v[k][j].x, v[k][j].y) | ((unsigned long long)pk2(v[k][j].z, v[k][j].w) << 32);
            if (lane_ == 0) ((float*)(ws_ + WS_RS))[m0 + k] = rsv; }
    }
}

typedef short bf16x8 __attribute__((ext_vector_type(8)));
typedef short s16x4 __attribute__((ext_vector_type(4)));
typedef float f32x16 __attribute__((ext_vector_type(16)));
#define MFMA32(a, b, c) __builtin_amdgcn_mfma_f32_32x32x16_bf16((a), (b), (c), 0, 0, 0)
__device__ __forceinline__ int crow(int r, int hi) { return (r & 3) + 8 * (r >> 2) + 4 * hi; }
__device__ __forceinline__ void wg_barrier() { asm volatile("s_waitcnt lgkmcnt(0)\n\ts_barrier" ::: "memory"); }

__device__ __forceinline__ void phase_prep(Frame& F, const Args& args, int l) {
    unsigned char* ws_ = F.ws; asm volatile("" : "+s"(ws_)); int lane_ = lane_id(); asm volatile("" : "+v"(lane_)); (void)ws_; (void)args;
    int tid_ = F.wave * 64 + lane_id(); asm volatile("" : "+v"(tid_));
    const int gw = F.vcu * NWAVES + F.wave, NGW = F.G * NWAVES, lane = lane_;
    {
        const int sub = lane >> 4, q = lane & 15;
        const bool r_idx = (q == 2), r_kv = (q >= 4 && q < 8), r_ka = (q < 2);
        const int which = q - 4;
        const int cbase = r_idx ? C_KIDX : (((which < 2) ? C_KSLC : C_KWIN) + (which & 1) * 64);
        constexpr int RB = 4;
        for (int row0 = gw * (4 * RB); row0 < M; row0 += NGW * (4 * RB)) {
            v4u cu[RB], ku[RB], e1[RB], e2[RB]; f32x4 t0[RB], t1[RB], t2[RB], t3[RB];
#pragma unroll
            for (int k = 0; k < RB; ++k) { const size_t row = (size_t)(row0 + 4 * k + sub); bf16* prow = B_PROJ + row * NP; const f32x4* tab = (const f32x4*)(B_ROPE + row * 24);
                cu[k] = *(const v4u*)(prow + C_CKV + 8 * q); ku[k] = *(const v4u*)(prow + C_KA + 8 * q);
                e1[k] = (v4u){0u, 0u, 0u, 0u}; e2[k] = e1[k]; t0[k] = (f32x4){0.f, 0.f, 0.f, 0.f}; t1[k] = t0[k]; t2[k] = t0[k]; t3[k] = t0[k];
                if (r_ka || r_kv) { t0[k] = tab[0]; t1[k] = tab[1]; t2[k] = tab[2]; t3[k] = tab[3]; }
                if (r_idx) { t0[k] = tab[4]; t2[k] = tab[5]; }
                if (r_idx || r_kv) e1[k] = *(const v4u*)(prow + cbase);
                if (r_kv) e2[k] = *(const v4u*)(prow + cbase + 8); }
#pragma unroll
            for (int k = 0; k < RB; ++k) { const size_t row = (size_t)(row0 + 4 * k + sub); bf16* prow = B_PROJ + row * NP;
                float x[8] = {bflo(cu[k].x), bfhi(cu[k].x), bflo(cu[k].y), bfhi(cu[k].y), bflo(cu[k].z), bfhi(cu[k].z), bflo(cu[k].w), bfhi(cu[k].w)};
                float ss = 0.f;
#pragma unroll
                for (int e = 0; e < 8; ++e) ss += x[e] * x[e];
                ss += dpp_f<0xB1>(ss); ss += dpp_f<0x4E>(ss); ss += dpp_f<0x141>(ss); ss += dpp_f<0x140>(ss);
                const float rs = rsqrtf(ss * (1.f / 128.f) + EPS);
                float y[8] = {bflo(ku[k].x) * rs, bfhi(ku[k].x) * rs, bflo(ku[k].y) * rs, bfhi(ku[k].y) * rs, bflo(ku[k].z) * rs, bfhi(ku[k].z) * rs, bflo(ku[k].w) * rs, bfhi(ku[k].w) * rs};
                const float cs[8] = {t0[k].x, t0[k].y, t0[k].z, t0[k].w, t1[k].x, t1[k].y, t1[k].z, t1[k].w};
                const float sn[8] = {t2[k].x, t2[k].y, t2[k].z, t2[k].w, t3[k].x, t3[k].y, t3[k].z, t3[k].w};
#pragma unroll
                for (int e = 0; e < 8; ++e) { const float pr = dpp_f<0xB1>(y[e]);
                    const float r0 = y[e] * cs[e] - pr * sn[e], r1 = pr * sn[e] + y[e] * cs[e];
                    y[e] = r_ka ? ((q == 0) ? r0 : r1) : y[e]; }
                *(v4u*)(prow + C_KA + 8 * q) = (v4u){pk2(y[0], y[1]), pk2(y[2], y[3]), pk2(y[4], y[5]), pk2(y[6], y[7])};
                if (r_idx) {
                    float z[8] = {bflo(e1[k].x), bfhi(e1[k].x), bflo(e1[k].y), bfhi(e1[k].y), bflo(e1[k].z), bfhi(e1[k].z), bflo(e1[k].w), bfhi(e1[k].w)};
                    const float ci[4] = {t0[k].x, t0[k].y, t0[k].z, t0[k].w}, si[4] = {t2[k].x, t2[k].y, t2[k].z, t2[k].w};
                    float o[8];
#pragma unroll
                    for (int i = 0; i < 4; ++i) { o[i] = z[i] * ci[i] - z[4 + i] * si[i]; o[4 + i] = z[i] * si[i] + z[4 + i] * ci[i]; }
                    *(v4u*)(prow + cbase) = (v4u){pk2(o[0], o[1]), pk2(o[2], o[3]), pk2(o[4], o[5]), pk2(o[6], o[7])};
                } else if (r_kv) {
                    float z1[8] = {bflo(e1[k].x), bfhi(e1[k].x), bflo(e1[k].y), bfhi(e1[k].y), bflo(e1[k].z), bfhi(e1[k].z), bflo(e1[k].w), bfhi(e1[k].w)};
                    float z2[8] = {bflo(e2[k].x), bfhi(e2[k].x), bflo(e2[k].y), bfhi(e2[k].y), bflo(e2[k].z), bfhi(e2[k].z), bflo(e2[k].w), bfhi(e2[k].w)};
                    float o1[8], o2[8];
#pragma unroll
                    for (int i = 0; i < 8; ++i) { o1[i] = z1[i] * cs[i] - z2[i] * sn[i]; o2[i] = z1[i] * sn[i] + z2[i] * cs[i]; }
                    *(v4u*)(prow + cbase) = (v4u){pk2(o1[0], o1[1]), pk2(o1[2], o1[3]), pk2(o1[4], o1[5]), pk2(o1[6], o1[7])};
                    *(v4u*)(prow + cbase + 8) = (v4u){pk2(o2[0], o2[1]), pk2(o2[2], o2[3]), pk2(o2[4], o2[5]), pk2(o2[6], o2[7])};
                }
            }
        }
    }
    {
        const int wid = F.wave, r32 = lane & 31, hi = lane >> 5;
        LAS float* P = (LAS float*)F.lds;
        for (int u = F.vcu; u < BATCH * 8; u += F.G) {
            const int b = u >> 3, g = (u >> 2) & 1, kv = (u >> 1) & 1, eh = u & 1;
            const int rt = wid >> 1, part = wid & 1;
            const bf16* ap = B_PROJ + ((size_t)b * S + 16 * (32 * rt + r32)) * NP + (kv ? C_VCMP : C_KCMP) + g * 64 + 8 * hi;
            const bf16* bp = (const bf16*)(ws_ + WS_WCT) + ((size_t)(l * 2 + kv) * 128 + part * 64 + eh * 32 + r32) * 1024 + 8 * hi;
            f32x16 acc = {};
#pragma unroll 8
            for (int ks = 0; ks < 64; ++ks) {
                const bf16x8 a = *(const bf16x8*)(ap + (size_t)(ks >> 2) * NP + 16 * (ks & 3));
                const bf16x8 bq = *(const bf16x8*)(bp + 16 * ks);
                acc = MFMA32(a, bq, acc);
            }
#pragma unroll
            for (int r = 0; r < 16; ++r) P[(part * 128 + 32 * rt + crow(r, hi)) * 32 + r32] = acc[r];
            wg_barrier();
            const float* cb = (const float*)(ws_ + WS_CB) + (l * 2 + kv) * 64 + eh * 32;
            bf16* ob = (bf16*)(ws_ + (kv ? WS_VCB : WS_KCB)) + (size_t)(b * 2 + g) * 128 * 64 + eh * 32;
            for (int idx = tid_; idx < 128 * 32; idx += 512) { const int c = idx >> 5, e = idx & 31;
                const float v = (c < NC) ? (P[c * 32 + e] + P[(128 + c + 1) * 32 + e] + cb[e]) : 0.f;
                ob[c * 64 + e] = (bf16)f2bf(v); }
            wg_barrier();
        }
    }
}

typedef float f32x2_t __attribute__((ext_vector_type(2))); typedef __bf16 bf16x2_t __attribute__((ext_vector_type(2)));
__device__ __forceinline__ unsigned cvtpk(float lo, float hi) { const f32x2_t v = {lo, hi}; const bf16x2_t b = __builtin_convertvector(v, bf16x2_t); return __builtin_bit_cast(unsigned, b); }
constexpr float C2 = 0.125f * 1.4426950408889634f;

__device__ __forceinline__ unsigned idxmask(int x, int hi) {
    unsigned m = 0u;
#pragma unroll
    for (int g = 0; g < 4; ++g) { int n = x - (8 * g + 4 * hi); n = n < 0 ? 0 : (n > 4 ? 4 : n); m |= ((1u << n) - 1u) << (4 * g); }
    return m;
}

constexpr int SEL_QF = 0, SEL_PART = 16384, SEL_HIST = 20480, SEL_HP = 260, SEL_RES = SEL_HIST + 32 * SEL_HP * 4;
__device__ __forceinline__ void dsa_select_unit(unsigned char* ws_, int tid_, int b, int qt32, LAS unsigned char* lds) {
    asm volatile("" : "+v"(tid_)); asm volatile("" : "+s"(ws_));
    const int lane = tid_ & 63, wid = __builtin_amdgcn_readfirstlane(tid_ >> 6), r32 = lane & 31, hi = lane >> 5;
    unsigned* maskbuf = (unsigned*)(ws_ + WS_MASK);
    if (qt32 < 8) {
        for (int i = tid_; i < 2048; i += 512) { const int qq = i >> 6, blk = i & 63; const int t = 32 * qt32 + qq; const int d = t - 32 * blk;
            const unsigned w = d < 0 ? 0u : (d >= 31 ? 0xffffffffu : ((2u << d) - 1u));
            maskbuf[((size_t)b * S + t) * 64 + blk] = w; }
        return;
    }
    const size_t qrow = (size_t)b * S + 32 * qt32 + r32;
    const bf16* prow = B_PROJ + qrow * NP;
    {
        const int h = wid >> 1, sk = wid & 1;
        const v4u raw = *(const v4u*)(prow + C_QIDX + h * 32 + 16 * sk + 8 * hi);
        float x[8] = {bflo(raw.x), bfhi(raw.x), bflo(raw.y), bfhi(raw.y), bflo(raw.z), bfhi(raw.z), bflo(raw.w), bfhi(raw.w)};
        if (sk == 0 && hi == 0) { const float* tab = B_ROPE + qrow * 24;
#pragma unroll
            for (int i = 0; i < 4; ++i) { const float c = tab[16 + i], sn = tab[20 + i]; const float x1 = x[i], x2 = x[4 + i]; x[i] = x1 * c - x2 * sn; x[4 + i] = x1 * sn + x2 * c; } }
        v4u hp, lp;
        { unsigned hh[4], ll[4];
#pragma unroll
          for (int k = 0; k < 4; ++k) { const float a = x[2 * k], bb = x[2 * k + 1]; const unsigned ha = f2bf(a), hb = f2bf(bb); hh[k] = ha | (hb << 16);
              ll[k] = pk2(a - bf2f((bf16)ha), bb - bf2f((bf16)hb)); }
          hp = (v4u){hh[0], hh[1], hh[2], hh[3]}; lp = (v4u){ll[0], ll[1], ll[2], ll[3]}; }
        LAS v4u* qf = (LAS v4u*)(lds + SEL_QF);
        qf[((h * 2 + sk) * 2 + 0) * 64 + lane] = hp; qf[((h * 2 + sk) * 2 + 1) * 64 + lane] = lp;
    }
    float w[4];
#pragma unroll
    for (int h = 0; h < 4; ++h) w[h] = bf2f(prow[C_WIDX + h]);
    __syncthreads();
    const int nblk = qt32 + 1;
    const bf16* kbase = B_PROJ + (size_t)b * S * NP + C_KIDX;
    unsigned key[8][16];
#pragma unroll
    for (int i = 0; i < 8; ++i) {
        const int blk = wid + 8 * i;
        if (blk < nblk) {
            const bf16* kp = kbase + (size_t)(32 * blk + r32) * NP + 8 * hi;
            const bf16x8 kf0 = *(const bf16x8*)kp, kf1 = *(const bf16x8*)(kp + 16);
            float sc[16];
            const LAS bf16x8* qf = (const LAS bf16x8*)(lds + SEL_QF);
#pragma unroll
            for (int h = 0; h < 4; ++h) {
                f32x16 acc = {};
                acc = MFMA32(kf0, qf[((h * 2 + 0) * 2 + 0) * 64 + lane], acc);
                acc = MFMA32(kf1, qf[((h * 2 + 1) * 2 + 0) * 64 + lane], acc);
                acc = MFMA32(kf0, qf[((h * 2 + 0) * 2 + 1) * 64 + lane], acc);
                acc = MFMA32(kf1, qf[((h * 2 + 1) * 2 + 1) * 64 + lane], acc);
#pragma unroll
                for (int r = 0; r < 16; ++r) sc[r] = (h == 0) ? w[0] * fmaxf(acc[r], 0.f) : fmaf(w[h], fmaxf(acc[r], 0.f), sc[r]);
            }
#pragma unroll
            for (int r = 0; r < 16; ++r) {
                unsigned bits = __builtin_bit_cast(unsigned, sc[r]);
                if (bits == 0x80000000u) bits = 0u;
                unsigned k = (bits & 0x80000000u) ? ~bits : (bits | 0x80000000u);
                if (blk == qt32 && crow(r, hi) > r32) k = 0u;
                key[i][r] = k;
            }
        } else {
#pragma unroll
            for (int r = 0; r < 16; ++r) key[i][r] = 0u;
        }
    }
    LAS unsigned* part = (LAS unsigned*)(lds + SEL_PART);
    int pbi = 0;
#define SEL_REDUCE(cnt_, tot_) do { LAS unsigned* pb_ = part + (pbi & 1) * 512; ++pbi; pb_[wid * 64 + lane] = (cnt_); wg_barrier(); unsigned t_ = 0u; \
        _Pragma("unroll") for (int w8 = 0; w8 < 8; ++w8) t_ += pb_[w8 * 64 + r32] + pb_[w8 * 64 + 32 + r32]; (tot_) = t_; } while (0)
    LAS unsigned* hist = (LAS unsigned*)(lds + SEL_HIST);
    LAS unsigned* resd = (LAS unsigned*)(lds + SEL_RES);
    { unsigned z_ = 0u; asm volatile("" : "+v"(z_)); const v4u zz = {z_, z_, z_, z_}; for (int i = tid_; i < 32 * SEL_HP / 4; i += 512) ((LAS v4u*)hist)[i] = zz; }
    wg_barrier();
    unsigned pfx = 0u, need = 256u;
    LAS unsigned* hrow = hist + r32 * SEL_HP;
#pragma unroll 1
    for (int pass = 0; pass < 4; ++pass) {
        const int shift = 24 - 8 * pass;
#pragma unroll
        for (int i = 0; i < 8; ++i) if (wid + 8 * i < nblk) {
#pragma unroll
            for (int r = 0; r < 16; ++r) {
                const unsigned k = key[i][r];
                const unsigned dg = (k >> shift) & 255u;
                const bool match = (pass == 0) || ((k >> (shift + 8)) == pfx);
                __hip_atomic_fetch_add(hrow + (match ? dg : 256u), 1u, __ATOMIC_RELAXED, __HIP_MEMORY_SCOPE_WORKGROUP);
            } }
        wg_barrier();
        {
            const int qq = lane >> 4, t16 = lane & 15, q = 4 * wid + qq;
            LAS v4u* hq = (LAS v4u*)(hist + q * SEL_HP + 16 * t16);
            unsigned g4[4];
#pragma unroll
            for (int i = 0; i < 4; ++i) { const v4u hv = hq[i]; g4[i] = (hv.x + hv.y) + (hv.z + hv.w); }
            const unsigned sL = (g4[0] + g4[1]) + (g4[2] + g4[3]);
            unsigned T = sL;
            T += (unsigned)dpp_i<0x101>((int)T); T += (unsigned)dpp_i<0x102>((int)T); T += (unsigned)dpp_i<0x104>((int)T); T += (unsigned)dpp_i<0x108>((int)T);
            const unsigned needq = (pass == 0) ? 256u : resd[32 + q];
            const unsigned long long bal = __ballot(T >= needq);
            const unsigned rowbits = (unsigned)(bal >> (16 * qq)) & 0xFFFFu;
            const int ts = 31 - __builtin_clz(rowbits | 1u);
            {
                const unsigned rem = needq - (T - sL);
                unsigned c = 0u; int gs = 0; unsigned abg = 0u; bool found = false;
#pragma unroll
                for (int i = 3; i >= 0; --i) { const unsigned cn = c + g4[i]; if (!found && rem <= cn) { gs = i; abg = c; found = true; } c = cn; }
                const v4u hv = hq[gs];
                const unsigned r2 = rem - abg;
                const unsigned c3 = hv.w, c2 = c3 + hv.z, c1 = c2 + hv.y;
                int d; unsigned ab;
                if (r2 <= c3) { d = 3; ab = 0u; } else if (r2 <= c2) { d = 2; ab = c3; } else if (r2 <= c1) { d = 1; ab = c2; } else { d = 0; ab = c1; }
                asm volatile("s_waitcnt lgkmcnt(0)" ::: "memory");
                if (t16 == ts) { resd[q] = 16u * (unsigned)ts + 4u * (unsigned)gs + (unsigned)d; resd[32 + q] = r2 - ab; }
            }
            { unsigned z_ = 0u; asm volatile("" : "+v"(z_)); const v4u zz = {z_, z_, z_, z_};
              hq[0] = zz; hq[1] = zz; hq[2] = zz; hq[3] = zz; if (t16 == 0) hist[q * SEL_HP + 256] = z_; }
        }
        wg_barrier();
        pfx = (pfx << 8) | resd[r32]; need = resd[32 + r32];
    }
    const unsigned thr = pfx;
    unsigned gtm[8], eqm[8];
#pragma unroll
    for (int i = 0; i < 8; ++i) { unsigned g = 0u, e = 0u;
        if (wid + 8 * i < nblk) {
#pragma unroll
            for (int r = 0; r < 16; ++r) { g |= (key[i][r] > thr) ? (1u << r) : 0u; e |= (key[i][r] == thr) ? (1u << r) : 0u; } }
        gtm[i] = g; eqm[i] = e; }
    const unsigned rneed = need;
    unsigned pc[8];
#pragma unroll
    for (int i = 0; i < 8; ++i) pc[i] = __builtin_popcount(eqm[i]);
    unsigned Y = 0u;
    for (int bit = 10; bit >= 5; --bit) {
        const unsigned c = Y | (1u << bit); const int cb = (int)(c >> 5);
        unsigned cnt = 0u;
#pragma unroll
        for (int i = 0; i < 8; ++i) cnt += (wid + 8 * i < cb) ? pc[i] : 0u;
        unsigned tot; SEL_REDUCE(cnt, tot);
        if (tot < rneed) Y = c;
    }
    {
        const int yb = (int)(Y >> 5);
        unsigned cbase = 0u, em = 0u;
#pragma unroll
        for (int i = 0; i < 8; ++i) { cbase += (wid + 8 * i < yb) ? pc[i] : 0u; em |= (wid + 8 * i == yb) ? eqm[i] : 0u; }
        for (int bit = 4; bit >= 0; --bit) {
            const unsigned c = Y | (1u << bit);
            const unsigned cnt = cbase + __builtin_popcount(em & idxmask((int)(c & 31u), hi));
            unsigned tot; SEL_REDUCE(cnt, tot);
            if (tot < rneed) Y = c;
        }
    }
#undef SEL_REDUCE
#pragma unroll
    for (int i = 0; i < 8; ++i) {
        const int blk = wid + 8 * i;
        const unsigned selm = gtm[i] | (eqm[i] & idxmask((int)Y + 1 - 32 * blk, hi));
        unsigned word = ((selm & 0xFu) | ((selm & 0xF0u) << 4) | ((selm & 0xF00u) << 8) | ((selm & 0xF000u) << 12)) << (4 * hi);
        word = or_halves(word);
        if (hi == 0) maskbuf[qrow * 64 + blk] = word;
    }
    __syncthreads();
}

constexpr int AT_K = 0, AT_V = 24576, AT_WS = 49152;
__device__ __forceinline__ void pv(f32x16* o, f32x16& lacc, unsigned vb, bf16x8 pa0, bf16x8 pa1, bf16x8 pa2, bf16x8 pa3) {
    { const bf16x8 ones = {0x3F80, 0x3F80, 0x3F80, 0x3F80, 0x3F80, 0x3F80, 0x3F80, 0x3F80};
      lacc = MFMA32(pa0, ones, lacc); lacc = MFMA32(pa1, ones, lacc); lacc = MFMA32(pa2, ones, lacc); lacc = MFMA32(pa3, ones, lacc); }
#pragma unroll
    for (int d0 = 0; d0 < 2; ++d0) { s16x4 lo0, lo1, lo2, lo3, hi0, hi1, hi2, hi3;
        asm volatile("ds_read_b64_tr_b16 %0,%8 offset:%c9\n\tds_read_b64_tr_b16 %1,%8 offset:%c10\n\tds_read_b64_tr_b16 %2,%8 offset:%c11\n\tds_read_b64_tr_b16 %3,%8 offset:%c12\n\t"
                     "ds_read_b64_tr_b16 %4,%8 offset:%c13\n\tds_read_b64_tr_b16 %5,%8 offset:%c14\n\tds_read_b64_tr_b16 %6,%8 offset:%c15\n\tds_read_b64_tr_b16 %7,%8 offset:%c16\n\t"
                     "s_waitcnt lgkmcnt(0)"
                     : "=&v"(lo0), "=&v"(hi0), "=&v"(lo1), "=&v"(hi1), "=&v"(lo2), "=&v"(hi2), "=&v"(lo3), "=&v"(hi3)
                     : "v"(vb), "i"(d0 * 4096 + 0), "i"(d0 * 4096 + 512), "i"(d0 * 4096 + 1024), "i"(d0 * 4096 + 1536), "i"(d0 * 4096 + 2048), "i"(d0 * 4096 + 2560), "i"(d0 * 4096 + 3072), "i"(d0 * 4096 + 3584)
                     : "memory");
#define PKV(l_, h_) (bf16x8){l_[0], l_[1], l_[2], l_[3], h_[0], h_[1], h_[2], h_[3]}
        o[d0] = MFMA32(pa0, PKV(lo0, hi0), o[d0]);
        o[d0] = MFMA32(pa1, PKV(lo1, hi1), o[d0]);
        o[d0] = MFMA32(pa2, PKV(lo2, hi2), o[d0]);
        o[d0] = MFMA32(pa3, PKV(lo3, hi3), o[d0]);
#undef PKV
    }
}
struct SmState { float mhat; f32x16 o[2]; f32x16 lacc; };
__device__ __forceinline__ unsigned bfe1(unsigned w, int c) { int r; asm("v_bfe_i32 %0, %1, %2, 1" : "=v"(r) : "v"(w), "n"(c)); return (unsigned)r; }
__device__ __forceinline__ float rowmax32(const f32x16& p0, const f32x16& p1) {
    float a = fmaxf(p0[0], p1[0]);
#pragma unroll
    for (int r = 1; r < 16; ++r) a = fmaxf(a, fmaxf(p0[r], p1[r]));
    return max_halves(a);
}
constexpr int NS_QF = 53248, NS_SELS = 86016, NS_SSUM = 118784, NS_SELM = 126976;
__device__ __forceinline__ unsigned range32(int lo, int up) {
    const int l2 = lo < 0 ? 0 : lo, u2 = up > 31 ? 31 : up;
    const unsigned hm = (u2 >= 31) ? ~0u : ((2u << (u2 & 31)) - 1u);
    const unsigned lm = (1u << (l2 & 31)) - 1u;
    return (up < 0 || lo > 31 || u2 < l2) ? 0u : (hm & ~lm);
}
struct M64 { unsigned x, y; };
__device__ __forceinline__ M64 mask_range(int lo, int up) { M64 m; m.x = range32(lo, up); m.y = range32(lo - 32, up - 32); return m; }
__device__ __forceinline__ void load_q(bf16x8* qr, const bf16* qp, const float* tab, bool rope, int hi) {
#pragma unroll
    for (int d0 = 0; d0 < 4; ++d0) {
        const v4u raw = *(const v4u*)(qp + 16 * d0);
        float x[8] = {bflo(raw.x), bfhi(raw.x), bflo(raw.y), bfhi(raw.y), bflo(raw.z), bfhi(raw.z), bflo(raw.w), bfhi(raw.w)};
        if (d0 == 0) {
#pragma unroll
            for (int j = 0; j < 8; ++j) { const float other = other_half_f(x[j], hi); const float c = tab[j], sn = tab[8 + j];
                const float rot = (hi == 0) ? (x[j] * c - other * sn) : (other * sn + x[j] * c); x[j] = rope ? rot : x[j]; }
        }
        v4u pk; pk.x = cvtpk(x[0] * C2, x[1] * C2); pk.y = cvtpk(x[2] * C2, x[3] * C2); pk.z = cvtpk(x[4] * C2, x[5] * C2); pk.w = cvtpk(x[6] * C2, x[7] * C2);
        qr[d0] = __builtin_bit_cast(bf16x8, pk);
    }
}
__device__ __forceinline__ void qkt_lq(f32x16& p0, f32x16& p1, const LAS unsigned char* Kslot, const LAS bf16x8* qf, int lane, int r32, int hi) {
    const LAS unsigned char* kb = Kslot + hi * 1024 + r32 * 16;
    p0 = f32x16{}; p1 = f32x16{};
#pragma unroll
    for (int d0 = 0; d0 < 4; ++d0) {
        const bf16x8 b0 = *(const LAS bf16x8*)(kb + d0 * 2048);
        const bf16x8 b1 = *(const LAS bf16x8*)(kb + d0 * 2048 + 512);
        const bf16x8 q = qf[d0 * 64 + lane];
        p0 = MFMA32(b0, q, p0); p1 = MFMA32(b1, q, p1);
        if (d0 & 1) __builtin_amdgcn_sched_barrier(0);
    }
}
template <bool SEL>
__device__ __forceinline__ void softmax_pv(SmState& st, f32x16& osel, f32x16& p0, f32x16& p1, unsigned vb, const M64 mcur, bool first, LAS float* wsf, int r32, int hi, int ctile) {
    (void)first; (void)wsf; (void)r32;
    const unsigned wx = mcur.x >> (4 * hi), wy = mcur.y >> (4 * hi);
    unsigned e0[16], e1[16];
#pragma unroll
    for (int r = 0; r < 16; ++r) { e0[r] = __builtin_bit_cast(unsigned, __builtin_amdgcn_exp2f(p0[r])); e1[r] = __builtin_bit_cast(unsigned, __builtin_amdgcn_exp2f(p1[r])); }
    const bool lane_uniform = !SEL && __all((mcur.x == mcur.y) && ((mcur.x + 1u) <= 1u));
    if (!lane_uniform && !__all((mcur.x & mcur.y) == ~0u)) {
#pragma unroll
        for (int r = 0; r < 16; ++r) { const int c = (r & 3) + 8 * (r >> 2); e0[r] &= bfe1(wx, c); e1[r] &= bfe1(wy, c); }
    }
    unsigned pw[16];
#pragma unroll
    for (int k = 0; k < 8; ++k) { pw[k] = cvtpk(__builtin_bit_cast(float, e0[2 * k]), __builtin_bit_cast(float, e0[2 * k + 1])); pw[8 + k] = cvtpk(__builtin_bit_cast(float, e1[2 * k]), __builtin_bit_cast(float, e1[2 * k + 1])); }
    if (lane_uniform) {
#pragma unroll
        for (int k = 0; k < 16; ++k) pw[k] &= mcur.x;
    }
    if (SEL) {
#pragma unroll
        for (int ks = 0; ks < 4; ++ks) {
            unsigned ov[4], pl[4];
#pragma unroll
            for (int k = 0; k < 4; ++k) {
                const int j0 = 2 * k, j1 = 2 * k + 1;
                const int c0 = 64 * ctile + 16 * ks + 8 * (j0 >> 2) + 4 * hi + (j0 & 3), c1 = 64 * ctile + 16 * ks + 8 * (j1 >> 2) + 4 * hi + (j1 & 3);
                const unsigned a = (c0 >= 4 * r32 - 1 && c0 <= 4 * r32 + 3) ? 0x3F80u : 0u, bq = (c1 >= 4 * r32 - 1 && c1 <= 4 * r32 + 3) ? 0x3F80u : 0u;
                ov[k] = a | (bq << 16);
                const int e = 4 * ks + k;
                const float v0 = __builtin_bit_cast(float, (e < 8) ? e0[2 * e] : e1[2 * (e - 8)]), v1 = __builtin_bit_cast(float, (e < 8) ? e0[2 * e + 1] : e1[2 * (e - 8) + 1]);
                pl[k] = cvtpk(v0 - bflo(pw[e]), v1 - bfhi(pw[e]));
            }
            const bf16x8 ovf = __builtin_bit_cast(bf16x8, (v4u){ov[0], ov[1], ov[2], ov[3]});
            osel = MFMA32(__builtin_bit_cast(bf16x8, (v4u){pw[4 * ks], pw[4 * ks + 1], pw[4 * ks + 2], pw[4 * ks + 3]}), ovf, osel);
            osel = MFMA32(__builtin_bit_cast(bf16x8, (v4u){pl[0], pl[1], pl[2], pl[3]}), ovf, osel);
        }
    }
    pv(st.o, st.lacc, vb, __builtin_bit_cast(bf16x8, (v4u){pw[0], pw[1], pw[2], pw[3]}), __builtin_bit_cast(bf16x8, (v4u){pw[4], pw[5], pw[6], pw[7]}),
       __builtin_bit_cast(bf16x8, (v4u){pw[8], pw[9], pw[10], pw[11]}), __builtin_bit_cast(bf16x8, (v4u){pw[12], pw[13], pw[14], pw[15]}));
}
template <bool SEL>
__device__ __forceinline__ void tile_step(SmState& st, f32x16& osel, const LAS unsigned char* Kslot, unsigned vb, const LAS bf16x8* qf, const M64 mcur, bool first, LAS float* wsf, int lane, int r32, int hi, int ctile) {
    f32x16 p0, p1;
    qkt_lq(p0, p1, Kslot, qf, lane, r32, hi);
    softmax_pv<SEL>(st, osel, p0, p1, vb, mcur, first, wsf, r32, hi, ctile);
}
__device__ __forceinline__ void qkt_rq(f32x16& p0, f32x16& p1, const LAS unsigned char* Kslot, const bf16x8* qr, int r32, int hi) {
    const LAS unsigned char* kb = Kslot + hi * 1024 + r32 * 16;
    p0 = f32x16{}; p1 = f32x16{};
#pragma unroll
    for (int d0 = 0; d0 < 4; ++d0) {
        const bf16x8 b0 = *(const LAS bf16x8*)(kb + d0 * 2048);
        const bf16x8 b1 = *(const LAS bf16x8*)(kb + d0 * 2048 + 512);
        p0 = MFMA32(b0, qr[d0], p0); p1 = MFMA32(b1, qr[d0], p1);
    }
}
__device__ __forceinline__ void sm_reset(SmState& st) { st.mhat = 0.f; st.o[0] = f32x16{}; st.o[1] = f32x16{}; st.lacc = f32x16{}; }
__device__ __forceinline__ float sigmoidf_(float x) { return 1.f / (1.f + __expf(-x)); }

__device__ __forceinline__ void dsa_attn_unit(unsigned char* ws_, int tid_, int b, int qt, LAS unsigned char* lds) {
    asm volatile("" : "+v"(tid_)); asm volatile("" : "+s"(ws_));
    const int lane = tid_ & 63, wid = __builtin_amdgcn_readfirstlane(tid_ >> 6), r32 = lane & 31, hi = lane >> 5;
    const int h = wid >> 1, qh = wid & 1;
    const size_t qrow = (size_t)b * S + 64 * qt + 32 * qh + r32;
    LAS float* wsf = (LAS float*)(lds + AT_WS) + wid * 128;
    bf16x8 qr[4];
    {
        const bf16* qp = B_PROJ + qrow * NP + C_QA + h * 64 + 8 * hi;
        const float* tab = B_ROPE + qrow * 24;
#pragma unroll
        for (int d0 = 0; d0 < 4; ++d0) {
            const v4u raw = *(const v4u*)(qp + 16 * d0);
            float x[8] = {bflo(raw.x), bfhi(raw.x), bflo(raw.y), bfhi(raw.y), bflo(raw.z), bfhi(raw.z), bflo(raw.w), bfhi(raw.w)};
            if (d0 == 0) {
#pragma unroll
                for (int j = 0; j < 8; ++j) { const float other = other_half_f(x[j], hi); const float c = tab[j], sn = tab[8 + j];
                    x[j] = (hi == 0) ? (x[j] * c - other * sn) : (other * sn + x[j] * c); }
            }
            v4u pk; pk.x = cvtpk(x[0] * C2, x[1] * C2); pk.y = cvtpk(x[2] * C2, x[3] * C2); pk.z = cvtpk(x[4] * C2, x[5] * C2); pk.w = cvtpk(x[6] * C2, x[7] * C2);
            qr[d0] = __builtin_bit_cast(bf16x8, pk);
        }
    }
    LAS bf16x8* qf = (LAS bf16x8*)(lds + NS_QF) + wid * 256;
#pragma unroll
    for (int d0 = 0; d0 < 4; ++d0) qf[d0 * 64 + lane] = qr[d0];
    const bf16* KAb = B_PROJ + (size_t)b * S * NP;
    const bf16* ksrc = KAb + (size_t)lane * NP + C_KA + wid * 8;
    const bf16* vsrc = KAb + (size_t)(16 * (wid & 3) + (lane >> 2)) * NP + C_VA + (wid >> 2) * 32 + (lane & 3) * 8;
#define AT_DMA(t, slot) do { \
        __builtin_amdgcn_global_load_lds((const unsigned*)(ksrc + (size_t)(t) * 64 * NP), (LAS unsigned*)(lds + AT_K + (slot) * 8192 + wid * 1024), 16, 0, 0); \
        __builtin_amdgcn_global_load_lds((const unsigned*)(vsrc + (size_t)(t) * 64 * NP), (LAS unsigned*)(lds + AT_V + (slot) * 8192 + wid * 1024), 16, 0, 0); } while (0)
    const unsigned vb0 = (unsigned)(uintptr_t)(lds + AT_V) + ((lane >> 4) & 1) * 32 + (lane & 3) * 8 + (4 * hi + ((lane & 15) >> 2)) * 64;
    const int NT = qt + 1;
    SmState st; sm_reset(st);
    const unsigned long long* mrow = (const unsigned long long*)((const unsigned*)(ws_ + WS_MASK) + qrow * 64);
    AT_DMA(0, 0);
    unsigned long long m0 = mrow[0], m1 = 0ull, m2 = 0ull;
    if (NT > 1) { AT_DMA(1, 1); m1 = mrow[1]; }
    int cs = 0, is = 2;
    f32x16 osel_unused = {};
#define AT_NEXT(c_) (((c_) == 2) ? 0 : (c_) + 1)
    for (int t = 0; t < NT; ++t) {
        if (t + 1 < NT) asm volatile("s_waitcnt vmcnt(3)" ::: "memory"); else asm volatile("s_waitcnt vmcnt(0)" ::: "memory");
        wg_barrier();
        if (t + 2 < NT) { AT_DMA(t + 2, is); m2 = mrow[t + 2]; }
        const unsigned long long mcur_ = m0; m0 = m1; m1 = m2;
        f32x16 p0, p1;
        qkt_lq(p0, p1, lds + AT_K + cs * 8192, qf, lane, r32, hi);
        softmax_pv<false>(st, osel_unused, p0, p1, vb0 + cs * 8192, (M64){(unsigned)mcur_, (unsigned)(mcur_ >> 32)}, t == 0, wsf, r32, hi, 0);
        cs = AT_NEXT(cs); is = AT_NEXT(is);
    }
#undef AT_NEXT
#undef AT_DMA
    {
        bf16* ob = B_MIX + ((size_t)b * S + 64 * qt + 32 * qh) * D + h * 64 + r32;
#pragma unroll
        for (int r = 0; r < 16; ++r) { const int rq = crow(r, hi); const float f = __builtin_amdgcn_rcpf(st.lacc[r]);
            ob[(size_t)rq * D] = (bf16)f2bf(st.o[0][r] * f); ob[(size_t)rq * D + 32] = (bf16)f2bf(st.o[1][r] * f); }
    }
    __syncthreads();
}


template <bool SEL>
__device__ __forceinline__ void nsa_unit(unsigned char* ws_, int tid_, int b, int g, int qt, LAS unsigned char* lds) {
    asm volatile("" : "+v"(tid_)); asm volatile("" : "+s"(ws_));
    const int lane = tid_ & 63, wid = __builtin_amdgcn_readfirstlane(tid_ >> 6), r32 = lane & 31, hi = lane >> 5;
    const int hr = wid >> 1, qh = wid & 1, H = 4 * g + hr;
    const int tq = 64 * qt + 32 * qh + r32;
    const size_t qrow = (size_t)b * S + tq;
    LAS float* wsf = (LAS float*)(lds + AT_WS) + wid * 128;
    const unsigned vb0 = (unsigned)(uintptr_t)(lds + AT_V) + ((lane >> 4) & 1) * 32 + (lane & 3) * 8 + (4 * hi + ((lane & 15) >> 2)) * 64;
    const bf16* kcb = (const bf16*)(ws_ + WS_KCB) + (size_t)(b * 2 + g) * 128 * 64;
    const bf16* vcb = (const bf16*)(ws_ + WS_VCB) + (size_t)(b * 2 + g) * 128 * 64;
    const bf16* pb = B_PROJ + (size_t)b * S * NP + g * 64;
    const int vrow = 16 * (wid & 3) + (lane >> 2), vcol = (wid >> 2) * 32 + (lane & 3) * 8;
#define NS_DMA(kp_, vp_, slot_) do { \
        __builtin_amdgcn_global_load_lds((const unsigned*)(kp_), (LAS unsigned*)(lds + AT_K + (slot_) * 8192 + wid * 1024), 16, 0, 0); \
        __builtin_amdgcn_global_load_lds((const unsigned*)(vp_), (LAS unsigned*)(lds + AT_V + (slot_) * 8192 + wid * 1024), 16, 0, 0); } while (0)
#define NS_DMA_CMP(i_, slot_) NS_DMA(kcb + (size_t)(64 * (i_) + lane) * 64 + wid * 8, vcb + (size_t)(64 * (i_) + vrow) * 64 + vcol, slot_)
#define NS_DMA_PROJ(ck_, cv_, j_, slot_) NS_DMA(pb + (size_t)(64 * (j_) + lane) * NP + (ck_) + wid * 8, pb + (size_t)(64 * (j_) + vrow) * NP + (cv_) + vcol, slot_)
    const int ncmp = (qt >= 16) ? 2 : 1;
    const int jw0 = (qt > 8) ? qt - 8 : 0, nwin = qt - jw0 + 1;
    if (hi == 0) { const bf16* gp = B_PROJ + qrow * NP + C_GATE + H * 3;
        wsf[64 + r32] = sigmoidf_(bf2f(gp[0])); wsf[96 + r32] = sigmoidf_(bf2f(gp[2])); wsf[32 + r32] = sigmoidf_(bf2f(gp[1])); }
    int nissued = 0, islot = 0, ti = 0, cslot = 0;
    unsigned remI = SEL ? 0u : ((2u << qt) - 1u);
#define NS_ISSUE() do { \
        if (nissued < ncmp) { NS_DMA_CMP(nissued, islot); } \
        else if (nissued < ncmp + nwin) { NS_DMA_PROJ(C_KWIN, C_VWIN, jw0 + nissued - ncmp, islot); } \
        else if (remI) { const int j_ = __builtin_ctz(remI); remI &= remI - 1u; NS_DMA_PROJ(C_KSLC, C_VSLC, j_, islot); } \
        else break; \
        ++nissued; islot = (islot == 2) ? 0 : islot + 1; } while (0)
#define NS_TOP() do { if (nissued > ti + 1) asm volatile("s_waitcnt vmcnt(2)" ::: "memory"); else asm volatile("s_waitcnt vmcnt(0)" ::: "memory"); wg_barrier(); NS_ISSUE(); } while (0)
#define NS_ADV() do { ++ti; cslot = (cslot == 2) ? 0 : cslot + 1; } while (0)
    NS_ISSUE(); NS_ISSUE();
    LAS bf16x8* qf = (LAS bf16x8*)(lds + NS_QF) + wid * 256;
    { bf16x8 qr[4]; load_q(qr, B_PROJ + qrow * NP + C_QB + H * 64 + 8 * hi, B_ROPE + qrow * 24, false, hi);
#pragma unroll
      for (int d0 = 0; d0 < 4; ++d0) qf[d0 * 64 + lane] = qr[d0]; }
    SmState st; sm_reset(st);
    f32x16 osel = {};
    unsigned oaccp[16];
    const int ncv = (tq >= 31) ? (((tq - 31) >> 4) + 1) : 0;
    for (int i = 0; i < ncmp; ++i) {
        NS_TOP();
        const M64 m = mask_range(0, ncv - 64 * i - 1);
        tile_step<SEL>(st, osel, lds + AT_K + cslot * 8192, vb0 + cslot * 8192, qf, m, i == 0, wsf, lane, r32, hi, i);
        NS_ADV();
    }
    {
        asm volatile("s_waitcnt lgkmcnt(0)" ::: "memory");
        LAS float* sels = (LAS float*)(lds + NS_SELS);
#pragma unroll
        for (int r = 0; r < 16; ++r) { const int rq = crow(r, hi); const float lt = st.lacc[r]; const float inv = lt > 0.f ? __builtin_amdgcn_rcpf(lt) : 0.f; const float f2 = wsf[64 + rq] * inv;
            oaccp[r] = cvtpk(st.o[0][r] * f2, st.o[1][r] * f2);
            if (SEL) sels[(hr * 64 + 32 * qh + rq) * 32 + r32] = osel[r] * inv; }
        asm volatile("s_waitcnt lgkmcnt(0)" ::: "memory");
    }
    unsigned selunion;
    if (SEL) {
        wg_barrier();
        LAS float* sels = (LAS float*)(lds + NS_SELS);
        LAS float* ssum = (LAS float*)(lds + NS_SSUM);
        LAS unsigned* selm = (LAS unsigned*)(lds + NS_SELM);
        const int q = tid_ >> 3, jg = tid_ & 7;
        f32x4 s4 = *(const LAS f32x4*)(sels + (0 * 64 + q) * 32 + 4 * jg);
        s4 += *(const LAS f32x4*)(sels + (1 * 64 + q) * 32 + 4 * jg);
        s4 += *(const LAS f32x4*)(sels + (2 * 64 + q) * 32 + 4 * jg);
        s4 += *(const LAS f32x4*)(sels + (3 * 64 + q) * 32 + 4 * jg);
        *(LAS f32x4*)(ssum + q * 32 + 4 * jg) = s4;
        asm volatile("s_waitcnt lgkmcnt(0)" ::: "memory");
        float sv[32];
#pragma unroll
        for (int k = 0; k < 8; ++k) { const f32x4 v = *(const LAS f32x4*)(ssum + q * 32 + 4 * k); sv[4 * k] = v.x; sv[4 * k + 1] = v.y; sv[4 * k + 2] = v.z; sv[4 * k + 3] = v.w; }
        const float PINF = __builtin_inff();
#pragma unroll
        for (int i = 0; i < 32; ++i) sv[i] = (i > qt) ? -PINF : ((i == 0 || i == qt || i == qt - 1) ? PINF : sv[i]);
        unsigned bits4 = 0u;
#pragma unroll
        for (int jj = 0; jj < 4; ++jj) {
            const int j = 4 * jg + jj;
            float mine = (jj == 0) ? s4.x : (jj == 1) ? s4.y : (jj == 2) ? s4.z : s4.w;
            mine = (j > qt) ? -PINF : ((j == 0 || j == qt || j == qt - 1) ? PINF : mine);
            int rank = 0;
#pragma unroll
            for (int i = 0; i < 32; ++i) rank += ((sv[i] > mine) || (sv[i] == mine && i < j)) ? 1 : 0;
            bits4 |= (rank < 16) ? (1u << jj) : 0u;
        }
        unsigned mm = bits4 << (4 * jg);
        mm |= (unsigned)dpp_i<0xB1>((int)mm); mm |= (unsigned)dpp_i<0x4E>((int)mm); mm |= (unsigned)dpp_i<0x141>((int)mm);
        if (jg == 0) selm[q] = mm;
        wg_barrier();
        unsigned u = selm[lane];
        u = or_halves(or32(u));
        selunion = (unsigned)__builtin_amdgcn_readfirstlane((int)u);
    } else {
        selunion = (2u << qt) - 1u;
    }
    { bf16x8 qr[4]; load_q(qr, B_PROJ + qrow * NP + C_QB + H * 64 + 8 * hi, B_ROPE + qrow * 24, true, hi);
#pragma unroll
      for (int d0 = 0; d0 < 4; ++d0) qf[d0 * 64 + lane] = qr[d0]; }
    sm_reset(st);
    if (SEL) remI = selunion;
    for (int j = jw0; j <= qt; ++j) {
        NS_TOP();
        const M64 m = mask_range(tq - 511 - 64 * j, tq - 64 * j);
        tile_step<false>(st, osel, lds + AT_K + cslot * 8192, vb0 + cslot * 8192, qf, m, j == jw0, wsf, lane, r32, hi, 0);
        NS_ADV();
    }
    {
        asm volatile("s_waitcnt lgkmcnt(0)" ::: "memory");
#pragma unroll
        for (int r = 0; r < 16; ++r) { const float lt = st.lacc[r]; const float f2 = lt > 0.f ? wsf[96 + crow(r, hi)] * __builtin_amdgcn_rcpf(lt) : 0.f; oaccp[r] = cvtpk(bflo(oaccp[r]) + st.o[0][r] * f2, bfhi(oaccp[r]) + st.o[1][r] * f2); }
        asm volatile("s_waitcnt lgkmcnt(0)" ::: "memory");
    }
    sm_reset(st);
    bool firstb = true;
    unsigned rem = selunion;
    while (rem) {
        const int j = __builtin_ctz(rem); rem &= rem - 1u;
        NS_TOP();
        const unsigned mysel_ = SEL ? ((const LAS unsigned*)(lds + NS_SELM))[32 * qh + r32] : ((2u << qt) - 1u);
        M64 m = mask_range(0, tq - 64 * j); if (!((mysel_ >> j) & 1u)) { m.x = 0u; m.y = 0u; }
        tile_step<false>(st, osel, lds + AT_K + cslot * 8192, vb0 + cslot * 8192, qf, m, firstb, wsf, lane, r32, hi, 0);
        firstb = false; NS_ADV();
    }
    {
        asm volatile("s_waitcnt lgkmcnt(0)" ::: "memory");
        bf16* ob = B_MIX + ((size_t)b * S + 64 * qt + 32 * qh) * D + 256 + H * 64 + r32;
#pragma unroll
        for (int r = 0; r < 16; ++r) { const int rq = crow(r, hi); const float lt = st.lacc[r]; const float f2 = lt > 0.f ? wsf[32 + rq] * __builtin_amdgcn_rcpf(lt) : 0.f;
            ob[(size_t)rq * D] = (bf16)f2bf(bflo(oaccp[r]) + st.o[0][r] * f2); ob[(size_t)rq * D + 32] = (bf16)f2bf(bfhi(oaccp[r]) + st.o[1][r] * f2); }
    }
    __syncthreads();
#undef NS_DMA
#undef NS_DMA_CMP
#undef NS_DMA_PROJ
#undef NS_ISSUE
#undef NS_TOP
#undef NS_ADV
}

__device__ __forceinline__ void phase_attn(Frame& F, int l) {
    (void)l;
    unsigned char* ws_ = F.ws; asm volatile("" : "+s"(ws_)); int lane_ = lane_id(); asm volatile("" : "+v"(lane_)); (void)ws_;
    int tid_ = F.wave * 64 + lane_id(); asm volatile("" : "+v"(tid_));
    for (int u = F.vcu; u < BATCH * 64; u += F.G) {
        const int c = u & 255, i = u >> 8; const int b = c >> 3, sft = c & 7; const int base = 16 * (i >> 1); const int qt32 = (i & 1) ? base + 15 - sft : base + sft;
        dsa_select_unit(ws_, tid_, b, qt32, F.lds);
    }
    __syncthreads();
#if PROBE_MASK
    if (blockIdx.x == 0 && F.wave == 0 && lane_id() == 0) { const unsigned long long ts_ = __builtin_amdgcn_s_memrealtime(); F.MISC[16] = (unsigned)ts_; F.MISC[17] = (unsigned)(ts_ >> 32); }
#endif
    for (int u = F.vcu; u < BATCH * 64; u += F.G) {
        const int c = u & 255, i = u >> 8; const int b = c >> 3, sft = c & 7; const int g = i & 1, k = i >> 1; const int base = 16 * (k >> 1); const int qt = (k & 1) ? base + 15 - sft : base + sft;
        if (qt >= 16) nsa_unit<true>(ws_, tid_, b, g, qt, F.lds); else nsa_unit<false>(ws_, tid_, b, g, qt, F.lds);
    }
}
__device__ __forceinline__ void phase_dsa_attn(Frame& F) {
    unsigned char* ws_ = F.ws; asm volatile("" : "+s"(ws_));
    int tid_ = F.wave * 64 + lane_id(); asm volatile("" : "+v"(tid_));
    for (int u = F.vcu; u < BATCH * 32; u += F.G) {
        const int c = u & 255, i = u >> 8; const int b = c >> 3, sft = c & 7; const int base = 16 * (i >> 1); const int qt = (i & 1) ? base + 15 - sft : base + sft;
        dsa_attn_unit(ws_, tid_, b, qt, F.lds);
    }
}

constexpr int WP_PITCH = 72;
__device__ __forceinline__ void phase_merge(Frame& F, const Args& args, int l) {
    unsigned char* ws_ = F.ws; asm volatile("" : "+s"(ws_)); int lane_ = lane_id(); asm volatile("" : "+v"(lane_)); (void)ws_;
    int tid_ = F.wave * 64 + lane_id(); asm volatile("" : "+v"(tid_));
    const int gw = F.vcu * NWAVES + F.wave, NGW = F.G * NWAVES, lane = lane_;
    const float* psc = P_POOL_SCALE + l * 256;
    const float* goa = P_G_OUT_A + l * 256; const float* gob = P_G_OUT_B + l * 512;
    LAS bf16* wp = (LAS bf16*)F.lds;
    {
        const float* wsrc = P_W_POOL + (size_t)l * 4 * 64 * 64;
        for (int idx = tid_; idx < 4 * 64 * 64; idx += 512) { const int g = idx >> 12, c = (idx >> 6) & 63, d = idx & 63; wp[(g * 64 + d) * WP_PITCH + c] = (bf16)f2bf(wsrc[idx]); }
    }
    {
        constexpr int RB = 4;
        const f32x4 gga = ((const f32x4*)goa)[lane]; const f32x4 gb0 = ((const f32x4*)gob)[2 * lane], gb1 = ((const f32x4*)gob)[2 * lane + 1];
        for (int row0 = gw * RB; row0 < M; row0 += NGW * RB) {
            unsigned long long ua[RB]; v4u ub[RB];
#pragma unroll
            for (int k = 0; k < RB; ++k) { const bf16* mrow = B_MIX + (size_t)(row0 + k) * D; ua[k] = *((const unsigned long long*)mrow + lane); ub[k] = *((const v4u*)(mrow + 256) + lane); }
#pragma unroll
            for (int k = 0; k < RB; ++k) { bf16* mrow = B_MIX + (size_t)(row0 + k) * D;
                { const unsigned long long u = ua[k];
                  const float a0 = bflo((unsigned)u), a1 = bfhi((unsigned)u), a2 = bflo((unsigned)(u >> 32)), a3 = bfhi((unsigned)(u >> 32));
                  const float rs = rsqrtf(wave_sum((a0 * a0 + a1 * a1) + (a2 * a2 + a3 * a3)) * (1.f / 256.f) + EPS);
                  *((unsigned long long*)mrow + lane) = (unsigned long long)pk2(a0 * rs * gga.x, a1 * rs * gga.y) | ((unsigned long long)pk2(a2 * rs * gga.z, a3 * rs * gga.w) << 32); }
                { const v4u u = ub[k];
                  float a[8] = {bflo(u.x), bfhi(u.x), bflo(u.y), bfhi(u.y), bflo(u.z), bfhi(u.z), bflo(u.w), bfhi(u.w)};
                  float ss = 0.f;
#pragma unroll
                  for (int i = 0; i < 8; ++i) ss += a[i] * a[i];
                  const float rs = rsqrtf(wave_sum(ss) * (1.f / 512.f) + EPS);
                  v4u o; o.x = pk2(a[0] * rs * gb0.x, a[1] * rs * gb0.y); o.y = pk2(a[2] * rs * gb0.z, a[3] * rs * gb0.w); o.z = pk2(a[4] * rs * gb1.x, a[5] * rs * gb1.y); o.w = pk2(a[6] * rs * gb1.z, a[7] * rs * gb1.w);
                  *((v4u*)(mrow + 256) + lane) = o; }
            }
        }
    }
    __syncthreads();
    {
        const int r32 = lane & 31, hi = lane >> 5;
        for (int tile = gw; tile < M / 32; tile += NGW) {
            const int row = 32 * tile + r32, t = row % S;
            const bf16* up = B_PROJ + (size_t)row * NP + C_UC + 8 * hi;
            f32x16 acc[4][2];
#pragma unroll
            for (int g = 0; g < 4; ++g) {
                acc[g][0] = f32x16{}; acc[g][1] = f32x16{};
                const int w = 2 << g;
                const float icnt = 1.f / (float)((t + 1 < w) ? t + 1 : w);
#pragma unroll
                for (int ks = 0; ks < 4; ++ks) {
                    const bf16* p0 = up + g * 64 + 16 * ks;
                    const v4u u0 = *(const v4u*)p0;
                    float cur[8] = {bflo(u0.x), bfhi(u0.x), bflo(u0.y), bfhi(u0.y), bflo(u0.z), bfhi(u0.z), bflo(u0.w), bfhi(u0.w)};
                    float sum[8];
#pragma unroll
                    for (int j = 0; j < 8; ++j) sum[j] = cur[j];
#pragma unroll
                    for (int i = 1; i < w; ++i) {
                        if (t - i >= 0) { const v4u ui = *(const v4u*)(p0 - (size_t)i * NP);
                            sum[0] += bflo(ui.x); sum[1] += bfhi(ui.x); sum[2] += bflo(ui.y); sum[3] += bfhi(ui.y); sum[4] += bflo(ui.z); sum[5] += bfhi(ui.z); sum[6] += bflo(ui.w); sum[7] += bfhi(ui.w); }
                    }
                    v4u pk; pk.x = cvtpk(sum[0] * icnt - cur[0], sum[1] * icnt - cur[1]); pk.y = cvtpk(sum[2] * icnt - cur[2], sum[3] * icnt - cur[3]);
                    pk.z = cvtpk(sum[4] * icnt - cur[4], sum[5] * icnt - cur[5]); pk.w = cvtpk(sum[6] * icnt - cur[6], sum[7] * icnt - cur[7]);
                    const bf16x8 af = __builtin_bit_cast(bf16x8, pk);
#pragma unroll
                    for (int nb = 0; nb < 2; ++nb) {
                        const bf16x8 bfr = *(const LAS bf16x8*)(wp + (g * 64 + 32 * nb + r32) * WP_PITCH + 16 * ks + 8 * hi);
                        acc[g][nb] = MFMA32(af, bfr, acc[g][nb]);
                    }
                }
            }
            float ss[16];
#pragma unroll
            for (int r = 0; r < 16; ++r) { float a = 0.f;
#pragma unroll
                for (int g = 0; g < 4; ++g) a += acc[g][0][r] * acc[g][0][r] + acc[g][1][r] * acc[g][1][r];
                a = sum32(a);
                ss[r] = rsqrtf(a * (1.f / 256.f) + EPS); }
            bf16* ob = B_MIX + (size_t)(32 * tile) * D + 768 + r32;
#pragma unroll
            for (int g = 0; g < 4; ++g)
#pragma unroll
                for (int nb = 0; nb < 2; ++nb) { const float sc = psc[g * 64 + 32 * nb + r32];
#pragma unroll
                    for (int r = 0; r < 16; ++r) ob[(size_t)crow(r, hi) * D + g * 64 + 32 * nb] = (bf16)f2bf(acc[g][nb][r] * ss[r] * sc); }
        }
    }
    __syncthreads();
}

template <bool XIN_F32, bool OUT_F32>
__device__ __forceinline__ void phase_finish(Frame& F, const float* xsrc, const float* gpost, const float* gnext  ) {
    unsigned char* ws_ = F.ws; asm volatile("" : "+s"(ws_)); int lane_ = lane_id(); asm volatile("" : "+v"(lane_)); (void)ws_;
    const int gw = F.vcu * NWAVES + F.wave, NGW = F.G * NWAVES, lane = lane_;
    bf16* xb = (bf16*)(ws_ + WS_XB);
    constexpr int RB = 4;
    for (int row0 = gw * RB; row0 < M; row0 += NGW * RB) {
        v4u fu[RB][2]; float x[RB][2][8];
#pragma unroll
        for (int k = 0; k < RB; ++k) { const size_t row = (size_t)(row0 + k);
#pragma unroll
            for (int j = 0; j < 2; ++j) { fu[k][j] = *((const v4u*)(B_F + row * D + 512 * j) + lane);
                if (XIN_F32) { const f32x4 a = *((const f32x4*)(xsrc + row * D + 512 * j) + 2 * lane), c = *((const f32x4*)(xsrc + row * D + 512 * j) + 2 * lane + 1);
                    x[k][j][0] = a.x; x[k][j][1] = a.y; x[k][j][2] = a.z; x[k][j][3] = a.w; x[k][j][4] = c.x; x[k][j][5] = c.y; x[k][j][6] = c.z; x[k][j][7] = c.w; }
                else { const v4u ux = *((const v4u*)(xb + row * D + 512 * j) + lane);
                    x[k][j][0] = bflo(ux.x); x[k][j][1] = bfhi(ux.x); x[k][j][2] = bflo(ux.y); x[k][j][3] = bfhi(ux.y); x[k][j][4] = bflo(ux.z); x[k][j][5] = bfhi(ux.z); x[k][j][6] = bflo(ux.w); x[k][j][7] = bfhi(ux.w); } } }
        float gp[2][8];
#pragma unroll
        for (int j = 0; j < 2; ++j) { const f32x4 a = *((const f32x4*)(gpost + 512 * j) + 2 * lane), c = *((const f32x4*)(gpost + 512 * j) + 2 * lane + 1);
            gp[j][0] = a.x; gp[j][1] = a.y; gp[j][2] = a.z; gp[j][3] = a.w; gp[j][4] = c.x; gp[j][5] = c.y; gp[j][6] = c.z; gp[j][7] = c.w;
 }
#pragma unroll
        for (int k = 0; k < RB; ++k) { const size_t row = (size_t)(row0 + k);
            float f[2][8]; float ss = 0.f;
#pragma unroll
            for (int j = 0; j < 2; ++j) { const v4u u = fu[k][j];
                f[j][0] = bflo(u.x); f[j][1] = bfhi(u.x); f[j][2] = bflo(u.y); f[j][3] = bfhi(u.y); f[j][4] = bflo(u.z); f[j][5] = bfhi(u.z); f[j][6] = bflo(u.w); f[j][7] = bfhi(u.w);
#pragma unroll
                for (int e = 0; e < 8; ++e) ss += f[j][e] * f[j][e]; }
            const float rs = rsqrtf(wave_sum(ss) * (1.f / D) + EPS);
            float s2 = 0.f;
#pragma unroll
            for (int j = 0; j < 2; ++j) {
#pragma unroll
                for (int e = 0; e < 8; ++e) { const float xv = x[k][j][e] + f[j][e] * rs * gp[j][e]; x[k][j][e] = xv; s2 += xv * xv; }
                if (OUT_F32) { f32x4* o = (f32x4*)(F.out + row * D + 512 * j) + 2 * lane;
                    o[0] = (f32x4){x[k][j][0], x[k][j][1], x[k][j][2], x[k][j][3]}; o[1] = (f32x4){x[k][j][4], x[k][j][5], x[k][j][6], x[k][j][7]}; }
                else *((v4u*)(xb + row * D + 512 * j) + lane) = (v4u){pk2(x[k][j][0], x[k][j][1]), pk2(x[k][j][2], x[k][j][3]), pk2(x[k][j][4], x[k][j][5]), pk2(x[k][j][6], x[k][j][7])};
            }
            if (gnext) { const float r2 = rsqrtf(wave_sum(s2) * (1.f / D) + EPS); if (lane == 0) ((float*)(ws_ + WS_RS))[row] = r2; }
        }
    }
}

template <int ACT>
__device__ __forceinline__ void phase_gemm(Frame& F, const bf16* A, const bf16* Bt, bf16* O, int N, int K, const float* rs) {
    asm volatile("" : "+s"(A), "+s"(Bt), "+s"(O), "+s"(rs));
    int bx_ = (int)blockIdx.x, gg_ = F.G; asm volatile("" : "+s"(bx_), "+s"(gg_));
    pg8::Gemm g{A, Bt, M, N, K}; pg8::StaticOrder So; So.init(M, N, gg_, bx_);
    pg8::EpiStore<ACT> E{O, N, rs};
    pg8::gemm_phase<pg8::EpiStore<ACT>, pg8::StaticOrder, true, true>(F.lds, g, So, E, F.wave);
}

constexpr int PH_PER_LAYER = 10, NPHASES = 2 + DEPTH * PH_PER_LAYER;
__global__ void __launch_bounds__(NWAVES * 64, 2) mk_fwd(Args args) {
    extern __shared__ __attribute__((aligned(16))) unsigned char lds[];
    Frame F;
    F.lds = (LAS unsigned char*)lds;
    F.MISC = (volatile LAS unsigned*)(F.lds + MISC_OFF);
    { const int t0_ = threadIdx.x; F.wave = __builtin_amdgcn_readfirstlane(t0_ >> 6);
      for (int u = t0_; u < (LDS_BYTES - LDSCTL_OFF) / 4; u += NWAVES * 64) ((LAS unsigned*)(F.lds + LDSCTL_OFF))[u] = 0u; }
    F.G = gridDim.x; { const int bx = blockIdx.x; F.vcu = (F.G % 8 == 0) ? (bx % 8) * (F.G / 8) + bx / 8 : bx; }
    unsigned char* ws = args.ws; F.ws = ws;
    F.ctl = (gu32*)(ws + WS_CTL);
    F.out = args.out;
    __syncthreads();
    XcdBarrier bar; bar.bar = (unsigned*)(F.ctl + CW_BAR); bar.x = 0; bar.st = F.MISC + 8; bar.wv = 0;
    if (args.use_bar) bar = xcd_barrier_post((unsigned*)(F.ctl + CW_BAR), F.MISC + 8);
    bar.wv = F.wave;
    const int lo = args.ph_lo, hi = args.ph_hi;
    int pid = 0;
    unsigned char* ws_ = F.ws;
#define PH_ON (pid >= lo && pid < hi)
#if PROBE_MASK
    if (blockIdx.x == 0 && F.wave == 0 && lane_id() == 0) { const unsigned long long t_ = __builtin_amdgcn_s_memrealtime(); F.MISC[18] = (unsigned)t_; F.MISC[19] = (unsigned)(t_ >> 32); F.MISC[20] = 0u; F.MISC[21] = 0u; }
#define PH_END(kind) do { if (PH_ON && pid + 1 < hi) xcd_barrier(bar); ++pid; \
        if (blockIdx.x == 0 && F.wave == 0 && lane_id() == 0) { const unsigned long long now_ = __builtin_amdgcn_s_memrealtime(); \
          const unsigned long long last_ = (unsigned long long)F.MISC[18] | ((unsigned long long)F.MISC[19] << 32); unsigned long long acc_ = (unsigned long long)F.MISC[20] | ((unsigned long long)F.MISC[21] << 32); \
          if ((kind) == 3) { const unsigned long long sp_ = (unsigned long long)F.MISC[16] | ((unsigned long long)F.MISC[17] << 32); \
              if ((PROBE_MASK >> 11) & 1) acc_ += sp_ - last_; if ((PROBE_MASK >> 3) & 1) acc_ += now_ - sp_; } \
          else if ((PROBE_MASK >> (kind)) & 1) acc_ += now_ - last_; \
          F.MISC[18] = (unsigned)now_; F.MISC[19] = (unsigned)(now_ >> 32); F.MISC[20] = (unsigned)acc_; F.MISC[21] = (unsigned)(acc_ >> 32); } } while (0)
#else
#define PH_END(kind) do { if (PH_ON && pid + 1 < hi) xcd_barrier(bar); ++pid; } while (0)
#endif

    if (PH_ON && !(SKIPM & 1)) phase_prologue(F, args);
    PH_END(0);
    if (PH_ON && !(SKIPM & 1)) phase_prologue_b(F, args);
    PH_END(0);
    for (int l = 0; l < DEPTH; ++l) {
        unsigned char* ws_ = F.ws; asm volatile("" : "+s"(ws_));
        if (PH_ON && !(SKIPM & 2)) phase_gemm<0>(F, (const bf16*)(ws_ + WS_XB), w_in_t(ws_, l), B_PROJ, NP, D, (const float*)(ws_ + WS_RS));
        PH_END(1);
        if (PH_ON && !(SKIPM & 4)) phase_prep(F, args, l);
        PH_END(2);
        if (PH_ON && !(SKIPM & 8)) phase_attn(F, l);
        PH_END(3);
        if (PH_ON && !(SKIPM & 8)) phase_dsa_attn(F);
        PH_END(4);
        if (PH_ON && !(SKIPM & 16)) phase_merge(F, args, l);
        PH_END(5);
        if (PH_ON && !(SKIPM & 32)) phase_gemm<0>(F, B_MIX, w_out_t(ws_, l), B_F, D, D, nullptr);
        PH_END(6);
        if (PH_ON && !(SKIPM & 64)) { if (l == 0) phase_finish<true, false>(F, P_X_IN, P_G_POST_MIX + l * D, P_G_PRE_MLP + l * D); else phase_finish<false, false>(F, nullptr, P_G_POST_MIX + l * D, P_G_PRE_MLP + l * D); }
        PH_END(7);
        if (PH_ON && !(SKIPM & 128)) phase_gemm<2>(F, (const bf16*)(ws_ + WS_XB), w_up_t(ws_, l), B_HID, FF, D, (const float*)(ws_ + WS_RS));
        PH_END(8);
        if (PH_ON && !(SKIPM & 256)) phase_gemm<0>(F, B_HID, w_dn_t(ws_, l), B_F, D, FF, nullptr);
        PH_END(9);
        if (PH_ON && !(SKIPM & 512)) { if (l + 1 < DEPTH) phase_finish<false, false>(F, nullptr, P_G_POST_MLP + l * D, P_G_PRE_MIX + (l + 1) * D); else phase_finish<false, true>(F, nullptr, P_G_POST_MLP + l * D, nullptr); }
        PH_END(10);
    }
#if PROBE_MASK
    if (blockIdx.x == 0 && F.wave == 0 && lane_id() == 0) { const unsigned long long pr_acc = (unsigned long long)F.MISC[20] | ((unsigned long long)F.MISC[21] << 32);
        const unsigned long long t0_ = __builtin_amdgcn_s_memrealtime(); while (__builtin_amdgcn_s_memrealtime() - t0_ < pr_acc) __builtin_amdgcn_s_sleep(8); }
#endif
#undef PH_ON
#undef PH_END
}

extern "C" void kernel_launch(void* const* d_in, const int* in_sizes, int n_in, void* d_out, int out_size, void* d_ws, size_t ws_size, hipStream_t stream) {
    static int grid = 0;
    if (grid == 0) {
        if (n_in != 20 || in_sizes[0] != M * D || out_size != M * D || ws_size < WS_END) {
            fprintf(stderr, "kernel_launch: unexpected shapes / workspace (n_in %d, in0 %d, out %d, ws %zu < %zu); nothing launched\n", n_in, n_in > 0 ? in_sizes[0] : -1, out_size, ws_size, (size_t)WS_END);
            grid = -1; return; }
        int dev = 0, cus = 0, per_cu = 0;
        if (hipGetDevice(&dev) != hipSuccess || hipDeviceGetAttribute(&cus, hipDeviceAttributeMultiprocessorCount, dev) != hipSuccess) { grid = -1; return; }
        if (hipFuncSetAttribute((const void*)mk_fwd, hipFuncAttributeMaxDynamicSharedMemorySize, LDS_BYTES) != hipSuccess) { fprintf(stderr, "kernel_launch: hipFuncSetAttribute failed\n"); grid = -1; return; }
        if (hipOccupancyMaxActiveBlocksPerMultiprocessor(&per_cu, (const void*)mk_fwd, NWAVES * 64, LDS_BYTES) != hipSuccess || per_cu < 1)
            fprintf(stderr, "kernel_launch: note: occupancy query reports %d workgroups per CU\n", per_cu);
        (void)hipGetLastError();
        grid = cus;
    }
    if (grid < 0) return;
    if (hipMemsetAsync((char*)d_ws + WS_CTL, 0, CTL_ZERO_BYTES, stream) != hipSuccess) return;
    Args a{};
    for (int i = 0; i < 20; ++i) a.in[i] = d_in[i];
    a.out = (float*)d_out; a.ws = (unsigned char*)d_ws; a.pad = 0;
#if MK_MULTI
    for (int p = 0; p < NPHASES; ++p) {
        a.ph_lo = p; a.ph_hi = p + 1; a.use_bar = 0;
        hipLaunchKernelGGL(mk_fwd, dim3(grid), dim3(NWAVES * 64), LDS_BYTES, stream, a);
    }
#else
    a.ph_lo = 0; a.ph_hi = NPHASES; a.use_bar = 1;
    hipLaunchKernelGGL(mk_fwd, dim3(grid), dim3(NWAVES * 64), LDS_BYTES, stream, a);
#endif
}
```

```cpp
#include <hip/hip_runtime.h>
#include <cstdio>
#include <cstdint>

#ifndef PROBE_MASK
#define PROBE_MASK 0
#endif
#ifndef SKIPM
#define SKIPM 0
#endif
#ifndef MK_MULTI
#define MK_MULTI 0
#endif

__device__ __forceinline__ int lane_id() { int l; asm volatile("v_mbcnt_lo_u32_b32 %0, -1, 0\n\tv_mbcnt_hi_u32_b32 %0, -1, %0" : "=v"(l)); return l; }
namespace pg8 {
#define PG8_LAS __attribute__((address_space(3)))
typedef unsigned short bf16_t;
typedef short bf16x8 __attribute__((ext_vector_type(8)));
typedef float f32x4 __attribute__((ext_vector_type(4)));
typedef unsigned u32x4 __attribute__((ext_vector_type(4)));
typedef int v4i_t __attribute__((ext_vector_type(4)));
typedef int v8i_t __attribute__((ext_vector_type(8)));
constexpr int BM = 256, BK = 64, HALF = 128, HTB = HALF * BK * 2, STAGE_BYTES = 8 * HTB, NXCD = 8, WGM = 8;

__host__ __device__ __forceinline__ int lds_byte(int r, int c) { const int st = (r >> 4) * 2 + (c >> 5), rr = r & 15, cc = c & 31, ob = rr * 64 + cc * 2; return st * 1024 + (ob ^ (((ob >> 9) & 1) << 5)); }
__host__ __device__ __forceinline__ void stage_rc(int b, int& R, int& C) { const int st = b / 1024, sb = b % 1024, swz = sb ^ (((sb >> 9) & 1) << 5); R = (st >> 1) * 16 + swz / 64; C = (st & 1) * 32 + (swz % 64) / 2; }
__host__ __device__ __forceinline__ int perm32(int rho) { const int n = rho >> 4, i = rho & 15; return 8 * (i >> 2) + 4 * n + (i & 3); }

struct Unit { int pm, pn; };
struct Gemm { const bf16_t* A; const bf16_t* Bt; int M, N, K; };

struct StaticOrder {
    int nM, nN, nwg, G, c;
    __host__ __device__ void init(int M, int N, int G_, int c_) { nM = M / BM; nN = N / BM; nwg = nM * nN; G = G_; c = c_; }
    __host__ __device__ bool next(int i, Unit& u) const {
        const long L = (long)i * G + c; if (L >= nwg) return false;
        int wgid = (int)L; { const int q = nwg / NXCD, r = nwg % NXCD, xcd = wgid % NXCD, off = wgid / NXCD; wgid = (xcd < r ? xcd * (q + 1) : r * (q + 1) + (xcd - r) * q) + off; }
        const int nig = WGM * nN, gid = wgid / nig, fm = gid * WGM, gsz = (nM - fm) < WGM ? (nM - fm) : WGM;
        u.pm = fm + ((wgid % nig) % gsz); u.pn = (wgid % nig) / gsz; return true;
    }
    __device__ __forceinline__ void a_ready(const Unit&) const {}
    __device__ __forceinline__ void done(const Unit&) const {}
};

__device__ __forceinline__ unsigned cvt_pk_bf16(float lo, float hi) { unsigned r; asm volatile("v_cvt_pk_bf16_f32 %0, %1, %2" : "=v"(r) : "v"(lo), "v"(hi)); return r; }

template <int ACT  > struct EpiStore {
    static constexpr int PERM = 2; static constexpr bool AFTER_DRAIN = false;
    bf16_t* O; int ldc; const float* rs;
    struct Pre { float sc[2][4]; };
    __device__ __forceinline__ Pre prefetch(const Unit& u, int wr, int fr) const { Pre p; const int row0 = u.pm * BM + wr * 64 + fr;
#pragma unroll
        for (int ai = 0; ai < 2; ++ai)
#pragma unroll
            for (int m = 0; m < 4; ++m) p.sc[ai][m] = (rs ? rs[row0 + ai * HALF + m * 16] : 1.f);
        return p; }
    __device__ __forceinline__ void operator()(const f32x4 (&acc)[2][2][4][2], const Unit& u, int wr, int wc, int fr, int fq, const Pre& pre) const {
        const int row0 = u.pm * BM + wr * 64 + fr;
        const int col0 = u.pn * BM + wc * 64 + 16 * fq;
        const float (&sc)[2][4] = pre.sc;
#pragma unroll
        for (int ai = 0; ai < 2; ++ai)
#pragma unroll
            for (int m = 0; m < 4; ++m) { const int row = row0 + ai * HALF + m * 16; bf16_t* rowp = O + (size_t)row * ldc + col0;
#pragma unroll
                for (int bj = 0; bj < 2; ++bj) { f32x4 v0 = acc[ai][bj][m][0] * sc[ai][m], v1 = acc[ai][bj][m][1] * sc[ai][m];
                    if (ACT == 2) {
#pragma unroll
                        for (int e = 0; e < 4; ++e) { const float a = fmaxf(v0[e], 0.f), b = fmaxf(v1[e], 0.f); v0[e] = a * a; v1[e] = b * b; } }
                    u32x4 w; w.x = cvt_pk_bf16(v0[0], v0[1]); w.y = cvt_pk_bf16(v0[2], v0[3]); w.z = cvt_pk_bf16(v1[0], v1[1]); w.w = cvt_pk_bf16(v1[2], v1[3]);
                    *(u32x4*)(rowp + bj * 8) = w; } }
    }
};

constexpr float XSC = 16.f, WUSC = 32.f;
constexpr float MSC = 16.f, WOSC = 32.f;
constexpr float HSC = 4.f, WDSC = 64.f;
__device__ __forceinline__ unsigned pk4_fp8(float a, float b, float c, float d) { int p = 0; p = __builtin_amdgcn_cvt_pk_fp8_f32(a, b, p, false); p = __builtin_amdgcn_cvt_pk_fp8_f32(c, d, p, true); return (unsigned)p; }
template <bool HAS_RS> struct EpiRelu2Fp8T {
    static constexpr int PERM = 2; static constexpr bool AFTER_DRAIN = false;
    unsigned char* O; int ldc; const float* rs;
    struct Pre { float sc[2][4]; };
    __device__ __forceinline__ Pre prefetch(const Unit& u, int wr, int fr) const { Pre p; const int row0 = u.pm * BM + wr * 64 + fr;
#pragma unroll
        for (int ai = 0; ai < 2; ++ai)
#pragma unroll
            for (int m = 0; m < 4; ++m) p.sc[ai][m] = HAS_RS ? rs[row0 + ai * HALF + m * 16] : (1.f / (XSC * WUSC));
        return p; }
    __device__ __forceinline__ void operator()(const f32x4 (&acc)[2][2][4][2], const Unit& u, int wr, int wc, int fr, int fq, const Pre& pre) const {
        const int row0 = u.pm * BM + wr * 64 + fr;
        const int col0 = u.pn * BM + wc * 64 + 16 * fq;
        float sc[2][4];
#pragma unroll
        for (int ai = 0; ai < 2; ++ai)
#pragma unroll
            for (int m = 0; m < 4; ++m) sc[ai][m] = pre.sc[ai][m] * 2.f;
#pragma unroll
        for (int ai = 0; ai < 2; ++ai)
#pragma unroll
            for (int m = 0; m < 4; ++m) { const int row = row0 + ai * HALF + m * 16; unsigned w[4];
#pragma unroll
                for (int bj = 0; bj < 2; ++bj)
#pragma unroll
                    for (int n = 0; n < 2; ++n) { f32x4 v = acc[ai][bj][m][n] * sc[ai][m];
#pragma unroll
                        for (int e = 0; e < 4; ++e) { const float a = fmaxf(v[e], 0.f); v[e] = fminf(a * a, 448.f); }
                        w[bj * 2 + n] = pk4_fp8(v[0], v[1], v[2], v[3]); }
                *(u32x4*)(O + (size_t)row * ldc + col0) = (u32x4){w[0], w[1], w[2], w[3]}; }
    }
};

template <class Epi, class Sched, bool ALIGN_EPI = false, bool SP2 = false, bool FP8 = false>
__device__ __forceinline__ void gemm_phase(PG8_LAS unsigned char* lds, const Gemm g, const Sched& S, const Epi& E, int wave_) {
    int tid_ = wave_ * 64 + lane_id(); asm volatile("" : "+v"(tid_));
    const int tid = tid_, wid = __builtin_amdgcn_readfirstlane(tid >> 6), lane = tid & 63, wr = wid >> 2, wc = wid & 3, fr = lane & 15, fq = lane >> 4;
    const int K = g.K, nt = K / BK;
    unsigned voffA[2], voffB[2];
#pragma unroll
    for (int i = 0; i < 2; ++i) { int R, C; stage_rc(tid * 16 + i * 8192, R, C);
        const int Rb = (Epi::PERM == 2) ? (64 * (R >> 5) + 16 * ((R & 15) >> 2) + 4 * ((R >> 4) & 1) + (R & 3)) : (Epi::PERM == 1) ? ((R & ~31) + perm32(R & 31)) : R;
        voffA[i] = (unsigned)(R * K + C) * 2u; voffB[i] = (unsigned)(Rb * K + C) * 2u; }
    const size_t kstep = (size_t)(BK * 2);
    const size_t hstep = (size_t)HALF * K * 2;
    const size_t hstepB = (Epi::PERM == 2) ? (size_t)8 * K * 2 : hstep;
    const size_t tstep = 2 * hstep;
    const unsigned ldsw = (unsigned)wid * 1024u;
    const int aoff = lds_byte(wr * 64 + fr, fq * 8); int boff = lds_byte(wc * 32 + fr, fq * 8) + 4 * HTB; asm volatile("" : "+v"(boff));
#define PG8_SA(b, h) (((b) * 2 + (h)) * HTB)
#define PG8_SB(b, h) ((4 + (b) * 2 + (h)) * HTB)
#define PG8_STAGE(bufoff, gbase, voff) do { _Pragma("unroll") for (int _i = 0; _i < 2; ++_i) \
        __builtin_amdgcn_global_load_lds((const unsigned*)((const char*)(gbase) + (voff)[_i]), (PG8_LAS unsigned*)(lds + (bufoff) + ldsw + _i * 8192), 16, 0, 0); } while (0)
#define PG8_SBR(b, h) (((b) * 2 + (h)) * HTB)
#define PG8_LD8(off_) __builtin_shufflevector(*(const PG8_LAS v4i_t*)(lds + (off_)), *(const PG8_LAS v4i_t*)(lds + (off_) + 1024), 0, 1, 2, 3, 4, 5, 6, 7)
#define PG8_LDA(dst, b, h) do { _Pragma("unroll") for (int m = 0; m < 4; ++m) { if constexpr (FP8) dst##8[m] = PG8_LD8(PG8_SA(b, h) + aoff + m * 2048); \
        else { _Pragma("unroll") for (int k = 0; k < 2; ++k) dst[m][k] = *(const PG8_LAS bf16x8*)(lds + PG8_SA(b, h) + aoff + m * 2048 + k * 1024); } } } while (0)
#define PG8_LDB(dst, b, h) do { _Pragma("unroll") for (int n = 0; n < 2; ++n) { if constexpr (FP8) dst##8[n] = PG8_LD8(PG8_SBR(b, h) + boff + n * 2048); \
        else { _Pragma("unroll") for (int k = 0; k < 2; ++k) dst[n][k] = *(const PG8_LAS bf16x8*)(lds + PG8_SBR(b, h) + boff + n * 2048 + k * 1024); } } } while (0)
#define PG8_MMA(ai, bj, At, Bt) do { __builtin_amdgcn_s_setprio(1); _Pragma("unroll") for (int m = 0; m < 4; ++m) _Pragma("unroll") for (int n = 0; n < 2; ++n) { \
        if constexpr (FP8) asm volatile("v_mfma_f32_16x16x128_f8f6f4 %0, %1, %2, %0" : "+v"(acc[ai][bj][m][n]) : "v"(Bt##8[n]), "v"(At##8[m]));   \
        else { _Pragma("unroll") for (int k = 0; k < 2; ++k) acc[ai][bj][m][n] = __builtin_amdgcn_mfma_f32_16x16x32_bf16(Bt[n][k], At[m][k], acc[ai][bj][m][n], 0, 0, 0); } } \
        __builtin_amdgcn_s_setprio(0); } while (0)
#define PG8_WAIT_V(n) asm volatile("s_waitcnt vmcnt(" #n ")" ::: "memory")
#define PG8_WAIT_L(n) asm volatile("s_waitcnt lgkmcnt(" #n ")" ::: "memory")
#define PG8_BAR __builtin_amdgcn_s_barrier()
#define PG8_SCHED __builtin_amdgcn_sched_barrier(0)
    Unit cur, nxt; int ui = 0;
    if (!S.next(0, cur)) return;
    typename Epi::Pre pre = E.prefetch(cur, wr, fr);
    f32x4 acc[2][2][4][2];
#pragma unroll
    for (int a = 0; a < 2; ++a)
#pragma unroll
        for (int b = 0; b < 2; ++b)
#pragma unroll
            for (int m = 0; m < 4; ++m)
#pragma unroll
                for (int n = 0; n < 2; ++n) acc[a][b][m][n] = (f32x4){0.f, 0.f, 0.f, 0.f};
    bf16x8 At[4][2], B0[2][2], B1[2][2];
    v8i_t At8[4], B08[2], B18[2];
    const char* cA = (const char*)g.A + (size_t)cur.pm * tstep; const char* cB = (const char*)g.Bt + (size_t)cur.pn * tstep;
    S.a_ready(cur);
    if constexpr (SP2) {
        PG8_STAGE(PG8_SB(0, 0), cB, voffB); PG8_STAGE(PG8_SB(0, 1), cB + hstepB, voffB); PG8_STAGE(PG8_SA(0, 0), cA, voffA); PG8_STAGE(PG8_SA(0, 1), cA + hstep, voffA);
        if (wr == 1) PG8_BAR;
        PG8_WAIT_V(2); PG8_BAR;
        PG8_STAGE(PG8_SB(1, 0), cB + kstep, voffB); PG8_STAGE(PG8_SA(1, 0), cA + kstep, voffA); PG8_STAGE(PG8_SB(1, 1), cB + hstepB + kstep, voffB);
        PG8_WAIT_V(6); PG8_BAR;
    } else {
        PG8_STAGE(PG8_SB(0, 0), cB, voffB); PG8_STAGE(PG8_SA(0, 0), cA, voffA); PG8_STAGE(PG8_SB(0, 1), cB + hstepB, voffB); PG8_STAGE(PG8_SA(0, 1), cA + hstep, voffA);
        if (wr == 1) PG8_BAR;
        PG8_WAIT_V(4); PG8_BAR;
        PG8_STAGE(PG8_SB(1, 0), cB + kstep, voffB); PG8_STAGE(PG8_SA(1, 0), cA + kstep, voffA); PG8_STAGE(PG8_SB(1, 1), cB + hstepB + kstep, voffB);
        PG8_WAIT_V(6); PG8_BAR;
    }
    for (;;) {
        const bool has_next = S.next(ui + 1, nxt);
        const char* nA = has_next ? (const char*)g.A + (size_t)nxt.pm * tstep : cA; const char* nB = has_next ? (const char*)g.Bt + (size_t)nxt.pn * tstep : cB;
        for (int t = 0; t < nt; t += 2) {
            const bool last = (t == nt - 2);
            const char* a1 = cA + (size_t)(t + 1) * kstep;
            const char* a2 = last ? nA : cA + (size_t)(t + 2) * kstep; const char* b2 = last ? nB : cB + (size_t)(t + 2) * kstep;
            const char* a3 = a2 + kstep; const char* b3 = b2 + kstep;
            if (last && has_next) S.a_ready(nxt);
            if constexpr (SP2) {
            PG8_LDB(B0, 0, 0); PG8_LDB(B1, 0, 1); PG8_SCHED; PG8_LDA(At, 0, 0); PG8_STAGE(PG8_SA(1, 1), a1 + hstep, voffA);
            PG8_WAIT_V(8); PG8_WAIT_L(0); PG8_BAR; PG8_MMA(0, 0, At, B0); PG8_MMA(0, 1, At, B1); PG8_BAR; PG8_SCHED;
            PG8_LDA(At, 0, 1); PG8_STAGE(PG8_SB(0, 0), b2, voffB); PG8_STAGE(PG8_SB(0, 1), b2 + hstepB, voffB); PG8_STAGE(PG8_SA(0, 0), a2, voffA);
            PG8_WAIT_V(8); PG8_WAIT_L(0); PG8_BAR; PG8_MMA(1, 0, At, B0); PG8_MMA(1, 1, At, B1); PG8_BAR; PG8_SCHED;
            PG8_LDB(B0, 1, 0); PG8_LDB(B1, 1, 1); PG8_SCHED; PG8_LDA(At, 1, 0); PG8_STAGE(PG8_SA(0, 1), a2 + hstep, voffA);
            PG8_WAIT_V(8); PG8_WAIT_L(0); PG8_BAR; PG8_MMA(0, 0, At, B0); PG8_MMA(0, 1, At, B1); PG8_BAR; PG8_SCHED;
            PG8_LDA(At, 1, 1); PG8_STAGE(PG8_SB(1, 0), b3, voffB); PG8_STAGE(PG8_SB(1, 1), b3 + hstepB, voffB); PG8_STAGE(PG8_SA(1, 0), a3, voffA);
            PG8_WAIT_V(8); PG8_WAIT_L(0); PG8_BAR; PG8_MMA(1, 0, At, B0); PG8_MMA(1, 1, At, B1); PG8_BAR; PG8_SCHED;
            } else {
            PG8_LDB(B0, 0, 0); PG8_SCHED; PG8_LDA(At, 0, 0); PG8_STAGE(PG8_SA(1, 1), a1 + hstep, voffA);
            PG8_WAIT_L(8); PG8_BAR; PG8_WAIT_L(0); PG8_MMA(0, 0, At, B0); PG8_BAR; PG8_SCHED;
            PG8_LDB(B1, 0, 1); PG8_STAGE(PG8_SB(0, 0), b2, voffB);
            PG8_BAR; PG8_WAIT_L(0); PG8_MMA(0, 1, At, B1); PG8_BAR;
            PG8_LDA(At, 0, 1); PG8_STAGE(PG8_SA(0, 0), a2, voffA);
            PG8_BAR; PG8_WAIT_L(0); PG8_MMA(1, 0, At, B0); PG8_BAR; PG8_SCHED;
            PG8_STAGE(PG8_SB(0, 1), b2 + hstepB, voffB);
            PG8_WAIT_V(6); PG8_BAR; PG8_MMA(1, 1, At, B1); PG8_BAR;
            PG8_LDB(B0, 1, 0); PG8_SCHED; PG8_LDA(At, 1, 0); PG8_STAGE(PG8_SA(0, 1), a2 + hstep, voffA);
            PG8_WAIT_L(8); PG8_BAR; PG8_WAIT_L(0); PG8_MMA(0, 0, At, B0); PG8_BAR; PG8_SCHED;
            PG8_LDB(B1, 1, 1); PG8_STAGE(PG8_SB(1, 0), b3, voffB);
            PG8_BAR; PG8_WAIT_L(0); PG8_MMA(0, 1, At, B1); PG8_BAR;
            PG8_LDA(At, 1, 1); PG8_STAGE(PG8_SA(1, 0), a3, voffA);
            PG8_BAR; PG8_WAIT_L(0); PG8_MMA(1, 0, At, B0); PG8_BAR; PG8_SCHED;
            PG8_STAGE(PG8_SB(1, 1), b3 + hstepB, voffB);
            PG8_WAIT_V(6); PG8_BAR; PG8_MMA(1, 1, At, B1); PG8_BAR;
            }
        }
        if constexpr (FP8) asm volatile("s_nop 15\n\ts_nop 7" ::: "memory");
        if constexpr (ALIGN_EPI) { if (wr == 0) PG8_BAR; }
        if constexpr (!Epi::AFTER_DRAIN) { E(acc, cur, wr, wc, fr, fq, pre); S.done(cur); }
        if (!has_next) break;
#pragma unroll
        for (int a = 0; a < 2; ++a)
#pragma unroll
            for (int b = 0; b < 2; ++b)
#pragma unroll
                for (int m = 0; m < 4; ++m)
#pragma unroll
                    for (int n = 0; n < 2; ++n) acc[a][b][m][n] = (f32x4){0.f, 0.f, 0.f, 0.f};
        cur = nxt; cA = nA; cB = nB; ++ui;
        pre = E.prefetch(cur, wr, fr);
        if constexpr (ALIGN_EPI) { if (wr == 1) PG8_BAR; }
    }
    PG8_WAIT_V(0);
    if constexpr (!ALIGN_EPI) { if (wr == 0) PG8_BAR; }
    PG8_BAR;
#undef PG8_SA
#undef PG8_SB
#undef PG8_STAGE
#undef PG8_LDA
#undef PG8_LD8
#undef PG8_SBR
#undef PG8_LDB
#undef PG8_MMA
#undef PG8_WAIT_V
#undef PG8_WAIT_L
#undef PG8_BAR
#undef PG8_SCHED
}
}

constexpr int NWAVES = 8;
constexpr int BATCH = 32, S = 2048, D = 1024, DEPTH = 4, FF = 4096;
constexpr int M = BATCH * S;
constexpr int NP = 2304;
constexpr int DIN = 2108;
constexpr int C_QA = 0, C_CKV = 256, C_QIDX = 384, C_QB = 512, C_KCMP = 1024, C_VCMP = 1152, C_KSLC = 1280, C_VSLC = 1408, C_KWIN = 1536, C_VWIN = 1664,
              C_UC = 1792, C_KIDX = 2048, C_WIDX = 2080, C_GATE = 2084, C_KA = 2112, C_VA = 2176;
constexpr int NC = 127;
constexpr float EPS = 1e-6f;
constexpr float NEGF = -1e30f;

__host__ __device__ __forceinline__ int win_src(int n) {
    if (n < 512) return n;
    if (n < 1024) return 548 + (n - 512);
    if (n < 1792) return 1060 + (n - 1024);
    if (n < 2048) return 1852 + (n - 1792);
    if (n < 2080) return 512 + (n - 2048);
    if (n < 2084) return 544 + (n - 2080);
    if (n < 2108) return 1828 + (n - 2084);
    return -1;
}

constexpr size_t MiB = 1u << 20;
constexpr size_t WS_CTL = 0, CTL_ZERO_BYTES = 1 * MiB;
constexpr size_t WS_W = 2 * MiB;
constexpr size_t W_IN_B = (size_t)NP * D * 2, W_OUT_B = (size_t)D * D * 2, W_UP_B = (size_t)FF * D * 2, W_DN_B = (size_t)D * FF * 2;
constexpr size_t W_LAYER_B = W_IN_B + W_OUT_B + W_UP_B + W_DN_B;
constexpr size_t WS_ROPE = 96 * MiB;
constexpr size_t WS_WCT = 102 * MiB;
constexpr size_t WS_CB = 104 * MiB;
constexpr size_t WS_KCB = 124 * MiB, WS_VCB = 125 * MiB;
constexpr size_t WS_KA = 108 * MiB;
constexpr size_t WS_RS = 126 * MiB;
constexpr size_t WS_F = 256 * MiB;
constexpr size_t WS_PROJ = 384 * MiB;
constexpr size_t WS_MIX = 672 * MiB;
constexpr size_t WS_MASK = 800 * MiB;
constexpr size_t WS_HID = 384 * MiB;
constexpr size_t WS_X8 = 128 * MiB;
constexpr size_t WS_MIX8 = 816 * MiB;
constexpr size_t WS_XB = 896 * MiB;
constexpr size_t WS_END = 1024 * MiB;
static_assert(WS_W + DEPTH * W_LAYER_B <= WS_ROPE, "weights");
static_assert(WS_ROPE + (size_t)M * 24 * 4 <= WS_WCT && WS_WCT + (size_t)DEPTH * 2 * 128 * 1024 * 2 <= WS_CB, "map");
static_assert(WS_PROJ + (size_t)M * NP * 2 <= WS_MIX && WS_MIX + (size_t)M * D * 2 <= WS_END && WS_HID + (size_t)M * FF * 2 <= WS_END, "map2");

constexpr int CW_BAR = 4096;
constexpr int RING_BYTES = 131072;
constexpr int LDSCTL_OFF = RING_BYTES, MISC_OFF = LDSCTL_OFF + 320;
constexpr int LDS_BYTES = 147456;
constexpr int WSCR = 16384;

#define GAS __attribute__((address_space(1)))
#define LAS __attribute__((address_space(3)))
typedef unsigned short bf16;
typedef unsigned v4u __attribute__((ext_vector_type(4)));
typedef float f32x4 __attribute__((ext_vector_type(4)));
typedef GAS unsigned gu32;
#define LDS_FENCE() asm volatile("s_waitcnt lgkmcnt(0)" ::: "memory")
__device__ __forceinline__ unsigned f2bf(float f) { unsigned u = __builtin_bit_cast(unsigned, f); return (u + 0x7fffu + ((u >> 16) & 1u)) >> 16; }
__device__ __forceinline__ unsigned pk2(float lo, float hi) { return f2bf(lo) | (f2bf(hi) << 16); }
__device__ __forceinline__ float bf2f(bf16 u) { return __builtin_bit_cast(float, (unsigned)u << 16); }
__device__ __forceinline__ float bflo(unsigned u) { return __builtin_bit_cast(float, u << 16); }
__device__ __forceinline__ float bfhi(unsigned u) { return __builtin_bit_cast(float, u & 0xffff0000u); }

#define XB_TMO      128
#define XB_XCNT(j)  (256  + 64 * (j))
#define XB_XSUB(j)  (1280 + 64 * (j))
#define XB_XGEN(j)  (2304 + 64 * (j))
#define XB_TOP      3328
#define XB_TOPGEN   3392
#define XCD_BAR_WORDS 3456
#define XB_SPIN_CAP (1u << 22)

__device__ __forceinline__ unsigned xb_ld(unsigned* p)              { return __hip_atomic_load(p, __ATOMIC_RELAXED, __HIP_MEMORY_SCOPE_AGENT); }
__device__ __forceinline__ unsigned xb_add(unsigned* p, unsigned v) { return __hip_atomic_fetch_add(p, v, __ATOMIC_RELAXED, __HIP_MEMORY_SCOPE_AGENT); }
__device__ __forceinline__ unsigned xb_xcc_id() { return (unsigned)__builtin_amdgcn_s_getreg((3 << 11) | 20) & 0xFu; }
#define XB_SPIN(cond, bar) do { unsigned _sp = 0; while (cond) { __builtin_amdgcn_s_sleep(1); \
    if ((++_sp & 255u) == 0u) { if (xb_ld(&(bar)[XB_TMO])) break; if (_sp > XB_SPIN_CAP) { atomicAdd(&(bar)[XB_TMO], 1u); break; } } } } while (0)

struct XcdBarrier { unsigned* bar; unsigned x; volatile LAS unsigned* st; int wv; };

__device__ __forceinline__ XcdBarrier xcd_barrier_post(unsigned* bar, volatile LAS unsigned* st) {
    XcdBarrier b; b.bar = bar; b.x = xb_xcc_id(); b.st = st; b.wv = 0;
    if (threadIdx.x == 0) (void)xb_add(&bar[XB_XCNT(b.x)], 1u);
    return b;
}
__device__ __forceinline__ void xcd_barrier_complete(unsigned* bar, unsigned x, unsigned& nloc, unsigned& nx) {
    const unsigned G = gridDim.x * gridDim.y * gridDim.z;
    unsigned sum, cnt, mine, sp = 0u;
    for (;;) {
        sum = 0u; cnt = 0u; mine = 0u;
#pragma unroll
        for (unsigned j = 0; j < 16; ++j) { const unsigned c = xb_ld(&bar[XB_XCNT(j)]); sum += c; cnt += (c > 0u) ? 1u : 0u; mine = (j == x) ? c : mine; }
        if (sum == G) break;
        __builtin_amdgcn_s_sleep(1);
        if ((++sp & 255u) == 0u) { if (xb_ld(&bar[XB_TMO])) break; if (sp > XB_SPIN_CAP) { atomicAdd(&bar[XB_TMO], 1u); break; } }
    }
    nloc = mine > 0u ? mine : 1u; nx = cnt > 0u ? cnt : 1u;
}
__device__ __forceinline__ void xcd_barrier(const XcdBarrier& b) {
    asm volatile("s_waitcnt vmcnt(0)" ::: "memory");
    __syncthreads();
    if (b.wv == 0 && lane_id() == 0) {
        unsigned* bar = b.bar; asm volatile("" : "+s"(bar));
        __builtin_amdgcn_s_waitcnt(0);
        unsigned nloc = b.st[0], nx = b.st[1];
        unsigned bx_ = b.x; asm volatile("" : "+s"(bx_));
        if (nloc == 0u) { xcd_barrier_complete(bar, bx_, nloc, nx); b.st[0] = nloc; b.st[1] = nx; }
        const unsigned old = xb_add(&bar[XB_XSUB(bx_)], 1u);
        const unsigned gen = old / nloc;
        if (old + 1u == (gen + 1u) * nloc) {
            __builtin_amdgcn_fence(__ATOMIC_RELEASE, "agent");
            asm volatile("s_waitcnt vmcnt(0)" ::: "memory");
            const unsigned og = xb_add(&bar[XB_TOP], 1u);
            const unsigned tg = og / nx;
            if (og + 1u == (tg + 1u) * nx) xb_add(&bar[XB_TOPGEN], 1u);
            else XB_SPIN(xb_ld(&bar[XB_TOPGEN]) == tg, bar);
            __builtin_amdgcn_fence(__ATOMIC_ACQUIRE, "agent");
            xb_add(&bar[XB_XGEN(bx_)], 1u);
            asm volatile("s_waitcnt vmcnt(0)" ::: "memory");
        } else {
            XB_SPIN(xb_ld(&bar[XB_XGEN(bx_)]) == gen, bar);
            __builtin_amdgcn_fence(__ATOMIC_ACQUIRE, "agent");
            asm volatile("s_waitcnt vmcnt(0)" ::: "memory");
        }
    }
    __syncthreads();
}

struct Frame {
    LAS unsigned char* lds;
    volatile LAS unsigned* MISC;
    gu32* ctl;
    int wave, vcu, G;
    float* out; unsigned char* ws;
};
struct Args { const void* in[20]; float* out; unsigned char* ws; int ph_lo, ph_hi, use_bar, pad; };
#define IN_F(k) ((const float*)args.in[k])
#define P_X_IN IN_F(0)
#define P_POS ((const int*)args.in[1])
#define P_W_IN IN_F(2)
#define P_G_KV_A IN_F(3)
#define P_W_KV_UP IN_F(4)
#define P_W_CMP_K IN_F(5)
#define P_W_CMP_V IN_F(6)
#define P_PE_K IN_F(7)
#define P_PE_V IN_F(8)
#define P_W_POOL IN_F(9)
#define P_POOL_SCALE IN_F(10)
#define P_G_OUT_A IN_F(11)
#define P_G_OUT_B IN_F(12)
#define P_W_OUT IN_F(13)
#define P_G_PRE_MIX IN_F(14)
#define P_G_POST_MIX IN_F(15)
#define P_G_PRE_MLP IN_F(16)
#define P_G_POST_MLP IN_F(17)
#define P_W_UP IN_F(18)
#define P_W_DOWN IN_F(19)
#define B_ROPE ((float*)(ws_ + WS_ROPE))
#define B_F ((bf16*)(ws_ + WS_F))
#define B_PROJ ((bf16*)(ws_ + WS_PROJ))
#define B_MIX ((bf16*)(ws_ + WS_MIX))
#define B_HID ((bf16*)(ws_ + WS_HID))

template <int CTRL> __device__ __forceinline__ int dpp_i(int v) { return __builtin_amdgcn_update_dpp(0, v, CTRL, 0xF, 0xF, true); }
template <int CTRL> __device__ __forceinline__ float dpp_f(float v) { return __builtin_bit_cast(float, dpp_i<CTRL>(__builtin_bit_cast(int, v))); }
__device__ __forceinline__ int swz16_i(int v) { return __builtin_amdgcn_ds_swizzle(v, (16 << 10) | 0x1F); }
__device__ __forceinline__ float swz16_f(float v) { return __builtin_bit_cast(float, swz16_i(__builtin_bit_cast(int, v))); }
struct HalfPair { unsigned lo, hi; };
__device__ __forceinline__ HalfPair halves_u(unsigned v) { const auto rr = __builtin_amdgcn_permlane32_swap(v, v, false, false); HalfPair h; h.lo = rr[0]; h.hi = rr[1]; return h; }
__device__ __forceinline__ float other_half_f(float v, int hi) { const HalfPair h = halves_u(__builtin_bit_cast(unsigned, v)); return __builtin_bit_cast(float, hi ? h.lo : h.hi); }
__device__ __forceinline__ float sum32(float v) {
    v += dpp_f<0xB1>(v); v += dpp_f<0x4E>(v); v += dpp_f<0x141>(v); v += dpp_f<0x140>(v); v += swz16_f(v); return v; }
__device__ __forceinline__ float wave_sum(float v) { v = sum32(v); const HalfPair h = halves_u(__builtin_bit_cast(unsigned, v)); return __builtin_bit_cast(float, h.lo) + __builtin_bit_cast(float, h.hi); }
__device__ __forceinline__ float max_halves(float v) { const HalfPair h = halves_u(__builtin_bit_cast(unsigned, v)); return fmaxf(__builtin_bit_cast(float, h.lo), __builtin_bit_cast(float, h.hi)); }
__device__ __forceinline__ unsigned or_halves(unsigned v) { const HalfPair h = halves_u(v); return h.lo | h.hi; }
__device__ __forceinline__ unsigned or32(unsigned v) { v |= (unsigned)dpp_i<0xB1>((int)v); v |= (unsigned)dpp_i<0x4E>((int)v); v |= (unsigned)dpp_i<0x141>((int)v); v |= (unsigned)dpp_i<0x140>((int)v); v |= (unsigned)swz16_i((int)v); return v; }

__constant__ double c_rope_inv[12] = {1.0, 0.19392274474868576, 0.03760603093086393, 0.007292664737217109, 0.001414213562373095, 0.0002742481756762073, 5.318295896944988e-05, 1.031338537721246e-05,
                                       1.0, 0.03760603093086393, 0.001414213562373095, 5.318295896944988e-05};
template <int MODE, bool GAIN = false, bool OUT8 = false>
__device__ __forceinline__ void transpose_item(const float* W, int K, int Nsrc, int nblk, bf16* WT, LAS float* scr, int item, int lane, const float* gk = nullptr, float ws = 1.f) {
    const int kb = item / nblk, nb = item % nblk, k0 = 64 * kb, n0 = 32 * nb;
    if (MODE && n0 >= C_KA && n0 < C_KA + 128) return;
    const int np = n0 + 4 * (lane & 7);
    const int src = MODE ? win_src(np) : np;
#pragma unroll
    for (int i = 0; i < 8; ++i) { const int kk = 8 * i + (lane >> 3);
        f32x4 v = (f32x4){0.f, 0.f, 0.f, 0.f};
        if (src >= 0) v = *(const f32x4*)(W + (size_t)(k0 + kk) * Nsrc + src);
        const float gg = GAIN ? gk[k0 + kk] : 1.f;
        LAS float* d = scr + kk * 33 + 4 * (lane & 7);
        d[0] = v.x * gg; d[1] = v.y * gg; d[2] = v.z * gg; d[3] = v.w * gg; }
    LDS_FENCE();
    const int c = lane & 7;
#pragma unroll
    for (int j = 0; j < 4; ++j) { const int n = (lane >> 3) + 8 * j; const LAS float* s = scr + (8 * c) * 33 + n;
        if (OUT8) { unsigned long long o = (unsigned long long)pg8::pk4_fp8(s[0 * 33] * ws, s[1 * 33] * ws, s[2 * 33] * ws, s[3 * 33] * ws) | ((unsigned long long)pg8::pk4_fp8(s[4 * 33] * ws, s[5 * 33] * ws, s[6 * 33] * ws, s[7 * 33] * ws) << 32);
            *(unsigned long long*)((unsigned char*)WT + (size_t)(n0 + n) * K + k0 + 8 * c) = o; }
        else { v4u o; o.x = pk2(s[0 * 33], s[1 * 33]); o.y = pk2(s[2 * 33], s[3 * 33]); o.z = pk2(s[4 * 33], s[5 * 33]); o.w = pk2(s[6 * 33], s[7 * 33]);
            *(v4u*)(WT + (size_t)(n0 + n) * K + k0 + 8 * c) = o; } }
    LDS_FENCE();
}

__device__ __forceinline__ bf16* w_in_t(unsigned char* ws_, int l)  { return (bf16*)(ws_ + WS_W + (size_t)l * W_LAYER_B); }
__device__ __forceinline__ bf16* w_out_t(unsigned char* ws_, int l) { return (bf16*)(ws_ + WS_W + (size_t)l * W_LAYER_B + W_IN_B); }
__device__ __forceinline__ bf16* w_up_t(unsigned char* ws_, int l)  { return (bf16*)(ws_ + WS_W + (size_t)l * W_LAYER_B + W_IN_B + W_OUT_B); }
__device__ __forceinline__ bf16* w_dn_t(unsigned char* ws_, int l)  { return (bf16*)(ws_ + WS_W + (size_t)l * W_LAYER_B + W_IN_B + W_OUT_B + W_UP_B); }

__device__ __forceinline__ void phase_prologue(Frame& F, const Args& args) {
    unsigned char* ws_ = F.ws; asm volatile("" : "+s"(ws_)); int lane_ = lane_id(); asm volatile("" : "+v"(lane_)); (void)ws_;
    LAS float* scr = (LAS float*)(F.lds + F.wave * WSCR);
    const int gw = F.vcu * NWAVES + F.wave, NGW = F.G * NWAVES;
    constexpr int I_IN = (D / 64) * (NP / 32), I_OUT = (D / 64) * (D / 32), I_UP = (D / 64) * (FF / 32), I_DN = (FF / 64) * (D / 32);
    for (int it = gw; it < DEPTH * I_IN; it += NGW) { const int l = it / I_IN, r = it % I_IN; transpose_item<1, true>(P_W_IN + (size_t)l * D * DIN, D, DIN, NP / 32, w_in_t(ws_, l), scr, r, lane_, P_G_PRE_MIX + l * D); }
    for (int it = gw; it < DEPTH * I_OUT; it += NGW) { const int l = it / I_OUT, r = it % I_OUT; transpose_item<0>(P_W_OUT + (size_t)l * D * D, D, D, D / 32, w_out_t(ws_, l), scr, r, lane_); }
    for (int it = gw; it < DEPTH * I_UP; it += NGW) { const int l = it / I_UP, r = it % I_UP; transpose_item<0, true, true>(P_W_UP + (size_t)l * D * FF, D, FF, FF / 32, w_up_t(ws_, l), scr, r, lane_, P_G_PRE_MLP + l * D, pg8::WUSC); }
    for (int it = gw; it < DEPTH * I_DN; it += NGW) { const int l = it / I_DN, r = it % I_DN; transpose_item<0, false, true>(P_W_DOWN + (size_t)l * FF * D, FF, D, D / 32, w_dn_t(ws_, l), scr, r, lane_, nullptr, pg8::WDSC); }
    for (int it = gw; it < DEPTH * D * 2; it += NGW) {
        const int l = it / (D * 2), r = it % (D * 2), k = r >> 1, n = lane_ + 64 * (r & 1);
        const float* wi = P_W_IN + ((size_t)l * D + k) * DIN + 256; const float* gk = P_G_KV_A + l * 128; const float* wu = P_W_KV_UP + (size_t)l * 128 * 128 + n;
        float acc = 0.f;
#pragma unroll 32
        for (int j = 0; j < 128; ++j) acc += (wi[j] * gk[j]) * wu[j * 128];
        w_in_t(ws_, l)[(size_t)(C_KA + n) * D + k] = (bf16)f2bf(acc * P_G_PRE_MIX[l * D + k]);
    }
    for (int it = gw; it < DEPTH * 2 * 2 * 32; it += NGW) {
        const int lk = it >> 6, part = (it >> 5) & 1, r = it & 31, l = lk >> 1, kv = lk & 1;
        const float* W = (kv ? P_W_CMP_V : P_W_CMP_K) + (size_t)l * 32 * 64 * 64 + (size_t)part * 1024 * 64;
        transpose_item<0>(W, 1024, 64, 2, (bf16*)(ws_ + WS_WCT) + ((size_t)lk * 128 + part * 64) * 1024, scr, r, lane_);
    }
    {
        __syncthreads();
        LAS float* part = (LAS float*)F.lds;
        for (int it = F.vcu; it < DEPTH * 2 * 8; it += F.G) {
            const int lk = it >> 3, kc = it & 7, l = lk >> 1, kv = lk & 1;
            const float* W = (kv ? P_W_CMP_V : P_W_CMP_K) + (size_t)l * 32 * 64 * 64 + lane_; const float* pe = (kv ? P_PE_V : P_PE_K) + l * 32 * 64;
            float acc = 0.f;
            const int kb0 = kc * 256 + F.wave * 32;
#pragma unroll
            for (int k = 0; k < 32; ++k) acc += pe[kb0 + k] * W[(size_t)(kb0 + k) * 64];
            part[F.wave * 64 + lane_] = acc;
            __syncthreads();
            if (F.wave == 0) { float t = 0.f;
#pragma unroll
                for (int w8 = 0; w8 < 8; ++w8) t += part[w8 * 64 + lane_];
                ((float*)(ws_ + WS_CB + 4096))[it * 64 + lane_] = t; }
            __syncthreads();
        }
    }
}
__device__ __forceinline__ void phase_prologue_b(Frame& F, const Args& args) {
    unsigned char* ws_ = F.ws; asm volatile("" : "+s"(ws_)); int lane_ = lane_id(); asm volatile("" : "+v"(lane_)); (void)ws_;
    const int gw = F.vcu * NWAVES + F.wave, NGW = F.G * NWAVES;
    if (gw < DEPTH * 2) { float t = 0.f;
#pragma unroll
        for (int kc = 0; kc < 8; ++kc) t += ((const float*)(ws_ + WS_CB + 4096))[(gw * 8 + kc) * 64 + lane_];
        ((float*)(ws_ + WS_CB))[gw * 64 + lane_] = t; }
    for (int e = gw * 64 + lane_; e < M * 12; e += NGW * 64) {
        const int row = e / 12, i = e % 12;
        const double inv = c_rope_inv[i];
        const double a = (double)P_POS[row] * inv;
        const double k = __builtin_rint(a * 0.15915494309189535);
        const float r = (float)(a - k * 6.283185307179586);
        const float c = __builtin_cosf(r), s = __builtin_sinf(r);
        float* t = B_ROPE + (size_t)row * 24;
        if (i < 8) { t[i] = c; t[8 + i] = s; } else { t[16 + (i - 8)] = c; t[20 + (i - 8)] = s; }
    }
    for (int m0 = gw * 4; m0 < M; m0 += NGW * 4) {
        f32x4 v[4][4];
#pragma unroll
        for (int k = 0; k < 4; ++k) { const f32x4* xr = (const f32x4*)(P_X_IN + (size_t)(m0 + k) * D) + lane_;
#pragma unroll
            for (int j = 0; j < 4; ++j) v[k][j] = xr[64 * j]; }
#pragma unroll
        for (int k = 0; k < 4; ++k) { float sq = 0.f;
#pragma unroll
            for (int j = 0; j < 4; ++j) sq += (v[k][j].x * v[k][j].x + v[k][j].y * v[k][j].y) + (v[k][j].z * v[k][j].z + v[k][j].w * v[k][j].w);
            const float rsv = rsqrtf(wave_sum(sq) * (1.f / D) + EPS);
            unsigned long long* o8 = (unsigned long long*)((bf16*)(ws_ + WS_XB) + (size_t)(m0 + k) * D) + lane_;
#pragma unroll
            for (int j = 0; j < 4; ++j) o8[64 * j] = (unsigned long long)pk2(v[k][j].x, v[k][j].y) | ((unsigned long long)pk2(v[k][j].z, v[k][j].w) << 32);
            if (lane_ == 0) ((float*)(ws_ + WS_RS))[m0 + k] = rsv; }
    }
}

typedef short bf16x8 __attribute__((ext_vector_type(8)));
typedef short s16x4 __attribute__((ext_vector_type(4)));
typedef float f32x16 __attribute__((ext_vector_type(16)));
#define MFMA32(a, b, c) __builtin_amdgcn_mfma_f32_32x32x16_bf16((a), (b), (c), 0, 0, 0)
__device__ __forceinline__ int crow(int r, int hi) { return (r & 3) + 8 * (r >> 2) + 4 * hi; }
__device__ __forceinline__ void wg_barrier() { asm volatile("s_waitcnt lgkmcnt(0)\n\ts_barrier" ::: "memory"); }

__device__ __forceinline__ void phase_prep(Frame& F, const Args& args, int l) {
    unsigned char* ws_ = F.ws; asm volatile("" : "+s"(ws_)); int lane_ = lane_id(); asm volatile("" : "+v"(lane_)); (void)ws_; (void)args;
    int tid_ = F.wave * 64 + lane_id(); asm volatile("" : "+v"(tid_));
    const int gw = F.vcu * NWAVES + F.wave, NGW = F.G * NWAVES, lane = lane_;
    {
        const int sub = lane >> 4, q = lane & 15;
        const bool r_idx = (q == 2), r_kv = (q >= 4 && q < 8), r_ka = (q < 2);
        const int which = q - 4;
        const int cbase = r_idx ? C_KIDX : (((which < 2) ? C_KSLC : C_KWIN) + (which & 1) * 64);
        constexpr int RB = 4;
        for (int row0 = gw * (4 * RB); row0 < M; row0 += NGW * (4 * RB)) {
            v4u cu[RB], ku[RB], e1[RB], e2[RB]; f32x4 t0[RB], t1[RB], t2[RB], t3[RB];
#pragma unroll
            for (int k = 0; k < RB; ++k) { const size_t row = (size_t)(row0 + 4 * k + sub); bf16* prow = B_PROJ + row * NP; const f32x4* tab = (const f32x4*)(B_ROPE + row * 24);
                cu[k] = *(const v4u*)(prow + C_CKV + 8 * q); ku[k] = *(const v4u*)(prow + C_KA + 8 * q);
                e1[k] = (v4u){0u, 0u, 0u, 0u}; e2[k] = e1[k]; t0[k] = (f32x4){0.f, 0.f, 0.f, 0.f}; t1[k] = t0[k]; t2[k] = t0[k]; t3[k] = t0[k];
                if (r_ka || r_kv) { t0[k] = tab[0]; t1[k] = tab[1]; t2[k] = tab[2]; t3[k] = tab[3]; }
                if (r_idx) { t0[k] = tab[4]; t2[k] = tab[5]; }
                if (r_idx || r_kv) e1[k] = *(const v4u*)(prow + cbase);
                if (r_kv) e2[k] = *(const v4u*)(prow + cbase + 8); }
#pragma unroll
            for (int k = 0; k < RB; ++k) { const size_t row = (size_t)(row0 + 4 * k + sub); bf16* prow = B_PROJ + row * NP;
                float x[8] = {bflo(cu[k].x), bfhi(cu[k].x), bflo(cu[k].y), bfhi(cu[k].y), bflo(cu[k].z), bfhi(cu[k].z), bflo(cu[k].w), bfhi(cu[k].w)};
                float ss = 0.f;
#pragma unroll
                for (int e = 0; e < 8; ++e) ss += x[e] * x[e];
                ss += dpp_f<0xB1>(ss); ss += dpp_f<0x4E>(ss); ss += dpp_f<0x141>(ss); ss += dpp_f<0x140>(ss);
                const float rs = rsqrtf(ss * (1.f / 128.f) + EPS);
                float y[8] = {bflo(ku[k].x) * rs, bfhi(ku[k].x) * rs, bflo(ku[k].y) * rs, bfhi(ku[k].y) * rs, bflo(ku[k].z) * rs, bfhi(ku[k].z) * rs, bflo(ku[k].w) * rs, bfhi(ku[k].w) * rs};
                const float cs[8] = {t0[k].x, t0[k].y, t0[k].z, t0[k].w, t1[k].x, t1[k].y, t1[k].z, t1[k].w};
                const float sn[8] = {t2[k].x, t2[k].y, t2[k].z, t2[k].w, t3[k].x, t3[k].y, t3[k].z, t3[k].w};
#pragma unroll
                for (int e = 0; e < 8; ++e) { const float pr = dpp_f<0xB1>(y[e]);
                    const float r0 = y[e] * cs[e] - pr * sn[e], r1 = pr * sn[e] + y[e] * cs[e];
                    y[e] = r_ka ? ((q == 0) ? r0 : r1) : y[e]; }
                *(v4u*)(prow + C_KA + 8 * q) = (v4u){pk2(y[0], y[1]), pk2(y[2], y[3]), pk2(y[4], y[5]), pk2(y[6], y[7])};
                if (r_idx) {
                    float z[8] = {bflo(e1[k].x), bfhi(e1[k].x), bflo(e1[k].y), bfhi(e1[k].y), bflo(e1[k].z), bfhi(e1[k].z), bflo(e1[k].w), bfhi(e1[k].w)};
                    const float ci[4] = {t0[k].x, t0[k].y, t0[k].z, t0[k].w}, si[4] = {t2[k].x, t2[k].y, t2[k].z, t2[k].w};
                    float o[8];
#pragma unroll
                    for (int i = 0; i < 4; ++i) { o[i] = z[i] * ci[i] - z[4 + i] * si[i]; o[4 + i] = z[i] * si[i] + z[4 + i] * ci[i]; }
                    *(v4u*)(prow + cbase) = (v4u){pk2(o[0], o[1]), pk2(o[2], o[3]), pk2(o[4], o[5]), pk2(o[6], o[7])};
                } else if (r_kv) {
                    float z1[8] = {bflo(e1[k].x), bfhi(e1[k].x), bflo(e1[k].y), bfhi(e1[k].y), bflo(e1[k].z), bfhi(e1[k].z), bflo(e1[k].w), bfhi(e1[k].w)};
                    float z2[8] = {bflo(e2[k].x), bfhi(e2[k].x), bflo(e2[k].y), bfhi(e2[k].y), bflo(e2[k].z), bfhi(e2[k].z), bflo(e2[k].w), bfhi(e2[k].w)};
                    float o1[8], o2[8];
#pragma unroll
                    for (int i = 0; i < 8; ++i) { o1[i] = z1[i] * cs[i] - z2[i] * sn[i]; o2[i] = z1[i] * sn[i] + z2[i] * cs[i]; }
                    *(v4u*)(prow + cbase) = (v4u){pk2(o1[0], o1[1]), pk2(o1[2], o1[3]), pk2(o1[4], o1[5]), pk2(o1[6], o1[7])};
                    *(v4u*)(prow + cbase + 8) = (v4u){pk2(o2[0], o2[1]), pk2(o2[2], o2[3]), pk2(o2[4], o2[5]), pk2(o2[6], o2[7])};
                }
            }
        }
    }
    {
        const int wid = F.wave, r32 = lane & 31, hi = lane >> 5;
        LAS float* P = (LAS float*)F.lds;
        for (int u = F.vcu; u < BATCH * 8; u += F.G) {
            const int b = u >> 3, g = (u >> 2) & 1, kv = (u >> 1) & 1, eh = u & 1;
            const int rt = wid >> 1, part = wid & 1;
            const bf16* ap = B_PROJ + ((size_t)b * S + 16 * (32 * rt + r32)) * NP + (kv ? C_VCMP : C_KCMP) + g * 64 + 8 * hi;
            const bf16* bp = (const bf16*)(ws_ + WS_WCT) + ((size_t)(l * 2 + kv) * 128 + part * 64 + eh * 32 + r32) * 1024 + 8 * hi;
            f32x16 acc = {};
#pragma unroll 8
            for (int ks = 0; ks < 64; ++ks) {
                const bf16x8 a = *(const bf16x8*)(ap + (size_t)(ks >> 2) * NP + 16 * (ks & 3));
                const bf16x8 bq = *(const bf16x8*)(bp + 16 * ks);
                acc = MFMA32(a, bq, acc);
            }
#pragma unroll
            for (int r = 0; r < 16; ++r) P[(part * 128 + 32 * rt + crow(r, hi)) * 32 + r32] = acc[r];
            wg_barrier();
            const float* cb = (const float*)(ws_ + WS_CB) + (l * 2 + kv) * 64 + eh * 32;
            bf16* ob = (bf16*)(ws_ + (kv ? WS_VCB : WS_KCB)) + (size_t)(b * 2 + g) * 128 * 64 + eh * 32;
            for (int idx = tid_; idx < 128 * 32; idx += 512) { const int c = idx >> 5, e = idx & 31;
                const float v = (c < NC) ? (P[c * 32 + e] + P[(128 + c + 1) * 32 + e] + cb[e]) : 0.f;
                ob[c * 64 + e] = (bf16)f2bf(v); }
            wg_barrier();
        }
    }
}

typedef float f32x2_t __attribute__((ext_vector_type(2))); typedef __bf16 bf16x2_t __attribute__((ext_vector_type(2)));
__device__ __forceinline__ unsigned cvtpk(float lo, float hi) { const f32x2_t v = {lo, hi}; const bf16x2_t b = __builtin_convertvector(v, bf16x2_t); return __builtin_bit_cast(unsigned, b); }
constexpr float C2 = 0.125f * 1.4426950408889634f;

__device__ __forceinline__ unsigned idxmask(int x, int hi) {
    unsigned m = 0u;
#pragma unroll
    for (int g = 0; g < 4; ++g) { int n = x - (8 * g + 4 * hi); n = n < 0 ? 0 : (n > 4 ? 4 : n); m |= ((1u << n) - 1u) << (4 * g); }
    return m;
}

__device__ __forceinline__ size_t mask_idx(int b, int t, int blk) { return ((((size_t)b * 64 + (t >> 5)) * 32 + (blk >> 1)) * 32 + (t & 31)) * 2 + (blk & 1); }
constexpr int SEL_QF = 0, SEL_PART = 16384, SEL_HIST = 20480, SEL_HP = 260, SEL_RES = SEL_HIST + 32 * SEL_HP * 4;
__device__ __forceinline__ void dsa_select_unit(unsigned char* ws_, int tid_, int b, int qt32, LAS unsigned char* lds) {
    asm volatile("" : "+v"(tid_)); asm volatile("" : "+s"(ws_));
    const int lane = tid_ & 63, wid = __builtin_amdgcn_readfirstlane(tid_ >> 6), r32 = lane & 31, hi = lane >> 5;
    unsigned* maskbuf = (unsigned*)(ws_ + WS_MASK);
    if (qt32 < 8) {
        for (int i = tid_; i < 2048; i += 512) { const int qq = i >> 6, blk = i & 63; const int t = 32 * qt32 + qq; const int d = t - 32 * blk;
            const unsigned w = d < 0 ? 0u : (d >= 31 ? 0xffffffffu : ((2u << d) - 1u));
            maskbuf[mask_idx(b, t, blk)] = w; }
        return;
    }
    const size_t qrow = (size_t)b * S + 32 * qt32 + r32;
    const bf16* prow = B_PROJ + qrow * NP;
    {
        const int h = wid >> 1, sk = wid & 1;
        const v4u raw = *(const v4u*)(prow + C_QIDX + h * 32 + 16 * sk + 8 * hi);
        float x[8] = {bflo(raw.x), bfhi(raw.x), bflo(raw.y), bfhi(raw.y), bflo(raw.z), bfhi(raw.z), bflo(raw.w), bfhi(raw.w)};
        if (sk == 0 && hi == 0) { const float* tab = B_ROPE + qrow * 24;
#pragma unroll
            for (int i = 0; i < 4; ++i) { const float c = tab[16 + i], sn = tab[20 + i]; const float x1 = x[i], x2 = x[4 + i]; x[i] = x1 * c - x2 * sn; x[4 + i] = x1 * sn + x2 * c; } }
        v4u hp, lp;
        { unsigned hh[4], ll[4];
#pragma unroll
          for (int k = 0; k < 4; ++k) { const float a = x[2 * k], bb = x[2 * k + 1]; const unsigned ha = f2bf(a), hb = f2bf(bb); hh[k] = ha | (hb << 16);
              ll[k] = pk2(a - bf2f((bf16)ha), bb - bf2f((bf16)hb)); }
          hp = (v4u){hh[0], hh[1], hh[2], hh[3]}; lp = (v4u){ll[0], ll[1], ll[2], ll[3]}; }
        LAS v4u* qf = (LAS v4u*)(lds + SEL_QF);
        qf[((h * 2 + sk) * 2 + 0) * 64 + lane] = hp; qf[((h * 2 + sk) * 2 + 1) * 64 + lane] = lp;
    }
    float w[4];
#pragma unroll
    for (int h = 0; h < 4; ++h) w[h] = bf2f(prow[C_WIDX + h]);
    __syncthreads();
    const int nblk = qt32 + 1;
    const bf16* kbase = B_PROJ + (size_t)b * S * NP + C_KIDX;
    unsigned key[8][16];
#pragma unroll
    for (int i = 0; i < 8; ++i) {
        const int blk = wid + 8 * i;
        if (blk < nblk) {
            const bf16* kp = kbase + (size_t)(32 * blk + r32) * NP + 8 * hi;
            const bf16x8 kf0 = *(const bf16x8*)kp, kf1 = *(const bf16x8*)(kp + 16);
            float sc[16];
            const LAS bf16x8* qf = (const LAS bf16x8*)(lds + SEL_QF);
#pragma unroll
            for (int h = 0; h < 4; ++h) {
                f32x16 acc = {};
                acc = MFMA32(kf0, qf[((h * 2 + 0) * 2 + 0) * 64 + lane], acc);
                acc = MFMA32(kf1, qf[((h * 2 + 1) * 2 + 0) * 64 + lane], acc);
                acc = MFMA32(kf0, qf[((h * 2 + 0) * 2 + 1) * 64 + lane], acc);
                acc = MFMA32(kf1, qf[((h * 2 + 1) * 2 + 1) * 64 + lane], acc);
#pragma unroll
                for (int r = 0; r < 16; ++r) sc[r] = (h == 0) ? w[0] * fmaxf(acc[r], 0.f) : fmaf(w[h], fmaxf(acc[r], 0.f), sc[r]);
            }
#pragma unroll
            for (int r = 0; r < 16; ++r) {
                unsigned bits = __builtin_bit_cast(unsigned, sc[r]);
                if (bits == 0x80000000u) bits = 0u;
                unsigned k = (bits & 0x80000000u) ? ~bits : (bits | 0x80000000u);
                if (blk == qt32 && crow(r, hi) > r32) k = 0u;
                key[i][r] = k;
            }
        } else {
#pragma unroll
            for (int r = 0; r < 16; ++r) key[i][r] = 0u;
        }
    }
    LAS unsigned* part = (LAS unsigned*)(lds + SEL_PART);
    int pbi = 0;
#define SEL_REDUCE(cnt_, tot_) do { LAS unsigned* pb_ = part + (pbi & 1) * 512; ++pbi; pb_[wid * 64 + lane] = (cnt_); wg_barrier(); unsigned t_ = 0u; \
        _Pragma("unroll") for (int w8 = 0; w8 < 8; ++w8) t_ += pb_[w8 * 64 + r32] + pb_[w8 * 64 + 32 + r32]; (tot_) = t_; } while (0)
    LAS unsigned* hist = (LAS unsigned*)(lds + SEL_HIST);
    LAS unsigned* resd = (LAS unsigned*)(lds + SEL_RES);
    { unsigned z_ = 0u; asm volatile("" : "+v"(z_)); const v4u zz = {z_, z_, z_, z_}; for (int i = tid_; i < 32 * SEL_HP / 4; i += 512) ((LAS v4u*)hist)[i] = zz; }
    wg_barrier();
    unsigned pfx = 0u, need = 256u;
    LAS unsigned* hrow = hist + r32 * SEL_HP;
#pragma unroll 1
    for (int pass = 0; pass < 4; ++pass) {
        const int shift = 24 - 8 * pass;
#pragma unroll
        for (int i = 0; i < 8; ++i) if (wid + 8 * i < nblk) {
#pragma unroll
            for (int r = 0; r < 16; ++r) {
                const unsigned k = key[i][r];
                const unsigned dg = (k >> shift) & 255u;
                const bool match = (pass == 0) || ((k >> (shift + 8)) == pfx);
                __hip_atomic_fetch_add(hrow + (match ? dg : 256u), 1u, __ATOMIC_RELAXED, __HIP_MEMORY_SCOPE_WORKGROUP);
            } }
        wg_barrier();
        {
            const int qq = lane >> 4, t16 = lane & 15, q = 4 * wid + qq;
            LAS v4u* hq = (LAS v4u*)(hist + q * SEL_HP + 16 * t16);
            unsigned g4[4];
#pragma unroll
            for (int i = 0; i < 4; ++i) { const v4u hv = hq[i]; g4[i] = (hv.x + hv.y) + (hv.z + hv.w); }
            const unsigned sL = (g4[0] + g4[1]) + (g4[2] + g4[3]);
            unsigned T = sL;
            T += (unsigned)dpp_i<0x101>((int)T); T += (unsigned)dpp_i<0x102>((int)T); T += (unsigned)dpp_i<0x104>((int)T); T += (unsigned)dpp_i<0x108>((int)T);
            const unsigned needq = (pass == 0) ? 256u : resd[32 + q];
            const unsigned long long bal = __ballot(T >= needq);
            const unsigned rowbits = (unsigned)(bal >> (16 * qq)) & 0xFFFFu;
            const int ts = 31 - __builtin_clz(rowbits | 1u);
            {
                const unsigned rem = needq - (T - sL);
                unsigned c = 0u; int gs = 0; unsigned abg = 0u; bool found = false;
#pragma unroll
                for (int i = 3; i >= 0; --i) { const unsigned cn = c + g4[i]; if (!found && rem <= cn) { gs = i; abg = c; found = true; } c = cn; }
                const v4u hv = hq[gs];
                const unsigned r2 = rem - abg;
                const unsigned c3 = hv.w, c2 = c3 + hv.z, c1 = c2 + hv.y;
                int d; unsigned ab;
                if (r2 <= c3) { d = 3; ab = 0u; } else if (r2 <= c2) { d = 2; ab = c3; } else if (r2 <= c1) { d = 1; ab = c2; } else { d = 0; ab = c1; }
                asm volatile("s_waitcnt lgkmcnt(0)" ::: "memory");
                const unsigned cd = (d == 3) ? hv.w : (d == 2) ? hv.z : (d == 1) ? hv.y : hv.x;
                if (t16 == ts) { resd[q] = 16u * (unsigned)ts + 4u * (unsigned)gs + (unsigned)d; resd[32 + q] = r2 - ab; resd[64 + q] = (cd == r2 - ab) ? 1u : 0u; }
            }
            { unsigned z_ = 0u; asm volatile("" : "+v"(z_)); const v4u zz = {z_, z_, z_, z_};
              hq[0] = zz; hq[1] = zz; hq[2] = zz; hq[3] = zz; if (t16 == 0) hist[q * SEL_HP + 256] = z_; }
        }
        wg_barrier();
        pfx = (pfx << 8) | resd[r32]; need = resd[32 + r32];
    }
    const unsigned thr = pfx;
    if (__all(resd[64 + r32] != 0u)) {
#pragma unroll
        for (int i = 0; i < 8; ++i) {
            const int blk = wid + 8 * i; unsigned selm = 0u;
            if (blk < nblk) {
#pragma unroll
                for (int r = 0; r < 16; ++r) selm |= (key[i][r] >= thr) ? (1u << r) : 0u; }
            unsigned word = ((selm & 0xFu) | ((selm & 0xF0u) << 4) | ((selm & 0xF00u) << 8) | ((selm & 0xF000u) << 12)) << (4 * hi);
            word = or_halves(word);
            if (hi == 0) maskbuf[mask_idx(b, 32 * qt32 + r32, blk)] = word;
        }
        __syncthreads();
        return;
    }
    unsigned gtm[8], eqm[8];
#pragma unroll
    for (int i = 0; i < 8; ++i) { unsigned g = 0u, e = 0u;
        if (wid + 8 * i < nblk) {
#pragma unroll
            for (int r = 0; r < 16; ++r) { g |= (key[i][r] > thr) ? (1u << r) : 0u; e |= (key[i][r] == thr) ? (1u << r) : 0u; } }
        gtm[i] = g; eqm[i] = e; }
    const unsigned rneed = need;
    unsigned pc[8];
#pragma unroll
    for (int i = 0; i < 8; ++i) pc[i] = __builtin_popcount(eqm[i]);
    unsigned Y = 0u;
    for (int bit = 10; bit >= 5; --bit) {
        const unsigned c = Y | (1u << bit); const int cb = (int)(c >> 5);
        unsigned cnt = 0u;
#pragma unroll
        for (int i = 0; i < 8; ++i) cnt += (wid + 8 * i < cb) ? pc[i] : 0u;
        unsigned tot; SEL_REDUCE(cnt, tot);
        if (tot < rneed) Y = c;
    }
    {
        const int yb = (int)(Y >> 5);
        unsigned cbase = 0u, em = 0u;
#pragma unroll
        for (int i = 0; i < 8; ++i) { cbase += (wid + 8 * i < yb) ? pc[i] : 0u; em |= (wid + 8 * i == yb) ? eqm[i] : 0u; }
        for (int bit = 4; bit >= 0; --bit) {
            const unsigned c = Y | (1u << bit);
            const unsigned cnt = cbase + __builtin_popcount(em & idxmask((int)(c & 31u), hi));
            unsigned tot; SEL_REDUCE(cnt, tot);
            if (tot < rneed) Y = c;
        }
    }
#undef SEL_REDUCE
#pragma unroll
    for (int i = 0; i < 8; ++i) {
        const int blk = wid + 8 * i;
        const unsigned selm = gtm[i] | (eqm[i] & idxmask((int)Y + 1 - 32 * blk, hi));
        unsigned word = ((selm & 0xFu) | ((selm & 0xF0u) << 4) | ((selm & 0xF00u) << 8) | ((selm & 0xF000u) << 12)) << (4 * hi);
        word = or_halves(word);
        if (hi == 0) maskbuf[mask_idx(b, 32 * qt32 + r32, blk)] = word;
    }
    __syncthreads();
}

constexpr int AT_K = 0, AT_V = 32768, AT_WS = 132096;
typedef short v4i16_t __attribute__((ext_vector_type(4)));
__device__ __forceinline__ s16x4 vtr(unsigned addr) { return __builtin_bit_cast(s16x4, __builtin_amdgcn_ds_read_tr16_b64_v4i16((LAS v4i16_t*)(uintptr_t)addr)); }
template <bool ROWSUM = true>
__device__ __forceinline__ void pv(f32x16* o, f32x16& lacc, unsigned vb, bf16x8 pa0, bf16x8 pa1, bf16x8 pa2, bf16x8 pa3) {
    if (ROWSUM) { const bf16x8 ones = {0x3F80, 0x3F80, 0x3F80, 0x3F80, 0x3F80, 0x3F80, 0x3F80, 0x3F80};
      lacc = MFMA32(pa0, ones, lacc); lacc = MFMA32(pa1, ones, lacc); lacc = MFMA32(pa2, ones, lacc); lacc = MFMA32(pa3, ones, lacc); }
#pragma unroll
    for (int d0 = 0; d0 < 2; ++d0) {
        const s16x4 lo0 = vtr(vb + d0 * 4096 + 0), hi0 = vtr(vb + d0 * 4096 + 512), lo1 = vtr(vb + d0 * 4096 + 1024), hi1 = vtr(vb + d0 * 4096 + 1536);
        const s16x4 lo2 = vtr(vb + d0 * 4096 + 2048), hi2 = vtr(vb + d0 * 4096 + 2560), lo3 = vtr(vb + d0 * 4096 + 3072), hi3 = vtr(vb + d0 * 4096 + 3584);
#define PKV(l_, h_) (bf16x8){l_[0], l_[1], l_[2], l_[3], h_[0], h_[1], h_[2], h_[3]}
        o[d0] = MFMA32(pa0, PKV(lo0, hi0), o[d0]);
        o[d0] = MFMA32(pa1, PKV(lo1, hi1), o[d0]);
        o[d0] = MFMA32(pa2, PKV(lo2, hi2), o[d0]);
        o[d0] = MFMA32(pa3, PKV(lo3, hi3), o[d0]);
#undef PKV
    }
}
struct SmState { float mhat; f32x16 o[2]; f32x16 lacc; };
__device__ __forceinline__ unsigned bfe1(unsigned w, int c) { int r; asm("v_bfe_i32 %0, %1, %2, 1" : "=v"(r) : "v"(w), "n"(c)); return (unsigned)r; }
__device__ __forceinline__ float rowmax32(const f32x16& p0, const f32x16& p1) {
    float a = fmaxf(p0[0], p1[0]);
#pragma unroll
    for (int r = 1; r < 16; ++r) a = fmaxf(a, fmaxf(p0[r], p1[r]));
    return max_halves(a);
}
constexpr int NS_QF = 65536, NS_SELS = 98304, NS_SSUM = 136192, NS_SELM = 144384;
static_assert(NS_SELS + 32768 <= LDSCTL_OFF && AT_WS >= MISC_OFF + 256 && NS_SELM + 256 <= LDS_BYTES, "attention LDS map");
__device__ __forceinline__ unsigned range32(int lo, int up) {
    const int l2 = lo < 0 ? 0 : lo, u2 = up > 31 ? 31 : up;
    const unsigned hm = (u2 >= 31) ? ~0u : ((2u << (u2 & 31)) - 1u);
    const unsigned lm = (1u << (l2 & 31)) - 1u;
    return (up < 0 || lo > 31 || u2 < l2) ? 0u : (hm & ~lm);
}
struct M64 { unsigned x, y; };
__device__ __forceinline__ M64 mask_range(int lo, int up) { M64 m; m.x = range32(lo, up); m.y = range32(lo - 32, up - 32); return m; }
__device__ __forceinline__ void load_q(bf16x8* qr, const bf16* qp, const float* tab, bool rope, int hi) {
#pragma unroll
    for (int d0 = 0; d0 < 4; ++d0) {
        const v4u raw = *(const v4u*)(qp + 16 * d0);
        float x[8] = {bflo(raw.x), bfhi(raw.x), bflo(raw.y), bfhi(raw.y), bflo(raw.z), bfhi(raw.z), bflo(raw.w), bfhi(raw.w)};
        if (d0 == 0) {
#pragma unroll
            for (int j = 0; j < 8; ++j) { const float other = other_half_f(x[j], hi); const float c = tab[j], sn = tab[8 + j];
                const float rot = (hi == 0) ? (x[j] * c - other * sn) : (other * sn + x[j] * c); x[j] = rope ? rot : x[j]; }
        }
        v4u pk; pk.x = cvtpk(x[0] * C2, x[1] * C2); pk.y = cvtpk(x[2] * C2, x[3] * C2); pk.z = cvtpk(x[4] * C2, x[5] * C2); pk.w = cvtpk(x[6] * C2, x[7] * C2);
        qr[d0] = __builtin_bit_cast(bf16x8, pk);
    }
}
__device__ __forceinline__ void qkt_lq(f32x16& p0, f32x16& p1, const LAS unsigned char* Kslot, const LAS bf16x8* qf, int lane, int r32, int hi) {
    const LAS unsigned char* kb = Kslot + hi * 1024 + r32 * 16;
    p0 = f32x16{}; p1 = f32x16{};
#pragma unroll
    for (int d0 = 0; d0 < 4; ++d0) {
        const bf16x8 b0 = *(const LAS bf16x8*)(kb + d0 * 2048);
        const bf16x8 b1 = *(const LAS bf16x8*)(kb + d0 * 2048 + 512);
        const bf16x8 q = qf[d0 * 64 + lane];
        p0 = MFMA32(b0, q, p0); p1 = MFMA32(b1, q, p1);
        if (d0 & 1) __builtin_amdgcn_sched_barrier(0);
    }
}
template <bool SEL>
__device__ __forceinline__ void softmax_pv(SmState& st, f32x16& osel, f32x16& p0, f32x16& p1, unsigned vb, const M64 mcur, bool first, LAS float* wsf, int r32, int hi, int ctile) {
    (void)first; (void)wsf; (void)r32;
    const unsigned wx = mcur.x >> (4 * hi), wy = mcur.y >> (4 * hi);
    unsigned e0[16], e1[16];
#pragma unroll
    for (int r = 0; r < 16; ++r) { e0[r] = __builtin_bit_cast(unsigned, __builtin_amdgcn_exp2f(p0[r])); e1[r] = __builtin_bit_cast(unsigned, __builtin_amdgcn_exp2f(p1[r])); }
    const bool lane_uniform = !SEL && __all((mcur.x == mcur.y) && ((mcur.x + 1u) <= 1u));
    if (!lane_uniform && !__all((mcur.x & mcur.y) == ~0u)) {
#pragma unroll
        for (int r = 0; r < 16; ++r) { const int c = (r & 3) + 8 * (r >> 2); e0[r] &= bfe1(wx, c); e1[r] &= bfe1(wy, c); }
    }
    unsigned pw[16];
#pragma unroll
    for (int k = 0; k < 8; ++k) { pw[k] = cvtpk(__builtin_bit_cast(float, e0[2 * k]), __builtin_bit_cast(float, e0[2 * k + 1])); pw[8 + k] = cvtpk(__builtin_bit_cast(float, e1[2 * k]), __builtin_bit_cast(float, e1[2 * k + 1])); }
    if (lane_uniform) {
#pragma unroll
        for (int k = 0; k < 16; ++k) pw[k] &= mcur.x;
    }
    if (SEL) {
#pragma unroll
        for (int ks = 0; ks < 4; ++ks) {
            unsigned ov[4], pl[4];
#pragma unroll
            for (int k = 0; k < 4; ++k) {
                const int j0 = 2 * k, j1 = 2 * k + 1;
                const int c0 = 64 * ctile + 16 * ks + 8 * (j0 >> 2) + 4 * hi + (j0 & 3), c1 = 64 * ctile + 16 * ks + 8 * (j1 >> 2) + 4 * hi + (j1 & 3);
                const unsigned a = (c0 >= 4 * r32 - 1 && c0 <= 4 * r32 + 3) ? 0x3F80u : 0u, bq = (c1 >= 4 * r32 - 1 && c1 <= 4 * r32 + 3) ? 0x3F80u : 0u;
                ov[k] = a | (bq << 16);
                const int e = 4 * ks + k;
                const float v0 = __builtin_bit_cast(float, (e < 8) ? e0[2 * e] : e1[2 * (e - 8)]), v1 = __builtin_bit_cast(float, (e < 8) ? e0[2 * e + 1] : e1[2 * (e - 8) + 1]);
                pl[k] = cvtpk(v0 - bflo(pw[e]), v1 - bfhi(pw[e]));
            }
            const bf16x8 ovf = __builtin_bit_cast(bf16x8, (v4u){ov[0], ov[1], ov[2], ov[3]});
            osel = MFMA32(__builtin_bit_cast(bf16x8, (v4u){pw[4 * ks], pw[4 * ks + 1], pw[4 * ks + 2], pw[4 * ks + 3]}), ovf, osel);
            osel = MFMA32(__builtin_bit_cast(bf16x8, (v4u){pl[0], pl[1], pl[2], pl[3]}), ovf, osel);
        }
    }
    pv(st.o, st.lacc, vb, __builtin_bit_cast(bf16x8, (v4u){pw[0], pw[1], pw[2], pw[3]}), __builtin_bit_cast(bf16x8, (v4u){pw[4], pw[5], pw[6], pw[7]}),
       __builtin_bit_cast(bf16x8, (v4u){pw[8], pw[9], pw[10], pw[11]}), __builtin_bit_cast(bf16x8, (v4u){pw[12], pw[13], pw[14], pw[15]}));
}
template <bool SEL>
__device__ __forceinline__ void tile_step(SmState& st, f32x16& osel, const LAS unsigned char* Kslot, unsigned vb, const LAS bf16x8* qf, const M64 mcur, bool first, LAS float* wsf, int lane, int r32, int hi, int ctile) {
    f32x16 p0, p1;
    qkt_lq(p0, p1, Kslot, qf, lane, r32, hi);
    softmax_pv<SEL>(st, osel, p0, p1, vb, mcur, first, wsf, r32, hi, ctile);
}
__device__ __forceinline__ void qkt_rq(f32x16& p0, f32x16& p1, const LAS unsigned char* Kslot, const bf16x8* qr, int r32, int hi) {
    const LAS unsigned char* kb = Kslot + hi * 1024 + r32 * 16;
    p0 = f32x16{}; p1 = f32x16{};
#pragma unroll
    for (int d0 = 0; d0 < 4; ++d0) {
        const bf16x8 b0 = *(const LAS bf16x8*)(kb + d0 * 2048);
        const bf16x8 b1 = *(const LAS bf16x8*)(kb + d0 * 2048 + 512);
        p0 = MFMA32(b0, qr[d0], p0); p1 = MFMA32(b1, qr[d0], p1);
    }
}
__device__ __forceinline__ void sm_reset(SmState& st) { st.mhat = 0.f; st.o[0] = f32x16{}; st.o[1] = f32x16{}; st.lacc = f32x16{}; }
__device__ __forceinline__ float sigmoidf_(float x) { return 1.f / (1.f + __expf(-x)); }

__device__ __forceinline__ void dsa_attn_unit(unsigned char* ws_, int tid_, int b, int qt, LAS unsigned char* lds) {
    asm volatile("" : "+v"(tid_)); asm volatile("" : "+s"(ws_));
    const int lane = tid_ & 63, wid = __builtin_amdgcn_readfirstlane(tid_ >> 6), r32 = lane & 31, hi = lane >> 5;
    const int h = wid >> 1, qh = wid & 1;
    const size_t qrow = (size_t)b * S + 64 * qt + 32 * qh + r32;
    LAS float* wsf = (LAS float*)(lds + AT_WS) + wid * 128;
    bf16x8 qr[4];
    {
        const bf16* qp = B_PROJ + qrow * NP + C_QA + h * 64 + 8 * hi;
        const float* tab = B_ROPE + qrow * 24;
#pragma unroll
        for (int d0 = 0; d0 < 4; ++d0) {
            const v4u raw = *(const v4u*)(qp + 16 * d0);
            float x[8] = {bflo(raw.x), bfhi(raw.x), bflo(raw.y), bfhi(raw.y), bflo(raw.z), bfhi(raw.z), bflo(raw.w), bfhi(raw.w)};
            if (d0 == 0) {
#pragma unroll
                for (int j = 0; j < 8; ++j) { const float other = other_half_f(x[j], hi); const float c = tab[j], sn = tab[8 + j];
                    x[j] = (hi == 0) ? (x[j] * c - other * sn) : (other * sn + x[j] * c); }
            }
            v4u pk; pk.x = cvtpk(x[0] * C2, x[1] * C2); pk.y = cvtpk(x[2] * C2, x[3] * C2); pk.z = cvtpk(x[4] * C2, x[5] * C2); pk.w = cvtpk(x[6] * C2, x[7] * C2);
            qr[d0] = __builtin_bit_cast(bf16x8, pk);
        }
    }
    constexpr int DK = 0, DV = 32768;
    const bf16* KAb = B_PROJ + (size_t)b * S * NP;
    const bf16* ksrc = KAb + (size_t)lane * NP + C_KA + wid * 8;
    const bf16* vsrc = KAb + (size_t)(16 * (wid & 3) + (lane >> 2)) * NP + C_VA + (wid >> 2) * 32 + (lane & 3) * 8;
#define AT_DMA(t, slot) do { \
        __builtin_amdgcn_global_load_lds((const unsigned*)(ksrc + (size_t)(t) * 64 * NP), (LAS unsigned*)(lds + DK + (slot) * 8192 + wid * 1024), 16, 0, 0); \
        __builtin_amdgcn_global_load_lds((const unsigned*)(vsrc + (size_t)(t) * 64 * NP), (LAS unsigned*)(lds + DV + (slot) * 8192 + wid * 1024), 16, 0, 0); } while (0)
    const unsigned vb0 = (unsigned)(uintptr_t)(lds + DV) + ((lane >> 4) & 1) * 32 + (lane & 3) * 8 + (4 * hi + ((lane & 15) >> 2)) * 64;
    const LAS unsigned char* kb0 = lds + DK + hi * 1024 + r32 * 16;
    const int NT = qt + 1;
    SmState st; sm_reset(st);
    const unsigned long long* mrow = (const unsigned long long*)((const unsigned*)(ws_ + WS_MASK) + mask_idx(b, 64 * qt + 32 * qh + r32, 0));
    AT_DMA(0, 0);
    unsigned long long m0 = mrow[0], m1 = 0ull, m2 = 0ull;
    if (NT > 1) { AT_DMA(1, 1); m1 = mrow[32]; }
    (void)wsf;
#define SBAR() __builtin_amdgcn_sched_barrier(0)
#define PINV(x) asm volatile("" : "+v"(x))
#define KFR(t_, d0_, n_) (*(const LAS bf16x8*)(kb0 + ((t_) & 3) * 8192 + (d0_) * 2048 + (n_) * 512))
    f32x16 c0, c1;
    unsigned e0[16], e1[16];
    unsigned pw[16];
    unsigned long long mprev;
    {
        if (NT > 1) asm volatile("s_waitcnt vmcnt(3)" ::: "memory"); else asm volatile("s_waitcnt vmcnt(0)" ::: "memory");
        wg_barrier();
        if (NT > 2) { AT_DMA(2, 2); m2 = mrow[64]; }
        mprev = m0; m0 = m1; m1 = m2;
        c0 = f32x16{}; c1 = f32x16{};
#pragma unroll
        for (int d0 = 0; d0 < 4; ++d0) { c0 = MFMA32(KFR(0, d0, 0), qr[d0], c0); c1 = MFMA32(KFR(0, d0, 1), qr[d0], c1); }
#pragma unroll
        for (int r = 0; r < 16; ++r) { e0[r] = __builtin_bit_cast(unsigned, __builtin_amdgcn_exp2f(c0[r])); e1[r] = __builtin_bit_cast(unsigned, __builtin_amdgcn_exp2f(c1[r])); }
    }
    const bf16x8 ones = {0x3F80, 0x3F80, 0x3F80, 0x3F80, 0x3F80, 0x3F80, 0x3F80, 0x3F80};
#define MPK(E_, W_, r_) (E_[r_] & bfe1(W_, ((r_) & 3) + 8 * ((r_) >> 2)))
#define PACK_SLICE(g_) do { if ((g_) < 4) { pw[2 * (g_)] = cvtpk(__builtin_bit_cast(float, MPK(e0, wx, 4 * (g_))), __builtin_bit_cast(float, MPK(e0, wx, 4 * (g_) + 1))); \
                                            pw[2 * (g_) + 1] = cvtpk(__builtin_bit_cast(float, MPK(e0, wx, 4 * (g_) + 2)), __builtin_bit_cast(float, MPK(e0, wx, 4 * (g_) + 3))); } \
        else { pw[2 * (g_)] = cvtpk(__builtin_bit_cast(float, MPK(e1, wy, 4 * ((g_) - 4))), __builtin_bit_cast(float, MPK(e1, wy, 4 * ((g_) - 4) + 1))); \
               pw[2 * (g_) + 1] = cvtpk(__builtin_bit_cast(float, MPK(e1, wy, 4 * ((g_) - 4) + 2)), __builtin_bit_cast(float, MPK(e1, wy, 4 * ((g_) - 4) + 3))); } \
        PINV(pw[2 * (g_)]); PINV(pw[2 * (g_) + 1]); } while (0)
#define PAF(j_) __builtin_bit_cast(bf16x8, (v4u){pw[4 * (j_)], pw[4 * (j_) + 1], pw[4 * (j_) + 2], pw[4 * (j_) + 3]})
#define VFRAG(d0_, j_) (bf16x8){vlo[d0_][j_][0], vlo[d0_][j_][1], vlo[d0_][j_][2], vlo[d0_][j_][3], vhi[d0_][j_][0], vhi[d0_][j_][1], vhi[d0_][j_][2], vhi[d0_][j_][3]}
#define EXPS(C_, E_, r_) do { E_[r_] = __builtin_bit_cast(unsigned, __builtin_amdgcn_exp2f(C_[r_])); PINV(E_[r_]); } while (0)
    for (int t = 1; t < NT; ++t) {
        if (t + 1 < NT) asm volatile("s_waitcnt vmcnt(3)" ::: "memory"); else asm volatile("s_waitcnt vmcnt(0)" ::: "memory");
        wg_barrier();
        if (t + 2 < NT) { AT_DMA(t + 2, (t + 2) & 3); m2 = mrow[32 * (t + 2)]; }
        const unsigned wx = (unsigned)mprev >> (4 * hi), wy = (unsigned)(mprev >> 32) >> (4 * hi);
        const unsigned vbp = vb0 + ((t - 1) & 3) * 8192;
        bf16x8 kf[8];
#pragma unroll
        for (int i = 0; i < 8; ++i) kf[i] = KFR(t, i >> 1, i & 1);
        SBAR();
        c0 = MFMA32(kf[0], qr[0], (f32x16{})); PACK_SLICE(0); SBAR();
        c1 = MFMA32(kf[1], qr[0], (f32x16{})); PACK_SLICE(1); SBAR();
        c0 = MFMA32(kf[2], qr[1], c0); PACK_SLICE(2); SBAR();
        c1 = MFMA32(kf[3], qr[1], c1); PACK_SLICE(3); SBAR();
        c0 = MFMA32(kf[4], qr[2], c0); PACK_SLICE(4); SBAR();
        c1 = MFMA32(kf[5], qr[2], c1); PACK_SLICE(5); SBAR();
        c0 = MFMA32(kf[6], qr[3], c0); PACK_SLICE(6); SBAR();
        c1 = MFMA32(kf[7], qr[3], c1); PACK_SLICE(7); SBAR();
        s16x4 vlo[2][4], vhi[2][4];
#pragma unroll
        for (int d0 = 0; d0 < 2; ++d0)
#pragma unroll
            for (int j = 0; j < 4; ++j) { vlo[d0][j] = vtr(vbp + d0 * 4096 + j * 1024); vhi[d0][j] = vtr(vbp + d0 * 4096 + j * 1024 + 512); }
        SBAR();
        st.lacc = MFMA32(PAF(0), ones, st.lacc); SBAR();
        st.lacc = MFMA32(PAF(1), ones, st.lacc); SBAR();
        st.lacc = MFMA32(PAF(2), ones, st.lacc); EXPS(c0, e0, 0); EXPS(c0, e0, 1); EXPS(c0, e0, 2); SBAR();
        st.lacc = MFMA32(PAF(3), ones, st.lacc); EXPS(c0, e0, 3); EXPS(c0, e0, 4); EXPS(c0, e0, 5); SBAR();
        st.o[0] = MFMA32(PAF(0), VFRAG(0, 0), st.o[0]); EXPS(c0, e0, 6); EXPS(c0, e0, 7); EXPS(c0, e0, 8); SBAR();
        st.o[1] = MFMA32(PAF(0), VFRAG(1, 0), st.o[1]); EXPS(c0, e0, 9); EXPS(c0, e0, 10); EXPS(c0, e0, 11); SBAR();
        st.o[0] = MFMA32(PAF(1), VFRAG(0, 1), st.o[0]); EXPS(c0, e0, 12); EXPS(c0, e0, 13); EXPS(c0, e0, 14); EXPS(c0, e0, 15); SBAR();
        st.o[1] = MFMA32(PAF(1), VFRAG(1, 1), st.o[1]); EXPS(c1, e1, 0); EXPS(c1, e1, 1); EXPS(c1, e1, 2); EXPS(c1, e1, 3); SBAR();
        st.o[0] = MFMA32(PAF(2), VFRAG(0, 2), st.o[0]); EXPS(c1, e1, 4); EXPS(c1, e1, 5); EXPS(c1, e1, 6); EXPS(c1, e1, 7); SBAR();
        st.o[1] = MFMA32(PAF(2), VFRAG(1, 2), st.o[1]); EXPS(c1, e1, 8); EXPS(c1, e1, 9); EXPS(c1, e1, 10); EXPS(c1, e1, 11); SBAR();
        st.o[0] = MFMA32(PAF(3), VFRAG(0, 3), st.o[0]); EXPS(c1, e1, 12); EXPS(c1, e1, 13); SBAR();
        st.o[1] = MFMA32(PAF(3), VFRAG(1, 3), st.o[1]); EXPS(c1, e1, 14); EXPS(c1, e1, 15); SBAR();
        mprev = m0; m0 = m1; m1 = m2;
    }
    {
        const unsigned wx = (unsigned)mprev >> (4 * hi), wy = (unsigned)(mprev >> 32) >> (4 * hi);
#pragma unroll
        for (int g = 0; g < 8; ++g) PACK_SLICE(g);
        pv(st.o, st.lacc, vb0 + ((NT - 1) & 3) * 8192, PAF(0), PAF(1), PAF(2), PAF(3));
    }
#undef SBAR
#undef PINV
#undef KFR
#undef MPK
#undef PACK_SLICE
#undef PAF
#undef VFRAG
#undef EXPS
#undef AT_DMA
    {
        bf16* ob = B_MIX + ((size_t)b * S + 64 * qt + 32 * qh) * D + h * 64 + r32;
#pragma unroll
        for (int r = 0; r < 16; ++r) { const int rq = crow(r, hi); const float f = __builtin_amdgcn_rcpf(st.lacc[r]);
            ob[(size_t)rq * D] = (bf16)f2bf(st.o[0][r] * f); ob[(size_t)rq * D + 32] = (bf16)f2bf(st.o[1][r] * f); }
    }
    __syncthreads();
}


struct PipeState { unsigned e0[16], e1[16]; M64 mprev; unsigned vbprev; float lsum; };
__device__ __forceinline__ void pipe_pack(PipeState& ps, int hi, unsigned (&pw)[16]) {
    const M64 mcur = ps.mprev;
    const unsigned wx = mcur.x >> (4 * hi), wy = mcur.y >> (4 * hi);
    const bool lane_uniform = __all((mcur.x == mcur.y) && ((mcur.x + 1u) <= 1u));
    if (!lane_uniform && !__all((mcur.x & mcur.y) == ~0u)) {
#pragma unroll
        for (int r = 0; r < 16; ++r) { const int c = (r & 3) + 8 * (r >> 2); ps.e0[r] &= bfe1(wx, c); ps.e1[r] &= bfe1(wy, c); }
    }
#pragma unroll
    for (int k = 0; k < 8; ++k) { pw[k] = cvtpk(__builtin_bit_cast(float, ps.e0[2 * k]), __builtin_bit_cast(float, ps.e0[2 * k + 1])); pw[8 + k] = cvtpk(__builtin_bit_cast(float, ps.e1[2 * k]), __builtin_bit_cast(float, ps.e1[2 * k + 1])); }
    float sa = 0.f, sb = 0.f;
#pragma unroll
    for (int r = 0; r < 16; ++r) { sa += __builtin_bit_cast(float, ps.e0[r]); sb += __builtin_bit_cast(float, ps.e1[r]); }
    float sm = sa + sb;
    if (lane_uniform) {
#pragma unroll
        for (int k = 0; k < 16; ++k) pw[k] &= mcur.x;
        sm = mcur.x ? sm : 0.f;
    }
    ps.lsum += sm;
}
__device__ __forceinline__ void pipe_step(SmState& st, PipeState& ps, const LAS unsigned char* Kslot, unsigned vb, const bf16x8 (&qr)[4], const M64 mcur, bool first, int lane, int r32, int hi) {
    (void)lane;
    f32x16 c0, c1;
    if (first) {
        ps.lsum = 0.f;
        qkt_rq(c0, c1, Kslot, qr, r32, hi);
#pragma unroll
        for (int r = 0; r < 16; ++r) { ps.e0[r] = __builtin_bit_cast(unsigned, __builtin_amdgcn_exp2f(c0[r])); ps.e1[r] = __builtin_bit_cast(unsigned, __builtin_amdgcn_exp2f(c1[r])); }
    } else {
        unsigned pw[16];
        pipe_pack(ps, hi, pw);
        qkt_rq(c0, c1, Kslot, qr, r32, hi);
        const unsigned vbp = ps.vbprev;
        s16x4 vlo[2][4], vhi[2][4];
#pragma unroll
        for (int d0 = 0; d0 < 2; ++d0)
#pragma unroll
            for (int j = 0; j < 4; ++j) { vlo[d0][j] = vtr(vbp + d0 * 4096 + j * 1024); vhi[d0][j] = vtr(vbp + d0 * 4096 + j * 1024 + 512); }
        const bf16x8 ones = {0x3F80, 0x3F80, 0x3F80, 0x3F80, 0x3F80, 0x3F80, 0x3F80, 0x3F80};
#define SBAR() __builtin_amdgcn_sched_barrier(0)
#define PAF(j_) __builtin_bit_cast(bf16x8, (v4u){pw[4 * (j_)], pw[4 * (j_) + 1], pw[4 * (j_) + 2], pw[4 * (j_) + 3]})
#define VFRAG(d0_, j_) (bf16x8){vlo[d0_][j_][0], vlo[d0_][j_][1], vlo[d0_][j_][2], vlo[d0_][j_][3], vhi[d0_][j_][0], vhi[d0_][j_][1], vhi[d0_][j_][2], vhi[d0_][j_][3]}
#define EXPS(C_, E_, r_) do { E_[r_] = __builtin_bit_cast(unsigned, __builtin_amdgcn_exp2f(C_[r_])); asm volatile("" : "+v"(E_[r_])); } while (0)
        (void)ones;
        SBAR();
        st.o[0] = MFMA32(PAF(0), VFRAG(0, 0), st.o[0]); SBAR();
        st.o[1] = MFMA32(PAF(0), VFRAG(1, 0), st.o[1]); EXPS(c0, ps.e0, 0); EXPS(c0, ps.e0, 1); EXPS(c0, ps.e0, 2); EXPS(c0, ps.e0, 3); SBAR();
        st.o[0] = MFMA32(PAF(1), VFRAG(0, 1), st.o[0]); EXPS(c0, ps.e0, 4); EXPS(c0, ps.e0, 5); EXPS(c0, ps.e0, 6); EXPS(c0, ps.e0, 7); EXPS(c0, ps.e0, 8); SBAR();
        st.o[1] = MFMA32(PAF(1), VFRAG(1, 1), st.o[1]); EXPS(c0, ps.e0, 9); EXPS(c0, ps.e0, 10); EXPS(c0, ps.e0, 11); EXPS(c0, ps.e0, 12); EXPS(c0, ps.e0, 13); SBAR();
        st.o[0] = MFMA32(PAF(2), VFRAG(0, 2), st.o[0]); EXPS(c0, ps.e0, 14); EXPS(c0, ps.e0, 15); EXPS(c1, ps.e1, 0); EXPS(c1, ps.e1, 1); EXPS(c1, ps.e1, 2); SBAR();
        st.o[1] = MFMA32(PAF(2), VFRAG(1, 2), st.o[1]); EXPS(c1, ps.e1, 3); EXPS(c1, ps.e1, 4); EXPS(c1, ps.e1, 5); EXPS(c1, ps.e1, 6); EXPS(c1, ps.e1, 7); SBAR();
        st.o[0] = MFMA32(PAF(3), VFRAG(0, 3), st.o[0]); EXPS(c1, ps.e1, 8); EXPS(c1, ps.e1, 9); EXPS(c1, ps.e1, 10); EXPS(c1, ps.e1, 11); SBAR();
        st.o[1] = MFMA32(PAF(3), VFRAG(1, 3), st.o[1]); EXPS(c1, ps.e1, 12); EXPS(c1, ps.e1, 13); EXPS(c1, ps.e1, 14); EXPS(c1, ps.e1, 15); SBAR();
#undef SBAR
#undef VFRAG
#undef EXPS
    }
    ps.mprev = mcur; ps.vbprev = vb;
}
__device__ __forceinline__ void pipe_drain(SmState& st, PipeState& ps, int hi) {
    unsigned pw[16];
    pipe_pack(ps, hi, pw);
    pv<false>(st.o, st.lacc, ps.vbprev, PAF(0), PAF(1), PAF(2), PAF(3));
#undef PAF
}
__device__ __forceinline__ void pipe_rowsums(const PipeState& ps, LAS float* rsc, int r32, int hi) {
    const float tot = ps.lsum + other_half_f(ps.lsum, hi);
    if (hi == 0) rsc[r32] = tot;
    asm volatile("s_waitcnt lgkmcnt(0)" ::: "memory");
}

template <bool SEL>
__device__ __forceinline__ void nsa_unit(unsigned char* ws_, int tid_, int b, int g, int qt, LAS unsigned char* lds) {
    asm volatile("" : "+v"(tid_)); asm volatile("" : "+s"(ws_));
    const int lane = tid_ & 63, wid = __builtin_amdgcn_readfirstlane(tid_ >> 6), r32 = lane & 31, hi = lane >> 5;
    const int hr = wid >> 1, qh = wid & 1, H = 4 * g + hr;
    const int tq = 64 * qt + 32 * qh + r32;
    const size_t qrow = (size_t)b * S + tq;
    LAS float* wsf = (LAS float*)(lds + AT_WS) + wid * 128;
    const unsigned vb0 = (unsigned)(uintptr_t)(lds + AT_V) + ((lane >> 4) & 1) * 32 + (lane & 3) * 8 + (4 * hi + ((lane & 15) >> 2)) * 64;
    const bf16* kcb = (const bf16*)(ws_ + WS_KCB) + (size_t)(b * 2 + g) * 128 * 64;
    const bf16* vcb = (const bf16*)(ws_ + WS_VCB) + (size_t)(b * 2 + g) * 128 * 64;
    const bf16* pb = B_PROJ + (size_t)b * S * NP + g * 64;
    const int vrow = 16 * (wid & 3) + (lane >> 2), vcol = (wid >> 2) * 32 + (lane & 3) * 8;
#define NS_DMA(kp_, vp_, slot_) do { \
        __builtin_amdgcn_global_load_lds((const unsigned*)(kp_), (LAS unsigned*)(lds + AT_K + (slot_) * 8192 + wid * 1024), 16, 0, 0); \
        __builtin_amdgcn_global_load_lds((const unsigned*)(vp_), (LAS unsigned*)(lds + AT_V + (slot_) * 8192 + wid * 1024), 16, 0, 0); } while (0)
#define NS_DMA_CMP(i_, slot_) NS_DMA(kcb + (size_t)(64 * (i_) + lane) * 64 + wid * 8, vcb + (size_t)(64 * (i_) + vrow) * 64 + vcol, slot_)
#define NS_DMA_PROJ(ck_, cv_, j_, slot_) NS_DMA(pb + (size_t)(64 * (j_) + lane) * NP + (ck_) + wid * 8, pb + (size_t)(64 * (j_) + vrow) * NP + (cv_) + vcol, slot_)
    const int ncmp = (qt >= 16) ? 2 : 1;
    const int jw0 = (qt > 8) ? qt - 8 : 0, nwin = qt - jw0 + 1;
    if (hi == 0) { const bf16* gp = B_PROJ + qrow * NP + C_GATE + H * 3;
        wsf[64 + r32] = sigmoidf_(bf2f(gp[0])); wsf[96 + r32] = sigmoidf_(bf2f(gp[2])); wsf[32 + r32] = sigmoidf_(bf2f(gp[1])); }
    int nissued = 0, islot = 0, ti = 0, cslot = 0;
    unsigned remI = SEL ? 0u : ((2u << qt) - 1u);
#define NS_ISSUE() do { \
        if (nissued < ncmp) { NS_DMA_CMP(nissued, islot); } \
        else if (nissued < ncmp + nwin) { NS_DMA_PROJ(C_KWIN, C_VWIN, jw0 + nissued - ncmp, islot); } \
        else if (remI) { const int j_ = __builtin_ctz(remI); remI &= remI - 1u; NS_DMA_PROJ(C_KSLC, C_VSLC, j_, islot); } \
        else break; \
        ++nissued; islot = (islot + 1) & 3; } while (0)
#define NS_TOP() do { if (nissued > ti + 1) asm volatile("s_waitcnt vmcnt(2)" ::: "memory"); else asm volatile("s_waitcnt vmcnt(0)" ::: "memory"); wg_barrier(); NS_ISSUE(); } while (0)
#define NS_ADV() do { ++ti; cslot = (cslot + 1) & 3; } while (0)
    NS_ISSUE(); NS_ISSUE();
    LAS bf16x8* qf = (LAS bf16x8*)(lds + NS_QF) + wid * 256;
    { bf16x8 qr[4]; load_q(qr, B_PROJ + qrow * NP + C_QB + H * 64 + 8 * hi, B_ROPE + qrow * 24, false, hi);
#pragma unroll
      for (int d0 = 0; d0 < 4; ++d0) qf[d0 * 64 + lane] = qr[d0]; }
    SmState st; sm_reset(st);
    f32x16 osel = {};
    unsigned oaccp[16];
    const int ncv = (tq >= 31) ? (((tq - 31) >> 4) + 1) : 0;
    for (int i = 0; i < ncmp; ++i) {
        NS_TOP();
        const M64 m = mask_range(0, ncv - 64 * i - 1);
        tile_step<SEL>(st, osel, lds + AT_K + cslot * 8192, vb0 + cslot * 8192, qf, m, i == 0, wsf, lane, r32, hi, i);
        NS_ADV();
    }
    {
        asm volatile("s_waitcnt lgkmcnt(0)" ::: "memory");
        LAS float* sels = (LAS float*)(lds + NS_SELS);
#pragma unroll
        for (int r = 0; r < 16; ++r) { const int rq = crow(r, hi); const float lt = st.lacc[r]; const float inv = lt > 0.f ? __builtin_amdgcn_rcpf(lt) : 0.f; const float f2 = wsf[64 + rq] * inv;
            oaccp[r] = cvtpk(st.o[0][r] * f2, st.o[1][r] * f2); asm volatile("" : "+v"(oaccp[r]));
            if (SEL) sels[(hr * 64 + 32 * qh + rq) * 32 + r32] = osel[r] * inv; }
        asm volatile("s_waitcnt lgkmcnt(0)" ::: "memory");
    }
    unsigned selunion;
    if (SEL) {
        wg_barrier();
        LAS float* sels = (LAS float*)(lds + NS_SELS);
        LAS float* ssum = (LAS float*)(lds + NS_SSUM);
        LAS unsigned* selm = (LAS unsigned*)(lds + NS_SELM);
        const int q = tid_ >> 3, jg = tid_ & 7;
        f32x4 s4 = *(const LAS f32x4*)(sels + (0 * 64 + q) * 32 + 4 * jg);
        s4 += *(const LAS f32x4*)(sels + (1 * 64 + q) * 32 + 4 * jg);
        s4 += *(const LAS f32x4*)(sels + (2 * 64 + q) * 32 + 4 * jg);
        s4 += *(const LAS f32x4*)(sels + (3 * 64 + q) * 32 + 4 * jg);
        *(LAS f32x4*)(ssum + q * 32 + 4 * jg) = s4;
        asm volatile("s_waitcnt lgkmcnt(0)" ::: "memory");
        float sv[32];
#pragma unroll
        for (int k = 0; k < 8; ++k) { const f32x4 v = *(const LAS f32x4*)(ssum + q * 32 + 4 * k); sv[4 * k] = v.x; sv[4 * k + 1] = v.y; sv[4 * k + 2] = v.z; sv[4 * k + 3] = v.w; }
        const float PINF = __builtin_inff();
#pragma unroll
        for (int i = 0; i < 32; ++i) sv[i] = (i > qt) ? -PINF : ((i == 0 || i == qt || i == qt - 1) ? PINF : sv[i]);
        unsigned bits4 = 0u;
#pragma unroll
        for (int jj = 0; jj < 4; ++jj) {
            const int j = 4 * jg + jj;
            float mine = (jj == 0) ? s4.x : (jj == 1) ? s4.y : (jj == 2) ? s4.z : s4.w;
            mine = (j > qt) ? -PINF : ((j == 0 || j == qt || j == qt - 1) ? PINF : mine);
            int rank = 0;
#pragma unroll
            for (int i = 0; i < 32; ++i) rank += ((sv[i] > mine) || (sv[i] == mine && i < j)) ? 1 : 0;
            bits4 |= (rank < 16) ? (1u << jj) : 0u;
        }
        unsigned mm = bits4 << (4 * jg);
        mm |= (unsigned)dpp_i<0xB1>((int)mm); mm |= (unsigned)dpp_i<0x4E>((int)mm); mm |= (unsigned)dpp_i<0x141>((int)mm);
        if (jg == 0) selm[q] = mm;
        wg_barrier();
        unsigned u = selm[lane];
        u = or_halves(or32(u));
        selunion = (unsigned)__builtin_amdgcn_readfirstlane((int)u);
    } else {
        selunion = (2u << qt) - 1u;
    }
    bf16x8 qr[4]; load_q(qr, B_PROJ + qrow * NP + C_QB + H * 64 + 8 * hi, B_ROPE + qrow * 24, true, hi);
    sm_reset(st);
    if (SEL) remI = selunion;
    PipeState ps;
    for (int j = jw0; j <= qt; ++j) {
        NS_TOP();
        const M64 m = mask_range(tq - 511 - 64 * j, tq - 64 * j);
        pipe_step(st, ps, lds + AT_K + cslot * 8192, vb0 + cslot * 8192, qr, m, j == jw0, lane, r32, hi);
        NS_ADV();
    }
    pipe_drain(st, ps, hi);
    pipe_rowsums(ps, wsf, r32, hi);
    {
        asm volatile("s_waitcnt lgkmcnt(0)" ::: "memory");
#pragma unroll
        for (int r = 0; r < 16; ++r) { const float lt = wsf[crow(r, hi)]; const float f2 = lt > 0.f ? wsf[96 + crow(r, hi)] * __builtin_amdgcn_rcpf(lt) : 0.f; oaccp[r] = cvtpk(bflo(oaccp[r]) + st.o[0][r] * f2, bfhi(oaccp[r]) + st.o[1][r] * f2); asm volatile("" : "+v"(oaccp[r])); }
        asm volatile("s_waitcnt lgkmcnt(0)" ::: "memory");
    }
    sm_reset(st);
    bool firstb = true;
    unsigned rem = selunion;
    while (rem) {
        const int j = __builtin_ctz(rem); rem &= rem - 1u;
        NS_TOP();
        const unsigned mysel_ = SEL ? ((const LAS unsigned*)(lds + NS_SELM))[32 * qh + r32] : ((2u << qt) - 1u);
        M64 m = mask_range(0, tq - 64 * j); if (!((mysel_ >> j) & 1u)) { m.x = 0u; m.y = 0u; }
        pipe_step(st, ps, lds + AT_K + cslot * 8192, vb0 + cslot * 8192, qr, m, firstb, lane, r32, hi);
        firstb = false; NS_ADV();
    }
    pipe_drain(st, ps, hi);
    pipe_rowsums(ps, wsf, r32, hi);
    {
        asm volatile("s_waitcnt lgkmcnt(0)" ::: "memory");
        bf16* ob = B_MIX + ((size_t)b * S + 64 * qt + 32 * qh) * D + 256 + H * 64 + r32;
#pragma unroll
        for (int r = 0; r < 16; ++r) { const int rq = crow(r, hi); const float lt = wsf[rq]; const float f2 = lt > 0.f ? wsf[32 + rq] * __builtin_amdgcn_rcpf(lt) : 0.f;
            ob[(size_t)rq * D] = (bf16)f2bf(bflo(oaccp[r]) + st.o[0][r] * f2); ob[(size_t)rq * D + 32] = (bf16)f2bf(bfhi(oaccp[r]) + st.o[1][r] * f2); }
    }
    __syncthreads();
#undef NS_DMA
#undef NS_DMA_CMP
#undef NS_DMA_PROJ
#undef NS_ISSUE
#undef NS_TOP
#undef NS_ADV
}

__device__ __forceinline__ void phase_attn(Frame& F, int l) {
    (void)l;
    unsigned char* ws_ = F.ws; asm volatile("" : "+s"(ws_)); int lane_ = lane_id(); asm volatile("" : "+v"(lane_)); (void)ws_;
    int tid_ = F.wave * 64 + lane_id(); asm volatile("" : "+v"(tid_));
    for (int u = F.vcu; u < BATCH * 64; u += F.G) {
        const int c = u & 255, i = u >> 8; const int b = c >> 3, sft = c & 7; const int base = 16 * (i >> 1); const int qt32 = (i & 1) ? base + 15 - sft : base + sft;
        dsa_select_unit(ws_, tid_, b, qt32, F.lds);
    }
    __syncthreads();
#if PROBE_MASK
    if (blockIdx.x == 0 && F.wave == 0 && lane_id() == 0) { const unsigned long long ts_ = __builtin_amdgcn_s_memrealtime(); F.MISC[16] = (unsigned)ts_; F.MISC[17] = (unsigned)(ts_ >> 32); }
#endif
    for (int u = F.vcu; u < BATCH * 64; u += F.G) {
        const int c = u & 255, i = u >> 8; const int b = c >> 3, sft = c & 7; const int g = i & 1, k = i >> 1; const int base = 16 * (k >> 1); const int qt = (k & 1) ? base + 15 - sft : base + sft;
        if (qt >= 16) nsa_unit<true>(ws_, tid_, b, g, qt, F.lds); else nsa_unit<false>(ws_, tid_, b, g, qt, F.lds);
    }
}
__device__ __forceinline__ void phase_dsa_attn(Frame& F) {
    unsigned char* ws_ = F.ws; asm volatile("" : "+s"(ws_));
    int tid_ = F.wave * 64 + lane_id(); asm volatile("" : "+v"(tid_));
    for (int u = F.vcu; u < BATCH * 32; u += F.G) {
        const int c = u & 255, i = u >> 8; const int b = c >> 3, sft = c & 7; const int base = 16 * (i >> 1); const int qt = (i & 1) ? base + 15 - sft : base + sft;
        dsa_attn_unit(ws_, tid_, b, qt, F.lds);
    }
}

constexpr int WP_PITCH = 72;
__device__ __forceinline__ void phase_merge(Frame& F, const Args& args, int l) {
    unsigned char* ws_ = F.ws; asm volatile("" : "+s"(ws_)); int lane_ = lane_id(); asm volatile("" : "+v"(lane_)); (void)ws_;
    int tid_ = F.wave * 64 + lane_id(); asm volatile("" : "+v"(tid_));
    const int gw = F.vcu * NWAVES + F.wave, NGW = F.G * NWAVES, lane = lane_;
    const float* psc = P_POOL_SCALE + l * 256;
    const float* goa = P_G_OUT_A + l * 256; const float* gob = P_G_OUT_B + l * 512;
    LAS bf16* wp = (LAS bf16*)F.lds;
    {
        const float* wsrc = P_W_POOL + (size_t)l * 4 * 64 * 64;
        for (int idx = tid_; idx < 4 * 64 * 64; idx += 512) { const int g = idx >> 12, c = (idx >> 6) & 63, d = idx & 63; wp[(g * 64 + d) * WP_PITCH + c] = (bf16)f2bf(wsrc[idx]); }
    }
    {
        constexpr int RB = 4;
        const f32x4 gga = ((const f32x4*)goa)[lane]; const f32x4 gb0 = ((const f32x4*)gob)[2 * lane], gb1 = ((const f32x4*)gob)[2 * lane + 1];
        for (int row0 = gw * RB; row0 < M; row0 += NGW * RB) {
            unsigned long long ua[RB]; v4u ub[RB];
#pragma unroll
            for (int k = 0; k < RB; ++k) { const bf16* mrow = B_MIX + (size_t)(row0 + k) * D; ua[k] = *((const unsigned long long*)mrow + lane); ub[k] = *((const v4u*)(mrow + 256) + lane); }
#pragma unroll
            for (int k = 0; k < RB; ++k) { bf16* mrow = B_MIX + (size_t)(row0 + k) * D;
                { const unsigned long long u = ua[k];
                  const float a0 = bflo((unsigned)u), a1 = bfhi((unsigned)u), a2 = bflo((unsigned)(u >> 32)), a3 = bfhi((unsigned)(u >> 32));
                  const float rs = rsqrtf(wave_sum((a0 * a0 + a1 * a1) + (a2 * a2 + a3 * a3)) * (1.f / 256.f) + EPS);
                  *((unsigned long long*)mrow + lane) = (unsigned long long)pk2(a0 * rs * gga.x, a1 * rs * gga.y) | ((unsigned long long)pk2(a2 * rs * gga.z, a3 * rs * gga.w) << 32); }
                { const v4u u = ub[k];
                  float a[8] = {bflo(u.x), bfhi(u.x), bflo(u.y), bfhi(u.y), bflo(u.z), bfhi(u.z), bflo(u.w), bfhi(u.w)};
                  float ss = 0.f;
#pragma unroll
                  for (int i = 0; i < 8; ++i) ss += a[i] * a[i];
                  const float rs = rsqrtf(wave_sum(ss) * (1.f / 512.f) + EPS);
                  v4u o; o.x = pk2(a[0] * rs * gb0.x, a[1] * rs * gb0.y); o.y = pk2(a[2] * rs * gb0.z, a[3] * rs * gb0.w); o.z = pk2(a[4] * rs * gb1.x, a[5] * rs * gb1.y); o.w = pk2(a[6] * rs * gb1.z, a[7] * rs * gb1.w);
                  *((v4u*)(mrow + 256) + lane) = o; }
            }
        }
    }
    __syncthreads();
    {
        const int r32 = lane & 31, hi = lane >> 5;
        for (int tile = gw; tile < M / 32; tile += NGW) {
            const int row = 32 * tile + r32, t = row % S;
            const bf16* up = B_PROJ + (size_t)row * NP + C_UC + 8 * hi;
            f32x16 acc[4][2];
#pragma unroll
            for (int g = 0; g < 4; ++g) {
                acc[g][0] = f32x16{}; acc[g][1] = f32x16{};
                const int w = 2 << g;
                const float icnt = 1.f / (float)((t + 1 < w) ? t + 1 : w);
#pragma unroll
                for (int ks = 0; ks < 4; ++ks) {
                    const bf16* p0 = up + g * 64 + 16 * ks;
                    const v4u u0 = *(const v4u*)p0;
                    float cur[8] = {bflo(u0.x), bfhi(u0.x), bflo(u0.y), bfhi(u0.y), bflo(u0.z), bfhi(u0.z), bflo(u0.w), bfhi(u0.w)};
                    float sum[8];
#pragma unroll
                    for (int j = 0; j < 8; ++j) sum[j] = cur[j];
#pragma unroll
                    for (int i = 1; i < w; ++i) {
                        if (t - i >= 0) { const v4u ui = *(const v4u*)(p0 - (size_t)i * NP);
                            sum[0] += bflo(ui.x); sum[1] += bfhi(ui.x); sum[2] += bflo(ui.y); sum[3] += bfhi(ui.y); sum[4] += bflo(ui.z); sum[5] += bfhi(ui.z); sum[6] += bflo(ui.w); sum[7] += bfhi(ui.w); }
                    }
                    v4u pk; pk.x = cvtpk(sum[0] * icnt - cur[0], sum[1] * icnt - cur[1]); pk.y = cvtpk(sum[2] * icnt - cur[2], sum[3] * icnt - cur[3]);
                    pk.z = cvtpk(sum[4] * icnt - cur[4], sum[5] * icnt - cur[5]); pk.w = cvtpk(sum[6] * icnt - cur[6], sum[7] * icnt - cur[7]);
                    const bf16x8 af = __builtin_bit_cast(bf16x8, pk);
#pragma unroll
                    for (int nb = 0; nb < 2; ++nb) {
                        const bf16x8 bfr = *(const LAS bf16x8*)(wp + (g * 64 + 32 * nb + r32) * WP_PITCH + 16 * ks + 8 * hi);
                        acc[g][nb] = MFMA32(af, bfr, acc[g][nb]);
                    }
                }
            }
            float ss[16];
#pragma unroll
            for (int r = 0; r < 16; ++r) { float a = 0.f;
#pragma unroll
                for (int g = 0; g < 4; ++g) a += acc[g][0][r] * acc[g][0][r] + acc[g][1][r] * acc[g][1][r];
                a = sum32(a);
                ss[r] = rsqrtf(a * (1.f / 256.f) + EPS); }
            bf16* ob = B_MIX + (size_t)(32 * tile) * D + 768 + r32;
#pragma unroll
            for (int g = 0; g < 4; ++g)
#pragma unroll
                for (int nb = 0; nb < 2; ++nb) { const float sc = psc[g * 64 + 32 * nb + r32];
#pragma unroll
                    for (int r = 0; r < 16; ++r) ob[(size_t)crow(r, hi) * D + g * 64 + 32 * nb] = (bf16)f2bf(acc[g][nb][r] * ss[r] * sc); }
        }
    }
    __syncthreads();
}

template <bool XIN_F32, bool OUT_F32, bool X8OUT = false>
__device__ __forceinline__ void phase_finish(Frame& F, const float* xsrc, const float* gpost, const float* gnext  , float fsc) {
    const float eps_eff = fsc * fsc * EPS;
    unsigned char* ws_ = F.ws; asm volatile("" : "+s"(ws_)); int lane_ = lane_id(); asm volatile("" : "+v"(lane_)); (void)ws_;
    const int gw = F.vcu * NWAVES + F.wave, NGW = F.G * NWAVES, lane = lane_;
    bf16* xb = (bf16*)(ws_ + WS_XB);
    constexpr int RB = 4;
    for (int row0 = gw * RB; row0 < M; row0 += NGW * RB) {
        v4u fu[RB][2]; float x[RB][2][8];
#pragma unroll
        for (int k = 0; k < RB; ++k) { const size_t row = (size_t)(row0 + k);
#pragma unroll
            for (int j = 0; j < 2; ++j) { fu[k][j] = *((const v4u*)(B_F + row * D + 512 * j) + lane);
                if (XIN_F32) { const f32x4 a = *((const f32x4*)(xsrc + row * D + 512 * j) + 2 * lane), c = *((const f32x4*)(xsrc + row * D + 512 * j) + 2 * lane + 1);
                    x[k][j][0] = a.x; x[k][j][1] = a.y; x[k][j][2] = a.z; x[k][j][3] = a.w; x[k][j][4] = c.x; x[k][j][5] = c.y; x[k][j][6] = c.z; x[k][j][7] = c.w; }
                else { const v4u ux = *((const v4u*)(xb + row * D + 512 * j) + lane);
                    x[k][j][0] = bflo(ux.x); x[k][j][1] = bfhi(ux.x); x[k][j][2] = bflo(ux.y); x[k][j][3] = bfhi(ux.y); x[k][j][4] = bflo(ux.z); x[k][j][5] = bfhi(ux.z); x[k][j][6] = bflo(ux.w); x[k][j][7] = bfhi(ux.w); } } }
        float gp[2][8];
#pragma unroll
        for (int j = 0; j < 2; ++j) { const f32x4 a = *((const f32x4*)(gpost + 512 * j) + 2 * lane), c = *((const f32x4*)(gpost + 512 * j) + 2 * lane + 1);
            gp[j][0] = a.x; gp[j][1] = a.y; gp[j][2] = a.z; gp[j][3] = a.w; gp[j][4] = c.x; gp[j][5] = c.y; gp[j][6] = c.z; gp[j][7] = c.w;
 }
#pragma unroll
        for (int k = 0; k < RB; ++k) { const size_t row = (size_t)(row0 + k);
            float f[2][8]; float ss = 0.f;
#pragma unroll
            for (int j = 0; j < 2; ++j) { const v4u u = fu[k][j];
                f[j][0] = bflo(u.x); f[j][1] = bfhi(u.x); f[j][2] = bflo(u.y); f[j][3] = bfhi(u.y); f[j][4] = bflo(u.z); f[j][5] = bfhi(u.z); f[j][6] = bflo(u.w); f[j][7] = bfhi(u.w);
#pragma unroll
                for (int e = 0; e < 8; ++e) ss += f[j][e] * f[j][e]; }
            const float rs = rsqrtf(wave_sum(ss) * (1.f / D) + eps_eff);
            float s2 = 0.f;
#pragma unroll
            for (int j = 0; j < 2; ++j) {
#pragma unroll
                for (int e = 0; e < 8; ++e) { const float xv = x[k][j][e] + f[j][e] * rs * gp[j][e]; x[k][j][e] = xv; s2 += xv * xv; }
                if (OUT_F32) { f32x4* o = (f32x4*)(F.out + row * D + 512 * j) + 2 * lane;
                    o[0] = (f32x4){x[k][j][0], x[k][j][1], x[k][j][2], x[k][j][3]}; o[1] = (f32x4){x[k][j][4], x[k][j][5], x[k][j][6], x[k][j][7]}; }
                else *((v4u*)(xb + row * D + 512 * j) + lane) = (v4u){pk2(x[k][j][0], x[k][j][1]), pk2(x[k][j][2], x[k][j][3]), pk2(x[k][j][4], x[k][j][5]), pk2(x[k][j][6], x[k][j][7])};
            }
            if (gnext) { const float r2 = rsqrtf(wave_sum(s2) * (1.f / D) + EPS); if (lane == 0) ((float*)(ws_ + WS_RS))[row] = r2;
                if (X8OUT) { const float r3 = r2 * pg8::XSC; unsigned char* x8 = ws_ + WS_X8 + row * D;
#pragma unroll
                    for (int j = 0; j < 2; ++j) *((unsigned long long*)(x8 + 512 * j) + lane) = (unsigned long long)pg8::pk4_fp8(x[k][j][0] * r3, x[k][j][1] * r3, x[k][j][2] * r3, x[k][j][3] * r3)
                        | ((unsigned long long)pg8::pk4_fp8(x[k][j][4] * r3, x[k][j][5] * r3, x[k][j][6] * r3, x[k][j][7] * r3) << 32); } }
        }
    }
}

template <int ACT>
__device__ __forceinline__ void phase_gemm(Frame& F, const bf16* A, const bf16* Bt, bf16* O, int N, int K, const float* rs) {
    asm volatile("" : "+s"(A), "+s"(Bt), "+s"(O), "+s"(rs));
    int bx_ = (int)blockIdx.x, gg_ = F.G; asm volatile("" : "+s"(bx_), "+s"(gg_));
    pg8::Gemm g{A, Bt, M, N, K}; pg8::StaticOrder So; So.init(M, N, gg_, bx_);
    pg8::EpiStore<ACT> E{O, N, rs};
    pg8::gemm_phase<pg8::EpiStore<ACT>, pg8::StaticOrder, true, true>(F.lds, g, So, E, F.wave);
}

__device__ __forceinline__ void phase_gemm_up8(Frame& F, const bf16* A, const bf16* Bt, unsigned char* O8, const float* rs) {
    asm volatile("" : "+s"(A), "+s"(Bt), "+s"(O8), "+s"(rs));
    int bx_ = (int)blockIdx.x, gg_ = F.G; asm volatile("" : "+s"(bx_), "+s"(gg_));
    pg8::Gemm g{A, Bt, M, FF, D}; pg8::StaticOrder So; So.init(M, FF, gg_, bx_);
    pg8::EpiRelu2Fp8T<true> E{O8, FF, rs};
    pg8::gemm_phase<pg8::EpiRelu2Fp8T<true>, pg8::StaticOrder, true, true>(F.lds, g, So, E, F.wave);
}
__device__ __forceinline__ void phase_gemm_up88(Frame& F, const unsigned char* A8, const unsigned char* Bt8, unsigned char* O8) {
    asm volatile("" : "+s"(A8), "+s"(Bt8), "+s"(O8));
    int bx_ = (int)blockIdx.x, gg_ = F.G; asm volatile("" : "+s"(bx_), "+s"(gg_));
    pg8::Gemm g{(const bf16*)A8, (const bf16*)Bt8, M, FF, D / 2}; pg8::StaticOrder So; So.init(M, FF, gg_, bx_);
    pg8::EpiRelu2Fp8T<false> E{O8, FF, nullptr};
    pg8::gemm_phase<pg8::EpiRelu2Fp8T<false>, pg8::StaticOrder, true, true, true>(F.lds, g, So, E, F.wave);
}
__device__ __forceinline__ void phase_gemm_down8(Frame& F, const unsigned char* A8, const unsigned char* Bt8, bf16* O) {
    asm volatile("" : "+s"(A8), "+s"(Bt8), "+s"(O));
    int bx_ = (int)blockIdx.x, gg_ = F.G; asm volatile("" : "+s"(bx_), "+s"(gg_));
    pg8::Gemm g{(const bf16*)A8, (const bf16*)Bt8, M, D, FF / 2}; pg8::StaticOrder So; So.init(M, D, gg_, bx_);
    pg8::EpiStore<0> E{O, D, nullptr};
    pg8::gemm_phase<pg8::EpiStore<0>, pg8::StaticOrder, true, true, true>(F.lds, g, So, E, F.wave);
}
__device__ __forceinline__ void phase_gemm_out8(Frame& F, const unsigned char* A8, const unsigned char* Bt8, bf16* O) {
    asm volatile("" : "+s"(A8), "+s"(Bt8), "+s"(O));
    int bx_ = (int)blockIdx.x, gg_ = F.G; asm volatile("" : "+s"(bx_), "+s"(gg_));
    pg8::Gemm g{(const bf16*)A8, (const bf16*)Bt8, M, D, D / 2}; pg8::StaticOrder So; So.init(M, D, gg_, bx_);
    pg8::EpiStore<0> E{O, D, nullptr};
    pg8::gemm_phase<pg8::EpiStore<0>, pg8::StaticOrder, true, true, true>(F.lds, g, So, E, F.wave);
}

constexpr int PH_PER_LAYER = 10, NPHASES = 2 + DEPTH * PH_PER_LAYER;
__global__ void __launch_bounds__(NWAVES * 64, 2) mk_fwd(Args args) {
    extern __shared__ __attribute__((aligned(16))) unsigned char lds[];
    Frame F;
    F.lds = (LAS unsigned char*)lds;
    F.MISC = (volatile LAS unsigned*)(F.lds + MISC_OFF);
    { const int t0_ = threadIdx.x; F.wave = __builtin_amdgcn_readfirstlane(t0_ >> 6);
      for (int u = t0_; u < (LDS_BYTES - LDSCTL_OFF) / 4; u += NWAVES * 64) ((LAS unsigned*)(F.lds + LDSCTL_OFF))[u] = 0u; }
    F.G = gridDim.x; { const int bx = blockIdx.x; F.vcu = (F.G % 8 == 0) ? (bx % 8) * (F.G / 8) + bx / 8 : bx; }
    unsigned char* ws = args.ws; F.ws = ws;
    F.ctl = (gu32*)(ws + WS_CTL);
    F.out = args.out;
    __syncthreads();
    XcdBarrier bar; bar.bar = (unsigned*)(F.ctl + CW_BAR); bar.x = 0; bar.st = F.MISC + 8; bar.wv = 0;
    if (args.use_bar) bar = xcd_barrier_post((unsigned*)(F.ctl + CW_BAR), F.MISC + 8);
    bar.wv = F.wave;
    const int lo = args.ph_lo, hi = args.ph_hi;
    int pid = 0;
    unsigned char* ws_ = F.ws;
#define PH_ON (pid >= lo && pid < hi)
#if PROBE_MASK
    if (blockIdx.x == 0 && F.wave == 0 && lane_id() == 0) { const unsigned long long t_ = __builtin_amdgcn_s_memrealtime(); F.MISC[18] = (unsigned)t_; F.MISC[19] = (unsigned)(t_ >> 32); F.MISC[20] = 0u; F.MISC[21] = 0u; }
#define PH_END(kind) do { if (PH_ON && pid + 1 < hi) xcd_barrier(bar); ++pid; \
        if (blockIdx.x == 0 && F.wave == 0 && lane_id() == 0) { const unsigned long long now_ = __builtin_amdgcn_s_memrealtime(); \
          const unsigned long long last_ = (unsigned long long)F.MISC[18] | ((unsigned long long)F.MISC[19] << 32); unsigned long long acc_ = (unsigned long long)F.MISC[20] | ((unsigned long long)F.MISC[21] << 32); \
          if ((kind) == 3) { const unsigned long long sp_ = (unsigned long long)F.MISC[16] | ((unsigned long long)F.MISC[17] << 32); \
              if ((PROBE_MASK >> 11) & 1) acc_ += sp_ - last_; if ((PROBE_MASK >> 3) & 1) acc_ += now_ - sp_; } \
          else if ((PROBE_MASK >> (kind)) & 1) acc_ += now_ - last_; \
          F.MISC[18] = (unsigned)now_; F.MISC[19] = (unsigned)(now_ >> 32); F.MISC[20] = (unsigned)acc_; F.MISC[21] = (unsigned)(acc_ >> 32); } } while (0)
#else
#define PH_END(kind) do { if (PH_ON && pid + 1 < hi) xcd_barrier(bar); ++pid; } while (0)
#endif

    if (PH_ON && !(SKIPM & 1)) phase_prologue(F, args);
    PH_END(0);
    if (PH_ON && !(SKIPM & 1)) phase_prologue_b(F, args);
    PH_END(0);
    for (int l = 0; l < DEPTH; ++l) {
        unsigned char* ws_ = F.ws; asm volatile("" : "+s"(ws_));
        if (PH_ON && !(SKIPM & 2)) phase_gemm<0>(F, (const bf16*)(ws_ + WS_XB), w_in_t(ws_, l), B_PROJ, NP, D, (const float*)(ws_ + WS_RS));
        PH_END(1);
        if (PH_ON && !(SKIPM & 4)) phase_prep(F, args, l);
        PH_END(2);
        if (PH_ON && !(SKIPM & 8)) phase_attn(F, l);
        PH_END(3);
        if (PH_ON && !(SKIPM & 8)) phase_dsa_attn(F);
        PH_END(4);
        if (PH_ON && !(SKIPM & 16)) phase_merge(F, args, l);
        PH_END(5);
        if (PH_ON && !(SKIPM & 32)) phase_gemm<0>(F, B_MIX, w_out_t(ws_, l), B_F, D, D, nullptr);
        PH_END(6);
        if (PH_ON && !(SKIPM & 64)) { phase_finish<false, false, true>(F, nullptr, P_G_POST_MIX + l * D, P_G_PRE_MLP + l * D, 1.f); }
        PH_END(7);
        if (PH_ON && !(SKIPM & 128)) phase_gemm_up88(F, (const unsigned char*)(ws_ + WS_X8), (const unsigned char*)w_up_t(ws_, l), (unsigned char*)(ws_ + WS_HID));
        PH_END(8);
        if (PH_ON && !(SKIPM & 256)) phase_gemm_down8(F, (const unsigned char*)(ws_ + WS_HID), (const unsigned char*)w_dn_t(ws_, l), B_F);
        PH_END(9);
        if (PH_ON && !(SKIPM & 512)) { if (l + 1 < DEPTH) phase_finish<false, false>(F, nullptr, P_G_POST_MLP + l * D, P_G_PRE_MIX + (l + 1) * D, pg8::HSC * pg8::WDSC); else phase_finish<false, true>(F, nullptr, P_G_POST_MLP + l * D, nullptr, pg8::HSC * pg8::WDSC); }
        PH_END(10);
    }
#if PROBE_MASK
    if (blockIdx.x == 0 && F.wave == 0 && lane_id() == 0) { const unsigned long long pr_acc = (unsigned long long)F.MISC[20] | ((unsigned long long)F.MISC[21] << 32);
        const unsigned long long t0_ = __builtin_amdgcn_s_memrealtime(); while (__builtin_amdgcn_s_memrealtime() - t0_ < pr_acc) __builtin_amdgcn_s_sleep(8); }
#endif
#undef PH_ON
#undef PH_END
}

extern "C" void kernel_launch(void* const* d_in, const int* in_sizes, int n_in, void* d_out, int out_size, void* d_ws, size_t ws_size, hipStream_t stream) {
    static int grid = 0;
    if (grid == 0) {
        if (n_in != 20 || in_sizes[0] != M * D || out_size != M * D || ws_size < WS_END) {
            fprintf(stderr, "kernel_launch: unexpected shapes / workspace (n_in %d, in0 %d, out %d, ws %zu < %zu); nothing launched\n", n_in, n_in > 0 ? in_sizes[0] : -1, out_size, ws_size, (size_t)WS_END);
            grid = -1; return; }
        int dev = 0, cus = 0, per_cu = 0;
        if (hipGetDevice(&dev) != hipSuccess || hipDeviceGetAttribute(&cus, hipDeviceAttributeMultiprocessorCount, dev) != hipSuccess) { grid = -1; return; }
        if (hipFuncSetAttribute((const void*)mk_fwd, hipFuncAttributeMaxDynamicSharedMemorySize, LDS_BYTES) != hipSuccess) { fprintf(stderr, "kernel_launch: hipFuncSetAttribute failed\n"); grid = -1; return; }
        if (hipOccupancyMaxActiveBlocksPerMultiprocessor(&per_cu, (const void*)mk_fwd, NWAVES * 64, LDS_BYTES) != hipSuccess || per_cu < 1)
            fprintf(stderr, "kernel_launch: note: occupancy query reports %d workgroups per CU\n", per_cu);
        (void)hipGetLastError();
        grid = cus;
    }
    if (grid < 0) return;
    if (hipMemsetAsync((char*)d_ws + WS_CTL, 0, CTL_ZERO_BYTES, stream) != hipSuccess) return;
    Args a{};
    for (int i = 0; i < 20; ++i) a.in[i] = d_in[i];
    a.out = (float*)d_out; a.ws = (unsigned char*)d_ws; a.pad = 0;
#if MK_MULTI
    for (int p = 0; p < NPHASES; ++p) {
        a.ph_lo = p; a.ph_hi = p + 1; a.use_bar = 0;
        hipLaunchKernelGGL(mk_fwd, dim3(grid), dim3(NWAVES * 64), LDS_BYTES, stream, a);
    }
#else
    a.ph_lo = 0; a.ph_hi = NPHASES; a.use_bar = 1;
    hipLaunchKernelGGL(mk_fwd, dim3(grid), dim3(NWAVES * 64), LDS_BYTES, stream, a);
#endif
}
```

```cpp
#include <hip/hip_runtime.h>
#include <cstdio>
#include <cstdint>

#ifndef PROBE_MASK
#define PROBE_MASK 0
#endif
#ifndef SKIPM
#define SKIPM 0
#endif
#ifndef MK_MULTI
#define MK_MULTI 0
#endif

__device__ __forceinline__ int lane_id() { int l; asm volatile("v_mbcnt_lo_u32_b32 %0, -1, 0\n\tv_mbcnt_hi_u32_b32 %0, -1, %0" : "=v"(l)); return l; }
namespace pg8 {
#define PG8_LAS __attribute__((address_space(3)))
typedef unsigned short bf16_t;
typedef short bf16x8 __attribute__((ext_vector_type(8)));
typedef float f32x4 __attribute__((ext_vector_type(4)));
typedef unsigned u32x4 __attribute__((ext_vector_type(4)));
typedef int v4i_t __attribute__((ext_vector_type(4)));
typedef int v8i_t __attribute__((ext_vector_type(8)));
constexpr int BM = 256, BK = 64, HALF = 128, HTB = HALF * BK * 2, STAGE_BYTES = 8 * HTB, NXCD = 8, WGM = 8;

__host__ __device__ __forceinline__ int lds_byte(int r, int c) { const int st = (r >> 4) * 2 + (c >> 5), rr = r & 15, cc = c & 31, ob = rr * 64 + cc * 2; return st * 1024 + (ob ^ (((ob >> 9) & 1) << 5)); }
__host__ __device__ __forceinline__ void stage_rc(int b, int& R, int& C) { const int st = b / 1024, sb = b % 1024, swz = sb ^ (((sb >> 9) & 1) << 5); R = (st >> 1) * 16 + swz / 64; C = (st & 1) * 32 + (swz % 64) / 2; }
__host__ __device__ __forceinline__ int perm32(int rho) { const int n = rho >> 4, i = rho & 15; return 8 * (i >> 2) + 4 * n + (i & 3); }

struct Unit { int pm, pn; };
struct Gemm { const bf16_t* A; const bf16_t* Bt; int M, N, K; };

struct StaticOrder {
    int nM, nN, nwg, G, c;
    __host__ __device__ void init(int M, int N, int G_, int c_) { nM = M / BM; nN = N / BM; nwg = nM * nN; G = G_; c = c_; }
    __host__ __device__ bool next(int i, Unit& u) const {
        const long L = (long)i * G + c; if (L >= nwg) return false;
        int wgid = (int)L; { const int q = nwg / NXCD, r = nwg % NXCD, xcd = wgid % NXCD, off = wgid / NXCD; wgid = (xcd < r ? xcd * (q + 1) : r * (q + 1) + (xcd - r) * q) + off; }
        const int nig = WGM * nN, gid = wgid / nig, fm = gid * WGM, gsz = (nM - fm) < WGM ? (nM - fm) : WGM;
        u.pm = fm + ((wgid % nig) % gsz); u.pn = (wgid % nig) / gsz; return true;
    }
    __device__ __forceinline__ void a_ready(const Unit&) const {}
    __device__ __forceinline__ void done(const Unit&) const {}
};

__device__ __forceinline__ unsigned cvt_pk_bf16(float lo, float hi) { unsigned r; asm volatile("v_cvt_pk_bf16_f32 %0, %1, %2" : "=v"(r) : "v"(lo), "v"(hi)); return r; }

template <int ACT  > struct EpiStore {
    static constexpr int PERM = 2; static constexpr bool AFTER_DRAIN = false;
    bf16_t* O; int ldc; const float* rs;
    struct Pre { float sc[2][4]; };
    __device__ __forceinline__ Pre prefetch(const Unit& u, int wr, int fr) const { Pre p; const int row0 = u.pm * BM + wr * 64 + fr;
#pragma unroll
        for (int ai = 0; ai < 2; ++ai)
#pragma unroll
            for (int m = 0; m < 4; ++m) p.sc[ai][m] = (rs ? rs[row0 + ai * HALF + m * 16] : 1.f);
        return p; }
    __device__ __forceinline__ void operator()(const f32x4 (&acc)[2][2][4][2], const Unit& u, int wr, int wc, int fr, int fq, const Pre& pre) const {
        const int row0 = u.pm * BM + wr * 64 + fr;
        const int col0 = u.pn * BM + wc * 64 + 16 * fq;
        const float (&sc)[2][4] = pre.sc;
#pragma unroll
        for (int ai = 0; ai < 2; ++ai)
#pragma unroll
            for (int m = 0; m < 4; ++m) { const int row = row0 + ai * HALF + m * 16; bf16_t* rowp = O + (size_t)row * ldc + col0;
#pragma unroll
                for (int bj = 0; bj < 2; ++bj) { f32x4 v0 = acc[ai][bj][m][0] * sc[ai][m], v1 = acc[ai][bj][m][1] * sc[ai][m];
                    if (ACT == 2) {
#pragma unroll
                        for (int e = 0; e < 4; ++e) { const float a = fmaxf(v0[e], 0.f), b = fmaxf(v1[e], 0.f); v0[e] = a * a; v1[e] = b * b; } }
                    u32x4 w; w.x = cvt_pk_bf16(v0[0], v0[1]); w.y = cvt_pk_bf16(v0[2], v0[3]); w.z = cvt_pk_bf16(v1[0], v1[1]); w.w = cvt_pk_bf16(v1[2], v1[3]);
                    *(u32x4*)(rowp + bj * 8) = w; } }
    }
};

constexpr float XSC = 16.f, WUSC = 32.f;
constexpr float MSC = 16.f, WOSC = 32.f;
constexpr float HSC = 4.f, WDSC = 64.f;
__device__ __forceinline__ unsigned pk4_fp8(float a, float b, float c, float d) { int p = 0; p = __builtin_amdgcn_cvt_pk_fp8_f32(a, b, p, false); p = __builtin_amdgcn_cvt_pk_fp8_f32(c, d, p, true); return (unsigned)p; }
template <bool HAS_RS> struct EpiRelu2Fp8T {
    static constexpr int PERM = 2; static constexpr bool AFTER_DRAIN = false;
    unsigned char* O; int ldc; const float* rs;
    struct Pre { float sc[2][4]; };
    __device__ __forceinline__ Pre prefetch(const Unit& u, int wr, int fr) const { Pre p; const int row0 = u.pm * BM + wr * 64 + fr;
#pragma unroll
        for (int ai = 0; ai < 2; ++ai)
#pragma unroll
            for (int m = 0; m < 4; ++m) p.sc[ai][m] = HAS_RS ? rs[row0 + ai * HALF + m * 16] : (1.f / (XSC * WUSC));
        return p; }
    __device__ __forceinline__ void operator()(const f32x4 (&acc)[2][2][4][2], const Unit& u, int wr, int wc, int fr, int fq, const Pre& pre) const {
        const int row0 = u.pm * BM + wr * 64 + fr;
        const int col0 = u.pn * BM + wc * 64 + 16 * fq;
        float sc[2][4];
#pragma unroll
        for (int ai = 0; ai < 2; ++ai)
#pragma unroll
            for (int m = 0; m < 4; ++m) sc[ai][m] = pre.sc[ai][m] * 2.f;
#pragma unroll
        for (int ai = 0; ai < 2; ++ai)
#pragma unroll
            for (int m = 0; m < 4; ++m) { const int row = row0 + ai * HALF + m * 16; unsigned w[4];
#pragma unroll
                for (int bj = 0; bj < 2; ++bj)
#pragma unroll
                    for (int n = 0; n < 2; ++n) { f32x4 v = acc[ai][bj][m][n] * sc[ai][m];
#pragma unroll
                        for (int e = 0; e < 4; ++e) { const float a = fmaxf(v[e], 0.f); v[e] = fminf(a * a, 448.f); }
                        w[bj * 2 + n] = pk4_fp8(v[0], v[1], v[2], v[3]); }
                *(u32x4*)(O + (size_t)row * ldc + col0) = (u32x4){w[0], w[1], w[2], w[3]}; }
    }
};

template <class Epi, class Sched, bool ALIGN_EPI = false, bool SP2 = false, bool FP8 = false>
__device__ __forceinline__ void gemm_phase(PG8_LAS unsigned char* lds, const Gemm g, const Sched& S, const Epi& E, int wave_) {
    int tid_ = wave_ * 64 + lane_id(); asm volatile("" : "+v"(tid_));
    const int tid = tid_, wid = __builtin_amdgcn_readfirstlane(tid >> 6), lane = tid & 63, wr = wid >> 2, wc = wid & 3, fr = lane & 15, fq = lane >> 4;
    const int K = g.K, nt = K / BK;
    unsigned voffA[2], voffB[2];
#pragma unroll
    for (int i = 0; i < 2; ++i) { int R, C; stage_rc(tid * 16 + i * 8192, R, C);
        const int Rb = (Epi::PERM == 2) ? (64 * (R >> 5) + 16 * ((R & 15) >> 2) + 4 * ((R >> 4) & 1) + (R & 3)) : (Epi::PERM == 1) ? ((R & ~31) + perm32(R & 31)) : R;
        voffA[i] = (unsigned)(R * K + C) * 2u; voffB[i] = (unsigned)(Rb * K + C) * 2u; }
    const size_t kstep = (size_t)(BK * 2);
    const size_t hstep = (size_t)HALF * K * 2;
    const size_t hstepB = (Epi::PERM == 2) ? (size_t)8 * K * 2 : hstep;
    const size_t tstep = 2 * hstep;
    const unsigned ldsw = (unsigned)wid * 1024u;
    const int aoff = lds_byte(wr * 64 + fr, fq * 8); int boff = lds_byte(wc * 32 + fr, fq * 8) + 4 * HTB; asm volatile("" : "+v"(boff));
#define PG8_SA(b, h) (((b) * 2 + (h)) * HTB)
#define PG8_SB(b, h) ((4 + (b) * 2 + (h)) * HTB)
#define PG8_STAGE(bufoff, gbase, voff) do { _Pragma("unroll") for (int _i = 0; _i < 2; ++_i) \
        __builtin_amdgcn_global_load_lds((const unsigned*)((const char*)(gbase) + (voff)[_i]), (PG8_LAS unsigned*)(lds + (bufoff) + ldsw + _i * 8192), 16, 0, 0); } while (0)
#define PG8_SBR(b, h) (((b) * 2 + (h)) * HTB)
#define PG8_LD8(off_) __builtin_shufflevector(*(const PG8_LAS v4i_t*)(lds + (off_)), *(const PG8_LAS v4i_t*)(lds + (off_) + 1024), 0, 1, 2, 3, 4, 5, 6, 7)
#define PG8_LDA(dst, b, h) do { _Pragma("unroll") for (int m = 0; m < 4; ++m) { if constexpr (FP8) dst##8[m] = PG8_LD8(PG8_SA(b, h) + aoff + m * 2048); \
        else { _Pragma("unroll") for (int k = 0; k < 2; ++k) dst[m][k] = *(const PG8_LAS bf16x8*)(lds + PG8_SA(b, h) + aoff + m * 2048 + k * 1024); } } } while (0)
#define PG8_LDB(dst, b, h) do { _Pragma("unroll") for (int n = 0; n < 2; ++n) { if constexpr (FP8) dst##8[n] = PG8_LD8(PG8_SBR(b, h) + boff + n * 2048); \
        else { _Pragma("unroll") for (int k = 0; k < 2; ++k) dst[n][k] = *(const PG8_LAS bf16x8*)(lds + PG8_SBR(b, h) + boff + n * 2048 + k * 1024); } } } while (0)
#define PG8_MMA(ai, bj, At, Bt) do { __builtin_amdgcn_s_setprio(1); _Pragma("unroll") for (int m = 0; m < 4; ++m) _Pragma("unroll") for (int n = 0; n < 2; ++n) { \
        if constexpr (FP8) asm volatile("v_mfma_f32_16x16x128_f8f6f4 %0, %1, %2, %0" : "+v"(acc[ai][bj][m][n]) : "v"(Bt##8[n]), "v"(At##8[m]));   \
        else { _Pragma("unroll") for (int k = 0; k < 2; ++k) acc[ai][bj][m][n] = __builtin_amdgcn_mfma_f32_16x16x32_bf16(Bt[n][k], At[m][k], acc[ai][bj][m][n], 0, 0, 0); } } \
        __builtin_amdgcn_s_setprio(0); } while (0)
#define PG8_WAIT_V(n) asm volatile("s_waitcnt vmcnt(" #n ")" ::: "memory")
#define PG8_WAIT_L(n) asm volatile("s_waitcnt lgkmcnt(" #n ")" ::: "memory")
#define PG8_BAR __builtin_amdgcn_s_barrier()
#define PG8_SCHED __builtin_amdgcn_sched_barrier(0)
    Unit cur, nxt; int ui = 0;
    if (!S.next(0, cur)) return;
    typename Epi::Pre pre = E.prefetch(cur, wr, fr);
    f32x4 acc[2][2][4][2];
#pragma unroll
    for (int a = 0; a < 2; ++a)
#pragma unroll
        for (int b = 0; b < 2; ++b)
#pragma unroll
            for (int m = 0; m < 4; ++m)
#pragma unroll
                for (int n = 0; n < 2; ++n) acc[a][b][m][n] = (f32x4){0.f, 0.f, 0.f, 0.f};
    bf16x8 At[4][2], B0[2][2], B1[2][2];
    v8i_t At8[4], B08[2], B18[2];
    const char* cA = (const char*)g.A + (size_t)cur.pm * tstep; const char* cB = (const char*)g.Bt + (size_t)cur.pn * tstep;
    S.a_ready(cur);
    if constexpr (SP2) {
        PG8_STAGE(PG8_SB(0, 0), cB, voffB); PG8_STAGE(PG8_SB(0, 1), cB + hstepB, voffB); PG8_STAGE(PG8_SA(0, 0), cA, voffA); PG8_STAGE(PG8_SA(0, 1), cA + hstep, voffA);
        if (wr == 1) PG8_BAR;
        PG8_WAIT_V(2); PG8_BAR;
        PG8_STAGE(PG8_SB(1, 0), cB + kstep, voffB); PG8_STAGE(PG8_SA(1, 0), cA + kstep, voffA); PG8_STAGE(PG8_SB(1, 1), cB + hstepB + kstep, voffB);
        PG8_WAIT_V(6); PG8_BAR;
    } else {
        PG8_STAGE(PG8_SB(0, 0), cB, voffB); PG8_STAGE(PG8_SA(0, 0), cA, voffA); PG8_STAGE(PG8_SB(0, 1), cB + hstepB, voffB); PG8_STAGE(PG8_SA(0, 1), cA + hstep, voffA);
        if (wr == 1) PG8_BAR;
        PG8_WAIT_V(4); PG8_BAR;
        PG8_STAGE(PG8_SB(1, 0), cB + kstep, voffB); PG8_STAGE(PG8_SA(1, 0), cA + kstep, voffA); PG8_STAGE(PG8_SB(1, 1), cB + hstepB + kstep, voffB);
        PG8_WAIT_V(6); PG8_BAR;
    }
    for (;;) {
        const bool has_next = S.next(ui + 1, nxt);
        const char* nA = has_next ? (const char*)g.A + (size_t)nxt.pm * tstep : cA; const char* nB = has_next ? (const char*)g.Bt + (size_t)nxt.pn * tstep : cB;
        for (int t = 0; t < nt; t += 2) {
            const bool last = (t == nt - 2);
            const char* a1 = cA + (size_t)(t + 1) * kstep;
            const char* a2 = last ? nA : cA + (size_t)(t + 2) * kstep; const char* b2 = last ? nB : cB + (size_t)(t + 2) * kstep;
            const char* a3 = a2 + kstep; const char* b3 = b2 + kstep;
            if (last && has_next) S.a_ready(nxt);
            if constexpr (SP2) {
            PG8_LDB(B0, 0, 0); PG8_LDB(B1, 0, 1); PG8_SCHED; PG8_LDA(At, 0, 0); PG8_STAGE(PG8_SA(1, 1), a1 + hstep, voffA);
            PG8_WAIT_V(8); PG8_WAIT_L(0); PG8_BAR; PG8_MMA(0, 0, At, B0); PG8_MMA(0, 1, At, B1); PG8_BAR; PG8_SCHED;
            PG8_LDA(At, 0, 1); PG8_STAGE(PG8_SB(0, 0), b2, voffB); PG8_STAGE(PG8_SB(0, 1), b2 + hstepB, voffB); PG8_STAGE(PG8_SA(0, 0), a2, voffA);
            PG8_WAIT_V(8); PG8_WAIT_L(0); PG8_BAR; PG8_MMA(1, 0, At, B0); PG8_MMA(1, 1, At, B1); PG8_BAR; PG8_SCHED;
            PG8_LDB(B0, 1, 0); PG8_LDB(B1, 1, 1); PG8_SCHED; PG8_LDA(At, 1, 0); PG8_STAGE(PG8_SA(0, 1), a2 + hstep, voffA);
            PG8_WAIT_V(8); PG8_WAIT_L(0); PG8_BAR; PG8_MMA(0, 0, At, B0); PG8_MMA(0, 1, At, B1); PG8_BAR; PG8_SCHED;
            PG8_LDA(At, 1, 1); PG8_STAGE(PG8_SB(1, 0), b3, voffB); PG8_STAGE(PG8_SB(1, 1), b3 + hstepB, voffB); PG8_STAGE(PG8_SA(1, 0), a3, voffA);
            PG8_WAIT_V(8); PG8_WAIT_L(0); PG8_BAR; PG8_MMA(1, 0, At, B0); PG8_MMA(1, 1, At, B1); PG8_BAR; PG8_SCHED;
            } else {
            PG8_LDB(B0, 0, 0); PG8_SCHED; PG8_LDA(At, 0, 0); PG8_STAGE(PG8_SA(1, 1), a1 + hstep, voffA);
            PG8_WAIT_L(8); PG8_BAR; PG8_WAIT_L(0); PG8_MMA(0, 0, At, B0); PG8_BAR; PG8_SCHED;
            PG8_LDB(B1, 0, 1); PG8_STAGE(PG8_SB(0, 0), b2, voffB);
            PG8_BAR; PG8_WAIT_L(0); PG8_MMA(0, 1, At, B1); PG8_BAR;
            PG8_LDA(At, 0, 1); PG8_STAGE(PG8_SA(0, 0), a2, voffA);
            PG8_BAR; PG8_WAIT_L(0); PG8_MMA(1, 0, At, B0); PG8_BAR; PG8_SCHED;
            PG8_STAGE(PG8_SB(0, 1), b2 + hstepB, voffB);
            PG8_WAIT_V(6); PG8_BAR; PG8_MMA(1, 1, At, B1); PG8_BAR;
            PG8_LDB(B0, 1, 0); PG8_SCHED; PG8_LDA(At, 1, 0); PG8_STAGE(PG8_SA(0, 1), a2 + hstep, voffA);
            PG8_WAIT_L(8); PG8_BAR; PG8_WAIT_L(0); PG8_MMA(0, 0, At, B0); PG8_BAR; PG8_SCHED;
            PG8_LDB(B1, 1, 1); PG8_STAGE(PG8_SB(1, 0), b3, voffB);
            PG8_BAR; PG8_WAIT_L(0); PG8_MMA(0, 1, At, B1); PG8_BAR;
            PG8_LDA(At, 1, 1); PG8_STAGE(PG8_SA(1, 0), a3, voffA);
            PG8_BAR; PG8_WAIT_L(0); PG8_MMA(1, 0, At, B0); PG8_BAR; PG8_SCHED;
            PG8_STAGE(PG8_SB(1, 1), b3 + hstepB, voffB);
            PG8_WAIT_V(6); PG8_BAR; PG8_MMA(1, 1, At, B1); PG8_BAR;
            }
        }
        if constexpr (FP8) asm volatile("s_nop 15\n\ts_nop 7" ::: "memory");
        if constexpr (ALIGN_EPI) { if (wr == 0) PG8_BAR; }
        if constexpr (!Epi::AFTER_DRAIN) { E(acc, cur, wr, wc, fr, fq, pre); S.done(cur); }
        if (!has_next) break;
#pragma unroll
        for (int a = 0; a < 2; ++a)
#pragma unroll
            for (int b = 0; b < 2; ++b)
#pragma unroll
                for (int m = 0; m < 4; ++m)
#pragma unroll
                    for (int n = 0; n < 2; ++n) acc[a][b][m][n] = (f32x4){0.f, 0.f, 0.f, 0.f};
        cur = nxt; cA = nA; cB = nB; ++ui;
        pre = E.prefetch(cur, wr, fr);
        if constexpr (ALIGN_EPI) { if (wr == 1) PG8_BAR; }
    }
    PG8_WAIT_V(0);
    if constexpr (!ALIGN_EPI) { if (wr == 0) PG8_BAR; }
    PG8_BAR;
#undef PG8_SA
#undef PG8_SB
#undef PG8_STAGE
#undef PG8_LDA
#undef PG8_LD8
#undef PG8_SBR
#undef PG8_LDB
#undef PG8_MMA
#undef PG8_WAIT_V
#undef PG8_WAIT_L
#undef PG8_BAR
#undef PG8_SCHED
}
}

constexpr int NWAVES = 8;
constexpr int BATCH = 32, S = 2048, D = 1024, DEPTH = 4, FF = 4096;
constexpr int M = BATCH * S;
constexpr int NP = 2304;
constexpr int DIN = 2108;
constexpr int C_QA = 0, C_CKV = 256, C_QIDX = 384, C_QB = 512, C_KCMP = 1024, C_VCMP = 1152, C_KSLC = 1280, C_VSLC = 1408, C_KWIN = 1536, C_VWIN = 1664,
              C_UC = 1792, C_KIDX = 2048, C_WIDX = 2080, C_GATE = 2084, C_KA = 2112, C_VA = 2176;
constexpr int NC = 127;
constexpr float EPS = 1e-6f;
constexpr float NEGF = -1e30f;

__host__ __device__ __forceinline__ int win_src(int n) {
    if (n < 512) return n;
    if (n < 1024) return 548 + (n - 512);
    if (n < 1792) return 1060 + (n - 1024);
    if (n < 2048) return 1852 + (n - 1792);
    if (n < 2080) return 512 + (n - 2048);
    if (n < 2084) return 544 + (n - 2080);
    if (n < 2108) return 1828 + (n - 2084);
    return -1;
}

constexpr size_t MiB = 1u << 20;
constexpr size_t WS_CTL = 0, CTL_ZERO_BYTES = 1 * MiB;
constexpr size_t WS_W = 2 * MiB;
constexpr size_t W_IN_B = (size_t)NP * D * 2, W_OUT_B = (size_t)D * D * 2, W_UP_B = (size_t)FF * D * 2, W_DN_B = (size_t)D * FF * 2;
constexpr size_t W_LAYER_B = W_IN_B + W_OUT_B + W_UP_B + W_DN_B;
constexpr size_t WS_ROPE = 96 * MiB;
constexpr size_t WS_WCT = 102 * MiB;
constexpr size_t WS_CB = 104 * MiB;
constexpr size_t WS_KCB = 124 * MiB, WS_VCB = 125 * MiB;
constexpr size_t WS_KA = 108 * MiB;
constexpr size_t WS_RS = 126 * MiB;
constexpr size_t WS_F = 256 * MiB;
constexpr size_t WS_PROJ = 384 * MiB;
constexpr size_t WS_MIX = 672 * MiB;
constexpr size_t WS_MASK = 800 * MiB;
constexpr size_t WS_HID = 384 * MiB;
constexpr size_t WS_X8 = 128 * MiB;
constexpr size_t WS_MIX8 = 816 * MiB;
constexpr size_t WS_XB = 896 * MiB;
constexpr size_t WS_END = 1024 * MiB;
static_assert(WS_W + DEPTH * W_LAYER_B <= WS_ROPE, "weights");
static_assert(WS_ROPE + (size_t)M * 24 * 4 <= WS_WCT && WS_WCT + (size_t)DEPTH * 2 * 128 * 1024 * 2 <= WS_CB, "map");
static_assert(WS_PROJ + (size_t)M * NP * 2 <= WS_MIX && WS_MIX + (size_t)M * D * 2 <= WS_END && WS_HID + (size_t)M * FF * 2 <= WS_END, "map2");

constexpr int CW_BAR = 4096;
constexpr int RING_BYTES = 131072;
constexpr int LDSCTL_OFF = RING_BYTES, MISC_OFF = LDSCTL_OFF + 320;
constexpr int LDS_BYTES = 147456;
constexpr int WSCR = 16384;

#define GAS __attribute__((address_space(1)))
#define LAS __attribute__((address_space(3)))
typedef unsigned short bf16;
typedef unsigned v4u __attribute__((ext_vector_type(4)));
typedef float f32x4 __attribute__((ext_vector_type(4)));
typedef GAS unsigned gu32;
#define LDS_FENCE() asm volatile("s_waitcnt lgkmcnt(0)" ::: "memory")
__device__ __forceinline__ unsigned f2bf(float f) { unsigned u = __builtin_bit_cast(unsigned, f); return (u + 0x7fffu + ((u >> 16) & 1u)) >> 16; }
__device__ __forceinline__ unsigned pk2(float lo, float hi) { return f2bf(lo) | (f2bf(hi) << 16); }
__device__ __forceinline__ float bf2f(bf16 u) { return __builtin_bit_cast(float, (unsigned)u << 16); }
__device__ __forceinline__ float bflo(unsigned u) { return __builtin_bit_cast(float, u << 16); }
__device__ __forceinline__ float bfhi(unsigned u) { return __builtin_bit_cast(float, u & 0xffff0000u); }

#define XB_TMO      128
#define XB_XCNT(j)  (256  + 64 * (j))
#define XB_XSUB(j)  (1280 + 64 * (j))
#define XB_XGEN(j)  (2304 + 64 * (j))
#define XB_TOP      3328
#define XB_TOPGEN   3392
#define XCD_BAR_WORDS 3456
#define XB_SPIN_CAP (1u << 22)

__device__ __forceinline__ unsigned xb_ld(unsigned* p)              { return __hip_atomic_load(p, __ATOMIC_RELAXED, __HIP_MEMORY_SCOPE_AGENT); }
__device__ __forceinline__ unsigned xb_add(unsigned* p, unsigned v) { return __hip_atomic_fetch_add(p, v, __ATOMIC_RELAXED, __HIP_MEMORY_SCOPE_AGENT); }
__device__ __forceinline__ unsigned xb_xcc_id() { return (unsigned)__builtin_amdgcn_s_getreg((3 << 11) | 20) & 0xFu; }
#define XB_SPIN(cond, bar) do { unsigned _sp = 0; while (cond) { __builtin_amdgcn_s_sleep(1); \
    if ((++_sp & 255u) == 0u) { if (xb_ld(&(bar)[XB_TMO])) break; if (_sp > XB_SPIN_CAP) { atomicAdd(&(bar)[XB_TMO], 1u); break; } } } } while (0)

struct XcdBarrier { unsigned* bar; unsigned x; volatile LAS unsigned* st; int wv; };

__device__ __forceinline__ XcdBarrier xcd_barrier_post(unsigned* bar, volatile LAS unsigned* st) {
    XcdBarrier b; b.bar = bar; b.x = xb_xcc_id(); b.st = st; b.wv = 0;
    if (threadIdx.x == 0) (void)xb_add(&bar[XB_XCNT(b.x)], 1u);
    return b;
}
__device__ __forceinline__ void xcd_barrier_complete(unsigned* bar, unsigned x, unsigned& nloc, unsigned& nx) {
    const unsigned G = gridDim.x * gridDim.y * gridDim.z;
    unsigned sum, cnt, mine, sp = 0u;
    for (;;) {
        sum = 0u; cnt = 0u; mine = 0u;
#pragma unroll
        for (unsigned j = 0; j < 16; ++j) { const unsigned c = xb_ld(&bar[XB_XCNT(j)]); sum += c; cnt += (c > 0u) ? 1u : 0u; mine = (j == x) ? c : mine; }
        if (sum == G) break;
        __builtin_amdgcn_s_sleep(1);
        if ((++sp & 255u) == 0u) { if (xb_ld(&bar[XB_TMO])) break; if (sp > XB_SPIN_CAP) { atomicAdd(&bar[XB_TMO], 1u); break; } }
    }
    nloc = mine > 0u ? mine : 1u; nx = cnt > 0u ? cnt : 1u;
}
__device__ __forceinline__ void xcd_barrier(const XcdBarrier& b) {
    asm volatile("s_waitcnt vmcnt(0)" ::: "memory");
    __syncthreads();
    if (b.wv == 0 && lane_id() == 0) {
        unsigned* bar = b.bar; asm volatile("" : "+s"(bar));
        __builtin_amdgcn_s_waitcnt(0);
        unsigned nloc = b.st[0], nx = b.st[1];
        unsigned bx_ = b.x; asm volatile("" : "+s"(bx_));
        if (nloc == 0u) { xcd_barrier_complete(bar, bx_, nloc, nx); b.st[0] = nloc; b.st[1] = nx; }
        const unsigned old = xb_add(&bar[XB_XSUB(bx_)], 1u);
        const unsigned gen = old / nloc;
        if (old + 1u == (gen + 1u) * nloc) {
            __builtin_amdgcn_fence(__ATOMIC_RELEASE, "agent");
            asm volatile("s_waitcnt vmcnt(0)" ::: "memory");
            const unsigned og = xb_add(&bar[XB_TOP], 1u);
            const unsigned tg = og / nx;
            if (og + 1u == (tg + 1u) * nx) xb_add(&bar[XB_TOPGEN], 1u);
            else XB_SPIN(xb_ld(&bar[XB_TOPGEN]) == tg, bar);
            __builtin_amdgcn_fence(__ATOMIC_ACQUIRE, "agent");
            xb_add(&bar[XB_XGEN(bx_)], 1u);
            asm volatile("s_waitcnt vmcnt(0)" ::: "memory");
        } else {
            XB_SPIN(xb_ld(&bar[XB_XGEN(bx_)]) == gen, bar);
            __builtin_amdgcn_fence(__ATOMIC_ACQUIRE, "agent");
            asm volatile("s_waitcnt vmcnt(0)" ::: "memory");
        }
    }
    __syncthreads();
}

struct Frame {
    LAS unsigned char* lds;
    volatile LAS unsigned* MISC;
    gu32* ctl;
    int wave, vcu, G;
    float* out; unsigned char* ws;
};
struct Args { const void* in[20]; float* out; unsigned char* ws; int ph_lo, ph_hi, use_bar, pad; };
#define IN_F(k) ((const float*)args.in[k])
#define P_X_IN IN_F(0)
#define P_POS ((const int*)args.in[1])
#define P_W_IN IN_F(2)
#define P_G_KV_A IN_F(3)
#define P_W_KV_UP IN_F(4)
#define P_W_CMP_K IN_F(5)
#define P_W_CMP_V IN_F(6)
#define P_PE_K IN_F(7)
#define P_PE_V IN_F(8)
#define P_W_POOL IN_F(9)
#define P_POOL_SCALE IN_F(10)
#define P_G_OUT_A IN_F(11)
#define P_G_OUT_B IN_F(12)
#define P_W_OUT IN_F(13)
#define P_G_PRE_MIX IN_F(14)
#define P_G_POST_MIX IN_F(15)
#define P_G_PRE_MLP IN_F(16)
#define P_G_POST_MLP IN_F(17)
#define P_W_UP IN_F(18)
#define P_W_DOWN IN_F(19)
#define B_ROPE ((float*)(ws_ + WS_ROPE))
#define B_F ((bf16*)(ws_ + WS_F))
#define B_PROJ ((bf16*)(ws_ + WS_PROJ))
#define B_MIX ((bf16*)(ws_ + WS_MIX))
#define B_HID ((bf16*)(ws_ + WS_HID))

template <int CTRL> __device__ __forceinline__ int dpp_i(int v) { return __builtin_amdgcn_update_dpp(0, v, CTRL, 0xF, 0xF, true); }
template <int CTRL> __device__ __forceinline__ float dpp_f(float v) { return __builtin_bit_cast(float, dpp_i<CTRL>(__builtin_bit_cast(int, v))); }
__device__ __forceinline__ int swz16_i(int v) { return __builtin_amdgcn_ds_swizzle(v, (16 << 10) | 0x1F); }
__device__ __forceinline__ float swz16_f(float v) { return __builtin_bit_cast(float, swz16_i(__builtin_bit_cast(int, v))); }
struct HalfPair { unsigned lo, hi; };
__device__ __forceinline__ HalfPair halves_u(unsigned v) { const auto rr = __builtin_amdgcn_permlane32_swap(v, v, false, false); HalfPair h; h.lo = rr[0]; h.hi = rr[1]; return h; }
__device__ __forceinline__ float other_half_f(float v, int hi) { const HalfPair h = halves_u(__builtin_bit_cast(unsigned, v)); return __builtin_bit_cast(float, hi ? h.lo : h.hi); }
__device__ __forceinline__ float sum32(float v) {
    v += dpp_f<0xB1>(v); v += dpp_f<0x4E>(v); v += dpp_f<0x141>(v); v += dpp_f<0x140>(v); v += swz16_f(v); return v; }
__device__ __forceinline__ float wave_sum(float v) { v = sum32(v); const HalfPair h = halves_u(__builtin_bit_cast(unsigned, v)); return __builtin_bit_cast(float, h.lo) + __builtin_bit_cast(float, h.hi); }
__device__ __forceinline__ float max_halves(float v) { const HalfPair h = halves_u(__builtin_bit_cast(unsigned, v)); return fmaxf(__builtin_bit_cast(float, h.lo), __builtin_bit_cast(float, h.hi)); }
__device__ __forceinline__ unsigned or_halves(unsigned v) { const HalfPair h = halves_u(v); return h.lo | h.hi; }
__device__ __forceinline__ unsigned or32(unsigned v) { v |= (unsigned)dpp_i<0xB1>((int)v); v |= (unsigned)dpp_i<0x4E>((int)v); v |= (unsigned)dpp_i<0x141>((int)v); v |= (unsigned)dpp_i<0x140>((int)v); v |= (unsigned)swz16_i((int)v); return v; }

__constant__ double c_rope_inv[12] = {1.0, 0.19392274474868576, 0.03760603093086393, 0.007292664737217109, 0.001414213562373095, 0.0002742481756762073, 5.318295896944988e-05, 1.031338537721246e-05,
                                       1.0, 0.03760603093086393, 0.001414213562373095, 5.318295896944988e-05};
template <int MODE, bool GAIN = false, bool OUT8 = false>
__device__ __forceinline__ void transpose_item(const float* W, int K, int Nsrc, int nblk, bf16* WT, LAS float* scr, int item, int lane, const float* gk = nullptr, float ws = 1.f) {
    const int kb = item / nblk, nb = item % nblk, k0 = 64 * kb, n0 = 32 * nb;
    if (MODE && n0 >= C_KA && n0 < C_KA + 128) return;
    const int np = n0 + 4 * (lane & 7);
    const int src = MODE ? win_src(np) : np;
#pragma unroll
    for (int i = 0; i < 8; ++i) { const int kk = 8 * i + (lane >> 3);
        f32x4 v = (f32x4){0.f, 0.f, 0.f, 0.f};
        if (src >= 0) v = *(const f32x4*)(W + (size_t)(k0 + kk) * Nsrc + src);
        const float gg = GAIN ? gk[k0 + kk] : 1.f;
        LAS float* d = scr + kk * 33 + 4 * (lane & 7);
        d[0] = v.x * gg; d[1] = v.y * gg; d[2] = v.z * gg; d[3] = v.w * gg; }
    LDS_FENCE();
    const int c = lane & 7;
#pragma unroll
    for (int j = 0; j < 4; ++j) { const int n = (lane >> 3) + 8 * j; const LAS float* s = scr + (8 * c) * 33 + n;
        if (OUT8) { unsigned long long o = (unsigned long long)pg8::pk4_fp8(s[0 * 33] * ws, s[1 * 33] * ws, s[2 * 33] * ws, s[3 * 33] * ws) | ((unsigned long long)pg8::pk4_fp8(s[4 * 33] * ws, s[5 * 33] * ws, s[6 * 33] * ws, s[7 * 33] * ws) << 32);
            *(unsigned long long*)((unsigned char*)WT + (size_t)(n0 + n) * K + k0 + 8 * c) = o; }
        else { v4u o; o.x = pk2(s[0 * 33], s[1 * 33]); o.y = pk2(s[2 * 33], s[3 * 33]); o.z = pk2(s[4 * 33], s[5 * 33]); o.w = pk2(s[6 * 33], s[7 * 33]);
            *(v4u*)(WT + (size_t)(n0 + n) * K + k0 + 8 * c) = o; } }
    LDS_FENCE();
}

__device__ __forceinline__ bf16* w_in_t(unsigned char* ws_, int l)  { return (bf16*)(ws_ + WS_W + (size_t)l * W_LAYER_B); }
__device__ __forceinline__ bf16* w_out_t(unsigned char* ws_, int l) { return (bf16*)(ws_ + WS_W + (size_t)l * W_LAYER_B + W_IN_B); }
__device__ __forceinline__ bf16* w_up_t(unsigned char* ws_, int l)  { return (bf16*)(ws_ + WS_W + (size_t)l * W_LAYER_B + W_IN_B + W_OUT_B); }
__device__ __forceinline__ bf16* w_dn_t(unsigned char* ws_, int l)  { return (bf16*)(ws_ + WS_W + (size_t)l * W_LAYER_B + W_IN_B + W_OUT_B + W_UP_B); }

__device__ __forceinline__ void phase_prologue(Frame& F, const Args& args) {
    unsigned char* ws_ = F.ws; asm volatile("" : "+s"(ws_)); int lane_ = lane_id(); asm volatile("" : "+v"(lane_)); (void)ws_;
    LAS float* scr = (LAS float*)(F.lds + F.wave * WSCR);
    const int gw = F.vcu * NWAVES + F.wave, NGW = F.G * NWAVES;
    constexpr int I_IN = (D / 64) * (NP / 32), I_OUT = (D / 64) * (D / 32), I_UP = (D / 64) * (FF / 32), I_DN = (FF / 64) * (D / 32);
    for (int it = gw; it < DEPTH * I_IN; it += NGW) { const int l = it / I_IN, r = it % I_IN; transpose_item<1, true>(P_W_IN + (size_t)l * D * DIN, D, DIN, NP / 32, w_in_t(ws_, l), scr, r, lane_, P_G_PRE_MIX + l * D); }
    for (int it = gw; it < DEPTH * I_OUT; it += NGW) { const int l = it / I_OUT, r = it % I_OUT; transpose_item<0, false, true>(P_W_OUT + (size_t)l * D * D, D, D, D / 32, w_out_t(ws_, l), scr, r, lane_, nullptr, pg8::WOSC); }
    for (int it = gw; it < DEPTH * I_UP; it += NGW) { const int l = it / I_UP, r = it % I_UP; transpose_item<0, true, true>(P_W_UP + (size_t)l * D * FF, D, FF, FF / 32, w_up_t(ws_, l), scr, r, lane_, P_G_PRE_MLP + l * D, pg8::WUSC); }
    for (int it = gw; it < DEPTH * I_DN; it += NGW) { const int l = it / I_DN, r = it % I_DN; transpose_item<0, false, true>(P_W_DOWN + (size_t)l * FF * D, FF, D, D / 32, w_dn_t(ws_, l), scr, r, lane_, nullptr, pg8::WDSC); }
    for (int it = gw; it < DEPTH * D * 2; it += NGW) {
        const int l = it / (D * 2), r = it % (D * 2), k = r >> 1, n = lane_ + 64 * (r & 1);
        const float* wi = P_W_IN + ((size_t)l * D + k) * DIN + 256; const float* gk = P_G_KV_A + l * 128; const float* wu = P_W_KV_UP + (size_t)l * 128 * 128 + n;
        float acc = 0.f;
#pragma unroll 32
        for (int j = 0; j < 128; ++j) acc += (wi[j] * gk[j]) * wu[j * 128];
        w_in_t(ws_, l)[(size_t)(C_KA + n) * D + k] = (bf16)f2bf(acc * P_G_PRE_MIX[l * D + k]);
    }
    for (int it = gw; it < DEPTH * 2 * 2 * 32; it += NGW) {
        const int lk = it >> 6, part = (it >> 5) & 1, r = it & 31, l = lk >> 1, kv = lk & 1;
        const float* W = (kv ? P_W_CMP_V : P_W_CMP_K) + (size_t)l * 32 * 64 * 64 + (size_t)part * 1024 * 64;
        transpose_item<0>(W, 1024, 64, 2, (bf16*)(ws_ + WS_WCT) + ((size_t)lk * 128 + part * 64) * 1024, scr, r, lane_);
    }
    {
        __syncthreads();
        LAS float* part = (LAS float*)F.lds;
        for (int it = F.vcu; it < DEPTH * 2 * 8; it += F.G) {
            const int lk = it >> 3, kc = it & 7, l = lk >> 1, kv = lk & 1;
            const float* W = (kv ? P_W_CMP_V : P_W_CMP_K) + (size_t)l * 32 * 64 * 64 + lane_; const float* pe = (kv ? P_PE_V : P_PE_K) + l * 32 * 64;
            float acc = 0.f;
            const int kb0 = kc * 256 + F.wave * 32;
#pragma unroll
            for (int k = 0; k < 32; ++k) acc += pe[kb0 + k] * W[(size_t)(kb0 + k) * 64];
            part[F.wave * 64 + lane_] = acc;
            __syncthreads();
            if (F.wave == 0) { float t = 0.f;
#pragma unroll
                for (int w8 = 0; w8 < 8; ++w8) t += part[w8 * 64 + lane_];
                ((float*)(ws_ + WS_CB + 4096))[it * 64 + lane_] = t; }
            __syncthreads();
        }
    }
}
__device__ __forceinline__ void phase_prologue_b(Frame& F, const Args& args) {
    unsigned char* ws_ = F.ws; asm volatile("" : "+s"(ws_)); int lane_ = lane_id(); asm volatile("" : "+v"(lane_)); (void)ws_;
    const int gw = F.vcu * NWAVES + F.wave, NGW = F.G * NWAVES;
    if (gw < DEPTH * 2) { float t = 0.f;
#pragma unroll
        for (int kc = 0; kc < 8; ++kc) t += ((const float*)(ws_ + WS_CB + 4096))[(gw * 8 + kc) * 64 + lane_];
        ((float*)(ws_ + WS_CB))[gw * 64 + lane_] = t; }
    for (int e = gw * 64 + lane_; e < M * 12; e += NGW * 64) {
        const int row = e / 12, i = e % 12;
        const double inv = c_rope_inv[i];
        const double a = (double)P_POS[row] * inv;
        const double k = __builtin_rint(a * 0.15915494309189535);
        const float r = (float)(a - k * 6.283185307179586);
        const float c = __builtin_cosf(r), s = __builtin_sinf(r);
        float* t = B_ROPE + (size_t)row * 24;
        if (i < 8) { t[i] = c; t[8 + i] = s; } else { t[16 + (i - 8)] = c; t[20 + (i - 8)] = s; }
    }
    for (int m0 = gw * 4; m0 < M; m0 += NGW * 4) {
        f32x4 v[4][4];
#pragma unroll
        for (int k = 0; k < 4; ++k) { const f32x4* xr = (const f32x4*)(P_X_IN + (size_t)(m0 + k) * D) + lane_;
#pragma unroll
            for (int j = 0; j < 4; ++j) v[k][j] = xr[64 * j]; }
#pragma unroll
        for (int k = 0; k < 4; ++k) { float sq = 0.f;
#pragma unroll
            for (int j = 0; j < 4; ++j) sq += (v[k][j].x * v[k][j].x + v[k][j].y * v[k][j].y) + (v[k][j].z * v[k][j].z + v[k][j].w * v[k][j].w);
            const float rsv = rsqrtf(wave_sum(sq) * (1.f / D) + EPS);
            unsigned long long* o8 = (unsigned long long*)((bf16*)(ws_ + WS_XB) + (size_t)(m0 + k) * D) + lane_;
#pragma unroll
            for (int j = 0; j < 4; ++j) o8[64 * j] = (unsigned long long)pk2(v[k][j].x, v[k][j].y) | ((unsigned long long)pk2(v[k][j].z, v[k][j].w) << 32);
            if (lane_ == 0) ((float*)(ws_ + WS_RS))[m0 + k] = rsv; }
    }
}

typedef short bf16x8 __attribute__((ext_vector_type(8)));
typedef short s16x4 __attribute__((ext_vector_type(4)));
typedef float f32x16 __attribute__((ext_vector_type(16)));
#define MFMA32(a, b, c) __builtin_amdgcn_mfma_f32_32x32x16_bf16((a), (b), (c), 0, 0, 0)
__device__ __forceinline__ int crow(int r, int hi) { return (r & 3) + 8 * (r >> 2) + 4 * hi; }
__device__ __forceinline__ void wg_barrier() { asm volatile("s_waitcnt lgkmcnt(0)\n\ts_barrier" ::: "memory"); }

__device__ __forceinline__ void phase_prep(Frame& F, const Args& args, int l) {
    unsigned char* ws_ = F.ws; asm volatile("" : "+s"(ws_)); int lane_ = lane_id(); asm volatile("" : "+v"(lane_)); (void)ws_; (void)args;
    int tid_ = F.wave * 64 + lane_id(); asm volatile("" : "+v"(tid_));
    const int gw = F.vcu * NWAVES + F.wave, NGW = F.G * NWAVES, lane = lane_;
    {
        const int sub = lane >> 4, q = lane & 15;
        const bool r_idx = (q == 2), r_kv = (q >= 4 && q < 8), r_ka = (q < 2);
        const int which = q - 4;
        const int cbase = r_idx ? C_KIDX : (((which < 2) ? C_KSLC : C_KWIN) + (which & 1) * 64);
        constexpr int RB = 4;
        for (int row0 = gw * (4 * RB); row0 < M; row0 += NGW * (4 * RB)) {
            v4u cu[RB], ku[RB], e1[RB], e2[RB]; f32x4 t0[RB], t1[RB], t2[RB], t3[RB];
#pragma unroll
            for (int k = 0; k < RB; ++k) { const size_t row = (size_t)(row0 + 4 * k + sub); bf16* prow = B_PROJ + row * NP; const f32x4* tab = (const f32x4*)(B_ROPE + row * 24);
                cu[k] = *(const v4u*)(prow + C_CKV + 8 * q); ku[k] = *(const v4u*)(prow + C_KA + 8 * q);
                e1[k] = (v4u){0u, 0u, 0u, 0u}; e2[k] = e1[k]; t0[k] = (f32x4){0.f, 0.f, 0.f, 0.f}; t1[k] = t0[k]; t2[k] = t0[k]; t3[k] = t0[k];
                if (r_ka || r_kv) { t0[k] = tab[0]; t1[k] = tab[1]; t2[k] = tab[2]; t3[k] = tab[3]; }
                if (r_idx) { t0[k] = tab[4]; t2[k] = tab[5]; }
                if (r_idx || r_kv) e1[k] = *(const v4u*)(prow + cbase);
                if (r_kv) e2[k] = *(const v4u*)(prow + cbase + 8); }
#pragma unroll
            for (int k = 0; k < RB; ++k) { const size_t row = (size_t)(row0 + 4 * k + sub); bf16* prow = B_PROJ + row * NP;
                float x[8] = {bflo(cu[k].x), bfhi(cu[k].x), bflo(cu[k].y), bfhi(cu[k].y), bflo(cu[k].z), bfhi(cu[k].z), bflo(cu[k].w), bfhi(cu[k].w)};
                float ss = 0.f;
#pragma unroll
                for (int e = 0; e < 8; ++e) ss += x[e] * x[e];
                ss += dpp_f<0xB1>(ss); ss += dpp_f<0x4E>(ss); ss += dpp_f<0x141>(ss); ss += dpp_f<0x140>(ss);
                const float rs = rsqrtf(ss * (1.f / 128.f) + EPS);
                float y[8] = {bflo(ku[k].x) * rs, bfhi(ku[k].x) * rs, bflo(ku[k].y) * rs, bfhi(ku[k].y) * rs, bflo(ku[k].z) * rs, bfhi(ku[k].z) * rs, bflo(ku[k].w) * rs, bfhi(ku[k].w) * rs};
                const float cs[8] = {t0[k].x, t0[k].y, t0[k].z, t0[k].w, t1[k].x, t1[k].y, t1[k].z, t1[k].w};
                const float sn[8] = {t2[k].x, t2[k].y, t2[k].z, t2[k].w, t3[k].x, t3[k].y, t3[k].z, t3[k].w};
#pragma unroll
                for (int e = 0; e < 8; ++e) { const float pr = dpp_f<0xB1>(y[e]);
                    const float r0 = y[e] * cs[e] - pr * sn[e], r1 = pr * sn[e] + y[e] * cs[e];
                    y[e] = r_ka ? ((q == 0) ? r0 : r1) : y[e]; }
                *(v4u*)(prow + C_KA + 8 * q) = (v4u){pk2(y[0], y[1]), pk2(y[2], y[3]), pk2(y[4], y[5]), pk2(y[6], y[7])};
                if (r_idx) {
                    float z[8] = {bflo(e1[k].x), bfhi(e1[k].x), bflo(e1[k].y), bfhi(e1[k].y), bflo(e1[k].z), bfhi(e1[k].z), bflo(e1[k].w), bfhi(e1[k].w)};
                    const float ci[4] = {t0[k].x, t0[k].y, t0[k].z, t0[k].w}, si[4] = {t2[k].x, t2[k].y, t2[k].z, t2[k].w};
                    float o[8];
#pragma unroll
                    for (int i = 0; i < 4; ++i) { o[i] = z[i] * ci[i] - z[4 + i] * si[i]; o[4 + i] = z[i] * si[i] + z[4 + i] * ci[i]; }
                    *(v4u*)(prow + cbase) = (v4u){pk2(o[0], o[1]), pk2(o[2], o[3]), pk2(o[4], o[5]), pk2(o[6], o[7])};
                } else if (r_kv) {
                    float z1[8] = {bflo(e1[k].x), bfhi(e1[k].x), bflo(e1[k].y), bfhi(e1[k].y), bflo(e1[k].z), bfhi(e1[k].z), bflo(e1[k].w), bfhi(e1[k].w)};
                    float z2[8] = {bflo(e2[k].x), bfhi(e2[k].x), bflo(e2[k].y), bfhi(e2[k].y), bflo(e2[k].z), bfhi(e2[k].z), bflo(e2[k].w), bfhi(e2[k].w)};
                    float o1[8], o2[8];
#pragma unroll
                    for (int i = 0; i < 8; ++i) { o1[i] = z1[i] * cs[i] - z2[i] * sn[i]; o2[i] = z1[i] * sn[i] + z2[i] * cs[i]; }
                    *(v4u*)(prow + cbase) = (v4u){pk2(o1[0], o1[1]), pk2(o1[2], o1[3]), pk2(o1[4], o1[5]), pk2(o1[6], o1[7])};
                    *(v4u*)(prow + cbase + 8) = (v4u){pk2(o2[0], o2[1]), pk2(o2[2], o2[3]), pk2(o2[4], o2[5]), pk2(o2[6], o2[7])};
                }
            }
        }
    }
    {
        const int wid = F.wave, r32 = lane & 31, hi = lane >> 5;
        LAS float* P = (LAS float*)F.lds;
        for (int u = F.vcu; u < BATCH * 8; u += F.G) {
            const int b = u >> 3, g = (u >> 2) & 1, kv = (u >> 1) & 1, eh = u & 1;
            const int rt = wid >> 1, part = wid & 1;
            const bf16* ap = B_PROJ + ((size_t)b * S + 16 * (32 * rt + r32)) * NP + (kv ? C_VCMP : C_KCMP) + g * 64 + 8 * hi;
            const bf16* bp = (const bf16*)(ws_ + WS_WCT) + ((size_t)(l * 2 + kv) * 128 + part * 64 + eh * 32 + r32) * 1024 + 8 * hi;
            f32x16 acc = {};
#pragma unroll 8
            for (int ks = 0; ks < 64; ++ks) {
                const bf16x8 a = *(const bf16x8*)(ap + (size_t)(ks >> 2) * NP + 16 * (ks & 3));
                const bf16x8 bq = *(const bf16x8*)(bp + 16 * ks);
                acc = MFMA32(a, bq, acc);
            }
#pragma unroll
            for (int r = 0; r < 16; ++r) P[(part * 128 + 32 * rt + crow(r, hi)) * 32 + r32] = acc[r];
            wg_barrier();
            const float* cb = (const float*)(ws_ + WS_CB) + (l * 2 + kv) * 64 + eh * 32;
            bf16* ob = (bf16*)(ws_ + (kv ? WS_VCB : WS_KCB)) + (size_t)(b * 2 + g) * 128 * 64 + eh * 32;
            for (int idx = tid_; idx < 128 * 32; idx += 512) { const int c = idx >> 5, e = idx & 31;
                const float v = (c < NC) ? (P[c * 32 + e] + P[(128 + c + 1) * 32 + e] + cb[e]) : 0.f;
                ob[c * 64 + e] = (bf16)f2bf(v); }
            wg_barrier();
        }
    }
}

typedef float f32x2_t __attribute__((ext_vector_type(2))); typedef __bf16 bf16x2_t __attribute__((ext_vector_type(2)));
__device__ __forceinline__ unsigned cvtpk(float lo, float hi) { const f32x2_t v = {lo, hi}; const bf16x2_t b = __builtin_convertvector(v, bf16x2_t); return __builtin_bit_cast(unsigned, b); }
constexpr float C2 = 0.125f * 1.4426950408889634f;

__device__ __forceinline__ unsigned idxmask(int x, int hi) {
    unsigned m = 0u;
#pragma unroll
    for (int g = 0; g < 4; ++g) { int n = x - (8 * g + 4 * hi); n = n < 0 ? 0 : (n > 4 ? 4 : n); m |= ((1u << n) - 1u) << (4 * g); }
    return m;
}

constexpr int SEL_QF = 0, SEL_PART = 16384, SEL_HIST = 20480, SEL_HP = 260, SEL_RES = SEL_HIST + 32 * SEL_HP * 4;
__device__ __forceinline__ void dsa_select_unit(unsigned char* ws_, int tid_, int b, int qt32, LAS unsigned char* lds) {
    asm volatile("" : "+v"(tid_)); asm volatile("" : "+s"(ws_));
    const int lane = tid_ & 63, wid = __builtin_amdgcn_readfirstlane(tid_ >> 6), r32 = lane & 31, hi = lane >> 5;
    unsigned* maskbuf = (unsigned*)(ws_ + WS_MASK);
    if (qt32 < 8) {
        for (int i = tid_; i < 2048; i += 512) { const int qq = i >> 6, blk = i & 63; const int t = 32 * qt32 + qq; const int d = t - 32 * blk;
            const unsigned w = d < 0 ? 0u : (d >= 31 ? 0xffffffffu : ((2u << d) - 1u));
            maskbuf[((size_t)b * S + t) * 64 + blk] = w; }
        return;
    }
    const size_t qrow = (size_t)b * S + 32 * qt32 + r32;
    const bf16* prow = B_PROJ + qrow * NP;
    {
        const int h = wid >> 1, sk = wid & 1;
        const v4u raw = *(const v4u*)(prow + C_QIDX + h * 32 + 16 * sk + 8 * hi);
        float x[8] = {bflo(raw.x), bfhi(raw.x), bflo(raw.y), bfhi(raw.y), bflo(raw.z), bfhi(raw.z), bflo(raw.w), bfhi(raw.w)};
        if (sk == 0 && hi == 0) { const float* tab = B_ROPE + qrow * 24;
#pragma unroll
            for (int i = 0; i < 4; ++i) { const float c = tab[16 + i], sn = tab[20 + i]; const float x1 = x[i], x2 = x[4 + i]; x[i] = x1 * c - x2 * sn; x[4 + i] = x1 * sn + x2 * c; } }
        v4u hp, lp;
        { unsigned hh[4], ll[4];
#pragma unroll
          for (int k = 0; k < 4; ++k) { const float a = x[2 * k], bb = x[2 * k + 1]; const unsigned ha = f2bf(a), hb = f2bf(bb); hh[k] = ha | (hb << 16);
              ll[k] = pk2(a - bf2f((bf16)ha), bb - bf2f((bf16)hb)); }
          hp = (v4u){hh[0], hh[1], hh[2], hh[3]}; lp = (v4u){ll[0], ll[1], ll[2], ll[3]}; }
        LAS v4u* qf = (LAS v4u*)(lds + SEL_QF);
        qf[((h * 2 + sk) * 2 + 0) * 64 + lane] = hp; qf[((h * 2 + sk) * 2 + 1) * 64 + lane] = lp;
    }
    float w[4];
#pragma unroll
    for (int h = 0; h < 4; ++h) w[h] = bf2f(prow[C_WIDX + h]);
    __syncthreads();
    const int nblk = qt32 + 1;
    const bf16* kbase = B_PROJ + (size_t)b * S * NP + C_KIDX;
    unsigned key[8][16];
#pragma unroll
    for (int i = 0; i < 8; ++i) {
        const int blk = wid + 8 * i;
        if (blk < nblk) {
            const bf16* kp = kbase + (size_t)(32 * blk + r32) * NP + 8 * hi;
            const bf16x8 kf0 = *(const bf16x8*)kp, kf1 = *(const bf16x8*)(kp + 16);
            float sc[16];
            const LAS bf16x8* qf = (const LAS bf16x8*)(lds + SEL_QF);
#pragma unroll
            for (int h = 0; h < 4; ++h) {
                f32x16 acc = {};
                acc = MFMA32(kf0, qf[((h * 2 + 0) * 2 + 0) * 64 + lane], acc);
                acc = MFMA32(kf1, qf[((h * 2 + 1) * 2 + 0) * 64 + lane], acc);
                acc = MFMA32(kf0, qf[((h * 2 + 0) * 2 + 1) * 64 + lane], acc);
                acc = MFMA32(kf1, qf[((h * 2 + 1) * 2 + 1) * 64 + lane], acc);
#pragma unroll
                for (int r = 0; r < 16; ++r) sc[r] = (h == 0) ? w[0] * fmaxf(acc[r], 0.f) : fmaf(w[h], fmaxf(acc[r], 0.f), sc[r]);
            }
#pragma unroll
            for (int r = 0; r < 16; ++r) {
                unsigned bits = __builtin_bit_cast(unsigned, sc[r]);
                if (bits == 0x80000000u) bits = 0u;
                unsigned k = (bits & 0x80000000u) ? ~bits : (bits | 0x80000000u);
                if (blk == qt32 && crow(r, hi) > r32) k = 0u;
                key[i][r] = k;
            }
        } else {
#pragma unroll
            for (int r = 0; r < 16; ++r) key[i][r] = 0u;
        }
    }
    LAS unsigned* part = (LAS unsigned*)(lds + SEL_PART);
    int pbi = 0;
#define SEL_REDUCE(cnt_, tot_) do { LAS unsigned* pb_ = part + (pbi & 1) * 512; ++pbi; pb_[wid * 64 + lane] = (cnt_); wg_barrier(); unsigned t_ = 0u; \
        _Pragma("unroll") for (int w8 = 0; w8 < 8; ++w8) t_ += pb_[w8 * 64 + r32] + pb_[w8 * 64 + 32 + r32]; (tot_) = t_; } while (0)
    LAS unsigned* hist = (LAS unsigned*)(lds + SEL_HIST);
    LAS unsigned* resd = (LAS unsigned*)(lds + SEL_RES);
    { unsigned z_ = 0u; asm volatile("" : "+v"(z_)); const v4u zz = {z_, z_, z_, z_}; for (int i = tid_; i < 32 * SEL_HP / 4; i += 512) ((LAS v4u*)hist)[i] = zz; }
    wg_barrier();
    unsigned pfx = 0u, need = 256u;
    LAS unsigned* hrow = hist + r32 * SEL_HP;
#pragma unroll 1
    for (int pass = 0; pass < 4; ++pass) {
        const int shift = 24 - 8 * pass;
#pragma unroll
        for (int i = 0; i < 8; ++i) if (wid + 8 * i < nblk) {
#pragma unroll
            for (int r = 0; r < 16; ++r) {
                const unsigned k = key[i][r];
                const unsigned dg = (k >> shift) & 255u;
                const bool match = (pass == 0) || ((k >> (shift + 8)) == pfx);
                __hip_atomic_fetch_add(hrow + (match ? dg : 256u), 1u, __ATOMIC_RELAXED, __HIP_MEMORY_SCOPE_WORKGROUP);
            } }
        wg_barrier();
        {
            const int qq = lane >> 4, t16 = lane & 15, q = 4 * wid + qq;
            LAS v4u* hq = (LAS v4u*)(hist + q * SEL_HP + 16 * t16);
            unsigned g4[4];
#pragma unroll
            for (int i = 0; i < 4; ++i) { const v4u hv = hq[i]; g4[i] = (hv.x + hv.y) + (hv.z + hv.w); }
            const unsigned sL = (g4[0] + g4[1]) + (g4[2] + g4[3]);
            unsigned T = sL;
            T += (unsigned)dpp_i<0x101>((int)T); T += (unsigned)dpp_i<0x102>((int)T); T += (unsigned)dpp_i<0x104>((int)T); T += (unsigned)dpp_i<0x108>((int)T);
            const unsigned needq = (pass == 0) ? 256u : resd[32 + q];
            const unsigned long long bal = __ballot(T >= needq);
            const unsigned rowbits = (unsigned)(bal >> (16 * qq)) & 0xFFFFu;
            const int ts = 31 - __builtin_clz(rowbits | 1u);
            {
                const unsigned rem = needq - (T - sL);
                unsigned c = 0u; int gs = 0; unsigned abg = 0u; bool found = false;
#pragma unroll
                for (int i = 3; i >= 0; --i) { const unsigned cn = c + g4[i]; if (!found && rem <= cn) { gs = i; abg = c; found = true; } c = cn; }
                const v4u hv = hq[gs];
                const unsigned r2 = rem - abg;
                const unsigned c3 = hv.w, c2 = c3 + hv.z, c1 = c2 + hv.y;
                int d; unsigned ab;
                if (r2 <= c3) { d = 3; ab = 0u; } else if (r2 <= c2) { d = 2; ab = c3; } else if (r2 <= c1) { d = 1; ab = c2; } else { d = 0; ab = c1; }
                asm volatile("s_waitcnt lgkmcnt(0)" ::: "memory");
                const unsigned cd = (d == 3) ? hv.w : (d == 2) ? hv.z : (d == 1) ? hv.y : hv.x;
                if (t16 == ts) { resd[q] = 16u * (unsigned)ts + 4u * (unsigned)gs + (unsigned)d; resd[32 + q] = r2 - ab; resd[64 + q] = (cd == r2 - ab) ? 1u : 0u; }
            }
            { unsigned z_ = 0u; asm volatile("" : "+v"(z_)); const v4u zz = {z_, z_, z_, z_};
              hq[0] = zz; hq[1] = zz; hq[2] = zz; hq[3] = zz; if (t16 == 0) hist[q * SEL_HP + 256] = z_; }
        }
        wg_barrier();
        pfx = (pfx << 8) | resd[r32]; need = resd[32 + r32];
    }
    const unsigned thr = pfx;
    if (__all(resd[64 + r32] != 0u)) {
#pragma unroll
        for (int i = 0; i < 8; ++i) {
            const int blk = wid + 8 * i; unsigned selm = 0u;
            if (blk < nblk) {
#pragma unroll
                for (int r = 0; r < 16; ++r) selm |= (key[i][r] >= thr) ? (1u << r) : 0u; }
            unsigned word = ((selm & 0xFu) | ((selm & 0xF0u) << 4) | ((selm & 0xF00u) << 8) | ((selm & 0xF000u) << 12)) << (4 * hi);
            word = or_halves(word);
            if (hi == 0) maskbuf[qrow * 64 + blk] = word;
        }
        __syncthreads();
        return;
    }
    unsigned gtm[8], eqm[8];
#pragma unroll
    for (int i = 0; i < 8; ++i) { unsigned g = 0u, e = 0u;
        if (wid + 8 * i < nblk) {
#pragma unroll
            for (int r = 0; r < 16; ++r) { g |= (key[i][r] > thr) ? (1u << r) : 0u; e |= (key[i][r] == thr) ? (1u << r) : 0u; } }
        gtm[i] = g; eqm[i] = e; }
    const unsigned rneed = need;
    unsigned pc[8];
#pragma unroll
    for (int i = 0; i < 8; ++i) pc[i] = __builtin_popcount(eqm[i]);
    unsigned Y = 0u;
    for (int bit = 10; bit >= 5; --bit) {
        const unsigned c = Y | (1u << bit); const int cb = (int)(c >> 5);
        unsigned cnt = 0u;
#pragma unroll
        for (int i = 0; i < 8; ++i) cnt += (wid + 8 * i < cb) ? pc[i] : 0u;
        unsigned tot; SEL_REDUCE(cnt, tot);
        if (tot < rneed) Y = c;
    }
    {
        const int yb = (int)(Y >> 5);
        unsigned cbase = 0u, em = 0u;
#pragma unroll
        for (int i = 0; i < 8; ++i) { cbase += (wid + 8 * i < yb) ? pc[i] : 0u; em |= (wid + 8 * i == yb) ? eqm[i] : 0u; }
        for (int bit = 4; bit >= 0; --bit) {
            const unsigned c = Y | (1u << bit);
            const unsigned cnt = cbase + __builtin_popcount(em & idxmask((int)(c & 31u), hi));
            unsigned tot; SEL_REDUCE(cnt, tot);
            if (tot < rneed) Y = c;
        }
    }
#undef SEL_REDUCE
#pragma unroll
    for (int i = 0; i < 8; ++i) {
        const int blk = wid + 8 * i;
        const unsigned selm = gtm[i] | (eqm[i] & idxmask((int)Y + 1 - 32 * blk, hi));
        unsigned word = ((selm & 0xFu) | ((selm & 0xF0u) << 4) | ((selm & 0xF00u) << 8) | ((selm & 0xF000u) << 12)) << (4 * hi);
        word = or_halves(word);
        if (hi == 0) maskbuf[qrow * 64 + blk] = word;
    }
    __syncthreads();
}

constexpr int AT_K = 0, AT_V = 32768, AT_WS = 132096;
typedef short v4i16_t __attribute__((ext_vector_type(4)));
__device__ __forceinline__ s16x4 vtr(unsigned addr) { return __builtin_bit_cast(s16x4, __builtin_amdgcn_ds_read_tr16_b64_v4i16((LAS v4i16_t*)(uintptr_t)addr)); }
__device__ __forceinline__ void pv(f32x16* o, f32x16& lacc, unsigned vb, bf16x8 pa0, bf16x8 pa1, bf16x8 pa2, bf16x8 pa3) {
    { const bf16x8 ones = {0x3F80, 0x3F80, 0x3F80, 0x3F80, 0x3F80, 0x3F80, 0x3F80, 0x3F80};
      lacc = MFMA32(pa0, ones, lacc); lacc = MFMA32(pa1, ones, lacc); lacc = MFMA32(pa2, ones, lacc); lacc = MFMA32(pa3, ones, lacc); }
#pragma unroll
    for (int d0 = 0; d0 < 2; ++d0) {
        const s16x4 lo0 = vtr(vb + d0 * 4096 + 0), hi0 = vtr(vb + d0 * 4096 + 512), lo1 = vtr(vb + d0 * 4096 + 1024), hi1 = vtr(vb + d0 * 4096 + 1536);
        const s16x4 lo2 = vtr(vb + d0 * 4096 + 2048), hi2 = vtr(vb + d0 * 4096 + 2560), lo3 = vtr(vb + d0 * 4096 + 3072), hi3 = vtr(vb + d0 * 4096 + 3584);
#define PKV(l_, h_) (bf16x8){l_[0], l_[1], l_[2], l_[3], h_[0], h_[1], h_[2], h_[3]}
        o[d0] = MFMA32(pa0, PKV(lo0, hi0), o[d0]);
        o[d0] = MFMA32(pa1, PKV(lo1, hi1), o[d0]);
        o[d0] = MFMA32(pa2, PKV(lo2, hi2), o[d0]);
        o[d0] = MFMA32(pa3, PKV(lo3, hi3), o[d0]);
#undef PKV
    }
}
struct SmState { float mhat; f32x16 o[2]; f32x16 lacc; };
__device__ __forceinline__ unsigned bfe1(unsigned w, int c) { int r; asm("v_bfe_i32 %0, %1, %2, 1" : "=v"(r) : "v"(w), "n"(c)); return (unsigned)r; }
__device__ __forceinline__ float rowmax32(const f32x16& p0, const f32x16& p1) {
    float a = fmaxf(p0[0], p1[0]);
#pragma unroll
    for (int r = 1; r < 16; ++r) a = fmaxf(a, fmaxf(p0[r], p1[r]));
    return max_halves(a);
}
constexpr int NS_QF = 65536, NS_SELS = 98304, NS_SSUM = 136192, NS_SELM = 144384;
static_assert(NS_SELS + 32768 <= LDSCTL_OFF && AT_WS >= MISC_OFF + 256 && NS_SELM + 256 <= LDS_BYTES, "attention LDS map");
__device__ __forceinline__ unsigned range32(int lo, int up) {
    const int l2 = lo < 0 ? 0 : lo, u2 = up > 31 ? 31 : up;
    const unsigned hm = (u2 >= 31) ? ~0u : ((2u << (u2 & 31)) - 1u);
    const unsigned lm = (1u << (l2 & 31)) - 1u;
    return (up < 0 || lo > 31 || u2 < l2) ? 0u : (hm & ~lm);
}
struct M64 { unsigned x, y; };
__device__ __forceinline__ M64 mask_range(int lo, int up) { M64 m; m.x = range32(lo, up); m.y = range32(lo - 32, up - 32); return m; }
__device__ __forceinline__ void load_q(bf16x8* qr, const bf16* qp, const float* tab, bool rope, int hi) {
#pragma unroll
    for (int d0 = 0; d0 < 4; ++d0) {
        const v4u raw = *(const v4u*)(qp + 16 * d0);
        float x[8] = {bflo(raw.x), bfhi(raw.x), bflo(raw.y), bfhi(raw.y), bflo(raw.z), bfhi(raw.z), bflo(raw.w), bfhi(raw.w)};
        if (d0 == 0) {
#pragma unroll
            for (int j = 0; j < 8; ++j) { const float other = other_half_f(x[j], hi); const float c = tab[j], sn = tab[8 + j];
                const float rot = (hi == 0) ? (x[j] * c - other * sn) : (other * sn + x[j] * c); x[j] = rope ? rot : x[j]; }
        }
        v4u pk; pk.x = cvtpk(x[0] * C2, x[1] * C2); pk.y = cvtpk(x[2] * C2, x[3] * C2); pk.z = cvtpk(x[4] * C2, x[5] * C2); pk.w = cvtpk(x[6] * C2, x[7] * C2);
        qr[d0] = __builtin_bit_cast(bf16x8, pk);
    }
}
__device__ __forceinline__ void qkt_lq(f32x16& p0, f32x16& p1, const LAS unsigned char* Kslot, const LAS bf16x8* qf, int lane, int r32, int hi) {
    const LAS unsigned char* kb = Kslot + hi * 1024 + r32 * 16;
    p0 = f32x16{}; p1 = f32x16{};
#pragma unroll
    for (int d0 = 0; d0 < 4; ++d0) {
        const bf16x8 b0 = *(const LAS bf16x8*)(kb + d0 * 2048);
        const bf16x8 b1 = *(const LAS bf16x8*)(kb + d0 * 2048 + 512);
        const bf16x8 q = qf[d0 * 64 + lane];
        p0 = MFMA32(b0, q, p0); p1 = MFMA32(b1, q, p1);
        if (d0 & 1) __builtin_amdgcn_sched_barrier(0);
    }
}
template <bool SEL>
__device__ __forceinline__ void softmax_pv(SmState& st, f32x16& osel, f32x16& p0, f32x16& p1, unsigned vb, const M64 mcur, bool first, LAS float* wsf, int r32, int hi, int ctile) {
    (void)first; (void)wsf; (void)r32;
    const unsigned wx = mcur.x >> (4 * hi), wy = mcur.y >> (4 * hi);
    unsigned e0[16], e1[16];
#pragma unroll
    for (int r = 0; r < 16; ++r) { e0[r] = __builtin_bit_cast(unsigned, __builtin_amdgcn_exp2f(p0[r])); e1[r] = __builtin_bit_cast(unsigned, __builtin_amdgcn_exp2f(p1[r])); }
    const bool lane_uniform = !SEL && __all((mcur.x == mcur.y) && ((mcur.x + 1u) <= 1u));
    if (!lane_uniform && !__all((mcur.x & mcur.y) == ~0u)) {
#pragma unroll
        for (int r = 0; r < 16; ++r) { const int c = (r & 3) + 8 * (r >> 2); e0[r] &= bfe1(wx, c); e1[r] &= bfe1(wy, c); }
    }
    unsigned pw[16];
#pragma unroll
    for (int k = 0; k < 8; ++k) { pw[k] = cvtpk(__builtin_bit_cast(float, e0[2 * k]), __builtin_bit_cast(float, e0[2 * k + 1])); pw[8 + k] = cvtpk(__builtin_bit_cast(float, e1[2 * k]), __builtin_bit_cast(float, e1[2 * k + 1])); }
    if (lane_uniform) {
#pragma unroll
        for (int k = 0; k < 16; ++k) pw[k] &= mcur.x;
    }
    if (SEL) {
#pragma unroll
        for (int ks = 0; ks < 4; ++ks) {
            unsigned ov[4], pl[4];
#pragma unroll
            for (int k = 0; k < 4; ++k) {
                const int j0 = 2 * k, j1 = 2 * k + 1;
                const int c0 = 64 * ctile + 16 * ks + 8 * (j0 >> 2) + 4 * hi + (j0 & 3), c1 = 64 * ctile + 16 * ks + 8 * (j1 >> 2) + 4 * hi + (j1 & 3);
                const unsigned a = (c0 >= 4 * r32 - 1 && c0 <= 4 * r32 + 3) ? 0x3F80u : 0u, bq = (c1 >= 4 * r32 - 1 && c1 <= 4 * r32 + 3) ? 0x3F80u : 0u;
                ov[k] = a | (bq << 16);
                const int e = 4 * ks + k;
                const float v0 = __builtin_bit_cast(float, (e < 8) ? e0[2 * e] : e1[2 * (e - 8)]), v1 = __builtin_bit_cast(float, (e < 8) ? e0[2 * e + 1] : e1[2 * (e - 8) + 1]);
                pl[k] = cvtpk(v0 - bflo(pw[e]), v1 - bfhi(pw[e]));
            }
            const bf16x8 ovf = __builtin_bit_cast(bf16x8, (v4u){ov[0], ov[1], ov[2], ov[3]});
            osel = MFMA32(__builtin_bit_cast(bf16x8, (v4u){pw[4 * ks], pw[4 * ks + 1], pw[4 * ks + 2], pw[4 * ks + 3]}), ovf, osel);
            osel = MFMA32(__builtin_bit_cast(bf16x8, (v4u){pl[0], pl[1], pl[2], pl[3]}), ovf, osel);
        }
    }
    pv(st.o, st.lacc, vb, __builtin_bit_cast(bf16x8, (v4u){pw[0], pw[1], pw[2], pw[3]}), __builtin_bit_cast(bf16x8, (v4u){pw[4], pw[5], pw[6], pw[7]}),
       __builtin_bit_cast(bf16x8, (v4u){pw[8], pw[9], pw[10], pw[11]}), __builtin_bit_cast(bf16x8, (v4u){pw[12], pw[13], pw[14], pw[15]}));
}
template <bool SEL>
__device__ __forceinline__ void tile_step(SmState& st, f32x16& osel, const LAS unsigned char* Kslot, unsigned vb, const LAS bf16x8* qf, const M64 mcur, bool first, LAS float* wsf, int lane, int r32, int hi, int ctile) {
    f32x16 p0, p1;
    qkt_lq(p0, p1, Kslot, qf, lane, r32, hi);
    softmax_pv<SEL>(st, osel, p0, p1, vb, mcur, first, wsf, r32, hi, ctile);
}
__device__ __forceinline__ void qkt_rq(f32x16& p0, f32x16& p1, const LAS unsigned char* Kslot, const bf16x8* qr, int r32, int hi) {
    const LAS unsigned char* kb = Kslot + hi * 1024 + r32 * 16;
    p0 = f32x16{}; p1 = f32x16{};
#pragma unroll
    for (int d0 = 0; d0 < 4; ++d0) {
        const bf16x8 b0 = *(const LAS bf16x8*)(kb + d0 * 2048);
        const bf16x8 b1 = *(const LAS bf16x8*)(kb + d0 * 2048 + 512);
        p0 = MFMA32(b0, qr[d0], p0); p1 = MFMA32(b1, qr[d0], p1);
    }
}
__device__ __forceinline__ void sm_reset(SmState& st) { st.mhat = 0.f; st.o[0] = f32x16{}; st.o[1] = f32x16{}; st.lacc = f32x16{}; }
__device__ __forceinline__ float sigmoidf_(float x) { return 1.f / (1.f + __expf(-x)); }

__device__ __forceinline__ void dsa_attn_unit(unsigned char* ws_, int tid_, int b, int qt, LAS unsigned char* lds) {
    asm volatile("" : "+v"(tid_)); asm volatile("" : "+s"(ws_));
    const int lane = tid_ & 63, wid = __builtin_amdgcn_readfirstlane(tid_ >> 6), r32 = lane & 31, hi = lane >> 5;
    const int h = wid >> 1, qh = wid & 1;
    const size_t qrow = (size_t)b * S + 64 * qt + 32 * qh + r32;
    LAS float* wsf = (LAS float*)(lds + AT_WS) + wid * 128;
    bf16x8 qr[4];
    {
        const bf16* qp = B_PROJ + qrow * NP + C_QA + h * 64 + 8 * hi;
        const float* tab = B_ROPE + qrow * 24;
#pragma unroll
        for (int d0 = 0; d0 < 4; ++d0) {
            const v4u raw = *(const v4u*)(qp + 16 * d0);
            float x[8] = {bflo(raw.x), bfhi(raw.x), bflo(raw.y), bfhi(raw.y), bflo(raw.z), bfhi(raw.z), bflo(raw.w), bfhi(raw.w)};
            if (d0 == 0) {
#pragma unroll
                for (int j = 0; j < 8; ++j) { const float other = other_half_f(x[j], hi); const float c = tab[j], sn = tab[8 + j];
                    x[j] = (hi == 0) ? (x[j] * c - other * sn) : (other * sn + x[j] * c); }
            }
            v4u pk; pk.x = cvtpk(x[0] * C2, x[1] * C2); pk.y = cvtpk(x[2] * C2, x[3] * C2); pk.z = cvtpk(x[4] * C2, x[5] * C2); pk.w = cvtpk(x[6] * C2, x[7] * C2);
            qr[d0] = __builtin_bit_cast(bf16x8, pk);
        }
    }
    constexpr int DK = 0, DV = 32768;
    const bf16* KAb = B_PROJ + (size_t)b * S * NP;
    const bf16* ksrc = KAb + (size_t)lane * NP + C_KA + wid * 8;
    const bf16* vsrc = KAb + (size_t)(16 * (wid & 3) + (lane >> 2)) * NP + C_VA + (wid >> 2) * 32 + (lane & 3) * 8;
#define AT_DMA(t, slot) do { \
        __builtin_amdgcn_global_load_lds((const unsigned*)(ksrc + (size_t)(t) * 64 * NP), (LAS unsigned*)(lds + DK + (slot) * 8192 + wid * 1024), 16, 0, 0); \
        __builtin_amdgcn_global_load_lds((const unsigned*)(vsrc + (size_t)(t) * 64 * NP), (LAS unsigned*)(lds + DV + (slot) * 8192 + wid * 1024), 16, 0, 0); } while (0)
    const unsigned vb0 = (unsigned)(uintptr_t)(lds + DV) + ((lane >> 4) & 1) * 32 + (lane & 3) * 8 + (4 * hi + ((lane & 15) >> 2)) * 64;
    const LAS unsigned char* kb0 = lds + DK + hi * 1024 + r32 * 16;
    const int NT = qt + 1;
    SmState st; sm_reset(st);
    const unsigned long long* mrow = (const unsigned long long*)((const unsigned*)(ws_ + WS_MASK) + qrow * 64);
    AT_DMA(0, 0);
    unsigned long long m0 = mrow[0], m1 = 0ull, m2 = 0ull;
    if (NT > 1) { AT_DMA(1, 1); m1 = mrow[1]; }
    (void)wsf;
#define SBAR() __builtin_amdgcn_sched_barrier(0)
#define PINV(x) asm volatile("" : "+v"(x))
#define KFR(t_, d0_, n_) (*(const LAS bf16x8*)(kb0 + ((t_) & 3) * 8192 + (d0_) * 2048 + (n_) * 512))
    f32x16 c0, c1;
    unsigned e0[16], e1[16];
    unsigned pw[16];
    unsigned long long mprev;
    {
        if (NT > 1) asm volatile("s_waitcnt vmcnt(3)" ::: "memory"); else asm volatile("s_waitcnt vmcnt(0)" ::: "memory");
        wg_barrier();
        if (NT > 2) { AT_DMA(2, 2); m2 = mrow[2]; }
        mprev = m0; m0 = m1; m1 = m2;
        c0 = f32x16{}; c1 = f32x16{};
#pragma unroll
        for (int d0 = 0; d0 < 4; ++d0) { c0 = MFMA32(KFR(0, d0, 0), qr[d0], c0); c1 = MFMA32(KFR(0, d0, 1), qr[d0], c1); }
#pragma unroll
        for (int r = 0; r < 16; ++r) { e0[r] = __builtin_bit_cast(unsigned, __builtin_amdgcn_exp2f(c0[r])); e1[r] = __builtin_bit_cast(unsigned, __builtin_amdgcn_exp2f(c1[r])); }
    }
    const bf16x8 ones = {0x3F80, 0x3F80, 0x3F80, 0x3F80, 0x3F80, 0x3F80, 0x3F80, 0x3F80};
#define MPK(E_, W_, r_) (E_[r_] & bfe1(W_, ((r_) & 3) + 8 * ((r_) >> 2)))
#define PACK_SLICE(g_) do { if ((g_) < 4) { pw[2 * (g_)] = cvtpk(__builtin_bit_cast(float, MPK(e0, wx, 4 * (g_))), __builtin_bit_cast(float, MPK(e0, wx, 4 * (g_) + 1))); \
                                            pw[2 * (g_) + 1] = cvtpk(__builtin_bit_cast(float, MPK(e0, wx, 4 * (g_) + 2)), __builtin_bit_cast(float, MPK(e0, wx, 4 * (g_) + 3))); } \
        else { pw[2 * (g_)] = cvtpk(__builtin_bit_cast(float, MPK(e1, wy, 4 * ((g_) - 4))), __builtin_bit_cast(float, MPK(e1, wy, 4 * ((g_) - 4) + 1))); \
               pw[2 * (g_) + 1] = cvtpk(__builtin_bit_cast(float, MPK(e1, wy, 4 * ((g_) - 4) + 2)), __builtin_bit_cast(float, MPK(e1, wy, 4 * ((g_) - 4) + 3))); } \
        PINV(pw[2 * (g_)]); PINV(pw[2 * (g_) + 1]); } while (0)
#define PAF(j_) __builtin_bit_cast(bf16x8, (v4u){pw[4 * (j_)], pw[4 * (j_) + 1], pw[4 * (j_) + 2], pw[4 * (j_) + 3]})
#define VFRAG(d0_, j_) (bf16x8){vlo[d0_][j_][0], vlo[d0_][j_][1], vlo[d0_][j_][2], vlo[d0_][j_][3], vhi[d0_][j_][0], vhi[d0_][j_][1], vhi[d0_][j_][2], vhi[d0_][j_][3]}
#define EXPS(C_, E_, r_) do { E_[r_] = __builtin_bit_cast(unsigned, __builtin_amdgcn_exp2f(C_[r_])); PINV(E_[r_]); } while (0)
    for (int t = 1; t < NT; ++t) {
        if (t + 1 < NT) asm volatile("s_waitcnt vmcnt(3)" ::: "memory"); else asm volatile("s_waitcnt vmcnt(0)" ::: "memory");
        wg_barrier();
        if (t + 2 < NT) { AT_DMA(t + 2, (t + 2) & 3); m2 = mrow[t + 2]; }
        const unsigned wx = (unsigned)mprev >> (4 * hi), wy = (unsigned)(mprev >> 32) >> (4 * hi);
        const unsigned vbp = vb0 + ((t - 1) & 3) * 8192;
        bf16x8 kf[8];
#pragma unroll
        for (int i = 0; i < 8; ++i) kf[i] = KFR(t, i >> 1, i & 1);
        SBAR();
        c0 = MFMA32(kf[0], qr[0], (f32x16{})); PACK_SLICE(0); SBAR();
        c1 = MFMA32(kf[1], qr[0], (f32x16{})); PACK_SLICE(1); SBAR();
        c0 = MFMA32(kf[2], qr[1], c0); PACK_SLICE(2); SBAR();
        c1 = MFMA32(kf[3], qr[1], c1); PACK_SLICE(3); SBAR();
        c0 = MFMA32(kf[4], qr[2], c0); PACK_SLICE(4); SBAR();
        c1 = MFMA32(kf[5], qr[2], c1); PACK_SLICE(5); SBAR();
        c0 = MFMA32(kf[6], qr[3], c0); PACK_SLICE(6); SBAR();
        c1 = MFMA32(kf[7], qr[3], c1); PACK_SLICE(7); SBAR();
        s16x4 vlo[2][4], vhi[2][4];
#pragma unroll
        for (int d0 = 0; d0 < 2; ++d0)
#pragma unroll
            for (int j = 0; j < 4; ++j) { vlo[d0][j] = vtr(vbp + d0 * 4096 + j * 1024); vhi[d0][j] = vtr(vbp + d0 * 4096 + j * 1024 + 512); }
        SBAR();
        st.lacc = MFMA32(PAF(0), ones, st.lacc); SBAR();
        st.lacc = MFMA32(PAF(1), ones, st.lacc); SBAR();
        st.lacc = MFMA32(PAF(2), ones, st.lacc); EXPS(c0, e0, 0); EXPS(c0, e0, 1); EXPS(c0, e0, 2); SBAR();
        st.lacc = MFMA32(PAF(3), ones, st.lacc); EXPS(c0, e0, 3); EXPS(c0, e0, 4); EXPS(c0, e0, 5); SBAR();
        st.o[0] = MFMA32(PAF(0), VFRAG(0, 0), st.o[0]); EXPS(c0, e0, 6); EXPS(c0, e0, 7); EXPS(c0, e0, 8); SBAR();
        st.o[1] = MFMA32(PAF(0), VFRAG(1, 0), st.o[1]); EXPS(c0, e0, 9); EXPS(c0, e0, 10); EXPS(c0, e0, 11); SBAR();
        st.o[0] = MFMA32(PAF(1), VFRAG(0, 1), st.o[0]); EXPS(c0, e0, 12); EXPS(c0, e0, 13); EXPS(c0, e0, 14); EXPS(c0, e0, 15); SBAR();
        st.o[1] = MFMA32(PAF(1), VFRAG(1, 1), st.o[1]); EXPS(c1, e1, 0); EXPS(c1, e1, 1); EXPS(c1, e1, 2); EXPS(c1, e1, 3); SBAR();
        st.o[0] = MFMA32(PAF(2), VFRAG(0, 2), st.o[0]); EXPS(c1, e1, 4); EXPS(c1, e1, 5); EXPS(c1, e1, 6); EXPS(c1, e1, 7); SBAR();
        st.o[1] = MFMA32(PAF(2), VFRAG(1, 2), st.o[1]); EXPS(c1, e1, 8); EXPS(c1, e1, 9); EXPS(c1, e1, 10); EXPS(c1, e1, 11); SBAR();
        st.o[0] = MFMA32(PAF(3), VFRAG(0, 3), st.o[0]); EXPS(c1, e1, 12); EXPS(c1, e1, 13); SBAR();
        st.o[1] = MFMA32(PAF(3), VFRAG(1, 3), st.o[1]); EXPS(c1, e1, 14); EXPS(c1, e1, 15); SBAR();
        mprev = m0; m0 = m1; m1 = m2;
    }
    {
        const unsigned wx = (unsigned)mprev >> (4 * hi), wy = (unsigned)(mprev >> 32) >> (4 * hi);
#pragma unroll
        for (int g = 0; g < 8; ++g) PACK_SLICE(g);
        pv(st.o, st.lacc, vb0 + ((NT - 1) & 3) * 8192, PAF(0), PAF(1), PAF(2), PAF(3));
    }
#undef SBAR
#undef PINV
#undef KFR
#undef MPK
#undef PACK_SLICE
#undef PAF
#undef VFRAG
#undef EXPS
#undef AT_DMA
    {
        bf16* ob = B_MIX + ((size_t)b * S + 64 * qt + 32 * qh) * D + h * 64 + r32;
#pragma unroll
        for (int r = 0; r < 16; ++r) { const int rq = crow(r, hi); const float f = __builtin_amdgcn_rcpf(st.lacc[r]);
            ob[(size_t)rq * D] = (bf16)f2bf(st.o[0][r] * f); ob[(size_t)rq * D + 32] = (bf16)f2bf(st.o[1][r] * f); }
    }
    __syncthreads();
}


struct PipeState { unsigned e0[16], e1[16]; M64 mprev; unsigned vbprev; };
__device__ __forceinline__ void pipe_pack(PipeState& ps, int hi, unsigned (&pw)[16]) {
    const M64 mcur = ps.mprev;
    const unsigned wx = mcur.x >> (4 * hi), wy = mcur.y >> (4 * hi);
    const bool lane_uniform = __all((mcur.x == mcur.y) && ((mcur.x + 1u) <= 1u));
    if (!lane_uniform && !__all((mcur.x & mcur.y) == ~0u)) {
#pragma unroll
        for (int r = 0; r < 16; ++r) { const int c = (r & 3) + 8 * (r >> 2); ps.e0[r] &= bfe1(wx, c); ps.e1[r] &= bfe1(wy, c); }
    }
#pragma unroll
    for (int k = 0; k < 8; ++k) { pw[k] = cvtpk(__builtin_bit_cast(float, ps.e0[2 * k]), __builtin_bit_cast(float, ps.e0[2 * k + 1])); pw[8 + k] = cvtpk(__builtin_bit_cast(float, ps.e1[2 * k]), __builtin_bit_cast(float, ps.e1[2 * k + 1])); }
    if (lane_uniform) {
#pragma unroll
        for (int k = 0; k < 16; ++k) pw[k] &= mcur.x;
    }
}
__device__ __forceinline__ void pipe_step(SmState& st, PipeState& ps, const LAS unsigned char* Kslot, unsigned vb, const LAS bf16x8* qf, const M64 mcur, bool first, int lane, int r32, int hi) {
    f32x16 c0, c1;
    if (first) {
        qkt_lq(c0, c1, Kslot, qf, lane, r32, hi);
#pragma unroll
        for (int r = 0; r < 16; ++r) { ps.e0[r] = __builtin_bit_cast(unsigned, __builtin_amdgcn_exp2f(c0[r])); ps.e1[r] = __builtin_bit_cast(unsigned, __builtin_amdgcn_exp2f(c1[r])); }
    } else {
        unsigned pw[16];
        pipe_pack(ps, hi, pw);
        qkt_lq(c0, c1, Kslot, qf, lane, r32, hi);
        const unsigned vbp = ps.vbprev;
        s16x4 vlo[2][4], vhi[2][4];
#pragma unroll
        for (int d0 = 0; d0 < 2; ++d0)
#pragma unroll
            for (int j = 0; j < 4; ++j) { vlo[d0][j] = vtr(vbp + d0 * 4096 + j * 1024); vhi[d0][j] = vtr(vbp + d0 * 4096 + j * 1024 + 512); }
        const bf16x8 ones = {0x3F80, 0x3F80, 0x3F80, 0x3F80, 0x3F80, 0x3F80, 0x3F80, 0x3F80};
#define SBAR() __builtin_amdgcn_sched_barrier(0)
#define PAF(j_) __builtin_bit_cast(bf16x8, (v4u){pw[4 * (j_)], pw[4 * (j_) + 1], pw[4 * (j_) + 2], pw[4 * (j_) + 3]})
#define VFRAG(d0_, j_) (bf16x8){vlo[d0_][j_][0], vlo[d0_][j_][1], vlo[d0_][j_][2], vlo[d0_][j_][3], vhi[d0_][j_][0], vhi[d0_][j_][1], vhi[d0_][j_][2], vhi[d0_][j_][3]}
#define EXPS(C_, E_, r_) do { E_[r_] = __builtin_bit_cast(unsigned, __builtin_amdgcn_exp2f(C_[r_])); asm volatile("" : "+v"(E_[r_])); } while (0)
        SBAR();
        st.lacc = MFMA32(PAF(0), ones, st.lacc); SBAR();
        st.lacc = MFMA32(PAF(1), ones, st.lacc); SBAR();
        st.lacc = MFMA32(PAF(2), ones, st.lacc); EXPS(c0, ps.e0, 0); EXPS(c0, ps.e0, 1); EXPS(c0, ps.e0, 2); SBAR();
        st.lacc = MFMA32(PAF(3), ones, st.lacc); EXPS(c0, ps.e0, 3); EXPS(c0, ps.e0, 4); EXPS(c0, ps.e0, 5); SBAR();
        st.o[0] = MFMA32(PAF(0), VFRAG(0, 0), st.o[0]); EXPS(c0, ps.e0, 6); EXPS(c0, ps.e0, 7); EXPS(c0, ps.e0, 8); SBAR();
        st.o[1] = MFMA32(PAF(0), VFRAG(1, 0), st.o[1]); EXPS(c0, ps.e0, 9); EXPS(c0, ps.e0, 10); EXPS(c0, ps.e0, 11); SBAR();
        st.o[0] = MFMA32(PAF(1), VFRAG(0, 1), st.o[0]); EXPS(c0, ps.e0, 12); EXPS(c0, ps.e0, 13); EXPS(c0, ps.e0, 14); EXPS(c0, ps.e0, 15); SBAR();
        st.o[1] = MFMA32(PAF(1), VFRAG(1, 1), st.o[1]); EXPS(c1, ps.e1, 0); EXPS(c1, ps.e1, 1); EXPS(c1, ps.e1, 2); EXPS(c1, ps.e1, 3); SBAR();
        st.o[0] = MFMA32(PAF(2), VFRAG(0, 2), st.o[0]); EXPS(c1, ps.e1, 4); EXPS(c1, ps.e1, 5); EXPS(c1, ps.e1, 6); EXPS(c1, ps.e1, 7); SBAR();
        st.o[1] = MFMA32(PAF(2), VFRAG(1, 2), st.o[1]); EXPS(c1, ps.e1, 8); EXPS(c1, ps.e1, 9); EXPS(c1, ps.e1, 10); EXPS(c1, ps.e1, 11); SBAR();
        st.o[0] = MFMA32(PAF(3), VFRAG(0, 3), st.o[0]); EXPS(c1, ps.e1, 12); EXPS(c1, ps.e1, 13); SBAR();
        st.o[1] = MFMA32(PAF(3), VFRAG(1, 3), st.o[1]); EXPS(c1, ps.e1, 14); EXPS(c1, ps.e1, 15); SBAR();
#undef SBAR
#undef VFRAG
#undef EXPS
    }
    ps.mprev = mcur; ps.vbprev = vb;
}
__device__ __forceinline__ void pipe_drain(SmState& st, PipeState& ps, int hi) {
    unsigned pw[16];
    pipe_pack(ps, hi, pw);
    pv(st.o, st.lacc, ps.vbprev, PAF(0), PAF(1), PAF(2), PAF(3));
#undef PAF
}

template <bool SEL>
__device__ __forceinline__ void nsa_unit(unsigned char* ws_, int tid_, int b, int g, int qt, LAS unsigned char* lds) {
    asm volatile("" : "+v"(tid_)); asm volatile("" : "+s"(ws_));
    const int lane = tid_ & 63, wid = __builtin_amdgcn_readfirstlane(tid_ >> 6), r32 = lane & 31, hi = lane >> 5;
    const int hr = wid >> 1, qh = wid & 1, H = 4 * g + hr;
    const int tq = 64 * qt + 32 * qh + r32;
    const size_t qrow = (size_t)b * S + tq;
    LAS float* wsf = (LAS float*)(lds + AT_WS) + wid * 128;
    const unsigned vb0 = (unsigned)(uintptr_t)(lds + AT_V) + ((lane >> 4) & 1) * 32 + (lane & 3) * 8 + (4 * hi + ((lane & 15) >> 2)) * 64;
    const bf16* kcb = (const bf16*)(ws_ + WS_KCB) + (size_t)(b * 2 + g) * 128 * 64;
    const bf16* vcb = (const bf16*)(ws_ + WS_VCB) + (size_t)(b * 2 + g) * 128 * 64;
    const bf16* pb = B_PROJ + (size_t)b * S * NP + g * 64;
    const int vrow = 16 * (wid & 3) + (lane >> 2), vcol = (wid >> 2) * 32 + (lane & 3) * 8;
#define NS_DMA(kp_, vp_, slot_) do { \
        __builtin_amdgcn_global_load_lds((const unsigned*)(kp_), (LAS unsigned*)(lds + AT_K + (slot_) * 8192 + wid * 1024), 16, 0, 0); \
        __builtin_amdgcn_global_load_lds((const unsigned*)(vp_), (LAS unsigned*)(lds + AT_V + (slot_) * 8192 + wid * 1024), 16, 0, 0); } while (0)
#define NS_DMA_CMP(i_, slot_) NS_DMA(kcb + (size_t)(64 * (i_) + lane) * 64 + wid * 8, vcb + (size_t)(64 * (i_) + vrow) * 64 + vcol, slot_)
#define NS_DMA_PROJ(ck_, cv_, j_, slot_) NS_DMA(pb + (size_t)(64 * (j_) + lane) * NP + (ck_) + wid * 8, pb + (size_t)(64 * (j_) + vrow) * NP + (cv_) + vcol, slot_)
    const int ncmp = (qt >= 16) ? 2 : 1;
    const int jw0 = (qt > 8) ? qt - 8 : 0, nwin = qt - jw0 + 1;
    if (hi == 0) { const bf16* gp = B_PROJ + qrow * NP + C_GATE + H * 3;
        wsf[64 + r32] = sigmoidf_(bf2f(gp[0])); wsf[96 + r32] = sigmoidf_(bf2f(gp[2])); wsf[32 + r32] = sigmoidf_(bf2f(gp[1])); }
    int nissued = 0, islot = 0, ti = 0, cslot = 0;
    unsigned remI = SEL ? 0u : ((2u << qt) - 1u);
#define NS_ISSUE() do { \
        if (nissued < ncmp) { NS_DMA_CMP(nissued, islot); } \
        else if (nissued < ncmp + nwin) { NS_DMA_PROJ(C_KWIN, C_VWIN, jw0 + nissued - ncmp, islot); } \
        else if (remI) { const int j_ = __builtin_ctz(remI); remI &= remI - 1u; NS_DMA_PROJ(C_KSLC, C_VSLC, j_, islot); } \
        else break; \
        ++nissued; islot = (islot + 1) & 3; } while (0)
#define NS_TOP() do { if (nissued > ti + 1) asm volatile("s_waitcnt vmcnt(2)" ::: "memory"); else asm volatile("s_waitcnt vmcnt(0)" ::: "memory"); wg_barrier(); NS_ISSUE(); } while (0)
#define NS_ADV() do { ++ti; cslot = (cslot + 1) & 3; } while (0)
    NS_ISSUE(); NS_ISSUE();
    LAS bf16x8* qf = (LAS bf16x8*)(lds + NS_QF) + wid * 256;
    { bf16x8 qr[4]; load_q(qr, B_PROJ + qrow * NP + C_QB + H * 64 + 8 * hi, B_ROPE + qrow * 24, false, hi);
#pragma unroll
      for (int d0 = 0; d0 < 4; ++d0) qf[d0 * 64 + lane] = qr[d0]; }
    SmState st; sm_reset(st);
    f32x16 osel = {};
    unsigned oaccp[16];
    const int ncv = (tq >= 31) ? (((tq - 31) >> 4) + 1) : 0;
    for (int i = 0; i < ncmp; ++i) {
        NS_TOP();
        const M64 m = mask_range(0, ncv - 64 * i - 1);
        tile_step<SEL>(st, osel, lds + AT_K + cslot * 8192, vb0 + cslot * 8192, qf, m, i == 0, wsf, lane, r32, hi, i);
        NS_ADV();
    }
    {
        asm volatile("s_waitcnt lgkmcnt(0)" ::: "memory");
        LAS float* sels = (LAS float*)(lds + NS_SELS);
#pragma unroll
        for (int r = 0; r < 16; ++r) { const int rq = crow(r, hi); const float lt = st.lacc[r]; const float inv = lt > 0.f ? __builtin_amdgcn_rcpf(lt) : 0.f; const float f2 = wsf[64 + rq] * inv;
            oaccp[r] = cvtpk(st.o[0][r] * f2, st.o[1][r] * f2); asm volatile("" : "+v"(oaccp[r]));
            if (SEL) sels[(hr * 64 + 32 * qh + rq) * 32 + r32] = osel[r] * inv; }
        asm volatile("s_waitcnt lgkmcnt(0)" ::: "memory");
    }
    unsigned selunion;
    if (SEL) {
        wg_barrier();
        LAS float* sels = (LAS float*)(lds + NS_SELS);
        LAS float* ssum = (LAS float*)(lds + NS_SSUM);
        LAS unsigned* selm = (LAS unsigned*)(lds + NS_SELM);
        const int q = tid_ >> 3, jg = tid_ & 7;
        f32x4 s4 = *(const LAS f32x4*)(sels + (0 * 64 + q) * 32 + 4 * jg);
        s4 += *(const LAS f32x4*)(sels + (1 * 64 + q) * 32 + 4 * jg);
        s4 += *(const LAS f32x4*)(sels + (2 * 64 + q) * 32 + 4 * jg);
        s4 += *(const LAS f32x4*)(sels + (3 * 64 + q) * 32 + 4 * jg);
        *(LAS f32x4*)(ssum + q * 32 + 4 * jg) = s4;
        asm volatile("s_waitcnt lgkmcnt(0)" ::: "memory");
        float sv[32];
#pragma unroll
        for (int k = 0; k < 8; ++k) { const f32x4 v = *(const LAS f32x4*)(ssum + q * 32 + 4 * k); sv[4 * k] = v.x; sv[4 * k + 1] = v.y; sv[4 * k + 2] = v.z; sv[4 * k + 3] = v.w; }
        const float PINF = __builtin_inff();
#pragma unroll
        for (int i = 0; i < 32; ++i) sv[i] = (i > qt) ? -PINF : ((i == 0 || i == qt || i == qt - 1) ? PINF : sv[i]);
        unsigned bits4 = 0u;
#pragma unroll
        for (int jj = 0; jj < 4; ++jj) {
            const int j = 4 * jg + jj;
            float mine = (jj == 0) ? s4.x : (jj == 1) ? s4.y : (jj == 2) ? s4.z : s4.w;
            mine = (j > qt) ? -PINF : ((j == 0 || j == qt || j == qt - 1) ? PINF : mine);
            int rank = 0;
#pragma unroll
            for (int i = 0; i < 32; ++i) rank += ((sv[i] > mine) || (sv[i] == mine && i < j)) ? 1 : 0;
            bits4 |= (rank < 16) ? (1u << jj) : 0u;
        }
        unsigned mm = bits4 << (4 * jg);
        mm |= (unsigned)dpp_i<0xB1>((int)mm); mm |= (unsigned)dpp_i<0x4E>((int)mm); mm |= (unsigned)dpp_i<0x141>((int)mm);
        if (jg == 0) selm[q] = mm;
        wg_barrier();
        unsigned u = selm[lane];
        u = or_halves(or32(u));
        selunion = (unsigned)__builtin_amdgcn_readfirstlane((int)u);
    } else {
        selunion = (2u << qt) - 1u;
    }
    { bf16x8 qr[4]; load_q(qr, B_PROJ + qrow * NP + C_QB + H * 64 + 8 * hi, B_ROPE + qrow * 24, true, hi);
#pragma unroll
      for (int d0 = 0; d0 < 4; ++d0) qf[d0 * 64 + lane] = qr[d0]; }
    sm_reset(st);
    if (SEL) remI = selunion;
    PipeState ps;
    for (int j = jw0; j <= qt; ++j) {
        NS_TOP();
        const M64 m = mask_range(tq - 511 - 64 * j, tq - 64 * j);
        pipe_step(st, ps, lds + AT_K + cslot * 8192, vb0 + cslot * 8192, qf, m, j == jw0, lane, r32, hi);
        NS_ADV();
    }
    pipe_drain(st, ps, hi);
    {
        asm volatile("s_waitcnt lgkmcnt(0)" ::: "memory");
#pragma unroll
        for (int r = 0; r < 16; ++r) { const float lt = st.lacc[r]; const float f2 = lt > 0.f ? wsf[96 + crow(r, hi)] * __builtin_amdgcn_rcpf(lt) : 0.f; oaccp[r] = cvtpk(bflo(oaccp[r]) + st.o[0][r] * f2, bfhi(oaccp[r]) + st.o[1][r] * f2); asm volatile("" : "+v"(oaccp[r])); }
        asm volatile("s_waitcnt lgkmcnt(0)" ::: "memory");
    }
    sm_reset(st);
    bool firstb = true;
    unsigned rem = selunion;
    while (rem) {
        const int j = __builtin_ctz(rem); rem &= rem - 1u;
        NS_TOP();
        const unsigned mysel_ = SEL ? ((const LAS unsigned*)(lds + NS_SELM))[32 * qh + r32] : ((2u << qt) - 1u);
        M64 m = mask_range(0, tq - 64 * j); if (!((mysel_ >> j) & 1u)) { m.x = 0u; m.y = 0u; }
        pipe_step(st, ps, lds + AT_K + cslot * 8192, vb0 + cslot * 8192, qf, m, firstb, lane, r32, hi);
        firstb = false; NS_ADV();
    }
    pipe_drain(st, ps, hi);
    {
        asm volatile("s_waitcnt lgkmcnt(0)" ::: "memory");
        bf16* ob = B_MIX + ((size_t)b * S + 64 * qt + 32 * qh) * D + 256 + H * 64 + r32;
#pragma unroll
        for (int r = 0; r < 16; ++r) { const int rq = crow(r, hi); const float lt = st.lacc[r]; const float f2 = lt > 0.f ? wsf[32 + rq] * __builtin_amdgcn_rcpf(lt) : 0.f;
            ob[(size_t)rq * D] = (bf16)f2bf(bflo(oaccp[r]) + st.o[0][r] * f2); ob[(size_t)rq * D + 32] = (bf16)f2bf(bfhi(oaccp[r]) + st.o[1][r] * f2); }
    }
    __syncthreads();
#undef NS_DMA
#undef NS_DMA_CMP
#undef NS_DMA_PROJ
#undef NS_ISSUE
#undef NS_TOP
#undef NS_ADV
}

__device__ __forceinline__ void phase_attn(Frame& F, int l) {
    (void)l;
    unsigned char* ws_ = F.ws; asm volatile("" : "+s"(ws_)); int lane_ = lane_id(); asm volatile("" : "+v"(lane_)); (void)ws_;
    int tid_ = F.wave * 64 + lane_id(); asm volatile("" : "+v"(tid_));
    for (int u = F.vcu; u < BATCH * 64; u += F.G) {
        const int c = u & 255, i = u >> 8; const int b = c >> 3, sft = c & 7; const int base = 16 * (i >> 1); const int qt32 = (i & 1) ? base + 15 - sft : base + sft;
        dsa_select_unit(ws_, tid_, b, qt32, F.lds);
    }
    __syncthreads();
#if PROBE_MASK
    if (blockIdx.x == 0 && F.wave == 0 && lane_id() == 0) { const unsigned long long ts_ = __builtin_amdgcn_s_memrealtime(); F.MISC[16] = (unsigned)ts_; F.MISC[17] = (unsigned)(ts_ >> 32); }
#endif
    for (int u = F.vcu; u < BATCH * 64; u += F.G) {
        const int c = u & 255, i = u >> 8; const int b = c >> 3, sft = c & 7; const int g = i & 1, k = i >> 1; const int base = 16 * (k >> 1); const int qt = (k & 1) ? base + 15 - sft : base + sft;
        if (qt >= 16) nsa_unit<true>(ws_, tid_, b, g, qt, F.lds); else nsa_unit<false>(ws_, tid_, b, g, qt, F.lds);
    }
}
__device__ __forceinline__ void phase_dsa_attn(Frame& F) {
    unsigned char* ws_ = F.ws; asm volatile("" : "+s"(ws_));
    int tid_ = F.wave * 64 + lane_id(); asm volatile("" : "+v"(tid_));
    for (int u = F.vcu; u < BATCH * 32; u += F.G) {
        const int c = u & 255, i = u >> 8; const int b = c >> 3, sft = c & 7; const int base = 16 * (i >> 1); const int qt = (i & 1) ? base + 15 - sft : base + sft;
        dsa_attn_unit(ws_, tid_, b, qt, F.lds);
    }
}

constexpr int WP_PITCH = 72;
__device__ __forceinline__ void phase_merge(Frame& F, const Args& args, int l) {
    unsigned char* ws_ = F.ws; asm volatile("" : "+s"(ws_)); int lane_ = lane_id(); asm volatile("" : "+v"(lane_)); (void)ws_;
    int tid_ = F.wave * 64 + lane_id(); asm volatile("" : "+v"(tid_));
    const int gw = F.vcu * NWAVES + F.wave, NGW = F.G * NWAVES, lane = lane_;
    const float* psc = P_POOL_SCALE + l * 256;
    const float* goa = P_G_OUT_A + l * 256; const float* gob = P_G_OUT_B + l * 512;
    LAS bf16* wp = (LAS bf16*)F.lds;
    {
        const float* wsrc = P_W_POOL + (size_t)l * 4 * 64 * 64;
        for (int idx = tid_; idx < 4 * 64 * 64; idx += 512) { const int g = idx >> 12, c = (idx >> 6) & 63, d = idx & 63; wp[(g * 64 + d) * WP_PITCH + c] = (bf16)f2bf(wsrc[idx]); }
    }
    {
        constexpr int RB = 4;
        const f32x4 gga = ((const f32x4*)goa)[lane]; const f32x4 gb0 = ((const f32x4*)gob)[2 * lane], gb1 = ((const f32x4*)gob)[2 * lane + 1];
        for (int row0 = gw * RB; row0 < M; row0 += NGW * RB) {
            unsigned long long ua[RB]; v4u ub[RB];
#pragma unroll
            for (int k = 0; k < RB; ++k) { const bf16* mrow = B_MIX + (size_t)(row0 + k) * D; ua[k] = *((const unsigned long long*)mrow + lane); ub[k] = *((const v4u*)(mrow + 256) + lane); }
#pragma unroll
            for (int k = 0; k < RB; ++k) { unsigned char* m8 = ws_ + WS_MIX8 + (size_t)(row0 + k) * D;
                { const unsigned long long u = ua[k];
                  const float a0 = bflo((unsigned)u), a1 = bfhi((unsigned)u), a2 = bflo((unsigned)(u >> 32)), a3 = bfhi((unsigned)(u >> 32));
                  const float rs = rsqrtf(wave_sum((a0 * a0 + a1 * a1) + (a2 * a2 + a3 * a3)) * (1.f / 256.f) + EPS);
                  const float rm = rs * pg8::MSC;
                  *((unsigned*)m8 + lane) = pg8::pk4_fp8(a0 * rm * gga.x, a1 * rm * gga.y, a2 * rm * gga.z, a3 * rm * gga.w); }
                { const v4u u = ub[k];
                  float a[8] = {bflo(u.x), bfhi(u.x), bflo(u.y), bfhi(u.y), bflo(u.z), bfhi(u.z), bflo(u.w), bfhi(u.w)};
                  float ss = 0.f;
#pragma unroll
                  for (int i = 0; i < 8; ++i) ss += a[i] * a[i];
                  const float rs = rsqrtf(wave_sum(ss) * (1.f / 512.f) + EPS) * pg8::MSC;
                  *((unsigned long long*)(m8 + 256) + lane) = (unsigned long long)pg8::pk4_fp8(a[0] * rs * gb0.x, a[1] * rs * gb0.y, a[2] * rs * gb0.z, a[3] * rs * gb0.w)
                                                             | ((unsigned long long)pg8::pk4_fp8(a[4] * rs * gb1.x, a[5] * rs * gb1.y, a[6] * rs * gb1.z, a[7] * rs * gb1.w) << 32); }
            }
        }
    }
    __syncthreads();
    {
        const int r32 = lane & 31, hi = lane >> 5;
        for (int tile = gw; tile < M / 32; tile += NGW) {
            const int row = 32 * tile + r32, t = row % S;
            const bf16* up = B_PROJ + (size_t)row * NP + C_UC + 8 * hi;
            f32x16 acc[4][2];
#pragma unroll
            for (int g = 0; g < 4; ++g) {
                acc[g][0] = f32x16{}; acc[g][1] = f32x16{};
                const int w = 2 << g;
                const float icnt = 1.f / (float)((t + 1 < w) ? t + 1 : w);
#pragma unroll
                for (int ks = 0; ks < 4; ++ks) {
                    const bf16* p0 = up + g * 64 + 16 * ks;
                    const v4u u0 = *(const v4u*)p0;
                    float cur[8] = {bflo(u0.x), bfhi(u0.x), bflo(u0.y), bfhi(u0.y), bflo(u0.z), bfhi(u0.z), bflo(u0.w), bfhi(u0.w)};
                    float sum[8];
#pragma unroll
                    for (int j = 0; j < 8; ++j) sum[j] = cur[j];
#pragma unroll
                    for (int i = 1; i < w; ++i) {
                        if (t - i >= 0) { const v4u ui = *(const v4u*)(p0 - (size_t)i * NP);
                            sum[0] += bflo(ui.x); sum[1] += bfhi(ui.x); sum[2] += bflo(ui.y); sum[3] += bfhi(ui.y); sum[4] += bflo(ui.z); sum[5] += bfhi(ui.z); sum[6] += bflo(ui.w); sum[7] += bfhi(ui.w); }
                    }
                    v4u pk; pk.x = cvtpk(sum[0] * icnt - cur[0], sum[1] * icnt - cur[1]); pk.y = cvtpk(sum[2] * icnt - cur[2], sum[3] * icnt - cur[3]);
                    pk.z = cvtpk(sum[4] * icnt - cur[4], sum[5] * icnt - cur[5]); pk.w = cvtpk(sum[6] * icnt - cur[6], sum[7] * icnt - cur[7]);
                    const bf16x8 af = __builtin_bit_cast(bf16x8, pk);
#pragma unroll
                    for (int nb = 0; nb < 2; ++nb) {
                        const bf16x8 bfr = *(const LAS bf16x8*)(wp + (g * 64 + 32 * nb + r32) * WP_PITCH + 16 * ks + 8 * hi);
                        acc[g][nb] = MFMA32(af, bfr, acc[g][nb]);
                    }
                }
            }
            float ss[16];
#pragma unroll
            for (int r = 0; r < 16; ++r) { float a = 0.f;
#pragma unroll
                for (int g = 0; g < 4; ++g) a += acc[g][0][r] * acc[g][0][r] + acc[g][1][r] * acc[g][1][r];
                a = sum32(a);
                ss[r] = rsqrtf(a * (1.f / 256.f) + EPS); }
            LAS unsigned char* stg = (LAS unsigned char*)F.lds + 40960 + F.wave * 8192;
#pragma unroll
            for (int g = 0; g < 4; ++g)
#pragma unroll
                for (int nb = 0; nb < 2; ++nb) { const float sc = psc[g * 64 + 32 * nb + r32] * pg8::MSC;
#pragma unroll
                    for (int r = 0; r < 16; r += 2) { const unsigned p2 = (unsigned)__builtin_amdgcn_cvt_pk_fp8_f32(acc[g][nb][r] * ss[r] * sc, acc[g][nb][r + 1] * ss[r + 1] * sc, 0, false);
                        stg[crow(r, hi) * 256 + g * 64 + 32 * nb + r32] = (unsigned char)p2; stg[crow(r + 1, hi) * 256 + g * 64 + 32 * nb + r32] = (unsigned char)(p2 >> 8); } }
            LDS_FENCE();
            unsigned char* ob8 = ws_ + WS_MIX8 + (size_t)(32 * tile) * D + 768;
#pragma unroll
            for (int i = 0; i < 8; ++i) { const int row = 4 * i + (lane >> 4), c16 = lane & 15; *(v4u*)(ob8 + (size_t)row * D + 16 * c16) = *(const LAS v4u*)(stg + row * 256 + 16 * c16); }
            LDS_FENCE();
        }
    }
    __syncthreads();
}

template <bool XIN_F32, bool OUT_F32, bool X8OUT = false>
__device__ __forceinline__ void phase_finish(Frame& F, const float* xsrc, const float* gpost, const float* gnext  , float fsc) {
    const float eps_eff = fsc * fsc * EPS;
    unsigned char* ws_ = F.ws; asm volatile("" : "+s"(ws_)); int lane_ = lane_id(); asm volatile("" : "+v"(lane_)); (void)ws_;
    const int gw = F.vcu * NWAVES + F.wave, NGW = F.G * NWAVES, lane = lane_;
    bf16* xb = (bf16*)(ws_ + WS_XB);
    constexpr int RB = 4;
    for (int row0 = gw * RB; row0 < M; row0 += NGW * RB) {
        v4u fu[RB][2]; float x[RB][2][8];
#pragma unroll
        for (int k = 0; k < RB; ++k) { const size_t row = (size_t)(row0 + k);
#pragma unroll
            for (int j = 0; j < 2; ++j) { fu[k][j] = *((const v4u*)(B_F + row * D + 512 * j) + lane);
                if (XIN_F32) { const f32x4 a = *((const f32x4*)(xsrc + row * D + 512 * j) + 2 * lane), c = *((const f32x4*)(xsrc + row * D + 512 * j) + 2 * lane + 1);
                    x[k][j][0] = a.x; x[k][j][1] = a.y; x[k][j][2] = a.z; x[k][j][3] = a.w; x[k][j][4] = c.x; x[k][j][5] = c.y; x[k][j][6] = c.z; x[k][j][7] = c.w; }
                else { const v4u ux = *((const v4u*)(xb + row * D + 512 * j) + lane);
                    x[k][j][0] = bflo(ux.x); x[k][j][1] = bfhi(ux.x); x[k][j][2] = bflo(ux.y); x[k][j][3] = bfhi(ux.y); x[k][j][4] = bflo(ux.z); x[k][j][5] = bfhi(ux.z); x[k][j][6] = bflo(ux.w); x[k][j][7] = bfhi(ux.w); } } }
        float gp[2][8];
#pragma unroll
        for (int j = 0; j < 2; ++j) { const f32x4 a = *((const f32x4*)(gpost + 512 * j) + 2 * lane), c = *((const f32x4*)(gpost + 512 * j) + 2 * lane + 1);
            gp[j][0] = a.x; gp[j][1] = a.y; gp[j][2] = a.z; gp[j][3] = a.w; gp[j][4] = c.x; gp[j][5] = c.y; gp[j][6] = c.z; gp[j][7] = c.w;
 }
#pragma unroll
        for (int k = 0; k < RB; ++k) { const size_t row = (size_t)(row0 + k);
            float f[2][8]; float ss = 0.f;
#pragma unroll
            for (int j = 0; j < 2; ++j) { const v4u u = fu[k][j];
                f[j][0] = bflo(u.x); f[j][1] = bfhi(u.x); f[j][2] = bflo(u.y); f[j][3] = bfhi(u.y); f[j][4] = bflo(u.z); f[j][5] = bfhi(u.z); f[j][6] = bflo(u.w); f[j][7] = bfhi(u.w);
#pragma unroll
                for (int e = 0; e < 8; ++e) ss += f[j][e] * f[j][e]; }
            const float rs = rsqrtf(wave_sum(ss) * (1.f / D) + eps_eff);
            float s2 = 0.f;
#pragma unroll
            for (int j = 0; j < 2; ++j) {
#pragma unroll
                for (int e = 0; e < 8; ++e) { const float xv = x[k][j][e] + f[j][e] * rs * gp[j][e]; x[k][j][e] = xv; s2 += xv * xv; }
                if (OUT_F32) { f32x4* o = (f32x4*)(F.out + row * D + 512 * j) + 2 * lane;
                    o[0] = (f32x4){x[k][j][0], x[k][j][1], x[k][j][2], x[k][j][3]}; o[1] = (f32x4){x[k][j][4], x[k][j][5], x[k][j][6], x[k][j][7]}; }
                else *((v4u*)(xb + row * D + 512 * j) + lane) = (v4u){pk2(x[k][j][0], x[k][j][1]), pk2(x[k][j][2], x[k][j][3]), pk2(x[k][j][4], x[k][j][5]), pk2(x[k][j][6], x[k][j][7])};
            }
            if (gnext) { const float r2 = rsqrtf(wave_sum(s2) * (1.f / D) + EPS); if (lane == 0) ((float*)(ws_ + WS_RS))[row] = r2;
                if (X8OUT) { const float r3 = r2 * pg8::XSC; unsigned char* x8 = ws_ + WS_X8 + row * D;
#pragma unroll
                    for (int j = 0; j < 2; ++j) *((unsigned long long*)(x8 + 512 * j) + lane) = (unsigned long long)pg8::pk4_fp8(x[k][j][0] * r3, x[k][j][1] * r3, x[k][j][2] * r3, x[k][j][3] * r3)
                        | ((unsigned long long)pg8::pk4_fp8(x[k][j][4] * r3, x[k][j][5] * r3, x[k][j][6] * r3, x[k][j][7] * r3) << 32); } }
        }
    }
}

template <int ACT>
__device__ __forceinline__ void phase_gemm(Frame& F, const bf16* A, const bf16* Bt, bf16* O, int N, int K, const float* rs) {
    asm volatile("" : "+s"(A), "+s"(Bt), "+s"(O), "+s"(rs));
    int bx_ = (int)blockIdx.x, gg_ = F.G; asm volatile("" : "+s"(bx_), "+s"(gg_));
    pg8::Gemm g{A, Bt, M, N, K}; pg8::StaticOrder So; So.init(M, N, gg_, bx_);
    pg8::EpiStore<ACT> E{O, N, rs};
    pg8::gemm_phase<pg8::EpiStore<ACT>, pg8::StaticOrder, true, true>(F.lds, g, So, E, F.wave);
}

__device__ __forceinline__ void phase_gemm_up8(Frame& F, const bf16* A, const bf16* Bt, unsigned char* O8, const float* rs) {
    asm volatile("" : "+s"(A), "+s"(Bt), "+s"(O8), "+s"(rs));
    int bx_ = (int)blockIdx.x, gg_ = F.G; asm volatile("" : "+s"(bx_), "+s"(gg_));
    pg8::Gemm g{A, Bt, M, FF, D}; pg8::StaticOrder So; So.init(M, FF, gg_, bx_);
    pg8::EpiRelu2Fp8T<true> E{O8, FF, rs};
    pg8::gemm_phase<pg8::EpiRelu2Fp8T<true>, pg8::StaticOrder, true, true>(F.lds, g, So, E, F.wave);
}
__device__ __forceinline__ void phase_gemm_up88(Frame& F, const unsigned char* A8, const unsigned char* Bt8, unsigned char* O8) {
    asm volatile("" : "+s"(A8), "+s"(Bt8), "+s"(O8));
    int bx_ = (int)blockIdx.x, gg_ = F.G; asm volatile("" : "+s"(bx_), "+s"(gg_));
    pg8::Gemm g{(const bf16*)A8, (const bf16*)Bt8, M, FF, D / 2}; pg8::StaticOrder So; So.init(M, FF, gg_, bx_);
    pg8::EpiRelu2Fp8T<false> E{O8, FF, nullptr};
    pg8::gemm_phase<pg8::EpiRelu2Fp8T<false>, pg8::StaticOrder, true, true, true>(F.lds, g, So, E, F.wave);
}
__device__ __forceinline__ void phase_gemm_down8(Frame& F, const unsigned char* A8, const unsigned char* Bt8, bf16* O) {
    asm volatile("" : "+s"(A8), "+s"(Bt8), "+s"(O));
    int bx_ = (int)blockIdx.x, gg_ = F.G; asm volatile("" : "+s"(bx_), "+s"(gg_));
    pg8::Gemm g{(const bf16*)A8, (const bf16*)Bt8, M, D, FF / 2}; pg8::StaticOrder So; So.init(M, D, gg_, bx_);
    pg8::EpiStore<0> E{O, D, nullptr};
    pg8::gemm_phase<pg8::EpiStore<0>, pg8::StaticOrder, true, true, true>(F.lds, g, So, E, F.wave);
}
__device__ __forceinline__ void phase_gemm_out8(Frame& F, const unsigned char* A8, const unsigned char* Bt8, bf16* O) {
    asm volatile("" : "+s"(A8), "+s"(Bt8), "+s"(O));
    int bx_ = (int)blockIdx.x, gg_ = F.G; asm volatile("" : "+s"(bx_), "+s"(gg_));
    pg8::Gemm g{(const bf16*)A8, (const bf16*)Bt8, M, D, D / 2}; pg8::StaticOrder So; So.init(M, D, gg_, bx_);
    pg8::EpiStore<0> E{O, D, nullptr};
    pg8::gemm_phase<pg8::EpiStore<0>, pg8::StaticOrder, true, true, true>(F.lds, g, So, E, F.wave);
}

constexpr int PH_PER_LAYER = 10, NPHASES = 2 + DEPTH * PH_PER_LAYER;
__global__ void __launch_bounds__(NWAVES * 64, 2) mk_fwd(Args args) {
    extern __shared__ __attribute__((aligned(16))) unsigned char lds[];
    Frame F;
    F.lds = (LAS unsigned char*)lds;
    F.MISC = (volatile LAS unsigned*)(F.lds + MISC_OFF);
    { const int t0_ = threadIdx.x; F.wave = __builtin_amdgcn_readfirstlane(t0_ >> 6);
      for (int u = t0_; u < (LDS_BYTES - LDSCTL_OFF) / 4; u += NWAVES * 64) ((LAS unsigned*)(F.lds + LDSCTL_OFF))[u] = 0u; }
    F.G = gridDim.x; { const int bx = blockIdx.x; F.vcu = (F.G % 8 == 0) ? (bx % 8) * (F.G / 8) + bx / 8 : bx; }
    unsigned char* ws = args.ws; F.ws = ws;
    F.ctl = (gu32*)(ws + WS_CTL);
    F.out = args.out;
    __syncthreads();
    XcdBarrier bar; bar.bar = (unsigned*)(F.ctl + CW_BAR); bar.x = 0; bar.st = F.MISC + 8; bar.wv = 0;
    if (args.use_bar) bar = xcd_barrier_post((unsigned*)(F.ctl + CW_BAR), F.MISC + 8);
    bar.wv = F.wave;
    const int lo = args.ph_lo, hi = args.ph_hi;
    int pid = 0;
    unsigned char* ws_ = F.ws;
#define PH_ON (pid >= lo && pid < hi)
#if PROBE_MASK
    if (blockIdx.x == 0 && F.wave == 0 && lane_id() == 0) { const unsigned long long t_ = __builtin_amdgcn_s_memrealtime(); F.MISC[18] = (unsigned)t_; F.MISC[19] = (unsigned)(t_ >> 32); F.MISC[20] = 0u; F.MISC[21] = 0u; }
#define PH_END(kind) do { if (PH_ON && pid + 1 < hi) xcd_barrier(bar); ++pid; \
        if (blockIdx.x == 0 && F.wave == 0 && lane_id() == 0) { const unsigned long long now_ = __builtin_amdgcn_s_memrealtime(); \
          const unsigned long long last_ = (unsigned long long)F.MISC[18] | ((unsigned long long)F.MISC[19] << 32); unsigned long long acc_ = (unsigned long long)F.MISC[20] | ((unsigned long long)F.MISC[21] << 32); \
          if ((kind) == 3) { const unsigned long long sp_ = (unsigned long long)F.MISC[16] | ((unsigned long long)F.MISC[17] << 32); \
              if ((PROBE_MASK >> 11) & 1) acc_ += sp_ - last_; if ((PROBE_MASK >> 3) & 1) acc_ += now_ - sp_; } \
          else if ((PROBE_MASK >> (kind)) & 1) acc_ += now_ - last_; \
          F.MISC[18] = (unsigned)now_; F.MISC[19] = (unsigned)(now_ >> 32); F.MISC[20] = (unsigned)acc_; F.MISC[21] = (unsigned)(acc_ >> 32); } } while (0)
#else
#define PH_END(kind) do { if (PH_ON && pid + 1 < hi) xcd_barrier(bar); ++pid; } while (0)
#endif

    if (PH_ON && !(SKIPM & 1)) phase_prologue(F, args);
    PH_END(0);
    if (PH_ON && !(SKIPM & 1)) phase_prologue_b(F, args);
    PH_END(0);
    for (int l = 0; l < DEPTH; ++l) {
        unsigned char* ws_ = F.ws; asm volatile("" : "+s"(ws_));
        if (PH_ON && !(SKIPM & 2)) phase_gemm<0>(F, (const bf16*)(ws_ + WS_XB), w_in_t(ws_, l), B_PROJ, NP, D, (const float*)(ws_ + WS_RS));
        PH_END(1);
        if (PH_ON && !(SKIPM & 4)) phase_prep(F, args, l);
        PH_END(2);
        if (PH_ON && !(SKIPM & 8)) phase_attn(F, l);
        PH_END(3);
        if (PH_ON && !(SKIPM & 8)) phase_dsa_attn(F);
        PH_END(4);
        if (PH_ON && !(SKIPM & 16)) phase_merge(F, args, l);
        PH_END(5);
        if (PH_ON && !(SKIPM & 32)) phase_gemm_out8(F, (const unsigned char*)(ws_ + WS_MIX8), (const unsigned char*)w_out_t(ws_, l), B_F);
        PH_END(6);
        if (PH_ON && !(SKIPM & 64)) { phase_finish<false, false, true>(F, nullptr, P_G_POST_MIX + l * D, P_G_PRE_MLP + l * D, pg8::MSC * pg8::WOSC); }
        PH_END(7);
        if (PH_ON && !(SKIPM & 128)) phase_gemm_up88(F, (const unsigned char*)(ws_ + WS_X8), (const unsigned char*)w_up_t(ws_, l), (unsigned char*)(ws_ + WS_HID));
        PH_END(8);
        if (PH_ON && !(SKIPM & 256)) phase_gemm_down8(F, (const unsigned char*)(ws_ + WS_HID), (const unsigned char*)w_dn_t(ws_, l), B_F);
        PH_END(9);
        if (PH_ON && !(SKIPM & 512)) { if (l + 1 < DEPTH) phase_finish<false, false>(F, nullptr, P_G_POST_MLP + l * D, P_G_PRE_MIX + (l + 1) * D, pg8::HSC * pg8::WDSC); else phase_finish<false, true>(F, nullptr, P_G_POST_MLP + l * D, nullptr, pg8::HSC * pg8::WDSC); }
        PH_END(10);
    }
#if PROBE_MASK
    if (blockIdx.x == 0 && F.wave == 0 && lane_id() == 0) { const unsigned long long pr_acc = (unsigned long long)F.MISC[20] | ((unsigned long long)F.MISC[21] << 32);
        const unsigned long long t0_ = __builtin_amdgcn_s_memrealtime(); while (__builtin_amdgcn_s_memrealtime() - t0_ < pr_acc) __builtin_amdgcn_s_sleep(8); }
#endif
#undef PH_ON
#undef PH_END
}

extern "C" void kernel_launch(void* const* d_in, const int* in_sizes, int n_in, void* d_out, int out_size, void* d_ws, size_t ws_size, hipStream_t stream) {
    static int grid = 0;
    if (grid == 0) {
        if (n_in != 20 || in_sizes[0] != M * D || out_size != M * D || ws_size < WS_END) {
            fprintf(stderr, "kernel_launch: unexpected shapes / workspace (n_in %d, in0 %d, out %d, ws %zu < %zu); nothing launched\n", n_in, n_in > 0 ? in_sizes[0] : -1, out_size, ws_size, (size_t)WS_END);
            grid = -1; return; }
        int dev = 0, cus = 0, per_cu = 0;
        if (hipGetDevice(&dev) != hipSuccess || hipDeviceGetAttribute(&cus, hipDeviceAttributeMultiprocessorCount, dev) != hipSuccess) { grid = -1; return; }
        if (hipFuncSetAttribute((const void*)mk_fwd, hipFuncAttributeMaxDynamicSharedMemorySize, LDS_BYTES) != hipSuccess) { fprintf(stderr, "kernel_launch: hipFuncSetAttribute failed\n"); grid = -1; return; }
        if (hipOccupancyMaxActiveBlocksPerMultiprocessor(&per_cu, (const void*)mk_fwd, NWAVES * 64, LDS_BYTES) != hipSuccess || per_cu < 1)
            fprintf(stderr, "kernel_launch: note: occupancy query reports %d workgroups per CU\n", per_cu);
        (void)hipGetLastError();
        grid = cus;
    }
    if (grid < 0) return;
    if (hipMemsetAsync((char*)d_ws + WS_CTL, 0, CTL_ZERO_BYTES, stream) != hipSuccess) return;
    Args a{};
    for (int i = 0; i < 20; ++i) a.in[i] = d_in[i];
    a.out = (float*)d_out; a.ws = (unsigned char*)d_ws; a.pad = 0;
#if MK_MULTI
    for (int p = 0; p < NPHASES; ++p) {
        a.ph_lo = p; a.ph_hi = p + 1; a.use_bar = 0;
        hipLaunchKernelGGL(mk_fwd, dim3(grid), dim3(NWAVES * 64), LDS_BYTES, stream, a);
    }
#else
    a.ph_lo = 0; a.ph_hi = NPHASES; a.use_bar = 1;
    hipLaunchKernelGGL(mk_fwd, dim3(grid), dim3(NWAVES * 64), LDS_BYTES, stream, a);
#endif
}
```

```cpp
#include <hip/hip_runtime.h>
#include <cstdio>
#include <cstdint>

#ifndef PROBE_MASK
#define PROBE_MASK 0
#endif
#ifndef SKIPM
#define SKIPM 0
#endif
#ifndef MK_MULTI
#define MK_MULTI 0
#endif

__device__ __forceinline__ int lane_id() { int l; asm volatile("v_mbcnt_lo_u32_b32 %0, -1, 0\n\tv_mbcnt_hi_u32_b32 %0, -1, %0" : "=v"(l)); return l; }
namespace pg8 {
#define PG8_LAS __attribute__((address_space(3)))
#define PG8_GAS __attribute__((address_space(1)))
typedef unsigned short bf16_t;
typedef short bf16x8 __attribute__((ext_vector_type(8)));
typedef float f32x4 __attribute__((ext_vector_type(4)));
typedef float f32x2 __attribute__((ext_vector_type(2)));
typedef unsigned u32x4 __attribute__((ext_vector_type(4)));
typedef int v4i_t __attribute__((ext_vector_type(4)));
typedef int v8i_t __attribute__((ext_vector_type(8)));
constexpr int BM = 256, BK = 64, HALF = 128, HTB = HALF * BK * 2, STAGE_BYTES = 8 * HTB, NXCD = 8, WGM = 8;

__host__ __device__ __forceinline__ int lds_byte(int r, int c) { const int st = (r >> 4) * 2 + (c >> 5), rr = r & 15, cc = c & 31, ob = rr * 64 + cc * 2; return st * 1024 + (ob ^ (((ob >> 9) & 1) << 5)); }
__host__ __device__ __forceinline__ void stage_rc(int b, int& R, int& C) { const int st = b / 1024, sb = b % 1024, swz = sb ^ (((sb >> 9) & 1) << 5); R = (st >> 1) * 16 + swz / 64; C = (st & 1) * 32 + (swz % 64) / 2; }
__host__ __device__ __forceinline__ int perm32(int rho) { const int n = rho >> 4, i = rho & 15; return 8 * (i >> 2) + 4 * n + (i & 3); }

struct Unit { int pm, pn; };
struct Gemm { const bf16_t* A; const bf16_t* Bt; int M, N, K; };

struct StaticOrder {
    int nM, nN, nwg, G, c;
    __host__ __device__ void init(int M, int N, int G_, int c_) { nM = M / BM; nN = N / BM; nwg = nM * nN; G = G_; c = c_; }
    __host__ __device__ bool next(int i, Unit& u) const {
        const long L = (long)i * G + c; if (L >= nwg) return false;
        int wgid = (int)L; { const int q = nwg / NXCD, r = nwg % NXCD, xcd = wgid % NXCD, off = wgid / NXCD; wgid = (xcd < r ? xcd * (q + 1) : r * (q + 1) + (xcd - r) * q) + off; }
        const int nig = WGM * nN, gid = wgid / nig, fm = gid * WGM, gsz = (nM - fm) < WGM ? (nM - fm) : WGM;
        u.pm = fm + ((wgid % nig) % gsz); u.pn = (wgid % nig) / gsz; return true;
    }
    __device__ __forceinline__ void a_ready(const Unit&) const {}
    __device__ __forceinline__ void done(const Unit&) const {}
};

__device__ __forceinline__ unsigned cvt_pk_bf16(float lo, float hi) { unsigned r; asm volatile("v_cvt_pk_bf16_f32 %0, %1, %2" : "=v"(r) : "v"(lo), "v"(hi)); return r; }

template <int ACT  > struct EpiStore {
    static constexpr int PERM = 2; static constexpr bool AFTER_DRAIN = false;
    bf16_t* O; int ldc; const float* rs;
    struct Pre { float sc[2][4]; };
    __device__ __forceinline__ Pre prefetch(const Unit& u, int wr, int fr) const { Pre p; const int row0 = u.pm * BM + wr * 64 + fr;
#pragma unroll
        for (int ai = 0; ai < 2; ++ai)
#pragma unroll
            for (int m = 0; m < 4; ++m) p.sc[ai][m] = (rs ? ((PG8_GAS const float*)rs)[row0 + ai * HALF + m * 16] : 1.f);
        return p; }
    __device__ __forceinline__ void operator()(const f32x4 (&acc)[2][2][4][2], const Unit& u, int wr, int wc, int fr, int fq, const Pre& pre) const {
        const int row0 = u.pm * BM + wr * 64 + fr;
        const int col0 = u.pn * BM + wc * 64 + 16 * fq;
        const float (&sc)[2][4] = pre.sc;
#pragma unroll
        for (int ai = 0; ai < 2; ++ai)
#pragma unroll
            for (int m = 0; m < 4; ++m) { const int row = row0 + ai * HALF + m * 16; bf16_t* rowp = O + (size_t)row * ldc + col0;
#pragma unroll
                for (int bj = 0; bj < 2; ++bj) { f32x4 v0 = acc[ai][bj][m][0] * sc[ai][m], v1 = acc[ai][bj][m][1] * sc[ai][m];
                    if (ACT == 2) {
#pragma unroll
                        for (int e = 0; e < 4; ++e) { const float a = fmaxf(v0[e], 0.f), b = fmaxf(v1[e], 0.f); v0[e] = a * a; v1[e] = b * b; } }
                    u32x4 w; w.x = cvt_pk_bf16(v0[0], v0[1]); w.y = cvt_pk_bf16(v0[2], v0[3]); w.z = cvt_pk_bf16(v1[0], v1[1]); w.w = cvt_pk_bf16(v1[2], v1[3]);
                    *(PG8_GAS u32x4*)(rowp + bj * 8) = w; } }
    }
};

constexpr float XSC = 16.f, WUSC = 32.f;
constexpr float MSC = 16.f, WOSC = 32.f;
constexpr float HSC = 4.f, WDSC = 64.f;
__device__ __forceinline__ unsigned pk4_fp8(float a, float b, float c, float d) { int p = 0; p = __builtin_amdgcn_cvt_pk_fp8_f32(a, b, p, false); p = __builtin_amdgcn_cvt_pk_fp8_f32(c, d, p, true); return (unsigned)p; }
template <bool HAS_RS> struct EpiRelu2Fp8T {
    static constexpr int PERM = 2; static constexpr bool AFTER_DRAIN = false;
    unsigned char* O; int ldc; const float* rs;
    struct Pre { float sc[2][4]; };
    __device__ __forceinline__ Pre prefetch(const Unit& u, int wr, int fr) const { Pre p; const int row0 = u.pm * BM + wr * 64 + fr;
#pragma unroll
        for (int ai = 0; ai < 2; ++ai)
#pragma unroll
            for (int m = 0; m < 4; ++m) p.sc[ai][m] = HAS_RS ? ((PG8_GAS const float*)rs)[row0 + ai * HALF + m * 16] : (1.f / (XSC * WUSC));
        return p; }
    __device__ __forceinline__ void operator()(const f32x4 (&acc)[2][2][4][2], const Unit& u, int wr, int wc, int fr, int fq, const Pre& pre) const {
        const int row0 = u.pm * BM + wr * 64 + fr;
        const int col0 = u.pn * BM + wc * 64 + 16 * fq;
        float sc[2][4];
#pragma unroll
        for (int ai = 0; ai < 2; ++ai)
#pragma unroll
            for (int m = 0; m < 4; ++m) sc[ai][m] = pre.sc[ai][m] * (2.f / 21.16f);
        const f32x2 c2 = {21.16f * 21.16f, 21.16f * 21.16f};
#pragma unroll
        for (int ai = 0; ai < 2; ++ai)
#pragma unroll
            for (int m = 0; m < 4; ++m) { const int row = row0 + ai * HALF + m * 16; unsigned w[4];
#pragma unroll
                for (int bj = 0; bj < 2; ++bj)
#pragma unroll
                    for (int n = 0; n < 2; ++n) { const f32x4 a = acc[ai][bj][m][n];
                        const f32x2 lo = {a[0], a[1]}, hi = {a[2], a[3]}, s2 = {sc[ai][m], sc[ai][m]}; f32x2 ul, uh, tl, th;
                        asm volatile("v_pk_mul_f32 %0, %1, %2 clamp" : "=v"(ul) : "v"(lo), "v"(s2)); asm volatile("v_pk_mul_f32 %0, %1, %2 clamp" : "=v"(uh) : "v"(hi), "v"(s2));
                        asm volatile("v_pk_mul_f32 %0, %1, %2" : "=v"(tl) : "v"(ul), "v"(c2)); asm volatile("v_pk_mul_f32 %0, %1, %2" : "=v"(th) : "v"(uh), "v"(c2));
                        asm volatile("v_pk_mul_f32 %0, %1, %2" : "=v"(tl) : "v"(tl), "v"(ul)); asm volatile("v_pk_mul_f32 %0, %1, %2" : "=v"(th) : "v"(th), "v"(uh));
                        int pw; asm volatile("" : "=v"(pw));
                        pw = __builtin_amdgcn_cvt_pk_fp8_f32(tl[0], tl[1], pw, false); pw = __builtin_amdgcn_cvt_pk_fp8_f32(th[0], th[1], pw, true);
                        w[bj * 2 + n] = (unsigned)pw; }
                *(PG8_GAS u32x4*)(O + (size_t)row * ldc + col0) = (u32x4){w[0], w[1], w[2], w[3]}; }
    }
};

template <class Epi, class Sched, bool ALIGN_EPI = false, bool SP2 = false, bool FP8 = false>
__device__ __forceinline__ void gemm_phase(PG8_LAS unsigned char* lds, const Gemm g, const Sched& S, const Epi& E, int wave_) {
    int tid_ = wave_ * 64 + lane_id(); asm volatile("" : "+v"(tid_));
    const int tid = tid_, wid = __builtin_amdgcn_readfirstlane(tid >> 6), lane = tid & 63, wr = wid >> 2, wc = wid & 3, fr = lane & 15, fq = lane >> 4;
    const int K = g.K, nt = K / BK;
    unsigned voffA[2], voffB[2];
#pragma unroll
    for (int i = 0; i < 2; ++i) { int R, C; stage_rc(tid * 16 + i * 8192, R, C);
        const int Rb = (Epi::PERM == 2) ? (64 * (R >> 5) + 16 * ((R & 15) >> 2) + 4 * ((R >> 4) & 1) + (R & 3)) : (Epi::PERM == 1) ? ((R & ~31) + perm32(R & 31)) : R;
        voffA[i] = (unsigned)(R * K + C) * 2u; voffB[i] = (unsigned)(Rb * K + C) * 2u; }
    const size_t kstep = (size_t)(BK * 2);
    const size_t hstep = (size_t)HALF * K * 2;
    const size_t hstepB = (Epi::PERM == 2) ? (size_t)8 * K * 2 : hstep;
    const size_t tstep = 2 * hstep;
    const unsigned ldsw = (unsigned)wid * 1024u;
    const int aoff = lds_byte(wr * 64 + fr, fq * 8); int boff = lds_byte(wc * 32 + fr, fq * 8) + 4 * HTB; asm volatile("" : "+v"(boff));
#define PG8_SA(b, h) (((b) * 2 + (h)) * HTB)
#define PG8_SB(b, h) ((4 + (b) * 2 + (h)) * HTB)
#define PG8_STAGE(bufoff, gbase, voff) do { _Pragma("unroll") for (int _i = 0; _i < 2; ++_i) \
        __builtin_amdgcn_global_load_lds((const unsigned*)((const char*)(gbase) + (voff)[_i]), (PG8_LAS unsigned*)(lds + (bufoff) + ldsw + _i * 8192), 16, 0, 0); } while (0)
#define PG8_SBR(b, h) (((b) * 2 + (h)) * HTB)
#define PG8_LD8(off_) __builtin_shufflevector(*(const PG8_LAS v4i_t*)(lds + (off_)), *(const PG8_LAS v4i_t*)(lds + (off_) + 1024), 0, 1, 2, 3, 4, 5, 6, 7)
#define PG8_LDA(dst, b, h) do { _Pragma("unroll") for (int m = 0; m < 4; ++m) { if constexpr (FP8) dst##8[m] = PG8_LD8(PG8_SA(b, h) + aoff + m * 2048); \
        else { _Pragma("unroll") for (int k = 0; k < 2; ++k) dst[m][k] = *(const PG8_LAS bf16x8*)(lds + PG8_SA(b, h) + aoff + m * 2048 + k * 1024); } } } while (0)
#define PG8_LDB(dst, b, h) do { _Pragma("unroll") for (int n = 0; n < 2; ++n) { if constexpr (FP8) dst##8[n] = PG8_LD8(PG8_SBR(b, h) + boff + n * 2048); \
        else { _Pragma("unroll") for (int k = 0; k < 2; ++k) dst[n][k] = *(const PG8_LAS bf16x8*)(lds + PG8_SBR(b, h) + boff + n * 2048 + k * 1024); } } } while (0)
#define PG8_MMA(ai, bj, At, Bt) do { __builtin_amdgcn_s_setprio(1); _Pragma("unroll") for (int m = 0; m < 4; ++m) _Pragma("unroll") for (int n = 0; n < 2; ++n) { \
        if constexpr (FP8) asm volatile("v_mfma_f32_16x16x128_f8f6f4 %0, %1, %2, %0" : "+v"(acc[ai][bj][m][n]) : "v"(Bt##8[n]), "v"(At##8[m]));   \
        else { _Pragma("unroll") for (int k = 0; k < 2; ++k) acc[ai][bj][m][n] = __builtin_amdgcn_mfma_f32_16x16x32_bf16(Bt[n][k], At[m][k], acc[ai][bj][m][n], 0, 0, 0); } } \
        __builtin_amdgcn_s_setprio(0); } while (0)
#define PG8_MMAZ(ai, bj, At, Bt) do { __builtin_amdgcn_s_setprio(1); _Pragma("unroll") for (int m = 0; m < 4; ++m) _Pragma("unroll") for (int n = 0; n < 2; ++n) \
        asm volatile("v_mfma_f32_16x16x128_f8f6f4 %0, %1, %2, 0" : "=&v"(acc[ai][bj][m][n]) : "v"(Bt##8[n]), "v"(At##8[m]));   \
        __builtin_amdgcn_s_setprio(0); } while (0)
#define PG8_ZERO(q) do { f32x2 z0_, z1_; asm volatile("v_mov_b64 %0, 0" : "=v"(z0_)); asm volatile("v_mov_b64 %0, 0" : "=v"(z1_)); q = __builtin_shufflevector(z0_, z1_, 0, 1, 2, 3); } while (0)
#define PG8_WAIT_V(n) asm volatile("s_waitcnt vmcnt(" #n ")" ::: "memory")
#define PG8_WAIT_L(n) asm volatile("s_waitcnt lgkmcnt(" #n ")" ::: "memory")
#define PG8_BAR __builtin_amdgcn_s_barrier()
#define PG8_SCHED __builtin_amdgcn_sched_barrier(0)
    Unit cur, nxt; int ui = 0;
    if (!S.next(0, cur)) return;
    typename Epi::Pre pre = E.prefetch(cur, wr, fr);
    f32x4 acc[2][2][4][2];
#pragma unroll
    for (int a = 0; a < 2; ++a)
#pragma unroll
        for (int b = 0; b < 2; ++b)
#pragma unroll
            for (int m = 0; m < 4; ++m)
#pragma unroll
                for (int n = 0; n < 2; ++n) { if constexpr (!FP8) PG8_ZERO(acc[a][b][m][n]); }
    bf16x8 At[4][2], B0[2][2], B1[2][2];
    v8i_t At8[4], B08[2], B18[2];
    const char* cA = (const char*)g.A + (size_t)cur.pm * tstep; const char* cB = (const char*)g.Bt + (size_t)cur.pn * tstep;
    S.a_ready(cur);
    if constexpr (SP2) {
        PG8_STAGE(PG8_SB(0, 0), cB, voffB); PG8_STAGE(PG8_SB(0, 1), cB + hstepB, voffB); PG8_STAGE(PG8_SA(0, 0), cA, voffA); PG8_STAGE(PG8_SA(0, 1), cA + hstep, voffA);
        if (wr == 1) PG8_BAR;
        PG8_WAIT_V(2); PG8_BAR;
        PG8_STAGE(PG8_SB(1, 0), cB + kstep, voffB); PG8_STAGE(PG8_SA(1, 0), cA + kstep, voffA); PG8_STAGE(PG8_SB(1, 1), cB + hstepB + kstep, voffB);
        PG8_WAIT_V(6); PG8_BAR;
    } else {
        PG8_STAGE(PG8_SB(0, 0), cB, voffB); PG8_STAGE(PG8_SA(0, 0), cA, voffA); PG8_STAGE(PG8_SB(0, 1), cB + hstepB, voffB); PG8_STAGE(PG8_SA(0, 1), cA + hstep, voffA);
        if (wr == 1) PG8_BAR;
        PG8_WAIT_V(4); PG8_BAR;
        PG8_STAGE(PG8_SB(1, 0), cB + kstep, voffB); PG8_STAGE(PG8_SA(1, 0), cA + kstep, voffA); PG8_STAGE(PG8_SB(1, 1), cB + hstepB + kstep, voffB);
        PG8_WAIT_V(6); PG8_BAR;
    }
    for (;;) {
        const bool has_next = S.next(ui + 1, nxt);
        const char* nA = has_next ? (const char*)g.A + (size_t)nxt.pm * tstep : cA; const char* nB = has_next ? (const char*)g.Bt + (size_t)nxt.pn * tstep : cB;
        for (int t = 0; t < nt; t += 2) {
            const bool last = (t == nt - 2);
            const char* a1 = cA + (size_t)(t + 1) * kstep;
            const char* a2 = last ? nA : cA + (size_t)(t + 2) * kstep; const char* b2 = last ? nB : cB + (size_t)(t + 2) * kstep;
            const char* a3 = a2 + kstep; const char* b3 = b2 + kstep;
            if (last && has_next) S.a_ready(nxt);
            if constexpr (SP2) {
            PG8_LDB(B0, 0, 0); PG8_LDB(B1, 0, 1); PG8_SCHED; PG8_LDA(At, 0, 0); PG8_STAGE(PG8_SA(1, 1), a1 + hstep, voffA);
            PG8_WAIT_V(8); PG8_WAIT_L(0); PG8_BAR;
            if constexpr (FP8) { if (t == 0) { PG8_MMAZ(0, 0, At, B0); PG8_MMAZ(0, 1, At, B1); } else { PG8_MMA(0, 0, At, B0); PG8_MMA(0, 1, At, B1); } } else { PG8_MMA(0, 0, At, B0); PG8_MMA(0, 1, At, B1); }
            PG8_BAR; PG8_SCHED;
            PG8_LDA(At, 0, 1); PG8_STAGE(PG8_SB(0, 0), b2, voffB); PG8_STAGE(PG8_SB(0, 1), b2 + hstepB, voffB); PG8_STAGE(PG8_SA(0, 0), a2, voffA);
            PG8_WAIT_V(8); PG8_WAIT_L(0); PG8_BAR;
            if constexpr (FP8) { if (t == 0) { PG8_MMAZ(1, 0, At, B0); PG8_MMAZ(1, 1, At, B1); } else { PG8_MMA(1, 0, At, B0); PG8_MMA(1, 1, At, B1); } } else { PG8_MMA(1, 0, At, B0); PG8_MMA(1, 1, At, B1); }
            PG8_BAR; PG8_SCHED;
            PG8_LDB(B0, 1, 0); PG8_LDB(B1, 1, 1); PG8_SCHED; PG8_LDA(At, 1, 0); PG8_STAGE(PG8_SA(0, 1), a2 + hstep, voffA);
            PG8_WAIT_V(8); PG8_WAIT_L(0); PG8_BAR; PG8_MMA(0, 0, At, B0); PG8_MMA(0, 1, At, B1); PG8_BAR; PG8_SCHED;
            PG8_LDA(At, 1, 1); PG8_STAGE(PG8_SB(1, 0), b3, voffB); PG8_STAGE(PG8_SB(1, 1), b3 + hstepB, voffB); PG8_STAGE(PG8_SA(1, 0), a3, voffA);
            PG8_WAIT_V(8); PG8_WAIT_L(0); PG8_BAR; PG8_MMA(1, 0, At, B0); PG8_MMA(1, 1, At, B1); PG8_BAR; PG8_SCHED;
            } else {
            PG8_LDB(B0, 0, 0); PG8_SCHED; PG8_LDA(At, 0, 0); PG8_STAGE(PG8_SA(1, 1), a1 + hstep, voffA);
            PG8_WAIT_L(8); PG8_BAR; PG8_WAIT_L(0); PG8_MMA(0, 0, At, B0); PG8_BAR; PG8_SCHED;
            PG8_LDB(B1, 0, 1); PG8_STAGE(PG8_SB(0, 0), b2, voffB);
            PG8_BAR; PG8_WAIT_L(0); PG8_MMA(0, 1, At, B1); PG8_BAR;
            PG8_LDA(At, 0, 1); PG8_STAGE(PG8_SA(0, 0), a2, voffA);
            PG8_BAR; PG8_WAIT_L(0); PG8_MMA(1, 0, At, B0); PG8_BAR; PG8_SCHED;
            PG8_STAGE(PG8_SB(0, 1), b2 + hstepB, voffB);
            PG8_WAIT_V(6); PG8_BAR; PG8_MMA(1, 1, At, B1); PG8_BAR;
            PG8_LDB(B0, 1, 0); PG8_SCHED; PG8_LDA(At, 1, 0); PG8_STAGE(PG8_SA(0, 1), a2 + hstep, voffA);
            PG8_WAIT_L(8); PG8_BAR; PG8_WAIT_L(0); PG8_MMA(0, 0, At, B0); PG8_BAR; PG8_SCHED;
            PG8_LDB(B1, 1, 1); PG8_STAGE(PG8_SB(1, 0), b3, voffB);
            PG8_BAR; PG8_WAIT_L(0); PG8_MMA(0, 1, At, B1); PG8_BAR;
            PG8_LDA(At, 1, 1); PG8_STAGE(PG8_SA(1, 0), a3, voffA);
            PG8_BAR; PG8_WAIT_L(0); PG8_MMA(1, 0, At, B0); PG8_BAR; PG8_SCHED;
            PG8_STAGE(PG8_SB(1, 1), b3 + hstepB, voffB);
            PG8_WAIT_V(6); PG8_BAR; PG8_MMA(1, 1, At, B1); PG8_BAR;
            }
        }
        if constexpr (FP8) asm volatile("s_nop 15\n\ts_nop 7" ::: "memory");
        if constexpr (ALIGN_EPI) { if (wr == 0) PG8_BAR; }
        if constexpr (!Epi::AFTER_DRAIN) { E(acc, cur, wr, wc, fr, fq, pre); S.done(cur); }
        if (!has_next) break;
#pragma unroll
        for (int a = 0; a < 2; ++a)
#pragma unroll
            for (int b = 0; b < 2; ++b)
#pragma unroll
                for (int m = 0; m < 4; ++m)
#pragma unroll
                    for (int n = 0; n < 2; ++n) { if constexpr (!FP8) PG8_ZERO(acc[a][b][m][n]); }
        cur = nxt; cA = nA; cB = nB; ++ui;
        pre = E.prefetch(cur, wr, fr);
        if constexpr (ALIGN_EPI) { if (wr == 1) PG8_BAR; }
    }
    PG8_WAIT_V(0);
    if constexpr (!ALIGN_EPI) { if (wr == 0) PG8_BAR; }
    PG8_BAR;
#undef PG8_SA
#undef PG8_SB
#undef PG8_STAGE
#undef PG8_LDA
#undef PG8_LD8
#undef PG8_SBR
#undef PG8_LDB
#undef PG8_MMA
#undef PG8_ZERO
#undef PG8_MMAZ
#undef PG8_WAIT_V
#undef PG8_WAIT_L
#undef PG8_BAR
#undef PG8_SCHED
}
}

constexpr int NWAVES = 8;
constexpr int BATCH = 32, S = 2048, D = 1024, DEPTH = 4, FF = 4096;
constexpr int M = BATCH * S;
constexpr int NP = 2304;
constexpr int DIN = 2108;
constexpr int C_QA = 0, C_CKV = 256, C_QIDX = 384, C_QB = 512, C_KCMP = 1024, C_VCMP = 1152, C_KSLC = 1280, C_VSLC = 1408, C_KWIN = 1536, C_VWIN = 1664,
              C_UC = 1792, C_KIDX = 2048, C_WIDX = 2080, C_GATE = 2084, C_KA = 2112, C_VA = 2176;
constexpr int NC = 127;
constexpr float EPS = 1e-6f;
constexpr float NEGF = -1e30f;

__host__ __device__ __forceinline__ int win_src(int n) {
    if (n < 512) return n;
    if (n < 1024) return 548 + (n - 512);
    if (n < 1792) return 1060 + (n - 1024);
    if (n < 2048) return 1852 + (n - 1792);
    if (n < 2080) return 512 + (n - 2048);
    if (n < 2084) return 544 + (n - 2080);
    if (n < 2108) return 1828 + (n - 2084);
    return -1;
}

constexpr size_t MiB = 1u << 20;
constexpr size_t WS_CTL = 0, CTL_ZERO_BYTES = 32768;
constexpr size_t WS_W = 2 * MiB;
constexpr size_t W_IN_B = (size_t)NP * D * 2, W_OUT_B = (size_t)D * D * 2, W_UP_B = (size_t)FF * D * 2, W_DN_B = (size_t)D * FF * 2;
constexpr size_t W_LAYER_B = W_IN_B + W_OUT_B + W_UP_B + W_DN_B;
constexpr size_t WS_ROPE = 96 * MiB;
constexpr size_t WS_WCT = 102 * MiB;
constexpr size_t WS_CB = 104 * MiB;
constexpr size_t WS_KCB = 124 * MiB, WS_VCB = 125 * MiB;
constexpr size_t WS_KA = 108 * MiB;
constexpr size_t WS_RS = 126 * MiB;
constexpr size_t WS_F = 256 * MiB;
constexpr size_t WS_PROJ = 384 * MiB;
constexpr size_t WS_MIX = 672 * MiB;
constexpr size_t WS_MASK = 800 * MiB;
constexpr size_t WS_HID = 384 * MiB;
constexpr size_t WS_X8 = 128 * MiB;
constexpr size_t WS_MIX8 = 816 * MiB;
constexpr size_t WS_XB = 896 * MiB;
constexpr size_t WS_END = 1024 * MiB;
static_assert(WS_W + DEPTH * W_LAYER_B <= WS_ROPE, "weights");
static_assert(WS_ROPE + (size_t)M * 24 * 4 <= WS_WCT && WS_WCT + (size_t)DEPTH * 2 * 128 * 1024 * 2 <= WS_CB, "map");
static_assert(WS_PROJ + (size_t)M * NP * 2 <= WS_MIX && WS_MIX + (size_t)M * D * 2 <= WS_END && WS_HID + (size_t)M * FF * 2 <= WS_END, "map2");

constexpr int CW_BAR = 4096;
constexpr int RING_BYTES = 131072;
constexpr int LDSCTL_OFF = RING_BYTES, MISC_OFF = LDSCTL_OFF + 320;
constexpr int LDS_BYTES = 147456;
constexpr int WSCR = 16384;

#define GAS __attribute__((address_space(1)))
#define LAS __attribute__((address_space(3)))
typedef unsigned short bf16;
typedef unsigned v4u __attribute__((ext_vector_type(4)));
typedef float f32x4 __attribute__((ext_vector_type(4)));
typedef GAS unsigned gu32;
#define LDS_FENCE() asm volatile("s_waitcnt lgkmcnt(0)" ::: "memory")
__device__ __forceinline__ unsigned f2bf(float f) { unsigned u = __builtin_bit_cast(unsigned, f); return (u + 0x7fffu + ((u >> 16) & 1u)) >> 16; }
__device__ __forceinline__ unsigned pk2(float lo, float hi) { return f2bf(lo) | (f2bf(hi) << 16); }
__device__ __forceinline__ float bf2f(bf16 u) { return __builtin_bit_cast(float, (unsigned)u << 16); }
__device__ __forceinline__ float bflo(unsigned u) { return __builtin_bit_cast(float, u << 16); }
__device__ __forceinline__ float bfhi(unsigned u) { return __builtin_bit_cast(float, u & 0xffff0000u); }

#define XB_TMO      128
#define XB_XCNT(j)  (256  + 64 * (j))
#define XB_XSUB(j)  (1280 + 64 * (j))
#define XB_XGEN(j)  (2304 + 64 * (j))
#define XB_TOP      3328
#define XB_TOPGEN   3392
#define XCD_BAR_WORDS 3456
#define XB_SPIN_CAP (1u << 22)

__device__ __forceinline__ unsigned xb_ld(unsigned* p)              { return __hip_atomic_load(p, __ATOMIC_RELAXED, __HIP_MEMORY_SCOPE_AGENT); }
__device__ __forceinline__ unsigned xb_add(unsigned* p, unsigned v) { return __hip_atomic_fetch_add(p, v, __ATOMIC_RELAXED, __HIP_MEMORY_SCOPE_AGENT); }
__device__ __forceinline__ unsigned xb_xcc_id() { return (unsigned)__builtin_amdgcn_s_getreg((3 << 11) | 20) & 0xFu; }
#define XB_SPIN(cond, bar) do { unsigned _sp = 0; while (cond) { __builtin_amdgcn_s_sleep(1); \
    if ((++_sp & 255u) == 0u) { if (xb_ld(&(bar)[XB_TMO])) break; if (_sp > XB_SPIN_CAP) { atomicAdd(&(bar)[XB_TMO], 1u); break; } } } } while (0)

struct XcdBarrier { unsigned* bar; unsigned x; volatile LAS unsigned* st; int wv; };

__device__ __forceinline__ XcdBarrier xcd_barrier_post(unsigned* bar, volatile LAS unsigned* st) {
    XcdBarrier b; b.bar = bar; b.x = xb_xcc_id(); b.st = st; b.wv = 0;
    if (threadIdx.x == 0) (void)xb_add(&bar[XB_XCNT(b.x)], 1u);
    return b;
}
__device__ __forceinline__ void xcd_barrier_complete(unsigned* bar, unsigned x, unsigned& nloc, unsigned& nx) {
    const unsigned G = gridDim.x * gridDim.y * gridDim.z;
    unsigned sum, cnt, mine, sp = 0u;
    for (;;) {
        sum = 0u; cnt = 0u; mine = 0u;
#pragma unroll
        for (unsigned j = 0; j < 16; ++j) { const unsigned c = xb_ld(&bar[XB_XCNT(j)]); sum += c; cnt += (c > 0u) ? 1u : 0u; mine = (j == x) ? c : mine; }
        if (sum == G) break;
        __builtin_amdgcn_s_sleep(1);
        if ((++sp & 255u) == 0u) { if (xb_ld(&bar[XB_TMO])) break; if (sp > XB_SPIN_CAP) { atomicAdd(&bar[XB_TMO], 1u); break; } }
    }
    nloc = mine > 0u ? mine : 1u; nx = cnt > 0u ? cnt : 1u;
}
__device__ __forceinline__ void xcd_barrier(const XcdBarrier& b) {
    asm volatile("s_waitcnt vmcnt(0)" ::: "memory");
    __syncthreads();
    if (b.wv == 0 && lane_id() == 0) {
        unsigned* bar = b.bar; asm volatile("" : "+s"(bar));
        __builtin_amdgcn_s_waitcnt(0);
        unsigned nloc = b.st[0], nx = b.st[1];
        unsigned bx_ = b.x; asm volatile("" : "+s"(bx_));
        if (nloc == 0u) { xcd_barrier_complete(bar, bx_, nloc, nx); b.st[0] = nloc; b.st[1] = nx; }
        const unsigned old = xb_add(&bar[XB_XSUB(bx_)], 1u);
        const unsigned gen = old / nloc;
        if (old + 1u == (gen + 1u) * nloc) {
            __builtin_amdgcn_fence(__ATOMIC_RELEASE, "agent");
            asm volatile("s_waitcnt vmcnt(0)" ::: "memory");
            const unsigned og = xb_add(&bar[XB_TOP], 1u);
            const unsigned tg = og / nx;
            if (og + 1u == (tg + 1u) * nx) xb_add(&bar[XB_TOPGEN], 1u);
            else XB_SPIN(xb_ld(&bar[XB_TOPGEN]) == tg, bar);
            __builtin_amdgcn_fence(__ATOMIC_ACQUIRE, "agent");
            xb_add(&bar[XB_XGEN(bx_)], 1u);
            asm volatile("s_waitcnt vmcnt(0)" ::: "memory");
        } else {
            XB_SPIN(xb_ld(&bar[XB_XGEN(bx_)]) == gen, bar);
            __builtin_amdgcn_fence(__ATOMIC_ACQUIRE, "agent");
            asm volatile("s_waitcnt vmcnt(0)" ::: "memory");
        }
    }
    __syncthreads();
}

struct Frame {
    LAS unsigned char* lds;
    volatile LAS unsigned* MISC;
    gu32* ctl;
    int wave, vcu, G;
    float* out; unsigned char* ws;
};
struct Args { const void* in[20]; float* out; unsigned char* ws; int ph_lo, ph_hi, use_bar, pad; };
#define IN_F(k) ((const float*)args.in[k])
#define P_X_IN IN_F(0)
#define P_POS ((const int*)args.in[1])
#define P_W_IN IN_F(2)
#define P_G_KV_A IN_F(3)
#define P_W_KV_UP IN_F(4)
#define P_W_CMP_K IN_F(5)
#define P_W_CMP_V IN_F(6)
#define P_PE_K IN_F(7)
#define P_PE_V IN_F(8)
#define P_W_POOL IN_F(9)
#define P_POOL_SCALE IN_F(10)
#define P_G_OUT_A IN_F(11)
#define P_G_OUT_B IN_F(12)
#define P_W_OUT IN_F(13)
#define P_G_PRE_MIX IN_F(14)
#define P_G_POST_MIX IN_F(15)
#define P_G_PRE_MLP IN_F(16)
#define P_G_POST_MLP IN_F(17)
#define P_W_UP IN_F(18)
#define P_W_DOWN IN_F(19)
#define B_ROPE ((float*)(ws_ + WS_ROPE))
#define B_F ((bf16*)(ws_ + WS_F))
#define B_PROJ ((bf16*)(ws_ + WS_PROJ))
#define B_MIX ((bf16*)(ws_ + WS_MIX))
#define B_HID ((bf16*)(ws_ + WS_HID))

template <int CTRL> __device__ __forceinline__ int dpp_i(int v) { return __builtin_amdgcn_update_dpp(0, v, CTRL, 0xF, 0xF, true); }
template <int CTRL> __device__ __forceinline__ float dpp_f(float v) { return __builtin_bit_cast(float, dpp_i<CTRL>(__builtin_bit_cast(int, v))); }
__device__ __forceinline__ int swz16_i(int v) { return __builtin_amdgcn_ds_swizzle(v, (16 << 10) | 0x1F); }
__device__ __forceinline__ float swz16_f(float v) { return __builtin_bit_cast(float, swz16_i(__builtin_bit_cast(int, v))); }
struct HalfPair { unsigned lo, hi; };
__device__ __forceinline__ HalfPair halves_u(unsigned v) { const auto rr = __builtin_amdgcn_permlane32_swap(v, v, false, false); HalfPair h; h.lo = rr[0]; h.hi = rr[1]; return h; }
__device__ __forceinline__ float other_half_f(float v, int hi) { const HalfPair h = halves_u(__builtin_bit_cast(unsigned, v)); return __builtin_bit_cast(float, hi ? h.lo : h.hi); }
__device__ __forceinline__ float sum32(float v) {
    v += dpp_f<0xB1>(v); v += dpp_f<0x4E>(v); v += dpp_f<0x141>(v); v += dpp_f<0x140>(v); v += swz16_f(v); return v; }
__device__ __forceinline__ float wave_sum(float v) { v = sum32(v); const HalfPair h = halves_u(__builtin_bit_cast(unsigned, v)); return __builtin_bit_cast(float, h.lo) + __builtin_bit_cast(float, h.hi); }
__device__ __forceinline__ float max_halves(float v) { const HalfPair h = halves_u(__builtin_bit_cast(unsigned, v)); return fmaxf(__builtin_bit_cast(float, h.lo), __builtin_bit_cast(float, h.hi)); }
__device__ __forceinline__ unsigned or_halves(unsigned v) { const HalfPair h = halves_u(v); return h.lo | h.hi; }
__device__ __forceinline__ unsigned or32(unsigned v) { v |= (unsigned)dpp_i<0xB1>((int)v); v |= (unsigned)dpp_i<0x4E>((int)v); v |= (unsigned)dpp_i<0x141>((int)v); v |= (unsigned)dpp_i<0x140>((int)v); v |= (unsigned)swz16_i((int)v); return v; }

__constant__ double c_rope_inv[12] = {1.0, 0.19392274474868576, 0.03760603093086393, 0.007292664737217109, 0.001414213562373095, 0.0002742481756762073, 5.318295896944988e-05, 1.031338537721246e-05,
                                       1.0, 0.03760603093086393, 0.001414213562373095, 5.318295896944988e-05};
template <int MODE, bool GAIN = false, bool OUT8 = false>
__device__ __forceinline__ void transpose_item(const float* W, int K, int Nsrc, int nblk, bf16* WT, LAS float* scr, int item, int lane, const float* gk = nullptr, float ws = 1.f) {
    const int kb = item / nblk, nb = item % nblk, k0 = 64 * kb, n0 = 32 * nb;
    if (MODE && n0 >= C_KA && n0 < C_KA + 128) return;
    const int np = n0 + 4 * (lane & 7);
    const int src = MODE ? win_src(np) : np;
#pragma unroll
    for (int i = 0; i < 8; ++i) { const int kk = 8 * i + (lane >> 3);
        f32x4 v = (f32x4){0.f, 0.f, 0.f, 0.f};
        if (src >= 0) v = *(const f32x4*)(W + (size_t)(k0 + kk) * Nsrc + src);
        const float gg = GAIN ? gk[k0 + kk] : 1.f;
        LAS float* d = scr + kk * 33 + 4 * (lane & 7);
        d[0] = v.x * gg; d[1] = v.y * gg; d[2] = v.z * gg; d[3] = v.w * gg; }
    LDS_FENCE();
    const int c = lane & 7;
#pragma unroll
    for (int j = 0; j < 4; ++j) { const int n = (lane >> 3) + 8 * j; const LAS float* s = scr + (8 * c) * 33 + n;
        if (OUT8) { unsigned long long o = (unsigned long long)pg8::pk4_fp8(s[0 * 33] * ws, s[1 * 33] * ws, s[2 * 33] * ws, s[3 * 33] * ws) | ((unsigned long long)pg8::pk4_fp8(s[4 * 33] * ws, s[5 * 33] * ws, s[6 * 33] * ws, s[7 * 33] * ws) << 32);
            *(unsigned long long*)((unsigned char*)WT + (size_t)(n0 + n) * K + k0 + 8 * c) = o; }
        else { v4u o; o.x = pk2(s[0 * 33], s[1 * 33]); o.y = pk2(s[2 * 33], s[3 * 33]); o.z = pk2(s[4 * 33], s[5 * 33]); o.w = pk2(s[6 * 33], s[7 * 33]);
            *(v4u*)(WT + (size_t)(n0 + n) * K + k0 + 8 * c) = o; } }
    LDS_FENCE();
}

__device__ __forceinline__ bf16* w_in_t(unsigned char* ws_, int l)  { return (bf16*)(ws_ + WS_W + (size_t)l * W_LAYER_B); }
__device__ __forceinline__ bf16* w_out_t(unsigned char* ws_, int l) { return (bf16*)(ws_ + WS_W + (size_t)l * W_LAYER_B + W_IN_B); }
__device__ __forceinline__ bf16* w_up_t(unsigned char* ws_, int l)  { return (bf16*)(ws_ + WS_W + (size_t)l * W_LAYER_B + W_IN_B + W_OUT_B); }
__device__ __forceinline__ bf16* w_dn_t(unsigned char* ws_, int l)  { return (bf16*)(ws_ + WS_W + (size_t)l * W_LAYER_B + W_IN_B + W_OUT_B + W_UP_B); }

__device__ __forceinline__ void phase_prologue(Frame& F, const Args& args) {
    unsigned char* ws_ = F.ws; asm volatile("" : "+s"(ws_)); int lane_ = lane_id(); asm volatile("" : "+v"(lane_)); (void)ws_;
    LAS float* scr = (LAS float*)(F.lds + F.wave * WSCR);
    const int gw = F.vcu * NWAVES + F.wave, NGW = F.G * NWAVES;
    constexpr int I_IN = (D / 64) * (NP / 32), I_OUT = (D / 64) * (D / 32), I_UP = (D / 64) * (FF / 32), I_DN = (FF / 64) * (D / 32);
    for (int it = gw; it < DEPTH * I_IN; it += NGW) { const int l = it / I_IN, r = it % I_IN; transpose_item<1, true>(P_W_IN + (size_t)l * D * DIN, D, DIN, NP / 32, w_in_t(ws_, l), scr, r, lane_, P_G_PRE_MIX + l * D); }
    for (int it = gw; it < DEPTH * I_OUT; it += NGW) { const int l = it / I_OUT, r = it % I_OUT; transpose_item<0, false, true>(P_W_OUT + (size_t)l * D * D, D, D, D / 32, w_out_t(ws_, l), scr, r, lane_, nullptr, pg8::WOSC); }
    for (int it = gw; it < DEPTH * I_UP; it += NGW) { const int l = it / I_UP, r = it % I_UP; transpose_item<0, true, true>(P_W_UP + (size_t)l * D * FF, D, FF, FF / 32, w_up_t(ws_, l), scr, r, lane_, P_G_PRE_MLP + l * D, pg8::WUSC); }
    for (int it = gw; it < DEPTH * I_DN; it += NGW) { const int l = it / I_DN, r = it % I_DN; transpose_item<0, false, true>(P_W_DOWN + (size_t)l * FF * D, FF, D, D / 32, w_dn_t(ws_, l), scr, r, lane_, nullptr, pg8::WDSC); }
    for (int it = gw; it < DEPTH * D * 2; it += NGW) {
        const int l = it / (D * 2), r = it % (D * 2), k = r >> 1, n = lane_ + 64 * (r & 1);
        const float* wi = P_W_IN + ((size_t)l * D + k) * DIN + 256; const float* gk = P_G_KV_A + l * 128; const float* wu = P_W_KV_UP + (size_t)l * 128 * 128 + n;
        float acc = 0.f;
#pragma unroll 32
        for (int j = 0; j < 128; ++j) acc += (wi[j] * gk[j]) * wu[j * 128];
        w_in_t(ws_, l)[(size_t)(C_KA + n) * D + k] = (bf16)f2bf(acc * P_G_PRE_MIX[l * D + k]);
    }
    for (int it = gw; it < DEPTH * 2 * 2 * 32; it += NGW) {
        const int lk = it >> 6, part = (it >> 5) & 1, r = it & 31, l = lk >> 1, kv = lk & 1;
        const float* W = (kv ? P_W_CMP_V : P_W_CMP_K) + (size_t)l * 32 * 64 * 64 + (size_t)part * 1024 * 64;
        transpose_item<0>(W, 1024, 64, 2, (bf16*)(ws_ + WS_WCT) + ((size_t)lk * 128 + part * 64) * 1024, scr, r, lane_);
    }
    {
        __syncthreads();
        LAS float* part = (LAS float*)F.lds;
        for (int it = F.vcu; it < DEPTH * 2 * 8; it += F.G) {
            const int lk = it >> 3, kc = it & 7, l = lk >> 1, kv = lk & 1;
            const float* W = (kv ? P_W_CMP_V : P_W_CMP_K) + (size_t)l * 32 * 64 * 64 + lane_; const float* pe = (kv ? P_PE_V : P_PE_K) + l * 32 * 64;
            float acc = 0.f;
            const int kb0 = kc * 256 + F.wave * 32;
#pragma unroll
            for (int k = 0; k < 32; ++k) acc += pe[kb0 + k] * W[(size_t)(kb0 + k) * 64];
            part[F.wave * 64 + lane_] = acc;
            __syncthreads();
            if (F.wave == 0) { float t = 0.f;
#pragma unroll
                for (int w8 = 0; w8 < 8; ++w8) t += part[w8 * 64 + lane_];
                ((float*)(ws_ + WS_CB + 4096))[it * 64 + lane_] = t; }
            __syncthreads();
        }
    }
}
__device__ __forceinline__ void phase_prologue_b(Frame& F, const Args& args) {
    unsigned char* ws_ = F.ws; asm volatile("" : "+s"(ws_)); int lane_ = lane_id(); asm volatile("" : "+v"(lane_)); (void)ws_;
    const int gw = F.vcu * NWAVES + F.wave, NGW = F.G * NWAVES;
    if (gw < DEPTH * 2) { float t = 0.f;
#pragma unroll
        for (int kc = 0; kc < 8; ++kc) t += ((const float*)(ws_ + WS_CB + 4096))[(gw * 8 + kc) * 64 + lane_];
        ((float*)(ws_ + WS_CB))[gw * 64 + lane_] = t; }
    for (int e = gw * 64 + lane_; e < M * 12; e += NGW * 64) {
        const int row = e / 12, i = e % 12;
        const double inv = c_rope_inv[i];
        const double a = (double)P_POS[row] * inv;
        const double k = __builtin_rint(a * 0.15915494309189535);
        const float r = (float)(a - k * 6.283185307179586);
        const float c = __builtin_cosf(r), s = __builtin_sinf(r);
        float* t = B_ROPE + (size_t)row * 24;
        if (i < 8) { t[i] = c; t[8 + i] = s; } else { t[16 + (i - 8)] = c; t[20 + (i - 8)] = s; }
    }
    for (int m0 = gw * 4; m0 < M; m0 += NGW * 4) {
        f32x4 v[4][4];
#pragma unroll
        for (int k = 0; k < 4; ++k) { const f32x4* xr = (const f32x4*)(P_X_IN + (size_t)(m0 + k) * D) + lane_;
#pragma unroll
            for (int j = 0; j < 4; ++j) v[k][j] = xr[64 * j]; }
#pragma unroll
        for (int k = 0; k < 4; ++k) { float sq = 0.f;
#pragma unroll
            for (int j = 0; j < 4; ++j) sq += (v[k][j].x * v[k][j].x + v[k][j].y * v[k][j].y) + (v[k][j].z * v[k][j].z + v[k][j].w * v[k][j].w);
            const float rsv = rsqrtf(wave_sum(sq) * (1.f / D) + EPS);
            unsigned long long* o8 = (unsigned long long*)((bf16*)(ws_ + WS_XB) + (size_t)(m0 + k) * D) + lane_;
#pragma unroll
            for (int j = 0; j < 4; ++j) o8[64 * j] = (unsigned long long)pk2(v[k][j].x, v[k][j].y) | ((unsigned long long)pk2(v[k][j].z, v[k][j].w) << 32);
            if (lane_ == 0) ((float*)(ws_ + WS_RS))[m0 + k] = rsv; }
    }
}

typedef short bf16x8 __attribute__((ext_vector_type(8)));
typedef short s16x4 __attribute__((ext_vector_type(4)));
typedef float f32x16 __attribute__((ext_vector_type(16)));
#define MFMA32(a, b, c) __builtin_amdgcn_mfma_f32_32x32x16_bf16((a), (b), (c), 0, 0, 0)
__device__ __forceinline__ int crow(int r, int hi) { return (r & 3) + 8 * (r >> 2) + 4 * hi; }
__device__ __forceinline__ void wg_barrier() { asm volatile("s_waitcnt lgkmcnt(0)\n\ts_barrier" ::: "memory"); }

__device__ __forceinline__ void phase_prep(Frame& F, const Args& args, int l) {
    unsigned char* ws_ = F.ws; asm volatile("" : "+s"(ws_)); int lane_ = lane_id(); asm volatile("" : "+v"(lane_)); (void)ws_; (void)args;
    int tid_ = F.wave * 64 + lane_id(); asm volatile("" : "+v"(tid_));
    const int gw = F.vcu * NWAVES + F.wave, NGW = F.G * NWAVES, lane = lane_;
    {
        const int sub = lane >> 4, q = lane & 15;
        const bool r_idx = (q == 2), r_kv = (q >= 4 && q < 8), r_ka = (q < 2);
        const int which = q - 4;
        const int cbase = r_idx ? C_KIDX : (((which < 2) ? C_KSLC : C_KWIN) + (which & 1) * 64);
        constexpr int RB = 4;
        for (int row0 = gw * (4 * RB); row0 < M; row0 += NGW * (4 * RB)) {
            v4u cu[RB], ku[RB], e1[RB], e2[RB]; f32x4 t0[RB], t1[RB], t2[RB], t3[RB];
#pragma unroll
            for (int k = 0; k < RB; ++k) { const size_t row = (size_t)(row0 + 4 * k + sub); bf16* prow = B_PROJ + row * NP; const f32x4* tab = (const f32x4*)(B_ROPE + row * 24);
                cu[k] = *(const v4u*)(prow + C_CKV + 8 * q); ku[k] = *(const v4u*)(prow + C_KA + 8 * q);
                e1[k] = (v4u){0u, 0u, 0u, 0u}; e2[k] = e1[k]; t0[k] = (f32x4){0.f, 0.f, 0.f, 0.f}; t1[k] = t0[k]; t2[k] = t0[k]; t3[k] = t0[k];
                if (r_ka || r_kv) { t0[k] = tab[0]; t1[k] = tab[1]; t2[k] = tab[2]; t3[k] = tab[3]; }
                if (r_idx) { t0[k] = tab[4]; t2[k] = tab[5]; }
                if (r_idx || r_kv) e1[k] = *(const v4u*)(prow + cbase);
                if (r_kv) e2[k] = *(const v4u*)(prow + cbase + 8); }
#pragma unroll
            for (int k = 0; k < RB; ++k) { const size_t row = (size_t)(row0 + 4 * k + sub); bf16* prow = B_PROJ + row * NP;
                float x[8] = {bflo(cu[k].x), bfhi(cu[k].x), bflo(cu[k].y), bfhi(cu[k].y), bflo(cu[k].z), bfhi(cu[k].z), bflo(cu[k].w), bfhi(cu[k].w)};
                float ss = 0.f;
#pragma unroll
                for (int e = 0; e < 8; ++e) ss += x[e] * x[e];
                ss += dpp_f<0xB1>(ss); ss += dpp_f<0x4E>(ss); ss += dpp_f<0x141>(ss); ss += dpp_f<0x140>(ss);
                const float rs = rsqrtf(ss * (1.f / 128.f) + EPS);
                float y[8] = {bflo(ku[k].x) * rs, bfhi(ku[k].x) * rs, bflo(ku[k].y) * rs, bfhi(ku[k].y) * rs, bflo(ku[k].z) * rs, bfhi(ku[k].z) * rs, bflo(ku[k].w) * rs, bfhi(ku[k].w) * rs};
                const float cs[8] = {t0[k].x, t0[k].y, t0[k].z, t0[k].w, t1[k].x, t1[k].y, t1[k].z, t1[k].w};
                const float sn[8] = {t2[k].x, t2[k].y, t2[k].z, t2[k].w, t3[k].x, t3[k].y, t3[k].z, t3[k].w};
#pragma unroll
                for (int e = 0; e < 8; ++e) { const float pr = dpp_f<0xB1>(y[e]);
                    const float r0 = y[e] * cs[e] - pr * sn[e], r1 = pr * sn[e] + y[e] * cs[e];
                    y[e] = r_ka ? ((q == 0) ? r0 : r1) : y[e]; }
                *(v4u*)(prow + C_KA + 8 * q) = (v4u){pk2(y[0], y[1]), pk2(y[2], y[3]), pk2(y[4], y[5]), pk2(y[6], y[7])};
                if (r_idx) {
                    float z[8] = {bflo(e1[k].x), bfhi(e1[k].x), bflo(e1[k].y), bfhi(e1[k].y), bflo(e1[k].z), bfhi(e1[k].z), bflo(e1[k].w), bfhi(e1[k].w)};
                    const float ci[4] = {t0[k].x, t0[k].y, t0[k].z, t0[k].w}, si[4] = {t2[k].x, t2[k].y, t2[k].z, t2[k].w};
                    float o[8];
#pragma unroll
                    for (int i = 0; i < 4; ++i) { o[i] = z[i] * ci[i] - z[4 + i] * si[i]; o[4 + i] = z[i] * si[i] + z[4 + i] * ci[i]; }
                    *(v4u*)(prow + cbase) = (v4u){pk2(o[0], o[1]), pk2(o[2], o[3]), pk2(o[4], o[5]), pk2(o[6], o[7])};
                } else if (r_kv) {
                    float z1[8] = {bflo(e1[k].x), bfhi(e1[k].x), bflo(e1[k].y), bfhi(e1[k].y), bflo(e1[k].z), bfhi(e1[k].z), bflo(e1[k].w), bfhi(e1[k].w)};
                    float z2[8] = {bflo(e2[k].x), bfhi(e2[k].x), bflo(e2[k].y), bfhi(e2[k].y), bflo(e2[k].z), bfhi(e2[k].z), bflo(e2[k].w), bfhi(e2[k].w)};
                    float o1[8], o2[8];
#pragma unroll
                    for (int i = 0; i < 8; ++i) { o1[i] = z1[i] * cs[i] - z2[i] * sn[i]; o2[i] = z1[i] * sn[i] + z2[i] * cs[i]; }
                    *(v4u*)(prow + cbase) = (v4u){pk2(o1[0], o1[1]), pk2(o1[2], o1[3]), pk2(o1[4], o1[5]), pk2(o1[6], o1[7])};
                    *(v4u*)(prow + cbase + 8) = (v4u){pk2(o2[0], o2[1]), pk2(o2[2], o2[3]), pk2(o2[4], o2[5]), pk2(o2[6], o2[7])};
                }
            }
        }
    }
    {
        const int wid = F.wave, r32 = lane & 31, hi = lane >> 5;
        LAS float* P = (LAS float*)F.lds;
        for (int u = F.vcu; u < BATCH * 8; u += F.G) {
            const int b = u >> 3, g = (u >> 2) & 1, kv = (u >> 1) & 1, eh = u & 1;
            const int rt = wid >> 1, part = wid & 1;
            const bf16* ap = B_PROJ + ((size_t)b * S + 16 * (32 * rt + r32)) * NP + (kv ? C_VCMP : C_KCMP) + g * 64 + 8 * hi;
            const bf16* bp = (const bf16*)(ws_ + WS_WCT) + ((size_t)(l * 2 + kv) * 128 + part * 64 + eh * 32 + r32) * 1024 + 8 * hi;
            f32x16 acc = {};
#pragma unroll 16
            for (int ks = 0; ks < 64; ++ks) {
                const bf16x8 a = *(const GAS bf16x8*)(ap + (size_t)(ks >> 2) * NP + 16 * (ks & 3));
                const bf16x8 bq = *(const GAS bf16x8*)(bp + 16 * ks);
                acc = MFMA32(a, bq, acc);
            }
#pragma unroll
            for (int r = 0; r < 16; ++r) P[(part * 128 + 32 * rt + crow(r, hi)) * 32 + r32] = acc[r];
            wg_barrier();
            const float* cb = (const float*)(ws_ + WS_CB) + (l * 2 + kv) * 64 + eh * 32;
            bf16* ob = (bf16*)(ws_ + (kv ? WS_VCB : WS_KCB)) + (size_t)(b * 2 + g) * 128 * 64 + eh * 32;
            for (int idx = tid_; idx < 128 * 32; idx += 512) { const int c = idx >> 5, e = idx & 31;
                const float v = (c < NC) ? (P[c * 32 + e] + P[(128 + c + 1) * 32 + e] + cb[e]) : 0.f;
                ob[c * 64 + e] = (bf16)f2bf(v); }
            wg_barrier();
        }
    }
}

typedef float f32x2_t __attribute__((ext_vector_type(2))); typedef __bf16 bf16x2_t __attribute__((ext_vector_type(2)));
__device__ __forceinline__ unsigned cvtpk(float lo, float hi) { const f32x2_t v = {lo, hi}; const bf16x2_t b = __builtin_convertvector(v, bf16x2_t); return __builtin_bit_cast(unsigned, b); }
constexpr float C2 = 0.125f * 1.4426950408889634f;

__device__ __forceinline__ unsigned idxmask(int x, int hi) {
    unsigned m = 0u;
#pragma unroll
    for (int g = 0; g < 4; ++g) { int n = x - (8 * g + 4 * hi); n = n < 0 ? 0 : (n > 4 ? 4 : n); m |= ((1u << n) - 1u) << (4 * g); }
    return m;
}

__device__ __forceinline__ void glds16(const void* g, unsigned lds_base) {
    unsigned sv; asm volatile("s_mov_b32 %0, m0\n\ts_mov_b32 m0, %2\n\ts_nop 0\n\tglobal_load_lds_dwordx4 %1, off\n\ts_mov_b32 m0, %0" : "=&s"(sv) : "v"(g), "s"(lds_base) : "memory"); }
__device__ __forceinline__ void glds4(const void* g, unsigned lds_base) {
    unsigned sv; asm volatile("s_mov_b32 %0, m0\n\ts_mov_b32 m0, %2\n\ts_nop 0\n\tglobal_load_lds_dword %1, off\n\ts_mov_b32 m0, %0" : "=&s"(sv) : "v"(g), "s"(lds_base) : "memory"); }
constexpr int SEL_QF = 0, SEL_PART = 16384, SEL_HIST = 20480, SEL_HP = 260, SEL_RES = SEL_HIST + 32 * SEL_HP * 4;
__device__ __forceinline__ void dsa_select_unit(unsigned char* ws_, int tid_, int b, int qt32, LAS unsigned char* lds) {
    asm volatile("" : "+v"(tid_)); asm volatile("" : "+s"(ws_));
    const int lane = tid_ & 63, wid = __builtin_amdgcn_readfirstlane(tid_ >> 6), r32 = lane & 31, hi = lane >> 5;
    unsigned* maskbuf = (unsigned*)(ws_ + WS_MASK);
    if (qt32 < 8) {
        for (int i = tid_; i < 2048; i += 512) { const int qq = i >> 6, blk = i & 63; const int t = 32 * qt32 + qq; const int d = t - 32 * blk;
            const unsigned w = d < 0 ? 0u : (d >= 31 ? 0xffffffffu : ((2u << d) - 1u));
            maskbuf[((size_t)b * S + t) * 64 + blk] = w; }
        return;
    }
    const size_t qrow = (size_t)b * S + 32 * qt32 + r32;
    const bf16* prow = B_PROJ + qrow * NP;
    {
        const int h = wid >> 1, sk = wid & 1;
        const v4u raw = *(const v4u*)(prow + C_QIDX + h * 32 + 16 * sk + 8 * hi);
        float x[8] = {bflo(raw.x), bfhi(raw.x), bflo(raw.y), bfhi(raw.y), bflo(raw.z), bfhi(raw.z), bflo(raw.w), bfhi(raw.w)};
        if (sk == 0 && hi == 0) { const float* tab = B_ROPE + qrow * 24;
#pragma unroll
            for (int i = 0; i < 4; ++i) { const float c = tab[16 + i], sn = tab[20 + i]; const float x1 = x[i], x2 = x[4 + i]; x[i] = x1 * c - x2 * sn; x[4 + i] = x1 * sn + x2 * c; } }
        v4u hp, lp;
        { unsigned hh[4], ll[4];
#pragma unroll
          for (int k = 0; k < 4; ++k) { const float a = x[2 * k], bb = x[2 * k + 1]; const unsigned ha = f2bf(a), hb = f2bf(bb); hh[k] = ha | (hb << 16);
              ll[k] = pk2(a - bf2f((bf16)ha), bb - bf2f((bf16)hb)); }
          hp = (v4u){hh[0], hh[1], hh[2], hh[3]}; lp = (v4u){ll[0], ll[1], ll[2], ll[3]}; }
        LAS v4u* qf = (LAS v4u*)(lds + SEL_QF);
        qf[((h * 2 + sk) * 2 + 0) * 64 + lane] = hp; qf[((h * 2 + sk) * 2 + 1) * 64 + lane] = lp;
    }
    float w[4];
#pragma unroll
    for (int h = 0; h < 4; ++h) w[h] = bf2f(prow[C_WIDX + h]);
    __syncthreads();
    const int nblk = qt32 + 1;
    const bf16* kbase = B_PROJ + (size_t)b * S * NP + C_KIDX;
    unsigned key[8][16];
    bf16x8 qhi[8];
#pragma unroll
    for (int j = 0; j < 8; ++j) qhi[j] = ((const LAS bf16x8*)(lds + SEL_QF))[(j * 2 + 0) * 64 + lane];
#pragma unroll
    for (int i = 0; i < 8; ++i) {
        const int blk = wid + 8 * i;
        if (blk < nblk) {
            const bf16* kp = kbase + (size_t)(32 * blk + r32) * NP + 8 * hi;
            const bf16x8 kf0 = *(const bf16x8*)kp, kf1 = *(const bf16x8*)(kp + 16);
            float sc[16];
            const LAS bf16x8* qf = (const LAS bf16x8*)(lds + SEL_QF);
#pragma unroll
            for (int h = 0; h < 4; ++h) {
                f32x16 acc = {};
                acc = MFMA32(kf0, qhi[h * 2 + 0], acc);
                acc = MFMA32(kf1, qhi[h * 2 + 1], acc);
                acc = MFMA32(kf0, qf[((h * 2 + 0) * 2 + 1) * 64 + lane], acc);
                acc = MFMA32(kf1, qf[((h * 2 + 1) * 2 + 1) * 64 + lane], acc);
#pragma unroll
                for (int r = 0; r < 16; ++r) sc[r] = (h == 0) ? w[0] * fmaxf(acc[r], 0.f) : fmaf(w[h], fmaxf(acc[r], 0.f), sc[r]);
            }
#pragma unroll
            for (int r = 0; r < 16; ++r) {
                unsigned bits = __builtin_bit_cast(unsigned, sc[r]);
                if (bits == 0x80000000u) bits = 0u;
                unsigned k = (bits & 0x80000000u) ? ~bits : (bits | 0x80000000u);
                if (blk == qt32 && crow(r, hi) > r32) k = 0u;
                key[i][r] = k;
            }
        } else {
#pragma unroll
            for (int r = 0; r < 16; ++r) key[i][r] = 0u;
        }
    }
    LAS unsigned* part = (LAS unsigned*)(lds + SEL_PART);
    int pbi = 0;
#define SEL_REDUCE(cnt_, tot_) do { LAS unsigned* pb_ = part + (pbi & 1) * 512; ++pbi; pb_[wid * 64 + lane] = (cnt_); wg_barrier(); unsigned t_ = 0u; \
        _Pragma("unroll") for (int w8 = 0; w8 < 8; ++w8) t_ += pb_[w8 * 64 + r32] + pb_[w8 * 64 + 32 + r32]; (tot_) = t_; } while (0)
    LAS unsigned* hist = (LAS unsigned*)(lds + SEL_HIST);
    LAS unsigned* resd = (LAS unsigned*)(lds + SEL_RES);
    { unsigned z_ = 0u; asm volatile("" : "+v"(z_)); const v4u zz = {z_, z_, z_, z_}; for (int i = tid_; i < 32 * SEL_HP / 4; i += 512) ((LAS v4u*)hist)[i] = zz; }
    wg_barrier();
    unsigned pfx = 0u, need = 256u;
    LAS unsigned* hrow = hist + r32 * SEL_HP;
#pragma unroll 1
    for (int pass = 0; pass < 4; ++pass) {
        const int shift = 24 - 8 * pass;
#pragma unroll
        for (int i = 0; i < 8; ++i) if (wid + 8 * i < nblk) {
#pragma unroll
            for (int r = 0; r < 16; ++r) {
                const unsigned k = key[i][r];
                const unsigned dg = (k >> shift) & 255u;
                const bool match = (pass == 0) || ((k >> (shift + 8)) == pfx);
                __hip_atomic_fetch_add(hrow + (match ? dg : 256u), 1u, __ATOMIC_RELAXED, __HIP_MEMORY_SCOPE_WORKGROUP);
            } }
        wg_barrier();
        {
            const int qq = lane >> 4, t16 = lane & 15, q = 4 * wid + qq;
            LAS v4u* hq = (LAS v4u*)(hist + q * SEL_HP + 16 * t16);
            unsigned g4[4];
#pragma unroll
            for (int i = 0; i < 4; ++i) { const v4u hv = hq[i]; g4[i] = (hv.x + hv.y) + (hv.z + hv.w); }
            const unsigned sL = (g4[0] + g4[1]) + (g4[2] + g4[3]);
            unsigned T = sL;
            T += (unsigned)dpp_i<0x101>((int)T); T += (unsigned)dpp_i<0x102>((int)T); T += (unsigned)dpp_i<0x104>((int)T); T += (unsigned)dpp_i<0x108>((int)T);
            const unsigned needq = (pass == 0) ? 256u : resd[32 + q];
            const unsigned long long bal = __ballot(T >= needq);
            const unsigned rowbits = (unsigned)(bal >> (16 * qq)) & 0xFFFFu;
            const int ts = 31 - __builtin_clz(rowbits | 1u);
            {
                const unsigned rem = needq - (T - sL);
                unsigned c = 0u; int gs = 0; unsigned abg = 0u; bool found = false;
#pragma unroll
                for (int i = 3; i >= 0; --i) { const unsigned cn = c + g4[i]; if (!found && rem <= cn) { gs = i; abg = c; found = true; } c = cn; }
                const v4u hv = hq[gs];
                const unsigned r2 = rem - abg;
                const unsigned c3 = hv.w, c2 = c3 + hv.z, c1 = c2 + hv.y;
                int d; unsigned ab;
                if (r2 <= c3) { d = 3; ab = 0u; } else if (r2 <= c2) { d = 2; ab = c3; } else if (r2 <= c1) { d = 1; ab = c2; } else { d = 0; ab = c1; }
                asm volatile("s_waitcnt lgkmcnt(0)" ::: "memory");
                const unsigned cd = (d == 3) ? hv.w : (d == 2) ? hv.z : (d == 1) ? hv.y : hv.x;
                if (t16 == ts) { resd[q] = 16u * (unsigned)ts + 4u * (unsigned)gs + (unsigned)d; resd[32 + q] = r2 - ab; resd[64 + q] = (cd == r2 - ab) ? 1u : 0u; }
            }
            { unsigned z_ = 0u; asm volatile("" : "+v"(z_)); const v4u zz = {z_, z_, z_, z_};
              hq[0] = zz; hq[1] = zz; hq[2] = zz; hq[3] = zz; if (t16 == 0) hist[q * SEL_HP + 256] = z_; }
        }
        wg_barrier();
        pfx = (pfx << 8) | resd[r32]; need = resd[32 + r32];
    }
    const unsigned thr = pfx;
    if (__all(resd[64 + r32] != 0u)) {
#pragma unroll
        for (int i = 0; i < 8; ++i) {
            const int blk = wid + 8 * i; unsigned selm = 0u;
            if (blk < nblk) {
#pragma unroll
                for (int r = 0; r < 16; ++r) selm |= (key[i][r] >= thr) ? (1u << r) : 0u; }
            unsigned word = ((selm & 0xFu) | ((selm & 0xF0u) << 4) | ((selm & 0xF00u) << 8) | ((selm & 0xF000u) << 12)) << (4 * hi);
            word = or_halves(word);
            if (hi == 0) maskbuf[qrow * 64 + blk] = word;
        }
        __syncthreads();
        return;
    }
    unsigned gtm[8], eqm[8];
#pragma unroll
    for (int i = 0; i < 8; ++i) { unsigned g = 0u, e = 0u;
        if (wid + 8 * i < nblk) {
#pragma unroll
            for (int r = 0; r < 16; ++r) { g |= (key[i][r] > thr) ? (1u << r) : 0u; e |= (key[i][r] == thr) ? (1u << r) : 0u; } }
        gtm[i] = g; eqm[i] = e; }
    const unsigned rneed = need;
    unsigned pc[8];
#pragma unroll
    for (int i = 0; i < 8; ++i) pc[i] = __builtin_popcount(eqm[i]);
    unsigned Y = 0u;
    for (int bit = 10; bit >= 5; --bit) {
        const unsigned c = Y | (1u << bit); const int cb = (int)(c >> 5);
        unsigned cnt = 0u;
#pragma unroll
        for (int i = 0; i < 8; ++i) cnt += (wid + 8 * i < cb) ? pc[i] : 0u;
        unsigned tot; SEL_REDUCE(cnt, tot);
        if (tot < rneed) Y = c;
    }
    {
        const int yb = (int)(Y >> 5);
        unsigned cbase = 0u, em = 0u;
#pragma unroll
        for (int i = 0; i < 8; ++i) { cbase += (wid + 8 * i < yb) ? pc[i] : 0u; em |= (wid + 8 * i == yb) ? eqm[i] : 0u; }
        for (int bit = 4; bit >= 0; --bit) {
            const unsigned c = Y | (1u << bit);
            const unsigned cnt = cbase + __builtin_popcount(em & idxmask((int)(c & 31u), hi));
            unsigned tot; SEL_REDUCE(cnt, tot);
            if (tot < rneed) Y = c;
        }
    }
#undef SEL_REDUCE
#pragma unroll
    for (int i = 0; i < 8; ++i) {
        const int blk = wid + 8 * i;
        const unsigned selm = gtm[i] | (eqm[i] & idxmask((int)Y + 1 - 32 * blk, hi));
        unsigned word = ((selm & 0xFu) | ((selm & 0xF0u) << 4) | ((selm & 0xF00u) << 8) | ((selm & 0xF000u) << 12)) << (4 * hi);
        word = or_halves(word);
        if (hi == 0) maskbuf[qrow * 64 + blk] = word;
    }
    __syncthreads();
}

constexpr int AT_K = 0, AT_V = 32768, AT_WS = 132096;
typedef short v4i16_t __attribute__((ext_vector_type(4)));
__device__ __forceinline__ s16x4 vtr(unsigned addr) { return __builtin_bit_cast(s16x4, __builtin_amdgcn_ds_read_tr16_b64_v4i16((LAS v4i16_t*)(uintptr_t)addr)); }
template <bool LACC = true>
__device__ __forceinline__ void pv(f32x16* o, f32x16& lacc, unsigned vb, bf16x8 pa0, bf16x8 pa1, bf16x8 pa2, bf16x8 pa3) {
    if constexpr (LACC) { const bf16x8 ones = {0x3F80, 0x3F80, 0x3F80, 0x3F80, 0x3F80, 0x3F80, 0x3F80, 0x3F80};
      lacc = MFMA32(pa0, ones, lacc); lacc = MFMA32(pa1, ones, lacc); lacc = MFMA32(pa2, ones, lacc); lacc = MFMA32(pa3, ones, lacc); }
#pragma unroll
    for (int d0 = 0; d0 < 2; ++d0) {
        const s16x4 lo0 = vtr(vb + d0 * 4096 + 0), hi0 = vtr(vb + d0 * 4096 + 512), lo1 = vtr(vb + d0 * 4096 + 1024), hi1 = vtr(vb + d0 * 4096 + 1536);
        const s16x4 lo2 = vtr(vb + d0 * 4096 + 2048), hi2 = vtr(vb + d0 * 4096 + 2560), lo3 = vtr(vb + d0 * 4096 + 3072), hi3 = vtr(vb + d0 * 4096 + 3584);
#define PKV(l_, h_) (bf16x8){l_[0], l_[1], l_[2], l_[3], h_[0], h_[1], h_[2], h_[3]}
        o[d0] = MFMA32(pa0, PKV(lo0, hi0), o[d0]);
        o[d0] = MFMA32(pa1, PKV(lo1, hi1), o[d0]);
        o[d0] = MFMA32(pa2, PKV(lo2, hi2), o[d0]);
        o[d0] = MFMA32(pa3, PKV(lo3, hi3), o[d0]);
#undef PKV
    }
}
struct SmState { float mhat; f32x16 o[2]; f32x16 lacc; };
__device__ __forceinline__ unsigned bfe1(unsigned w, int c) { int r; asm("v_bfe_i32 %0, %1, %2, 1" : "=v"(r) : "v"(w), "n"(c)); return (unsigned)r; }
__device__ __forceinline__ float rowmax32(const f32x16& p0, const f32x16& p1) {
    float a = fmaxf(p0[0], p1[0]);
#pragma unroll
    for (int r = 1; r < 16; ++r) a = fmaxf(a, fmaxf(p0[r], p1[r]));
    return max_halves(a);
}
constexpr int NS_QF = 65536, NS_SELS = 98304, NS_SSUM = 136192, NS_SELM = 144384;
static_assert(NS_SELS + 32768 <= LDSCTL_OFF && AT_WS >= MISC_OFF + 256 && NS_SELM + 256 <= LDS_BYTES, "attention LDS map");
__device__ __forceinline__ unsigned range32(int lo, int up) {
    const int l2 = lo < 0 ? 0 : lo, u2 = up > 31 ? 31 : up;
    const unsigned hm = (u2 >= 31) ? ~0u : ((2u << (u2 & 31)) - 1u);
    const unsigned lm = (1u << (l2 & 31)) - 1u;
    return (up < 0 || lo > 31 || u2 < l2) ? 0u : (hm & ~lm);
}
struct M64 { unsigned x, y; };
__device__ __forceinline__ M64 mask_range(int lo, int up) { M64 m; m.x = range32(lo, up); m.y = range32(lo - 32, up - 32); return m; }
__device__ __forceinline__ void load_q(bf16x8* qr, const bf16* qp, const float* tab, bool rope, int hi) {
#pragma unroll
    for (int d0 = 0; d0 < 4; ++d0) {
        const v4u raw = *(const v4u*)(qp + 16 * d0);
        float x[8] = {bflo(raw.x), bfhi(raw.x), bflo(raw.y), bfhi(raw.y), bflo(raw.z), bfhi(raw.z), bflo(raw.w), bfhi(raw.w)};
        if (d0 == 0) {
#pragma unroll
            for (int j = 0; j < 8; ++j) { const float other = other_half_f(x[j], hi); const float c = tab[j], sn = tab[8 + j];
                const float rot = (hi == 0) ? (x[j] * c - other * sn) : (other * sn + x[j] * c); x[j] = rope ? rot : x[j]; }
        }
        v4u pk; pk.x = cvtpk(x[0] * C2, x[1] * C2); pk.y = cvtpk(x[2] * C2, x[3] * C2); pk.z = cvtpk(x[4] * C2, x[5] * C2); pk.w = cvtpk(x[6] * C2, x[7] * C2);
        qr[d0] = __builtin_bit_cast(bf16x8, pk);
    }
}
__device__ __forceinline__ void qkt_lq(f32x16& p0, f32x16& p1, const LAS unsigned char* Kslot, const LAS bf16x8* qf, int lane, int r32, int hi) {
    const LAS unsigned char* kb = Kslot + hi * 1024 + r32 * 16;
    p0 = f32x16{}; p1 = f32x16{};
#pragma unroll
    for (int d0 = 0; d0 < 4; ++d0) {
        const bf16x8 b0 = *(const LAS bf16x8*)(kb + d0 * 2048);
        const bf16x8 b1 = *(const LAS bf16x8*)(kb + d0 * 2048 + 512);
        const bf16x8 q = qf[d0 * 64 + lane];
        p0 = MFMA32(b0, q, p0); p1 = MFMA32(b1, q, p1);
        if (d0 & 1) __builtin_amdgcn_sched_barrier(0);
    }
}
template <bool SEL>
__device__ __forceinline__ void softmax_pv(SmState& st, f32x16& osel, f32x16& p0, f32x16& p1, unsigned vb, const M64 mcur, bool first, LAS float* wsf, int r32, int hi, int ctile) {
    (void)first; (void)wsf; (void)r32;
    const unsigned wx = mcur.x >> (4 * hi), wy = mcur.y >> (4 * hi);
    unsigned e0[16], e1[16];
#pragma unroll
    for (int r = 0; r < 16; ++r) { e0[r] = __builtin_bit_cast(unsigned, __builtin_amdgcn_exp2f(p0[r])); e1[r] = __builtin_bit_cast(unsigned, __builtin_amdgcn_exp2f(p1[r])); }
    const bool lane_uniform = !SEL && __all((mcur.x == mcur.y) && ((mcur.x + 1u) <= 1u));
    if (!lane_uniform && !__all((mcur.x & mcur.y) == ~0u)) {
#pragma unroll
        for (int r = 0; r < 16; ++r) { const int c = (r & 3) + 8 * (r >> 2); e0[r] &= bfe1(wx, c); e1[r] &= bfe1(wy, c); }
    }
    unsigned pw[16];
#pragma unroll
    for (int k = 0; k < 8; ++k) { pw[k] = cvtpk(__builtin_bit_cast(float, e0[2 * k]), __builtin_bit_cast(float, e0[2 * k + 1])); pw[8 + k] = cvtpk(__builtin_bit_cast(float, e1[2 * k]), __builtin_bit_cast(float, e1[2 * k + 1])); }
    if (lane_uniform) {
#pragma unroll
        for (int k = 0; k < 16; ++k) pw[k] &= mcur.x;
    }
    if (SEL) {
#pragma unroll
        for (int ks = 0; ks < 4; ++ks) {
            unsigned ov[4], pl[4];
#pragma unroll
            for (int k = 0; k < 4; ++k) {
                const int j0 = 2 * k, j1 = 2 * k + 1;
                const int c0 = 64 * ctile + 16 * ks + 8 * (j0 >> 2) + 4 * hi + (j0 & 3), c1 = 64 * ctile + 16 * ks + 8 * (j1 >> 2) + 4 * hi + (j1 & 3);
                const unsigned a = (c0 >= 4 * r32 - 1 && c0 <= 4 * r32 + 3) ? 0x3F80u : 0u, bq = (c1 >= 4 * r32 - 1 && c1 <= 4 * r32 + 3) ? 0x3F80u : 0u;
                ov[k] = a | (bq << 16);
                const int e = 4 * ks + k;
                const float v0 = __builtin_bit_cast(float, (e < 8) ? e0[2 * e] : e1[2 * (e - 8)]), v1 = __builtin_bit_cast(float, (e < 8) ? e0[2 * e + 1] : e1[2 * (e - 8) + 1]);
                pl[k] = cvtpk(v0 - bflo(pw[e]), v1 - bfhi(pw[e]));
            }
            const bf16x8 ovf = __builtin_bit_cast(bf16x8, (v4u){ov[0], ov[1], ov[2], ov[3]});
            osel = MFMA32(__builtin_bit_cast(bf16x8, (v4u){pw[4 * ks], pw[4 * ks + 1], pw[4 * ks + 2], pw[4 * ks + 3]}), ovf, osel);
            osel = MFMA32(__builtin_bit_cast(bf16x8, (v4u){pl[0], pl[1], pl[2], pl[3]}), ovf, osel);
        }
    }
    pv(st.o, st.lacc, vb, __builtin_bit_cast(bf16x8, (v4u){pw[0], pw[1], pw[2], pw[3]}), __builtin_bit_cast(bf16x8, (v4u){pw[4], pw[5], pw[6], pw[7]}),
       __builtin_bit_cast(bf16x8, (v4u){pw[8], pw[9], pw[10], pw[11]}), __builtin_bit_cast(bf16x8, (v4u){pw[12], pw[13], pw[14], pw[15]}));
}
template <bool SEL>
__device__ __forceinline__ void tile_step(SmState& st, f32x16& osel, const LAS unsigned char* Kslot, unsigned vb, const LAS bf16x8* qf, const M64 mcur, bool first, LAS float* wsf, int lane, int r32, int hi, int ctile) {
    f32x16 p0, p1;
    qkt_lq(p0, p1, Kslot, qf, lane, r32, hi);
    softmax_pv<SEL>(st, osel, p0, p1, vb, mcur, first, wsf, r32, hi, ctile);
}
__device__ __forceinline__ void qkt_rq(f32x16& p0, f32x16& p1, const LAS unsigned char* Kslot, const bf16x8* qr, int r32, int hi) {
    const LAS unsigned char* kb = Kslot + hi * 1024 + r32 * 16;
    p0 = f32x16{}; p1 = f32x16{};
#pragma unroll
    for (int d0 = 0; d0 < 4; ++d0) {
        const bf16x8 b0 = *(const LAS bf16x8*)(kb + d0 * 2048);
        const bf16x8 b1 = *(const LAS bf16x8*)(kb + d0 * 2048 + 512);
        p0 = MFMA32(b0, qr[d0], p0); p1 = MFMA32(b1, qr[d0], p1);
    }
}
__device__ __forceinline__ void sm_reset(SmState& st) { st.mhat = 0.f; st.o[0] = f32x16{}; st.o[1] = f32x16{}; st.lacc = f32x16{}; }
__device__ __forceinline__ float sigmoidf_(float x) { return 1.f / (1.f + __expf(-x)); }

__device__ __forceinline__ void dsa_attn_unit(unsigned char* ws_, int tid_, int b, int qt, LAS unsigned char* lds) {
    asm volatile("" : "+v"(tid_)); asm volatile("" : "+s"(ws_));
    const int lane = tid_ & 63, wid = __builtin_amdgcn_readfirstlane(tid_ >> 6), r32 = lane & 31, hi = lane >> 5;
    const int h = wid >> 1, qh = wid & 1;
    const size_t qrow = (size_t)b * S + 64 * qt + 32 * qh + r32;
    LAS float* wsf = (LAS float*)(lds + AT_WS) + wid * 128;
    bf16x8 qr[4];
    {
        const bf16* qp = B_PROJ + qrow * NP + C_QA + h * 64 + 8 * hi;
        const float* tab = B_ROPE + qrow * 24;
#pragma unroll
        for (int d0 = 0; d0 < 4; ++d0) {
            const v4u raw = *(const v4u*)(qp + 16 * d0);
            float x[8] = {bflo(raw.x), bfhi(raw.x), bflo(raw.y), bfhi(raw.y), bflo(raw.z), bfhi(raw.z), bflo(raw.w), bfhi(raw.w)};
            if (d0 == 0) {
#pragma unroll
                for (int j = 0; j < 8; ++j) { const float other = other_half_f(x[j], hi); const float c = tab[j], sn = tab[8 + j];
                    x[j] = (hi == 0) ? (x[j] * c - other * sn) : (other * sn + x[j] * c); }
            }
            v4u pk; pk.x = cvtpk(x[0] * C2, x[1] * C2); pk.y = cvtpk(x[2] * C2, x[3] * C2); pk.z = cvtpk(x[4] * C2, x[5] * C2); pk.w = cvtpk(x[6] * C2, x[7] * C2);
            qr[d0] = __builtin_bit_cast(bf16x8, pk);
        }
    }
    constexpr int DK = 0, DV = 32768;
    const bf16* KAb = B_PROJ + (size_t)b * S * NP;
    const bf16* ksrc = KAb + (size_t)lane * NP + C_KA + wid * 8;
    const bf16* vsrc = KAb + (size_t)(16 * (wid & 3) + (lane >> 2)) * NP + C_VA + (wid >> 2) * 32 + (lane & 3) * 8;
#define AT_DMA(t, slot) do { \
        glds16(ksrc + (size_t)(t) * 64 * NP, (unsigned)__builtin_amdgcn_readfirstlane((int)(lds0 + DK + (slot) * 8192 + wid * 1024))); \
        glds16(vsrc + (size_t)(t) * 64 * NP, (unsigned)__builtin_amdgcn_readfirstlane((int)(lds0 + DV + (slot) * 8192 + wid * 1024))); } while (0)
    const unsigned lds0 = (unsigned)(uintptr_t)lds;
    const unsigned vb0 = (unsigned)(uintptr_t)(lds + DV) + ((lane >> 4) & 1) * 32 + (lane & 3) * 8 + (4 * hi + ((lane & 15) >> 2)) * 64;
    const LAS unsigned char* kb0 = lds + DK + hi * 1024 + r32 * 16;
    const int NT = qt + 1;
    SmState st; sm_reset(st);
    const GAS unsigned long long* mrow = (const GAS unsigned long long*)((const unsigned*)(ws_ + WS_MASK) + qrow * 64);
    AT_DMA(0, 0);
    constexpr int DM_LDS = 65536;
    const unsigned* msrc = (const unsigned*)(ws_ + WS_MASK) + ((size_t)b * S + 64 * qt + 32 * qh + (lane >> 1)) * 64 + (lane & 1);
#define MLD(k_, slot_) glds4(msrc + 2 * (k_), (unsigned)__builtin_amdgcn_readfirstlane((int)(lds0 + DM_LDS + (slot_) * 2048 + wid * 256)))
#define MRD(slot_) (*(const LAS unsigned long long*)(lds + DM_LDS + (slot_) * 2048 + wid * 256 + r32 * 8))
    MLD(0, 0);
    if (NT > 1) { AT_DMA(1, 1); MLD(1, 1); }
    (void)wsf;
#define SBAR() __builtin_amdgcn_sched_barrier(0)
#define PINV(x) asm volatile("" : "+v"(x))
#define KFR(t_, d0_, n_) (*(const LAS bf16x8*)(kb0 + ((t_) & 3) * 8192 + (d0_) * 2048 + (n_) * 512))
    f32x16 c0, c1;
    unsigned e0[16], e1[16];
    unsigned pw[16];
    unsigned long long mprev;
    {
        if (NT > 1) asm volatile("s_waitcnt vmcnt(3)" ::: "memory"); else asm volatile("s_waitcnt vmcnt(0)" ::: "memory");
        wg_barrier();
        if (NT > 2) { AT_DMA(2, 2); MLD(2, 2); }
        mprev = MRD(0);
        c0 = f32x16{}; c1 = f32x16{};
#pragma unroll
        for (int d0 = 0; d0 < 4; ++d0) { c0 = MFMA32(KFR(0, d0, 0), qr[d0], c0); c1 = MFMA32(KFR(0, d0, 1), qr[d0], c1); }
#pragma unroll
        for (int r = 0; r < 16; ++r) { e0[r] = __builtin_bit_cast(unsigned, __builtin_amdgcn_exp2f(c0[r])); e1[r] = __builtin_bit_cast(unsigned, __builtin_amdgcn_exp2f(c1[r])); }
    }
    const bf16x8 ones = {0x3F80, 0x3F80, 0x3F80, 0x3F80, 0x3F80, 0x3F80, 0x3F80, 0x3F80};
#define MPK(E_, W_, r_) (E_[r_] & bfe1(W_, ((r_) & 3) + 8 * ((r_) >> 2)))
#define PACK_SLICE(g_) do { if ((g_) < 4) { pw[2 * (g_)] = cvtpk(__builtin_bit_cast(float, MPK(e0, wx, 4 * (g_))), __builtin_bit_cast(float, MPK(e0, wx, 4 * (g_) + 1))); \
                                            pw[2 * (g_) + 1] = cvtpk(__builtin_bit_cast(float, MPK(e0, wx, 4 * (g_) + 2)), __builtin_bit_cast(float, MPK(e0, wx, 4 * (g_) + 3))); } \
        else { pw[2 * (g_)] = cvtpk(__builtin_bit_cast(float, MPK(e1, wy, 4 * ((g_) - 4))), __builtin_bit_cast(float, MPK(e1, wy, 4 * ((g_) - 4) + 1))); \
               pw[2 * (g_) + 1] = cvtpk(__builtin_bit_cast(float, MPK(e1, wy, 4 * ((g_) - 4) + 2)), __builtin_bit_cast(float, MPK(e1, wy, 4 * ((g_) - 4) + 3))); } \
        PINV(pw[2 * (g_)]); PINV(pw[2 * (g_) + 1]); } while (0)
#define PAF(j_) __builtin_bit_cast(bf16x8, (v4u){pw[4 * (j_)], pw[4 * (j_) + 1], pw[4 * (j_) + 2], pw[4 * (j_) + 3]})
#define VFRAG(d0_, j_) (bf16x8){vlo[d0_][j_][0], vlo[d0_][j_][1], vlo[d0_][j_][2], vlo[d0_][j_][3], vhi[d0_][j_][0], vhi[d0_][j_][1], vhi[d0_][j_][2], vhi[d0_][j_][3]}
#define EXPS(C_, E_, r_) do { E_[r_] = __builtin_bit_cast(unsigned, __builtin_amdgcn_exp2f(C_[r_])); PINV(E_[r_]); } while (0)
    for (int t = 1; t < NT; ++t) {
        if (t + 1 < NT) asm volatile("s_waitcnt vmcnt(3)" ::: "memory"); else asm volatile("s_waitcnt vmcnt(0)" ::: "memory");
        wg_barrier();
        if (t + 2 < NT) { AT_DMA(t + 2, (t + 2) & 3); MLD(t + 2, (t + 2) & 3); }
        const unsigned wx = (unsigned)mprev >> (4 * hi), wy = (unsigned)(mprev >> 32) >> (4 * hi);
        const unsigned vbp = vb0 + ((t - 1) & 3) * 8192;
        bf16x8 kf[8];
#pragma unroll
        for (int i = 0; i < 8; ++i) kf[i] = KFR(t, i >> 1, i & 1);
        SBAR();
        c0 = MFMA32(kf[0], qr[0], (f32x16{})); PACK_SLICE(0); SBAR();
        c1 = MFMA32(kf[1], qr[0], (f32x16{})); PACK_SLICE(1); SBAR();
        c0 = MFMA32(kf[2], qr[1], c0); PACK_SLICE(2); SBAR();
        c1 = MFMA32(kf[3], qr[1], c1); PACK_SLICE(3); SBAR();
        c0 = MFMA32(kf[4], qr[2], c0); PACK_SLICE(4); SBAR();
        c1 = MFMA32(kf[5], qr[2], c1); PACK_SLICE(5); SBAR();
        c0 = MFMA32(kf[6], qr[3], c0); PACK_SLICE(6); SBAR();
        c1 = MFMA32(kf[7], qr[3], c1); PACK_SLICE(7); SBAR();
        s16x4 vlo[2][4], vhi[2][4];
#pragma unroll
        for (int d0 = 0; d0 < 2; ++d0)
#pragma unroll
            for (int j = 0; j < 4; ++j) { vlo[d0][j] = vtr(vbp + d0 * 4096 + j * 1024); vhi[d0][j] = vtr(vbp + d0 * 4096 + j * 1024 + 512); }
        SBAR();
        st.lacc = MFMA32(PAF(0), ones, st.lacc); SBAR();
        st.lacc = MFMA32(PAF(1), ones, st.lacc); SBAR();
        st.lacc = MFMA32(PAF(2), ones, st.lacc); EXPS(c0, e0, 0); EXPS(c0, e0, 1); EXPS(c0, e0, 2); SBAR();
        st.lacc = MFMA32(PAF(3), ones, st.lacc); EXPS(c0, e0, 3); EXPS(c0, e0, 4); EXPS(c0, e0, 5); SBAR();
        st.o[0] = MFMA32(PAF(0), VFRAG(0, 0), st.o[0]); EXPS(c0, e0, 6); EXPS(c0, e0, 7); EXPS(c0, e0, 8); SBAR();
        st.o[1] = MFMA32(PAF(0), VFRAG(1, 0), st.o[1]); EXPS(c0, e0, 9); EXPS(c0, e0, 10); EXPS(c0, e0, 11); SBAR();
        st.o[0] = MFMA32(PAF(1), VFRAG(0, 1), st.o[0]); EXPS(c0, e0, 12); EXPS(c0, e0, 13); EXPS(c0, e0, 14); EXPS(c0, e0, 15); SBAR();
        st.o[1] = MFMA32(PAF(1), VFRAG(1, 1), st.o[1]); EXPS(c1, e1, 0); EXPS(c1, e1, 1); EXPS(c1, e1, 2); EXPS(c1, e1, 3); SBAR();
        st.o[0] = MFMA32(PAF(2), VFRAG(0, 2), st.o[0]); EXPS(c1, e1, 4); EXPS(c1, e1, 5); EXPS(c1, e1, 6); EXPS(c1, e1, 7); SBAR();
        st.o[1] = MFMA32(PAF(2), VFRAG(1, 2), st.o[1]); EXPS(c1, e1, 8); EXPS(c1, e1, 9); EXPS(c1, e1, 10); EXPS(c1, e1, 11); SBAR();
        st.o[0] = MFMA32(PAF(3), VFRAG(0, 3), st.o[0]); EXPS(c1, e1, 12); EXPS(c1, e1, 13); SBAR();
        st.o[1] = MFMA32(PAF(3), VFRAG(1, 3), st.o[1]); EXPS(c1, e1, 14); EXPS(c1, e1, 15); SBAR();
        mprev = MRD(t & 3);
    }
    {
        const unsigned wx = (unsigned)mprev >> (4 * hi), wy = (unsigned)(mprev >> 32) >> (4 * hi);
#pragma unroll
        for (int g = 0; g < 8; ++g) PACK_SLICE(g);
        pv(st.o, st.lacc, vb0 + ((NT - 1) & 3) * 8192, PAF(0), PAF(1), PAF(2), PAF(3));
    }
#undef SBAR
#undef PINV
#undef KFR
#undef MPK
#undef PACK_SLICE
#undef PAF
#undef VFRAG
#undef EXPS
#undef AT_DMA
#undef MLD
#undef MRD
    {
        GAS bf16* ob = (GAS bf16*)(B_MIX + ((size_t)b * S + 64 * qt + 32 * qh) * D + h * 64 + r32);
#pragma unroll
        for (int r = 0; r < 16; ++r) { const int rq = crow(r, hi); const float f = __builtin_amdgcn_rcpf(st.lacc[r]);
            ob[(size_t)rq * D] = (bf16)f2bf(st.o[0][r] * f); ob[(size_t)rq * D + 32] = (bf16)f2bf(st.o[1][r] * f); }
    }
    wg_barrier();
}


struct PipeState { unsigned e0[16], e1[16]; M64 mprev; unsigned vbprev; float ls; };
__device__ __forceinline__ void pipe_pack(PipeState& ps, int hi, unsigned (&pw)[16]) {
    const M64 mcur = ps.mprev;
    const unsigned wx = mcur.x >> (4 * hi), wy = mcur.y >> (4 * hi);
    const bool lane_uniform = __all((mcur.x == mcur.y) && ((mcur.x + 1u) <= 1u));
    if (!lane_uniform && !__all((mcur.x & mcur.y) == ~0u)) {
#pragma unroll
        for (int r = 0; r < 16; ++r) { const int c = (r & 3) + 8 * (r >> 2); ps.e0[r] &= bfe1(wx, c); ps.e1[r] &= bfe1(wy, c); }
    }
    { f32x2_t a2 = {0.f, 0.f};
#pragma unroll
      for (int k = 0; k < 8; ++k) { a2 += (f32x2_t){__builtin_bit_cast(float, ps.e0[2 * k]), __builtin_bit_cast(float, ps.e0[2 * k + 1])}; a2 += (f32x2_t){__builtin_bit_cast(float, ps.e1[2 * k]), __builtin_bit_cast(float, ps.e1[2 * k + 1])}; }
      float ts = a2[0] + a2[1];
      if (lane_uniform) ts = __builtin_bit_cast(float, __builtin_bit_cast(unsigned, ts) & mcur.x);
      ps.ls += ts; }
#pragma unroll
    for (int k = 0; k < 8; ++k) { pw[k] = cvtpk(__builtin_bit_cast(float, ps.e0[2 * k]), __builtin_bit_cast(float, ps.e0[2 * k + 1])); pw[8 + k] = cvtpk(__builtin_bit_cast(float, ps.e1[2 * k]), __builtin_bit_cast(float, ps.e1[2 * k + 1])); }
    if (lane_uniform) {
#pragma unroll
        for (int k = 0; k < 16; ++k) pw[k] &= mcur.x;
    }
}
__device__ __forceinline__ void pipe_step(SmState& st, PipeState& ps, const LAS unsigned char* Kslot, unsigned vb, const bf16x8 (&qf)[4], const M64 mcur, bool first, int lane, int r32, int hi) {
    f32x16 c0, c1;
    if (first) {
        qkt_rq(c0, c1, Kslot, qf, r32, hi);
#pragma unroll
        for (int r = 0; r < 16; ++r) { ps.e0[r] = __builtin_bit_cast(unsigned, __builtin_amdgcn_exp2f(c0[r])); ps.e1[r] = __builtin_bit_cast(unsigned, __builtin_amdgcn_exp2f(c1[r])); }
    } else {
        unsigned pw[16];
        pipe_pack(ps, hi, pw);
        qkt_rq(c0, c1, Kslot, qf, r32, hi);
        const unsigned vbp = ps.vbprev;
        s16x4 vlo[2][4], vhi[2][4];
#pragma unroll
        for (int d0 = 0; d0 < 2; ++d0)
#pragma unroll
            for (int j = 0; j < 4; ++j) { vlo[d0][j] = vtr(vbp + d0 * 4096 + j * 1024); vhi[d0][j] = vtr(vbp + d0 * 4096 + j * 1024 + 512); }
        const bf16x8 ones = {0x3F80, 0x3F80, 0x3F80, 0x3F80, 0x3F80, 0x3F80, 0x3F80, 0x3F80};
#define SBAR() __builtin_amdgcn_sched_barrier(0)
#define PAF(j_) __builtin_bit_cast(bf16x8, (v4u){pw[4 * (j_)], pw[4 * (j_) + 1], pw[4 * (j_) + 2], pw[4 * (j_) + 3]})
#define VFRAG(d0_, j_) (bf16x8){vlo[d0_][j_][0], vlo[d0_][j_][1], vlo[d0_][j_][2], vlo[d0_][j_][3], vhi[d0_][j_][0], vhi[d0_][j_][1], vhi[d0_][j_][2], vhi[d0_][j_][3]}
#define EXPS(C_, E_, r_) do { E_[r_] = __builtin_bit_cast(unsigned, __builtin_amdgcn_exp2f(C_[r_])); asm volatile("" : "+v"(E_[r_])); } while (0)
        (void)ones;
        SBAR();
        st.o[0] = MFMA32(PAF(0), VFRAG(0, 0), st.o[0]); SBAR();
        st.o[1] = MFMA32(PAF(0), VFRAG(1, 0), st.o[1]); EXPS(c0, ps.e0, 0); EXPS(c0, ps.e0, 1); EXPS(c0, ps.e0, 2); EXPS(c0, ps.e0, 3); SBAR();
        st.o[0] = MFMA32(PAF(1), VFRAG(0, 1), st.o[0]); EXPS(c0, ps.e0, 4); EXPS(c0, ps.e0, 5); EXPS(c0, ps.e0, 6); EXPS(c0, ps.e0, 7); EXPS(c0, ps.e0, 8); SBAR();
        st.o[1] = MFMA32(PAF(1), VFRAG(1, 1), st.o[1]); EXPS(c0, ps.e0, 9); EXPS(c0, ps.e0, 10); EXPS(c0, ps.e0, 11); EXPS(c0, ps.e0, 12); EXPS(c0, ps.e0, 13); SBAR();
        st.o[0] = MFMA32(PAF(2), VFRAG(0, 2), st.o[0]); EXPS(c0, ps.e0, 14); EXPS(c0, ps.e0, 15); EXPS(c1, ps.e1, 0); EXPS(c1, ps.e1, 1); EXPS(c1, ps.e1, 2); SBAR();
        st.o[1] = MFMA32(PAF(2), VFRAG(1, 2), st.o[1]); EXPS(c1, ps.e1, 3); EXPS(c1, ps.e1, 4); EXPS(c1, ps.e1, 5); EXPS(c1, ps.e1, 6); EXPS(c1, ps.e1, 7); SBAR();
        st.o[0] = MFMA32(PAF(3), VFRAG(0, 3), st.o[0]); EXPS(c1, ps.e1, 8); EXPS(c1, ps.e1, 9); EXPS(c1, ps.e1, 10); EXPS(c1, ps.e1, 11); SBAR();
        st.o[1] = MFMA32(PAF(3), VFRAG(1, 3), st.o[1]); EXPS(c1, ps.e1, 12); EXPS(c1, ps.e1, 13); EXPS(c1, ps.e1, 14); EXPS(c1, ps.e1, 15); SBAR();
#undef SBAR
#undef VFRAG
#undef EXPS
    }
    ps.mprev = mcur; ps.vbprev = vb;
}
__device__ __forceinline__ void pipe_drain(SmState& st, PipeState& ps, int hi) {
    unsigned pw[16];
    pipe_pack(ps, hi, pw);
    pv<false>(st.o, st.lacc, ps.vbprev, PAF(0), PAF(1), PAF(2), PAF(3));
#undef PAF
}
__device__ __forceinline__ void pipe_lsum(SmState& st, const PipeState& ps, LAS float* wsf, int r32, int hi) {
    const float t = ps.ls + __shfl_xor(ps.ls, 32);
    if (hi == 0) wsf[r32] = t;
    asm volatile("s_waitcnt lgkmcnt(0)" ::: "memory");
#pragma unroll
    for (int r = 0; r < 16; ++r) st.lacc[r] = wsf[crow(r, hi)];
}

template <bool SEL>
__device__ __forceinline__ void nsa_unit(unsigned char* ws_, int tid_, int b, int g, int qt, LAS unsigned char* lds) {
    asm volatile("" : "+v"(tid_)); asm volatile("" : "+s"(ws_));
    const int lane = tid_ & 63, wid = __builtin_amdgcn_readfirstlane(tid_ >> 6), r32 = lane & 31, hi = lane >> 5;
    const int hr = wid >> 1, qh = wid & 1, H = 4 * g + hr;
    const int tq = 64 * qt + 32 * qh + r32;
    const size_t qrow = (size_t)b * S + tq;
    LAS float* wsf = (LAS float*)(lds + AT_WS) + wid * 128;
    const unsigned lds0 = (unsigned)(uintptr_t)lds;
    const unsigned vb0 = (unsigned)(uintptr_t)(lds + AT_V) + ((lane >> 4) & 1) * 32 + (lane & 3) * 8 + (4 * hi + ((lane & 15) >> 2)) * 64;
    const bf16* kcb = (const bf16*)(ws_ + WS_KCB) + (size_t)(b * 2 + g) * 128 * 64;
    const bf16* vcb = (const bf16*)(ws_ + WS_VCB) + (size_t)(b * 2 + g) * 128 * 64;
    const bf16* pb = B_PROJ + (size_t)b * S * NP + g * 64;
    const int vrow = 16 * (wid & 3) + (lane >> 2), vcol = (wid >> 2) * 32 + (lane & 3) * 8;
#define NS_DMA(kp_, vp_, slot_) do { \
        glds16((kp_), (unsigned)__builtin_amdgcn_readfirstlane((int)(lds0 + AT_K + (slot_) * 8192 + wid * 1024))); \
        glds16((vp_), (unsigned)__builtin_amdgcn_readfirstlane((int)(lds0 + AT_V + (slot_) * 8192 + wid * 1024))); } while (0)
#define NS_DMA_CMP(i_, slot_) NS_DMA(kcb + (size_t)(64 * (i_) + lane) * 64 + wid * 8, vcb + (size_t)(64 * (i_) + vrow) * 64 + vcol, slot_)
#define NS_DMA_PROJ(ck_, cv_, j_, slot_) NS_DMA(pb + (size_t)(64 * (j_) + lane) * NP + (ck_) + wid * 8, pb + (size_t)(64 * (j_) + vrow) * NP + (cv_) + vcol, slot_)
    const int ncmp = (qt >= 16) ? 2 : 1;
    const int jw0 = (qt > 8) ? qt - 8 : 0, nwin = qt - jw0 + 1;
    if (hi == 0) { const bf16* gp = B_PROJ + qrow * NP + C_GATE + H * 3;
        wsf[64 + r32] = sigmoidf_(bf2f(gp[0])); wsf[96 + r32] = sigmoidf_(bf2f(gp[2])); wsf[32 + r32] = sigmoidf_(bf2f(gp[1])); }
    int nissued = 0, islot = 0, ti = 0, cslot = 0;
    unsigned remI = SEL ? 0u : ((2u << qt) - 1u);
#define NS_ISSUE() do { \
        if (nissued < ncmp) { NS_DMA_CMP(nissued, islot); } \
        else if (nissued < ncmp + nwin) { NS_DMA_PROJ(C_KWIN, C_VWIN, jw0 + nissued - ncmp, islot); } \
        else if (remI) { const int j_ = __builtin_ctz(remI); remI &= remI - 1u; NS_DMA_PROJ(C_KSLC, C_VSLC, j_, islot); } \
        else break; \
        ++nissued; islot = (islot + 1) & 3; } while (0)
#define NS_TOP() do { if (nissued > ti + 1) asm volatile("s_waitcnt vmcnt(2)" ::: "memory"); else asm volatile("s_waitcnt vmcnt(0)" ::: "memory"); wg_barrier(); NS_ISSUE(); } while (0)
#define NS_ADV() do { ++ti; cslot = (cslot + 1) & 3; } while (0)
    NS_ISSUE(); NS_ISSUE();
    LAS bf16x8* qf = (LAS bf16x8*)(lds + NS_QF) + wid * 256;
    { bf16x8 qr[4]; load_q(qr, B_PROJ + qrow * NP + C_QB + H * 64 + 8 * hi, B_ROPE + qrow * 24, false, hi);
#pragma unroll
      for (int d0 = 0; d0 < 4; ++d0) qf[d0 * 64 + lane] = qr[d0]; }
    SmState st; sm_reset(st);
    f32x16 osel = {};
    unsigned oaccp[16];
    const int ncv = (tq >= 31) ? (((tq - 31) >> 4) + 1) : 0;
    for (int i = 0; i < ncmp; ++i) {
        NS_TOP();
        const M64 m = mask_range(0, ncv - 64 * i - 1);
        tile_step<SEL>(st, osel, lds + AT_K + cslot * 8192, vb0 + cslot * 8192, qf, m, i == 0, wsf, lane, r32, hi, i);
        NS_ADV();
    }
    {
        asm volatile("s_waitcnt lgkmcnt(0)" ::: "memory");
        LAS float* sels = (LAS float*)(lds + NS_SELS);
#pragma unroll
        for (int r = 0; r < 16; ++r) { const int rq = crow(r, hi); const float lt = st.lacc[r]; const float inv = lt > 0.f ? __builtin_amdgcn_rcpf(lt) : 0.f; const float f2 = wsf[64 + rq] * inv;
            oaccp[r] = cvtpk(st.o[0][r] * f2, st.o[1][r] * f2); asm volatile("" : "+v"(oaccp[r]));
            if (SEL) sels[(hr * 64 + 32 * qh + rq) * 32 + r32] = osel[r] * inv; }
        asm volatile("s_waitcnt lgkmcnt(0)" ::: "memory");
    }
    unsigned selunion;
    if (SEL) {
        wg_barrier();
        LAS float* sels = (LAS float*)(lds + NS_SELS);
        LAS float* ssum = (LAS float*)(lds + NS_SSUM);
        LAS unsigned* selm = (LAS unsigned*)(lds + NS_SELM);
        const int q = tid_ >> 3, jg = tid_ & 7;
        f32x4 s4 = *(const LAS f32x4*)(sels + (0 * 64 + q) * 32 + 4 * jg);
        s4 += *(const LAS f32x4*)(sels + (1 * 64 + q) * 32 + 4 * jg);
        s4 += *(const LAS f32x4*)(sels + (2 * 64 + q) * 32 + 4 * jg);
        s4 += *(const LAS f32x4*)(sels + (3 * 64 + q) * 32 + 4 * jg);
        *(LAS f32x4*)(ssum + q * 32 + 4 * jg) = s4;
        asm volatile("s_waitcnt lgkmcnt(0)" ::: "memory");
        float sv[32];
#pragma unroll
        for (int k = 0; k < 8; ++k) { const f32x4 v = *(const LAS f32x4*)(ssum + q * 32 + 4 * k); sv[4 * k] = v.x; sv[4 * k + 1] = v.y; sv[4 * k + 2] = v.z; sv[4 * k + 3] = v.w; }
        const float PINF = __builtin_inff();
#pragma unroll
        for (int i = 0; i < 32; ++i) sv[i] = (i > qt) ? -PINF : ((i == 0 || i == qt || i == qt - 1) ? PINF : sv[i]);
        unsigned bits4 = 0u;
#pragma unroll
        for (int jj = 0; jj < 4; ++jj) {
            const int j = 4 * jg + jj;
            float mine = (jj == 0) ? s4.x : (jj == 1) ? s4.y : (jj == 2) ? s4.z : s4.w;
            mine = (j > qt) ? -PINF : ((j == 0 || j == qt || j == qt - 1) ? PINF : mine);
            int rank = 0;
#pragma unroll
            for (int i = 0; i < 32; ++i) rank += ((sv[i] > mine) || (sv[i] == mine && i < j)) ? 1 : 0;
            bits4 |= (rank < 16) ? (1u << jj) : 0u;
        }
        unsigned mm = bits4 << (4 * jg);
        mm |= (unsigned)dpp_i<0xB1>((int)mm); mm |= (unsigned)dpp_i<0x4E>((int)mm); mm |= (unsigned)dpp_i<0x141>((int)mm);
        if (jg == 0) selm[q] = mm;
        wg_barrier();
        unsigned u = selm[lane];
        u = or_halves(or32(u));
        selunion = (unsigned)__builtin_amdgcn_readfirstlane((int)u);
    } else {
        selunion = (2u << qt) - 1u;
    }
    bf16x8 qrw[4]; load_q(qrw, B_PROJ + qrow * NP + C_QB + H * 64 + 8 * hi, B_ROPE + qrow * 24, true, hi);
    sm_reset(st);
    if (SEL) remI = selunion;
    PipeState ps; ps.ls = 0.f;
    for (int j = jw0; j <= qt; ++j) {
        NS_TOP();
        const M64 m = mask_range(tq - 511 - 64 * j, tq - 64 * j);
        pipe_step(st, ps, lds + AT_K + cslot * 8192, vb0 + cslot * 8192, qrw, m, j == jw0, lane, r32, hi);
        NS_ADV();
    }
    pipe_drain(st, ps, hi);
    pipe_lsum(st, ps, wsf, r32, hi);
    {
        asm volatile("s_waitcnt lgkmcnt(0)" ::: "memory");
#pragma unroll
        for (int r = 0; r < 16; ++r) { const float lt = st.lacc[r]; const float f2 = lt > 0.f ? wsf[96 + crow(r, hi)] * __builtin_amdgcn_rcpf(lt) : 0.f; oaccp[r] = cvtpk(bflo(oaccp[r]) + st.o[0][r] * f2, bfhi(oaccp[r]) + st.o[1][r] * f2); asm volatile("" : "+v"(oaccp[r])); }
        asm volatile("s_waitcnt lgkmcnt(0)" ::: "memory");
    }
    sm_reset(st); ps.ls = 0.f;
    bool firstb = true;
    unsigned rem = selunion;
    while (rem) {
        const int j = __builtin_ctz(rem); rem &= rem - 1u;
        NS_TOP();
        const unsigned mysel_ = SEL ? ((const LAS unsigned*)(lds + NS_SELM))[32 * qh + r32] : ((2u << qt) - 1u);
        M64 m = mask_range(0, tq - 64 * j); if (!((mysel_ >> j) & 1u)) { m.x = 0u; m.y = 0u; }
        pipe_step(st, ps, lds + AT_K + cslot * 8192, vb0 + cslot * 8192, qrw, m, firstb, lane, r32, hi);
        firstb = false; NS_ADV();
    }
    pipe_drain(st, ps, hi);
    pipe_lsum(st, ps, wsf, r32, hi);
    {
        asm volatile("s_waitcnt lgkmcnt(0)" ::: "memory");
        GAS bf16* ob = (GAS bf16*)(B_MIX + ((size_t)b * S + 64 * qt + 32 * qh) * D + 256 + H * 64 + r32);
#pragma unroll
        for (int r = 0; r < 16; ++r) { const int rq = crow(r, hi); const float lt = st.lacc[r]; const float f2 = lt > 0.f ? wsf[32 + rq] * __builtin_amdgcn_rcpf(lt) : 0.f;
            ob[(size_t)rq * D] = (bf16)f2bf(bflo(oaccp[r]) + st.o[0][r] * f2); ob[(size_t)rq * D + 32] = (bf16)f2bf(bfhi(oaccp[r]) + st.o[1][r] * f2); }
    }
    wg_barrier();
#undef NS_DMA
#undef NS_DMA_CMP
#undef NS_DMA_PROJ
#undef NS_ISSUE
#undef NS_TOP
#undef NS_ADV
}

__device__ __forceinline__ void phase_attn(Frame& F, int l) {
    (void)l;
    unsigned char* ws_ = F.ws; asm volatile("" : "+s"(ws_)); int lane_ = lane_id(); asm volatile("" : "+v"(lane_)); (void)ws_;
    int tid_ = F.wave * 64 + lane_id(); asm volatile("" : "+v"(tid_));
    for (int u = F.vcu; u < BATCH * 64; u += F.G) {
        const int c = u & 255, i = u >> 8; const int b = c >> 3, sft = c & 7; const int base = 16 * (i >> 1); const int qt32 = (i & 1) ? base + 15 - sft : base + sft;
        dsa_select_unit(ws_, tid_, b, qt32, F.lds);
    }
    __syncthreads();
#if PROBE_MASK
    if (blockIdx.x == 0 && F.wave == 0 && lane_id() == 0) { const unsigned long long ts_ = __builtin_amdgcn_s_memrealtime(); F.MISC[16] = (unsigned)ts_; F.MISC[17] = (unsigned)(ts_ >> 32); }
#endif
    for (int u = F.vcu; u < BATCH * 64; u += F.G) {
        const int c = u & 255, i = u >> 8; const int b = c >> 3, sft = c & 7; const int g = i & 1, k = i >> 1; const int base = 16 * (k >> 1); const int qt = (k & 1) ? base + 15 - sft : base + sft;
        if (qt >= 16) nsa_unit<true>(ws_, tid_, b, g, qt, F.lds); else nsa_unit<false>(ws_, tid_, b, g, qt, F.lds);
    }
}
__device__ __forceinline__ void phase_dsa_attn(Frame& F) {
    unsigned char* ws_ = F.ws; asm volatile("" : "+s"(ws_));
    int tid_ = F.wave * 64 + lane_id(); asm volatile("" : "+v"(tid_));
    for (int u = F.vcu; u < BATCH * 32; u += F.G) {
        const int c = u & 255, i = u >> 8; const int b = c >> 3, sft = c & 7; const int base = 16 * (i >> 1); const int qt = (i & 1) ? base + 15 - sft : base + sft;
        dsa_attn_unit(ws_, tid_, b, qt, F.lds);
    }
}

constexpr int WP_PITCH = 72;
__device__ __forceinline__ void phase_merge(Frame& F, const Args& args, int l) {
    unsigned char* ws_ = F.ws; asm volatile("" : "+s"(ws_)); int lane_ = lane_id(); asm volatile("" : "+v"(lane_)); (void)ws_;
    int tid_ = F.wave * 64 + lane_id(); asm volatile("" : "+v"(tid_));
    const int gw = F.vcu * NWAVES + F.wave, NGW = F.G * NWAVES, lane = lane_;
    const float* psc = P_POOL_SCALE + l * 256;
    const float* goa = P_G_OUT_A + l * 256; const float* gob = P_G_OUT_B + l * 512;
    LAS bf16* wp = (LAS bf16*)F.lds;
    {
        const float* wsrc = P_W_POOL + (size_t)l * 4 * 64 * 64;
        for (int idx = tid_; idx < 4 * 64 * 64; idx += 512) { const int g = idx >> 12, c = (idx >> 6) & 63, d = idx & 63; wp[(g * 64 + d) * WP_PITCH + c] = (bf16)f2bf(wsrc[idx]); }
    }
    {
        constexpr int RB = 4;
        const f32x4 gga = ((const f32x4*)goa)[lane]; const f32x4 gb0 = ((const f32x4*)gob)[2 * lane], gb1 = ((const f32x4*)gob)[2 * lane + 1];
        for (int row0 = gw * RB; row0 < M; row0 += NGW * RB) {
            unsigned long long ua[RB]; v4u ub[RB];
#pragma unroll
            for (int k = 0; k < RB; ++k) { const bf16* mrow = B_MIX + (size_t)(row0 + k) * D; ua[k] = __builtin_nontemporal_load((const unsigned long long*)mrow + lane); ub[k] = __builtin_nontemporal_load((const v4u*)(mrow + 256) + lane); }
#pragma unroll
            for (int k = 0; k < RB; ++k) { unsigned char* m8 = ws_ + WS_MIX8 + (size_t)(row0 + k) * D;
                { const unsigned long long u = ua[k];
                  const float a0 = bflo((unsigned)u), a1 = bfhi((unsigned)u), a2 = bflo((unsigned)(u >> 32)), a3 = bfhi((unsigned)(u >> 32));
                  const float rs = rsqrtf(wave_sum((a0 * a0 + a1 * a1) + (a2 * a2 + a3 * a3)) * (1.f / 256.f) + EPS);
                  const float rm = rs * pg8::MSC;
                  *((unsigned*)m8 + lane) = pg8::pk4_fp8(a0 * rm * gga.x, a1 * rm * gga.y, a2 * rm * gga.z, a3 * rm * gga.w); }
                { const v4u u = ub[k];
                  float a[8] = {bflo(u.x), bfhi(u.x), bflo(u.y), bfhi(u.y), bflo(u.z), bfhi(u.z), bflo(u.w), bfhi(u.w)};
                  float ss = 0.f;
#pragma unroll
                  for (int i = 0; i < 8; ++i) ss += a[i] * a[i];
                  const float rs = rsqrtf(wave_sum(ss) * (1.f / 512.f) + EPS) * pg8::MSC;
                  *((unsigned long long*)(m8 + 256) + lane) = (unsigned long long)pg8::pk4_fp8(a[0] * rs * gb0.x, a[1] * rs * gb0.y, a[2] * rs * gb0.z, a[3] * rs * gb0.w)
                                                             | ((unsigned long long)pg8::pk4_fp8(a[4] * rs * gb1.x, a[5] * rs * gb1.y, a[6] * rs * gb1.z, a[7] * rs * gb1.w) << 32); }
            }
        }
    }
    __syncthreads();
    {
        const int r32 = lane & 31, hi = lane >> 5;
        for (int tile = gw; tile < M / 32; tile += NGW) {
            const int row = 32 * tile + r32, t = row % S, t0 = (32 * tile) % S;
            LAS unsigned char* stg = (LAS unsigned char*)F.lds + 40960 + F.wave * 8192;
            f32x16 acc[4][2];
#pragma unroll
            for (int g = 0; g < 4; ++g) {
                acc[g][0] = f32x16{}; acc[g][1] = f32x16{};
                const int w = 2 << g, nh = w - 1;
                const float icnt = 1.f / (float)((t + 1 < w) ? t + 1 : w);
                int lane_g = lane; asm volatile("" : "+v"(lane_g));
#pragma unroll
                for (int c0 = 0; c0 < (32 + nh) * 8; c0 += 64) { const int c = c0 + lane_g; if (c < (32 + nh) * 8) { const int j = c >> 3, c16 = c & 7;
                    v4u v = {0u, 0u, 0u, 0u};
                    if (t0 - nh + j >= 0) v = *(const GAS v4u*)(B_PROJ + ((size_t)32 * tile - nh + j) * NP + C_UC + g * 64 + c16 * 8);
                    *(LAS v4u*)(stg + j * 144 + c16 * 16) = v; } __builtin_amdgcn_sched_barrier(0); }
                LDS_FENCE();
#pragma unroll
                for (int ks = 0; ks < 4; ++ks) {
                    const LAS unsigned char* p0 = stg + (r32 + nh) * 144 + (16 * ks + 8 * hi) * 2;
                    const v4u u0 = *(const LAS v4u*)p0;
                    float cur[8] = {bflo(u0.x), bfhi(u0.x), bflo(u0.y), bfhi(u0.y), bflo(u0.z), bfhi(u0.z), bflo(u0.w), bfhi(u0.w)};
                    float sum[8];
#pragma unroll
                    for (int j = 0; j < 8; ++j) sum[j] = cur[j];
#pragma unroll
                    for (int i = 1; i < w; ++i) {
                        { const v4u ui = *(const LAS v4u*)(p0 - i * 144);
                            sum[0] += bflo(ui.x); sum[1] += bfhi(ui.x); sum[2] += bflo(ui.y); sum[3] += bfhi(ui.y); sum[4] += bflo(ui.z); sum[5] += bfhi(ui.z); sum[6] += bflo(ui.w); sum[7] += bfhi(ui.w); }
                    }
                    v4u pk; pk.x = cvtpk(sum[0] * icnt - cur[0], sum[1] * icnt - cur[1]); pk.y = cvtpk(sum[2] * icnt - cur[2], sum[3] * icnt - cur[3]);
                    pk.z = cvtpk(sum[4] * icnt - cur[4], sum[5] * icnt - cur[5]); pk.w = cvtpk(sum[6] * icnt - cur[6], sum[7] * icnt - cur[7]);
                    const bf16x8 af = __builtin_bit_cast(bf16x8, pk);
#pragma unroll
                    for (int nb = 0; nb < 2; ++nb) {
                        const bf16x8 bfr = *(const LAS bf16x8*)(wp + (g * 64 + 32 * nb + r32) * WP_PITCH + 16 * ks + 8 * hi);
                        acc[g][nb] = MFMA32(af, bfr, acc[g][nb]);
                    }
                    __builtin_amdgcn_sched_barrier(0);
                }
                LDS_FENCE();
            }
            float ss[16];
#pragma unroll
            for (int r = 0; r < 16; ++r) { float a = 0.f;
#pragma unroll
                for (int g = 0; g < 4; ++g) a += acc[g][0][r] * acc[g][0][r] + acc[g][1][r] * acc[g][1][r];
                a = sum32(a);
                ss[r] = rsqrtf(a * (1.f / 256.f) + EPS); }
#pragma unroll
            for (int g = 0; g < 4; ++g)
#pragma unroll
                for (int nb = 0; nb < 2; ++nb) { const float sc = psc[g * 64 + 32 * nb + r32] * pg8::MSC;
#pragma unroll
                    for (int r = 0; r < 16; r += 2) { const unsigned p2 = (unsigned)__builtin_amdgcn_cvt_pk_fp8_f32(acc[g][nb][r] * ss[r] * sc, acc[g][nb][r + 1] * ss[r + 1] * sc, 0, false);
                        stg[crow(r, hi) * 256 + g * 64 + 32 * nb + r32] = (unsigned char)p2; stg[crow(r + 1, hi) * 256 + g * 64 + 32 * nb + r32] = (unsigned char)(p2 >> 8); } }
            LDS_FENCE();
            unsigned char* ob8 = ws_ + WS_MIX8 + (size_t)(32 * tile) * D + 768;
            int lane_o = lane; asm volatile("" : "+v"(lane_o));
#pragma unroll
            for (int i = 0; i < 8; ++i) { const int row = 4 * i + (lane_o >> 4), c16 = lane_o & 15; *(GAS v4u*)(ob8 + (size_t)row * D + 16 * c16) = *(const LAS v4u*)(stg + row * 256 + 16 * c16); }
            LDS_FENCE();
        }
    }
    __syncthreads();
}

template <bool XIN_F32, bool OUT_F32, bool X8OUT = false>
__device__ __forceinline__ void phase_finish(Frame& F, const float* xsrc, const float* gpost, const float* gnext  , float fsc) {
    const float eps_eff = fsc * fsc * EPS;
    unsigned char* ws_ = F.ws; asm volatile("" : "+s"(ws_)); int lane_ = lane_id(); asm volatile("" : "+v"(lane_)); (void)ws_;
    const int gw = F.vcu * NWAVES + F.wave, NGW = F.G * NWAVES, lane = lane_;
    bf16* xb = (bf16*)(ws_ + WS_XB);
    constexpr int RB = 4;
    for (int row0 = gw * RB; row0 < M; row0 += NGW * RB) {
        v4u fu[RB][2]; float x[RB][2][8];
#pragma unroll
        for (int k = 0; k < RB; ++k) { const size_t row = (size_t)(row0 + k);
#pragma unroll
            for (int j = 0; j < 2; ++j) { fu[k][j] = __builtin_nontemporal_load((const v4u*)(B_F + row * D + 512 * j) + lane);
                if (XIN_F32) { const f32x4 a = *((const f32x4*)(xsrc + row * D + 512 * j) + 2 * lane), c = *((const f32x4*)(xsrc + row * D + 512 * j) + 2 * lane + 1);
                    x[k][j][0] = a.x; x[k][j][1] = a.y; x[k][j][2] = a.z; x[k][j][3] = a.w; x[k][j][4] = c.x; x[k][j][5] = c.y; x[k][j][6] = c.z; x[k][j][7] = c.w; }
                else { const v4u ux = __builtin_nontemporal_load((const v4u*)(xb + row * D + 512 * j) + lane);
                    x[k][j][0] = bflo(ux.x); x[k][j][1] = bfhi(ux.x); x[k][j][2] = bflo(ux.y); x[k][j][3] = bfhi(ux.y); x[k][j][4] = bflo(ux.z); x[k][j][5] = bfhi(ux.z); x[k][j][6] = bflo(ux.w); x[k][j][7] = bfhi(ux.w); } } }
        float gp[2][8];
#pragma unroll
        for (int j = 0; j < 2; ++j) { const f32x4 a = *((const f32x4*)(gpost + 512 * j) + 2 * lane), c = *((const f32x4*)(gpost + 512 * j) + 2 * lane + 1);
            gp[j][0] = a.x; gp[j][1] = a.y; gp[j][2] = a.z; gp[j][3] = a.w; gp[j][4] = c.x; gp[j][5] = c.y; gp[j][6] = c.z; gp[j][7] = c.w;
 }
#pragma unroll
        for (int k = 0; k < RB; ++k) { const size_t row = (size_t)(row0 + k);
            float f[2][8]; float ss = 0.f;
#pragma unroll
            for (int j = 0; j < 2; ++j) { const v4u u = fu[k][j];
                f[j][0] = bflo(u.x); f[j][1] = bfhi(u.x); f[j][2] = bflo(u.y); f[j][3] = bfhi(u.y); f[j][4] = bflo(u.z); f[j][5] = bfhi(u.z); f[j][6] = bflo(u.w); f[j][7] = bfhi(u.w);
#pragma unroll
                for (int e = 0; e < 8; ++e) ss += f[j][e] * f[j][e]; }
            const float rs = rsqrtf(wave_sum(ss) * (1.f / D) + eps_eff);
            float s2 = 0.f;
#pragma unroll
            for (int j = 0; j < 2; ++j) {
#pragma unroll
                for (int e = 0; e < 8; ++e) { const float xv = x[k][j][e] + f[j][e] * rs * gp[j][e]; x[k][j][e] = xv; s2 += xv * xv; }
                if (OUT_F32) { f32x4* o = (f32x4*)(F.out + row * D + 512 * j) + 2 * lane;
                    __builtin_nontemporal_store((f32x4){x[k][j][0], x[k][j][1], x[k][j][2], x[k][j][3]}, o); __builtin_nontemporal_store((f32x4){x[k][j][4], x[k][j][5], x[k][j][6], x[k][j][7]}, o + 1); }
                else __builtin_nontemporal_store((v4u){pk2(x[k][j][0], x[k][j][1]), pk2(x[k][j][2], x[k][j][3]), pk2(x[k][j][4], x[k][j][5]), pk2(x[k][j][6], x[k][j][7])}, (v4u*)(xb + row * D + 512 * j) + lane);
            }
            if (gnext) { const float r2 = rsqrtf(wave_sum(s2) * (1.f / D) + EPS); if (lane == 0) ((float*)(ws_ + WS_RS))[row] = r2;
                if (X8OUT) { const float r3 = r2 * pg8::XSC; unsigned char* x8 = ws_ + WS_X8 + row * D;
#pragma unroll
                    for (int j = 0; j < 2; ++j) __builtin_nontemporal_store((unsigned long long)pg8::pk4_fp8(x[k][j][0] * r3, x[k][j][1] * r3, x[k][j][2] * r3, x[k][j][3] * r3)
                        | ((unsigned long long)pg8::pk4_fp8(x[k][j][4] * r3, x[k][j][5] * r3, x[k][j][6] * r3, x[k][j][7] * r3) << 32), (unsigned long long*)(x8 + 512 * j) + lane); } }
        }
    }
}

template <int ACT>
__device__ __forceinline__ void phase_gemm(Frame& F, const bf16* A, const bf16* Bt, bf16* O, int N, int K, const float* rs) {
    asm volatile("" : "+s"(A), "+s"(Bt), "+s"(O), "+s"(rs));
    int bx_ = (int)blockIdx.x, gg_ = F.G; asm volatile("" : "+s"(bx_), "+s"(gg_));
    pg8::Gemm g{A, Bt, M, N, K}; pg8::StaticOrder So; So.init(M, N, gg_, bx_);
    pg8::EpiStore<ACT> E{O, N, rs};
    pg8::gemm_phase<pg8::EpiStore<ACT>, pg8::StaticOrder, true, true>(F.lds, g, So, E, F.wave);
}

__device__ __forceinline__ void phase_gemm_up8(Frame& F, const bf16* A, const bf16* Bt, unsigned char* O8, const float* rs) {
    asm volatile("" : "+s"(A), "+s"(Bt), "+s"(O8), "+s"(rs));
    int bx_ = (int)blockIdx.x, gg_ = F.G; asm volatile("" : "+s"(bx_), "+s"(gg_));
    pg8::Gemm g{A, Bt, M, FF, D}; pg8::StaticOrder So; So.init(M, FF, gg_, bx_);
    pg8::EpiRelu2Fp8T<true> E{O8, FF, rs};
    pg8::gemm_phase<pg8::EpiRelu2Fp8T<true>, pg8::StaticOrder, true, true>(F.lds, g, So, E, F.wave);
}
__device__ __forceinline__ void phase_gemm_up88(Frame& F, const unsigned char* A8, const unsigned char* Bt8, unsigned char* O8) {
    asm volatile("" : "+s"(A8), "+s"(Bt8), "+s"(O8));
    int bx_ = (int)blockIdx.x, gg_ = F.G; asm volatile("" : "+s"(bx_), "+s"(gg_));
    pg8::Gemm g{(const bf16*)A8, (const bf16*)Bt8, M, FF, D / 2}; pg8::StaticOrder So; So.init(M, FF, gg_, bx_);
    pg8::EpiRelu2Fp8T<false> E{O8, FF, nullptr};
    pg8::gemm_phase<pg8::EpiRelu2Fp8T<false>, pg8::StaticOrder, true, true, true>(F.lds, g, So, E, F.wave);
}
__device__ __forceinline__ void phase_gemm_down8(Frame& F, const unsigned char* A8, const unsigned char* Bt8, bf16* O) {
    asm volatile("" : "+s"(A8), "+s"(Bt8), "+s"(O));
    int bx_ = (int)blockIdx.x, gg_ = F.G; asm volatile("" : "+s"(bx_), "+s"(gg_));
    pg8::Gemm g{(const bf16*)A8, (const bf16*)Bt8, M, D, FF / 2}; pg8::StaticOrder So; So.init(M, D, gg_, bx_);
    pg8::EpiStore<0> E{O, D, nullptr};
    pg8::gemm_phase<pg8::EpiStore<0>, pg8::StaticOrder, true, true, true>(F.lds, g, So, E, F.wave);
}
__device__ __forceinline__ void phase_gemm_out8(Frame& F, const unsigned char* A8, const unsigned char* Bt8, bf16* O) {
    asm volatile("" : "+s"(A8), "+s"(Bt8), "+s"(O));
    int bx_ = (int)blockIdx.x, gg_ = F.G; asm volatile("" : "+s"(bx_), "+s"(gg_));
    pg8::Gemm g{(const bf16*)A8, (const bf16*)Bt8, M, D, D / 2}; pg8::StaticOrder So; So.init(M, D, gg_, bx_);
    pg8::EpiStore<0> E{O, D, nullptr};
    pg8::gemm_phase<pg8::EpiStore<0>, pg8::StaticOrder, true, true, true>(F.lds, g, So, E, F.wave);
}

constexpr int PH_PER_LAYER = 10, NPHASES = 2 + DEPTH * PH_PER_LAYER;
__global__ void __launch_bounds__(NWAVES * 64, 2) mk_fwd(Args args) {
    extern __shared__ __attribute__((aligned(16))) unsigned char lds[];
    Frame F;
    F.lds = (LAS unsigned char*)lds;
    F.MISC = (volatile LAS unsigned*)(F.lds + MISC_OFF);
    { const int t0_ = threadIdx.x; F.wave = __builtin_amdgcn_readfirstlane(t0_ >> 6);
      for (int u = t0_; u < (LDS_BYTES - LDSCTL_OFF) / 4; u += NWAVES * 64) ((LAS unsigned*)(F.lds + LDSCTL_OFF))[u] = 0u; }
    F.G = gridDim.x; { const int bx = blockIdx.x; F.vcu = (F.G % 8 == 0) ? (bx % 8) * (F.G / 8) + bx / 8 : bx; }
    unsigned char* ws = args.ws; F.ws = ws;
    F.ctl = (gu32*)(ws + WS_CTL);
    F.out = args.out;
    __syncthreads();
    XcdBarrier bar; bar.bar = (unsigned*)(F.ctl + CW_BAR); bar.x = 0; bar.st = F.MISC + 8; bar.wv = 0;
    if (args.use_bar) bar = xcd_barrier_post((unsigned*)(F.ctl + CW_BAR), F.MISC + 8);
    bar.wv = F.wave;
    const int lo = args.ph_lo, hi = args.ph_hi;
    int pid = 0;
    unsigned char* ws_ = F.ws;
#define PH_ON (pid >= lo && pid < hi)
#if PROBE_MASK
    if (blockIdx.x == 0 && F.wave == 0 && lane_id() == 0) { const unsigned long long t_ = __builtin_amdgcn_s_memrealtime(); F.MISC[18] = (unsigned)t_; F.MISC[19] = (unsigned)(t_ >> 32); F.MISC[20] = 0u; F.MISC[21] = 0u; }
#define PH_END(kind) do { if (PH_ON && pid + 1 < hi) xcd_barrier(bar); ++pid; \
        if (blockIdx.x == 0 && F.wave == 0 && lane_id() == 0) { const unsigned long long now_ = __builtin_amdgcn_s_memrealtime(); \
          const unsigned long long last_ = (unsigned long long)F.MISC[18] | ((unsigned long long)F.MISC[19] << 32); unsigned long long acc_ = (unsigned long long)F.MISC[20] | ((unsigned long long)F.MISC[21] << 32); \
          if ((kind) == 3) { const unsigned long long sp_ = (unsigned long long)F.MISC[16] | ((unsigned long long)F.MISC[17] << 32); \
              if ((PROBE_MASK >> 11) & 1) acc_ += sp_ - last_; if ((PROBE_MASK >> 3) & 1) acc_ += now_ - sp_; } \
          else if ((PROBE_MASK >> (kind)) & 1) acc_ += now_ - last_; \
          F.MISC[18] = (unsigned)now_; F.MISC[19] = (unsigned)(now_ >> 32); F.MISC[20] = (unsigned)acc_; F.MISC[21] = (unsigned)(acc_ >> 32); } } while (0)
#else
#define PH_END(kind) do { if (PH_ON && pid + 1 < hi) xcd_barrier(bar); ++pid; } while (0)
#endif

    if (PH_ON && !(SKIPM & 1)) phase_prologue(F, args);
    PH_END(0);
    if (PH_ON && !(SKIPM & 1)) phase_prologue_b(F, args);
    PH_END(0);
    for (int l = 0; l < DEPTH; ++l) {
        unsigned char* ws_ = F.ws; asm volatile("" : "+s"(ws_));
        if (PH_ON && !(SKIPM & 2)) phase_gemm<0>(F, (const bf16*)(ws_ + WS_XB), w_in_t(ws_, l), B_PROJ, NP, D, (const float*)(ws_ + WS_RS));
        PH_END(1);
        if (PH_ON && !(SKIPM & 4)) phase_prep(F, args, l);
        PH_END(2);
        if (PH_ON && !(SKIPM & 8)) phase_attn(F, l);
        PH_END(3);
        if (PH_ON && !(SKIPM & 8)) phase_dsa_attn(F);
        PH_END(4);
        if (PH_ON && !(SKIPM & 16)) phase_merge(F, args, l);
        PH_END(5);
        if (PH_ON && !(SKIPM & 32)) phase_gemm_out8(F, (const unsigned char*)(ws_ + WS_MIX8), (const unsigned char*)w_out_t(ws_, l), B_F);
        PH_END(6);
        if (PH_ON && !(SKIPM & 64)) { phase_finish<false, false, true>(F, nullptr, P_G_POST_MIX + l * D, P_G_PRE_MLP + l * D, pg8::MSC * pg8::WOSC); }
        PH_END(7);
        if (PH_ON && !(SKIPM & 128)) phase_gemm_up88(F, (const unsigned char*)(ws_ + WS_X8), (const unsigned char*)w_up_t(ws_, l), (unsigned char*)(ws_ + WS_HID));
        PH_END(8);
        if (PH_ON && !(SKIPM & 256)) phase_gemm_down8(F, (const unsigned char*)(ws_ + WS_HID), (const unsigned char*)w_dn_t(ws_, l), B_F);
        PH_END(9);
        if (PH_ON && !(SKIPM & 512)) { if (l + 1 < DEPTH) phase_finish<false, false>(F, nullptr, P_G_POST_MLP + l * D, P_G_PRE_MIX + (l + 1) * D, pg8::HSC * pg8::WDSC); else phase_finish<false, true>(F, nullptr, P_G_POST_MLP + l * D, nullptr, pg8::HSC * pg8::WDSC); }
        PH_END(10);
    }
#if PROBE_MASK
    if (blockIdx.x == 0 && F.wave == 0 && lane_id() == 0) { const unsigned long long pr_acc = (unsigned long long)F.MISC[20] | ((unsigned long long)F.MISC[21] << 32);
        const unsigned long long t0_ = __builtin_amdgcn_s_memrealtime(); while (__builtin_amdgcn_s_memrealtime() - t0_ < pr_acc) __builtin_amdgcn_s_sleep(8); }
#endif
#undef PH_ON
#undef PH_END
}

extern "C" void kernel_launch(void* const* d_in, const int* in_sizes, int n_in, void* d_out, int out_size, void* d_ws, size_t ws_size, hipStream_t stream) {
    static int grid = 0;
    if (grid == 0) {
        if (n_in != 20 || in_sizes[0] != M * D || out_size != M * D || ws_size < WS_END) {
            fprintf(stderr, "kernel_launch: unexpected shapes / workspace (n_in %d, in0 %d, out %d, ws %zu < %zu); nothing launched\n", n_in, n_in > 0 ? in_sizes[0] : -1, out_size, ws_size, (size_t)WS_END);
            grid = -1; return; }
        int dev = 0, cus = 0, per_cu = 0;
        if (hipGetDevice(&dev) != hipSuccess || hipDeviceGetAttribute(&cus, hipDeviceAttributeMultiprocessorCount, dev) != hipSuccess) { grid = -1; return; }
        if (hipFuncSetAttribute((const void*)mk_fwd, hipFuncAttributeMaxDynamicSharedMemorySize, LDS_BYTES) != hipSuccess) { fprintf(stderr, "kernel_launch: hipFuncSetAttribute failed\n"); grid = -1; return; }
        if (hipOccupancyMaxActiveBlocksPerMultiprocessor(&per_cu, (const void*)mk_fwd, NWAVES * 64, LDS_BYTES) != hipSuccess || per_cu < 1)
            fprintf(stderr, "kernel_launch: note: occupancy query reports %d workgroups per CU\n", per_cu);
        (void)hipGetLastError();
        grid = cus;
    }
    if (grid < 0) return;
    if (hipMemsetAsync((char*)d_ws + WS_CTL, 0, CTL_ZERO_BYTES, stream) != hipSuccess) return;
    Args a{};
    for (int i = 0; i < 20; ++i) a.in[i] = d_in[i];
    a.out = (float*)d_out; a.ws = (unsigned char*)d_ws; a.pad = 0;
#if MK_MULTI
    for (int p = 0; p < NPHASES; ++p) {
        a.ph_lo = p; a.ph_hi = p + 1; a.use_bar = 0;
        hipLaunchKernelGGL(mk_fwd, dim3(grid), dim3(NWAVES * 64), LDS_BYTES, stream, a);
    }
#else
    a.ph_lo = 0; a.ph_hi = NPHASES; a.use_bar = 1;
    hipLaunchKernelGGL(mk_fwd, dim3(grid), dim3(NWAVES * 64), LDS_BYTES, stream, a);
#endif
}
```
